# Optimizing an MI355X kernel written in HIP

```python
import jax
import jax.numpy as jnp
from jax import lax
import numpy as np

D_MODEL = 1024
BATCH = 1
SEQ = 16384
DEPTH = 4

GRID_W = 64
CTX_LEN = 256
N_MIXERS = 4
N_MOD = 6

FN_GROUPS = 4

HEAD_DIM = 64
FA_Q_HEADS = 16
FA_KV_HEADS = 4
WA_Q_HEADS = 16
WA_KV_HEADS = 2
WINDOW = 128
Q_BLOCK = 128
ROPE_THETA = 10000.0

GM_CHUNK = 128
GM_DFFN = 4 * D_MODEL
GM_GROUPS = 8

N_EXPERTS = 32
TOP_K = 4
EXPERT_FF = D_MODEL
SWIGLU_LIMIT = 7.0
SWIGLU_ALPHA = 1.702
MOE_BLOCK = 128

LN_EPS = 1e-5
RMS_EPS = 1e-6
NEG_INF = -1e30
DEEPNORM_ALPHA = (2 * DEPTH) ** 0.25
DEEPNORM_BETA = (8 * DEPTH) ** -0.25

N_FN = len(range(0, DEPTH, N_MIXERS))
N_FA = len(range(1, DEPTH, N_MIXERS))
N_GM = len(range(2, DEPTH, N_MIXERS))
N_WA = len(range(3, DEPTH, N_MIXERS))

kernel_name = 'hybrid_dit_fourier_gqa_gmlp_swa_moe'


def _layer_norm(x, g, b):
    xf = x.astype(jnp.float32)
    mu = jnp.mean(xf, axis=-1, keepdims=True)
    var = jnp.mean(jnp.square(xf - mu), axis=-1, keepdims=True)
    y = (xf - mu) * lax.rsqrt(var + LN_EPS) * g.astype(jnp.float32) + b.astype(jnp.float32)
    return y.astype(x.dtype)


def _rms_norm(x, g):
    xf = x.astype(jnp.float32)
    y = xf * lax.rsqrt(jnp.mean(xf * xf, axis=-1, keepdims=True) + RMS_EPS) * g.astype(jnp.float32)
    return y.astype(x.dtype)


def _modulate(x, shift, scale):
    return x * (1 + scale) + shift


def _axial_rope_tables(rows):
    row = jnp.repeat(jnp.arange(rows, dtype=jnp.float32), GRID_W)
    col = jnp.tile(jnp.arange(GRID_W, dtype=jnp.float32), rows)
    n_freq = HEAD_DIM // 4
    inv = ROPE_THETA ** (-jnp.arange(n_freq, dtype=jnp.float32) / n_freq)
    ang = jnp.concatenate([row[:, None] * inv, col[:, None] * inv], axis=-1)
    return jnp.cos(ang), jnp.sin(ang)


def _apply_rope(x, cos, sin):
    xf = x.astype(jnp.float32)
    x1, x2 = xf[..., 0::2], xf[..., 1::2]
    out = jnp.stack([x1 * cos - x2 * sin, x1 * sin + x2 * cos], axis=-1).reshape(xf.shape)
    return out.astype(x.dtype)


def _qkv(h, w_qkv, b_qkv, n_q, n_kv):
    bsz, n, _ = h.shape
    grp = n_q // n_kv
    qkv = h @ w_qkv + b_qkv
    q, k, v = jnp.split(qkv, [n_q * HEAD_DIM, (n_q + n_kv) * HEAD_DIM], axis=-1)
    q = q.reshape(bsz, n, n_kv, grp, HEAD_DIM).transpose(0, 2, 3, 1, 4)
    k = k.reshape(bsz, n, n_kv, HEAD_DIM).transpose(0, 2, 1, 3)
    v = v.reshape(bsz, n, n_kv, HEAD_DIM).transpose(0, 2, 1, 3)
    return q, k, v


def _merge_heads(o):
    bsz, hk, grp, n, dh = o.shape
    return o.transpose(0, 3, 1, 2, 4).reshape(bsz, n, hk * grp * dh)


def _gqa_softmax(q, k, v, mask=None, sink=None):
    s = jnp.einsum('bhgqd,bhkd->bhgqk', q, k, preferred_element_type=jnp.float32) * (HEAD_DIM ** -0.5)
    if mask is not None:
        s = jnp.where(mask, s, NEG_INF)
    if sink is not None:
        sk = jnp.broadcast_to(sink.astype(jnp.float32)[None, :, :, None, None], s.shape[:-1] + (1,))
        s = jnp.concatenate([s, sk], axis=-1)
    p = jax.nn.softmax(s, axis=-1)
    if sink is not None:
        p = p[..., :-1]
    return jnp.einsum('bhgqk,bhkd->bhgqd', p.astype(v.dtype), v)


def _fourier_mixer(h_lat, h_ctx, w_out, b_out, with_ctx):
    def run(h):
        bsz, n, d = h.shape
        hg = h.astype(jnp.float32).reshape(bsz, n, FN_GROUPS, d // FN_GROUPS)
        mixed = jnp.fft.fft2(hg, axes=(1, 3), norm='ortho').real.astype(h.dtype).reshape(bsz, n, d)
        return mixed @ w_out + b_out
    return run(h_lat), (run(h_ctx) if with_ctx else None)


def _full_attention_mixer(h_lat, h_ctx, cos, sin, w_qkv, b_qkv, q_norm, k_norm, w_out, b_out, with_ctx):
    bsz, n, _ = h_lat.shape
    grp = FA_Q_HEADS // FA_KV_HEADS
    nb = n // Q_BLOCK
    q, k, v = _qkv(h_lat, w_qkv, b_qkv, FA_Q_HEADS, FA_KV_HEADS)
    q = _apply_rope(_rms_norm(q, q_norm), cos, sin)
    k = _apply_rope(_rms_norm(k, k_norm), cos, sin)
    qc, kc, vc = _qkv(h_ctx, w_qkv, b_qkv, FA_Q_HEADS, FA_KV_HEADS)
    qc = _rms_norm(qc, q_norm)
    kc = _rms_norm(kc, k_norm)
    k_all = jnp.concatenate([k, kc], axis=2)
    v_all = jnp.concatenate([v, vc], axis=2)
    q_blocks = jnp.moveaxis(q.reshape(bsz, FA_KV_HEADS, grp, nb, Q_BLOCK, HEAD_DIM), 3, 0)
    o = lax.map(lambda qb: _gqa_softmax(qb, k_all, v_all), q_blocks)
    o = jnp.moveaxis(o, 0, 3).reshape(bsz, FA_KV_HEADS, grp, n, HEAD_DIM)
    y_lat = _merge_heads(o) @ w_out + b_out
    y_ctx = (_merge_heads(_gqa_softmax(qc, kc, vc)) @ w_out + b_out) if with_ctx else None
    return y_lat, y_ctx


def _gmlp_mixer(h_lat, h_ctx, w_in, b_in, v_norm_g, v_norm_b, w_s, b_s, w_out, b_out, with_ctx):
    half = GM_DFFN // 2
    def run(h):
        bsz, n, _ = h.shape
        z = jax.nn.gelu(h @ w_in + b_in, approximate=False)
        u, v = jnp.split(z, 2, axis=-1)
        v = _layer_norm(v, v_norm_g, v_norm_b)
        v = v.reshape(bsz, n // GM_CHUNK, GM_CHUNK, GM_GROUPS, half // GM_GROUPS)
        v = jnp.einsum('hpq,bnqhc->bnphc', w_s, v) + b_s.T[None, None, :, :, None]
        return (u * v.reshape(bsz, n, half)) @ w_out + b_out
    return run(h_lat), (run(h_ctx) if with_ctx else None)


def _window_attention_mixer(h_lat, h_ctx, cos, sin, w_qkv, b_qkv, sink, w_out, b_out, with_ctx):
    bsz, n, _ = h_lat.shape
    grp = WA_Q_HEADS // WA_KV_HEADS
    nb = n // Q_BLOCK
    span = Q_BLOCK + 2 * WINDOW
    q, k, v = _qkv(h_lat, w_qkv, b_qkv, WA_Q_HEADS, WA_KV_HEADS)
    q = _apply_rope(q, cos, sin)
    k = _apply_rope(k, cos, sin)
    qc, kc, vc = _qkv(h_ctx, w_qkv, b_qkv, WA_Q_HEADS, WA_KV_HEADS)
    sink_hg = sink.reshape(WA_KV_HEADS, grp)
    pad = ((0, 0), (0, 0), (WINDOW, WINDOW), (0, 0))
    k_pad = jnp.pad(k, pad)
    v_pad = jnp.pad(v, pad)
    qi = jnp.arange(Q_BLOCK)[:, None]
    kj = jnp.arange(span)[None, :]
    band = jnp.abs(kj - WINDOW - qi) <= WINDOW
    ctx_ok = jnp.ones((Q_BLOCK, kc.shape[2]), dtype=bool)
    q_blocks = jnp.moveaxis(q.reshape(bsz, WA_KV_HEADS, grp, nb, Q_BLOCK, HEAD_DIM), 3, 0)

    def block(args):
        qb, b_idx = args
        start = b_idx * Q_BLOCK
        kw = lax.dynamic_slice_in_dim(k_pad, start, span, axis=2)
        vw = lax.dynamic_slice_in_dim(v_pad, start, span, axis=2)
        kpos = start - WINDOW + jnp.arange(span)
        valid = band & ((kpos >= 0) & (kpos < n))[None, :]
        mask = jnp.concatenate([valid, ctx_ok], axis=-1)
        return _gqa_softmax(qb, jnp.concatenate([kw, kc], axis=2), jnp.concatenate([vw, vc], axis=2), mask, sink_hg)

    o = lax.map(block, (q_blocks, jnp.arange(nb)))
    o = jnp.moveaxis(o, 0, 3).reshape(bsz, WA_KV_HEADS, grp, n, HEAD_DIM)
    y_lat = _merge_heads(o) @ w_out + b_out
    y_ctx = (_merge_heads(_gqa_softmax(qc, kc, vc, None, sink_hg)) @ w_out + b_out) if with_ctx else None
    return y_lat, y_ctx


def _moe(h, router_w, router_b, w_gate_up, b_gate_up, w_down, b_down):
    n_tok, d = h.shape
    logits = (h @ router_w + router_b).astype(jnp.float32)
    top_val, top_idx = lax.top_k(logits, TOP_K)
    gates = jax.nn.softmax(top_val, axis=-1)
    n_assign = n_tok * TOP_K
    n_blocks = -(-n_assign // MOE_BLOCK) + N_EXPERTS
    n_slots = n_blocks * MOE_BLOCK
    flat_e = top_idx.reshape(-1)
    flat_tok = jnp.repeat(jnp.arange(n_tok, dtype=jnp.int32), TOP_K)
    flat_g = gates.reshape(-1)
    order = jnp.argsort(flat_e, stable=True)
    e_sorted = flat_e[order]
    counts = jnp.bincount(flat_e, length=N_EXPERTS)
    padded = (counts + MOE_BLOCK - 1) // MOE_BLOCK * MOE_BLOCK
    ends_pad = jnp.cumsum(padded)
    starts = jnp.cumsum(counts) - counts
    dest = (ends_pad - padded)[e_sorted] + jnp.arange(n_assign) - starts[e_sorted]
    slot_tok = jnp.full((n_slots,), n_tok, dtype=jnp.int32).at[dest].set(flat_tok[order])
    slot_gate = jnp.zeros((n_slots,), dtype=jnp.float32).at[dest].set(flat_g[order])
    block_expert = jnp.minimum(jnp.searchsorted(ends_pad, jnp.arange(n_blocks) * MOE_BLOCK, side='right'), N_EXPERTS - 1)
    h_pad = jnp.concatenate([h, jnp.zeros((1, d), h.dtype)], axis=0)
    xb = h_pad[slot_tok].reshape(n_blocks, MOE_BLOCK, d)

    def expert_block(args):
        xe, e = args
        gu = xe @ w_gate_up[e] + b_gate_up[e]
        x_glu = jnp.minimum(gu[:, 0::2], SWIGLU_LIMIT)
        x_lin = jnp.clip(gu[:, 1::2], -SWIGLU_LIMIT, SWIGLU_LIMIT)
        act = x_glu * jax.nn.sigmoid(SWIGLU_ALPHA * x_glu) * (x_lin + 1)
        return act @ w_down[e] + b_down[e]

    yb = lax.map(expert_block, (xb, block_expert)).reshape(n_slots, d)
    y = jax.ops.segment_sum(yb * slot_gate[:, None].astype(yb.dtype), slot_tok, num_segments=n_tok + 1)
    return y[:n_tok]


def setup_inputs(seed: int = 0) -> dict:
    key = jax.random.key(seed)
    keys = iter(jax.random.split(key, 48))

    def nrm(shape, scale):
        return jax.random.normal(next(keys), shape, jnp.float32) * scale

    d = D_MODEL
    fa_qkv = (FA_Q_HEADS + 2 * FA_KV_HEADS) * HEAD_DIM
    wa_qkv = (WA_Q_HEADS + 2 * WA_KV_HEADS) * HEAD_DIM
    gm_half = GM_DFFN // 2
    return {
        'x': nrm((BATCH, SEQ, d), 1.0),
        'c': nrm((BATCH, d), 1.0),
        'ctx': nrm((BATCH, CTX_LEN, d), 1.0),
        'c_ctx': nrm((d,), 1.0),
        'ada_w': nrm((DEPTH, d, N_MOD * d), d ** -0.5),
        'ada_b': nrm((DEPTH, N_MOD * d), 0.02),
        'ln_mix_g': 1.0 + nrm((DEPTH, d), 0.02),
        'ln_mix_b': nrm((DEPTH, d), 0.02),
        'ln_ffn_g': 1.0 + nrm((DEPTH, d), 0.02),
        'ln_ffn_b': nrm((DEPTH, d), 0.02),
        'fn_w_out': nrm((N_FN, d, d), DEEPNORM_BETA * d ** -0.5),
        'fn_b_out': nrm((N_FN, d), 0.02),
        'fa_w_qkv': nrm((N_FA, d, fa_qkv), d ** -0.5),
        'fa_b_qkv': nrm((N_FA, fa_qkv), 0.02),
        'fa_q_norm': 1.0 + nrm((N_FA, HEAD_DIM), 0.02),
        'fa_k_norm': 1.0 + nrm((N_FA, HEAD_DIM), 0.02),
        'fa_w_out': nrm((N_FA, FA_Q_HEADS * HEAD_DIM, d), DEEPNORM_BETA * (FA_Q_HEADS * HEAD_DIM) ** -0.5),
        'fa_b_out': nrm((N_FA, d), 0.02),
        'gm_w_in': nrm((N_GM, d, GM_DFFN), d ** -0.5),
        'gm_b_in': nrm((N_GM, GM_DFFN), 0.02),
        'gm_v_norm_g': 1.0 + nrm((N_GM, gm_half), 0.02),
        'gm_v_norm_b': nrm((N_GM, gm_half), 0.02),
        'gm_w_s': nrm((N_GM, GM_GROUPS, GM_CHUNK, GM_CHUNK), GM_CHUNK ** -0.5),
        'gm_b_s': 1.0 + nrm((N_GM, GM_GROUPS, GM_CHUNK), 0.02),
        'gm_w_out': nrm((N_GM, gm_half, d), DEEPNORM_BETA * gm_half ** -0.5),
        'gm_b_out': nrm((N_GM, d), 0.02),
        'wa_w_qkv': nrm((N_WA, d, wa_qkv), d ** -0.5),
        'wa_b_qkv': nrm((N_WA, wa_qkv), 0.02),
        'wa_sink': nrm((N_WA, WA_Q_HEADS), 0.5),
        'wa_w_out': nrm((N_WA, WA_Q_HEADS * HEAD_DIM, d), DEEPNORM_BETA * (WA_Q_HEADS * HEAD_DIM) ** -0.5),
        'wa_b_out': nrm((N_WA, d), 0.02),
        'router_w': nrm((DEPTH, d, N_EXPERTS), d ** -0.5),
        'router_b': nrm((DEPTH, N_EXPERTS), 0.01),
        'exp_w_gate_up': nrm((DEPTH, N_EXPERTS, d, 2 * EXPERT_FF), d ** -0.5),
        'exp_b_gate_up': nrm((DEPTH, N_EXPERTS, 2 * EXPERT_FF), 0.02),
        'exp_w_down': nrm((DEPTH, N_EXPERTS, EXPERT_FF, d), DEEPNORM_BETA * EXPERT_FF ** -0.5),
        'exp_b_down': nrm((DEPTH, N_EXPERTS, d), 0.02),
    }


def reference(x, c, ctx, c_ctx, ada_w, ada_b, ln_mix_g, ln_mix_b, ln_ffn_g, ln_ffn_b,
              fn_w_out, fn_b_out,
              fa_w_qkv, fa_b_qkv, fa_q_norm, fa_k_norm, fa_w_out, fa_b_out,
              gm_w_in, gm_b_in, gm_v_norm_g, gm_v_norm_b, gm_w_s, gm_b_s, gm_w_out, gm_b_out,
              wa_w_qkv, wa_b_qkv, wa_sink, wa_w_out, wa_b_out,
              router_w, router_b, exp_w_gate_up, exp_b_gate_up, exp_w_down, exp_b_down):
    bsz, n_lat, d = x.shape
    n_ctx = ctx.shape[1]
    rows = n_lat // GRID_W
    cos, sin = _axial_rope_tables(rows)
    silu_c = jax.nn.silu(c)
    silu_cc = jax.nn.silu(c_ctx)
    for i in range(DEPTH):
        kind, j = i % N_MIXERS, i // N_MIXERS
        with_ctx = i < DEPTH - 1
        sh1, sc1, g1, sh2, sc2, g2 = jnp.split((silu_c @ ada_w[i] + ada_b[i])[:, None, :], N_MOD, axis=-1)
        sh1c, sc1c, g1c, sh2c, sc2c, g2c = jnp.split((silu_cc @ ada_w[i] + ada_b[i])[None, None, :], N_MOD, axis=-1)
        h_lat = _modulate(x, sh1, sc1)
        h_ctx = _modulate(ctx, sh1c, sc1c)
        if kind == 0:
            y_lat, y_ctx = _fourier_mixer(h_lat, h_ctx, fn_w_out[j], fn_b_out[j], with_ctx)
        elif kind == 1:
            y_lat, y_ctx = _full_attention_mixer(h_lat, h_ctx, cos, sin, fa_w_qkv[j], fa_b_qkv[j], fa_q_norm[j],
                                                 fa_k_norm[j], fa_w_out[j], fa_b_out[j], with_ctx)
        elif kind == 2:
            y_lat, y_ctx = _gmlp_mixer(h_lat, h_ctx, gm_w_in[j], gm_b_in[j], gm_v_norm_g[j], gm_v_norm_b[j],
                                       gm_w_s[j], gm_b_s[j], gm_w_out[j], gm_b_out[j], with_ctx)
        else:
            y_lat, y_ctx = _window_attention_mixer(h_lat, h_ctx, cos, sin, wa_w_qkv[j], wa_b_qkv[j], wa_sink[j],
                                                   wa_w_out[j], wa_b_out[j], with_ctx)
        x = _layer_norm(DEEPNORM_ALPHA * x + g1 * y_lat, ln_mix_g[i], ln_mix_b[i])
        h_lat = _modulate(x, sh2, sc2)
        moe_args = (router_w[i], router_b[i], exp_w_gate_up[i], exp_b_gate_up[i], exp_w_down[i], exp_b_down[i])
        if with_ctx:
            ctx = _layer_norm(DEEPNORM_ALPHA * ctx + g1c * y_ctx, ln_mix_g[i], ln_mix_b[i])
            h_ctx = _modulate(ctx, sh2c, sc2c)
            tok = jnp.concatenate([h_ctx, h_lat], axis=1).reshape(-1, d)
            f = _moe(tok, *moe_args).reshape(bsz, n_ctx + n_lat, d)
            f_ctx, f_lat = f[:, :n_ctx], f[:, n_ctx:]
            ctx = _layer_norm(DEEPNORM_ALPHA * ctx + g2c * f_ctx, ln_ffn_g[i], ln_ffn_b[i])
        else:
            f_lat = _moe(h_lat.reshape(-1, d), *moe_args).reshape(bsz, n_lat, d)
        x = _layer_norm(DEEPNORM_ALPHA * x + g2 * f_lat, ln_ffn_g[i], ln_ffn_b[i])
    return x
```

```cpp
#define MK_PER_PHASE 1
#define EN_MIX 15
#define EN_MOE 15
#include <hip/hip_runtime.h>
#include <hip/hip_bf16.h>
#include <cstdio>
#include <cstdint>
#include <cmath>
#ifndef MK_PER_PHASE
#define MK_PER_PHASE 0
#endif
namespace pg8 {
#define PG8_LAS __attribute__((address_space(3)))
typedef unsigned short bf16_t;
typedef short bf16x8 __attribute__((ext_vector_type(8)));
typedef float f32x4 __attribute__((ext_vector_type(4)));
typedef float f32x2 __attribute__((ext_vector_type(2)));
typedef unsigned u32x4 __attribute__((ext_vector_type(4)));
typedef unsigned u32x2 __attribute__((ext_vector_type(2)));
constexpr int BM = 256, BK = 64, HALF = 128, HTB = HALF * BK * 2  , STAGE_BYTES = 8 * HTB, NXCD = 8, WGM = 8;

__host__ __device__ __forceinline__ int lds_byte(int r, int c) { const int st = (r >> 4) * 2 + (c >> 5), rr = r & 15, cc = c & 31, ob = rr * 64 + cc * 2; return st * 1024 + (ob ^ (((ob >> 9) & 1) << 5)); }
__host__ __device__ __forceinline__ void stage_rc(int b, int& R, int& C) { const int st = b / 1024, sb = b % 1024, swz = sb ^ (((sb >> 9) & 1) << 5); R = (st >> 1) * 16 + swz / 64; C = (st & 1) * 32 + (swz % 64) / 2; }
__host__ __device__ __forceinline__ int perm32(int rho) { const int n = rho >> 4, i = rho & 15; return 8 * (i >> 2) + 4 * n + (i & 3); }

struct Unit { int pm, pn, e; };
struct Gemm { const bf16_t* A; const bf16_t* Bt; int K, lda, ldb; unsigned hstepA, hstepB; };

struct GridOrder {
    int nM, nN, nwg, G, c;
    __device__ __forceinline__ void init(int nM_, int nN_, int G_, int c_) { nM = nM_; nN = nN_; nwg = nM * nN; G = G_; c = c_; }
    __device__ __forceinline__ bool next_mn(int i, int& pm, int& pn) const {
        const long L = (long)i * G + c; if (L >= nwg) return false;
        int wgid = (int)L; { const int q = nwg / NXCD, r = nwg % NXCD, xcd = wgid % NXCD, off = wgid / NXCD; wgid = (xcd < r ? xcd * (q + 1) : r * (q + 1) + (xcd - r) * q) + off; }
        const int nig = WGM * nN, gid = wgid / nig, fm = gid * WGM, gsz = (nM - fm) < WGM ? (nM - fm) : WGM;
        pm = fm + ((wgid % nig) % gsz); pn = (wgid % nig) / gsz; return true;
    }
};
__device__ __forceinline__ unsigned cvt_pk_bf16(float lo, float hi) { unsigned r; asm volatile("v_cvt_pk_bf16_f32 %0, %1, %2" : "=v"(r) : "v"(lo), "v"(hi)); return r; }
__device__ __forceinline__ f32x2 gelu_pk(f32x2 v) {
    const f32x2 av = __builtin_elementwise_abs(v), d = av * 0.2316418882f + 1.0f;
    f32x2 t; t.x = __builtin_amdgcn_rcpf(d.x); t.y = __builtin_amdgcn_rcpf(d.y);
    f32x2 q = t * 0.5307027145f + (-0.7265760135f); q = q * t + 0.7107068705f; q = q * t + (-0.142248368f); q = q * t + 0.127414796f; q = q * t;
    const f32x2 s = (v * v) * (-0.72134752044f);
    f32x2 e; e.x = __builtin_amdgcn_exp2f(s.x); e.y = __builtin_amdgcn_exp2f(s.y);
    const f32x2 m = v * (q * e), r = v - m;
    f32x2 o; o.x = v.x < 0.f ? m.x : r.x; o.y = v.y < 0.f ? m.y : r.y; return o;
}

template <int ACT  > struct EpiBf16 {
    static constexpr bool PERM = true, AFTER_DRAIN = false; static_assert(ACT == 0 || ACT == 1, "EpiBf16: ACT is 0 (none) or 1 (gelu_pk)");
    bf16_t* O; int ldc; const float* bias; int split_cols; size_t split_stride; float scale0;
    __device__ __forceinline__ void operator()(const f32x4 (&acc)[2][2][4][2], const Unit& u, int wr, int wc, int fr, int fq) const {
        const int row0 = u.pm * BM + wr * 64 + fr; int colt = u.pn * BM; bf16_t* base = O;
        float sc = 1.f; if (split_cols) { const int t = colt / split_cols; base += (size_t)t * split_stride; colt -= t * split_cols; if (t == 0) sc = scale0; }
        const int col0 = colt + wc * 32 + 8 * fq, bcol0 = u.pn * BM + wc * 32 + 8 * fq;
        f32x4 bv[2][2];
#pragma unroll
        for (int bj = 0; bj < 2; ++bj)
#pragma unroll
            for (int n = 0; n < 2; ++n) bv[bj][n] = bias ? *(const f32x4*)(bias + bcol0 + bj * HALF + 4 * n) : (f32x4){0.f, 0.f, 0.f, 0.f};
#pragma unroll
        for (int ai = 0; ai < 2; ++ai)
#pragma unroll
            for (int m = 0; m < 4; ++m) { bf16_t* rowp = base + (size_t)(row0 + ai * HALF + m * 16) * ldc + col0;
#pragma unroll
                for (int bj = 0; bj < 2; ++bj) { f32x4 v0 = acc[ai][bj][m][0] + bv[bj][0], v1 = acc[ai][bj][m][1] + bv[bj][1];
                    if (ACT == 1) { f32x2 a = gelu_pk((f32x2){v0[0], v0[1]}), b = gelu_pk((f32x2){v0[2], v0[3]}), c = gelu_pk((f32x2){v1[0], v1[1]}), d = gelu_pk((f32x2){v1[2], v1[3]});
                        v0 = (f32x4){a.x, a.y, b.x, b.y}; v1 = (f32x4){c.x, c.y, d.x, d.y}; }
                    v0 = v0 * sc; v1 = v1 * sc; u32x4 w; w.x = cvt_pk_bf16(v0[0], v0[1]); w.y = cvt_pk_bf16(v0[2], v0[3]); w.z = cvt_pk_bf16(v1[0], v1[1]); w.w = cvt_pk_bf16(v1[2], v1[3]);
                    *(u32x4*)(rowp + bj * HALF) = w; } }
    }
};
template <class Epi, class Sched, bool ALIGN_EPI = false, bool SP2 = false>
__device__ __forceinline__ void gemm_phase(PG8_LAS unsigned char* lds, const Gemm g, const Sched& S, const Epi& E) {
    int tid_ = threadIdx.x; asm volatile("" : "+v"(tid_));
    const int tid = tid_, wid = __builtin_amdgcn_readfirstlane(tid >> 6), lane = tid & 63, wr = wid >> 2, wc = wid & 3, fr = lane & 15, fq = lane >> 4;
    const int K = g.K, nt = K / BK;
    unsigned voffA[2], voffB[2];
#pragma unroll
    for (int i = 0; i < 2; ++i) { int R, C; stage_rc(tid * 16 + i * 8192, R, C); const int Rb = Epi::PERM ? ((R & ~31) + perm32(R & 31)) : R;
        voffA[i] = (unsigned)(R * g.lda + C) * 2u; voffB[i] = (unsigned)(Rb * g.ldb + C) * 2u; }
    const size_t kstep = (size_t)(BK * 2);
    const size_t hstepA = g.hstepA, hstepB = g.hstepB;
    const unsigned ldsw = (unsigned)wid * 1024u;
    const int aoff = lds_byte(wr * 64 + fr, fq * 8), boff = lds_byte(wc * 32 + fr, fq * 8);
#define PG8_SA(b, h) (((b) * 2 + (h)) * HTB)
#define PG8_SB(b, h) ((4 + (b) * 2 + (h)) * HTB)
#define PG8_STAGE(bufoff, gbase, voff) do { _Pragma("unroll") for (int _i = 0; _i < 2; ++_i) { unsigned _vo = (voff)[_i]; asm volatile("" : "+v"(_vo));     \
        __builtin_amdgcn_global_load_lds((const unsigned*)((const char*)(gbase) + _vo), (PG8_LAS unsigned*)(lds + (bufoff) + ldsw + _i * 8192), 16, 0, 0); } } while (0)
#define PG8_LDA(dst, b, h) do { _Pragma("unroll") for (int m = 0; m < 4; ++m) _Pragma("unroll") for (int k = 0; k < 2; ++k) dst[m][k] = *(const PG8_LAS bf16x8*)(lds + PG8_SA(b, h) + aoff + m * 2048 + k * 1024); } while (0)
#define PG8_LDB(dst, b, h) do { _Pragma("unroll") for (int n = 0; n < 2; ++n) _Pragma("unroll") for (int k = 0; k < 2; ++k) dst[n][k] = *(const PG8_LAS bf16x8*)(lds + PG8_SB(b, h) + boff + n * 2048 + k * 1024); } while (0)
#define PG8_MMA(ai, bj, At, Bt) do { __builtin_amdgcn_s_setprio(1); _Pragma("unroll") for (int m = 0; m < 4; ++m) _Pragma("unroll") for (int n = 0; n < 2; ++n) _Pragma("unroll") for (int k = 0; k < 2; ++k) \
        acc[ai][bj][m][n] = __builtin_amdgcn_mfma_f32_16x16x32_bf16(Bt[n][k], At[m][k], acc[ai][bj][m][n], 0, 0, 0); __builtin_amdgcn_s_setprio(0); } while (0)
#define PG8_WAIT_V(n) asm volatile("s_waitcnt vmcnt(" #n ")" ::: "memory")
#define PG8_WAIT_L(n) asm volatile("s_waitcnt lgkmcnt(" #n ")" ::: "memory")
#define PG8_BAR __builtin_amdgcn_s_barrier()
#define PG8_SCHED __builtin_amdgcn_sched_barrier(0)
    Unit cur, nxt; int ui = 0;
    if (!S.next(0, cur)) return;
    f32x4 acc[2][2][4][2];
#pragma unroll
    for (int a = 0; a < 2; ++a)
#pragma unroll
        for (int b = 0; b < 2; ++b)
#pragma unroll
            for (int m = 0; m < 4; ++m)
#pragma unroll
                for (int n = 0; n < 2; ++n) acc[a][b][m][n] = (f32x4){0.f, 0.f, 0.f, 0.f};
    bf16x8 At[4][2], B0[2][2], B1[2][2];
    const char* cA = (const char*)g.A + S.offA(cur); const char* cB = (const char*)g.Bt + S.offB(cur);
    S.a_ready(cur);
    if constexpr (SP2) {
        PG8_STAGE(PG8_SB(0, 0), cB, voffB); PG8_STAGE(PG8_SB(0, 1), cB + hstepB, voffB); PG8_STAGE(PG8_SA(0, 0), cA, voffA); PG8_STAGE(PG8_SA(0, 1), cA + hstepA, voffA);
        if (wr == 1) PG8_BAR;
        PG8_WAIT_V(2); PG8_BAR;
        PG8_STAGE(PG8_SB(1, 0), cB + kstep, voffB); PG8_STAGE(PG8_SA(1, 0), cA + kstep, voffA); PG8_STAGE(PG8_SB(1, 1), cB + hstepB + kstep, voffB);
        PG8_WAIT_V(6); PG8_BAR;
    } else {
        PG8_STAGE(PG8_SB(0, 0), cB, voffB); PG8_STAGE(PG8_SA(0, 0), cA, voffA); PG8_STAGE(PG8_SB(0, 1), cB + hstepB, voffB); PG8_STAGE(PG8_SA(0, 1), cA + hstepA, voffA);
        if (wr == 1) PG8_BAR;
        PG8_WAIT_V(4); PG8_BAR;
        PG8_STAGE(PG8_SB(1, 0), cB + kstep, voffB); PG8_STAGE(PG8_SA(1, 0), cA + kstep, voffA); PG8_STAGE(PG8_SB(1, 1), cB + hstepB + kstep, voffB);
        PG8_WAIT_V(6); PG8_BAR;
    }
    for (;;) {
        const bool has_next = S.next(ui + 1, nxt);
        const char* nA = has_next ? (const char*)g.A + S.offA(nxt) : cA; const char* nB = has_next ? (const char*)g.Bt + S.offB(nxt) : cB;
        for (int t = 0; t < nt; t += 2) {
            const bool last = (t == nt - 2);
            const char* a1 = cA + (size_t)(t + 1) * kstep;
            const char* a2 = last ? nA : cA + (size_t)(t + 2) * kstep; const char* b2 = last ? nB : cB + (size_t)(t + 2) * kstep;
            const char* a3 = a2 + kstep; const char* b3 = b2 + kstep;
            if (last && has_next) S.a_ready(nxt);
            if constexpr (SP2) {
            PG8_LDB(B0, 0, 0); PG8_LDB(B1, 0, 1); PG8_SCHED; PG8_LDA(At, 0, 0); PG8_STAGE(PG8_SA(1, 1), a1 + hstepA, voffA);
            PG8_WAIT_V(8); PG8_WAIT_L(0); PG8_BAR; PG8_MMA(0, 0, At, B0); PG8_MMA(0, 1, At, B1); PG8_BAR; PG8_SCHED;
            PG8_LDA(At, 0, 1); PG8_STAGE(PG8_SB(0, 0), b2, voffB); PG8_STAGE(PG8_SB(0, 1), b2 + hstepB, voffB); PG8_STAGE(PG8_SA(0, 0), a2, voffA);
            PG8_WAIT_V(8); PG8_WAIT_L(0); PG8_BAR; PG8_MMA(1, 0, At, B0); PG8_MMA(1, 1, At, B1); PG8_BAR; PG8_SCHED;
            PG8_LDB(B0, 1, 0); PG8_LDB(B1, 1, 1); PG8_SCHED; PG8_LDA(At, 1, 0); PG8_STAGE(PG8_SA(0, 1), a2 + hstepA, voffA);
            PG8_WAIT_V(8); PG8_WAIT_L(0); PG8_BAR; PG8_MMA(0, 0, At, B0); PG8_MMA(0, 1, At, B1); PG8_BAR; PG8_SCHED;
            PG8_LDA(At, 1, 1); PG8_STAGE(PG8_SB(1, 0), b3, voffB); PG8_STAGE(PG8_SB(1, 1), b3 + hstepB, voffB); PG8_STAGE(PG8_SA(1, 0), a3, voffA);
            PG8_WAIT_V(8); PG8_WAIT_L(0); PG8_BAR; PG8_MMA(1, 0, At, B0); PG8_MMA(1, 1, At, B1); PG8_BAR; PG8_SCHED;
            } else {
            PG8_LDB(B0, 0, 0); PG8_SCHED; PG8_LDA(At, 0, 0); PG8_STAGE(PG8_SA(1, 1), a1 + hstepA, voffA);
            PG8_WAIT_L(8); PG8_BAR; PG8_WAIT_L(0); PG8_MMA(0, 0, At, B0); PG8_BAR; PG8_SCHED;
            PG8_LDB(B1, 0, 1); PG8_STAGE(PG8_SB(0, 0), b2, voffB);
            PG8_BAR; PG8_WAIT_L(0); PG8_MMA(0, 1, At, B1); PG8_BAR;
            PG8_LDA(At, 0, 1); PG8_STAGE(PG8_SA(0, 0), a2, voffA);
            PG8_BAR; PG8_WAIT_L(0); PG8_MMA(1, 0, At, B0); PG8_BAR; PG8_SCHED;
            PG8_STAGE(PG8_SB(0, 1), b2 + hstepB, voffB);
            PG8_WAIT_V(6); PG8_BAR; PG8_MMA(1, 1, At, B1); PG8_BAR;
            PG8_LDB(B0, 1, 0); PG8_SCHED; PG8_LDA(At, 1, 0); PG8_STAGE(PG8_SA(0, 1), a2 + hstepA, voffA);
            PG8_WAIT_L(8); PG8_BAR; PG8_WAIT_L(0); PG8_MMA(0, 0, At, B0); PG8_BAR; PG8_SCHED;
            PG8_LDB(B1, 1, 1); PG8_STAGE(PG8_SB(1, 0), b3, voffB);
            PG8_BAR; PG8_WAIT_L(0); PG8_MMA(0, 1, At, B1); PG8_BAR;
            PG8_LDA(At, 1, 1); PG8_STAGE(PG8_SA(1, 0), a3, voffA);
            PG8_BAR; PG8_WAIT_L(0); PG8_MMA(1, 0, At, B0); PG8_BAR; PG8_SCHED;
            PG8_STAGE(PG8_SB(1, 1), b3 + hstepB, voffB);
            PG8_WAIT_V(6); PG8_BAR; PG8_MMA(1, 1, At, B1); PG8_BAR;
            }
        }
        if constexpr (ALIGN_EPI) { if (wr == 0) PG8_BAR; }
        if constexpr (!Epi::AFTER_DRAIN) { E(acc, cur, wr, wc, fr, fq); S.done(cur); }
        if (!has_next) break;
#pragma unroll
        for (int a = 0; a < 2; ++a)
#pragma unroll
            for (int b = 0; b < 2; ++b)
#pragma unroll
                for (int m = 0; m < 4; ++m)
#pragma unroll
                    for (int n = 0; n < 2; ++n) acc[a][b][m][n] = (f32x4){0.f, 0.f, 0.f, 0.f};
        cur = nxt; cA = nA; cB = nB; ++ui;
        if constexpr (ALIGN_EPI) { if (wr == 1) PG8_BAR; }
    }
    PG8_WAIT_V(0);
    if constexpr (!ALIGN_EPI) { if (wr == 0) PG8_BAR; }
    PG8_BAR;
    if constexpr (Epi::AFTER_DRAIN) { E.fused(acc, cur, wr, wc, fr, fq, lds, wid, lane); S.done(cur); }
#undef PG8_SA
#undef PG8_SB
#undef PG8_STAGE
#undef PG8_LDA
#undef PG8_LDB
#undef PG8_MMA
#undef PG8_WAIT_V
#undef PG8_WAIT_L
#undef PG8_BAR
#undef PG8_SCHED
}
}
namespace attn_body {
using bf16=__hip_bfloat16;
using bf16x8=__attribute__((ext_vector_type(8)))short;
using s16x4=__attribute__((ext_vector_type(4)))short;
using f32x16=__attribute__((ext_vector_type(16)))float;
using u32x4=__attribute__((ext_vector_type(4)))unsigned;
constexpr int D=64,QP=1024;
constexpr int NW=8,QBLK=32,QB=QBLK*NW,KVBLK=64;
__device__ __forceinline__ void wmask(f32x16&p0,f32x16&p1,int t,int kstart,int qabs,int hi){
  if(t<4)return; const float NEG=-INFINITY; const int kb=kstart+64*(t-4)+4*hi-qabs;
  #pragma unroll
  for(int r=0;r<16;++r){const int dk=kb+(r&3)+8*(r>>2); if(dk>128||dk<-128)p0[r]=NEG; if(dk+32>128||dk+32<-128)p1[r]=NEG;}
}
__device__ __forceinline__ int crow(int r,int hi){return (r&3)+8*(r>>2)+4*hi;}
#define SBAR() __builtin_amdgcn_sched_barrier(0)
__device__ __forceinline__ void cmask(f32x16&p0,f32x16&p1,int jb,int qrel,int hi){
  const float NEG=-INFINITY; int kb=64*jb+4*hi;
  #pragma unroll
  for(int r=0;r<16;++r){int kv=kb+(r&3)+8*(r>>2); if(kv>qrel)p0[r]=NEG; if(kv+32>qrel)p1[r]=NEG;}
}

constexpr int NSLOT=3, SLOTB=8192;
constexpr int LDS_K=0, LDS_V=NSLOT*SLOTB, LDS_WS=2*NSLOT*SLOTB, LDS_OST=LDS_WS+NW*64*4, LDS_BYTES=LDS_OST+NW*4096;
constexpr float C2=0.125f*1.4426950408889634f;
__device__ __forceinline__ void glds16(const void*gsrc,unsigned lds_dst){unsigned keep;
  asm volatile("s_mov_b32 %0, m0\n\ts_mov_b32 m0, %2\n\ts_nop 0\n\tglobal_load_lds_dwordx4 %1, off\n\ts_mov_b32 m0, %0":"=&s"(keep):"v"(gsrc),"s"(lds_dst):"memory");}
__device__ __forceinline__ float max3f(float a,float b,float c){float r;asm("v_max3_f32 %0, %1, %2, %3":"=v"(r):"v"(a),"v"(b),"v"(c));return r;}
__device__ __forceinline__ float max2f(float a,float b){float r;asm("v_max_f32_e32 %0, %1, %2":"=v"(r):"v"(a),"v"(b));return r;}
__device__ __forceinline__ float fadd_s(float a,float b){float r;asm("v_add_f32_e32 %0, %1, %2":"=v"(r):"v"(a),"v"(b));return r;}
__device__ __forceinline__ float fsub_s(float a,float b){float r;asm("v_sub_f32_e32 %0, %1, %2":"=v"(r):"v"(a),"v"(b));return r;}
typedef float f32x2_t __attribute__((ext_vector_type(2))); typedef __bf16 bf16x2_t __attribute__((ext_vector_type(2)));
__device__ __forceinline__ unsigned cvtpk_s(float lo,float hi){f32x2_t v={lo,hi};bf16x2_t b=__builtin_convertvector(v,bf16x2_t);return __builtin_bit_cast(unsigned,b);}
#define WAIT_BAR(N) asm volatile("s_waitcnt vmcnt(" #N ") lgkmcnt(0)\n\ts_barrier":::"memory")

__device__ __forceinline__ void qkt(f32x16&p0,f32x16&p1,const char*Kslot,const bf16x8*qr,const f32x16&negm,int r32,int hi){
  const char*kb=Kslot+hi*1024+r32*16;
  #pragma unroll
  for(int d0=0;d0<4;++d0){
    const bf16x8 b0=*reinterpret_cast<const bf16x8*>(kb+d0*2048);
    const bf16x8 b1=*reinterpret_cast<const bf16x8*>(kb+d0*2048+512);
    if(d0==0){p0=__builtin_amdgcn_mfma_f32_32x32x16_bf16(b0,qr[0],negm,0,0,0);p1=__builtin_amdgcn_mfma_f32_32x32x16_bf16(b1,qr[0],negm,0,0,0);}
    else{p0=__builtin_amdgcn_mfma_f32_32x32x16_bf16(b0,qr[d0],p0,0,0,0);p1=__builtin_amdgcn_mfma_f32_32x32x16_bf16(b1,qr[d0],p1,0,0,0);}}
}
typedef __attribute__((address_space(3))) const char* lds_cptr;
typedef short v4i16_t __attribute__((ext_vector_type(4)));
__device__ __forceinline__ void kload8(bf16x8*kf,lds_cptr kp){
  kf[0]=*(const __attribute__((address_space(3))) bf16x8*)(kp);      kf[1]=*(const __attribute__((address_space(3))) bf16x8*)(kp+512);
  kf[2]=*(const __attribute__((address_space(3))) bf16x8*)(kp+2048); kf[3]=*(const __attribute__((address_space(3))) bf16x8*)(kp+2560);
  kf[4]=*(const __attribute__((address_space(3))) bf16x8*)(kp+4096); kf[5]=*(const __attribute__((address_space(3))) bf16x8*)(kp+4608);
  kf[6]=*(const __attribute__((address_space(3))) bf16x8*)(kp+6144); kf[7]=*(const __attribute__((address_space(3))) bf16x8*)(kp+6656);
}
__device__ __forceinline__ void kload2(bf16x8*kf,lds_cptr kp,int j){ kf[2*j]=*(const __attribute__((address_space(3))) bf16x8*)(kp+j*2048); kf[2*j+1]=*(const __attribute__((address_space(3))) bf16x8*)(kp+j*2048+512); }
__device__ __forceinline__ s16x4 vtr(lds_cptr p){ return __builtin_bit_cast(s16x4,__builtin_amdgcn_ds_read_tr16_b64_v4i16((__attribute__((address_space(3))) v4i16_t*)p)); }
__device__ __forceinline__ float rowmax(const f32x16&p0,const f32x16&p1){
  float a=max3f(p0[0],p0[1],p1[0]),b=max3f(p0[2],p0[3],p1[1]);a=max3f(a,p1[2],p1[3]);
  #pragma unroll
  for(int r=4;r<16;r+=4){a=max3f(a,p0[r],p0[r+1]);b=max3f(b,p0[r+2],p0[r+3]);a=max3f(a,p1[r],p1[r+1]);b=max3f(b,p1[r+2],p1[r+3]);}
  const float m=max2f(a,b);
  auto rr=__builtin_amdgcn_permlane32_swap(__float_as_uint(m),__float_as_uint(m),false,false);
  return max2f(__uint_as_float(rr[0]),__uint_as_float(rr[1]));
}
__device__ __forceinline__ void pv(f32x16*o,int vb,bf16x8 pa0,bf16x8 pa1,bf16x8 pa2,bf16x8 pa3){
  #pragma unroll
  for(int d0=0;d0<2;++d0){s16x4 lo[4],hi[4];
    #pragma unroll
    for(int ks=0;ks<4;++ks){
      asm volatile("ds_read_b64_tr_b16 %0,%1 offset:%c2":"=&v"(lo[ks]):"v"(vb),"i"(d0*4096+ks*1024):"memory");
      asm volatile("ds_read_b64_tr_b16 %0,%1 offset:%c2":"=&v"(hi[ks]):"v"(vb),"i"(d0*4096+ks*1024+512):"memory");}
    asm volatile("s_waitcnt lgkmcnt(0)":::"memory");SBAR();
    #define PK(k) (bf16x8){lo[k][0],lo[k][1],lo[k][2],lo[k][3],hi[k][0],hi[k][1],hi[k][2],hi[k][3]}
    o[d0]=__builtin_amdgcn_mfma_f32_32x32x16_bf16(pa0,PK(0),o[d0],0,0,0);
    o[d0]=__builtin_amdgcn_mfma_f32_32x32x16_bf16(pa1,PK(1),o[d0],0,0,0);
    o[d0]=__builtin_amdgcn_mfma_f32_32x32x16_bf16(pa2,PK(2),o[d0],0,0,0);
    o[d0]=__builtin_amdgcn_mfma_f32_32x32x16_bf16(pa3,PK(3),o[d0],0,0,0);
    #undef PK
  }
}

#ifndef ATTN_STORE16
#define ATTN_STORE16(p,v) (*(u32x4*)(p)=(v))
#endif
template<int MODE,int KP,int THRL> __device__ __forceinline__ void attn_unit(int h,int kvh,int q0,int NT,int kbase,float sink_l2,const bf16*Q,const bf16*__restrict__ K,const bf16*__restrict__ V,bf16*O,char*shm){
  int tid_=threadIdx.x; asm volatile("":"+v"(tid_)); const int tid=tid_,lane=tid&63,r32=lane&31,hi=lane>>5; const int wid=__builtin_amdgcn_readfirstlane(tid>>6);
  #define TROW(t) (MODE==0 ? (kbase+64*(t)) : ((t)<4 ? 16384+64*(t) : kbase+64*((t)-4)))
  const bf16*Qw=Q+(long)(q0+wid*QBLK)*QP+h*D;
  const bf16*Kh=K+kvh*D,*Vh=V+kvh*D;
  const unsigned lds0=(unsigned)(uintptr_t)shm;
  float*wsf=(float*)(shm+LDS_WS)+wid*64;
  const bf16*ksrc=Kh+(long)lane*KP+wid*8;
  const bf16*vsrc=Vh+(long)(16*(wid&3)+(lane>>2))*KP+(wid>>2)*32+(lane&3)*8;
  const unsigned kdst=lds0+LDS_K+wid*1024, vdst=lds0+LDS_V+wid*1024;
  #define DMA_K(t,slot) glds16(ksrc+(long)TROW(t)*KP,(unsigned)__builtin_amdgcn_readfirstlane(kdst+(slot)))
  #define DMA_V(t,slot) glds16(vsrc+(long)TROW(t)*KP,(unsigned)__builtin_amdgcn_readfirstlane(vdst+(slot)))
  const int vb0=(int)(lds0+LDS_V)+((lane>>4)&1)*32+(lane&3)*8+(4*hi+((lane&15)>>2))*64;
  const char*Kbase=shm+LDS_K; bf16x8 kf[8];
  const lds_cptr shm3=(lds_cptr)shm; const lds_cptr kp0=shm3+LDS_K+hi*1024+r32*16; const lds_cptr vp0=shm3+LDS_V+((lane>>4)&1)*32+(lane&3)*8+(4*hi+((lane&15)>>2))*64;
  DMA_K(0,0);DMA_V(0,0);DMA_K(1,SLOTB);
  bf16x8 qr[4];
  #pragma unroll
  for(int d0=0;d0<4;++d0)qr[d0]=*reinterpret_cast<const bf16x8*>(&Qw[(long)r32*QP+d0*16+hi*8]);
  float mhat=0.f,l_reg=0.f;f32x16 o[2];o[0]=f32x16{};o[1]=f32x16{};f32x16 negm=f32x16{};asm volatile("":"+v"(negm));
  const int qabs=q0+wid*QBLK+r32;
  #define CMASK(P0,P1,t) do{ if(MODE==1) wmask(P0,P1,(t),kbase,qabs,hi); }while(0)
  bool resc=false;
  #define START(P0,P1) do{ const float rm=rowmax(P0,P1); resc=false; \
    { const float dl=rm; mhat=fadd_s(mhat,dl); \
      _Pragma("unroll") for(int r=0;r<16;++r){P0[r]=fsub_s(P0[r],dl);P1[r]=fsub_s(P1[r],dl);} \
      _Pragma("unroll") for(int r=0;r<16;++r)negm[r]=-mhat; asm volatile("":"+v"(negm)); } \
    _Pragma("unroll") for(int r=0;r<16;++r)P0[r]=__builtin_amdgcn_exp2f(P0[r]); }while(0)
  #define RESC() do{ if(resc){ asm volatile("s_waitcnt lgkmcnt(0)":::"memory"); \
      _Pragma("unroll") for(int d_=0;d_<2;++d_) _Pragma("unroll") for(int r=0;r<16;++r)o[d_][r]*=wsf[crow(r,hi)]; } }while(0)
  f32x16 pA0,pA1,pB0,pB1;
  int sl_prev=0,sl_cur=0,sl_next=SLOTB;
  #define ROT() do{sl_prev=sl_cur;sl_cur=sl_next;sl_next=(sl_next==(NSLOT-1)*SLOTB)?0:sl_next+SLOTB;}while(0)
  DMA_K(2,2*SLOTB);
  WAIT_BAR(3);
  qkt(pA0,pA1,Kbase,qr,negm,r32,hi);asm volatile("s_nop 15\n\ts_nop 7":"+v"(pA0),"+v"(pA1));CMASK(pA0,pA1,0);
  START(pA0,pA1);
  _Pragma("unroll") for(int r=0;r<16;++r)pA1[r]=__builtin_amdgcn_exp2f(pA1[r]);
  WAIT_BAR(0);
  DMA_K(3,0);DMA_V(1,SLOTB);
  ROT();
  kload8(kf,kp0+sl_cur);
  WAIT_BAR(2);
  s16x4 vlo[8],vhi[8]; u32x4 pw0,pw1,pw2,pw3;
  #define PKW(P,B) cvtpk_s(P[B],P[B+1])
  #define PAF(k) __builtin_bit_cast(bf16x8,pw##k)
  #define VFR(i) (bf16x8){vlo[i][0],vlo[i][1],vlo[i][2],vlo[i][3],vhi[i][0],vhi[i][1],vhi[i][2],vhi[i][3]}
  #define PIN(x) asm volatile("":"+v"(x))
  #define MX3(a,b,c) __builtin_fmaxf(__builtin_fmaxf((a),(b)),(c))
  #define GAPA(MF,A0,A1,A2,A3,W0,W1,PW) do{ MF; sacc+=A0; sacc+=A1; sacc+=A2; sacc+=A3; PIN(sacc); W0; W1; PIN(PW); SBAR(); }while(0)
  #define EX(v) __builtin_amdgcn_exp2f(v)
  #define GAPB(MF,X,B) do{ MF; X[B]=EX(X[B]); X[B+1]=EX(X[B+1]); X[B+2]=EX(X[B+2]); X[B+3]=EX(X[B+3]); PIN(X); SBAR(); }while(0)
  #define VRD(i) do{ vlo[i]=vtr(vp_+(((i)>>2)*4096+((i)&3)*1024)); vhi[i]=vtr(vp_+(((i)>>2)*4096+((i)&3)*1024+512)); }while(0)
  #define KRD(G,j) do{ if(G){ kload2(kf,kp0+sl_next,j); SBAR(); } }while(0)
  #define STEP(C0,C1,P0,P1,t,GK,GV,GL) do{ SBAR(); \
    const lds_cptr vp_=vp0+sl_prev; \
    VRD(0); SBAR(); float sacc=(P0[0]+P0[1]); \
    GAPA(C0=__builtin_amdgcn_mfma_f32_32x32x16_bf16(kf[0],qr[0],negm,0,0,0), P0[2],P0[3],P0[4],P0[5],     pw0[0]=PKW(P0,0), pw0[1]=PKW(P0,2), pw0); \
    VRD(4); SBAR(); GAPA(C1=__builtin_amdgcn_mfma_f32_32x32x16_bf16(kf[1],qr[0],negm,0,0,0), P0[6],P0[7],P0[8],P0[9],     pw0[2]=PKW(P0,4), pw0[3]=PKW(P0,6), pw0); \
    VRD(1); SBAR(); GAPA(C0=__builtin_amdgcn_mfma_f32_32x32x16_bf16(kf[2],qr[1],C0,0,0,0),   P0[10],P0[11],P0[12],P0[13], pw1[0]=PKW(P0,8), pw1[1]=PKW(P0,10), pw1); \
    VRD(5); SBAR(); GAPA(C1=__builtin_amdgcn_mfma_f32_32x32x16_bf16(kf[3],qr[1],C1,0,0,0),   P0[14],P0[15],P1[0],P1[1],   pw1[2]=PKW(P0,12),pw1[3]=PKW(P0,14), pw1); \
    VRD(2); SBAR(); GAPA(C0=__builtin_amdgcn_mfma_f32_32x32x16_bf16(kf[4],qr[2],C0,0,0,0),   P1[2],P1[3],P1[4],P1[5],     pw2[0]=PKW(P1,0), pw2[1]=PKW(P1,2), pw2); \
    VRD(6); SBAR(); GAPA(C1=__builtin_amdgcn_mfma_f32_32x32x16_bf16(kf[5],qr[2],C1,0,0,0),   P1[6],P1[7],P1[8],P1[9],     pw2[2]=PKW(P1,4), pw2[3]=PKW(P1,6), pw2); \
    VRD(3); SBAR(); GAPA(C0=__builtin_amdgcn_mfma_f32_32x32x16_bf16(kf[6],qr[3],C0,0,0,0),   P1[10],P1[11],P1[12],P1[13], pw3[0]=PKW(P1,8), pw3[1]=PKW(P1,10), pw3); \
    VRD(7); SBAR(); GAPA(C1=__builtin_amdgcn_mfma_f32_32x32x16_bf16(kf[7],qr[3],C1,0,0,0),   P1[14],P1[15],0.f,0.f,       pw3[2]=PKW(P1,12),pw3[3]=PKW(P1,14), pw3); \
    l_reg+=sacc; \
    if(GK){DMA_K((t)+3,sl_cur);} if(GV){DMA_V((t)+1,sl_next);} \
    CMASK(C0,C1,t); \
    { float a=MX3(C0[0],C0[1],C1[0]),b=MX3(C0[2],C0[3],C1[1]); a=MX3(a,C1[2],C1[3]); \
      _Pragma("unroll") for(int r=4;r<16;r+=4){a=MX3(a,C0[r],C0[r+1]);b=MX3(b,C0[r+2],C0[r+3]);a=MX3(a,C1[r],C1[r+1]);b=MX3(b,C1[r+2],C1[r+3]);} \
      float rm=__builtin_fmaxf(a,b); { auto rr=__builtin_amdgcn_permlane32_swap(__float_as_uint(rm),__float_as_uint(rm),false,false); rm=__builtin_fmaxf(__uint_as_float(rr[0]),__uint_as_float(rr[1])); } \
      resc=false; \
      if(__builtin_expect(__any(rm>(float)THRL),0)){ const float dl=__builtin_fmaxf(rm,0.f); mhat+=dl; \
        _Pragma("unroll") for(int r=0;r<16;++r){C0[r]-=dl;C1[r]-=dl;} \
        _Pragma("unroll") for(int r=0;r<16;++r)negm[r]=-mhat; asm volatile("":"+v"(negm)); \
        const float f=__builtin_amdgcn_exp2f(-dl); l_reg*=f; if(hi==0)wsf[r32]=f; resc=true; } } \
    SBAR(); \
    GAPB(o[0]=__builtin_amdgcn_mfma_f32_32x32x16_bf16(PAF(0),VFR(0),o[0],0,0,0), C0,0); \
    GAPB(o[1]=__builtin_amdgcn_mfma_f32_32x32x16_bf16(PAF(0),VFR(4),o[1],0,0,0), C0,4); \
    KRD(GL,0); GAPB(o[0]=__builtin_amdgcn_mfma_f32_32x32x16_bf16(PAF(1),VFR(1),o[0],0,0,0), C0,8); \
    KRD(GL,1); GAPB(o[1]=__builtin_amdgcn_mfma_f32_32x32x16_bf16(PAF(1),VFR(5),o[1],0,0,0), C0,12); \
    KRD(GL,2); GAPB(o[0]=__builtin_amdgcn_mfma_f32_32x32x16_bf16(PAF(2),VFR(2),o[0],0,0,0), C1,0); \
    KRD(GL,3); GAPB(o[1]=__builtin_amdgcn_mfma_f32_32x32x16_bf16(PAF(2),VFR(6),o[1],0,0,0), C1,4); \
    GAPB(o[0]=__builtin_amdgcn_mfma_f32_32x32x16_bf16(PAF(3),VFR(3),o[0],0,0,0), C1,8); \
    GAPB(o[1]=__builtin_amdgcn_mfma_f32_32x32x16_bf16(PAF(3),VFR(7),o[1],0,0,0), C1,12); \
    }while(0)
  int t=1;
  #undef CMASK
  #define CMASK(P0,P1,t) do{}while(0)
  if constexpr(MODE==0)
  for(;t+5<NT;t+=2){
    STEP(pB0,pB1,pA0,pA1,t,true,true,true);     WAIT_BAR(2); RESC(); ROT();
    STEP(pA0,pA1,pB0,pB1,t+1,true,true,true);   WAIT_BAR(2); RESC(); ROT();
  }
  #undef CMASK
  #define CMASK(P0,P1,t) do{ if(MODE==1) wmask(P0,P1,(t),kbase,qabs,hi); }while(0)
  #define ENDW(tt) do{ if((tt)+3<NT){WAIT_BAR(2);} else if((tt)+2<NT){WAIT_BAR(1);} else {WAIT_BAR(0);} }while(0)
  for(;t+1<NT;t+=2){
    STEP(pB0,pB1,pA0,pA1,t,(t+3<NT),(t+1<NT),(t+1<NT));       ENDW(t);   RESC(); ROT();
    STEP(pA0,pA1,pB0,pB1,t+1,(t+4<NT),(t+2<NT),(t+2<NT));     ENDW(t+1); RESC(); ROT();
  }
  STEP(pB0,pB1,pA0,pA1,NT-1,false,false,false); RESC();
  { float sacc=pB0[0]+pB0[1]; _Pragma("unroll") for(int r=2;r<16;++r)sacc+=pB0[r]; _Pragma("unroll") for(int r=0;r<16;++r)sacc+=pB1[r]; l_reg+=sacc;
    pw0=(u32x4){PKW(pB0,0),PKW(pB0,2),PKW(pB0,4),PKW(pB0,6)};pw1=(u32x4){PKW(pB0,8),PKW(pB0,10),PKW(pB0,12),PKW(pB0,14)};pw2=(u32x4){PKW(pB1,0),PKW(pB1,2),PKW(pB1,4),PKW(pB1,6)};pw3=(u32x4){PKW(pB1,8),PKW(pB1,10),PKW(pB1,12),PKW(pB1,14)};
    SBAR(); pv(o,vb0+sl_cur,PAF(0),PAF(1),PAF(2),PAF(3)); }
  #undef PKW
  #undef PAF
  #undef VFR
  #undef PIN
  #undef MX3
  #undef GAPA
  #undef GAPB
  #undef EX
  #undef VRD
  #undef KRD
  #undef STEP
  #undef ENDW
  {auto rr=__builtin_amdgcn_permlane32_swap(__float_as_uint(l_reg),__float_as_uint(l_reg),false,false);l_reg=__uint_as_float(rr[0])+__uint_as_float(rr[1]);}
  if(MODE==1)l_reg+=__builtin_amdgcn_exp2f(sink_l2-mhat);
  if(hi==0)wsf[32+r32]=l_reg;asm volatile("s_waitcnt lgkmcnt(0)":::"memory");
  float rli[16];
  #pragma unroll
  for(int r=0;r<16;++r)rli[r]=__builtin_amdgcn_rcpf(wsf[32+crow(r,hi)]);
  bf16*Ow=O+(long)(q0+wid*QBLK)*QP+h*D;
  { bf16*stg=(bf16*)(shm+LDS_OST)+wid*2048;
    #pragma unroll
    for(int r=0;r<16;++r){const int orow=crow(r,hi);
      #pragma unroll
      for(int d0=0;d0<2;++d0)stg[orow*64+d0*32+r32]=__float2bfloat16(o[d0][r]*rli[r]);}
    asm volatile("s_waitcnt lgkmcnt(0)":::"memory");
    #pragma unroll
    for(int i=0;i<4;++i){const int row=i*8+(lane>>3),ch=lane&7; const u32x4 v=*(const u32x4*)(stg+row*64+ch*8); ATTN_STORE16(Ow+(long)row*QP+ch*8,v);} }
  asm volatile("s_waitcnt lgkmcnt(0)\n\ts_barrier":::"memory");
  #undef DMA_K
  #undef DMA_V
  #undef CMASK
  #undef TROW
  #undef START
  #undef RESC
  #undef ROT
}
constexpr int ATTN_LDS_BYTES=LDS_BYTES;
#undef SBAR
#undef WAIT_BAR
}
#ifndef EN_MIX
#define EN_MIX 15
#endif
#ifndef EN_MOE
#define EN_MOE 15
#endif
constexpr int NWAVES = 8, NTHR = 512;
constexpr int DM = 1024, NLAT = 16384, NCTX = 256, T = NLAT + NCTX, NPAN = T / 256;
constexpr int NE = 32, TOPK = 4, EFF = 1024;
constexpr int FA_NQKV = 1536, WA_NQKV = 1280, GM_FF = 4096, GM_HALF = 2048;
constexpr float LN_EPS = 1e-5f, RMS_EPS = 1e-6f;
constexpr float DN_ALPHA = 1.6817928305074292f;
constexpr float LOG2E = 1.4426950408889634f, QSCALE = 0.125f * LOG2E;
constexpr int NPHASE = 35;

constexpr size_t MiB = 1u << 20;
constexpr size_t WS_CTL = 0, CTL_ZERO_BYTES = 1 * MiB;
constexpr size_t WS_MOD = 1 * MiB;
constexpr size_t WS_TAB = 2 * MiB;
constexpr size_t TB_FC = WS_TAB, TB_FA = TB_FC + 512 * 256 * 2, TB_FCC = TB_FA + 256 * 256 * 2, TB_FX = TB_FCC + 256 * 256 * 2, TB_TWC = TB_FX + 256 * 512 * 2,
                 TB_TWS = TB_TWC + 128 * 128 * 4, TB_ROPC = TB_TWS + 128 * 128 * 4, TB_ROPS = TB_ROPC + (size_t)NLAT * 32 * 4, TB_END = TB_ROPS + (size_t)NLAT * 32 * 4;
static_assert(TB_END <= 10 * MiB, "tables");
constexpr size_t WS_RW = 10 * MiB;
constexpr size_t WS_LCNT = 11 * MiB;
constexpr size_t WS_ASG = 12 * MiB, WS_GATE = WS_ASG + (size_t)T * 16, WS_SLOT = WS_GATE + (size_t)T * 16;
static_assert(WS_SLOT + (size_t)T * 16 <= 16 * MiB, "assign");
constexpr size_t WS_WFN = 16 * MiB, WS_WFAQ = WS_WFN + 2 * MiB, WS_WFAO = WS_WFAQ + 3 * MiB, WS_WGI = WS_WFAO + 2 * MiB, WS_WGO = WS_WGI + 8 * MiB,
                 WS_WWQ = WS_WGO + 4 * MiB, WS_WWO = WS_WWQ + 3 * MiB, WS_WSM_END = WS_WWO + 2 * MiB;
static_assert(WS_WSM_END <= 40 * MiB, "small weights");
constexpr size_t WS_X = 40 * MiB;
constexpr size_t WS_H = 106 * MiB;
constexpr size_t WS_Y = 140 * MiB;
constexpr size_t WS_BIG = 176 * MiB;
constexpr size_t WS_BTA = WS_BIG, WS_BTC = WS_BTA + 64 * MiB, WS_BTX = WS_BTC + 64 * MiB, WS_MIXB = WS_BTX + 1 * MiB;
constexpr size_t WS_Q = WS_BIG, WS_K = WS_Q + 33 * MiB, WS_V = WS_K + 9 * MiB;
constexpr size_t WS_GU = WS_BIG, WS_GV = WS_GU + 65 * MiB, WS_GG = WS_GV + 65 * MiB;
constexpr int MAXMT = 292; constexpr size_t SLOTROWS = (size_t)MAXMT * 256;
constexpr size_t WS_XS = WS_BIG, WS_ACT = WS_XS + 146 * MiB, WS_YS = WS_ACT + 146 * MiB;
static_assert(SLOTROWS * 2048 <= 146 * MiB, "slots");
constexpr size_t WS_WEXP_GU = 640 * MiB, WS_WEXP_DN = WS_WEXP_GU + 512 * MiB, WS_END = WS_WEXP_DN + 256 * MiB;
static_assert(WS_YS + 146 * MiB <= WS_WEXP_GU, "big region");
constexpr int CW_BAR = 4096;

constexpr int RING_OFF = 0, RING_BYTES = 131072;
constexpr int PRO_SCR_BYTES = 8 * 64 * 65 * 4;
constexpr int MISC_OFF = 136 * 1024;
constexpr int LDS_BYTES = 147456;
constexpr int MW_BAR = 0, MW_LC = 8, MW_EBASE = 64, MW_MYBASE = 96, MW_NMT = 128, MW_MTE = 160;
static_assert(MISC_OFF + (MW_MTE + 304) * 4 <= LDS_BYTES && PRO_SCR_BYTES <= MISC_OFF, "LDS map");

#define GAS __attribute__((address_space(1)))
#define LAS __attribute__((address_space(3)))
typedef unsigned short bf16;
typedef unsigned v4u __attribute__((ext_vector_type(4)));
typedef unsigned v2u __attribute__((ext_vector_type(2)));
typedef float f32x4 __attribute__((ext_vector_type(4)));
typedef float f32x2 __attribute__((ext_vector_type(2)));
typedef float f32x16 __attribute__((ext_vector_type(16)));
typedef short bf16x8 __attribute__((ext_vector_type(8)));
typedef GAS unsigned gu32;
#define RLX_AGENT __ATOMIC_RELAXED, __HIP_MEMORY_SCOPE_AGENT
#define LDS_WAIT() asm volatile("s_waitcnt lgkmcnt(0)" ::: "memory")
#define VM_WAIT() asm volatile("s_waitcnt vmcnt(0)" ::: "memory")
__device__ __forceinline__ unsigned f2bf(float f) { unsigned u = __builtin_bit_cast(unsigned, f); return (u + 0x7fffu + ((u >> 16) & 1u)) >> 16; }
__device__ __forceinline__ unsigned pk2(float lo, float hi) { return f2bf(lo) | (f2bf(hi) << 16); }
__device__ __forceinline__ float bf_lo(unsigned w) { return __builtin_bit_cast(float, w << 16); }
__device__ __forceinline__ float bf_hi(unsigned w) { return __builtin_bit_cast(float, w & 0xffff0000u); }
#define XB_TMO      128
#define XB_XCNT(j)  (256  + 64 * (j))
#define XB_XSUB(j)  (1280 + 64 * (j))
#define XB_XGEN(j)  (2304 + 64 * (j))
#define XB_TOP      3328
#define XB_TOPGEN   3392
#define XCD_BAR_WORDS 3456
#define XB_SPIN_CAP (1u << 18)

__device__ __forceinline__ unsigned xb_ld(unsigned* p)              { return __hip_atomic_load(p, __ATOMIC_RELAXED, __HIP_MEMORY_SCOPE_AGENT); }
__device__ __forceinline__ unsigned xb_add(unsigned* p, unsigned v) { return __hip_atomic_fetch_add(p, v, __ATOMIC_RELAXED, __HIP_MEMORY_SCOPE_AGENT); }
__device__ __forceinline__ unsigned xb_xcc_id() { return (unsigned)__builtin_amdgcn_s_getreg((3 << 11) | 20) & 0xFu; }
#define XB_SPIN(cond, bar) do { unsigned _sp = 0; while (cond) { __builtin_amdgcn_s_sleep(1); \
    if ((++_sp & 255u) == 0u) { if (xb_ld(&(bar)[XB_TMO])) break; if (_sp > XB_SPIN_CAP) { atomicAdd(&(bar)[XB_TMO], 1u); break; } } } } while (0)

struct XcdBarrier {
    unsigned* bar; unsigned x;
    volatile LAS unsigned* st;
};

__device__ __forceinline__ XcdBarrier xcd_barrier_post(unsigned* bar, volatile LAS unsigned* st) {
    XcdBarrier b; b.bar = bar; b.x = xb_xcc_id(); b.st = st;
    if (threadIdx.x == 0) (void)xb_add(&bar[XB_XCNT(b.x)], 1u);
    return b;
}
__device__ __forceinline__ void xcd_barrier_complete(unsigned* bar, unsigned x, unsigned& nloc, unsigned& nx) {
    const unsigned G = gridDim.x * gridDim.y * gridDim.z;
    unsigned sum, cnt, mine, sp = 0u;
    for (;;) {
        sum = 0u; cnt = 0u; mine = 0u;
#pragma unroll
        for (unsigned j = 0; j < 16; ++j) { const unsigned c = xb_ld(&bar[XB_XCNT(j)]); sum += c; cnt += (c > 0u) ? 1u : 0u; mine = (j == x) ? c : mine; }
        if (sum == G) break;
        __builtin_amdgcn_s_sleep(1);
        if ((++sp & 255u) == 0u) { if (xb_ld(&bar[XB_TMO])) break; if (sp > XB_SPIN_CAP) { atomicAdd(&bar[XB_TMO], 1u); break; } }
    }
    nloc = mine > 0u ? mine : 1u; nx = cnt > 0u ? cnt : 1u;
}

__device__ __forceinline__ void xcd_barrier(const XcdBarrier& b) {
    asm volatile("s_waitcnt vmcnt(0)" ::: "memory");
    __syncthreads();
    if (threadIdx.x == 0) {
        unsigned* bar = b.bar;
        __builtin_amdgcn_s_waitcnt(0);
        unsigned nloc = b.st[0], nx = b.st[1];
        if (nloc == 0u) { xcd_barrier_complete(bar, b.x, nloc, nx); b.st[0] = nloc; b.st[1] = nx; }
        const unsigned old = xb_add(&bar[XB_XSUB(b.x)], 1u);
        const unsigned gen = old / nloc;
        if (old + 1u == (gen + 1u) * nloc) {
            __builtin_amdgcn_fence(__ATOMIC_RELEASE, "agent");
            asm volatile("s_waitcnt vmcnt(0)" ::: "memory");
            const unsigned og = xb_add(&bar[XB_TOP], 1u);
            const unsigned tg = og / nx;
            if (og + 1u == (tg + 1u) * nx) xb_add(&bar[XB_TOPGEN], 1u);
            else XB_SPIN(xb_ld(&bar[XB_TOPGEN]) == tg, bar);
            __builtin_amdgcn_fence(__ATOMIC_ACQUIRE, "agent");
            xb_add(&bar[XB_XGEN(b.x)], 1u);
            asm volatile("s_waitcnt vmcnt(0)" ::: "memory");
        } else {
            XB_SPIN(xb_ld(&bar[XB_XGEN(b.x)]) == gen, bar);
            __builtin_amdgcn_fence(__ATOMIC_ACQUIRE, "agent");
            asm volatile("s_waitcnt vmcnt(0)" ::: "memory");
        }
    }
    __syncthreads();
}
struct Frame {
    LAS unsigned char* lds;
    volatile LAS unsigned* MISC;
    gu32* ctl;
    unsigned char* ws;
    int wave, vcu, G, bx;
};
enum In { I_X = 0, I_C, I_CTX, I_CCTX, I_ADAW, I_ADAB, I_LNMG, I_LNMB, I_LNFG, I_LNFB, I_FNW, I_FNB, I_FAWQ, I_FABQ, I_FAQN, I_FAKN, I_FAWO, I_FABO,
          I_GMWI, I_GMBI, I_GMVG, I_GMVB, I_GMWS, I_GMBS, I_GMWO, I_GMBO, I_WAWQ, I_WABQ, I_WASK, I_WAWO, I_WABO, I_RW, I_RB, I_EWGU, I_EBGU, I_EWD, I_EBD, N_IN };

#define CAS __attribute__((address_space(4)))
typedef const float* cfptr_t;
__device__ __forceinline__ const float* argp(int idx) {
    unsigned long long a = (unsigned long long)__builtin_amdgcn_kernarg_segment_ptr(); asm volatile("" : "+s"(a));
    return ((const CAS cfptr_t*)a)[idx];
}
__device__ __forceinline__ int otid() { int t = threadIdx.x; asm volatile("" : "+v"(t)); return t; }
__device__ __forceinline__ float wave_sum(float v) {
#pragma unroll
    for (int o = 1; o < 64; o <<= 1) v += __shfl_xor(v, o);
    return v;
}
struct RowV { f32x4 v[4]; };
__device__ __forceinline__ RowV ldrow(const float* p, int lane) { RowV r; const f32x4* q = (const f32x4*)p + lane;
#pragma unroll
    for (int j = 0; j < 4; ++j) r.v[j] = q[64 * j]; return r; }
__device__ __forceinline__ void strow(float* p, int lane, const RowV& r) { f32x4* q = (f32x4*)p + lane;
#pragma unroll
    for (int j = 0; j < 4; ++j) q[64 * j] = r.v[j]; }
__device__ __forceinline__ void strow_bf16(bf16* p, int lane, const RowV& r) { unsigned long long* q = (unsigned long long*)p + lane;
#pragma unroll
    for (int j = 0; j < 4; ++j) q[64 * j] = (unsigned long long)pk2(r.v[j].x, r.v[j].y) | ((unsigned long long)pk2(r.v[j].z, r.v[j].w) << 32); }
__device__ __forceinline__ RowV ldrow_bf16(const bf16* p, int lane) { RowV r; const v2u* q = (const v2u*)p + lane;
#pragma unroll
    for (int j = 0; j < 4; ++j) { const v2u w = q[64 * j]; r.v[j] = (f32x4){bf_lo(w.x), bf_hi(w.x), bf_lo(w.y), bf_hi(w.y)}; } return r; }
__device__ __forceinline__ RowV ln_row(const RowV& x, const RowV& g, const RowV& b) {
    float s = 0.f;
#pragma unroll
    for (int j = 0; j < 4; ++j) s += (x.v[j].x + x.v[j].y) + (x.v[j].z + x.v[j].w);
    const float mean = wave_sum(s) * (1.f / DM); float s2 = 0.f; RowV d;
#pragma unroll
    for (int j = 0; j < 4; ++j) { d.v[j] = x.v[j] - mean; s2 += (d.v[j].x * d.v[j].x + d.v[j].y * d.v[j].y) + (d.v[j].z * d.v[j].z + d.v[j].w * d.v[j].w); }
    const float rstd = 1.f / sqrtf(wave_sum(s2) * (1.f / DM) + LN_EPS);
#pragma unroll
    for (int j = 0; j < 4; ++j) d.v[j] = d.v[j] * rstd * g.v[j] + b.v[j];
    return d;
}
__device__ __forceinline__ const float* modp(const Frame& F, int L, int s, int which) { return (const float*)(F.ws + WS_MOD) + ((size_t)(L * 2 + s) * 6 + which) * DM; }

struct TokOrder : pg8::GridOrder {
    size_t apan, bpan;
    __device__ __forceinline__ bool next(int i, pg8::Unit& u) const { u.e = 0; return next_mn(i, u.pm, u.pn); }
    __device__ __forceinline__ size_t offA(const pg8::Unit& u) const { return (size_t)u.pm * apan; }
    __device__ __forceinline__ size_t offB(const pg8::Unit& u) const { return (size_t)u.pn * bpan; }
    __device__ __forceinline__ void a_ready(const pg8::Unit&) const {}
    __device__ __forceinline__ void done(const pg8::Unit&) const {}
};
struct ChDftOrder : pg8::GridOrder {
    __device__ __forceinline__ bool next(int i, pg8::Unit& u) const { u.e = 0; return next_mn(i, u.pm, u.pn); }
    __device__ __forceinline__ size_t offA(const pg8::Unit& u) const { return (size_t)u.pm * (256 * 256 * 2); }
    __device__ __forceinline__ size_t offB(const pg8::Unit& u) const { const int g = u.pn >> 6, j = u.pn & 63; return ((size_t)(2 * j) * DM + g * 256) * 2; }
    __device__ __forceinline__ void a_ready(const pg8::Unit&) const {}
    __device__ __forceinline__ void done(const pg8::Unit&) const {}
};
struct ChDftCtxOrder : pg8::GridOrder {
    __device__ __forceinline__ bool next(int i, pg8::Unit& u) const { u.e = 0; return next_mn(i, u.pm, u.pn); }
    __device__ __forceinline__ size_t offA(const pg8::Unit& u) const { return (size_t)u.pm * (256 * 256 * 2); }
    __device__ __forceinline__ size_t offB(const pg8::Unit& u) const { return ((size_t)NLAT * DM + u.pn * 256) * 2; }
    __device__ __forceinline__ void a_ready(const pg8::Unit&) const {}
    __device__ __forceinline__ void done(const pg8::Unit&) const {}
};
struct MoeOrder : pg8::GridOrder {
    const volatile LAS unsigned* mte; size_t bexp;
    __device__ __forceinline__ bool next(int i, pg8::Unit& u) const { if (!next_mn(i, u.pm, u.pn)) return false; u.e = (int)mte[u.pm]; return true; }
    __device__ __forceinline__ size_t offA(const pg8::Unit& u) const { return (size_t)u.pm * (256 * 1024 * 2); }
    __device__ __forceinline__ size_t offB(const pg8::Unit& u) const { return (size_t)u.e * bexp + (size_t)u.pn * (256 * 1024 * 2); }
    __device__ __forceinline__ void a_ready(const pg8::Unit&) const {}
    __device__ __forceinline__ void done(const pg8::Unit&) const {}
};

#define EPI_ARGS const pg8::f32x4 (&acc)[2][2][4][2], const pg8::Unit& u, int wr, int wc, int fr, int fq
__device__ __forceinline__ v4u pack8(const f32x4& a, const f32x4& b) { v4u w; w.x = pg8::cvt_pk_bf16(a[0], a[1]); w.y = pg8::cvt_pk_bf16(a[2], a[3]); w.z = pg8::cvt_pk_bf16(b[0], b[1]); w.w = pg8::cvt_pk_bf16(b[2], b[3]); return w; }

struct EpiChDft { static constexpr bool PERM = true, AFTER_DRAIN = false; bf16* O;
    __device__ __forceinline__ void operator()(EPI_ARGS) const {
        const int g = u.pn >> 6, j = u.pn & 63, part = u.pm;
        char* ub = (char*)O + 2 * ((size_t)((g * 256 + 64 * wr) * 128 + 2 * j) * 256 + part * 128 + 32 * wc);
        unsigned lo = 2u * (unsigned)(fr * 128 * 256 + 8 * fq); asm volatile("" : "+v"(lo));
#pragma unroll
        for (int ai = 0; ai < 2; ++ai)
#pragma unroll
            for (int m = 0; m < 4; ++m)
#pragma unroll
                for (int bj = 0; bj < 2; ++bj)
                    *(v4u*)(ub + (size_t)(2 * (((128 * ai + 16 * m) * 128 + bj) * 256)) + lo) = pack8(acc[ai][bj][m][0], acc[ai][bj][m][1]);
    }
};
struct EpiChDftCtx { static constexpr bool PERM = true, AFTER_DRAIN = false; bf16* O;
    __device__ __forceinline__ void operator()(EPI_ARGS) const {
        const int g = u.pn, part = u.pm;
        char* ub = (char*)O + 2 * ((size_t)(g * 256 + 64 * wr) * 512 + part * 256 + 32 * wc);
        unsigned lo = 2u * (unsigned)(fr * 512 + 8 * fq); asm volatile("" : "+v"(lo));
#pragma unroll
        for (int ai = 0; ai < 2; ++ai)
#pragma unroll
            for (int m = 0; m < 4; ++m)
#pragma unroll
                for (int bj = 0; bj < 2; ++bj)
                    *(v4u*)(ub + (size_t)(2 * ((128 * ai + 16 * m) * 512 + 128 * bj)) + lo) = pack8(acc[ai][bj][m][0], acc[ai][bj][m][1]);
    }
};
struct EpiStepA { static constexpr bool PERM = true, AFTER_DRAIN = false; bf16* O; const float* twc; const float* tws;
    __device__ __forceinline__ void operator()(EPI_ARGS) const {
        char* ub = (char*)O + 2 * ((size_t)(64 * wr * 1024 + 2 * u.pn) * 256 + 32 * wc);
        unsigned lo = 2u * (unsigned)(fr * 1024 * 256 + 8 * fq); asm volatile("" : "+v"(lo));
        const char* tcb = (const char*)twc + 4 * (64 * wr * 128 + 32 * wc); const char* tsb = (const char*)tws + 4 * (64 * wr * 128 + 32 * wc);
        unsigned tlo = 4u * (unsigned)(fr * 128 + 8 * fq); asm volatile("" : "+v"(tlo));
#pragma unroll
        for (int m = 0; m < 4; ++m) {
            const f32x4 c0 = *(const f32x4*)(tcb + 4 * (16 * m * 128) + tlo), c1 = *(const f32x4*)(tcb + 4 * (16 * m * 128 + 4) + tlo), s0 = *(const f32x4*)(tsb + 4 * (16 * m * 128) + tlo), s1 = *(const f32x4*)(tsb + 4 * (16 * m * 128 + 4) + tlo);
#pragma unroll
            for (int bj = 0; bj < 2; ++bj) {
                const f32x4 zr0 = acc[0][bj][m][0], zr1 = acc[0][bj][m][1], zi0 = acc[1][bj][m][0], zi1 = acc[1][bj][m][1];
                const f32x4 yr0 = zr0 * c0 + zi0 * s0, yr1 = zr1 * c1 + zi1 * s1, yi0 = zi0 * c0 - zr0 * s0, yi1 = zi1 * c1 - zr1 * s1;
                char* p = ub + (size_t)(2 * ((16 * m * 1024 + bj) * 256)) + lo;
                *(v4u*)p = pack8(yr0, yr1); *(v4u*)(p + 256) = pack8(yi0, yi1); }
            asm volatile("" ::: "memory"); }
    }
};
struct EpiStepC { static constexpr bool PERM = true, AFTER_DRAIN = false; bf16* O;
    __device__ __forceinline__ void operator()(EPI_ARGS) const {
        const int k1 = u.pn >> 2, chb = (u.pn & 3) * 256;
        char* ub = (char*)O + 2 * ((size_t)(k1 + 128 * 64 * wr) * DM + chb + 32 * wc);
        unsigned lo = 2u * (unsigned)(128 * fr * DM + 8 * fq); asm volatile("" : "+v"(lo));
#pragma unroll
        for (int m = 0; m < 4; ++m)
#pragma unroll
            for (int bj = 0; bj < 2; ++bj)
                *(v4u*)(ub + (size_t)(2 * (128 * 16 * m * DM + 128 * bj)) + lo) = pack8(acc[0][bj][m][0], acc[0][bj][m][1]);
    }
};
struct EpiCtxPos { static constexpr bool PERM = true, AFTER_DRAIN = false; bf16* O;
    __device__ __forceinline__ void operator()(EPI_ARGS) const {
        char* ub = (char*)O + 2 * ((size_t)(NLAT + 64 * wr) * DM + u.pn * 256 + 32 * wc);
        unsigned lo = 2u * (unsigned)(fr * DM + 8 * fq); asm volatile("" : "+v"(lo));
#pragma unroll
        for (int ai = 0; ai < 2; ++ai)
#pragma unroll
            for (int m = 0; m < 4; ++m)
#pragma unroll
                for (int bj = 0; bj < 2; ++bj)
                    *(v4u*)(ub + (size_t)(2 * ((128 * ai + 16 * m) * DM + 128 * bj)) + lo) = pack8(acc[ai][bj][m][0], acc[ai][bj][m][1]);
    }
};
template <int NKV, bool RMS> struct EpiQKV { static constexpr bool PERM = true, AFTER_DRAIN = false;
    bf16 *Q, *K, *V; const float* bias; const float* qn; const float* kn; const float* ropc; const float* rops;
    __device__ __forceinline__ void operator()(EPI_ARGS) const {
        const int hh = 4 * u.pn + wc; const int kind = hh < 16 ? 0 : (hh < 16 + NKV ? 1 : 2);
        const int pitch = kind == 0 ? DM : NKV * 64, hd = kind == 0 ? hh : (kind == 1 ? hh - 16 : hh - 16 - NKV);
        const size_t doff = kind == 0 ? (size_t)0 : (kind == 1 ? (size_t)(WS_K - WS_Q) : (size_t)(WS_V - WS_Q));
        bf16* dst = (bf16*)((char*)Q + doff);
        const bool lat = u.pm < NLAT / 256;
        const int rowu = u.pm * 256 + 64 * wr;
        char* ub = (char*)dst + 2 * ((size_t)rowu * pitch + hd * 64);
        unsigned lo = 2u * (unsigned)(fr * pitch + 8 * fq); asm volatile("" : "+v"(lo));
        const char* rcb = (const char*)ropc + 4 * ((size_t)rowu * 32); const char* rsb = (const char*)rops + 4 * ((size_t)rowu * 32);
        unsigned rlo = 4u * (unsigned)(fr * 32 + 4 * fq); asm volatile("" : "+v"(rlo));
        f32x4 bv[2][2], gv[2][2];
#pragma unroll
        for (int bj = 0; bj < 2; ++bj)
#pragma unroll
            for (int n = 0; n < 2; ++n) { const int d = 32 * bj + 8 * fq + 4 * n; bv[bj][n] = *(const f32x4*)(bias + hh * 64 + d);
                if (RMS) { const f32x4 gq = *(const f32x4*)(qn + d), gk = *(const f32x4*)(kn + d); gv[bj][n] = kind == 0 ? gq : gk; } }
#pragma unroll
        for (int ai = 0; ai < 2; ++ai)
#pragma unroll
            for (int m = 0; m < 4; ++m) {
                f32x4 v[2][2];
#pragma unroll
                for (int bj = 0; bj < 2; ++bj)
#pragma unroll
                    for (int n = 0; n < 2; ++n) v[bj][n] = acc[ai][bj][m][n] + bv[bj][n];
                if (kind < 2) {
                    if (RMS) { float ss = 0.f;
#pragma unroll
                        for (int bj = 0; bj < 2; ++bj)
#pragma unroll
                            for (int n = 0; n < 2; ++n) ss += (v[bj][n][0] * v[bj][n][0] + v[bj][n][1] * v[bj][n][1]) + (v[bj][n][2] * v[bj][n][2] + v[bj][n][3] * v[bj][n][3]);
                        ss += __shfl_xor(ss, 16); ss += __shfl_xor(ss, 32);
                        const float rs = 1.f / sqrtf(ss * (1.f / 64.f) + RMS_EPS);
#pragma unroll
                        for (int bj = 0; bj < 2; ++bj)
#pragma unroll
                            for (int n = 0; n < 2; ++n) v[bj][n] = v[bj][n] * rs * gv[bj][n]; }
                    if (lat) {
#pragma unroll
                        for (int bj = 0; bj < 2; ++bj)
#pragma unroll
                            for (int n = 0; n < 2; ++n) {
                                const f32x2 c = *(const f32x2*)(rcb + 4 * ((128 * ai + 16 * m) * 32 + 16 * bj + 2 * n) + rlo), sn = *(const f32x2*)(rsb + 4 * ((128 * ai + 16 * m) * 32 + 16 * bj + 2 * n) + rlo);
                                const f32x4 x = v[bj][n];
                                v[bj][n] = (f32x4){x[0] * c.x - x[1] * sn.x, x[0] * sn.x + x[1] * c.x, x[2] * c.y - x[3] * sn.y, x[2] * sn.y + x[3] * c.y}; } }
                    if (kind == 0) {
#pragma unroll
                        for (int bj = 0; bj < 2; ++bj)
#pragma unroll
                            for (int n = 0; n < 2; ++n) v[bj][n] = v[bj][n] * QSCALE; }
                }
                char* p = ub + (size_t)(128 * ai + 16 * m) * (size_t)(2 * pitch) + lo;
                *(v4u*)p = pack8(v[0][0], v[0][1]); *(v4u*)(p + 64) = pack8(v[1][0], v[1][1]);
                asm volatile("" ::: "memory"); }
    }
};
struct EpiSwiGLU { static constexpr bool PERM = true, AFTER_DRAIN = false; bf16* O; const float* bias;
    __device__ __forceinline__ void operator()(EPI_ARGS) const {
        f32x4 bv[2][2];
        const float* bb = bias + (size_t)u.e * 2048 + u.pn * 256 + 32 * wc + 8 * fq;
#pragma unroll
        for (int bj = 0; bj < 2; ++bj)
#pragma unroll
            for (int n = 0; n < 2; ++n) bv[bj][n] = *(const f32x4*)(bb + 128 * bj + 4 * n);
        char* ub = (char*)O + 2 * (((size_t)u.pm * 256 + 64 * wr) * 1024 + u.pn * 128 + 16 * wc);
        unsigned lo = 2u * (unsigned)(fr * 1024 + 4 * fq); asm volatile("" : "+v"(lo));
#pragma unroll
        for (int ai = 0; ai < 2; ++ai)
#pragma unroll
            for (int m = 0; m < 4; ++m) {
#pragma unroll
                for (int bj = 0; bj < 2; ++bj) { float a[4];
#pragma unroll
                    for (int n = 0; n < 2; ++n) { const f32x4 x = acc[ai][bj][m][n] + bv[bj][n];
#pragma unroll
                        for (int q = 0; q < 2; ++q) { const float glu = fminf(x[2 * q], 7.0f), lin = fminf(fmaxf(x[2 * q + 1], -7.0f), 7.0f);
                            const float sg = __builtin_amdgcn_rcpf(1.0f + __builtin_amdgcn_exp2f(-1.702f * LOG2E * glu));
                            a[2 * n + q] = glu * sg * (lin + 1.0f); } }
                    v2u w; w.x = pg8::cvt_pk_bf16(a[0], a[1]); w.y = pg8::cvt_pk_bf16(a[2], a[3]);
                    *(v2u*)(ub + (size_t)(2 * ((128 * ai + 16 * m) * 1024 + 64 * bj)) + lo) = w; } }
    }
};
struct EpiDown { static constexpr bool PERM = true, AFTER_DRAIN = false; bf16* O; const float* bias;
    __device__ __forceinline__ void operator()(EPI_ARGS) const {
        f32x4 bv[2][2];
        const float* bb = bias + (size_t)u.e * 1024 + u.pn * 256 + 32 * wc + 8 * fq;
#pragma unroll
        for (int bj = 0; bj < 2; ++bj)
#pragma unroll
            for (int n = 0; n < 2; ++n) bv[bj][n] = *(const f32x4*)(bb + 128 * bj + 4 * n);
        char* ub = (char*)O + 2 * (((size_t)u.pm * 256 + 64 * wr) * 1024 + u.pn * 256 + 32 * wc);
        unsigned lo = 2u * (unsigned)(fr * 1024 + 8 * fq); asm volatile("" : "+v"(lo));
#pragma unroll
        for (int ai = 0; ai < 2; ++ai)
#pragma unroll
            for (int m = 0; m < 4; ++m)
#pragma unroll
                for (int bj = 0; bj < 2; ++bj)
                    *(v4u*)(ub + (size_t)(2 * ((128 * ai + 16 * m) * 1024 + 128 * bj)) + lo) = pack8(acc[ai][bj][m][0] + bv[bj][0], acc[ai][bj][m][1] + bv[bj][1]);
    }
};
__device__ __forceinline__ int qkv_rowmap(int n) { return (n & ~255) + ((n >> 5) & 1) * 128 + ((n >> 6) & 3) * 32 + (n & 31); }
__device__ __forceinline__ void p0_transpose_item(const float* W, int K, int N, bf16* WT, int rowmode, LAS float* scr, int item, int lane) {
    const int nblk = N / 64, kb = item / nblk, nb = item - kb * nblk, k0 = 64 * kb, n0 = 64 * nb;
    const int r = lane >> 4, cq = lane & 15;
    f32x4 t[16];
#pragma unroll
    for (int i = 0; i < 16; ++i) t[i] = *(const f32x4*)(W + (size_t)(k0 + 4 * i + r) * N + n0 + 4 * cq);
#pragma unroll
    for (int i = 0; i < 16; ++i) { LAS float* s = scr + (4 * i + r) * 65 + 4 * cq; s[0] = t[i].x; s[1] = t[i].y; s[2] = t[i].z; s[3] = t[i].w; }
    LDS_WAIT(); asm volatile("" ::: "memory");
    const int c = lane & 7, nn = lane >> 3;
#pragma unroll
    for (int j = 0; j < 8; ++j) { const int n = nn + 8 * j; const LAS float* s = scr + (8 * c) * 65 + n;
        v4u o; o.x = pk2(s[0 * 65], s[1 * 65]); o.y = pk2(s[2 * 65], s[3 * 65]); o.z = pk2(s[4 * 65], s[5 * 65]); o.w = pk2(s[6 * 65], s[7 * 65]);
        const int row = rowmode ? qkv_rowmap(n0 + n) : (n0 + n);
        *(GAS v4u*)(WT + (size_t)row * K + k0 + 8 * c) = o; }
    LDS_WAIT(); asm volatile("" ::: "memory");
}
__device__ __forceinline__ float siluf(float v) { return v / (1.f + __expf(-v)); }
__device__ __forceinline__ void p0_prologue(Frame& F) { const int tid = otid(), lane = tid & 63; (void)tid; (void)lane;
    {
        LAS float* sc = (LAS float*)(F.lds);
        LAS float* red = sc + 2048;
        { const float* c0 = argp(I_C); const float* c1 = argp(I_CCTX);
          for (int i = tid; i < 2048; i += NTHR) { const int s = i >> 10, k = i & 1023; sc[i] = siluf(s == 0 ? c0[k] : c1[k]); } }
        __syncthreads();
        const float* adaw = argp(I_ADAW); const float* adab = argp(I_ADAB);
        for (int task = F.bx; task < 4 * 48; task += F.G) {
            const int L = task / 48, n0 = (task % 48) * 128;
            const float* w = adaw + (size_t)L * DM * 6144 + n0 + 2 * lane;
            float a0 = 0.f, a1 = 0.f, b0 = 0.f, b1 = 0.f;
#pragma unroll 8
            for (int kk = 0; kk < 128; ++kk) { const int k = 128 * F.wave + kk; const f32x2 x = *(const f32x2*)(w + (size_t)k * 6144); const float sl = sc[k], sx = sc[1024 + k];
                a0 += sl * x.x; a1 += sl * x.y; b0 += sx * x.x; b1 += sx * x.y; }
            red[(F.wave * 2 + 0) * 128 + 2 * lane] = a0; red[(F.wave * 2 + 0) * 128 + 2 * lane + 1] = a1;
            red[(F.wave * 2 + 1) * 128 + 2 * lane] = b0; red[(F.wave * 2 + 1) * 128 + 2 * lane + 1] = b1;
            __syncthreads();
            if (tid < 256) { const int s = tid >> 7, col = tid & 127; float v = adab[(size_t)L * 6144 + n0 + col];
#pragma unroll
                for (int wv = 0; wv < 8; ++wv) v += red[(wv * 2 + s) * 128 + col];
                ((float*)(F.ws + WS_MOD))[(size_t)(L * 2 + s) * 6144 + n0 + col] = v; }
            __syncthreads();
        }
    }
    {
        const int gt = F.bx * NTHR + tid, NGT = F.G * NTHR;
        bf16* fc = (bf16*)(F.ws + TB_FC); bf16* fa = (bf16*)(F.ws + TB_FA); bf16* fcc = (bf16*)(F.ws + TB_FCC); bf16* fx = (bf16*)(F.ws + TB_FX);
        float* twc = (float*)(F.ws + TB_TWC); float* tws = (float*)(F.ws + TB_TWS); float* ropc = (float*)(F.ws + TB_ROPC); float* rops = (float*)(F.ws + TB_ROPS);
        for (int i = gt; i < 512 * 256; i += NGT) { const int row = i >> 8, c = i & 255, part = row >> 8, l = row & 255; const int m = (c * l) & 255;
            const float ang = (float)m * (2.0f / 256.0f); const float v = part == 0 ? cospif(ang) : -sinpif(ang); fc[i] = (bf16)f2bf(v * (1.0f / 16.0f)); }
        for (int i = gt; i < 256 * 256; i += NGT) { const int row = i >> 8, col = i & 255, pr = row >> 7, k1 = row & 127, pc = col >> 7, n1 = col & 127; const int m = (n1 * k1) & 127;
            const float ang = (float)m * (2.0f / 128.0f); const float cs = cospif(ang), sn = sinpif(ang);
            const float v = (pr == pc) ? cs : (pr == 0 ? sn : -sn); fa[i] = (bf16)f2bf(v * 0.08838834764831845f); }
        for (int i = gt; i < 256 * 256; i += NGT) { const int row = i >> 8, col = i & 255, pc = col >> 7, n2 = col & 127; float v = 0.f;
            if (row < 128) { const int m = (n2 * row) & 127; const float ang = (float)m * (2.0f / 128.0f); v = (pc == 0 ? cospif(ang) : sinpif(ang)) * 0.08838834764831845f; }
            fcc[i] = (bf16)f2bf(v); }
        for (int i = gt; i < 256 * 512; i += NGT) { const int k = i >> 9, col = i & 511, pc = col >> 8, n = col & 255; const int m = (n * k) & 255;
            const float ang = (float)m * (2.0f / 256.0f); fx[i] = (bf16)f2bf((pc == 0 ? cospif(ang) : sinpif(ang)) * (1.0f / 16.0f)); }
        for (int i = gt; i < 128 * 128; i += NGT) { const int k1 = i >> 7, n2 = i & 127; const float ang = (float)(k1 * n2) * (2.0f / 16384.0f); twc[i] = cospif(ang); tws[i] = sinpif(ang); }
        for (int i = gt; i < NLAT * 32; i += NGT) { const int t = i >> 5, j = i & 31; const float pos = (float)(j < 16 ? (t >> 6) : (t & 63));
            const float inv = powf(10000.0f, -(float)(j & 15) * (1.0f / 16.0f)); const float ang = pos * inv; float sn, cs; sincosf(ang, &sn, &cs); ropc[i] = cs; rops[i] = sn; }
        bf16* rw = (bf16*)(F.ws + WS_RW); const float* rwin = argp(I_RW);
        for (int i = gt; i < 4 * 32 * 1024; i += NGT) { const int L = i >> 15, e = (i >> 10) & 31, k = i & 1023; rw[i] = (bf16)f2bf(rwin[((size_t)L * 1024 + k) * 32 + e]); }
    }
    __syncthreads();
    {
        LAS float* scr = (LAS float*)(F.lds) + F.wave * (64 * 65);
        const int gw = F.vcu * NWAVES + F.wave, NGW = F.G * NWAVES;
        constexpr int I1 = 16 * 16, I2 = 16 * 24, I3 = 16 * 16, I4 = 16 * 64, I5 = 32 * 16, I6 = 16 * 20, I7 = 16 * 16, ISM = I1 + I2 + I3 + I4 + I5 + I6 + I7;
        constexpr int IGU = 16 * 32, IDN = 16 * 16, NITEMS = ISM + 128 * IGU + 128 * IDN;
        for (int it = gw; it < NITEMS; it += NGW) {
            int r = it;
            if (r < ISM) {
                if (r < I1) { p0_transpose_item(argp(I_FNW), 1024, 1024, (bf16*)(F.ws + WS_WFN), 0, scr, r, lane); continue; } r -= I1;
                if (r < I2) { p0_transpose_item(argp(I_FAWQ), 1024, FA_NQKV, (bf16*)(F.ws + WS_WFAQ), 1, scr, r, lane); continue; } r -= I2;
                if (r < I3) { p0_transpose_item(argp(I_FAWO), 1024, 1024, (bf16*)(F.ws + WS_WFAO), 0, scr, r, lane); continue; } r -= I3;
                if (r < I4) { p0_transpose_item(argp(I_GMWI), 1024, GM_FF, (bf16*)(F.ws + WS_WGI), 0, scr, r, lane); continue; } r -= I4;
                if (r < I5) { p0_transpose_item(argp(I_GMWO), 2048, 1024, (bf16*)(F.ws + WS_WGO), 0, scr, r, lane); continue; } r -= I5;
                if (r < I6) { p0_transpose_item(argp(I_WAWQ), 1024, WA_NQKV, (bf16*)(F.ws + WS_WWQ), 1, scr, r, lane); continue; } r -= I6;
                p0_transpose_item(argp(I_WAWO), 1024, 1024, (bf16*)(F.ws + WS_WWO), 0, scr, r, lane); continue;
            }
            r -= ISM;
            if (r < 128 * IGU) { const int le = r / IGU; p0_transpose_item(argp(I_EWGU) + (size_t)le * 1024 * 2048, 1024, 2048, (bf16*)(F.ws + WS_WEXP_GU) + (size_t)le * 2048 * 1024, 0, scr, r - le * IGU, lane); continue; }
            r -= 128 * IGU;
            { const int le = r / IDN; p0_transpose_item(argp(I_EWD) + (size_t)le * 1024 * 1024, 1024, 1024, (bf16*)(F.ws + WS_WEXP_DN) + (size_t)le * 1024 * 1024, 0, scr, r - le * IDN, lane); }
        }
    }
}

__device__ __forceinline__ void pass_init(Frame& F) { const int tid = otid(), lane = tid & 63; (void)tid; (void)lane;
    const int gw = F.vcu * NWAVES + F.wave, NGW = F.G * NWAVES;
    int cur_s = -1; RowV sc, sh;
    for (int m = gw; m < T; m += NGW) {
        const int s = m >= NLAT;
        if (s != cur_s) { cur_s = s; sh = ldrow(modp(F, 0, s, 0), lane); sc = ldrow(modp(F, 0, s, 1), lane); }
        const float* src = s ? argp(I_CTX) + (size_t)(m - NLAT) * DM : argp(I_X) + (size_t)m * DM;
        RowV x = ldrow(src, lane);
        strow((float*)(F.ws + WS_X) + (size_t)m * DM, lane, x);
        RowV h;
#pragma unroll
        for (int j = 0; j < 4; ++j) h.v[j] = x.v[j] * (1.f + sc.v[j]) + sh.v[j];
        strow_bf16((bf16*)(F.ws + WS_H) + (size_t)m * DM, lane, h);
    }
}

template <int L> __device__ __forceinline__ void pass_mix(Frame& F) { const int tid = otid(), lane = tid & 63; (void)tid; (void)lane;
    constexpr bool HAS_CTX = L < 3, MIX_ON = (EN_MIX >> L) & 1, MOE_ON = (EN_MOE >> L) & 1;
    constexpr int HP = 1032;
    LAS bf16* HT = (LAS bf16*)(F.lds);
    LAS float* PART = (LAS float*)(F.lds + 32 * HP * 2);
    LAS float* LOGT = PART + 8 * 32 * 33;
    volatile LAS unsigned* LC = F.MISC + MW_LC;
    float* X = (float*)(F.ws + WS_X); bf16* H = (bf16*)(F.ws + WS_H); const bf16* Y = (const bf16*)(F.ws + WS_Y);
    unsigned* ASG = (unsigned*)(F.ws + WS_ASG); float* GATE = (float*)(F.ws + WS_GATE);
    const bf16* RW = (const bf16*)(F.ws + WS_RW) + (size_t)L * 32 * 1024;
    if (tid < 32) LC[tid] = 0u;
    __syncthreads();
    const float* rbias = argp(I_RB);
    const int nlt = NLAT / 32, nct = HAS_CTX ? NCTX : 0;
    int cur_s = -1; RowV g1, lg, lb, sc2, sh2;
    for (int it = F.bx; it < nlt + nct; it += F.G) {
        const bool isl = it < nlt; const int s = isl ? 0 : 1; const int row0 = isl ? it * 32 : NLAT + (it - nlt); const int nrows = isl ? 32 : 1;
        if (s != cur_s) { cur_s = s; g1 = ldrow(modp(F, L, s, 2), lane); sh2 = ldrow(modp(F, L, s, 3), lane); sc2 = ldrow(modp(F, L, s, 4), lane);
            lg = ldrow(argp(I_LNMG) + L * DM, lane); lb = ldrow(argp(I_LNMB) + L * DM, lane); }
        for (int rr = F.wave * 4; rr < F.wave * 4 + 4 && rr < nrows; ++rr) {
            const int m = row0 + rr;
            RowV x = ldrow(X + (size_t)m * DM, lane);
            if (MIX_ON) { RowV y = ldrow_bf16(Y + (size_t)m * DM, lane);
#pragma unroll
                for (int j = 0; j < 4; ++j) x.v[j] = x.v[j] * DN_ALPHA + g1.v[j] * y.v[j]; }
            else {
#pragma unroll
                for (int j = 0; j < 4; ++j) x.v[j] = x.v[j] * DN_ALPHA; }
            x = ln_row(x, lg, lb);
            strow(X + (size_t)m * DM, lane, x);
            RowV h;
#pragma unroll
            for (int j = 0; j < 4; ++j) h.v[j] = x.v[j] * (1.f + sc2.v[j]) + sh2.v[j];
            strow_bf16(H + (size_t)m * DM, lane, h);
            if (MOE_ON) { LAS unsigned long long* q = (LAS unsigned long long*)(HT + rr * HP) + lane;
#pragma unroll
                for (int j = 0; j < 4; ++j) q[64 * j] = (unsigned long long)pk2(h.v[j].x, h.v[j].y) | ((unsigned long long)pk2(h.v[j].z, h.v[j].w) << 32); }
        }
        if (MOE_ON) {
            __syncthreads();
            { const int r32 = lane & 31, hi = lane >> 5; f32x16 acc = f32x16{};
#pragma unroll
                for (int st = 0; st < 8; ++st) { const int k = 128 * F.wave + 16 * st + 8 * hi;
                    const bf16x8 a = *(const LAS bf16x8*)(HT + r32 * HP + k); const bf16x8 b = *(const bf16x8*)(RW + (size_t)r32 * 1024 + k);
                    acc = __builtin_amdgcn_mfma_f32_32x32x16_bf16(a, b, acc, 0, 0, 0); }
#pragma unroll
                for (int r = 0; r < 16; ++r) { const int tok = (r & 3) + 8 * (r >> 2) + 4 * hi; PART[(F.wave * 32 + tok) * 33 + r32] = acc[r]; } }
            __syncthreads();
            { const int t = tid >> 4, e0 = tid & 15;
#pragma unroll
                for (int q = 0; q < 2; ++q) { const int e = e0 + 16 * q; float v = rbias[L * 32 + e];
#pragma unroll
                    for (int wv = 0; wv < 8; ++wv) v += PART[(wv * 32 + t) * 33 + e];
                    LOGT[t * 33 + e] = v; } }
            __syncthreads();
            if (tid < nrows) { const int t = tid; float lv[32];
#pragma unroll
                for (int e = 0; e < 32; ++e) lv[e] = LOGT[t * 33 + e];
                int idx[4]; float val[4]; unsigned taken = 0u;
#pragma unroll
                for (int k = 0; k < 4; ++k) { float best = -INFINITY; int bi = 0;
#pragma unroll
                    for (int e = 0; e < 32; ++e) { const bool ok = !((taken >> e) & 1u) && lv[e] > best; best = ok ? lv[e] : best; bi = ok ? e : bi; }
                    idx[k] = bi; val[k] = best; taken |= 1u << bi; }
                float ev[4], sum = 0.f;
#pragma unroll
                for (int k = 0; k < 4; ++k) { ev[k] = __expf(val[k] - val[0]); sum += ev[k]; }
                const float inv = 1.f / sum; const int m = row0 + t;
#pragma unroll
                for (int k = 0; k < 4; ++k) { const unsigned pos = atomicAdd((unsigned*)&LC[idx[k]], 1u); ASG[(size_t)m * 4 + k] = ((unsigned)idx[k] << 16) | pos; GATE[(size_t)m * 4 + k] = ev[k] * inv; } }
            __syncthreads();
        }
    }
    if (MOE_ON) { __syncthreads(); if (tid < 32) ((unsigned*)(F.ws + WS_LCNT))[F.bx * 32 + tid] = LC[tid]; }
}

__device__ __forceinline__ void moe_tables(Frame& F) { const int tid = otid(), lane = tid & 63; (void)tid; (void)lane;
    LAS unsigned* red = (LAS unsigned*)(F.lds);
    const unsigned* LCNT = (const unsigned*)(F.ws + WS_LCNT);
    { const int e = tid & 31, part = tid >> 5; unsigned tot = 0u, low = 0u;
        for (int w = part; w < F.G; w += 16) { const unsigned c = __hip_atomic_load(LCNT + w * 32 + e, RLX_AGENT); tot += c; low += (w < F.bx) ? c : 0u; }
        red[part * 32 + e] = tot; red[512 + part * 32 + e] = low; }
    __syncthreads();
    if (tid < 32) { unsigned tot = 0u, low = 0u;
#pragma unroll
        for (int p = 0; p < 16; ++p) { tot += red[p * 32 + tid]; low += red[512 + p * 32 + tid]; }
        red[1024 + tid] = tot; F.MISC[MW_MYBASE + tid] = low; }
    __syncthreads();
    if (tid == 0) { unsigned base = 0u, nmt = 0u;
        for (int e = 0; e < 32; ++e) { const unsigned tiles = (red[1024 + e] + 255u) >> 8; F.MISC[MW_EBASE + e] = base; for (unsigned q = 0; q < tiles; ++q) F.MISC[MW_MTE + nmt + q] = (unsigned)e; nmt += tiles; base += tiles * 256u; }
        F.MISC[MW_NMT] = nmt; }
    __syncthreads();
}
__device__ __forceinline__ void moe_gather(Frame& F, bool has_ctx) { const int tid = otid(), lane = tid & 63; (void)tid; (void)lane;
    moe_tables(F);
    const bf16* H = (const bf16*)(F.ws + WS_H); bf16* XS = (bf16*)(F.ws + WS_XS);
    const unsigned* ASG = (const unsigned*)(F.ws + WS_ASG); unsigned* SLOT = (unsigned*)(F.ws + WS_SLOT);
    const int nlt = NLAT / 32, nct = has_ctx ? NCTX : 0;
    for (int it = F.bx; it < nlt + nct; it += F.G) {
        const bool isl = it < nlt; const int row0 = isl ? it * 32 : NLAT + (it - nlt); const int nrows = isl ? 32 : 1;
        for (int rr = F.wave * 4; rr < F.wave * 4 + 4 && rr < nrows; ++rr) {
            const int m = row0 + rr;
            const v4u a = *(const v4u*)(ASG + (size_t)m * 4);
            unsigned sl[4];
#pragma unroll
            for (int k = 0; k < 4; ++k) { const unsigned e = a[k] >> 16, pos = a[k] & 0xffffu; sl[k] = F.MISC[MW_EBASE + e] + F.MISC[MW_MYBASE + e] + pos; }
            if (lane == 0) *(v4u*)(SLOT + (size_t)m * 4) = (v4u){sl[0], sl[1], sl[2], sl[3]};
            const v4u* src = (const v4u*)(H + (size_t)m * DM) + lane; const v4u h0 = src[0], h1 = src[64];
#pragma unroll
            for (int k = 0; k < 4; ++k) { v4u* dst = (v4u*)(XS + (size_t)sl[k] * DM) + lane; dst[0] = h0; dst[64] = h1; }
        }
    }
}
template <int L> __device__ __forceinline__ void pass_comb(Frame& F) { const int tid = otid(), lane = tid & 63; (void)tid; (void)lane;
    constexpr bool HAS_CTX = L < 3, MOE_ON = (EN_MOE >> L) & 1;
    const int gw = F.vcu * NWAVES + F.wave, NGW = F.G * NWAVES;
    float* X = (float*)(F.ws + WS_X); bf16* H = (bf16*)(F.ws + WS_H); const bf16* YS = (const bf16*)(F.ws + WS_YS);
    const unsigned* SLOT = (const unsigned*)(F.ws + WS_SLOT); const float* GATE = (const float*)(F.ws + WS_GATE);
    int cur_s = -1; RowV g2, lg, lb, sc, sh;
    for (int m = gw; m < (HAS_CTX ? T : NLAT); m += NGW) {
        const int s = m >= NLAT;
        if (s != cur_s) { cur_s = s; g2 = ldrow(modp(F, L, s, 5), lane); lg = ldrow(argp(I_LNFG) + L * DM, lane); lb = ldrow(argp(I_LNFB) + L * DM, lane);
            if (L < 3) { sh = ldrow(modp(F, L < 3 ? L + 1 : 0, s, 0), lane); sc = ldrow(modp(F, L < 3 ? L + 1 : 0, s, 1), lane); } }
        RowV x = ldrow(X + (size_t)m * DM, lane);
        if (MOE_ON) {
            const v4u sl = *(const v4u*)(SLOT + (size_t)m * 4); const f32x4 gt = *(const f32x4*)(GATE + (size_t)m * 4);
            RowV f;
#pragma unroll
            for (int j = 0; j < 4; ++j) f.v[j] = (f32x4){0.f, 0.f, 0.f, 0.f};
#pragma unroll
            for (int k = 0; k < 4; ++k) { const RowV y = ldrow_bf16(YS + (size_t)sl[k] * DM, lane);
#pragma unroll
                for (int j = 0; j < 4; ++j) f.v[j] += y.v[j] * gt[k]; }
#pragma unroll
            for (int j = 0; j < 4; ++j) x.v[j] = x.v[j] * DN_ALPHA + g2.v[j] * f.v[j];
        } else {
#pragma unroll
            for (int j = 0; j < 4; ++j) x.v[j] = x.v[j] * DN_ALPHA; }
        x = ln_row(x, lg, lb);
        if (L < 3) { strow(X + (size_t)m * DM, lane, x); RowV h;
#pragma unroll
            for (int j = 0; j < 4; ++j) h.v[j] = x.v[j] * (1.f + sc.v[j]) + sh.v[j];
            strow_bf16(H + (size_t)m * DM, lane, h); }
        else strow(((float*)argp(N_IN)) + (size_t)m * DM, lane, x);
    }
}
__device__ __forceinline__ void gate_phase(Frame& F) { const int tid = otid(), lane = tid & 63; (void)tid; (void)lane;
    constexpr int WP = 136, VP = 136;
    LAS bf16* WL = (LAS bf16*)(F.lds);
    LAS bf16* VT = (LAS bf16*)(F.lds + 128 * WP * 2);
    LAS float* STAT = (LAS float*)(F.lds + 128 * WP * 2 + 256 * VP * 2);
    const bf16* GU = (const bf16*)(F.ws + WS_GU); const bf16* GV = (const bf16*)(F.ws + WS_GV); bf16* GG = (bf16*)(F.ws + WS_GG);
    const float* ws_ = argp(I_GMWS); const float* bs_ = argp(I_GMBS); const float* vg = argp(I_GMVG); const float* vb = argp(I_GMVB);
    const int r32 = lane & 31, hi = lane >> 5;
    for (int uid = F.bx; uid < 2 * (T / 128); uid += F.G) {
        const int t0 = (uid >> 1) * 128, hf = uid & 1;
        for (int rr = 0; rr < 16; ++rr) { const int q = 16 * F.wave + rr; const v4u* src = (const v4u*)(GV + (size_t)(t0 + q) * GM_HALF) + lane;
            float x[32]; float s = 0.f;
#pragma unroll
            for (int j = 0; j < 4; ++j) { const v4u w = src[64 * j];
#pragma unroll
                for (int i = 0; i < 4; ++i) { x[8 * j + 2 * i] = bf_lo(w[i]); x[8 * j + 2 * i + 1] = bf_hi(w[i]); s += x[8 * j + 2 * i] + x[8 * j + 2 * i + 1]; } }
            const float mean = wave_sum(s) * (1.f / GM_HALF); float s2 = 0.f;
#pragma unroll
            for (int i = 0; i < 32; ++i) { const float d = x[i] - mean; s2 += d * d; }
            const float rstd = 1.f / sqrtf(wave_sum(s2) * (1.f / GM_HALF) + LN_EPS);
            if (lane == 0) { STAT[2 * q] = mean; STAT[2 * q + 1] = rstd; } }
        __syncthreads();
        for (int hh = 0; hh < 4; ++hh) { const int h = 4 * hf + hh;
            { const int p = tid >> 2, q0 = (tid & 3) * 32; const f32x4* src = (const f32x4*)(ws_ + ((size_t)h * 128 + p) * 128 + q0);
#pragma unroll
                for (int i = 0; i < 4; ++i) { const f32x4 a = src[2 * i], b = src[2 * i + 1]; v4u w; w.x = pk2(a[0], a[1]); w.y = pk2(a[2], a[3]); w.z = pk2(b[0], b[1]); w.w = pk2(b[2], b[3]);
                    *(LAS v4u*)(WL + p * WP + q0 + 8 * i) = w; } }
            { const int q = (F.wave & 1) * 64 + lane; const float mean = STAT[2 * q], rstd = STAT[2 * q + 1];
#pragma unroll
                for (int j = 0; j < 8; ++j) { const int c0 = ((F.wave >> 1) * 8 + j) * 8; const v4u w = *(const v4u*)(GV + (size_t)(t0 + q) * GM_HALF + h * 256 + c0);
                    const f32x4 g0 = *(const f32x4*)(vg + h * 256 + c0), g1 = *(const f32x4*)(vg + h * 256 + c0 + 4), b0 = *(const f32x4*)(vb + h * 256 + c0), b1 = *(const f32x4*)(vb + h * 256 + c0 + 4);
                    float x[8];
#pragma unroll
                    for (int i = 0; i < 4; ++i) { x[2 * i] = bf_lo(w[i]); x[2 * i + 1] = bf_hi(w[i]); }
#pragma unroll
                    for (int i = 0; i < 8; ++i) { const float gg = i < 4 ? g0[i & 3] : g1[i & 3], bb = i < 4 ? b0[i & 3] : b1[i & 3];
                        VT[(c0 + i) * VP + q] = (bf16)f2bf((x[i] - mean) * rstd * gg + bb); } } }
            __syncthreads();
            { const int wm = F.wave >> 2, wn = F.wave & 3; f32x16 acc[2][2];
#pragma unroll
                for (int i = 0; i < 2; ++i)
#pragma unroll
                    for (int jn = 0; jn < 2; ++jn) acc[i][jn] = f32x16{};
#pragma unroll
                for (int ks = 0; ks < 8; ++ks) { bf16x8 a[2], b[2];
#pragma unroll
                    for (int i = 0; i < 2; ++i) { a[i] = *(const LAS bf16x8*)(WL + (64 * wm + 32 * i + r32) * WP + 16 * ks + 8 * hi); b[i] = *(const LAS bf16x8*)(VT + (64 * wn + 32 * i + r32) * VP + 16 * ks + 8 * hi); }
#pragma unroll
                    for (int i = 0; i < 2; ++i)
#pragma unroll
                        for (int jn = 0; jn < 2; ++jn) acc[i][jn] = __builtin_amdgcn_mfma_f32_32x32x16_bf16(a[i], b[jn], acc[i][jn], 0, 0, 0); }
#pragma unroll
                for (int i = 0; i < 2; ++i)
#pragma unroll
                    for (int r = 0; r < 16; ++r) { const int p = 64 * wm + 32 * i + (r & 3) + 8 * (r >> 2) + 4 * hi; const float bias = bs_[h * 128 + p];
#pragma unroll
                        for (int jn = 0; jn < 2; ++jn) { const size_t off = (size_t)(t0 + p) * GM_HALF + h * 256 + 64 * wn + 32 * jn + r32;
                            const float uu = __builtin_bit_cast(float, (unsigned)GU[off] << 16); GG[off] = (bf16)f2bf(uu * (acc[i][jn][r] + bias)); } } }
            __syncthreads();
        }
    }
}

template <int MODE> __device__ __forceinline__ void attn_phase(Frame& F, char* lds_generic) {
    using abf = attn_body::bf16;
    const abf* Q = (const abf*)(F.ws + WS_Q); const abf* K = (const abf*)(F.ws + WS_K); const abf* V = (const abf*)(F.ws + WS_V); abf* O = (abf*)(F.ws + WS_Q);
    constexpr int U = 1024; const int per = (U + F.G - 1) / F.G;
    for (int i = 0; i <= per; ++i) {
        int h, kvh, q0, NT, kbase; float sink = 0.f;
        if (i < per) { const int id = F.vcu * per + i; if (id >= U) continue; const int x = id >> 7, r = id & 127; const int qb = (r >> 2) * 2 + (r & 1);
            q0 = 256 * qb;
            if (MODE == 0) { kvh = x >> 1; h = kvh * 4 + (x & 1) * 2 + ((r & 3) >> 1); NT = T / 64; kbase = 0; }
            else { h = 2 * x + ((r & 3) >> 1); kvh = h >> 3; const int ks = q0 >= 128 ? q0 - 128 : 0, ke = (q0 + 384) < NLAT ? (q0 + 384) : NLAT; kbase = ks; NT = 4 + (ke - ks) / 64; sink = argp(I_WASK)[h] * LOG2E; } }
        else { if (MODE != 0) continue; if ((F.vcu & 15) != 0 || (F.vcu >> 4) >= 16) continue; h = F.vcu >> 4; kvh = h >> 2; q0 = NLAT; NT = 4; kbase = NLAT; }
        attn_body::attn_unit<MODE, (MODE == 0 ? 256 : 128), 8>(h, kvh, q0, NT, kbase, sink, Q, K, V, O, lds_generic);
    }
}
struct Args { const float* in[N_IN]; float* out; unsigned char* ws; int ph_lo, ph_hi; };
static_assert(sizeof(Args) == N_IN * 8 + 8 + 8 + 8, "Args has no padding");

template <int ACT> __device__ __forceinline__ void tok_gemm(Frame& F, const bf16* A, const bf16* Bt, int N, int K, const pg8::EpiBf16<ACT>& E) {
    pg8::Gemm g{A, Bt, K, K, K, (unsigned)(128 * K * 2), (unsigned)(128 * K * 2)};
    TokOrder S; S.init(NPAN, N / 256, F.G, F.bx); S.apan = (size_t)256 * K * 2; S.bpan = (size_t)256 * K * 2;
    pg8::gemm_phase<pg8::EpiBf16<ACT>, TokOrder, true, true>(F.lds + RING_OFF, g, S, E);
}
template <int L> __device__ __forceinline__ void moe_up(Frame& F) {
    moe_tables(F);
    pg8::Gemm g{(const bf16*)(F.ws + WS_XS), (const bf16*)(F.ws + WS_WEXP_GU) + (size_t)L * 32 * 2048 * 1024, 1024, 1024, 1024, 128 * 1024 * 2, 128 * 1024 * 2};
    MoeOrder S; S.init((int)F.MISC[MW_NMT], 8, F.G, F.bx); S.mte = F.MISC + MW_MTE; S.bexp = (size_t)2048 * 1024 * 2;
    EpiSwiGLU E{(bf16*)(F.ws + WS_ACT), argp(I_EBGU) + (size_t)L * 32 * 2048};
    pg8::gemm_phase<EpiSwiGLU, MoeOrder, true, true>(F.lds + RING_OFF, g, S, E);
}
template <int L> __device__ __forceinline__ void moe_down(Frame& F) {
    moe_tables(F);
    pg8::Gemm g{(const bf16*)(F.ws + WS_ACT), (const bf16*)(F.ws + WS_WEXP_DN) + (size_t)L * 32 * 1024 * 1024, 1024, 1024, 1024, 128 * 1024 * 2, 128 * 1024 * 2};
    MoeOrder S; S.init((int)F.MISC[MW_NMT], 4, F.G, F.bx); S.mte = F.MISC + MW_MTE; S.bexp = (size_t)1024 * 1024 * 2;
    EpiDown E{(bf16*)(F.ws + WS_YS), argp(I_EBD) + (size_t)L * 32 * 1024};
    pg8::gemm_phase<EpiDown, MoeOrder, true, true>(F.lds + RING_OFF, g, S, E);
}

__global__ void __launch_bounds__(NTHR, 2) mk_fwd(Args args) {
    extern __shared__ __attribute__((aligned(16))) unsigned char lds[];
    Frame F;
    F.lds = (LAS unsigned char*)lds;
    F.MISC = (volatile LAS unsigned*)(F.lds + MISC_OFF);
    F.wave = __builtin_amdgcn_readfirstlane((int)threadIdx.x >> 6);
    F.G = gridDim.x; F.bx = blockIdx.x; F.vcu = (F.G % 8 == 0) ? (F.bx % 8) * (F.G / 8) + F.bx / 8 : F.bx;
    F.ws = args.ws; F.ctl = (gu32*)(args.ws + WS_CTL);
    for (int u = threadIdx.x; u < (LDS_BYTES - MISC_OFF) / 4; u += NTHR) ((LAS unsigned*)(F.lds + MISC_OFF))[u] = 0u;
    __syncthreads();
    XcdBarrier bar; bar.bar = (unsigned*)(F.ctl + CW_BAR); bar.x = 0; bar.st = nullptr;
    if (!MK_PER_PHASE) bar = xcd_barrier_post((unsigned*)(F.ctl + CW_BAR), F.MISC + MW_BAR);
    const int lo = args.ph_lo, hi = args.ph_hi;
#ifdef MK_ONLY
#define IN(k) ((k) == MK_ONLY && lo <= (k))
#else
#define IN(k) (lo <= (k) && (k) < hi)
#endif
#define SEAM(k) do { if (IN(k) && IN((k) + 1)) xcd_barrier(bar); } while (0)
    const bf16* Hb = (const bf16*)(F.ws + WS_H); bf16* Yb = (bf16*)(F.ws + WS_Y);

    if (IN(0)) { asm volatile("; MK_PHASE_0" ::: "memory"); p0_prologue(F); } SEAM(0);
    if (IN(1)) { asm volatile("; MK_PHASE_1" ::: "memory"); pass_init(F); } SEAM(1);
    if (IN(2)) { asm volatile("; MK_PHASE_2" ::: "memory"); if ((EN_MIX >> 0) & 1) {
        { pg8::Gemm g{(const bf16*)(F.ws + TB_FC), Hb, 256, 256, 128 * DM, 128 * 256 * 2, DM * 2};
          ChDftOrder S; S.init(2, 256, F.G, F.bx); EpiChDft E{(bf16*)(F.ws + WS_BTA)};
          pg8::gemm_phase<EpiChDft, ChDftOrder, true, true>(F.lds + RING_OFF, g, S, E); }
#ifndef NO_CTX_DFT
        { pg8::Gemm g{(const bf16*)(F.ws + TB_FC), Hb, 256, 256, DM, 128 * 256 * 2, 128 * DM * 2};
          ChDftCtxOrder S; S.init(2, 4, F.G, F.bx); EpiChDftCtx E{(bf16*)(F.ws + WS_BTX)};
          pg8::gemm_phase<EpiChDftCtx, ChDftCtxOrder, true, true>(F.lds + RING_OFF, g, S, E); }
#endif
        } } SEAM(2);
    if (IN(3)) { asm volatile("; MK_PHASE_3" ::: "memory"); if ((EN_MIX >> 0) & 1) {
        { pg8::Gemm g{(const bf16*)(F.ws + TB_FA), (const bf16*)(F.ws + WS_BTA), 256, 256, 256, 128 * 256 * 2, 128 * 256 * 2};
          TokOrder S; S.init(1, 512, F.G, F.bx); S.apan = 0; S.bpan = (size_t)256 * 256 * 2;
          EpiStepA E{(bf16*)(F.ws + WS_BTC), (const float*)(F.ws + TB_TWC), (const float*)(F.ws + TB_TWS)};
          pg8::gemm_phase<EpiStepA, TokOrder, true, true>(F.lds + RING_OFF, g, S, E); }
        } } SEAM(3);
    if (IN(4)) { asm volatile("; MK_PHASE_4" ::: "memory"); if ((EN_MIX >> 0) & 1) {
        { pg8::Gemm g{(const bf16*)(F.ws + TB_FCC), (const bf16*)(F.ws + WS_BTC), 256, 256, 256, 128 * 256 * 2, 128 * 256 * 2};
        TokOrder S; S.init(1, 512, F.G, F.bx); S.apan = 0; S.bpan = (size_t)256 * 256 * 2;
        EpiStepC E{(bf16*)(F.ws + WS_MIXB)};
        pg8::gemm_phase<EpiStepC, TokOrder, true, true>(F.lds + RING_OFF, g, S, E); }
#ifndef NO_CTX_DFT
        { pg8::Gemm g{(const bf16*)(F.ws + TB_FX), (const bf16*)(F.ws + WS_BTX), 512, 512, 512, 128 * 512 * 2, 128 * 512 * 2};
          TokOrder S; S.init(1, 4, F.G, F.bx); S.apan = 0; S.bpan = (size_t)256 * 512 * 2;
          EpiCtxPos E{(bf16*)(F.ws + WS_MIXB)};
          pg8::gemm_phase<EpiCtxPos, TokOrder, true, true>(F.lds + RING_OFF, g, S, E); }
#endif
        } } SEAM(4);
    if (IN(5)) { asm volatile("; MK_PHASE_5" ::: "memory"); if ((EN_MIX >> 0) & 1) { pg8::EpiBf16<0> E{Yb, DM, argp(I_FNB), 0, 0, 1.f}; tok_gemm<0>(F, (const bf16*)(F.ws + WS_MIXB), (const bf16*)(F.ws + WS_WFN), DM, DM, E); } } SEAM(5);
    if (IN(6)) { asm volatile("; MK_PHASE_6" ::: "memory"); pass_mix<0>(F); } SEAM(6);
    if (IN(7)) { asm volatile("; MK_PHASE_7" ::: "memory"); if ((EN_MOE >> 0) & 1) moe_gather(F, true); } SEAM(7);
    if (IN(8)) { asm volatile("; MK_PHASE_8" ::: "memory"); if ((EN_MOE >> 0) & 1) moe_up<0>(F); } SEAM(8);
    if (IN(9)) { asm volatile("; MK_PHASE_9" ::: "memory"); if ((EN_MOE >> 0) & 1) moe_down<0>(F); } SEAM(9);
    if (IN(10)) { asm volatile("; MK_PHASE_10" ::: "memory"); pass_comb<0>(F); } SEAM(10);
    if (IN(11)) { asm volatile("; MK_PHASE_11" ::: "memory"); if ((EN_MIX >> 1) & 1) {
        pg8::Gemm g{Hb, (const bf16*)(F.ws + WS_WFAQ), DM, DM, DM, 128 * DM * 2, 128 * DM * 2};
        TokOrder S; S.init(NPAN, FA_NQKV / 256, F.G, F.bx); S.apan = (size_t)256 * DM * 2; S.bpan = (size_t)256 * DM * 2;
        EpiQKV<4, true> E{(bf16*)(F.ws + WS_Q), (bf16*)(F.ws + WS_K), (bf16*)(F.ws + WS_V), argp(I_FABQ), argp(I_FAQN), argp(I_FAKN), (const float*)(F.ws + TB_ROPC), (const float*)(F.ws + TB_ROPS)};
        pg8::gemm_phase<EpiQKV<4, true>, TokOrder, true, true>(F.lds + RING_OFF, g, S, E); } } SEAM(11);
    if (IN(12)) { asm volatile("; MK_PHASE_12" ::: "memory"); if ((EN_MIX >> 1) & 1) attn_phase<0>(F, (char*)lds + RING_OFF); } SEAM(12);
    if (IN(13)) { asm volatile("; MK_PHASE_13" ::: "memory"); if ((EN_MIX >> 1) & 1) { pg8::EpiBf16<0> E{Yb, DM, argp(I_FABO), 0, 0, 1.f}; tok_gemm<0>(F, (const bf16*)(F.ws + WS_Q), (const bf16*)(F.ws + WS_WFAO), DM, DM, E); } } SEAM(13);
    if (IN(14)) { asm volatile("; MK_PHASE_14" ::: "memory"); pass_mix<1>(F); } SEAM(14);
    if (IN(15)) { asm volatile("; MK_PHASE_15" ::: "memory"); if ((EN_MOE >> 1) & 1) moe_gather(F, true); } SEAM(15);
    if (IN(16)) { asm volatile("; MK_PHASE_16" ::: "memory"); if ((EN_MOE >> 1) & 1) moe_up<1>(F); } SEAM(16);
    if (IN(17)) { asm volatile("; MK_PHASE_17" ::: "memory"); if ((EN_MOE >> 1) & 1) moe_down<1>(F); } SEAM(17);
    if (IN(18)) { asm volatile("; MK_PHASE_18" ::: "memory"); pass_comb<1>(F); } SEAM(18);
    if (IN(19)) { asm volatile("; MK_PHASE_19" ::: "memory"); if ((EN_MIX >> 2) & 1) { pg8::EpiBf16<1> E{(bf16*)(F.ws + WS_GU), GM_HALF, argp(I_GMBI), GM_HALF, (size_t)(WS_GV - WS_GU) / 2, 1.f};
        tok_gemm<1>(F, Hb, (const bf16*)(F.ws + WS_WGI), GM_FF, DM, E); } } SEAM(19);
    if (IN(20)) { asm volatile("; MK_PHASE_20" ::: "memory"); if ((EN_MIX >> 2) & 1) gate_phase(F); } SEAM(20);
    if (IN(21)) { asm volatile("; MK_PHASE_21" ::: "memory"); if ((EN_MIX >> 2) & 1) { pg8::EpiBf16<0> E{Yb, DM, argp(I_GMBO), 0, 0, 1.f}; tok_gemm<0>(F, (const bf16*)(F.ws + WS_GG), (const bf16*)(F.ws + WS_WGO), DM, GM_HALF, E); } } SEAM(21);
    if (IN(22)) { asm volatile("; MK_PHASE_22" ::: "memory"); pass_mix<2>(F); } SEAM(22);
    if (IN(23)) { asm volatile("; MK_PHASE_23" ::: "memory"); if ((EN_MOE >> 2) & 1) moe_gather(F, true); } SEAM(23);
    if (IN(24)) { asm volatile("; MK_PHASE_24" ::: "memory"); if ((EN_MOE >> 2) & 1) moe_up<2>(F); } SEAM(24);
    if (IN(25)) { asm volatile("; MK_PHASE_25" ::: "memory"); if ((EN_MOE >> 2) & 1) moe_down<2>(F); } SEAM(25);
    if (IN(26)) { asm volatile("; MK_PHASE_26" ::: "memory"); pass_comb<2>(F); } SEAM(26);
    if (IN(27)) { asm volatile("; MK_PHASE_27" ::: "memory"); if ((EN_MIX >> 3) & 1) {
        pg8::Gemm g{Hb, (const bf16*)(F.ws + WS_WWQ), DM, DM, DM, 128 * DM * 2, 128 * DM * 2};
        TokOrder S; S.init(NPAN, WA_NQKV / 256, F.G, F.bx); S.apan = (size_t)256 * DM * 2; S.bpan = (size_t)256 * DM * 2;
        EpiQKV<2, false> E{(bf16*)(F.ws + WS_Q), (bf16*)(F.ws + WS_K), (bf16*)(F.ws + WS_V), argp(I_WABQ), nullptr, nullptr, (const float*)(F.ws + TB_ROPC), (const float*)(F.ws + TB_ROPS)};
        pg8::gemm_phase<EpiQKV<2, false>, TokOrder, true, true>(F.lds + RING_OFF, g, S, E); } } SEAM(27);
    if (IN(28)) { asm volatile("; MK_PHASE_28" ::: "memory"); if ((EN_MIX >> 3) & 1) attn_phase<1>(F, (char*)lds + RING_OFF); } SEAM(28);
    if (IN(29)) { asm volatile("; MK_PHASE_29" ::: "memory"); if ((EN_MIX >> 3) & 1) { pg8::EpiBf16<0> E{Yb, DM, argp(I_WABO), 0, 0, 1.f}; tok_gemm<0>(F, (const bf16*)(F.ws + WS_Q), (const bf16*)(F.ws + WS_WWO), DM, DM, E); } } SEAM(29);
    if (IN(30)) { asm volatile("; MK_PHASE_30" ::: "memory"); pass_mix<3>(F); } SEAM(30);
    if (IN(31)) { asm volatile("; MK_PHASE_31" ::: "memory"); if ((EN_MOE >> 3) & 1) moe_gather(F, false); } SEAM(31);
    if (IN(32)) { asm volatile("; MK_PHASE_32" ::: "memory"); if ((EN_MOE >> 3) & 1) moe_up<3>(F); } SEAM(32);
    if (IN(33)) { asm volatile("; MK_PHASE_33" ::: "memory"); if ((EN_MOE >> 3) & 1) moe_down<3>(F); } SEAM(33);
    if (IN(34)) { asm volatile("; MK_PHASE_34" ::: "memory"); pass_comb<3>(F); }
#undef IN
#undef SEAM
}

extern "C" void kernel_launch(void* const* d_in, const int* in_sizes, int n_in, void* d_out, int out_size, void* d_ws, size_t ws_size, hipStream_t stream) {
    static int grid = 0;
    if (grid == 0) {
        if (n_in != N_IN || in_sizes[0] != NLAT * DM || out_size != NLAT * DM || ws_size < WS_END) { fprintf(stderr, "kernel_launch: unexpected shapes (n_in %d, in0 %d, out %d, ws %zu)\n", n_in, n_in > 0 ? in_sizes[0] : -1, out_size, ws_size); grid = -1; return; }
        int dev = 0, cus = 0, per_cu = 0;
        if (hipGetDevice(&dev) != hipSuccess || hipDeviceGetAttribute(&cus, hipDeviceAttributeMultiprocessorCount, dev) != hipSuccess) { grid = -1; return; }
        if (hipFuncSetAttribute((const void*)mk_fwd, hipFuncAttributeMaxDynamicSharedMemorySize, LDS_BYTES) != hipSuccess) { fprintf(stderr, "kernel_launch: hipFuncSetAttribute failed\n"); grid = -1; return; }
        if (hipOccupancyMaxActiveBlocksPerMultiprocessor(&per_cu, (const void*)mk_fwd, NTHR, LDS_BYTES) != hipSuccess || per_cu < 1) fprintf(stderr, "kernel_launch: occupancy query says %d\n", per_cu);
        (void)hipGetLastError();
        grid = cus;
    }
    if (grid < 0) return;
    if (hipMemsetAsync((char*)d_ws + WS_CTL, 0, CTL_ZERO_BYTES, stream) != hipSuccess) return;
    Args a{};
    for (int i = 0; i < N_IN; ++i) a.in[i] = (const float*)d_in[i];
    a.out = (float*)d_out; a.ws = (unsigned char*)d_ws;
#if MK_PER_PHASE
    for (int p = 0; p < NPHASE; ++p) { a.ph_lo = p; a.ph_hi = p + 1; hipLaunchKernelGGL(mk_fwd, dim3(grid), dim3(NTHR), LDS_BYTES, stream, a); }
#else
    a.ph_lo = 0; a.ph_hi = NPHASE; hipLaunchKernelGGL(mk_fwd, dim3(grid), dim3(NTHR), LDS_BYTES, stream, a);
#endif
}
```

```cpp
#define MK_PER_PHASE 0
#define EN_MIX 15
#define EN_MOE 15
#include <hip/hip_runtime.h>
#include <hip/hip_bf16.h>
#include <cstdio>
#include <cstdint>
#include <cmath>
#ifndef MK_PER_PHASE
#define MK_PER_PHASE 0
#endif
namespace pg8 {
#define PG8_LAS __attribute__((address_space(3)))
typedef unsigned short bf16_t;
typedef short bf16x8 __attribute__((ext_vector_type(8)));
typedef float f32x4 __attribute__((ext_vector_type(4)));
typedef float f32x2 __attribute__((ext_vector_type(2)));
typedef unsigned u32x4 __attribute__((ext_vector_type(4)));
typedef unsigned u32x2 __attribute__((ext_vector_type(2)));
constexpr int BM = 256, BK = 64, HALF = 128, HTB = HALF * BK * 2  , STAGE_BYTES = 8 * HTB, NXCD = 8, WGM = 8;

__host__ __device__ __forceinline__ int lds_byte(int r, int c) { const int st = (r >> 4) * 2 + (c >> 5), rr = r & 15, cc = c & 31, ob = rr * 64 + cc * 2; return st * 1024 + (ob ^ (((ob >> 9) & 1) << 5)); }
__host__ __device__ __forceinline__ void stage_rc(int b, int& R, int& C) { const int st = b / 1024, sb = b % 1024, swz = sb ^ (((sb >> 9) & 1) << 5); R = (st >> 1) * 16 + swz / 64; C = (st & 1) * 32 + (swz % 64) / 2; }
__host__ __device__ __forceinline__ int perm32(int rho) { const int n = rho >> 4, i = rho & 15; return 8 * (i >> 2) + 4 * n + (i & 3); }

struct Unit { int pm, pn, e; };
struct Gemm { const bf16_t* A; const bf16_t* Bt; int K, lda, ldb; unsigned hstepA, hstepB; };

struct GridOrder {
    int nM, nN, nwg, G, c;
    __device__ __forceinline__ void init(int nM_, int nN_, int G_, int c_) { nM = nM_; nN = nN_; nwg = nM * nN; G = G_; c = c_; }
    __device__ __forceinline__ bool next_mn(int i, int& pm, int& pn) const {
        const long L = (long)i * G + c; if (L >= nwg) return false;
        int wgid = (int)L; { const int q = nwg / NXCD, r = nwg % NXCD, xcd = wgid % NXCD, off = wgid / NXCD; wgid = (xcd < r ? xcd * (q + 1) : r * (q + 1) + (xcd - r) * q) + off; }
        const int nig = WGM * nN, gid = wgid / nig, fm = gid * WGM, gsz = (nM - fm) < WGM ? (nM - fm) : WGM;
        pm = fm + ((wgid % nig) % gsz); pn = (wgid % nig) / gsz; return true;
    }
};
__device__ __forceinline__ unsigned cvt_pk_bf16(float lo, float hi) { unsigned r; asm volatile("v_cvt_pk_bf16_f32 %0, %1, %2" : "=v"(r) : "v"(lo), "v"(hi)); return r; }
__device__ __forceinline__ f32x2 gelu_pk(f32x2 v) {
    const f32x2 av = __builtin_elementwise_abs(v), d = av * 0.2316418882f + 1.0f;
    f32x2 t; t.x = __builtin_amdgcn_rcpf(d.x); t.y = __builtin_amdgcn_rcpf(d.y);
    f32x2 q = t * 0.5307027145f + (-0.7265760135f); q = q * t + 0.7107068705f; q = q * t + (-0.142248368f); q = q * t + 0.127414796f; q = q * t;
    const f32x2 s = (v * v) * (-0.72134752044f);
    f32x2 e; e.x = __builtin_amdgcn_exp2f(s.x); e.y = __builtin_amdgcn_exp2f(s.y);
    const f32x2 m = v * (q * e), r = v - m;
    f32x2 o; o.x = v.x < 0.f ? m.x : r.x; o.y = v.y < 0.f ? m.y : r.y; return o;
}

template <int ACT  > struct EpiBf16 {
    static constexpr bool PERM = true, AFTER_DRAIN = false; static_assert(ACT == 0 || ACT == 1, "EpiBf16: ACT is 0 (none) or 1 (gelu_pk)");
    bf16_t* O; int ldc; const float* bias; int split_cols; size_t split_stride; float scale0;
    __device__ __forceinline__ void operator()(const f32x4 (&acc)[2][2][4][2], const Unit& u, int wr, int wc, int fr, int fq) const {
        const int row0 = u.pm * BM + wr * 64 + fr; int colt = u.pn * BM; bf16_t* base = O;
        float sc = 1.f; if (split_cols) { const int t = colt / split_cols; base += (size_t)t * split_stride; colt -= t * split_cols; if (t == 0) sc = scale0; }
        const int col0 = colt + wc * 32 + 8 * fq, bcol0 = u.pn * BM + wc * 32 + 8 * fq;
        f32x4 bv[2][2];
#pragma unroll
        for (int bj = 0; bj < 2; ++bj)
#pragma unroll
            for (int n = 0; n < 2; ++n) bv[bj][n] = bias ? *(const f32x4*)(bias + bcol0 + bj * HALF + 4 * n) : (f32x4){0.f, 0.f, 0.f, 0.f};
#pragma unroll
        for (int ai = 0; ai < 2; ++ai)
#pragma unroll
            for (int m = 0; m < 4; ++m) { bf16_t* rowp = base + (size_t)(row0 + ai * HALF + m * 16) * ldc + col0;
#pragma unroll
                for (int bj = 0; bj < 2; ++bj) { f32x4 v0 = acc[ai][bj][m][0] + bv[bj][0], v1 = acc[ai][bj][m][1] + bv[bj][1];
                    if (ACT == 1) { f32x2 a = gelu_pk((f32x2){v0[0], v0[1]}), b = gelu_pk((f32x2){v0[2], v0[3]}), c = gelu_pk((f32x2){v1[0], v1[1]}), d = gelu_pk((f32x2){v1[2], v1[3]});
                        v0 = (f32x4){a.x, a.y, b.x, b.y}; v1 = (f32x4){c.x, c.y, d.x, d.y}; }
                    v0 = v0 * sc; v1 = v1 * sc; u32x4 w; w.x = cvt_pk_bf16(v0[0], v0[1]); w.y = cvt_pk_bf16(v0[2], v0[3]); w.z = cvt_pk_bf16(v1[0], v1[1]); w.w = cvt_pk_bf16(v1[2], v1[3]);
                    *(u32x4*)(rowp + bj * HALF) = w; } }
    }
};
template <class Epi, class Sched, bool ALIGN_EPI = false, bool SP2 = false>
__device__ __forceinline__ void gemm_phase(PG8_LAS unsigned char* lds, const Gemm g, const Sched& S, const Epi& E) {
    int tid_ = threadIdx.x; asm volatile("" : "+v"(tid_));
    const int tid = tid_, wid = __builtin_amdgcn_readfirstlane(tid >> 6), lane = tid & 63, wr = wid >> 2, wc = wid & 3, fr = lane & 15, fq = lane >> 4;
    const int K = g.K, nt = K / BK;
    unsigned voffA[2], voffB[2];
#pragma unroll
    for (int i = 0; i < 2; ++i) { int R, C; stage_rc(tid * 16 + i * 8192, R, C); const int Rb = Epi::PERM ? ((R & ~31) + perm32(R & 31)) : R;
        voffA[i] = (unsigned)(R * g.lda + C) * 2u; voffB[i] = (unsigned)(Rb * g.ldb + C) * 2u; }
    const size_t kstep = (size_t)(BK * 2);
    const size_t hstepA = g.hstepA, hstepB = g.hstepB;
    const unsigned ldsw = (unsigned)wid * 1024u;
    const int aoff = lds_byte(wr * 64 + fr, fq * 8), boff = lds_byte(wc * 32 + fr, fq * 8);
#define PG8_SA(b, h) (((b) * 2 + (h)) * HTB)
#define PG8_SB(b, h) ((4 + (b) * 2 + (h)) * HTB)
#define PG8_STAGE(bufoff, gbase, voff) do { _Pragma("unroll") for (int _i = 0; _i < 2; ++_i) { unsigned _vo = (voff)[_i]; asm volatile("" : "+v"(_vo));     \
        __builtin_amdgcn_global_load_lds((const unsigned*)((const char*)(gbase) + _vo), (PG8_LAS unsigned*)(lds + (bufoff) + ldsw + _i * 8192), 16, 0, 0); } } while (0)
#define PG8_LDA(dst, b, h) do { _Pragma("unroll") for (int m = 0; m < 4; ++m) _Pragma("unroll") for (int k = 0; k < 2; ++k) dst[m][k] = *(const PG8_LAS bf16x8*)(lds + PG8_SA(b, h) + aoff + m * 2048 + k * 1024); } while (0)
#define PG8_LDB(dst, b, h) do { _Pragma("unroll") for (int n = 0; n < 2; ++n) _Pragma("unroll") for (int k = 0; k < 2; ++k) dst[n][k] = *(const PG8_LAS bf16x8*)(lds + PG8_SB(b, h) + boff + n * 2048 + k * 1024); } while (0)
#define PG8_MMA(ai, bj, At, Bt) do { __builtin_amdgcn_s_setprio(1); _Pragma("unroll") for (int m = 0; m < 4; ++m) _Pragma("unroll") for (int n = 0; n < 2; ++n) _Pragma("unroll") for (int k = 0; k < 2; ++k) \
        acc[ai][bj][m][n] = __builtin_amdgcn_mfma_f32_16x16x32_bf16(Bt[n][k], At[m][k], acc[ai][bj][m][n], 0, 0, 0); __builtin_amdgcn_s_setprio(0); } while (0)
#define PG8_WAIT_V(n) asm volatile("s_waitcnt vmcnt(" #n ")" ::: "memory")
#define PG8_WAIT_L(n) asm volatile("s_waitcnt lgkmcnt(" #n ")" ::: "memory")
#define PG8_BAR __builtin_amdgcn_s_barrier()
#define PG8_SCHED __builtin_amdgcn_sched_barrier(0)
    Unit cur, nxt; int ui = 0;
    if (!S.next(0, cur)) return;
    f32x4 acc[2][2][4][2];
#pragma unroll
    for (int a = 0; a < 2; ++a)
#pragma unroll
        for (int b = 0; b < 2; ++b)
#pragma unroll
            for (int m = 0; m < 4; ++m)
#pragma unroll
                for (int n = 0; n < 2; ++n) acc[a][b][m][n] = (f32x4){0.f, 0.f, 0.f, 0.f};
    bf16x8 At[4][2], B0[2][2], B1[2][2];
    const char* cA = (const char*)g.A + S.offA(cur); const char* cB = (const char*)g.Bt + S.offB(cur);
    S.a_ready(cur);
    if constexpr (SP2) {
        PG8_STAGE(PG8_SB(0, 0), cB, voffB); PG8_STAGE(PG8_SB(0, 1), cB + hstepB, voffB); PG8_STAGE(PG8_SA(0, 0), cA, voffA); PG8_STAGE(PG8_SA(0, 1), cA + hstepA, voffA);
        if (wr == 1) PG8_BAR;
        PG8_WAIT_V(2); PG8_BAR;
        PG8_STAGE(PG8_SB(1, 0), cB + kstep, voffB); PG8_STAGE(PG8_SA(1, 0), cA + kstep, voffA); PG8_STAGE(PG8_SB(1, 1), cB + hstepB + kstep, voffB);
        PG8_WAIT_V(6); PG8_BAR;
    } else {
        PG8_STAGE(PG8_SB(0, 0), cB, voffB); PG8_STAGE(PG8_SA(0, 0), cA, voffA); PG8_STAGE(PG8_SB(0, 1), cB + hstepB, voffB); PG8_STAGE(PG8_SA(0, 1), cA + hstepA, voffA);
        if (wr == 1) PG8_BAR;
        PG8_WAIT_V(4); PG8_BAR;
        PG8_STAGE(PG8_SB(1, 0), cB + kstep, voffB); PG8_STAGE(PG8_SA(1, 0), cA + kstep, voffA); PG8_STAGE(PG8_SB(1, 1), cB + hstepB + kstep, voffB);
        PG8_WAIT_V(6); PG8_BAR;
    }
    for (;;) {
        const bool has_next = S.next(ui + 1, nxt);
        const char* nA = has_next ? (const char*)g.A + S.offA(nxt) : cA; const char* nB = has_next ? (const char*)g.Bt + S.offB(nxt) : cB;
        for (int t = 0; t < nt; t += 2) {
            const bool last = (t == nt - 2);
            const char* a1 = cA + (size_t)(t + 1) * kstep;
            const char* a2 = last ? nA : cA + (size_t)(t + 2) * kstep; const char* b2 = last ? nB : cB + (size_t)(t + 2) * kstep;
            const char* a3 = a2 + kstep; const char* b3 = b2 + kstep;
            if (last && has_next) S.a_ready(nxt);
            if constexpr (SP2) {
            PG8_LDB(B0, 0, 0); PG8_LDB(B1, 0, 1); PG8_SCHED; PG8_LDA(At, 0, 0); PG8_STAGE(PG8_SA(1, 1), a1 + hstepA, voffA);
            PG8_WAIT_V(8); PG8_WAIT_L(0); PG8_BAR; PG8_MMA(0, 0, At, B0); PG8_MMA(0, 1, At, B1); PG8_BAR; PG8_SCHED;
            PG8_LDA(At, 0, 1); PG8_STAGE(PG8_SB(0, 0), b2, voffB); PG8_STAGE(PG8_SB(0, 1), b2 + hstepB, voffB); PG8_STAGE(PG8_SA(0, 0), a2, voffA);
            PG8_WAIT_V(8); PG8_WAIT_L(0); PG8_BAR; PG8_MMA(1, 0, At, B0); PG8_MMA(1, 1, At, B1); PG8_BAR; PG8_SCHED;
            PG8_LDB(B0, 1, 0); PG8_LDB(B1, 1, 1); PG8_SCHED; PG8_LDA(At, 1, 0); PG8_STAGE(PG8_SA(0, 1), a2 + hstepA, voffA);
            PG8_WAIT_V(8); PG8_WAIT_L(0); PG8_BAR; PG8_MMA(0, 0, At, B0); PG8_MMA(0, 1, At, B1); PG8_BAR; PG8_SCHED;
            PG8_LDA(At, 1, 1); PG8_STAGE(PG8_SB(1, 0), b3, voffB); PG8_STAGE(PG8_SB(1, 1), b3 + hstepB, voffB); PG8_STAGE(PG8_SA(1, 0), a3, voffA);
            PG8_WAIT_V(8); PG8_WAIT_L(0); PG8_BAR; PG8_MMA(1, 0, At, B0); PG8_MMA(1, 1, At, B1); PG8_BAR; PG8_SCHED;
            } else {
            PG8_LDB(B0, 0, 0); PG8_SCHED; PG8_LDA(At, 0, 0); PG8_STAGE(PG8_SA(1, 1), a1 + hstepA, voffA);
            PG8_WAIT_L(8); PG8_BAR; PG8_WAIT_L(0); PG8_MMA(0, 0, At, B0); PG8_BAR; PG8_SCHED;
            PG8_LDB(B1, 0, 1); PG8_STAGE(PG8_SB(0, 0), b2, voffB);
            PG8_BAR; PG8_WAIT_L(0); PG8_MMA(0, 1, At, B1); PG8_BAR;
            PG8_LDA(At, 0, 1); PG8_STAGE(PG8_SA(0, 0), a2, voffA);
            PG8_BAR; PG8_WAIT_L(0); PG8_MMA(1, 0, At, B0); PG8_BAR; PG8_SCHED;
            PG8_STAGE(PG8_SB(0, 1), b2 + hstepB, voffB);
            PG8_WAIT_V(6); PG8_BAR; PG8_MMA(1, 1, At, B1); PG8_BAR;
            PG8_LDB(B0, 1, 0); PG8_SCHED; PG8_LDA(At, 1, 0); PG8_STAGE(PG8_SA(0, 1), a2 + hstepA, voffA);
            PG8_WAIT_L(8); PG8_BAR; PG8_WAIT_L(0); PG8_MMA(0, 0, At, B0); PG8_BAR; PG8_SCHED;
            PG8_LDB(B1, 1, 1); PG8_STAGE(PG8_SB(1, 0), b3, voffB);
            PG8_BAR; PG8_WAIT_L(0); PG8_MMA(0, 1, At, B1); PG8_BAR;
            PG8_LDA(At, 1, 1); PG8_STAGE(PG8_SA(1, 0), a3, voffA);
            PG8_BAR; PG8_WAIT_L(0); PG8_MMA(1, 0, At, B0); PG8_BAR; PG8_SCHED;
            PG8_STAGE(PG8_SB(1, 1), b3 + hstepB, voffB);
            PG8_WAIT_V(6); PG8_BAR; PG8_MMA(1, 1, At, B1); PG8_BAR;
            }
        }
        if constexpr (ALIGN_EPI) { if (wr == 0) PG8_BAR; }
        if constexpr (!Epi::AFTER_DRAIN) { E(acc, cur, wr, wc, fr, fq); S.done(cur); }
        if (!has_next) break;
#pragma unroll
        for (int a = 0; a < 2; ++a)
#pragma unroll
            for (int b = 0; b < 2; ++b)
#pragma unroll
                for (int m = 0; m < 4; ++m)
#pragma unroll
                    for (int n = 0; n < 2; ++n) acc[a][b][m][n] = (f32x4){0.f, 0.f, 0.f, 0.f};
        cur = nxt; cA = nA; cB = nB; ++ui;
        if constexpr (ALIGN_EPI) { if (wr == 1) PG8_BAR; }
    }
    PG8_WAIT_V(0);
    if constexpr (!ALIGN_EPI) { if (wr == 0) PG8_BAR; }
    PG8_BAR;
    if constexpr (Epi::AFTER_DRAIN) { E.fused(acc, cur, wr, wc, fr, fq, lds, wid, lane); S.done(cur); }
#undef PG8_SA
#undef PG8_SB
#undef PG8_STAGE
#undef PG8_LDA
#undef PG8_LDB
#undef PG8_MMA
#undef PG8_WAIT_V
#undef PG8_WAIT_L
#undef PG8_BAR
#undef PG8_SCHED
}
}
namespace attn_body {
using bf16=__hip_bfloat16;
using bf16x8=__attribute__((ext_vector_type(8)))short;
using s16x4=__attribute__((ext_vector_type(4)))short;
using f32x16=__attribute__((ext_vector_type(16)))float;
using u32x4=__attribute__((ext_vector_type(4)))unsigned;
constexpr int D=64,QP=1024;
constexpr int NW=8,QBLK=32,QB=QBLK*NW,KVBLK=64;
__device__ __forceinline__ void wmask(f32x16&p0,f32x16&p1,int t,int kstart,int qabs,int hi){
  if(t<4)return; const float NEG=-INFINITY; const int kb=kstart+64*(t-4)+4*hi-qabs;
  #pragma unroll
  for(int r=0;r<16;++r){const int dk=kb+(r&3)+8*(r>>2); if(dk>128||dk<-128)p0[r]=NEG; if(dk+32>128||dk+32<-128)p1[r]=NEG;}
}
__device__ __forceinline__ int crow(int r,int hi){return (r&3)+8*(r>>2)+4*hi;}
#define SBAR() __builtin_amdgcn_sched_barrier(0)
__device__ __forceinline__ void cmask(f32x16&p0,f32x16&p1,int jb,int qrel,int hi){
  const float NEG=-INFINITY; int kb=64*jb+4*hi;
  #pragma unroll
  for(int r=0;r<16;++r){int kv=kb+(r&3)+8*(r>>2); if(kv>qrel)p0[r]=NEG; if(kv+32>qrel)p1[r]=NEG;}
}

constexpr int NSLOT=3, SLOTB=8192;
constexpr int LDS_K=0, LDS_V=NSLOT*SLOTB, LDS_WS=2*NSLOT*SLOTB, LDS_OST=LDS_WS+NW*64*4, LDS_BYTES=LDS_OST+NW*4096;
constexpr float C2=0.125f*1.4426950408889634f;
__device__ __forceinline__ void glds16(const void*gsrc,unsigned lds_dst){unsigned keep;
  asm volatile("s_mov_b32 %0, m0\n\ts_mov_b32 m0, %2\n\ts_nop 0\n\tglobal_load_lds_dwordx4 %1, off\n\ts_mov_b32 m0, %0":"=&s"(keep):"v"(gsrc),"s"(lds_dst):"memory");}
__device__ __forceinline__ float max3f(float a,float b,float c){float r;asm("v_max3_f32 %0, %1, %2, %3":"=v"(r):"v"(a),"v"(b),"v"(c));return r;}
__device__ __forceinline__ float max2f(float a,float b){float r;asm("v_max_f32_e32 %0, %1, %2":"=v"(r):"v"(a),"v"(b));return r;}
__device__ __forceinline__ float fadd_s(float a,float b){float r;asm("v_add_f32_e32 %0, %1, %2":"=v"(r):"v"(a),"v"(b));return r;}
__device__ __forceinline__ float fsub_s(float a,float b){float r;asm("v_sub_f32_e32 %0, %1, %2":"=v"(r):"v"(a),"v"(b));return r;}
typedef float f32x2_t __attribute__((ext_vector_type(2))); typedef __bf16 bf16x2_t __attribute__((ext_vector_type(2)));
__device__ __forceinline__ unsigned cvtpk_s(float lo,float hi){f32x2_t v={lo,hi};bf16x2_t b=__builtin_convertvector(v,bf16x2_t);return __builtin_bit_cast(unsigned,b);}
#define WAIT_BAR(N) asm volatile("s_waitcnt vmcnt(" #N ") lgkmcnt(0)\n\ts_barrier":::"memory")

__device__ __forceinline__ void qkt(f32x16&p0,f32x16&p1,const char*Kslot,const bf16x8*qr,const f32x16&negm,int r32,int hi){
  const char*kb=Kslot+hi*1024+r32*16;
  #pragma unroll
  for(int d0=0;d0<4;++d0){
    const bf16x8 b0=*reinterpret_cast<const bf16x8*>(kb+d0*2048);
    const bf16x8 b1=*reinterpret_cast<const bf16x8*>(kb+d0*2048+512);
    if(d0==0){p0=__builtin_amdgcn_mfma_f32_32x32x16_bf16(b0,qr[0],negm,0,0,0);p1=__builtin_amdgcn_mfma_f32_32x32x16_bf16(b1,qr[0],negm,0,0,0);}
    else{p0=__builtin_amdgcn_mfma_f32_32x32x16_bf16(b0,qr[d0],p0,0,0,0);p1=__builtin_amdgcn_mfma_f32_32x32x16_bf16(b1,qr[d0],p1,0,0,0);}}
}
typedef __attribute__((address_space(3))) const char* lds_cptr;
typedef short v4i16_t __attribute__((ext_vector_type(4)));
__device__ __forceinline__ void kload8(bf16x8*kf,lds_cptr kp){
  kf[0]=*(const __attribute__((address_space(3))) bf16x8*)(kp);      kf[1]=*(const __attribute__((address_space(3))) bf16x8*)(kp+512);
  kf[2]=*(const __attribute__((address_space(3))) bf16x8*)(kp+2048); kf[3]=*(const __attribute__((address_space(3))) bf16x8*)(kp+2560);
  kf[4]=*(const __attribute__((address_space(3))) bf16x8*)(kp+4096); kf[5]=*(const __attribute__((address_space(3))) bf16x8*)(kp+4608);
  kf[6]=*(const __attribute__((address_space(3))) bf16x8*)(kp+6144); kf[7]=*(const __attribute__((address_space(3))) bf16x8*)(kp+6656);
}
__device__ __forceinline__ void kload2(bf16x8*kf,lds_cptr kp,int j){ kf[2*j]=*(const __attribute__((address_space(3))) bf16x8*)(kp+j*2048); kf[2*j+1]=*(const __attribute__((address_space(3))) bf16x8*)(kp+j*2048+512); }
__device__ __forceinline__ s16x4 vtr(lds_cptr p){ return __builtin_bit_cast(s16x4,__builtin_amdgcn_ds_read_tr16_b64_v4i16((__attribute__((address_space(3))) v4i16_t*)p)); }
__device__ __forceinline__ float rowmax(const f32x16&p0,const f32x16&p1){
  float a=max3f(p0[0],p0[1],p1[0]),b=max3f(p0[2],p0[3],p1[1]);a=max3f(a,p1[2],p1[3]);
  #pragma unroll
  for(int r=4;r<16;r+=4){a=max3f(a,p0[r],p0[r+1]);b=max3f(b,p0[r+2],p0[r+3]);a=max3f(a,p1[r],p1[r+1]);b=max3f(b,p1[r+2],p1[r+3]);}
  const float m=max2f(a,b);
  auto rr=__builtin_amdgcn_permlane32_swap(__float_as_uint(m),__float_as_uint(m),false,false);
  return max2f(__uint_as_float(rr[0]),__uint_as_float(rr[1]));
}
__device__ __forceinline__ void pv(f32x16*o,int vb,bf16x8 pa0,bf16x8 pa1,bf16x8 pa2,bf16x8 pa3){
  #pragma unroll
  for(int d0=0;d0<2;++d0){s16x4 lo[4],hi[4];
    #pragma unroll
    for(int ks=0;ks<4;++ks){
      asm volatile("ds_read_b64_tr_b16 %0,%1 offset:%c2":"=&v"(lo[ks]):"v"(vb),"i"(d0*4096+ks*1024):"memory");
      asm volatile("ds_read_b64_tr_b16 %0,%1 offset:%c2":"=&v"(hi[ks]):"v"(vb),"i"(d0*4096+ks*1024+512):"memory");}
    asm volatile("s_waitcnt lgkmcnt(0)":::"memory");SBAR();
    #define PK(k) (bf16x8){lo[k][0],lo[k][1],lo[k][2],lo[k][3],hi[k][0],hi[k][1],hi[k][2],hi[k][3]}
    o[d0]=__builtin_amdgcn_mfma_f32_32x32x16_bf16(pa0,PK(0),o[d0],0,0,0);
    o[d0]=__builtin_amdgcn_mfma_f32_32x32x16_bf16(pa1,PK(1),o[d0],0,0,0);
    o[d0]=__builtin_amdgcn_mfma_f32_32x32x16_bf16(pa2,PK(2),o[d0],0,0,0);
    o[d0]=__builtin_amdgcn_mfma_f32_32x32x16_bf16(pa3,PK(3),o[d0],0,0,0);
    #undef PK
  }
}

#ifndef ATTN_STORE16
#define ATTN_STORE16(p,v) (*(u32x4*)(p)=(v))
#endif
template<int MODE,int KP,int THRL> __device__ __forceinline__ void attn_unit(int h,int kvh,int q0,int NT,int kbase,float sink_l2,const bf16*Q,const bf16*__restrict__ K,const bf16*__restrict__ V,bf16*O,char*shm){
  int tid_=threadIdx.x; asm volatile("":"+v"(tid_)); const int tid=tid_,lane=tid&63,r32=lane&31,hi=lane>>5; const int wid=__builtin_amdgcn_readfirstlane(tid>>6);
  #define TROW(t) (MODE==0 ? (kbase+64*(t)) : ((t)<4 ? 16384+64*(t) : kbase+64*((t)-4)))
  const bf16*Qw=Q+(long)(q0+wid*QBLK)*QP+h*D;
  const bf16*Kh=K+kvh*D,*Vh=V+kvh*D;
  const unsigned lds0=(unsigned)(uintptr_t)shm;
  float*wsf=(float*)(shm+LDS_WS)+wid*64;
  const bf16*ksrc=Kh+(long)lane*KP+wid*8;
  const bf16*vsrc=Vh+(long)(16*(wid&3)+(lane>>2))*KP+(wid>>2)*32+(lane&3)*8;
  const unsigned kdst=lds0+LDS_K+wid*1024, vdst=lds0+LDS_V+wid*1024;
  #define DMA_K(t,slot) glds16(ksrc+(long)TROW(t)*KP,(unsigned)__builtin_amdgcn_readfirstlane(kdst+(slot)))
  #define DMA_V(t,slot) glds16(vsrc+(long)TROW(t)*KP,(unsigned)__builtin_amdgcn_readfirstlane(vdst+(slot)))
  const int vb0=(int)(lds0+LDS_V)+((lane>>4)&1)*32+(lane&3)*8+(4*hi+((lane&15)>>2))*64;
  const char*Kbase=shm+LDS_K; bf16x8 kf[8];
  const lds_cptr shm3=(lds_cptr)shm; const lds_cptr kp0=shm3+LDS_K+hi*1024+r32*16; const lds_cptr vp0=shm3+LDS_V+((lane>>4)&1)*32+(lane&3)*8+(4*hi+((lane&15)>>2))*64;
  DMA_K(0,0);DMA_V(0,0);DMA_K(1,SLOTB);
  bf16x8 qr[4];
  #pragma unroll
  for(int d0=0;d0<4;++d0)qr[d0]=*reinterpret_cast<const bf16x8*>(&Qw[(long)r32*QP+d0*16+hi*8]);
  float mhat=0.f,l_reg=0.f;f32x16 o[2];o[0]=f32x16{};o[1]=f32x16{};f32x16 negm=f32x16{};asm volatile("":"+v"(negm));
  const int qabs=q0+wid*QBLK+r32;
  #define CMASK(P0,P1,t) do{ if(MODE==1) wmask(P0,P1,(t),kbase,qabs,hi); }while(0)
  bool resc=false;
  #define START(P0,P1) do{ const float rm=rowmax(P0,P1); resc=false; \
    { const float dl=rm; mhat=fadd_s(mhat,dl); \
      _Pragma("unroll") for(int r=0;r<16;++r){P0[r]=fsub_s(P0[r],dl);P1[r]=fsub_s(P1[r],dl);} \
      _Pragma("unroll") for(int r=0;r<16;++r)negm[r]=-mhat; asm volatile("":"+v"(negm)); } \
    _Pragma("unroll") for(int r=0;r<16;++r)P0[r]=__builtin_amdgcn_exp2f(P0[r]); }while(0)
  #define RESC() do{ if(resc){ asm volatile("s_waitcnt lgkmcnt(0)":::"memory"); \
      _Pragma("unroll") for(int d_=0;d_<2;++d_) _Pragma("unroll") for(int r=0;r<16;++r)o[d_][r]*=wsf[crow(r,hi)]; } }while(0)
  f32x16 pA0,pA1,pB0,pB1;
  int sl_prev=0,sl_cur=0,sl_next=SLOTB;
  #define ROT() do{sl_prev=sl_cur;sl_cur=sl_next;sl_next=(sl_next==(NSLOT-1)*SLOTB)?0:sl_next+SLOTB;}while(0)
  DMA_K(2,2*SLOTB);
  WAIT_BAR(3);
  qkt(pA0,pA1,Kbase,qr,negm,r32,hi);asm volatile("s_nop 15\n\ts_nop 7":"+v"(pA0),"+v"(pA1));CMASK(pA0,pA1,0);
  START(pA0,pA1);
  _Pragma("unroll") for(int r=0;r<16;++r)pA1[r]=__builtin_amdgcn_exp2f(pA1[r]);
  WAIT_BAR(0);
  DMA_K(3,0);DMA_V(1,SLOTB);
  ROT();
  kload8(kf,kp0+sl_cur);
  WAIT_BAR(2);
  s16x4 vlo[8],vhi[8]; u32x4 pw0,pw1,pw2,pw3;
  #define PKW(P,B) cvtpk_s(P[B],P[B+1])
  #define PAF(k) __builtin_bit_cast(bf16x8,pw##k)
  #define VFR(i) (bf16x8){vlo[i][0],vlo[i][1],vlo[i][2],vlo[i][3],vhi[i][0],vhi[i][1],vhi[i][2],vhi[i][3]}
  #define PIN(x) asm volatile("":"+v"(x))
  #define MX3(a,b,c) __builtin_fmaxf(__builtin_fmaxf((a),(b)),(c))
  #define GAPA(MF,A0,A1,A2,A3,W0,W1,PW) do{ MF; sacc+=A0; sacc+=A1; sacc+=A2; sacc+=A3; PIN(sacc); W0; W1; PIN(PW); SBAR(); }while(0)
  #define EX(v) __builtin_amdgcn_exp2f(v)
  #define GAPB(MF,X,B) do{ MF; X[B]=EX(X[B]); X[B+1]=EX(X[B+1]); X[B+2]=EX(X[B+2]); X[B+3]=EX(X[B+3]); PIN(X); SBAR(); }while(0)
  #define VRD(i) do{ vlo[i]=vtr(vp_+(((i)>>2)*4096+((i)&3)*1024)); vhi[i]=vtr(vp_+(((i)>>2)*4096+((i)&3)*1024+512)); }while(0)
  #define KRD(G,j) do{ if(G){ kload2(kf,kp0+sl_next,j); SBAR(); } }while(0)
  #define STEP(C0,C1,P0,P1,t,GK,GV,GL) do{ SBAR(); \
    const lds_cptr vp_=vp0+sl_prev; \
    VRD(0); SBAR(); float sacc=(P0[0]+P0[1]); \
    GAPA(C0=__builtin_amdgcn_mfma_f32_32x32x16_bf16(kf[0],qr[0],negm,0,0,0), P0[2],P0[3],P0[4],P0[5],     pw0[0]=PKW(P0,0), pw0[1]=PKW(P0,2), pw0); \
    VRD(4); SBAR(); GAPA(C1=__builtin_amdgcn_mfma_f32_32x32x16_bf16(kf[1],qr[0],negm,0,0,0), P0[6],P0[7],P0[8],P0[9],     pw0[2]=PKW(P0,4), pw0[3]=PKW(P0,6), pw0); \
    VRD(1); SBAR(); GAPA(C0=__builtin_amdgcn_mfma_f32_32x32x16_bf16(kf[2],qr[1],C0,0,0,0),   P0[10],P0[11],P0[12],P0[13], pw1[0]=PKW(P0,8), pw1[1]=PKW(P0,10), pw1); \
    VRD(5); SBAR(); GAPA(C1=__builtin_amdgcn_mfma_f32_32x32x16_bf16(kf[3],qr[1],C1,0,0,0),   P0[14],P0[15],P1[0],P1[1],   pw1[2]=PKW(P0,12),pw1[3]=PKW(P0,14), pw1); \
    VRD(2); SBAR(); GAPA(C0=__builtin_amdgcn_mfma_f32_32x32x16_bf16(kf[4],qr[2],C0,0,0,0),   P1[2],P1[3],P1[4],P1[5],     pw2[0]=PKW(P1,0), pw2[1]=PKW(P1,2), pw2); \
    VRD(6); SBAR(); GAPA(C1=__builtin_amdgcn_mfma_f32_32x32x16_bf16(kf[5],qr[2],C1,0,0,0),   P1[6],P1[7],P1[8],P1[9],     pw2[2]=PKW(P1,4), pw2[3]=PKW(P1,6), pw2); \
    VRD(3); SBAR(); GAPA(C0=__builtin_amdgcn_mfma_f32_32x32x16_bf16(kf[6],qr[3],C0,0,0,0),   P1[10],P1[11],P1[12],P1[13], pw3[0]=PKW(P1,8), pw3[1]=PKW(P1,10), pw3); \
    VRD(7); SBAR(); GAPA(C1=__builtin_amdgcn_mfma_f32_32x32x16_bf16(kf[7],qr[3],C1,0,0,0),   P1[14],P1[15],0.f,0.f,       pw3[2]=PKW(P1,12),pw3[3]=PKW(P1,14), pw3); \
    l_reg+=sacc; \
    if(GK){DMA_K((t)+3,sl_cur);} if(GV){DMA_V((t)+1,sl_next);} \
    CMASK(C0,C1,t); \
    { float a=MX3(C0[0],C0[1],C1[0]),b=MX3(C0[2],C0[3],C1[1]); a=MX3(a,C1[2],C1[3]); \
      _Pragma("unroll") for(int r=4;r<16;r+=4){a=MX3(a,C0[r],C0[r+1]);b=MX3(b,C0[r+2],C0[r+3]);a=MX3(a,C1[r],C1[r+1]);b=MX3(b,C1[r+2],C1[r+3]);} \
      float rm=__builtin_fmaxf(a,b); { auto rr=__builtin_amdgcn_permlane32_swap(__float_as_uint(rm),__float_as_uint(rm),false,false); rm=__builtin_fmaxf(__uint_as_float(rr[0]),__uint_as_float(rr[1])); } \
      resc=false; \
      if(__builtin_expect(__any(rm>(float)THRL),0)){ const float dl=__builtin_fmaxf(rm,0.f); mhat+=dl; \
        _Pragma("unroll") for(int r=0;r<16;++r){C0[r]-=dl;C1[r]-=dl;} \
        _Pragma("unroll") for(int r=0;r<16;++r)negm[r]=-mhat; asm volatile("":"+v"(negm)); \
        const float f=__builtin_amdgcn_exp2f(-dl); l_reg*=f; if(hi==0)wsf[r32]=f; resc=true; } } \
    SBAR(); \
    GAPB(o[0]=__builtin_amdgcn_mfma_f32_32x32x16_bf16(PAF(0),VFR(0),o[0],0,0,0), C0,0); \
    GAPB(o[1]=__builtin_amdgcn_mfma_f32_32x32x16_bf16(PAF(0),VFR(4),o[1],0,0,0), C0,4); \
    KRD(GL,0); GAPB(o[0]=__builtin_amdgcn_mfma_f32_32x32x16_bf16(PAF(1),VFR(1),o[0],0,0,0), C0,8); \
    KRD(GL,1); GAPB(o[1]=__builtin_amdgcn_mfma_f32_32x32x16_bf16(PAF(1),VFR(5),o[1],0,0,0), C0,12); \
    KRD(GL,2); GAPB(o[0]=__builtin_amdgcn_mfma_f32_32x32x16_bf16(PAF(2),VFR(2),o[0],0,0,0), C1,0); \
    KRD(GL,3); GAPB(o[1]=__builtin_amdgcn_mfma_f32_32x32x16_bf16(PAF(2),VFR(6),o[1],0,0,0), C1,4); \
    GAPB(o[0]=__builtin_amdgcn_mfma_f32_32x32x16_bf16(PAF(3),VFR(3),o[0],0,0,0), C1,8); \
    GAPB(o[1]=__builtin_amdgcn_mfma_f32_32x32x16_bf16(PAF(3),VFR(7),o[1],0,0,0), C1,12); \
    }while(0)
  int t=1;
  #undef CMASK
  #define CMASK(P0,P1,t) do{}while(0)
  if constexpr(MODE==0)
  for(;t+5<NT;t+=2){
    STEP(pB0,pB1,pA0,pA1,t,true,true,true);     WAIT_BAR(2); RESC(); ROT();
    STEP(pA0,pA1,pB0,pB1,t+1,true,true,true);   WAIT_BAR(2); RESC(); ROT();
  }
  #undef CMASK
  #define CMASK(P0,P1,t) do{ if(MODE==1) wmask(P0,P1,(t),kbase,qabs,hi); }while(0)
  #define ENDW(tt) do{ if((tt)+3<NT){WAIT_BAR(2);} else if((tt)+2<NT){WAIT_BAR(1);} else {WAIT_BAR(0);} }while(0)
  for(;t+1<NT;t+=2){
    STEP(pB0,pB1,pA0,pA1,t,(t+3<NT),(t+1<NT),(t+1<NT));       ENDW(t);   RESC(); ROT();
    STEP(pA0,pA1,pB0,pB1,t+1,(t+4<NT),(t+2<NT),(t+2<NT));     ENDW(t+1); RESC(); ROT();
  }
  STEP(pB0,pB1,pA0,pA1,NT-1,false,false,false); RESC();
  { float sacc=pB0[0]+pB0[1]; _Pragma("unroll") for(int r=2;r<16;++r)sacc+=pB0[r]; _Pragma("unroll") for(int r=0;r<16;++r)sacc+=pB1[r]; l_reg+=sacc;
    pw0=(u32x4){PKW(pB0,0),PKW(pB0,2),PKW(pB0,4),PKW(pB0,6)};pw1=(u32x4){PKW(pB0,8),PKW(pB0,10),PKW(pB0,12),PKW(pB0,14)};pw2=(u32x4){PKW(pB1,0),PKW(pB1,2),PKW(pB1,4),PKW(pB1,6)};pw3=(u32x4){PKW(pB1,8),PKW(pB1,10),PKW(pB1,12),PKW(pB1,14)};
    SBAR(); pv(o,vb0+sl_cur,PAF(0),PAF(1),PAF(2),PAF(3)); }
  #undef PKW
  #undef PAF
  #undef VFR
  #undef PIN
  #undef MX3
  #undef GAPA
  #undef GAPB
  #undef EX
  #undef VRD
  #undef KRD
  #undef STEP
  #undef ENDW
  {auto rr=__builtin_amdgcn_permlane32_swap(__float_as_uint(l_reg),__float_as_uint(l_reg),false,false);l_reg=__uint_as_float(rr[0])+__uint_as_float(rr[1]);}
  if(MODE==1)l_reg+=__builtin_amdgcn_exp2f(sink_l2-mhat);
  if(hi==0)wsf[32+r32]=l_reg;asm volatile("s_waitcnt lgkmcnt(0)":::"memory");
  float rli[16];
  #pragma unroll
  for(int r=0;r<16;++r)rli[r]=__builtin_amdgcn_rcpf(wsf[32+crow(r,hi)]);
  bf16*Ow=O+(long)(q0+wid*QBLK)*QP+h*D;
  { bf16*stg=(bf16*)(shm+LDS_OST)+wid*2048;
    #pragma unroll
    for(int r=0;r<16;++r){const int orow=crow(r,hi);
      #pragma unroll
      for(int d0=0;d0<2;++d0)stg[orow*64+d0*32+r32]=__float2bfloat16(o[d0][r]*rli[r]);}
    asm volatile("s_waitcnt lgkmcnt(0)":::"memory");
    #pragma unroll
    for(int i=0;i<4;++i){const int row=i*8+(lane>>3),ch=lane&7; const u32x4 v=*(const u32x4*)(stg+row*64+ch*8); ATTN_STORE16(Ow+(long)row*QP+ch*8,v);} }
  asm volatile("s_waitcnt lgkmcnt(0)\n\ts_barrier":::"memory");
  #undef DMA_K
  #undef DMA_V
  #undef CMASK
  #undef TROW
  #undef START
  #undef RESC
  #undef ROT
}
constexpr int ATTN_LDS_BYTES=LDS_BYTES;
#undef SBAR
#undef WAIT_BAR
}
#ifndef EN_MIX
#define EN_MIX 15
#endif
#ifndef EN_MOE
#define EN_MOE 15
#endif
constexpr int NWAVES = 8, NTHR = 512;
constexpr int DM = 1024, NLAT = 16384, NCTX = 256, T = NLAT + NCTX, NPAN = T / 256;
constexpr int NE = 32, TOPK = 4, EFF = 1024;
constexpr int FA_NQKV = 1536, WA_NQKV = 1280, GM_FF = 4096, GM_HALF = 2048;
constexpr float LN_EPS = 1e-5f, RMS_EPS = 1e-6f;
constexpr float DN_ALPHA = 1.6817928305074292f;
constexpr float LOG2E = 1.4426950408889634f, QSCALE = 0.125f * LOG2E;
constexpr int NPHASE = 35;

constexpr size_t MiB = 1u << 20;
constexpr size_t WS_CTL = 0, CTL_ZERO_BYTES = 1 * MiB;
constexpr size_t WS_MOD = 1 * MiB;
constexpr size_t WS_TAB = 2 * MiB;
constexpr size_t TB_FC = WS_TAB, TB_FA = TB_FC + 512 * 256 * 2, TB_FCC = TB_FA + 256 * 256 * 2, TB_FX = TB_FCC + 256 * 256 * 2, TB_TWC = TB_FX + 256 * 512 * 2,
                 TB_TWS = TB_TWC + 128 * 128 * 4, TB_ROPC = TB_TWS + 128 * 128 * 4, TB_ROPS = TB_ROPC + (size_t)NLAT * 32 * 4, TB_END = TB_ROPS + (size_t)NLAT * 32 * 4;
static_assert(TB_END <= 10 * MiB, "tables");
constexpr size_t WS_RW = 10 * MiB;
constexpr size_t WS_LCNT = 11 * MiB;
constexpr size_t WS_ASG = 12 * MiB, WS_GATE = WS_ASG + (size_t)T * 16, WS_SLOT = WS_GATE + (size_t)T * 16;
static_assert(WS_SLOT + (size_t)T * 16 <= 16 * MiB, "assign");
constexpr size_t WS_WFN = 16 * MiB, WS_WFAQ = WS_WFN + 2 * MiB, WS_WFAO = WS_WFAQ + 3 * MiB, WS_WGI = WS_WFAO + 2 * MiB, WS_WGO = WS_WGI + 8 * MiB,
                 WS_WWQ = WS_WGO + 4 * MiB, WS_WWO = WS_WWQ + 3 * MiB, WS_WSM_END = WS_WWO + 2 * MiB;
static_assert(WS_WSM_END <= 40 * MiB, "small weights");
constexpr size_t WS_X = 40 * MiB;
constexpr size_t WS_H = 106 * MiB;
constexpr size_t WS_Y = 140 * MiB;
constexpr size_t WS_BIG = 176 * MiB;
constexpr size_t WS_BTA = WS_BIG, WS_BTC = WS_BTA + 64 * MiB, WS_BTX = WS_BTC + 64 * MiB, WS_MIXB = WS_BTX + 1 * MiB;
constexpr size_t WS_Q = WS_BIG, WS_K = WS_Q + 33 * MiB, WS_V = WS_K + 9 * MiB;
constexpr size_t WS_GU = WS_BIG, WS_GV = WS_GU + 65 * MiB, WS_GG = WS_GV + 65 * MiB;
constexpr int MAXMT = 292; constexpr size_t SLOTROWS = (size_t)MAXMT * 256;
constexpr size_t WS_XS = WS_BIG, WS_ACT = WS_XS + 146 * MiB, WS_YS = WS_ACT + 146 * MiB;
static_assert(SLOTROWS * 2048 <= 146 * MiB, "slots");
constexpr size_t WS_WEXP_GU = 640 * MiB, WS_WEXP_DN = WS_WEXP_GU + 512 * MiB, WS_END = WS_WEXP_DN + 256 * MiB;
static_assert(WS_YS + 146 * MiB <= WS_WEXP_GU, "big region");
constexpr int CW_BAR = 4096;

constexpr int RING_OFF = 0, RING_BYTES = 131072;
constexpr int PRO_SCR_BYTES = 8 * 64 * 65 * 4;
constexpr int MISC_OFF = 136 * 1024;
constexpr int LDS_BYTES = 147456;
constexpr int MW_BAR = 0, MW_LC = 8, MW_EBASE = 64, MW_MYBASE = 96, MW_NMT = 128, MW_MTE = 160;
static_assert(MISC_OFF + (MW_MTE + 304) * 4 <= LDS_BYTES && PRO_SCR_BYTES <= MISC_OFF, "LDS map");

#define GAS __attribute__((address_space(1)))
#define LAS __attribute__((address_space(3)))
typedef unsigned short bf16;
typedef unsigned v4u __attribute__((ext_vector_type(4)));
typedef unsigned v2u __attribute__((ext_vector_type(2)));
typedef float f32x4 __attribute__((ext_vector_type(4)));
typedef float f32x2 __attribute__((ext_vector_type(2)));
typedef float f32x16 __attribute__((ext_vector_type(16)));
typedef short bf16x8 __attribute__((ext_vector_type(8)));
typedef GAS unsigned gu32;
#define RLX_AGENT __ATOMIC_RELAXED, __HIP_MEMORY_SCOPE_AGENT
#define LDS_WAIT() asm volatile("s_waitcnt lgkmcnt(0)" ::: "memory")
#define VM_WAIT() asm volatile("s_waitcnt vmcnt(0)" ::: "memory")
__device__ __forceinline__ unsigned f2bf(float f) { unsigned u = __builtin_bit_cast(unsigned, f); return (u + 0x7fffu + ((u >> 16) & 1u)) >> 16; }
__device__ __forceinline__ unsigned pk2(float lo, float hi) { return f2bf(lo) | (f2bf(hi) << 16); }
__device__ __forceinline__ float bf_lo(unsigned w) { return __builtin_bit_cast(float, w << 16); }
__device__ __forceinline__ float bf_hi(unsigned w) { return __builtin_bit_cast(float, w & 0xffff0000u); }
#define XB_TMO      128
#define XB_XCNT(j)  (256  + 64 * (j))
#define XB_XSUB(j)  (1280 + 64 * (j))
#define XB_XGEN(j)  (2304 + 64 * (j))
#define XB_TOP      3328
#define XB_TOPGEN   3392
#define XCD_BAR_WORDS 3456
#define XB_SPIN_CAP (1u << 18)

__device__ __forceinline__ unsigned xb_ld(unsigned* p)              { return __hip_atomic_load(p, __ATOMIC_RELAXED, __HIP_MEMORY_SCOPE_AGENT); }
__device__ __forceinline__ unsigned xb_add(unsigned* p, unsigned v) { return __hip_atomic_fetch_add(p, v, __ATOMIC_RELAXED, __HIP_MEMORY_SCOPE_AGENT); }
__device__ __forceinline__ unsigned xb_xcc_id() { return (unsigned)__builtin_amdgcn_s_getreg((3 << 11) | 20) & 0xFu; }
#define XB_SPIN(cond, bar) do { unsigned _sp = 0; while (cond) { __builtin_amdgcn_s_sleep(1); \
    if ((++_sp & 255u) == 0u) { if (xb_ld(&(bar)[XB_TMO])) break; if (_sp > XB_SPIN_CAP) { atomicAdd(&(bar)[XB_TMO], 1u); break; } } } } while (0)

struct XcdBarrier {
    unsigned* bar; unsigned x;
    volatile LAS unsigned* st;
};

__device__ __forceinline__ XcdBarrier xcd_barrier_post(unsigned* bar, volatile LAS unsigned* st) {
    XcdBarrier b; b.bar = bar; b.x = xb_xcc_id(); b.st = st;
    if (threadIdx.x == 0) (void)xb_add(&bar[XB_XCNT(b.x)], 1u);
    return b;
}
__device__ __forceinline__ void xcd_barrier_complete(unsigned* bar, unsigned x, unsigned& nloc, unsigned& nx) {
    const unsigned G = gridDim.x * gridDim.y * gridDim.z;
    unsigned sum, cnt, mine, sp = 0u;
    for (;;) {
        sum = 0u; cnt = 0u; mine = 0u;
#pragma unroll
        for (unsigned j = 0; j < 16; ++j) { const unsigned c = xb_ld(&bar[XB_XCNT(j)]); sum += c; cnt += (c > 0u) ? 1u : 0u; mine = (j == x) ? c : mine; }
        if (sum == G) break;
        __builtin_amdgcn_s_sleep(1);
        if ((++sp & 255u) == 0u) { if (xb_ld(&bar[XB_TMO])) break; if (sp > XB_SPIN_CAP) { atomicAdd(&bar[XB_TMO], 1u); break; } }
    }
    nloc = mine > 0u ? mine : 1u; nx = cnt > 0u ? cnt : 1u;
}

__device__ __forceinline__ void xcd_barrier(const XcdBarrier& b) {
    asm volatile("s_waitcnt vmcnt(0)" ::: "memory");
    __syncthreads();
    if (threadIdx.x == 0) {
        unsigned* bar = b.bar;
        __builtin_amdgcn_s_waitcnt(0);
        unsigned nloc = b.st[0], nx = b.st[1];
        if (nloc == 0u) { xcd_barrier_complete(bar, b.x, nloc, nx); b.st[0] = nloc; b.st[1] = nx; }
        const unsigned old = xb_add(&bar[XB_XSUB(b.x)], 1u);
        const unsigned gen = old / nloc;
        if (old + 1u == (gen + 1u) * nloc) {
            __builtin_amdgcn_fence(__ATOMIC_RELEASE, "agent");
            asm volatile("s_waitcnt vmcnt(0)" ::: "memory");
            const unsigned og = xb_add(&bar[XB_TOP], 1u);
            const unsigned tg = og / nx;
            if (og + 1u == (tg + 1u) * nx) xb_add(&bar[XB_TOPGEN], 1u);
            else XB_SPIN(xb_ld(&bar[XB_TOPGEN]) == tg, bar);
            __builtin_amdgcn_fence(__ATOMIC_ACQUIRE, "agent");
            xb_add(&bar[XB_XGEN(b.x)], 1u);
            asm volatile("s_waitcnt vmcnt(0)" ::: "memory");
        } else {
            XB_SPIN(xb_ld(&bar[XB_XGEN(b.x)]) == gen, bar);
            __builtin_amdgcn_fence(__ATOMIC_ACQUIRE, "agent");
            asm volatile("s_waitcnt vmcnt(0)" ::: "memory");
        }
    }
    __syncthreads();
}
struct Frame {
    LAS unsigned char* lds;
    volatile LAS unsigned* MISC;
    gu32* ctl;
    unsigned char* ws;
    int wave, vcu, G, bx;
};
enum In { I_X = 0, I_C, I_CTX, I_CCTX, I_ADAW, I_ADAB, I_LNMG, I_LNMB, I_LNFG, I_LNFB, I_FNW, I_FNB, I_FAWQ, I_FABQ, I_FAQN, I_FAKN, I_FAWO, I_FABO,
          I_GMWI, I_GMBI, I_GMVG, I_GMVB, I_GMWS, I_GMBS, I_GMWO, I_GMBO, I_WAWQ, I_WABQ, I_WASK, I_WAWO, I_WABO, I_RW, I_RB, I_EWGU, I_EBGU, I_EWD, I_EBD, N_IN };

#define CAS __attribute__((address_space(4)))
typedef const float* cfptr_t;
__device__ __forceinline__ const float* argp(int idx) {
    unsigned long long a = (unsigned long long)__builtin_amdgcn_kernarg_segment_ptr(); asm volatile("" : "+s"(a));
    return ((const CAS cfptr_t*)a)[idx];
}
__device__ __forceinline__ int otid() { int t = threadIdx.x; asm volatile("" : "+v"(t)); return t; }
__device__ __forceinline__ float wave_sum(float v) {
#pragma unroll
    for (int o = 1; o < 64; o <<= 1) v += __shfl_xor(v, o);
    return v;
}
struct RowV { f32x4 v[4]; };
__device__ __forceinline__ RowV ldrow(const float* p, int lane) { RowV r; const f32x4* q = (const f32x4*)p + lane;
#pragma unroll
    for (int j = 0; j < 4; ++j) r.v[j] = q[64 * j]; return r; }
__device__ __forceinline__ void strow(float* p, int lane, const RowV& r) { f32x4* q = (f32x4*)p + lane;
#pragma unroll
    for (int j = 0; j < 4; ++j) q[64 * j] = r.v[j]; }
__device__ __forceinline__ void strow_bf16(bf16* p, int lane, const RowV& r) { unsigned long long* q = (unsigned long long*)p + lane;
#pragma unroll
    for (int j = 0; j < 4; ++j) q[64 * j] = (unsigned long long)pk2(r.v[j].x, r.v[j].y) | ((unsigned long long)pk2(r.v[j].z, r.v[j].w) << 32); }
__device__ __forceinline__ RowV ldrow_bf16(const bf16* p, int lane) { RowV r; const v2u* q = (const v2u*)p + lane;
#pragma unroll
    for (int j = 0; j < 4; ++j) { const v2u w = q[64 * j]; r.v[j] = (f32x4){bf_lo(w.x), bf_hi(w.x), bf_lo(w.y), bf_hi(w.y)}; } return r; }
__device__ __forceinline__ RowV ln_row(const RowV& x, const RowV& g, const RowV& b) {
    float s = 0.f;
#pragma unroll
    for (int j = 0; j < 4; ++j) s += (x.v[j].x + x.v[j].y) + (x.v[j].z + x.v[j].w);
    const float mean = wave_sum(s) * (1.f / DM); float s2 = 0.f; RowV d;
#pragma unroll
    for (int j = 0; j < 4; ++j) { d.v[j] = x.v[j] - mean; s2 += (d.v[j].x * d.v[j].x + d.v[j].y * d.v[j].y) + (d.v[j].z * d.v[j].z + d.v[j].w * d.v[j].w); }
    const float rstd = 1.f / sqrtf(wave_sum(s2) * (1.f / DM) + LN_EPS);
#pragma unroll
    for (int j = 0; j < 4; ++j) d.v[j] = d.v[j] * rstd * g.v[j] + b.v[j];
    return d;
}
__device__ __forceinline__ const float* modp(const Frame& F, int L, int s, int which) { return (const float*)(F.ws + WS_MOD) + ((size_t)(L * 2 + s) * 6 + which) * DM; }

struct TokOrder : pg8::GridOrder {
    size_t apan, bpan;
    __device__ __forceinline__ bool next(int i, pg8::Unit& u) const { u.e = 0; return next_mn(i, u.pm, u.pn); }
    __device__ __forceinline__ size_t offA(const pg8::Unit& u) const { return (size_t)u.pm * apan; }
    __device__ __forceinline__ size_t offB(const pg8::Unit& u) const { return (size_t)u.pn * bpan; }
    __device__ __forceinline__ void a_ready(const pg8::Unit&) const {}
    __device__ __forceinline__ void done(const pg8::Unit&) const {}
};
struct ChDftOrder : pg8::GridOrder {
    __device__ __forceinline__ bool next(int i, pg8::Unit& u) const { u.e = 0; return next_mn(i, u.pm, u.pn); }
    __device__ __forceinline__ size_t offA(const pg8::Unit& u) const { return (size_t)u.pm * (256 * 256 * 2); }
    __device__ __forceinline__ size_t offB(const pg8::Unit& u) const { const int g = u.pn >> 6, j = u.pn & 63; return ((size_t)(2 * j) * DM + g * 256) * 2; }
    __device__ __forceinline__ void a_ready(const pg8::Unit&) const {}
    __device__ __forceinline__ void done(const pg8::Unit&) const {}
};
struct ChDftCtxOrder : pg8::GridOrder {
    __device__ __forceinline__ bool next(int i, pg8::Unit& u) const { u.e = 0; return next_mn(i, u.pm, u.pn); }
    __device__ __forceinline__ size_t offA(const pg8::Unit& u) const { return (size_t)u.pm * (256 * 256 * 2); }
    __device__ __forceinline__ size_t offB(const pg8::Unit& u) const { return ((size_t)NLAT * DM + u.pn * 256) * 2; }
    __device__ __forceinline__ void a_ready(const pg8::Unit&) const {}
    __device__ __forceinline__ void done(const pg8::Unit&) const {}
};
struct MoeOrder : pg8::GridOrder {
    const volatile LAS unsigned* mte; size_t bexp;
    __device__ __forceinline__ bool next(int i, pg8::Unit& u) const { if (!next_mn(i, u.pm, u.pn)) return false; u.e = (int)mte[u.pm]; return true; }
    __device__ __forceinline__ size_t offA(const pg8::Unit& u) const { return (size_t)u.pm * (256 * 1024 * 2); }
    __device__ __forceinline__ size_t offB(const pg8::Unit& u) const { return (size_t)u.e * bexp + (size_t)u.pn * (256 * 1024 * 2); }
    __device__ __forceinline__ void a_ready(const pg8::Unit&) const {}
    __device__ __forceinline__ void done(const pg8::Unit&) const {}
};

#define EPI_ARGS const pg8::f32x4 (&acc)[2][2][4][2], const pg8::Unit& u, int wr, int wc, int fr, int fq
__device__ __forceinline__ v4u pack8(const f32x4& a, const f32x4& b) { v4u w; w.x = pg8::cvt_pk_bf16(a[0], a[1]); w.y = pg8::cvt_pk_bf16(a[2], a[3]); w.z = pg8::cvt_pk_bf16(b[0], b[1]); w.w = pg8::cvt_pk_bf16(b[2], b[3]); return w; }

struct EpiChDft { static constexpr bool PERM = true, AFTER_DRAIN = false; bf16* O;
    __device__ __forceinline__ void operator()(EPI_ARGS) const {
        const int g = u.pn >> 6, j = u.pn & 63, part = u.pm;
        char* ub = (char*)O + 2 * ((size_t)((g * 256 + 64 * wr) * 128 + 2 * j) * 256 + part * 128 + 32 * wc);
        unsigned lo = 2u * (unsigned)(fr * 128 * 256 + 8 * fq); asm volatile("" : "+v"(lo));
#pragma unroll
        for (int ai = 0; ai < 2; ++ai)
#pragma unroll
            for (int m = 0; m < 4; ++m)
#pragma unroll
                for (int bj = 0; bj < 2; ++bj)
                    *(v4u*)(ub + (size_t)(2 * (((128 * ai + 16 * m) * 128 + bj) * 256)) + lo) = pack8(acc[ai][bj][m][0], acc[ai][bj][m][1]);
    }
};
struct EpiChDftCtx { static constexpr bool PERM = true, AFTER_DRAIN = false; bf16* O;
    __device__ __forceinline__ void operator()(EPI_ARGS) const {
        const int g = u.pn, part = u.pm;
        char* ub = (char*)O + 2 * ((size_t)(g * 256 + 64 * wr) * 512 + part * 256 + 32 * wc);
        unsigned lo = 2u * (unsigned)(fr * 512 + 8 * fq); asm volatile("" : "+v"(lo));
#pragma unroll
        for (int ai = 0; ai < 2; ++ai)
#pragma unroll
            for (int m = 0; m < 4; ++m)
#pragma unroll
                for (int bj = 0; bj < 2; ++bj)
                    *(v4u*)(ub + (size_t)(2 * ((128 * ai + 16 * m) * 512 + 128 * bj)) + lo) = pack8(acc[ai][bj][m][0], acc[ai][bj][m][1]);
    }
};
struct EpiStepA { static constexpr bool PERM = true, AFTER_DRAIN = false; bf16* O; const float* twc; const float* tws;
    __device__ __forceinline__ void operator()(EPI_ARGS) const {
        char* ub = (char*)O + 2 * ((size_t)(64 * wr * 1024 + 2 * u.pn) * 256 + 32 * wc);
        unsigned lo = 2u * (unsigned)(fr * 1024 * 256 + 8 * fq); asm volatile("" : "+v"(lo));
        const char* tcb = (const char*)twc + 4 * (64 * wr * 128 + 32 * wc); const char* tsb = (const char*)tws + 4 * (64 * wr * 128 + 32 * wc);
        unsigned tlo = 4u * (unsigned)(fr * 128 + 8 * fq); asm volatile("" : "+v"(tlo));
#pragma unroll
        for (int m = 0; m < 4; ++m) {
            const f32x4 c0 = *(const f32x4*)(tcb + 4 * (16 * m * 128) + tlo), c1 = *(const f32x4*)(tcb + 4 * (16 * m * 128 + 4) + tlo), s0 = *(const f32x4*)(tsb + 4 * (16 * m * 128) + tlo), s1 = *(const f32x4*)(tsb + 4 * (16 * m * 128 + 4) + tlo);
#pragma unroll
            for (int bj = 0; bj < 2; ++bj) {
                const f32x4 zr0 = acc[0][bj][m][0], zr1 = acc[0][bj][m][1], zi0 = acc[1][bj][m][0], zi1 = acc[1][bj][m][1];
                const f32x4 yr0 = zr0 * c0 + zi0 * s0, yr1 = zr1 * c1 + zi1 * s1, yi0 = zi0 * c0 - zr0 * s0, yi1 = zi1 * c1 - zr1 * s1;
                char* p = ub + (size_t)(2 * ((16 * m * 1024 + bj) * 256)) + lo;
                *(v4u*)p = pack8(yr0, yr1); *(v4u*)(p + 256) = pack8(yi0, yi1); }
            asm volatile("" ::: "memory"); }
    }
};
struct EpiStepC { static constexpr bool PERM = true, AFTER_DRAIN = false; bf16* O;
    __device__ __forceinline__ void operator()(EPI_ARGS) const {
        const int k1 = u.pn >> 2, chb = (u.pn & 3) * 256;
        char* ub = (char*)O + 2 * ((size_t)(k1 + 128 * 64 * wr) * DM + chb + 32 * wc);
        unsigned lo = 2u * (unsigned)(128 * fr * DM + 8 * fq); asm volatile("" : "+v"(lo));
#pragma unroll
        for (int m = 0; m < 4; ++m)
#pragma unroll
            for (int bj = 0; bj < 2; ++bj)
                *(v4u*)(ub + (size_t)(2 * (128 * 16 * m * DM + 128 * bj)) + lo) = pack8(acc[0][bj][m][0], acc[0][bj][m][1]);
    }
};
struct EpiCtxPos { static constexpr bool PERM = true, AFTER_DRAIN = false; bf16* O;
    __device__ __forceinline__ void operator()(EPI_ARGS) const {
        char* ub = (char*)O + 2 * ((size_t)(NLAT + 64 * wr) * DM + u.pn * 256 + 32 * wc);
        unsigned lo = 2u * (unsigned)(fr * DM + 8 * fq); asm volatile("" : "+v"(lo));
#pragma unroll
        for (int ai = 0; ai < 2; ++ai)
#pragma unroll
            for (int m = 0; m < 4; ++m)
#pragma unroll
                for (int bj = 0; bj < 2; ++bj)
                    *(v4u*)(ub + (size_t)(2 * ((128 * ai + 16 * m) * DM + 128 * bj)) + lo) = pack8(acc[ai][bj][m][0], acc[ai][bj][m][1]);
    }
};
template <int NKV, bool RMS> struct EpiQKV { static constexpr bool PERM = true, AFTER_DRAIN = false;
    bf16 *Q, *K, *V; const float* bias; const float* qn; const float* kn; const float* ropc; const float* rops;
    __device__ __forceinline__ void operator()(EPI_ARGS) const {
        const int hh = 4 * u.pn + wc; const int kind = hh < 16 ? 0 : (hh < 16 + NKV ? 1 : 2);
        const int pitch = kind == 0 ? DM : NKV * 64, hd = kind == 0 ? hh : (kind == 1 ? hh - 16 : hh - 16 - NKV);
        const size_t doff = kind == 0 ? (size_t)0 : (kind == 1 ? (size_t)(WS_K - WS_Q) : (size_t)(WS_V - WS_Q));
        bf16* dst = (bf16*)((char*)Q + doff);
        const bool lat = u.pm < NLAT / 256;
        const int rowu = u.pm * 256 + 64 * wr;
        char* ub = (char*)dst + 2 * ((size_t)rowu * pitch + hd * 64);
        unsigned lo = 2u * (unsigned)(fr * pitch + 8 * fq); asm volatile("" : "+v"(lo));
        const char* rcb = (const char*)ropc + 4 * ((size_t)rowu * 32); const char* rsb = (const char*)rops + 4 * ((size_t)rowu * 32);
        unsigned rlo = 4u * (unsigned)(fr * 32 + 4 * fq); asm volatile("" : "+v"(rlo));
        f32x4 bv[2][2], gv[2][2];
#pragma unroll
        for (int bj = 0; bj < 2; ++bj)
#pragma unroll
            for (int n = 0; n < 2; ++n) { const int d = 32 * bj + 8 * fq + 4 * n; bv[bj][n] = *(const f32x4*)(bias + hh * 64 + d);
                if (RMS) { const f32x4 gq = *(const f32x4*)(qn + d), gk = *(const f32x4*)(kn + d); gv[bj][n] = kind == 0 ? gq : gk; } }
#pragma unroll
        for (int ai = 0; ai < 2; ++ai)
#pragma unroll
            for (int m = 0; m < 4; ++m) {
                f32x4 v[2][2];
#pragma unroll
                for (int bj = 0; bj < 2; ++bj)
#pragma unroll
                    for (int n = 0; n < 2; ++n) v[bj][n] = acc[ai][bj][m][n] + bv[bj][n];
                if (kind < 2) {
                    if (RMS) { float ss = 0.f;
#pragma unroll
                        for (int bj = 0; bj < 2; ++bj)
#pragma unroll
                            for (int n = 0; n < 2; ++n) ss += (v[bj][n][0] * v[bj][n][0] + v[bj][n][1] * v[bj][n][1]) + (v[bj][n][2] * v[bj][n][2] + v[bj][n][3] * v[bj][n][3]);
                        ss += __shfl_xor(ss, 16); ss += __shfl_xor(ss, 32);
                        const float rs = 1.f / sqrtf(ss * (1.f / 64.f) + RMS_EPS);
#pragma unroll
                        for (int bj = 0; bj < 2; ++bj)
#pragma unroll
                            for (int n = 0; n < 2; ++n) v[bj][n] = v[bj][n] * rs * gv[bj][n]; }
                    if (lat) {
#pragma unroll
                        for (int bj = 0; bj < 2; ++bj)
#pragma unroll
                            for (int n = 0; n < 2; ++n) {
                                const f32x2 c = *(const f32x2*)(rcb + 4 * ((128 * ai + 16 * m) * 32 + 16 * bj + 2 * n) + rlo), sn = *(const f32x2*)(rsb + 4 * ((128 * ai + 16 * m) * 32 + 16 * bj + 2 * n) + rlo);
                                const f32x4 x = v[bj][n];
                                v[bj][n] = (f32x4){x[0] * c.x - x[1] * sn.x, x[0] * sn.x + x[1] * c.x, x[2] * c.y - x[3] * sn.y, x[2] * sn.y + x[3] * c.y}; } }
                    if (kind == 0) {
#pragma unroll
                        for (int bj = 0; bj < 2; ++bj)
#pragma unroll
                            for (int n = 0; n < 2; ++n) v[bj][n] = v[bj][n] * QSCALE; }
                }
                char* p = ub + (size_t)(128 * ai + 16 * m) * (size_t)(2 * pitch) + lo;
                *(v4u*)p = pack8(v[0][0], v[0][1]); *(v4u*)(p + 64) = pack8(v[1][0], v[1][1]);
                asm volatile("" ::: "memory"); }
    }
};
struct EpiSwiGLU { static constexpr bool PERM = true, AFTER_DRAIN = false; bf16* O; const float* bias;
    __device__ __forceinline__ void operator()(EPI_ARGS) const {
        f32x4 bv[2][2];
        const float* bb = bias + (size_t)u.e * 2048 + u.pn * 256 + 32 * wc + 8 * fq;
#pragma unroll
        for (int bj = 0; bj < 2; ++bj)
#pragma unroll
            for (int n = 0; n < 2; ++n) bv[bj][n] = *(const f32x4*)(bb + 128 * bj + 4 * n);
        char* ub = (char*)O + 2 * (((size_t)u.pm * 256 + 64 * wr) * 1024 + u.pn * 128 + 16 * wc);
        unsigned lo = 2u * (unsigned)(fr * 1024 + 4 * fq); asm volatile("" : "+v"(lo));
#pragma unroll
        for (int ai = 0; ai < 2; ++ai)
#pragma unroll
            for (int m = 0; m < 4; ++m) {
#pragma unroll
                for (int bj = 0; bj < 2; ++bj) { float a[4];
#pragma unroll
                    for (int n = 0; n < 2; ++n) { const f32x4 x = acc[ai][bj][m][n] + bv[bj][n];
#pragma unroll
                        for (int q = 0; q < 2; ++q) { const float glu = fminf(x[2 * q], 7.0f), lin = fminf(fmaxf(x[2 * q + 1], -7.0f), 7.0f);
                            const float sg = __builtin_amdgcn_rcpf(1.0f + __builtin_amdgcn_exp2f(-1.702f * LOG2E * glu));
                            a[2 * n + q] = glu * sg * (lin + 1.0f); } }
                    v2u w; w.x = pg8::cvt_pk_bf16(a[0], a[1]); w.y = pg8::cvt_pk_bf16(a[2], a[3]);
                    *(v2u*)(ub + (size_t)(2 * ((128 * ai + 16 * m) * 1024 + 64 * bj)) + lo) = w; } }
    }
};
struct EpiDown { static constexpr bool PERM = true, AFTER_DRAIN = false; bf16* O; const float* bias;
    __device__ __forceinline__ void operator()(EPI_ARGS) const {
        f32x4 bv[2][2];
        const float* bb = bias + (size_t)u.e * 1024 + u.pn * 256 + 32 * wc + 8 * fq;
#pragma unroll
        for (int bj = 0; bj < 2; ++bj)
#pragma unroll
            for (int n = 0; n < 2; ++n) bv[bj][n] = *(const f32x4*)(bb + 128 * bj + 4 * n);
        char* ub = (char*)O + 2 * (((size_t)u.pm * 256 + 64 * wr) * 1024 + u.pn * 256 + 32 * wc);
        unsigned lo = 2u * (unsigned)(fr * 1024 + 8 * fq); asm volatile("" : "+v"(lo));
#pragma unroll
        for (int ai = 0; ai < 2; ++ai)
#pragma unroll
            for (int m = 0; m < 4; ++m)
#pragma unroll
                for (int bj = 0; bj < 2; ++bj)
                    *(v4u*)(ub + (size_t)(2 * ((128 * ai + 16 * m) * 1024 + 128 * bj)) + lo) = pack8(acc[ai][bj][m][0] + bv[bj][0], acc[ai][bj][m][1] + bv[bj][1]);
    }
};
__device__ __forceinline__ int qkv_rowmap(int n) { return (n & ~255) + ((n >> 5) & 1) * 128 + ((n >> 6) & 3) * 32 + (n & 31); }
__device__ __forceinline__ void p0_transpose_item(const float* W, int K, int N, bf16* WT, int rowmode, LAS float* scr, int item, int lane) {
    const int nblk = N / 64, kb = item / nblk, nb = item - kb * nblk, k0 = 64 * kb, n0 = 64 * nb;
    const int r = lane >> 4, cq = lane & 15;
    f32x4 t[16];
#pragma unroll
    for (int i = 0; i < 16; ++i) t[i] = *(const f32x4*)(W + (size_t)(k0 + 4 * i + r) * N + n0 + 4 * cq);
#pragma unroll
    for (int i = 0; i < 16; ++i) { LAS float* s = scr + (4 * i + r) * 65 + 4 * cq; s[0] = t[i].x; s[1] = t[i].y; s[2] = t[i].z; s[3] = t[i].w; }
    LDS_WAIT(); asm volatile("" ::: "memory");
    const int c = lane & 7, nn = lane >> 3;
#pragma unroll
    for (int j = 0; j < 8; ++j) { const int n = nn + 8 * j; const LAS float* s = scr + (8 * c) * 65 + n;
        v4u o; o.x = pk2(s[0 * 65], s[1 * 65]); o.y = pk2(s[2 * 65], s[3 * 65]); o.z = pk2(s[4 * 65], s[5 * 65]); o.w = pk2(s[6 * 65], s[7 * 65]);
        const int row = rowmode ? qkv_rowmap(n0 + n) : (n0 + n);
        *(GAS v4u*)(WT + (size_t)row * K + k0 + 8 * c) = o; }
    LDS_WAIT(); asm volatile("" ::: "memory");
}
__device__ __forceinline__ float siluf(float v) { return v / (1.f + __expf(-v)); }
__device__ __forceinline__ void p0_prologue(Frame& F) { const int tid = otid(), lane = tid & 63; (void)tid; (void)lane;
    {
        LAS float* sc = (LAS float*)(F.lds);
        LAS float* red = sc + 2048;
        { const float* c0 = argp(I_C); const float* c1 = argp(I_CCTX);
          for (int i = tid; i < 2048; i += NTHR) { const int s = i >> 10, k = i & 1023; sc[i] = siluf(s == 0 ? c0[k] : c1[k]); } }
        __syncthreads();
        const float* adaw = argp(I_ADAW); const float* adab = argp(I_ADAB);
        for (int task = F.bx; task < 4 * 48; task += F.G) {
            const int L = task / 48, n0 = (task % 48) * 128;
            const float* w = adaw + (size_t)L * DM * 6144 + n0 + 2 * lane;
            float a0 = 0.f, a1 = 0.f, b0 = 0.f, b1 = 0.f;
#pragma unroll 8
            for (int kk = 0; kk < 128; ++kk) { const int k = 128 * F.wave + kk; const f32x2 x = *(const f32x2*)(w + (size_t)k * 6144); const float sl = sc[k], sx = sc[1024 + k];
                a0 += sl * x.x; a1 += sl * x.y; b0 += sx * x.x; b1 += sx * x.y; }
            red[(F.wave * 2 + 0) * 128 + 2 * lane] = a0; red[(F.wave * 2 + 0) * 128 + 2 * lane + 1] = a1;
            red[(F.wave * 2 + 1) * 128 + 2 * lane] = b0; red[(F.wave * 2 + 1) * 128 + 2 * lane + 1] = b1;
            __syncthreads();
            if (tid < 256) { const int s = tid >> 7, col = tid & 127; float v = adab[(size_t)L * 6144 + n0 + col];
#pragma unroll
                for (int wv = 0; wv < 8; ++wv) v += red[(wv * 2 + s) * 128 + col];
                ((float*)(F.ws + WS_MOD))[(size_t)(L * 2 + s) * 6144 + n0 + col] = v; }
            __syncthreads();
        }
    }
    {
        const int gt = F.bx * NTHR + tid, NGT = F.G * NTHR;
        bf16* fc = (bf16*)(F.ws + TB_FC); bf16* fa = (bf16*)(F.ws + TB_FA); bf16* fcc = (bf16*)(F.ws + TB_FCC); bf16* fx = (bf16*)(F.ws + TB_FX);
        float* twc = (float*)(F.ws + TB_TWC); float* tws = (float*)(F.ws + TB_TWS); float* ropc = (float*)(F.ws + TB_ROPC); float* rops = (float*)(F.ws + TB_ROPS);
        for (int i = gt; i < 512 * 256; i += NGT) { const int row = i >> 8, c = i & 255, part = row >> 8, l = row & 255; const int m = (c * l) & 255;
            const float ang = (float)m * (2.0f / 256.0f); const float v = part == 0 ? cospif(ang) : -sinpif(ang); fc[i] = (bf16)f2bf(v * (1.0f / 16.0f)); }
        for (int i = gt; i < 256 * 256; i += NGT) { const int row = i >> 8, col = i & 255, pr = row >> 7, k1 = row & 127, pc = col >> 7, n1 = col & 127; const int m = (n1 * k1) & 127;
            const float ang = (float)m * (2.0f / 128.0f); const float cs = cospif(ang), sn = sinpif(ang);
            const float v = (pr == pc) ? cs : (pr == 0 ? sn : -sn); fa[i] = (bf16)f2bf(v * 0.08838834764831845f); }
        for (int i = gt; i < 256 * 256; i += NGT) { const int row = i >> 8, col = i & 255, pc = col >> 7, n2 = col & 127; float v = 0.f;
            if (row < 128) { const int m = (n2 * row) & 127; const float ang = (float)m * (2.0f / 128.0f); v = (pc == 0 ? cospif(ang) : sinpif(ang)) * 0.08838834764831845f; }
            fcc[i] = (bf16)f2bf(v); }
        for (int i = gt; i < 256 * 512; i += NGT) { const int k = i >> 9, col = i & 511, pc = col >> 8, n = col & 255; const int m = (n * k) & 255;
            const float ang = (float)m * (2.0f / 256.0f); fx[i] = (bf16)f2bf((pc == 0 ? cospif(ang) : sinpif(ang)) * (1.0f / 16.0f)); }
        for (int i = gt; i < 128 * 128; i += NGT) { const int k1 = i >> 7, n2 = i & 127; const float ang = (float)(k1 * n2) * (2.0f / 16384.0f); twc[i] = cospif(ang); tws[i] = sinpif(ang); }
        for (int i = gt; i < NLAT * 32; i += NGT) { const int t = i >> 5, j = i & 31; const float pos = (float)(j < 16 ? (t >> 6) : (t & 63));
            const float inv = powf(10000.0f, -(float)(j & 15) * (1.0f / 16.0f)); const float ang = pos * inv; float sn, cs; sincosf(ang, &sn, &cs); ropc[i] = cs; rops[i] = sn; }
        bf16* rw = (bf16*)(F.ws + WS_RW); const float* rwin = argp(I_RW);
        for (int i = gt; i < 4 * 32 * 1024; i += NGT) { const int L = i >> 15, e = (i >> 10) & 31, k = i & 1023; rw[i] = (bf16)f2bf(rwin[((size_t)L * 1024 + k) * 32 + e]); }
    }
    __syncthreads();
    {
        LAS float* scr = (LAS float*)(F.lds) + F.wave * (64 * 65);
        const int gw = F.vcu * NWAVES + F.wave, NGW = F.G * NWAVES;
        constexpr int I1 = 16 * 16, I2 = 16 * 24, I3 = 16 * 16, I4 = 16 * 64, I5 = 32 * 16, I6 = 16 * 20, I7 = 16 * 16, ISM = I1 + I2 + I3 + I4 + I5 + I6 + I7;
        constexpr int IGU = 16 * 32, IDN = 16 * 16, NITEMS = ISM + 128 * IGU + 128 * IDN;
        for (int it = gw; it < NITEMS; it += NGW) {
            int r = it;
            if (r < ISM) {
                if (r < I1) { p0_transpose_item(argp(I_FNW), 1024, 1024, (bf16*)(F.ws + WS_WFN), 0, scr, r, lane); continue; } r -= I1;
                if (r < I2) { p0_transpose_item(argp(I_FAWQ), 1024, FA_NQKV, (bf16*)(F.ws + WS_WFAQ), 1, scr, r, lane); continue; } r -= I2;
                if (r < I3) { p0_transpose_item(argp(I_FAWO), 1024, 1024, (bf16*)(F.ws + WS_WFAO), 0, scr, r, lane); continue; } r -= I3;
                if (r < I4) { p0_transpose_item(argp(I_GMWI), 1024, GM_FF, (bf16*)(F.ws + WS_WGI), 0, scr, r, lane); continue; } r -= I4;
                if (r < I5) { p0_transpose_item(argp(I_GMWO), 2048, 1024, (bf16*)(F.ws + WS_WGO), 0, scr, r, lane); continue; } r -= I5;
                if (r < I6) { p0_transpose_item(argp(I_WAWQ), 1024, WA_NQKV, (bf16*)(F.ws + WS_WWQ), 1, scr, r, lane); continue; } r -= I6;
                p0_transpose_item(argp(I_WAWO), 1024, 1024, (bf16*)(F.ws + WS_WWO), 0, scr, r, lane); continue;
            }
            r -= ISM;
            if (r < 128 * IGU) { const int le = r / IGU; p0_transpose_item(argp(I_EWGU) + (size_t)le * 1024 * 2048, 1024, 2048, (bf16*)(F.ws + WS_WEXP_GU) + (size_t)le * 2048 * 1024, 0, scr, r - le * IGU, lane); continue; }
            r -= 128 * IGU;
            { const int le = r / IDN; p0_transpose_item(argp(I_EWD) + (size_t)le * 1024 * 1024, 1024, 1024, (bf16*)(F.ws + WS_WEXP_DN) + (size_t)le * 1024 * 1024, 0, scr, r - le * IDN, lane); }
        }
    }
}

__device__ __forceinline__ void pass_init(Frame& F) { const int tid = otid(), lane = tid & 63; (void)tid; (void)lane;
    const int gw = F.vcu * NWAVES + F.wave, NGW = F.G * NWAVES;
    int cur_s = -1; RowV sc, sh;
    for (int m = gw; m < T; m += NGW) {
        const int s = m >= NLAT;
        if (s != cur_s) { cur_s = s; sh = ldrow(modp(F, 0, s, 0), lane); sc = ldrow(modp(F, 0, s, 1), lane); }
        const float* src = s ? argp(I_CTX) + (size_t)(m - NLAT) * DM : argp(I_X) + (size_t)m * DM;
        RowV x = ldrow(src, lane);
        strow((float*)(F.ws + WS_X) + (size_t)m * DM, lane, x);
        RowV h;
#pragma unroll
        for (int j = 0; j < 4; ++j) h.v[j] = x.v[j] * (1.f + sc.v[j]) + sh.v[j];
        strow_bf16((bf16*)(F.ws + WS_H) + (size_t)m * DM, lane, h);
    }
}

template <int L> __device__ __forceinline__ void pass_mix(Frame& F) { const int tid = otid(), lane = tid & 63; (void)tid; (void)lane;
    constexpr bool HAS_CTX = L < 3, MIX_ON = (EN_MIX >> L) & 1, MOE_ON = (EN_MOE >> L) & 1;
    constexpr int HP = 1032;
    LAS bf16* HT = (LAS bf16*)(F.lds);
    LAS float* PART = (LAS float*)(F.lds + 32 * HP * 2);
    LAS float* LOGT = PART + 8 * 32 * 33;
    volatile LAS unsigned* LC = F.MISC + MW_LC;
    float* X = (float*)(F.ws + WS_X); bf16* H = (bf16*)(F.ws + WS_H); const bf16* Y = (const bf16*)(F.ws + WS_Y);
    unsigned* ASG = (unsigned*)(F.ws + WS_ASG); float* GATE = (float*)(F.ws + WS_GATE);
    const bf16* RW = (const bf16*)(F.ws + WS_RW) + (size_t)L * 32 * 1024;
    if (tid < 32) LC[tid] = 0u;
    __syncthreads();
    const float* rbias = argp(I_RB);
    const int nlt = NLAT / 32, nct = HAS_CTX ? NCTX : 0;
    int cur_s = -1; RowV g1, lg, lb, sc2, sh2;
    for (int it = F.bx; it < nlt + nct; it += F.G) {
        const bool isl = it < nlt; const int s = isl ? 0 : 1; const int row0 = isl ? it * 32 : NLAT + (it - nlt); const int nrows = isl ? 32 : 1;
        if (s != cur_s) { cur_s = s; g1 = ldrow(modp(F, L, s, 2), lane); sh2 = ldrow(modp(F, L, s, 3), lane); sc2 = ldrow(modp(F, L, s, 4), lane);
            lg = ldrow(argp(I_LNMG) + L * DM, lane); lb = ldrow(argp(I_LNMB) + L * DM, lane); }
        for (int rr = F.wave * 4; rr < F.wave * 4 + 4 && rr < nrows; ++rr) {
            const int m = row0 + rr;
            RowV x = ldrow(X + (size_t)m * DM, lane);
            if (MIX_ON) { RowV y = ldrow_bf16(Y + (size_t)m * DM, lane);
#pragma unroll
                for (int j = 0; j < 4; ++j) x.v[j] = x.v[j] * DN_ALPHA + g1.v[j] * y.v[j]; }
            else {
#pragma unroll
                for (int j = 0; j < 4; ++j) x.v[j] = x.v[j] * DN_ALPHA; }
            x = ln_row(x, lg, lb);
            strow(X + (size_t)m * DM, lane, x);
            RowV h;
#pragma unroll
            for (int j = 0; j < 4; ++j) h.v[j] = x.v[j] * (1.f + sc2.v[j]) + sh2.v[j];
            strow_bf16(H + (size_t)m * DM, lane, h);
            if (MOE_ON) { LAS unsigned long long* q = (LAS unsigned long long*)(HT + rr * HP) + lane;
#pragma unroll
                for (int j = 0; j < 4; ++j) q[64 * j] = (unsigned long long)pk2(h.v[j].x, h.v[j].y) | ((unsigned long long)pk2(h.v[j].z, h.v[j].w) << 32); }
        }
        if (MOE_ON) {
            __syncthreads();
            { const int r32 = lane & 31, hi = lane >> 5; f32x16 acc = f32x16{};
#pragma unroll
                for (int st = 0; st < 8; ++st) { const int k = 128 * F.wave + 16 * st + 8 * hi;
                    const bf16x8 a = *(const LAS bf16x8*)(HT + r32 * HP + k); const bf16x8 b = *(const bf16x8*)(RW + (size_t)r32 * 1024 + k);
                    acc = __builtin_amdgcn_mfma_f32_32x32x16_bf16(a, b, acc, 0, 0, 0); }
#pragma unroll
                for (int r = 0; r < 16; ++r) { const int tok = (r & 3) + 8 * (r >> 2) + 4 * hi; PART[(F.wave * 32 + tok) * 33 + r32] = acc[r]; } }
            __syncthreads();
            { const int t = tid >> 4, e0 = tid & 15;
#pragma unroll
                for (int q = 0; q < 2; ++q) { const int e = e0 + 16 * q; float v = rbias[L * 32 + e];
#pragma unroll
                    for (int wv = 0; wv < 8; ++wv) v += PART[(wv * 32 + t) * 33 + e];
                    LOGT[t * 33 + e] = v; } }
            __syncthreads();
            if (tid < nrows) { const int t = tid; float lv[32];
#pragma unroll
                for (int e = 0; e < 32; ++e) lv[e] = LOGT[t * 33 + e];
                int idx[4]; float val[4]; unsigned taken = 0u;
#pragma unroll
                for (int k = 0; k < 4; ++k) { float best = -INFINITY; int bi = 0;
#pragma unroll
                    for (int e = 0; e < 32; ++e) { const bool ok = !((taken >> e) & 1u) && lv[e] > best; best = ok ? lv[e] : best; bi = ok ? e : bi; }
                    idx[k] = bi; val[k] = best; taken |= 1u << bi; }
                float ev[4], sum = 0.f;
#pragma unroll
                for (int k = 0; k < 4; ++k) { ev[k] = __expf(val[k] - val[0]); sum += ev[k]; }
                const float inv = 1.f / sum; const int m = row0 + t;
#pragma unroll
                for (int k = 0; k < 4; ++k) { const unsigned pos = atomicAdd((unsigned*)&LC[idx[k]], 1u); ASG[(size_t)m * 4 + k] = ((unsigned)idx[k] << 16) | pos; GATE[(size_t)m * 4 + k] = ev[k] * inv; } }
            __syncthreads();
        }
    }
    if (MOE_ON) { __syncthreads(); if (tid < 32) ((unsigned*)(F.ws + WS_LCNT))[F.bx * 32 + tid] = LC[tid]; }
}

__device__ __forceinline__ void moe_tables(Frame& F) { const int tid = otid(), lane = tid & 63; (void)tid; (void)lane;
    LAS unsigned* red = (LAS unsigned*)(F.lds);
    const unsigned* LCNT = (const unsigned*)(F.ws + WS_LCNT);
    { const int e = tid & 31, part = tid >> 5; unsigned tot = 0u, low = 0u;
        for (int w = part; w < F.G; w += 16) { const unsigned c = __hip_atomic_load(LCNT + w * 32 + e, RLX_AGENT); tot += c; low += (w < F.bx) ? c : 0u; }
        red[part * 32 + e] = tot; red[512 + part * 32 + e] = low; }
    __syncthreads();
    if (tid < 32) { unsigned tot = 0u, low = 0u;
#pragma unroll
        for (int p = 0; p < 16; ++p) { tot += red[p * 32 + tid]; low += red[512 + p * 32 + tid]; }
        red[1024 + tid] = tot; F.MISC[MW_MYBASE + tid] = low; }
    __syncthreads();
    if (tid == 0) { unsigned base = 0u, nmt = 0u;
        for (int e = 0; e < 32; ++e) { const unsigned tiles = (red[1024 + e] + 255u) >> 8; F.MISC[MW_EBASE + e] = base; for (unsigned q = 0; q < tiles; ++q) F.MISC[MW_MTE + nmt + q] = (unsigned)e; nmt += tiles; base += tiles * 256u; }
        F.MISC[MW_NMT] = nmt; }
    __syncthreads();
}
__device__ __forceinline__ void moe_gather(Frame& F, bool has_ctx) { const int tid = otid(), lane = tid & 63; (void)tid; (void)lane;
    moe_tables(F);
    const bf16* H = (const bf16*)(F.ws + WS_H); bf16* XS = (bf16*)(F.ws + WS_XS);
    const unsigned* ASG = (const unsigned*)(F.ws + WS_ASG); unsigned* SLOT = (unsigned*)(F.ws + WS_SLOT);
    const int nlt = NLAT / 32, nct = has_ctx ? NCTX : 0;
    for (int it = F.bx; it < nlt + nct; it += F.G) {
        const bool isl = it < nlt; const int row0 = isl ? it * 32 : NLAT + (it - nlt); const int nrows = isl ? 32 : 1;
        for (int rr = F.wave * 4; rr < F.wave * 4 + 4 && rr < nrows; ++rr) {
            const int m = row0 + rr;
            const v4u a = *(const v4u*)(ASG + (size_t)m * 4);
            unsigned sl[4];
#pragma unroll
            for (int k = 0; k < 4; ++k) { const unsigned e = a[k] >> 16, pos = a[k] & 0xffffu; sl[k] = F.MISC[MW_EBASE + e] + F.MISC[MW_MYBASE + e] + pos; }
            if (lane == 0) *(v4u*)(SLOT + (size_t)m * 4) = (v4u){sl[0], sl[1], sl[2], sl[3]};
            const v4u* src = (const v4u*)(H + (size_t)m * DM) + lane; const v4u h0 = src[0], h1 = src[64];
#pragma unroll
            for (int k = 0; k < 4; ++k) { v4u* dst = (v4u*)(XS + (size_t)sl[k] * DM) + lane; dst[0] = h0; dst[64] = h1; }
        }
    }
}
template <int L> __device__ __forceinline__ void pass_comb(Frame& F) { const int tid = otid(), lane = tid & 63; (void)tid; (void)lane;
    constexpr bool HAS_CTX = L < 3, MOE_ON = (EN_MOE >> L) & 1;
    const int gw = F.vcu * NWAVES + F.wave, NGW = F.G * NWAVES;
    float* X = (float*)(F.ws + WS_X); bf16* H = (bf16*)(F.ws + WS_H); const bf16* YS = (const bf16*)(F.ws + WS_YS);
    const unsigned* SLOT = (const unsigned*)(F.ws + WS_SLOT); const float* GATE = (const float*)(F.ws + WS_GATE);
    int cur_s = -1; RowV g2, lg, lb, sc, sh;
    for (int m = gw; m < (HAS_CTX ? T : NLAT); m += NGW) {
        const int s = m >= NLAT;
        if (s != cur_s) { cur_s = s; g2 = ldrow(modp(F, L, s, 5), lane); lg = ldrow(argp(I_LNFG) + L * DM, lane); lb = ldrow(argp(I_LNFB) + L * DM, lane);
            if (L < 3) { sh = ldrow(modp(F, L < 3 ? L + 1 : 0, s, 0), lane); sc = ldrow(modp(F, L < 3 ? L + 1 : 0, s, 1), lane); } }
        RowV x = ldrow(X + (size_t)m * DM, lane);
        if (MOE_ON) {
            const v4u sl = *(const v4u*)(SLOT + (size_t)m * 4); const f32x4 gt = *(const f32x4*)(GATE + (size_t)m * 4);
            RowV f;
#pragma unroll
            for (int j = 0; j < 4; ++j) f.v[j] = (f32x4){0.f, 0.f, 0.f, 0.f};
#pragma unroll
            for (int k = 0; k < 4; ++k) { const RowV y = ldrow_bf16(YS + (size_t)sl[k] * DM, lane);
#pragma unroll
                for (int j = 0; j < 4; ++j) f.v[j] += y.v[j] * gt[k]; }
#pragma unroll
            for (int j = 0; j < 4; ++j) x.v[j] = x.v[j] * DN_ALPHA + g2.v[j] * f.v[j];
        } else {
#pragma unroll
            for (int j = 0; j < 4; ++j) x.v[j] = x.v[j] * DN_ALPHA; }
        x = ln_row(x, lg, lb);
        if (L < 3) { strow(X + (size_t)m * DM, lane, x); RowV h;
#pragma unroll
            for (int j = 0; j < 4; ++j) h.v[j] = x.v[j] * (1.f + sc.v[j]) + sh.v[j];
            strow_bf16(H + (size_t)m * DM, lane, h); }
        else strow(((float*)argp(N_IN)) + (size_t)m * DM, lane, x);
    }
}
__device__ __forceinline__ void gate_phase(Frame& F) { const int tid = otid(), lane = tid & 63; (void)tid; (void)lane;
    constexpr int WP = 136, VP = 136;
    LAS bf16* WL = (LAS bf16*)(F.lds);
    LAS bf16* VT = (LAS bf16*)(F.lds + 128 * WP * 2);
    LAS float* STAT = (LAS float*)(F.lds + 128 * WP * 2 + 256 * VP * 2);
    const bf16* GU = (const bf16*)(F.ws + WS_GU); const bf16* GV = (const bf16*)(F.ws + WS_GV); bf16* GG = (bf16*)(F.ws + WS_GG);
    const float* ws_ = argp(I_GMWS); const float* bs_ = argp(I_GMBS); const float* vg = argp(I_GMVG); const float* vb = argp(I_GMVB);
    const int r32 = lane & 31, hi = lane >> 5;
    for (int uid = F.bx; uid < 2 * (T / 128); uid += F.G) {
        const int t0 = (uid >> 1) * 128, hf = uid & 1;
        for (int rr = 0; rr < 16; ++rr) { const int q = 16 * F.wave + rr; const v4u* src = (const v4u*)(GV + (size_t)(t0 + q) * GM_HALF) + lane;
            float x[32]; float s = 0.f;
#pragma unroll
            for (int j = 0; j < 4; ++j) { const v4u w = src[64 * j];
#pragma unroll
                for (int i = 0; i < 4; ++i) { x[8 * j + 2 * i] = bf_lo(w[i]); x[8 * j + 2 * i + 1] = bf_hi(w[i]); s += x[8 * j + 2 * i] + x[8 * j + 2 * i + 1]; } }
            const float mean = wave_sum(s) * (1.f / GM_HALF); float s2 = 0.f;
#pragma unroll
            for (int i = 0; i < 32; ++i) { const float d = x[i] - mean; s2 += d * d; }
            const float rstd = 1.f / sqrtf(wave_sum(s2) * (1.f / GM_HALF) + LN_EPS);
            if (lane == 0) { STAT[2 * q] = mean; STAT[2 * q + 1] = rstd; } }
        __syncthreads();
        for (int hh = 0; hh < 4; ++hh) { const int h = 4 * hf + hh;
            { const int p = tid >> 2, q0 = (tid & 3) * 32; const f32x4* src = (const f32x4*)(ws_ + ((size_t)h * 128 + p) * 128 + q0);
#pragma unroll
                for (int i = 0; i < 4; ++i) { const f32x4 a = src[2 * i], b = src[2 * i + 1]; v4u w; w.x = pk2(a[0], a[1]); w.y = pk2(a[2], a[3]); w.z = pk2(b[0], b[1]); w.w = pk2(b[2], b[3]);
                    *(LAS v4u*)(WL + p * WP + q0 + 8 * i) = w; } }
            { const int q = (F.wave & 1) * 64 + lane; const float mean = STAT[2 * q], rstd = STAT[2 * q + 1];
#pragma unroll
                for (int j = 0; j < 8; ++j) { const int c0 = ((F.wave >> 1) * 8 + j) * 8; const v4u w = *(const v4u*)(GV + (size_t)(t0 + q) * GM_HALF + h * 256 + c0);
                    const f32x4 g0 = *(const f32x4*)(vg + h * 256 + c0), g1 = *(const f32x4*)(vg + h * 256 + c0 + 4), b0 = *(const f32x4*)(vb + h * 256 + c0), b1 = *(const f32x4*)(vb + h * 256 + c0 + 4);
                    float x[8];
#pragma unroll
                    for (int i = 0; i < 4; ++i) { x[2 * i] = bf_lo(w[i]); x[2 * i + 1] = bf_hi(w[i]); }
#pragma unroll
                    for (int i = 0; i < 8; ++i) { const float gg = i < 4 ? g0[i & 3] : g1[i & 3], bb = i < 4 ? b0[i & 3] : b1[i & 3];
                        VT[(c0 + i) * VP + q] = (bf16)f2bf((x[i] - mean) * rstd * gg + bb); } } }
            __syncthreads();
            { const int wm = F.wave >> 2, wn = F.wave & 3; f32x16 acc[2][2];
#pragma unroll
                for (int i = 0; i < 2; ++i)
#pragma unroll
                    for (int jn = 0; jn < 2; ++jn) acc[i][jn] = f32x16{};
#pragma unroll
                for (int ks = 0; ks < 8; ++ks) { bf16x8 a[2], b[2];
#pragma unroll
                    for (int i = 0; i < 2; ++i) { a[i] = *(const LAS bf16x8*)(WL + (64 * wm + 32 * i + r32) * WP + 16 * ks + 8 * hi); b[i] = *(const LAS bf16x8*)(VT + (64 * wn + 32 * i + r32) * VP + 16 * ks + 8 * hi); }
#pragma unroll
                    for (int i = 0; i < 2; ++i)
#pragma unroll
                        for (int jn = 0; jn < 2; ++jn) acc[i][jn] = __builtin_amdgcn_mfma_f32_32x32x16_bf16(a[i], b[jn], acc[i][jn], 0, 0, 0); }
#pragma unroll
                for (int i = 0; i < 2; ++i)
#pragma unroll
                    for (int r = 0; r < 16; ++r) { const int p = 64 * wm + 32 * i + (r & 3) + 8 * (r >> 2) + 4 * hi; const float bias = bs_[h * 128 + p];
#pragma unroll
                        for (int jn = 0; jn < 2; ++jn) { const size_t off = (size_t)(t0 + p) * GM_HALF + h * 256 + 64 * wn + 32 * jn + r32;
                            const float uu = __builtin_bit_cast(float, (unsigned)GU[off] << 16); GG[off] = (bf16)f2bf(uu * (acc[i][jn][r] + bias)); } } }
            __syncthreads();
        }
    }
}

template <int MODE> __device__ __forceinline__ void attn_phase(Frame& F, char* lds_generic) {
    using abf = attn_body::bf16;
    const abf* Q = (const abf*)(F.ws + WS_Q); const abf* K = (const abf*)(F.ws + WS_K); const abf* V = (const abf*)(F.ws + WS_V); abf* O = (abf*)(F.ws + WS_Q);
    constexpr int U = 1024; const int per = (U + F.G - 1) / F.G;
    for (int i = 0; i <= per; ++i) {
        int h, kvh, q0, NT, kbase; float sink = 0.f;
        if (i < per) { const int id = F.vcu * per + i; if (id >= U) continue; const int x = id >> 7, r = id & 127; const int qb = (r >> 2) * 2 + (r & 1);
            q0 = 256 * qb;
            if (MODE == 0) { kvh = x >> 1; h = kvh * 4 + (x & 1) * 2 + ((r & 3) >> 1); NT = T / 64; kbase = 0; }
            else { h = 2 * x + ((r & 3) >> 1); kvh = h >> 3; const int ks = q0 >= 128 ? q0 - 128 : 0, ke = (q0 + 384) < NLAT ? (q0 + 384) : NLAT; kbase = ks; NT = 4 + (ke - ks) / 64; sink = argp(I_WASK)[h] * LOG2E; } }
        else { if (MODE != 0) continue; if ((F.vcu & 15) != 0 || (F.vcu >> 4) >= 16) continue; h = F.vcu >> 4; kvh = h >> 2; q0 = NLAT; NT = 4; kbase = NLAT; }
        attn_body::attn_unit<MODE, (MODE == 0 ? 256 : 128), 8>(h, kvh, q0, NT, kbase, sink, Q, K, V, O, lds_generic);
    }
}
struct Args { const float* in[N_IN]; float* out; unsigned char* ws; int ph_lo, ph_hi; };
static_assert(sizeof(Args) == N_IN * 8 + 8 + 8 + 8, "Args has no padding");

template <int ACT> __device__ __forceinline__ void tok_gemm(Frame& F, const bf16* A, const bf16* Bt, int N, int K, const pg8::EpiBf16<ACT>& E) {
    pg8::Gemm g{A, Bt, K, K, K, (unsigned)(128 * K * 2), (unsigned)(128 * K * 2)};
    TokOrder S; S.init(NPAN, N / 256, F.G, F.bx); S.apan = (size_t)256 * K * 2; S.bpan = (size_t)256 * K * 2;
    pg8::gemm_phase<pg8::EpiBf16<ACT>, TokOrder, true, true>(F.lds + RING_OFF, g, S, E);
}
template <int L> __device__ __forceinline__ void moe_up(Frame& F) {
    moe_tables(F);
    pg8::Gemm g{(const bf16*)(F.ws + WS_XS), (const bf16*)(F.ws + WS_WEXP_GU) + (size_t)L * 32 * 2048 * 1024, 1024, 1024, 1024, 128 * 1024 * 2, 128 * 1024 * 2};
    MoeOrder S; S.init((int)F.MISC[MW_NMT], 8, F.G, F.bx); S.mte = F.MISC + MW_MTE; S.bexp = (size_t)2048 * 1024 * 2;
    EpiSwiGLU E{(bf16*)(F.ws + WS_ACT), argp(I_EBGU) + (size_t)L * 32 * 2048};
    pg8::gemm_phase<EpiSwiGLU, MoeOrder, true, true>(F.lds + RING_OFF, g, S, E);
}
template <int L> __device__ __forceinline__ void moe_down(Frame& F) {
    moe_tables(F);
    pg8::Gemm g{(const bf16*)(F.ws + WS_ACT), (const bf16*)(F.ws + WS_WEXP_DN) + (size_t)L * 32 * 1024 * 1024, 1024, 1024, 1024, 128 * 1024 * 2, 128 * 1024 * 2};
    MoeOrder S; S.init((int)F.MISC[MW_NMT], 4, F.G, F.bx); S.mte = F.MISC + MW_MTE; S.bexp = (size_t)1024 * 1024 * 2;
    EpiDown E{(bf16*)(F.ws + WS_YS), argp(I_EBD) + (size_t)L * 32 * 1024};
    pg8::gemm_phase<EpiDown, MoeOrder, true, true>(F.lds + RING_OFF, g, S, E);
}

__global__ void __launch_bounds__(NTHR, 2) mk_fwd(Args args) {
    extern __shared__ __attribute__((aligned(16))) unsigned char lds[];
    Frame F;
    F.lds = (LAS unsigned char*)lds;
    F.MISC = (volatile LAS unsigned*)(F.lds + MISC_OFF);
    F.wave = __builtin_amdgcn_readfirstlane((int)threadIdx.x >> 6);
    F.G = gridDim.x; F.bx = blockIdx.x; F.vcu = (F.G % 8 == 0) ? (F.bx % 8) * (F.G / 8) + F.bx / 8 : F.bx;
    F.ws = args.ws; F.ctl = (gu32*)(args.ws + WS_CTL);
    for (int u = threadIdx.x; u < (LDS_BYTES - MISC_OFF) / 4; u += NTHR) ((LAS unsigned*)(F.lds + MISC_OFF))[u] = 0u;
    __syncthreads();
    XcdBarrier bar; bar.bar = (unsigned*)(F.ctl + CW_BAR); bar.x = 0; bar.st = nullptr;
    if (!MK_PER_PHASE) bar = xcd_barrier_post((unsigned*)(F.ctl + CW_BAR), F.MISC + MW_BAR);
    const int lo = args.ph_lo, hi = args.ph_hi;
#ifdef MK_ONLY
#define IN(k) ((k) == MK_ONLY && lo <= (k))
#else
#define IN(k) (lo <= (k) && (k) < hi)
#endif
#define SEAM(k) do { if (IN(k) && IN((k) + 1)) xcd_barrier(bar); } while (0)
    const bf16* Hb = (const bf16*)(F.ws + WS_H); bf16* Yb = (bf16*)(F.ws + WS_Y);

    if (IN(0)) { asm volatile("; MK_PHASE_0" ::: "memory"); p0_prologue(F); } SEAM(0);
    if (IN(1)) { asm volatile("; MK_PHASE_1" ::: "memory"); pass_init(F); } SEAM(1);
    if (IN(2)) { asm volatile("; MK_PHASE_2" ::: "memory"); if ((EN_MIX >> 0) & 1) {
        { pg8::Gemm g{(const bf16*)(F.ws + TB_FC), Hb, 256, 256, 128 * DM, 128 * 256 * 2, DM * 2};
          ChDftOrder S; S.init(2, 256, F.G, F.bx); EpiChDft E{(bf16*)(F.ws + WS_BTA)};
          pg8::gemm_phase<EpiChDft, ChDftOrder, true, true>(F.lds + RING_OFF, g, S, E); }
#ifndef NO_CTX_DFT
        { pg8::Gemm g{(const bf16*)(F.ws + TB_FC), Hb, 256, 256, DM, 128 * 256 * 2, 128 * DM * 2};
          ChDftCtxOrder S; S.init(2, 4, F.G, F.bx); EpiChDftCtx E{(bf16*)(F.ws + WS_BTX)};
          pg8::gemm_phase<EpiChDftCtx, ChDftCtxOrder, true, true>(F.lds + RING_OFF, g, S, E); }
#endif
        } } SEAM(2);
    if (IN(3)) { asm volatile("; MK_PHASE_3" ::: "memory"); if ((EN_MIX >> 0) & 1) {
        { pg8::Gemm g{(const bf16*)(F.ws + TB_FA), (const bf16*)(F.ws + WS_BTA), 256, 256, 256, 128 * 256 * 2, 128 * 256 * 2};
          TokOrder S; S.init(1, 512, F.G, F.bx); S.apan = 0; S.bpan = (size_t)256 * 256 * 2;
          EpiStepA E{(bf16*)(F.ws + WS_BTC), (const float*)(F.ws + TB_TWC), (const float*)(F.ws + TB_TWS)};
          pg8::gemm_phase<EpiStepA, TokOrder, true, true>(F.lds + RING_OFF, g, S, E); }
        } } SEAM(3);
    if (IN(4)) { asm volatile("; MK_PHASE_4" ::: "memory"); if ((EN_MIX >> 0) & 1) {
        { pg8::Gemm g{(const bf16*)(F.ws + TB_FCC), (const bf16*)(F.ws + WS_BTC), 256, 256, 256, 128 * 256 * 2, 128 * 256 * 2};
        TokOrder S; S.init(1, 512, F.G, F.bx); S.apan = 0; S.bpan = (size_t)256 * 256 * 2;
        EpiStepC E{(bf16*)(F.ws + WS_MIXB)};
        pg8::gemm_phase<EpiStepC, TokOrder, true, true>(F.lds + RING_OFF, g, S, E); }
#ifndef NO_CTX_DFT
        { pg8::Gemm g{(const bf16*)(F.ws + TB_FX), (const bf16*)(F.ws + WS_BTX), 512, 512, 512, 128 * 512 * 2, 128 * 512 * 2};
          TokOrder S; S.init(1, 4, F.G, F.bx); S.apan = 0; S.bpan = (size_t)256 * 512 * 2;
          EpiCtxPos E{(bf16*)(F.ws + WS_MIXB)};
          pg8::gemm_phase<EpiCtxPos, TokOrder, true, true>(F.lds + RING_OFF, g, S, E); }
#endif
        } } SEAM(4);
    if (IN(5)) { asm volatile("; MK_PHASE_5" ::: "memory"); if ((EN_MIX >> 0) & 1) { pg8::EpiBf16<0> E{Yb, DM, argp(I_FNB), 0, 0, 1.f}; tok_gemm<0>(F, (const bf16*)(F.ws + WS_MIXB), (const bf16*)(F.ws + WS_WFN), DM, DM, E); } } SEAM(5);
    if (IN(6)) { asm volatile("; MK_PHASE_6" ::: "memory"); pass_mix<0>(F); } SEAM(6);
    if (IN(7)) { asm volatile("; MK_PHASE_7" ::: "memory"); if ((EN_MOE >> 0) & 1) moe_gather(F, true); } SEAM(7);
    if (IN(8)) { asm volatile("; MK_PHASE_8" ::: "memory"); if ((EN_MOE >> 0) & 1) moe_up<0>(F); } SEAM(8);
    if (IN(9)) { asm volatile("; MK_PHASE_9" ::: "memory"); if ((EN_MOE >> 0) & 1) moe_down<0>(F); } SEAM(9);
    if (IN(10)) { asm volatile("; MK_PHASE_10" ::: "memory"); pass_comb<0>(F); } SEAM(10);
    if (IN(11)) { asm volatile("; MK_PHASE_11" ::: "memory"); if ((EN_MIX >> 1) & 1) {
        pg8::Gemm g{Hb, (const bf16*)(F.ws + WS_WFAQ), DM, DM, DM, 128 * DM * 2, 128 * DM * 2};
        TokOrder S; S.init(NPAN, FA_NQKV / 256, F.G, F.bx); S.apan = (size_t)256 * DM * 2; S.bpan = (size_t)256 * DM * 2;
        EpiQKV<4, true> E{(bf16*)(F.ws + WS_Q), (bf16*)(F.ws + WS_K), (bf16*)(F.ws + WS_V), argp(I_FABQ), argp(I_FAQN), argp(I_FAKN), (const float*)(F.ws + TB_ROPC), (const float*)(F.ws + TB_ROPS)};
        pg8::gemm_phase<EpiQKV<4, true>, TokOrder, true, true>(F.lds + RING_OFF, g, S, E); } } SEAM(11);
    if (IN(12)) { asm volatile("; MK_PHASE_12" ::: "memory"); if ((EN_MIX >> 1) & 1) attn_phase<0>(F, (char*)lds + RING_OFF); } SEAM(12);
    if (IN(13)) { asm volatile("; MK_PHASE_13" ::: "memory"); if ((EN_MIX >> 1) & 1) { pg8::EpiBf16<0> E{Yb, DM, argp(I_FABO), 0, 0, 1.f}; tok_gemm<0>(F, (const bf16*)(F.ws + WS_Q), (const bf16*)(F.ws + WS_WFAO), DM, DM, E); } } SEAM(13);
    if (IN(14)) { asm volatile("; MK_PHASE_14" ::: "memory"); pass_mix<1>(F); } SEAM(14);
    if (IN(15)) { asm volatile("; MK_PHASE_15" ::: "memory"); if ((EN_MOE >> 1) & 1) moe_gather(F, true); } SEAM(15);
    if (IN(16)) { asm volatile("; MK_PHASE_16" ::: "memory"); if ((EN_MOE >> 1) & 1) moe_up<1>(F); } SEAM(16);
    if (IN(17)) { asm volatile("; MK_PHASE_17" ::: "memory"); if ((EN_MOE >> 1) & 1) moe_down<1>(F); } SEAM(17);
    if (IN(18)) { asm volatile("; MK_PHASE_18" ::: "memory"); pass_comb<1>(F); } SEAM(18);
    if (IN(19)) { asm volatile("; MK_PHASE_19" ::: "memory"); if ((EN_MIX >> 2) & 1) { pg8::EpiBf16<1> E{(bf16*)(F.ws + WS_GU), GM_HALF, argp(I_GMBI), GM_HALF, (size_t)(WS_GV - WS_GU) / 2, 1.f};
        tok_gemm<1>(F, Hb, (const bf16*)(F.ws + WS_WGI), GM_FF, DM, E); } } SEAM(19);
    if (IN(20)) { asm volatile("; MK_PHASE_20" ::: "memory"); if ((EN_MIX >> 2) & 1) gate_phase(F); } SEAM(20);
    if (IN(21)) { asm volatile("; MK_PHASE_21" ::: "memory"); if ((EN_MIX >> 2) & 1) { pg8::EpiBf16<0> E{Yb, DM, argp(I_GMBO), 0, 0, 1.f}; tok_gemm<0>(F, (const bf16*)(F.ws + WS_GG), (const bf16*)(F.ws + WS_WGO), DM, GM_HALF, E); } } SEAM(21);
    if (IN(22)) { asm volatile("; MK_PHASE_22" ::: "memory"); pass_mix<2>(F); } SEAM(22);
    if (IN(23)) { asm volatile("; MK_PHASE_23" ::: "memory"); if ((EN_MOE >> 2) & 1) moe_gather(F, true); } SEAM(23);
    if (IN(24)) { asm volatile("; MK_PHASE_24" ::: "memory"); if ((EN_MOE >> 2) & 1) moe_up<2>(F); } SEAM(24);
    if (IN(25)) { asm volatile("; MK_PHASE_25" ::: "memory"); if ((EN_MOE >> 2) & 1) moe_down<2>(F); } SEAM(25);
    if (IN(26)) { asm volatile("; MK_PHASE_26" ::: "memory"); pass_comb<2>(F); } SEAM(26);
    if (IN(27)) { asm volatile("; MK_PHASE_27" ::: "memory"); if ((EN_MIX >> 3) & 1) {
        pg8::Gemm g{Hb, (const bf16*)(F.ws + WS_WWQ), DM, DM, DM, 128 * DM * 2, 128 * DM * 2};
        TokOrder S; S.init(NPAN, WA_NQKV / 256, F.G, F.bx); S.apan = (size_t)256 * DM * 2; S.bpan = (size_t)256 * DM * 2;
        EpiQKV<2, false> E{(bf16*)(F.ws + WS_Q), (bf16*)(F.ws + WS_K), (bf16*)(F.ws + WS_V), argp(I_WABQ), nullptr, nullptr, (const float*)(F.ws + TB_ROPC), (const float*)(F.ws + TB_ROPS)};
        pg8::gemm_phase<EpiQKV<2, false>, TokOrder, true, true>(F.lds + RING_OFF, g, S, E); } } SEAM(27);
    if (IN(28)) { asm volatile("; MK_PHASE_28" ::: "memory"); if ((EN_MIX >> 3) & 1) attn_phase<1>(F, (char*)lds + RING_OFF); } SEAM(28);
    if (IN(29)) { asm volatile("; MK_PHASE_29" ::: "memory"); if ((EN_MIX >> 3) & 1) { pg8::EpiBf16<0> E{Yb, DM, argp(I_WABO), 0, 0, 1.f}; tok_gemm<0>(F, (const bf16*)(F.ws + WS_Q), (const bf16*)(F.ws + WS_WWO), DM, DM, E); } } SEAM(29);
    if (IN(30)) { asm volatile("; MK_PHASE_30" ::: "memory"); pass_mix<3>(F); } SEAM(30);
    if (IN(31)) { asm volatile("; MK_PHASE_31" ::: "memory"); if ((EN_MOE >> 3) & 1) moe_gather(F, false); } SEAM(31);
    if (IN(32)) { asm volatile("; MK_PHASE_32" ::: "memory"); if ((EN_MOE >> 3) & 1) moe_up<3>(F); } SEAM(32);
    if (IN(33)) { asm volatile("; MK_PHASE_33" ::: "memory"); if ((EN_MOE >> 3) & 1) moe_down<3>(F); } SEAM(33);
    if (IN(34)) { asm volatile("; MK_PHASE_34" ::: "memory"); pass_comb<3>(F); }
#undef IN
#undef SEAM
}

extern "C" void kernel_launch(void* const* d_in, const int* in_sizes, int n_in, void* d_out, int out_size, void* d_ws, size_t ws_size, hipStream_t stream) {
    static int grid = 0;
    if (grid == 0) {
        if (n_in != N_IN || in_sizes[0] != NLAT * DM || out_size != NLAT * DM || ws_size < WS_END) { fprintf(stderr, "kernel_launch: unexpected shapes (n_in %d, in0 %d, out %d, ws %zu)\n", n_in, n_in > 0 ? in_sizes[0] : -1, out_size, ws_size); grid = -1; return; }
        int dev = 0, cus = 0, per_cu = 0;
        if (hipGetDevice(&dev) != hipSuccess || hipDeviceGetAttribute(&cus, hipDeviceAttributeMultiprocessorCount, dev) != hipSuccess) { grid = -1; return; }
        if (hipFuncSetAttribute((const void*)mk_fwd, hipFuncAttributeMaxDynamicSharedMemorySize, LDS_BYTES) != hipSuccess) { fprintf(stderr, "kernel_launch: hipFuncSetAttribute failed\n"); grid = -1; return; }
        if (hipOccupancyMaxActiveBlocksPerMultiprocessor(&per_cu, (const void*)mk_fwd, NTHR, LDS_BYTES) != hipSuccess || per_cu < 1) fprintf(stderr, "kernel_launch: occupancy query says %d\n", per_cu);
        (void)hipGetLastError();
        grid = cus;
    }
    if (grid < 0) return;
    if (hipMemsetAsync((char*)d_ws + WS_CTL, 0, CTL_ZERO_BYTES, stream) != hipSuccess) return;
    Args a{};
    for (int i = 0; i < N_IN; ++i) a.in[i] = (const float*)d_in[i];
    a.out = (float*)d_out; a.ws = (unsigned char*)d_ws;
#if MK_PER_PHASE
    for (int p = 0; p < NPHASE; ++p) { a.ph_lo = p; a.ph_hi = p + 1; hipLaunchKernelGGL(mk_fwd, dim3(grid), dim3(NTHR), LDS_BYTES, stream, a); }
#else
    a.ph_lo = 0; a.ph_hi = NPHASE; hipLaunchKernelGGL(mk_fwd, dim3(grid), dim3(NTHR), LDS_BYTES, stream, a);
#endif
}
```

```cpp
#define MK_PER_PHASE 0
#define EN_MIX 15
#define EN_MOE 15
#include <hip/hip_runtime.h>
#include <hip/hip_bf16.h>
#include <cstdio>
#include <cstdint>
#include <cmath>
#ifndef MK_PER_PHASE
#define MK_PER_PHASE 0
#endif
namespace pg8 {
#define PG8_LAS __attribute__((address_space(3)))
typedef unsigned short bf16_t;
typedef short bf16x8 __attribute__((ext_vector_type(8)));
typedef float f32x4 __attribute__((ext_vector_type(4)));
typedef float f32x2 __attribute__((ext_vector_type(2)));
typedef unsigned u32x4 __attribute__((ext_vector_type(4)));
typedef unsigned u32x2 __attribute__((ext_vector_type(2)));
constexpr int BM = 256, BK = 64, HALF = 128, HTB = HALF * BK * 2  , STAGE_BYTES = 8 * HTB, NXCD = 8, WGM = 2;

__host__ __device__ __forceinline__ int lds_byte(int r, int c) { const int st = (r >> 4) * 2 + (c >> 5), rr = r & 15, cc = c & 31, ob = rr * 64 + cc * 2; return st * 1024 + (ob ^ (((ob >> 9) & 1) << 5)); }
__host__ __device__ __forceinline__ void stage_rc(int b, int& R, int& C) { const int st = b / 1024, sb = b % 1024, swz = sb ^ (((sb >> 9) & 1) << 5); R = (st >> 1) * 16 + swz / 64; C = (st & 1) * 32 + (swz % 64) / 2; }
__host__ __device__ __forceinline__ int perm32(int rho) { const int n = rho >> 4, i = rho & 15; return 8 * (i >> 2) + 4 * n + (i & 3); }

struct Unit { int pm, pn, e; };
struct Gemm { const bf16_t* A; const bf16_t* Bt; int K, lda, ldb; unsigned hstepA, hstepB; };

struct GridOrder {
    int nM, nN, nwg, G, c, wgm;
    __device__ __forceinline__ void init(int nM_, int nN_, int G_, int c_, int wgm_ = WGM) { nM = nM_; nN = nN_; nwg = nM * nN; G = G_; c = c_; wgm = wgm_; }
    __device__ __forceinline__ bool next_mn(int i, int& pm, int& pn) const {
        const long L = (long)i * G + c; if (L >= nwg) return false;
        int wgid = (int)L; { const int q = nwg / NXCD, r = nwg % NXCD, xcd = wgid % NXCD, off = wgid / NXCD; wgid = (xcd < r ? xcd * (q + 1) : r * (q + 1) + (xcd - r) * q) + off; }
        const int nig = wgm * nN, gid = wgid / nig, fm = gid * wgm, gsz = (nM - fm) < wgm ? (nM - fm) : wgm;
        pm = fm + ((wgid % nig) % gsz); pn = (wgid % nig) / gsz; return true;
    }
};
__device__ __forceinline__ unsigned cvt_pk_bf16(float lo, float hi) { unsigned r; asm volatile("v_cvt_pk_bf16_f32 %0, %1, %2" : "=v"(r) : "v"(lo), "v"(hi)); return r; }
__device__ __forceinline__ f32x2 gelu_pk(f32x2 v) {
    const f32x2 av = __builtin_elementwise_abs(v), d = av * 0.2316418882f + 1.0f;
    f32x2 t; t.x = __builtin_amdgcn_rcpf(d.x); t.y = __builtin_amdgcn_rcpf(d.y);
    f32x2 q = t * 0.5307027145f + (-0.7265760135f); q = q * t + 0.7107068705f; q = q * t + (-0.142248368f); q = q * t + 0.127414796f; q = q * t;
    const f32x2 s = (v * v) * (-0.72134752044f);
    f32x2 e; e.x = __builtin_amdgcn_exp2f(s.x); e.y = __builtin_amdgcn_exp2f(s.y);
    const f32x2 m = v * (q * e), r = v - m;
    f32x2 o; o.x = v.x < 0.f ? m.x : r.x; o.y = v.y < 0.f ? m.y : r.y; return o;
}

template <int ACT  > struct EpiBf16 {
    static constexpr bool PERM = true, AFTER_DRAIN = false; static_assert(ACT == 0 || ACT == 1, "EpiBf16: ACT is 0 (none) or 1 (gelu_pk)");
    bf16_t* O; int ldc; const float* bias; int split_cols; size_t split_stride; float scale0;
    __device__ __forceinline__ void operator()(const f32x4 (&acc)[2][2][4][2], const Unit& u, int wr, int wc, int fr, int fq) const {
        const int row0 = u.pm * BM + wr * 64 + fr; int colt = u.pn * BM; bf16_t* base = O;
        float sc = 1.f; if (split_cols) { const int t = colt / split_cols; base += (size_t)t * split_stride; colt -= t * split_cols; if (t == 0) sc = scale0; }
        const int col0 = colt + wc * 32 + 8 * fq, bcol0 = u.pn * BM + wc * 32 + 8 * fq;
        f32x4 bv[2][2];
#pragma unroll
        for (int bj = 0; bj < 2; ++bj)
#pragma unroll
            for (int n = 0; n < 2; ++n) bv[bj][n] = bias ? *(const f32x4*)(bias + bcol0 + bj * HALF + 4 * n) : (f32x4){0.f, 0.f, 0.f, 0.f};
#pragma unroll
        for (int ai = 0; ai < 2; ++ai)
#pragma unroll
            for (int m = 0; m < 4; ++m) { bf16_t* rowp = base + (size_t)(row0 + ai * HALF + m * 16) * ldc + col0;
#pragma unroll
                for (int bj = 0; bj < 2; ++bj) { f32x4 v0 = acc[ai][bj][m][0] + bv[bj][0], v1 = acc[ai][bj][m][1] + bv[bj][1];
                    if (ACT == 1) { f32x2 a = gelu_pk((f32x2){v0[0], v0[1]}), b = gelu_pk((f32x2){v0[2], v0[3]}), c = gelu_pk((f32x2){v1[0], v1[1]}), d = gelu_pk((f32x2){v1[2], v1[3]});
                        v0 = (f32x4){a.x, a.y, b.x, b.y}; v1 = (f32x4){c.x, c.y, d.x, d.y}; }
                    v0 = v0 * sc; v1 = v1 * sc; u32x4 w; w.x = cvt_pk_bf16(v0[0], v0[1]); w.y = cvt_pk_bf16(v0[2], v0[3]); w.z = cvt_pk_bf16(v1[0], v1[1]); w.w = cvt_pk_bf16(v1[2], v1[3]);
                    *(u32x4*)(rowp + bj * HALF) = w; } }
    }
};
typedef int v8i_t __attribute__((ext_vector_type(8))); typedef int v4i_t __attribute__((ext_vector_type(4)));
template <class Epi, class Sched, bool ALIGN_EPI = false, bool SP2 = false, bool GATHER = false, bool F8 = false>
__device__ __forceinline__ void gemm_phase(PG8_LAS unsigned char* lds, const Gemm g, const Sched& S, const Epi& E) {
    int tid_ = threadIdx.x; asm volatile("" : "+v"(tid_));
    const int tid = tid_, wid = __builtin_amdgcn_readfirstlane(tid >> 6), lane = tid & 63, wr = wid >> 2, wc = wid & 3, fr = lane & 15, fq = lane >> 4;
    const int K = g.K; int nt = K / BK; if constexpr (F8) asm volatile("" : "+s"(nt));
    unsigned voffA[2], voffB[2];
#pragma unroll
    for (int i = 0; i < 2; ++i) { int R, C; stage_rc(tid * 16 + i * 8192, R, C); const int Rb = Epi::PERM ? ((R & ~31) + perm32(R & 31)) : R;
        voffA[i] = (unsigned)(R * g.lda + C) * 2u; voffB[i] = (unsigned)(Rb * g.ldb + C) * 2u; }
    const size_t kstep = (size_t)(BK * 2);
    const size_t hstepA = g.hstepA, hstepB = g.hstepB;
    const unsigned ldsw = (unsigned)wid * 1024u;
    const int aoff = lds_byte(wr * 64 + fr, fq * 8), boff = lds_byte(wc * 32 + fr, fq * 8);
#define PG8_SA(b, h) (((b) * 2 + (h)) * HTB)
#define PG8_SB(b, h) ((4 + (b) * 2 + (h)) * HTB)
#define PG8_STAGE(bufoff, gbase, voff) do { _Pragma("unroll") for (int _i = 0; _i < 2; ++_i) { unsigned _vo = (voff)[_i]; asm volatile("" : "+v"(_vo));     \
        __builtin_amdgcn_global_load_lds((const unsigned*)((const char*)(gbase) + _vo), (PG8_LAS unsigned*)(lds + (bufoff) + ldsw + _i * 8192), 16, 0, 0); } } while (0)
#define PG8_CAT8(x, y) __builtin_shufflevector(__builtin_bit_cast(v4i_t, x), __builtin_bit_cast(v4i_t, y), 0, 1, 2, 3, 4, 5, 6, 7)
#define PG8_LDA(dst, b, h) do { _Pragma("unroll") for (int m = 0; m < 4; ++m) { const bf16x8 f0_ = *(const PG8_LAS bf16x8*)(lds + PG8_SA(b, h) + aoff + m * 2048), f1_ = *(const PG8_LAS bf16x8*)(lds + PG8_SA(b, h) + aoff + m * 2048 + 1024); \
        if constexpr (F8) dst##8[m] = PG8_CAT8(f0_, f1_); else { dst[m][0] = f0_; dst[m][1] = f1_; } } } while (0)
#define PG8_LDB(dst, b, h) do { _Pragma("unroll") for (int n = 0; n < 2; ++n) { const bf16x8 f0_ = *(const PG8_LAS bf16x8*)(lds + PG8_SB(b, h) + boff + n * 2048), f1_ = *(const PG8_LAS bf16x8*)(lds + PG8_SB(b, h) + boff + n * 2048 + 1024); \
        if constexpr (F8) dst##8[n] = PG8_CAT8(f0_, f1_); else { dst[n][0] = f0_; dst[n][1] = f1_; } } } while (0)
#define PG8_MMA(ai, bj, At, Bt) do { __builtin_amdgcn_s_setprio(1); _Pragma("unroll") for (int m = 0; m < 4; ++m) _Pragma("unroll") for (int n = 0; n < 2; ++n) { \
        if constexpr (F8) asm volatile("v_mfma_scale_f32_16x16x128_f8f6f4 %0, %1, %2, %0, %3, %3 op_sel_hi:[0,0,0]" : "+v"(acc[ai][bj][m][n]) : "v"(Bt##8[n]), "v"(At##8[m]), "v"(f8scale));   \
        else { _Pragma("unroll") for (int k = 0; k < 2; ++k) acc[ai][bj][m][n] = __builtin_amdgcn_mfma_f32_16x16x32_bf16(Bt[n][k], At[m][k], acc[ai][bj][m][n], 0, 0, 0); } } __builtin_amdgcn_s_setprio(0); } while (0)
#define PG8_WAIT_V(n) asm volatile("s_waitcnt vmcnt(" #n ")" ::: "memory")
#define PG8_WAIT_L(n) asm volatile("s_waitcnt lgkmcnt(" #n ")" ::: "memory")
#define PG8_BAR __builtin_amdgcn_s_barrier()
#define PG8_SCHED __builtin_amdgcn_sched_barrier(0)
    Unit cur, nxt; int ui = 0;
    if (!S.next(0, cur)) return;
    f32x4 acc[2][2][4][2];
#pragma unroll
    for (int a = 0; a < 2; ++a)
#pragma unroll
        for (int b = 0; b < 2; ++b)
#pragma unroll
            for (int m = 0; m < 4; ++m)
#pragma unroll
                for (int n = 0; n < 2; ++n) acc[a][b][m][n] = (f32x4){0.f, 0.f, 0.f, 0.f};
    const int f8scale = 0x7F7F7F7F;
    bf16x8 At[4][2], B0[2][2], B1[2][2]; v8i_t At8[4], B08[2], B18[2];
    const char* cA = (const char*)g.A + S.offA(cur); const char* cB = (const char*)g.Bt + S.offB(cur);
    unsigned va0[2], va1[2], vn0[2], vn1[2];
#define PG8_AOFFS(dst0, dst1, unit) do { _Pragma("unroll") for (int i = 0; i < 2; ++i) { if constexpr (GATHER) { int R, C; stage_rc(tid * 16 + i * 8192, R, C); \
        dst0[i] = S.rowoff(unit, R) + (unsigned)C * 2u; dst1[i] = S.rowoff(unit, R + HALF) + (unsigned)C * 2u; } else { dst0[i] = voffA[i]; dst1[i] = voffA[i] + (unsigned)hstepA; } } } while (0)
    PG8_AOFFS(va0, va1, cur);
    S.a_ready(cur);
    if constexpr (SP2) {
        PG8_STAGE(PG8_SB(0, 0), cB, voffB); PG8_STAGE(PG8_SB(0, 1), cB + hstepB, voffB); PG8_STAGE(PG8_SA(0, 0), cA, va0); PG8_STAGE(PG8_SA(0, 1), cA, va1);
        if (wr == 1) PG8_BAR;
        PG8_WAIT_V(2); PG8_BAR;
        PG8_STAGE(PG8_SB(1, 0), cB + kstep, voffB); PG8_STAGE(PG8_SA(1, 0), cA + kstep, va0); PG8_STAGE(PG8_SB(1, 1), cB + hstepB + kstep, voffB);
        PG8_WAIT_V(6); PG8_BAR;
    } else {
        PG8_STAGE(PG8_SB(0, 0), cB, voffB); PG8_STAGE(PG8_SA(0, 0), cA, va0); PG8_STAGE(PG8_SB(0, 1), cB + hstepB, voffB); PG8_STAGE(PG8_SA(0, 1), cA, va1);
        if (wr == 1) PG8_BAR;
        PG8_WAIT_V(4); PG8_BAR;
        PG8_STAGE(PG8_SB(1, 0), cB + kstep, voffB); PG8_STAGE(PG8_SA(1, 0), cA + kstep, va0); PG8_STAGE(PG8_SB(1, 1), cB + hstepB + kstep, voffB);
        PG8_WAIT_V(6); PG8_BAR;
    }
    for (;;) {
        const bool has_next = S.next(ui + 1, nxt);
        if (GATHER && has_next) PG8_AOFFS(vn0, vn1, nxt); else { vn0[0] = va0[0]; vn0[1] = va0[1]; vn1[0] = va1[0]; vn1[1] = va1[1]; }
        const char* nA = has_next ? (const char*)g.A + S.offA(nxt) : cA; const char* nB = has_next ? (const char*)g.Bt + S.offB(nxt) : cB;
        for (int t = 0; t < nt; t += 2) {
            const bool last = (t == nt - 2);
            const unsigned vs0[2] = {last ? vn0[0] : va0[0], last ? vn0[1] : va0[1]}, vs1[2] = {last ? vn1[0] : va1[0], last ? vn1[1] : va1[1]};
            const char* a1 = cA + (size_t)(t + 1) * kstep;
            const char* a2 = last ? nA : cA + (size_t)(t + 2) * kstep; const char* b2 = last ? nB : cB + (size_t)(t + 2) * kstep;
            const char* a3 = a2 + kstep; const char* b3 = b2 + kstep;
            if (last && has_next) S.a_ready(nxt);
            if constexpr (SP2) {
            PG8_LDB(B0, 0, 0); PG8_LDB(B1, 0, 1); PG8_SCHED; PG8_LDA(At, 0, 0); PG8_STAGE(PG8_SA(1, 1), a1, va1);
            PG8_WAIT_V(8); PG8_WAIT_L(0); PG8_BAR; PG8_MMA(0, 0, At, B0); PG8_MMA(0, 1, At, B1); PG8_BAR; PG8_SCHED;
            PG8_LDA(At, 0, 1); PG8_STAGE(PG8_SB(0, 0), b2, voffB); PG8_STAGE(PG8_SB(0, 1), b2 + hstepB, voffB); PG8_STAGE(PG8_SA(0, 0), a2, vs0);
            PG8_WAIT_V(8); PG8_WAIT_L(0); PG8_BAR; PG8_MMA(1, 0, At, B0); PG8_MMA(1, 1, At, B1); PG8_BAR; PG8_SCHED;
            PG8_LDB(B0, 1, 0); PG8_LDB(B1, 1, 1); PG8_SCHED; PG8_LDA(At, 1, 0); PG8_STAGE(PG8_SA(0, 1), a2, vs1);
            PG8_WAIT_V(8); PG8_WAIT_L(0); PG8_BAR; PG8_MMA(0, 0, At, B0); PG8_MMA(0, 1, At, B1); PG8_BAR; PG8_SCHED;
            PG8_LDA(At, 1, 1); PG8_STAGE(PG8_SB(1, 0), b3, voffB); PG8_STAGE(PG8_SB(1, 1), b3 + hstepB, voffB); PG8_STAGE(PG8_SA(1, 0), a3, vs0);
            PG8_WAIT_V(8); PG8_WAIT_L(0); PG8_BAR; PG8_MMA(1, 0, At, B0); PG8_MMA(1, 1, At, B1); PG8_BAR; PG8_SCHED;
            } else {
            PG8_LDB(B0, 0, 0); PG8_SCHED; PG8_LDA(At, 0, 0); PG8_STAGE(PG8_SA(1, 1), a1, va1);
            PG8_WAIT_L(8); PG8_BAR; PG8_WAIT_L(0); PG8_MMA(0, 0, At, B0); PG8_BAR; PG8_SCHED;
            PG8_LDB(B1, 0, 1); PG8_STAGE(PG8_SB(0, 0), b2, voffB);
            PG8_BAR; PG8_WAIT_L(0); PG8_MMA(0, 1, At, B1); PG8_BAR;
            PG8_LDA(At, 0, 1); PG8_STAGE(PG8_SA(0, 0), a2, vs0);
            PG8_BAR; PG8_WAIT_L(0); PG8_MMA(1, 0, At, B0); PG8_BAR; PG8_SCHED;
            PG8_STAGE(PG8_SB(0, 1), b2 + hstepB, voffB);
            PG8_WAIT_V(6); PG8_BAR; PG8_MMA(1, 1, At, B1); PG8_BAR;
            PG8_LDB(B0, 1, 0); PG8_SCHED; PG8_LDA(At, 1, 0); PG8_STAGE(PG8_SA(0, 1), a2, vs1);
            PG8_WAIT_L(8); PG8_BAR; PG8_WAIT_L(0); PG8_MMA(0, 0, At, B0); PG8_BAR; PG8_SCHED;
            PG8_LDB(B1, 1, 1); PG8_STAGE(PG8_SB(1, 0), b3, voffB);
            PG8_BAR; PG8_WAIT_L(0); PG8_MMA(0, 1, At, B1); PG8_BAR;
            PG8_LDA(At, 1, 1); PG8_STAGE(PG8_SA(1, 0), a3, vs0);
            PG8_BAR; PG8_WAIT_L(0); PG8_MMA(1, 0, At, B0); PG8_BAR; PG8_SCHED;
            PG8_STAGE(PG8_SB(1, 1), b3 + hstepB, voffB);
            PG8_WAIT_V(6); PG8_BAR; PG8_MMA(1, 1, At, B1); PG8_BAR;
            }
        }
        if constexpr (ALIGN_EPI) { if (wr == 0) PG8_BAR; }
        if constexpr (F8) asm volatile("s_nop 15\n\ts_nop 7" ::: "memory");
        if constexpr (!Epi::AFTER_DRAIN) { E(acc, cur, wr, wc, fr, fq); S.done(cur); }
        if (!has_next) break;
#pragma unroll
        for (int a = 0; a < 2; ++a)
#pragma unroll
            for (int b = 0; b < 2; ++b)
#pragma unroll
                for (int m = 0; m < 4; ++m)
#pragma unroll
                    for (int n = 0; n < 2; ++n) acc[a][b][m][n] = (f32x4){0.f, 0.f, 0.f, 0.f};
        cur = nxt; cA = nA; cB = nB; ++ui; va0[0] = vn0[0]; va0[1] = vn0[1]; va1[0] = vn1[0]; va1[1] = vn1[1];
        if constexpr (ALIGN_EPI) { if (wr == 1) PG8_BAR; }
    }
    PG8_WAIT_V(0);
    if constexpr (!ALIGN_EPI) { if (wr == 0) PG8_BAR; }
    PG8_BAR;
    if constexpr (Epi::AFTER_DRAIN) { E.fused(acc, cur, wr, wc, fr, fq, lds, wid, lane); S.done(cur); }
#undef PG8_SA
#undef PG8_AOFFS
#undef PG8_SB
#undef PG8_STAGE
#undef PG8_LDA
#undef PG8_LDB
#undef PG8_MMA
#undef PG8_CAT8
#undef PG8_WAIT_V
#undef PG8_WAIT_L
#undef PG8_BAR
#undef PG8_SCHED
}
}
namespace attn_body {
using bf16=__hip_bfloat16;
using bf16x8=__attribute__((ext_vector_type(8)))short;
using s16x4=__attribute__((ext_vector_type(4)))short;
using f32x16=__attribute__((ext_vector_type(16)))float;
using u32x4=__attribute__((ext_vector_type(4)))unsigned;
constexpr int D=64,QP=1024;
constexpr int NW=8,QBLK=32,QB=QBLK*NW,KVBLK=64;
__device__ __forceinline__ void wmask(f32x16&p0,f32x16&p1,int t,int kstart,int qabs,int hi){
  if(t<4)return; const float NEG=-INFINITY; const int kb=kstart+64*(t-4)+4*hi-qabs;
  #pragma unroll
  for(int r=0;r<16;++r){const int dk=kb+(r&3)+8*(r>>2); if(dk>128||dk<-128)p0[r]=NEG; if(dk+32>128||dk+32<-128)p1[r]=NEG;}
}
__device__ __forceinline__ int crow(int r,int hi){return (r&3)+8*(r>>2)+4*hi;}
#define SBAR() __builtin_amdgcn_sched_barrier(0)
__device__ __forceinline__ void cmask(f32x16&p0,f32x16&p1,int jb,int qrel,int hi){
  const float NEG=-INFINITY; int kb=64*jb+4*hi;
  #pragma unroll
  for(int r=0;r<16;++r){int kv=kb+(r&3)+8*(r>>2); if(kv>qrel)p0[r]=NEG; if(kv+32>qrel)p1[r]=NEG;}
}

constexpr int NSLOT=3, SLOTB=8192;
constexpr int LDS_K=0, LDS_V=NSLOT*SLOTB, LDS_WS=2*NSLOT*SLOTB, LDS_OST=LDS_WS+NW*64*4, LDS_BYTES=LDS_OST+NW*4096;
constexpr float C2=0.125f*1.4426950408889634f;
__device__ __forceinline__ void glds16(const void*gsrc,unsigned lds_dst){unsigned keep;
  asm volatile("s_mov_b32 %0, m0\n\ts_mov_b32 m0, %2\n\ts_nop 0\n\tglobal_load_lds_dwordx4 %1, off\n\ts_mov_b32 m0, %0":"=&s"(keep):"v"(gsrc),"s"(lds_dst):"memory");}
__device__ __forceinline__ float max3f(float a,float b,float c){float r;asm("v_max3_f32 %0, %1, %2, %3":"=v"(r):"v"(a),"v"(b),"v"(c));return r;}
__device__ __forceinline__ float max2f(float a,float b){float r;asm("v_max_f32_e32 %0, %1, %2":"=v"(r):"v"(a),"v"(b));return r;}
__device__ __forceinline__ float fadd_s(float a,float b){float r;asm("v_add_f32_e32 %0, %1, %2":"=v"(r):"v"(a),"v"(b));return r;}
__device__ __forceinline__ float fsub_s(float a,float b){float r;asm("v_sub_f32_e32 %0, %1, %2":"=v"(r):"v"(a),"v"(b));return r;}
typedef float f32x2_t __attribute__((ext_vector_type(2))); typedef __bf16 bf16x2_t __attribute__((ext_vector_type(2)));
__device__ __forceinline__ unsigned cvtpk_s(float lo,float hi){f32x2_t v={lo,hi};bf16x2_t b=__builtin_convertvector(v,bf16x2_t);return __builtin_bit_cast(unsigned,b);}
#define WAIT_BAR(N) asm volatile("s_waitcnt vmcnt(" #N ") lgkmcnt(0)\n\ts_barrier":::"memory")

__device__ __forceinline__ void qkt(f32x16&p0,f32x16&p1,const char*Kslot,const bf16x8*qr,const f32x16&negm,int r32,int hi){
  const char*kb=Kslot+hi*1024+r32*16;
  #pragma unroll
  for(int d0=0;d0<4;++d0){
    const bf16x8 b0=*reinterpret_cast<const bf16x8*>(kb+d0*2048);
    const bf16x8 b1=*reinterpret_cast<const bf16x8*>(kb+d0*2048+512);
    if(d0==0){p0=__builtin_amdgcn_mfma_f32_32x32x16_bf16(b0,qr[0],negm,0,0,0);p1=__builtin_amdgcn_mfma_f32_32x32x16_bf16(b1,qr[0],negm,0,0,0);}
    else{p0=__builtin_amdgcn_mfma_f32_32x32x16_bf16(b0,qr[d0],p0,0,0,0);p1=__builtin_amdgcn_mfma_f32_32x32x16_bf16(b1,qr[d0],p1,0,0,0);}}
}
typedef __attribute__((address_space(3))) const char* lds_cptr;
typedef short v4i16_t __attribute__((ext_vector_type(4)));
__device__ __forceinline__ void kload8(bf16x8*kf,lds_cptr kp){
  kf[0]=*(const __attribute__((address_space(3))) bf16x8*)(kp);      kf[1]=*(const __attribute__((address_space(3))) bf16x8*)(kp+512);
  kf[2]=*(const __attribute__((address_space(3))) bf16x8*)(kp+2048); kf[3]=*(const __attribute__((address_space(3))) bf16x8*)(kp+2560);
  kf[4]=*(const __attribute__((address_space(3))) bf16x8*)(kp+4096); kf[5]=*(const __attribute__((address_space(3))) bf16x8*)(kp+4608);
  kf[6]=*(const __attribute__((address_space(3))) bf16x8*)(kp+6144); kf[7]=*(const __attribute__((address_space(3))) bf16x8*)(kp+6656);
}
__device__ __forceinline__ void kload2(bf16x8*kf,lds_cptr kp,int j){ kf[2*j]=*(const __attribute__((address_space(3))) bf16x8*)(kp+j*2048); kf[2*j+1]=*(const __attribute__((address_space(3))) bf16x8*)(kp+j*2048+512); }
__device__ __forceinline__ s16x4 vtr(lds_cptr p){ return __builtin_bit_cast(s16x4,__builtin_amdgcn_ds_read_tr16_b64_v4i16((__attribute__((address_space(3))) v4i16_t*)p)); }
__device__ __forceinline__ float rowmax(const f32x16&p0,const f32x16&p1){
  float a=max3f(p0[0],p0[1],p1[0]),b=max3f(p0[2],p0[3],p1[1]);a=max3f(a,p1[2],p1[3]);
  #pragma unroll
  for(int r=4;r<16;r+=4){a=max3f(a,p0[r],p0[r+1]);b=max3f(b,p0[r+2],p0[r+3]);a=max3f(a,p1[r],p1[r+1]);b=max3f(b,p1[r+2],p1[r+3]);}
  const float m=max2f(a,b);
  auto rr=__builtin_amdgcn_permlane32_swap(__float_as_uint(m),__float_as_uint(m),false,false);
  return max2f(__uint_as_float(rr[0]),__uint_as_float(rr[1]));
}
__device__ __forceinline__ void pv(f32x16*o,int vb,bf16x8 pa0,bf16x8 pa1,bf16x8 pa2,bf16x8 pa3){
  #pragma unroll
  for(int d0=0;d0<2;++d0){s16x4 lo[4],hi[4];
    #pragma unroll
    for(int ks=0;ks<4;++ks){
      asm volatile("ds_read_b64_tr_b16 %0,%1 offset:%c2":"=&v"(lo[ks]):"v"(vb),"i"(d0*4096+ks*1024):"memory");
      asm volatile("ds_read_b64_tr_b16 %0,%1 offset:%c2":"=&v"(hi[ks]):"v"(vb),"i"(d0*4096+ks*1024+512):"memory");}
    asm volatile("s_waitcnt lgkmcnt(0)":::"memory");SBAR();
    #define PK(k) (bf16x8){lo[k][0],lo[k][1],lo[k][2],lo[k][3],hi[k][0],hi[k][1],hi[k][2],hi[k][3]}
    o[d0]=__builtin_amdgcn_mfma_f32_32x32x16_bf16(pa0,PK(0),o[d0],0,0,0);
    o[d0]=__builtin_amdgcn_mfma_f32_32x32x16_bf16(pa1,PK(1),o[d0],0,0,0);
    o[d0]=__builtin_amdgcn_mfma_f32_32x32x16_bf16(pa2,PK(2),o[d0],0,0,0);
    o[d0]=__builtin_amdgcn_mfma_f32_32x32x16_bf16(pa3,PK(3),o[d0],0,0,0);
    #undef PK
  }
}

#ifndef ATTN_STORE16
#define ATTN_STORE16(p,v) (*(u32x4*)(p)=(v))
#endif
template<int MODE,int KP,int THRL> __device__ __forceinline__ void attn_unit(int h,int kvh,int q0,int NT,int kbase,float sink_l2,const bf16*Q,const bf16*__restrict__ K,const bf16*__restrict__ V,bf16*O,char*shm){
  int tid_=threadIdx.x; asm volatile("":"+v"(tid_)); const int tid=tid_,lane=tid&63,r32=lane&31,hi=lane>>5; const int wid=__builtin_amdgcn_readfirstlane(tid>>6);
  #define TROW(t) (MODE==0 ? (kbase+64*(t)) : ((t)<4 ? 16384+64*(t) : kbase+64*((t)-4)))
  const bf16*Qw=Q+(long)(q0+wid*QBLK)*QP+h*D;
  const bf16*Kh=K+kvh*D,*Vh=V+kvh*D;
  const unsigned lds0=(unsigned)(uintptr_t)shm;
  float*wsf=(float*)(shm+LDS_WS)+wid*64;
  const bf16*ksrc=Kh+(long)lane*KP+wid*8;
  const bf16*vsrc=Vh+(long)(16*(wid&3)+(lane>>2))*KP+(wid>>2)*32+(lane&3)*8;
  const unsigned kdst=lds0+LDS_K+wid*1024, vdst=lds0+LDS_V+wid*1024;
  #define DMA_K(t,slot) glds16(ksrc+(long)TROW(t)*KP,(unsigned)__builtin_amdgcn_readfirstlane(kdst+(slot)))
  #define DMA_V(t,slot) glds16(vsrc+(long)TROW(t)*KP,(unsigned)__builtin_amdgcn_readfirstlane(vdst+(slot)))
  const int vb0=(int)(lds0+LDS_V)+((lane>>4)&1)*32+(lane&3)*8+(4*hi+((lane&15)>>2))*64;
  const char*Kbase=shm+LDS_K; bf16x8 kf[8];
  const lds_cptr shm3=(lds_cptr)shm; const lds_cptr kp0=shm3+LDS_K+hi*1024+r32*16; const lds_cptr vp0=shm3+LDS_V+((lane>>4)&1)*32+(lane&3)*8+(4*hi+((lane&15)>>2))*64;
  DMA_K(0,0);DMA_V(0,0);DMA_K(1,SLOTB);
  bf16x8 qr[4];
  #pragma unroll
  for(int d0=0;d0<4;++d0)qr[d0]=*reinterpret_cast<const bf16x8*>(&Qw[(long)r32*QP+d0*16+hi*8]);
  float mhat=0.f,l_reg=0.f;f32x16 o[2];o[0]=f32x16{};o[1]=f32x16{};f32x16 negm=f32x16{};asm volatile("":"+v"(negm));
  const int qabs=q0+wid*QBLK+r32;
  #define CMASK(P0,P1,t) do{ if(MODE==1) wmask(P0,P1,(t),kbase,qabs,hi); }while(0)
  bool resc=false;
  #define START(P0,P1) do{ const float rm=rowmax(P0,P1); resc=false; \
    { const float dl=rm; mhat=fadd_s(mhat,dl); \
      _Pragma("unroll") for(int r=0;r<16;++r){P0[r]=fsub_s(P0[r],dl);P1[r]=fsub_s(P1[r],dl);} \
      _Pragma("unroll") for(int r=0;r<16;++r)negm[r]=-mhat; asm volatile("":"+v"(negm)); } \
    _Pragma("unroll") for(int r=0;r<16;++r)P0[r]=__builtin_amdgcn_exp2f(P0[r]); }while(0)
  #define RESC() do{ if(resc){ asm volatile("s_waitcnt lgkmcnt(0)":::"memory"); \
      _Pragma("unroll") for(int d_=0;d_<2;++d_) _Pragma("unroll") for(int r=0;r<16;++r)o[d_][r]*=wsf[crow(r,hi)]; } }while(0)
  f32x16 pA0,pA1,pB0,pB1;
  int sl_prev=0,sl_cur=0,sl_next=SLOTB;
  #define ROT() do{sl_prev=sl_cur;sl_cur=sl_next;sl_next=(sl_next==(NSLOT-1)*SLOTB)?0:sl_next+SLOTB;}while(0)
  DMA_K(2,2*SLOTB);
  WAIT_BAR(3);
  qkt(pA0,pA1,Kbase,qr,negm,r32,hi);asm volatile("s_nop 15\n\ts_nop 7":"+v"(pA0),"+v"(pA1));CMASK(pA0,pA1,0);
  START(pA0,pA1);
  _Pragma("unroll") for(int r=0;r<16;++r)pA1[r]=__builtin_amdgcn_exp2f(pA1[r]);
  WAIT_BAR(0);
  DMA_K(3,0);DMA_V(1,SLOTB);
  ROT();
  kload8(kf,kp0+sl_cur);
  WAIT_BAR(2);
  s16x4 vlo[8],vhi[8]; u32x4 pw0,pw1,pw2,pw3;
  #define PKW(P,B) cvtpk_s(P[B],P[B+1])
  #define PAF(k) __builtin_bit_cast(bf16x8,pw##k)
  #define VFR(i) (bf16x8){vlo[i][0],vlo[i][1],vlo[i][2],vlo[i][3],vhi[i][0],vhi[i][1],vhi[i][2],vhi[i][3]}
  #define PIN(x) asm volatile("":"+v"(x))
  #define MX3(a,b,c) __builtin_fmaxf(__builtin_fmaxf((a),(b)),(c))
  #define GAPA(MF,A0,A1,A2,A3,W0,W1,PW) do{ MF; sacc+=A0; sacc+=A1; sacc+=A2; sacc+=A3; PIN(sacc); W0; W1; PIN(PW); SBAR(); }while(0)
  #define EX(v) __builtin_amdgcn_exp2f(v)
  #define GAPB(MF,X,B) do{ MF; X[B]=EX(X[B]); X[B+1]=EX(X[B+1]); X[B+2]=EX(X[B+2]); X[B+3]=EX(X[B+3]); PIN(X); SBAR(); }while(0)
  #define VRD(i) do{ vlo[i]=vtr(vp_+(((i)>>2)*4096+((i)&3)*1024)); vhi[i]=vtr(vp_+(((i)>>2)*4096+((i)&3)*1024+512)); }while(0)
  #define KRD(G,j) do{ if(G){ kload2(kf,kp0+sl_next,j); SBAR(); } }while(0)
  #define STEP(C0,C1,P0,P1,t,GK,GV,GL) do{ SBAR(); \
    const lds_cptr vp_=vp0+sl_prev; \
    VRD(0); SBAR(); float sacc=(P0[0]+P0[1]); \
    GAPA(C0=__builtin_amdgcn_mfma_f32_32x32x16_bf16(kf[0],qr[0],negm,0,0,0), P0[2],P0[3],P0[4],P0[5],     pw0[0]=PKW(P0,0), pw0[1]=PKW(P0,2), pw0); \
    VRD(4); SBAR(); GAPA(C1=__builtin_amdgcn_mfma_f32_32x32x16_bf16(kf[1],qr[0],negm,0,0,0), P0[6],P0[7],P0[8],P0[9],     pw0[2]=PKW(P0,4), pw0[3]=PKW(P0,6), pw0); \
    VRD(1); SBAR(); GAPA(C0=__builtin_amdgcn_mfma_f32_32x32x16_bf16(kf[2],qr[1],C0,0,0,0),   P0[10],P0[11],P0[12],P0[13], pw1[0]=PKW(P0,8), pw1[1]=PKW(P0,10), pw1); \
    VRD(5); SBAR(); GAPA(C1=__builtin_amdgcn_mfma_f32_32x32x16_bf16(kf[3],qr[1],C1,0,0,0),   P0[14],P0[15],P1[0],P1[1],   pw1[2]=PKW(P0,12),pw1[3]=PKW(P0,14), pw1); \
    VRD(2); SBAR(); GAPA(C0=__builtin_amdgcn_mfma_f32_32x32x16_bf16(kf[4],qr[2],C0,0,0,0),   P1[2],P1[3],P1[4],P1[5],     pw2[0]=PKW(P1,0), pw2[1]=PKW(P1,2), pw2); \
    VRD(6); SBAR(); GAPA(C1=__builtin_amdgcn_mfma_f32_32x32x16_bf16(kf[5],qr[2],C1,0,0,0),   P1[6],P1[7],P1[8],P1[9],     pw2[2]=PKW(P1,4), pw2[3]=PKW(P1,6), pw2); \
    VRD(3); SBAR(); GAPA(C0=__builtin_amdgcn_mfma_f32_32x32x16_bf16(kf[6],qr[3],C0,0,0,0),   P1[10],P1[11],P1[12],P1[13], pw3[0]=PKW(P1,8), pw3[1]=PKW(P1,10), pw3); \
    VRD(7); SBAR(); GAPA(C1=__builtin_amdgcn_mfma_f32_32x32x16_bf16(kf[7],qr[3],C1,0,0,0),   P1[14],P1[15],0.f,0.f,       pw3[2]=PKW(P1,12),pw3[3]=PKW(P1,14), pw3); \
    l_reg+=sacc; \
    if(GK){DMA_K((t)+3,sl_cur);} if(GV){DMA_V((t)+1,sl_next);} \
    CMASK(C0,C1,t); \
    { float a=MX3(C0[0],C0[1],C1[0]),b=MX3(C0[2],C0[3],C1[1]); a=MX3(a,C1[2],C1[3]); \
      _Pragma("unroll") for(int r=4;r<16;r+=4){a=MX3(a,C0[r],C0[r+1]);b=MX3(b,C0[r+2],C0[r+3]);a=MX3(a,C1[r],C1[r+1]);b=MX3(b,C1[r+2],C1[r+3]);} \
      float rm=__builtin_fmaxf(a,b); { auto rr=__builtin_amdgcn_permlane32_swap(__float_as_uint(rm),__float_as_uint(rm),false,false); rm=__builtin_fmaxf(__uint_as_float(rr[0]),__uint_as_float(rr[1])); } \
      resc=false; \
      if(__builtin_expect(__any(rm>(float)THRL),0)){ const float dl=__builtin_fmaxf(rm,0.f); mhat+=dl; \
        _Pragma("unroll") for(int r=0;r<16;++r){C0[r]-=dl;C1[r]-=dl;} \
        _Pragma("unroll") for(int r=0;r<16;++r)negm[r]=-mhat; asm volatile("":"+v"(negm)); \
        const float f=__builtin_amdgcn_exp2f(-dl); l_reg*=f; if(hi==0)wsf[r32]=f; resc=true; } } \
    SBAR(); \
    GAPB(o[0]=__builtin_amdgcn_mfma_f32_32x32x16_bf16(PAF(0),VFR(0),o[0],0,0,0), C0,0); \
    GAPB(o[1]=__builtin_amdgcn_mfma_f32_32x32x16_bf16(PAF(0),VFR(4),o[1],0,0,0), C0,4); \
    KRD(GL,0); GAPB(o[0]=__builtin_amdgcn_mfma_f32_32x32x16_bf16(PAF(1),VFR(1),o[0],0,0,0), C0,8); \
    KRD(GL,1); GAPB(o[1]=__builtin_amdgcn_mfma_f32_32x32x16_bf16(PAF(1),VFR(5),o[1],0,0,0), C0,12); \
    KRD(GL,2); GAPB(o[0]=__builtin_amdgcn_mfma_f32_32x32x16_bf16(PAF(2),VFR(2),o[0],0,0,0), C1,0); \
    KRD(GL,3); GAPB(o[1]=__builtin_amdgcn_mfma_f32_32x32x16_bf16(PAF(2),VFR(6),o[1],0,0,0), C1,4); \
    GAPB(o[0]=__builtin_amdgcn_mfma_f32_32x32x16_bf16(PAF(3),VFR(3),o[0],0,0,0), C1,8); \
    GAPB(o[1]=__builtin_amdgcn_mfma_f32_32x32x16_bf16(PAF(3),VFR(7),o[1],0,0,0), C1,12); \
    }while(0)
  int t=1;
  #undef CMASK
  #define CMASK(P0,P1,t) do{}while(0)
  if constexpr(MODE==0)
  for(;t+5<NT;t+=2){
    STEP(pB0,pB1,pA0,pA1,t,true,true,true);     WAIT_BAR(2); RESC(); ROT();
    STEP(pA0,pA1,pB0,pB1,t+1,true,true,true);   WAIT_BAR(2); RESC(); ROT();
  }
  #undef CMASK
  #define CMASK(P0,P1,t) do{ if(MODE==1) wmask(P0,P1,(t),kbase,qabs,hi); }while(0)
  #define ENDW(tt) do{ if((tt)+3<NT){WAIT_BAR(2);} else if((tt)+2<NT){WAIT_BAR(1);} else {WAIT_BAR(0);} }while(0)
  for(;t+1<NT;t+=2){
    STEP(pB0,pB1,pA0,pA1,t,(t+3<NT),(t+1<NT),(t+1<NT));       ENDW(t);   RESC(); ROT();
    STEP(pA0,pA1,pB0,pB1,t+1,(t+4<NT),(t+2<NT),(t+2<NT));     ENDW(t+1); RESC(); ROT();
  }
  STEP(pB0,pB1,pA0,pA1,NT-1,false,false,false); RESC();
  { float sacc=pB0[0]+pB0[1]; _Pragma("unroll") for(int r=2;r<16;++r)sacc+=pB0[r]; _Pragma("unroll") for(int r=0;r<16;++r)sacc+=pB1[r]; l_reg+=sacc;
    pw0=(u32x4){PKW(pB0,0),PKW(pB0,2),PKW(pB0,4),PKW(pB0,6)};pw1=(u32x4){PKW(pB0,8),PKW(pB0,10),PKW(pB0,12),PKW(pB0,14)};pw2=(u32x4){PKW(pB1,0),PKW(pB1,2),PKW(pB1,4),PKW(pB1,6)};pw3=(u32x4){PKW(pB1,8),PKW(pB1,10),PKW(pB1,12),PKW(pB1,14)};
    SBAR(); pv(o,vb0+sl_cur,PAF(0),PAF(1),PAF(2),PAF(3)); }
  #undef PKW
  #undef PAF
  #undef VFR
  #undef PIN
  #undef MX3
  #undef GAPA
  #undef GAPB
  #undef EX
  #undef VRD
  #undef KRD
  #undef STEP
  #undef ENDW
  {auto rr=__builtin_amdgcn_permlane32_swap(__float_as_uint(l_reg),__float_as_uint(l_reg),false,false);l_reg=__uint_as_float(rr[0])+__uint_as_float(rr[1]);}
  if(MODE==1)l_reg+=__builtin_amdgcn_exp2f(sink_l2-mhat);
  if(hi==0)wsf[32+r32]=l_reg;asm volatile("s_waitcnt lgkmcnt(0)":::"memory");
  float rli[16];
  #pragma unroll
  for(int r=0;r<16;++r)rli[r]=__builtin_amdgcn_rcpf(wsf[32+crow(r,hi)]);
  bf16*Ow=O+(long)(q0+wid*QBLK)*QP+h*D;
  { bf16*stg=(bf16*)(shm+LDS_OST)+wid*2048;
    #pragma unroll
    for(int r=0;r<16;++r){const int orow=crow(r,hi);
      #pragma unroll
      for(int d0=0;d0<2;++d0)stg[orow*64+d0*32+r32]=__float2bfloat16(o[d0][r]*rli[r]);}
    asm volatile("s_waitcnt lgkmcnt(0)":::"memory");
    #pragma unroll
    for(int i=0;i<4;++i){const int row=i*8+(lane>>3),ch=lane&7; const u32x4 v=*(const u32x4*)(stg+row*64+ch*8); ATTN_STORE16(Ow+(long)row*QP+ch*8,v);} }
  asm volatile("s_waitcnt lgkmcnt(0)\n\ts_barrier":::"memory");
  #undef DMA_K
  #undef DMA_V
  #undef CMASK
  #undef TROW
  #undef START
  #undef RESC
  #undef ROT
}
template<int KP> __device__ __forceinline__ void attn_unit_s(int h,int kvh,int q0,int NT,int kbase,float mstat,const bf16*Q,const bf16*__restrict__ K,const bf16*__restrict__ V,bf16*O,char*shm){
  int tid_=threadIdx.x; asm volatile("":"+v"(tid_)); const int tid=tid_,lane=tid&63,r32=lane&31,hi=lane>>5; const int wid=__builtin_amdgcn_readfirstlane(tid>>6);
  #define TROW(t) (kbase+64*(t))
  const bf16*Qw=Q+(long)(q0+wid*QBLK)*QP+h*D;
  const bf16*Kh=K+kvh*D,*Vh=V+kvh*D;
  const unsigned lds0=(unsigned)(uintptr_t)shm;
  float*wsf=(float*)(shm+LDS_WS)+wid*64;
  const bf16*ksrc=Kh+(long)lane*KP+wid*8;
  const bf16*vsrc=Vh+(long)(16*(wid&3)+(lane>>2))*KP+(wid>>2)*32+(lane&3)*8;
  const unsigned kdst=lds0+LDS_K+wid*1024, vdst=lds0+LDS_V+wid*1024;
  #define DMA_K(t,slot) glds16(ksrc+(long)TROW(t)*KP,(unsigned)__builtin_amdgcn_readfirstlane(kdst+(slot)))
  #define DMA_V(t,slot) glds16(vsrc+(long)TROW(t)*KP,(unsigned)__builtin_amdgcn_readfirstlane(vdst+(slot)))
  const int vb0=(int)(lds0+LDS_V)+((lane>>4)&1)*32+(lane&3)*8+(4*hi+((lane&15)>>2))*64;
  const char*Kbase=shm+LDS_K; bf16x8 kf[8];
  const lds_cptr shm3=(lds_cptr)shm; const lds_cptr kp0=shm3+LDS_K+hi*1024+r32*16; const lds_cptr vp0=shm3+LDS_V+((lane>>4)&1)*32+(lane&3)*8+(4*hi+((lane&15)>>2))*64;
  DMA_K(0,0);DMA_V(0,0);DMA_K(1,SLOTB);
  bf16x8 qr[4];
  #pragma unroll
  for(int d0=0;d0<4;++d0)qr[d0]=*reinterpret_cast<const bf16x8*>(&Qw[(long)r32*QP+d0*16+hi*8]);
  float l_reg=0.f;f32x16 o[2];o[0]=f32x16{};o[1]=f32x16{};f32x16 negm;
  #pragma unroll
  for(int r=0;r<16;++r)negm[r]=-mstat;
  asm volatile("":"+v"(negm));
  #define CMASK(P0,P1,t) do{}while(0)
  #define START(P0,P1) do{ _Pragma("unroll") for(int r=0;r<16;++r)P0[r]=__builtin_amdgcn_exp2f(P0[r]); }while(0)
  #define RESC() do{}while(0)
  f32x16 pA0,pA1,pB0,pB1;
  int sl_prev=0,sl_cur=0,sl_next=SLOTB;
  #define ROT() do{sl_prev=sl_cur;sl_cur=sl_next;sl_next=(sl_next==(NSLOT-1)*SLOTB)?0:sl_next+SLOTB;}while(0)
  DMA_K(2,2*SLOTB);
  WAIT_BAR(3);
  qkt(pA0,pA1,Kbase,qr,negm,r32,hi);asm volatile("s_nop 15\n\ts_nop 7":"+v"(pA0),"+v"(pA1));CMASK(pA0,pA1,0);
  START(pA0,pA1);
  _Pragma("unroll") for(int r=0;r<16;++r)pA1[r]=__builtin_amdgcn_exp2f(pA1[r]);
  WAIT_BAR(0);
  DMA_K(3,0);DMA_V(1,SLOTB);
  ROT();
  kload8(kf,kp0+sl_cur);
  WAIT_BAR(2);
  s16x4 vlo[8],vhi[8]; u32x4 pw0,pw1,pw2,pw3;
  #define PKW(P,B) cvtpk_s(P[B],P[B+1])
  #define PAF(k) __builtin_bit_cast(bf16x8,pw##k)
  #define VFR(i) (bf16x8){vlo[i][0],vlo[i][1],vlo[i][2],vlo[i][3],vhi[i][0],vhi[i][1],vhi[i][2],vhi[i][3]}
  #define PIN(x) asm volatile("":"+v"(x))
  #define MX3(a,b,c) __builtin_fmaxf(__builtin_fmaxf((a),(b)),(c))
  #define GAPA(MF,A0,A1,A2,A3,W0,W1,PW) do{ MF; sacc+=A0; sacc+=A1; sacc+=A2; sacc+=A3; PIN(sacc); W0; W1; PIN(PW); SBAR(); }while(0)
  #define EX(v) __builtin_amdgcn_exp2f(v)
  #define GAPB(MF,X,B) do{ MF; X[B]=EX(X[B]); X[B+1]=EX(X[B+1]); X[B+2]=EX(X[B+2]); X[B+3]=EX(X[B+3]); PIN(X); SBAR(); }while(0)
  #define VRD(i) do{ vlo[i]=vtr(vp_+(((i)>>2)*4096+((i)&3)*1024)); vhi[i]=vtr(vp_+(((i)>>2)*4096+((i)&3)*1024+512)); }while(0)
  #define KRD(G,j) do{ if(G){ kload2(kf,kp0+sl_next,j); SBAR(); } }while(0)
  #define STEP(C0,C1,P0,P1,t,GK,GV,GL) do{ SBAR(); \
    const lds_cptr vp_=vp0+sl_prev; \
    VRD(0); SBAR(); float sacc=(P0[0]+P0[1]); \
    GAPA(C0=__builtin_amdgcn_mfma_f32_32x32x16_bf16(kf[0],qr[0],negm,0,0,0), P0[2],P0[3],P0[4],P0[5],     pw0[0]=PKW(P0,0), pw0[1]=PKW(P0,2), pw0); \
    VRD(4); SBAR(); GAPA(C1=__builtin_amdgcn_mfma_f32_32x32x16_bf16(kf[1],qr[0],negm,0,0,0), P0[6],P0[7],P0[8],P0[9],     pw0[2]=PKW(P0,4), pw0[3]=PKW(P0,6), pw0); \
    VRD(1); SBAR(); GAPA(C0=__builtin_amdgcn_mfma_f32_32x32x16_bf16(kf[2],qr[1],C0,0,0,0),   P0[10],P0[11],P0[12],P0[13], pw1[0]=PKW(P0,8), pw1[1]=PKW(P0,10), pw1); \
    VRD(5); SBAR(); GAPA(C1=__builtin_amdgcn_mfma_f32_32x32x16_bf16(kf[3],qr[1],C1,0,0,0),   P0[14],P0[15],P1[0],P1[1],   pw1[2]=PKW(P0,12),pw1[3]=PKW(P0,14), pw1); \
    VRD(2); SBAR(); GAPA(C0=__builtin_amdgcn_mfma_f32_32x32x16_bf16(kf[4],qr[2],C0,0,0,0),   P1[2],P1[3],P1[4],P1[5],     pw2[0]=PKW(P1,0), pw2[1]=PKW(P1,2), pw2); \
    VRD(6); SBAR(); GAPA(C1=__builtin_amdgcn_mfma_f32_32x32x16_bf16(kf[5],qr[2],C1,0,0,0),   P1[6],P1[7],P1[8],P1[9],     pw2[2]=PKW(P1,4), pw2[3]=PKW(P1,6), pw2); \
    VRD(3); SBAR(); GAPA(C0=__builtin_amdgcn_mfma_f32_32x32x16_bf16(kf[6],qr[3],C0,0,0,0),   P1[10],P1[11],P1[12],P1[13], pw3[0]=PKW(P1,8), pw3[1]=PKW(P1,10), pw3); \
    VRD(7); SBAR(); GAPA(C1=__builtin_amdgcn_mfma_f32_32x32x16_bf16(kf[7],qr[3],C1,0,0,0),   P1[14],P1[15],0.f,0.f,       pw3[2]=PKW(P1,12),pw3[3]=PKW(P1,14), pw3); \
    l_reg+=sacc; \
    if(GK){DMA_K((t)+3,sl_cur);} if(GV){DMA_V((t)+1,sl_next);} \
    SBAR(); \
    GAPB(o[0]=__builtin_amdgcn_mfma_f32_32x32x16_bf16(PAF(0),VFR(0),o[0],0,0,0), C0,0); \
    GAPB(o[1]=__builtin_amdgcn_mfma_f32_32x32x16_bf16(PAF(0),VFR(4),o[1],0,0,0), C0,4); \
    KRD(GL,0); GAPB(o[0]=__builtin_amdgcn_mfma_f32_32x32x16_bf16(PAF(1),VFR(1),o[0],0,0,0), C0,8); \
    KRD(GL,1); GAPB(o[1]=__builtin_amdgcn_mfma_f32_32x32x16_bf16(PAF(1),VFR(5),o[1],0,0,0), C0,12); \
    KRD(GL,2); GAPB(o[0]=__builtin_amdgcn_mfma_f32_32x32x16_bf16(PAF(2),VFR(2),o[0],0,0,0), C1,0); \
    KRD(GL,3); GAPB(o[1]=__builtin_amdgcn_mfma_f32_32x32x16_bf16(PAF(2),VFR(6),o[1],0,0,0), C1,4); \
    GAPB(o[0]=__builtin_amdgcn_mfma_f32_32x32x16_bf16(PAF(3),VFR(3),o[0],0,0,0), C1,8); \
    GAPB(o[1]=__builtin_amdgcn_mfma_f32_32x32x16_bf16(PAF(3),VFR(7),o[1],0,0,0), C1,12); \
    }while(0)
  int t=1;
  #undef CMASK
  #define CMASK(P0,P1,t) do{}while(0)
  for(;t+5<NT;t+=2){
    STEP(pB0,pB1,pA0,pA1,t,true,true,true);     WAIT_BAR(2); RESC(); ROT();
    STEP(pA0,pA1,pB0,pB1,t+1,true,true,true);   WAIT_BAR(2); RESC(); ROT();
  }
  #undef CMASK
  #define CMASK(P0,P1,t) do{}while(0)
  #define ENDW(tt) do{ if((tt)+3<NT){WAIT_BAR(2);} else if((tt)+2<NT){WAIT_BAR(1);} else {WAIT_BAR(0);} }while(0)
  for(;t+1<NT;t+=2){
    STEP(pB0,pB1,pA0,pA1,t,(t+3<NT),(t+1<NT),(t+1<NT));       ENDW(t);   RESC(); ROT();
    STEP(pA0,pA1,pB0,pB1,t+1,(t+4<NT),(t+2<NT),(t+2<NT));     ENDW(t+1); RESC(); ROT();
  }
  STEP(pB0,pB1,pA0,pA1,NT-1,false,false,false); RESC();
  { float sacc=pB0[0]+pB0[1]; _Pragma("unroll") for(int r=2;r<16;++r)sacc+=pB0[r]; _Pragma("unroll") for(int r=0;r<16;++r)sacc+=pB1[r]; l_reg+=sacc;
    pw0=(u32x4){PKW(pB0,0),PKW(pB0,2),PKW(pB0,4),PKW(pB0,6)};pw1=(u32x4){PKW(pB0,8),PKW(pB0,10),PKW(pB0,12),PKW(pB0,14)};pw2=(u32x4){PKW(pB1,0),PKW(pB1,2),PKW(pB1,4),PKW(pB1,6)};pw3=(u32x4){PKW(pB1,8),PKW(pB1,10),PKW(pB1,12),PKW(pB1,14)};
    SBAR(); pv(o,vb0+sl_cur,PAF(0),PAF(1),PAF(2),PAF(3)); }
  #undef PKW
  #undef PAF
  #undef VFR
  #undef PIN
  #undef MX3
  #undef GAPA
  #undef GAPB
  #undef EX
  #undef VRD
  #undef KRD
  #undef STEP
  #undef ENDW
  {auto rr=__builtin_amdgcn_permlane32_swap(__float_as_uint(l_reg),__float_as_uint(l_reg),false,false);l_reg=__uint_as_float(rr[0])+__uint_as_float(rr[1]);}
  if(hi==0)wsf[32+r32]=l_reg;asm volatile("s_waitcnt lgkmcnt(0)":::"memory");
  float rli[16];
  #pragma unroll
  for(int r=0;r<16;++r)rli[r]=__builtin_amdgcn_rcpf(wsf[32+crow(r,hi)]);
  bf16*Ow=O+(long)(q0+wid*QBLK)*QP+h*D;
  { bf16*stg=(bf16*)(shm+LDS_OST)+wid*2048;
    #pragma unroll
    for(int r=0;r<16;++r){const int orow=crow(r,hi);
      #pragma unroll
      for(int d0=0;d0<2;++d0)stg[orow*64+d0*32+r32]=__float2bfloat16(o[d0][r]*rli[r]);}
    asm volatile("s_waitcnt lgkmcnt(0)":::"memory");
    #pragma unroll
    for(int i=0;i<4;++i){const int row=i*8+(lane>>3),ch=lane&7; const u32x4 v=*(const u32x4*)(stg+row*64+ch*8); ATTN_STORE16(Ow+(long)row*QP+ch*8,v);} }
  asm volatile("s_waitcnt lgkmcnt(0)\n\ts_barrier":::"memory");
  #undef DMA_K
  #undef DMA_V
  #undef CMASK
  #undef TROW
  #undef START
  #undef RESC
  #undef ROT
}
template<int KP> __device__ __forceinline__ void attn_unit_q8(int h,int kvh,int q0,int NT,int kbase,float mstat,const unsigned char*Q8,const unsigned char*__restrict__ K8,const bf16*__restrict__ V,bf16*O,char*shm){
  int tid_=threadIdx.x; asm volatile("":"+v"(tid_)); const int tid=tid_,lane=tid&63,r32=lane&31,hi=lane>>5; const int wid=__builtin_amdgcn_readfirstlane(tid>>6);
  #define TROW(t) (kbase+64*(t))
  const unsigned char*Qw=Q8+(long)(q0+wid*QBLK)*QP+h*D;
  const unsigned char*Kh=K8+kvh*D; const bf16*Vh=V+kvh*D;
  const unsigned lds0=(unsigned)(uintptr_t)shm;
  float*wsf=(float*)(shm+LDS_WS)+wid*64;
  const unsigned char*ksrc=Kh+(long)lane*KP+(wid&3)*16;
  const bf16*vsrc=Vh+(long)(16*(wid&3)+(lane>>2))*KP+(wid>>2)*32+(lane&3)*8;
  const unsigned kdst=lds0+LDS_K+(wid&3)*1024, vdst=lds0+LDS_V+wid*1024;
  #define DMA_K(t,slot) glds16(ksrc+(long)TROW(t)*KP,(unsigned)__builtin_amdgcn_readfirstlane(kdst+(slot)))
  #define DMA_V(t,slot) glds16(vsrc+(long)TROW(t)*KP,(unsigned)__builtin_amdgcn_readfirstlane(vdst+(slot)))
  const int vb0=(int)(lds0+LDS_V)+((lane>>4)&1)*32+(lane&3)*8+(4*hi+((lane&15)>>2))*64;
  typedef int v8i_t __attribute__((ext_vector_type(8))); typedef int v4i_t __attribute__((ext_vector_type(4))); typedef __attribute__((address_space(3))) const v4i_t* lds_v4p;
  v8i_t kf8[2];
  const int f8sc=0x7F7F7F7F;
  const lds_cptr shm3=(lds_cptr)shm; const lds_cptr kp0=shm3+LDS_K+hi*2048+r32*16; const lds_cptr vp0=shm3+LDS_V+((lane>>4)&1)*32+(lane&3)*8+(4*hi+((lane&15)>>2))*64;
  DMA_K(0,0);DMA_V(0,0);DMA_K(1,SLOTB);
  v8i_t q8; { const v4i_t qa=*reinterpret_cast<const v4i_t*>(Qw+(long)r32*QP+32*hi), qb=*reinterpret_cast<const v4i_t*>(Qw+(long)r32*QP+32*hi+16); q8=__builtin_shufflevector(qa,qb,0,1,2,3,4,5,6,7); }
  #define KLD(j,kp) do{ const v4i_t a_=*(lds_v4p)((kp)+(j)*512), b_=*(lds_v4p)((kp)+(j)*512+1024); kf8[j]=__builtin_shufflevector(a_,b_,0,1,2,3,4,5,6,7); }while(0)
  #define QKMF(C,j) asm volatile("v_mfma_scale_f32_32x32x64_f8f6f4 %0, %1, %2, %3, %4, %4 op_sel_hi:[0,0,0]":"=&v"(C):"v"(kf8[j]),"v"(q8),"v"(negm),"v"(f8sc))
  float l_reg=0.f;f32x16 o[2];o[0]=f32x16{};o[1]=f32x16{};f32x16 negm;
  #pragma unroll
  for(int r=0;r<16;++r)negm[r]=-mstat;
  asm volatile("":"+v"(negm));
  #define CMASK(P0,P1,t) do{}while(0)
  #define START(P0,P1) do{ _Pragma("unroll") for(int r=0;r<16;++r)P0[r]=__builtin_amdgcn_exp2f(P0[r]); }while(0)
  #define RESC() do{}while(0)
  f32x16 pA0,pA1,pB0,pB1;
  int sl_prev=0,sl_cur=0,sl_next=SLOTB;
  #define ROT() do{sl_prev=sl_cur;sl_cur=sl_next;sl_next=(sl_next==(NSLOT-1)*SLOTB)?0:sl_next+SLOTB;}while(0)
  DMA_K(2,2*SLOTB);
  WAIT_BAR(3);
  KLD(0,kp0);KLD(1,kp0);QKMF(pA0,0);QKMF(pA1,1);asm volatile("s_nop 15\n\ts_nop 15\n\ts_nop 15\n\ts_nop 15\n\ts_nop 15":"+v"(pA0),"+v"(pA1));
  START(pA0,pA1);
  _Pragma("unroll") for(int r=0;r<16;++r)pA1[r]=__builtin_amdgcn_exp2f(pA1[r]);
  WAIT_BAR(0);
  DMA_K(3,0);DMA_V(1,SLOTB);
  ROT();
  KLD(0,kp0+sl_cur);KLD(1,kp0+sl_cur);
  WAIT_BAR(2);
  s16x4 vlo[8],vhi[8]; u32x4 pw0,pw1,pw2,pw3;
  #define PKW(P,B) cvtpk_s(P[B],P[B+1])
  #define PAF(k) __builtin_bit_cast(bf16x8,pw##k)
  #define VFR(i) (bf16x8){vlo[i][0],vlo[i][1],vlo[i][2],vlo[i][3],vhi[i][0],vhi[i][1],vhi[i][2],vhi[i][3]}
  #define PIN(x) asm volatile("":"+v"(x))
  #define MX3(a,b,c) __builtin_fmaxf(__builtin_fmaxf((a),(b)),(c))
  #define GAPA(MF,A0,A1,A2,A3,W0,W1,PW) do{ MF; sacc+=A0; sacc+=A1; sacc+=A2; sacc+=A3; PIN(sacc); W0; W1; PIN(PW); SBAR(); }while(0)
  #define EX(v) __builtin_amdgcn_exp2f(v)
  #define GAPB(MF,X,B) do{ MF; X[B]=EX(X[B]); X[B+1]=EX(X[B+1]); X[B+2]=EX(X[B+2]); X[B+3]=EX(X[B+3]); PIN(X); SBAR(); }while(0)
  #define VRD(i) do{ vlo[i]=vtr(vp_+(((i)>>2)*4096+((i)&3)*1024)); vhi[i]=vtr(vp_+(((i)>>2)*4096+((i)&3)*1024+512)); }while(0)
  #define KRD(G,j) do{ if((G)&&(j)<2){ KLD(j,kp0+sl_next); SBAR(); } }while(0)
  #define STEP(C0,C1,P0,P1,t,GK,GV,GL) do{ SBAR(); \
    const lds_cptr vp_=vp0+sl_prev; \
    VRD(0); SBAR(); float sacc=(P0[0]+P0[1]); \
    GAPA(QKMF(C0,0), P0[2],P0[3],P0[4],P0[5],     pw0[0]=PKW(P0,0), pw0[1]=PKW(P0,2), pw0); \
    VRD(4); SBAR(); GAPA(QKMF(C1,1), P0[6],P0[7],P0[8],P0[9],     pw0[2]=PKW(P0,4), pw0[3]=PKW(P0,6), pw0); \
    VRD(1); SBAR(); GAPA((void)0, P0[10],P0[11],P0[12],P0[13], pw1[0]=PKW(P0,8), pw1[1]=PKW(P0,10), pw1); \
    VRD(5); SBAR(); GAPA((void)0, P0[14],P0[15],P1[0],P1[1],   pw1[2]=PKW(P0,12),pw1[3]=PKW(P0,14), pw1); \
    VRD(2); SBAR(); GAPA((void)0, P1[2],P1[3],P1[4],P1[5],     pw2[0]=PKW(P1,0), pw2[1]=PKW(P1,2), pw2); \
    VRD(6); SBAR(); GAPA((void)0, P1[6],P1[7],P1[8],P1[9],     pw2[2]=PKW(P1,4), pw2[3]=PKW(P1,6), pw2); \
    VRD(3); SBAR(); GAPA((void)0, P1[10],P1[11],P1[12],P1[13], pw3[0]=PKW(P1,8), pw3[1]=PKW(P1,10), pw3); \
    VRD(7); SBAR(); GAPA((void)0, P1[14],P1[15],0.f,0.f,       pw3[2]=PKW(P1,12),pw3[3]=PKW(P1,14), pw3); \
    l_reg+=sacc; \
    if(GK){DMA_K((t)+3,sl_cur);} if(GV){DMA_V((t)+1,sl_next);} \
    SBAR(); \
    GAPB(o[0]=__builtin_amdgcn_mfma_f32_32x32x16_bf16(PAF(0),VFR(0),o[0],0,0,0), C0,0); \
    GAPB(o[1]=__builtin_amdgcn_mfma_f32_32x32x16_bf16(PAF(0),VFR(4),o[1],0,0,0), C0,4); \
    KRD(GL,0); GAPB(o[0]=__builtin_amdgcn_mfma_f32_32x32x16_bf16(PAF(1),VFR(1),o[0],0,0,0), C0,8); \
    KRD(GL,1); GAPB(o[1]=__builtin_amdgcn_mfma_f32_32x32x16_bf16(PAF(1),VFR(5),o[1],0,0,0), C0,12); \
    KRD(GL,2); GAPB(o[0]=__builtin_amdgcn_mfma_f32_32x32x16_bf16(PAF(2),VFR(2),o[0],0,0,0), C1,0); \
    KRD(GL,3); GAPB(o[1]=__builtin_amdgcn_mfma_f32_32x32x16_bf16(PAF(2),VFR(6),o[1],0,0,0), C1,4); \
    GAPB(o[0]=__builtin_amdgcn_mfma_f32_32x32x16_bf16(PAF(3),VFR(3),o[0],0,0,0), C1,8); \
    GAPB(o[1]=__builtin_amdgcn_mfma_f32_32x32x16_bf16(PAF(3),VFR(7),o[1],0,0,0), C1,12); \
    }while(0)
  int t=1;
  #undef CMASK
  #define CMASK(P0,P1,t) do{}while(0)
  for(;t+5<NT;t+=2){
    STEP(pB0,pB1,pA0,pA1,t,true,true,true);     WAIT_BAR(2); RESC(); ROT();
    STEP(pA0,pA1,pB0,pB1,t+1,true,true,true);   WAIT_BAR(2); RESC(); ROT();
  }
  #undef CMASK
  #define CMASK(P0,P1,t) do{}while(0)
  #define ENDW(tt) do{ if((tt)+3<NT){WAIT_BAR(2);} else if((tt)+2<NT){WAIT_BAR(1);} else {WAIT_BAR(0);} }while(0)
  for(;t+1<NT;t+=2){
    STEP(pB0,pB1,pA0,pA1,t,(t+3<NT),(t+1<NT),(t+1<NT));       ENDW(t);   RESC(); ROT();
    STEP(pA0,pA1,pB0,pB1,t+1,(t+4<NT),(t+2<NT),(t+2<NT));     ENDW(t+1); RESC(); ROT();
  }
  STEP(pB0,pB1,pA0,pA1,NT-1,false,false,false); RESC();
  { float sacc=pB0[0]+pB0[1]; _Pragma("unroll") for(int r=2;r<16;++r)sacc+=pB0[r]; _Pragma("unroll") for(int r=0;r<16;++r)sacc+=pB1[r]; l_reg+=sacc;
    pw0=(u32x4){PKW(pB0,0),PKW(pB0,2),PKW(pB0,4),PKW(pB0,6)};pw1=(u32x4){PKW(pB0,8),PKW(pB0,10),PKW(pB0,12),PKW(pB0,14)};pw2=(u32x4){PKW(pB1,0),PKW(pB1,2),PKW(pB1,4),PKW(pB1,6)};pw3=(u32x4){PKW(pB1,8),PKW(pB1,10),PKW(pB1,12),PKW(pB1,14)};
    SBAR(); pv(o,vb0+sl_cur,PAF(0),PAF(1),PAF(2),PAF(3)); }
  #undef PKW
  #undef PAF
  #undef VFR
  #undef PIN
  #undef MX3
  #undef GAPA
  #undef GAPB
  #undef EX
  #undef VRD
  #undef KRD
  #undef KLD
  #undef QKMF
  #undef STEP
  #undef ENDW
  {auto rr=__builtin_amdgcn_permlane32_swap(__float_as_uint(l_reg),__float_as_uint(l_reg),false,false);l_reg=__uint_as_float(rr[0])+__uint_as_float(rr[1]);}
  if(hi==0)wsf[32+r32]=l_reg;asm volatile("s_waitcnt lgkmcnt(0)":::"memory");
  float rli[16];
  #pragma unroll
  for(int r=0;r<16;++r)rli[r]=__builtin_amdgcn_rcpf(wsf[32+crow(r,hi)]);
  bf16*Ow=O+(long)(q0+wid*QBLK)*QP+h*D;
  { bf16*stg=(bf16*)(shm+LDS_OST)+wid*2048;
    #pragma unroll
    for(int r=0;r<16;++r){const int orow=crow(r,hi);
      #pragma unroll
      for(int d0=0;d0<2;++d0)stg[orow*64+d0*32+r32]=__float2bfloat16(o[d0][r]*rli[r]);}
    asm volatile("s_waitcnt lgkmcnt(0)":::"memory");
    #pragma unroll
    for(int i=0;i<4;++i){const int row=i*8+(lane>>3),ch=lane&7; const u32x4 v=*(const u32x4*)(stg+row*64+ch*8); ATTN_STORE16(Ow+(long)row*QP+ch*8,v);} }
  asm volatile("s_waitcnt lgkmcnt(0)\n\ts_barrier":::"memory");
  #undef DMA_K
  #undef DMA_V
  #undef CMASK
  #undef TROW
  #undef START
  #undef RESC
  #undef ROT
}
constexpr int ATTN_LDS_BYTES=LDS_BYTES;
#undef SBAR
#undef WAIT_BAR
}
#ifndef EN_MIX
#define EN_MIX 15
#endif
#ifndef EN_MOE
#define EN_MOE 15
#endif
constexpr int NWAVES = 8, NTHR = 512;
constexpr int DM = 1024, NLAT = 16384, NCTX = 256, T = NLAT + NCTX, NPAN = T / 256;
constexpr int NE = 32, TOPK = 4, EFF = 1024;
constexpr int FA_NQKV = 1536, WA_NQKV = 1280, GM_FF = 4096, GM_HALF = 2048;
constexpr float LN_EPS = 1e-5f, RMS_EPS = 1e-6f;
constexpr float DN_ALPHA = 1.6817928305074292f;
constexpr float LOG2E = 1.4426950408889634f, QSCALE = 0.125f * LOG2E;
constexpr int NPHASE = 35;

constexpr size_t MiB = 1u << 20;
constexpr size_t WS_CTL = 0, CTL_ZERO_BYTES = 64 * 1024;
constexpr size_t WS_MOD = 1 * MiB;
constexpr size_t WS_TAB = 2 * MiB;
constexpr size_t TB_FC = WS_TAB, TB_FA = TB_FC + 512 * 256 * 2, TB_FCC = TB_FA + 256 * 256 * 2, TB_FX = TB_FCC + 256 * 256 * 2, TB_TWC = TB_FX + 256 * 512 * 2,
                 TB_TWS = TB_TWC + 128 * 128 * 4, TB_ROPC = TB_TWS + 128 * 128 * 4, TB_ROPS = TB_ROPC + (size_t)NLAT * 32 * 4, TB_END = TB_ROPS + (size_t)NLAT * 32 * 4;
static_assert(TB_END <= 10 * MiB, "tables");
constexpr size_t WS_RW = 10 * MiB;
constexpr size_t WS_LCNT = 11 * MiB;
constexpr size_t WS_ASG = 12 * MiB, WS_GATE = WS_ASG + (size_t)T * 16, WS_SLOT = WS_GATE + (size_t)T * 16;
constexpr int ECAPT = 65, ECAP = ECAPT * 256;
constexpr size_t WS_STOK_OLD = WS_ASG + 1 * MiB;
static_assert(WS_SLOT + (size_t)T * 16 <= WS_STOK_OLD, "assign");
constexpr size_t WS_WFN = 16 * MiB, WS_WFAQ = WS_WFN + 2 * MiB, WS_WFAO = WS_WFAQ + 3 * MiB, WS_WGI = WS_WFAO + 2 * MiB, WS_WGO = WS_WGI + 8 * MiB,
                 WS_WWQ = WS_WGO + 4 * MiB, WS_WWO = WS_WWQ + 3 * MiB, WS_WSM_END = WS_WWO + 2 * MiB;
static_assert(WS_WSM_END <= 40 * MiB, "small weights");
constexpr size_t WS_X = 40 * MiB;
constexpr size_t WS_H = 106 * MiB;
constexpr size_t WS_Y = 140 * MiB;
constexpr size_t WS_BIG = 176 * MiB;
constexpr size_t WS_BTA = WS_BIG, WS_BTC = WS_BTA + 64 * MiB, WS_BTX = WS_BTC + 64 * MiB, WS_MIXB = WS_BTX + 1 * MiB;
constexpr size_t WS_Q = WS_BIG, WS_K = WS_Q + 33 * MiB, WS_V = WS_K + 9 * MiB, WS_O = WS_V + 9 * MiB;
constexpr size_t WS_Q8 = WS_Q + 86 * MiB, WS_K8 = WS_Q + 104 * MiB;
constexpr size_t WS_GU = WS_BIG, WS_GV = WS_GU + 65 * MiB, WS_GG = WS_GV + 65 * MiB, WS_PSTAT = WS_GG + 66 * MiB;
constexpr int MAXMT = 292; constexpr size_t SLOTROWS = (size_t)MAXMT * 256;
constexpr size_t WS_XS = WS_BIG, WS_YS = WS_XS + 292 * MiB;
constexpr size_t WS_H8 = WS_XS;
constexpr float W8_SCALE = 32.0f, W8_INV = 1.0f / 32.0f;
static_assert(SLOTROWS * 2048 <= 146 * MiB, "slots");
constexpr size_t WS_WEXP_GU = 640 * MiB, WS_WEXP_DN = WS_WEXP_GU + 512 * MiB, WS_X2 = WS_WEXP_DN + 256 * MiB, WS_STOK = WS_X2 + 66 * MiB  , WS_ACT = WS_STOK + 4 * MiB  , WS_END = WS_ACT + (size_t)32 * ECAP * 2048;
static_assert(WS_YS + 146 * MiB <= WS_WEXP_GU && (size_t)32 * ECAP * 4 <= 4 * MiB, "big region");
constexpr int CW_BAR = 4096;
constexpr int CW_GCNT = 8192;
constexpr int CW_TMO = 0;
constexpr int CW_MCNT = 16384, MCNT_LAYER = 320 * 64;
static_assert((CW_BAR + 3456) <= CW_GCNT && (CW_GCNT + 4 * 32 * 64) * 4 <= (int)CTL_ZERO_BYTES, "control words inside the memset region");

constexpr int RING_OFF = 0, RING_BYTES = 131072;
constexpr int PRO_SCR_BYTES = 8 * 64 * 65 * 4;
constexpr int MISC_OFF = 136 * 1024;
constexpr int LDS_BYTES = 147456;
constexpr int MW_BAR = 0, MW_LC = 8, MW_TOT = 480, MW_EBASE = 64, MW_MYBASE = 96, MW_NMT = 128, MW_CONV = 132, MW_MTE = 160;
static_assert(MISC_OFF + (MW_MTE + 304) * 4 <= LDS_BYTES && PRO_SCR_BYTES <= MISC_OFF, "LDS map");

#define GAS __attribute__((address_space(1)))
#define LAS __attribute__((address_space(3)))
typedef unsigned short bf16;
typedef unsigned v4u __attribute__((ext_vector_type(4)));
typedef unsigned v2u __attribute__((ext_vector_type(2)));
typedef float f32x4 __attribute__((ext_vector_type(4)));
typedef float f32x2 __attribute__((ext_vector_type(2)));
typedef float f32x16 __attribute__((ext_vector_type(16)));
typedef short bf16x8 __attribute__((ext_vector_type(8)));
typedef GAS unsigned gu32;
#define RLX_AGENT __ATOMIC_RELAXED, __HIP_MEMORY_SCOPE_AGENT
#define LDS_WAIT() asm volatile("s_waitcnt lgkmcnt(0)" ::: "memory")
#define VM_WAIT() asm volatile("s_waitcnt vmcnt(0)" ::: "memory")
__device__ __forceinline__ unsigned f2bf(float f) { unsigned u = __builtin_bit_cast(unsigned, f); return (u + 0x7fffu + ((u >> 16) & 1u)) >> 16; }
__device__ __forceinline__ unsigned pk2(float lo, float hi) { return f2bf(lo) | (f2bf(hi) << 16); }
__device__ __forceinline__ float bf_lo(unsigned w) { return __builtin_bit_cast(float, w << 16); }
__device__ __forceinline__ float bf_hi(unsigned w) { return __builtin_bit_cast(float, w & 0xffff0000u); }
#define XB_TMO      128
#define XB_XCNT(j)  (256  + 64 * (j))
#define XB_XSUB(j)  (1280 + 64 * (j))
#define XB_XGEN(j)  (2304 + 64 * (j))
#define XB_TOP      3328
#define XB_TOPGEN   3392
#define XCD_BAR_WORDS 3456
#define XB_SPIN_CAP (1u << 18)

__device__ __forceinline__ unsigned xb_ld(unsigned* p)              { return __hip_atomic_load(p, __ATOMIC_RELAXED, __HIP_MEMORY_SCOPE_AGENT); }
__device__ __forceinline__ unsigned xb_add(unsigned* p, unsigned v) { return __hip_atomic_fetch_add(p, v, __ATOMIC_RELAXED, __HIP_MEMORY_SCOPE_AGENT); }
__device__ __forceinline__ unsigned xb_xcc_id() { return (unsigned)__builtin_amdgcn_s_getreg((3 << 11) | 20) & 0xFu; }
#define XB_SPIN(cond, bar) do { unsigned _sp = 0; while (cond) { __builtin_amdgcn_s_sleep(1); \
    if ((++_sp & 255u) == 0u) { if (xb_ld(&(bar)[XB_TMO])) break; if (_sp > XB_SPIN_CAP) { atomicAdd(&(bar)[XB_TMO], 1u); break; } } } } while (0)

struct XcdBarrier {
    unsigned* bar; unsigned x;
    volatile LAS unsigned* st;
};

__device__ __forceinline__ XcdBarrier xcd_barrier_post(unsigned* bar, volatile LAS unsigned* st) {
    XcdBarrier b; b.bar = bar; b.x = xb_xcc_id(); b.st = st;
    if (threadIdx.x == 0) (void)xb_add(&bar[XB_XCNT(b.x)], 1u);
    return b;
}
__device__ __forceinline__ void xcd_barrier_complete(unsigned* bar, unsigned x, unsigned& nloc, unsigned& nx) {
    const unsigned G = gridDim.x * gridDim.y * gridDim.z;
    unsigned sum, cnt, mine, sp = 0u;
    for (;;) {
        sum = 0u; cnt = 0u; mine = 0u;
#pragma unroll
        for (unsigned j = 0; j < 16; ++j) { const unsigned c = xb_ld(&bar[XB_XCNT(j)]); sum += c; cnt += (c > 0u) ? 1u : 0u; mine = (j == x) ? c : mine; }
        if (sum == G) break;
        __builtin_amdgcn_s_sleep(1);
        if ((++sp & 255u) == 0u) { if (xb_ld(&bar[XB_TMO])) break; if (sp > XB_SPIN_CAP) { atomicAdd(&bar[XB_TMO], 1u); break; } }
    }
    nloc = mine > 0u ? mine : 1u; nx = cnt > 0u ? cnt : 1u;
}

__device__ __forceinline__ void xcd_barrier(const XcdBarrier& b) {
    asm volatile("s_waitcnt vmcnt(0)" ::: "memory");
    __syncthreads();
    if (threadIdx.x == 0) {
        unsigned* bar = b.bar;
        __builtin_amdgcn_s_waitcnt(0);
        unsigned nloc = b.st[0], nx = b.st[1];
        if (nloc == 0u) { xcd_barrier_complete(bar, b.x, nloc, nx); b.st[0] = nloc; b.st[1] = nx; }
        const unsigned old = xb_add(&bar[XB_XSUB(b.x)], 1u);
        const unsigned gen = old / nloc;
        if (old + 1u == (gen + 1u) * nloc) {
            __builtin_amdgcn_fence(__ATOMIC_RELEASE, "agent");
            asm volatile("s_waitcnt vmcnt(0)" ::: "memory");
            const unsigned og = xb_add(&bar[XB_TOP], 1u);
            const unsigned tg = og / nx;
            if (og + 1u == (tg + 1u) * nx) xb_add(&bar[XB_TOPGEN], 1u);
            else XB_SPIN(xb_ld(&bar[XB_TOPGEN]) == tg, bar);
            __builtin_amdgcn_fence(__ATOMIC_ACQUIRE, "agent");
            xb_add(&bar[XB_XGEN(b.x)], 1u);
            asm volatile("s_waitcnt vmcnt(0)" ::: "memory");
        } else {
            XB_SPIN(xb_ld(&bar[XB_XGEN(b.x)]) == gen, bar);
            __builtin_amdgcn_fence(__ATOMIC_ACQUIRE, "agent");
            asm volatile("s_waitcnt vmcnt(0)" ::: "memory");
        }
    }
    __syncthreads();
}
struct Frame {
    LAS unsigned char* lds;
    volatile LAS unsigned* MISC;
    gu32* ctl;
    unsigned char* ws;
    int wave, vcu, G, bx;
};
enum In { I_X = 0, I_C, I_CTX, I_CCTX, I_ADAW, I_ADAB, I_LNMG, I_LNMB, I_LNFG, I_LNFB, I_FNW, I_FNB, I_FAWQ, I_FABQ, I_FAQN, I_FAKN, I_FAWO, I_FABO,
          I_GMWI, I_GMBI, I_GMVG, I_GMVB, I_GMWS, I_GMBS, I_GMWO, I_GMBO, I_WAWQ, I_WABQ, I_WASK, I_WAWO, I_WABO, I_RW, I_RB, I_EWGU, I_EBGU, I_EWD, I_EBD, N_IN };

#define CAS __attribute__((address_space(4)))
typedef const float* cfptr_t;
__device__ __forceinline__ const float* argp(int idx) {
    unsigned long long a = (unsigned long long)__builtin_amdgcn_kernarg_segment_ptr(); asm volatile("" : "+s"(a));
    return ((const CAS cfptr_t*)a)[idx];
}
__device__ __forceinline__ int otid() { int t = threadIdx.x; asm volatile("" : "+v"(t)); return t; }
__device__ __forceinline__ float wave_sum(float v) {
#pragma unroll
    for (int o = 1; o < 64; o <<= 1) v += __shfl_xor(v, o);
    return v;
}
struct RowV { f32x4 v[4]; };
__device__ __forceinline__ RowV ldrow(const float* p, int lane) { RowV r; const f32x4* q = (const f32x4*)p + lane;
#pragma unroll
    for (int j = 0; j < 4; ++j) r.v[j] = q[64 * j]; return r; }
__device__ __forceinline__ void strow(float* p, int lane, const RowV& r) { f32x4* q = (f32x4*)p + lane;
#pragma unroll
    for (int j = 0; j < 4; ++j) q[64 * j] = r.v[j]; }
__device__ __forceinline__ void strow_bf16(bf16* p, int lane, const RowV& r) { unsigned long long* q = (unsigned long long*)p + lane;
#pragma unroll
    for (int j = 0; j < 4; ++j) q[64 * j] = (unsigned long long)pk2(r.v[j].x, r.v[j].y) | ((unsigned long long)pk2(r.v[j].z, r.v[j].w) << 32); }
__device__ __forceinline__ RowV ldrow_bf16(const bf16* p, int lane) { RowV r; const v2u* q = (const v2u*)p + lane;
#pragma unroll
    for (int j = 0; j < 4; ++j) { const v2u w = q[64 * j]; r.v[j] = (f32x4){bf_lo(w.x), bf_hi(w.x), bf_lo(w.y), bf_hi(w.y)}; } return r; }
__device__ __forceinline__ RowV ln_row(const RowV& x, const RowV& g, const RowV& b) {
    float s = 0.f;
#pragma unroll
    for (int j = 0; j < 4; ++j) s += (x.v[j].x + x.v[j].y) + (x.v[j].z + x.v[j].w);
    const float mean = wave_sum(s) * (1.f / DM); float s2 = 0.f; RowV d;
#pragma unroll
    for (int j = 0; j < 4; ++j) { d.v[j] = x.v[j] - mean; s2 += (d.v[j].x * d.v[j].x + d.v[j].y * d.v[j].y) + (d.v[j].z * d.v[j].z + d.v[j].w * d.v[j].w); }
    const float rstd = 1.f / sqrtf(wave_sum(s2) * (1.f / DM) + LN_EPS);
#pragma unroll
    for (int j = 0; j < 4; ++j) d.v[j] = d.v[j] * rstd * g.v[j] + b.v[j];
    return d;
}
__device__ __forceinline__ const float* modp(const Frame& F, int L, int s, int which) { return (const float*)(F.ws + WS_MOD) + ((size_t)(L * 2 + s) * 6 + which) * DM; }

struct TokOrder : pg8::GridOrder {
    size_t apan, bpan;
    __device__ __forceinline__ bool next(int i, pg8::Unit& u) const { u.e = 0; return next_mn(i, u.pm, u.pn); }
    __device__ __forceinline__ size_t offA(const pg8::Unit& u) const { return (size_t)u.pm * apan; }
    __device__ __forceinline__ size_t offB(const pg8::Unit& u) const { return (size_t)u.pn * bpan; }
    __device__ __forceinline__ void a_ready(const pg8::Unit&) const {}
    __device__ __forceinline__ void done(const pg8::Unit&) const {}
};
struct ChDftOrder : pg8::GridOrder {
    __device__ __forceinline__ bool next(int i, pg8::Unit& u) const { u.e = 0; return next_mn(i, u.pm, u.pn); }
    __device__ __forceinline__ size_t offA(const pg8::Unit& u) const { return (size_t)u.pm * (256 * 256 * 2); }
    __device__ __forceinline__ size_t offB(const pg8::Unit& u) const { const int g = u.pn >> 6, j = u.pn & 63; return ((size_t)(2 * j) * DM + g * 256) * 2; }
    __device__ __forceinline__ void a_ready(const pg8::Unit&) const {}
    __device__ __forceinline__ void done(const pg8::Unit&) const {}
};
struct ChDftCtxOrder : pg8::GridOrder {
    __device__ __forceinline__ bool next(int i, pg8::Unit& u) const { u.e = 0; return next_mn(i, u.pm, u.pn); }
    __device__ __forceinline__ size_t offA(const pg8::Unit& u) const { return (size_t)u.pm * (256 * 256 * 2); }
    __device__ __forceinline__ size_t offB(const pg8::Unit& u) const { return ((size_t)NLAT * DM + u.pn * 256) * 2; }
    __device__ __forceinline__ void a_ready(const pg8::Unit&) const {}
    __device__ __forceinline__ void done(const pg8::Unit&) const {}
};
struct MoeOrder : pg8::GridOrder {
    const volatile LAS unsigned* mte; size_t bexp, apan, bpan;
    __device__ __forceinline__ bool next(int i, pg8::Unit& u) const { int pl; if (!next_mn(i, pl, u.pn)) return false; u.pm = (int)mte[pl]; u.e = u.pm / ECAPT; return true; }
    __device__ __forceinline__ size_t offA(const pg8::Unit& u) const { return (size_t)u.pm * apan; }
    __device__ __forceinline__ size_t offB(const pg8::Unit& u) const { return (size_t)u.e * bexp + (size_t)u.pn * bpan; }
    __device__ __forceinline__ void a_ready(const pg8::Unit&) const {}
    __device__ __forceinline__ void done(const pg8::Unit&) const {}
};

struct MoeOrderG : pg8::GridOrder {
    const volatile LAS unsigned* mte; size_t bexp, bpan; const unsigned* stok; unsigned rowbytes;
    __device__ __forceinline__ bool next(int i, pg8::Unit& u) const { int pl; if (!next_mn(i, pl, u.pn)) return false; u.pm = (int)mte[pl]; u.e = u.pm / ECAPT; return true; }
    __device__ __forceinline__ size_t offA(const pg8::Unit&) const { return 0; }
    __device__ __forceinline__ size_t offB(const pg8::Unit& u) const { return (size_t)u.e * bexp + (size_t)u.pn * bpan; }
    __device__ __forceinline__ unsigned rowoff(const pg8::Unit& u, int row) const { return (stok[u.pm * 256 + row] >> 2) * rowbytes; }
    __device__ __forceinline__ void a_ready(const pg8::Unit&) const {}
    __device__ __forceinline__ void done(const pg8::Unit&) const {}
};

#define EPI_ARGS const pg8::f32x4 (&acc)[2][2][4][2], const pg8::Unit& u, int wr, int wc, int fr, int fq
__device__ __forceinline__ unsigned pk4f8(float a, float b, float c, float d) { int w = 0; w = __builtin_amdgcn_cvt_pk_fp8_f32(a, b, w, false); w = __builtin_amdgcn_cvt_pk_fp8_f32(c, d, w, true); return (unsigned)w; }
__device__ __forceinline__ v2u pack8f8(const f32x4& a, const f32x4& b) { v2u w; w.x = pk4f8(a[0], a[1], a[2], a[3]); w.y = pk4f8(b[0], b[1], b[2], b[3]); return w; }
__device__ __forceinline__ v4u pack8(const f32x4& a, const f32x4& b) { v4u w; w.x = pg8::cvt_pk_bf16(a[0], a[1]); w.y = pg8::cvt_pk_bf16(a[2], a[3]); w.z = pg8::cvt_pk_bf16(b[0], b[1]); w.w = pg8::cvt_pk_bf16(b[2], b[3]); return w; }

struct EpiChDft { static constexpr bool PERM = true, AFTER_DRAIN = false; bf16* O;
    __device__ __forceinline__ void operator()(EPI_ARGS) const {
        const int g = u.pn >> 6, j = u.pn & 63, part = u.pm;
        char* ub = (char*)O + 2 * ((size_t)((g * 256 + 64 * wr) * 128 + 2 * j) * 256 + part * 128 + 32 * wc);
        unsigned lo = 2u * (unsigned)(fr * 128 * 256 + 8 * fq); asm volatile("" : "+v"(lo));
#pragma unroll
        for (int ai = 0; ai < 2; ++ai)
#pragma unroll
            for (int m = 0; m < 4; ++m)
#pragma unroll
                for (int bj = 0; bj < 2; ++bj)
                    *(v4u*)(ub + (size_t)(2 * (((128 * ai + 16 * m) * 128 + bj) * 256)) + lo) = pack8(acc[ai][bj][m][0], acc[ai][bj][m][1]);
    }
};
struct EpiChDftCtx { static constexpr bool PERM = true, AFTER_DRAIN = false; bf16* O;
    __device__ __forceinline__ void operator()(EPI_ARGS) const {
        const int g = u.pn, part = u.pm;
        char* ub = (char*)O + 2 * ((size_t)(g * 256 + 64 * wr) * 512 + part * 256 + 32 * wc);
        unsigned lo = 2u * (unsigned)(fr * 512 + 8 * fq); asm volatile("" : "+v"(lo));
#pragma unroll
        for (int ai = 0; ai < 2; ++ai)
#pragma unroll
            for (int m = 0; m < 4; ++m)
#pragma unroll
                for (int bj = 0; bj < 2; ++bj)
                    *(v4u*)(ub + (size_t)(2 * ((128 * ai + 16 * m) * 512 + 128 * bj)) + lo) = pack8(acc[ai][bj][m][0], acc[ai][bj][m][1]);
    }
};
struct EpiStepA { static constexpr bool PERM = true, AFTER_DRAIN = false; bf16* O; const float* twc; const float* tws;
    __device__ __forceinline__ void operator()(EPI_ARGS) const {
        char* ub = (char*)O + 2 * ((size_t)(64 * wr * 1024 + 2 * u.pn) * 256 + 32 * wc);
        unsigned lo = 2u * (unsigned)(fr * 1024 * 256 + 8 * fq); asm volatile("" : "+v"(lo));
        const char* tcb = (const char*)twc + 4 * (64 * wr * 128 + 32 * wc); const char* tsb = (const char*)tws + 4 * (64 * wr * 128 + 32 * wc);
        unsigned tlo = 4u * (unsigned)(fr * 128 + 8 * fq); asm volatile("" : "+v"(tlo));
#pragma unroll
        for (int m = 0; m < 4; ++m) {
            const f32x4 c0 = *(const f32x4*)(tcb + 4 * (16 * m * 128) + tlo), c1 = *(const f32x4*)(tcb + 4 * (16 * m * 128 + 4) + tlo), s0 = *(const f32x4*)(tsb + 4 * (16 * m * 128) + tlo), s1 = *(const f32x4*)(tsb + 4 * (16 * m * 128 + 4) + tlo);
#pragma unroll
            for (int bj = 0; bj < 2; ++bj) {
                const f32x4 zr0 = acc[0][bj][m][0], zr1 = acc[0][bj][m][1], zi0 = acc[1][bj][m][0], zi1 = acc[1][bj][m][1];
                const f32x4 yr0 = zr0 * c0 + zi0 * s0, yr1 = zr1 * c1 + zi1 * s1, yi0 = zi0 * c0 - zr0 * s0, yi1 = zi1 * c1 - zr1 * s1;
                char* p = ub + (size_t)(2 * ((16 * m * 1024 + bj) * 256)) + lo;
                *(v4u*)p = pack8(yr0, yr1); *(v4u*)(p + 256) = pack8(yi0, yi1); }
            asm volatile("" ::: "memory"); }
    }
};
struct EpiStepC { static constexpr bool PERM = true, AFTER_DRAIN = false; bf16* O;
    __device__ __forceinline__ void operator()(EPI_ARGS) const {
        const int k1 = u.pn >> 2, chb = (u.pn & 3) * 256;
        char* ub = (char*)O + 2 * ((size_t)(k1 + 128 * 64 * wr) * DM + chb + 32 * wc);
        unsigned lo = 2u * (unsigned)(128 * fr * DM + 8 * fq); asm volatile("" : "+v"(lo));
#pragma unroll
        for (int m = 0; m < 4; ++m)
#pragma unroll
            for (int bj = 0; bj < 2; ++bj)
                *(v4u*)(ub + (size_t)(2 * (128 * 16 * m * DM + 128 * bj)) + lo) = pack8(acc[0][bj][m][0], acc[0][bj][m][1]);
    }
};
struct EpiCtxPos { static constexpr bool PERM = true, AFTER_DRAIN = false; bf16* O;
    __device__ __forceinline__ void operator()(EPI_ARGS) const {
        char* ub = (char*)O + 2 * ((size_t)(NLAT + 64 * wr) * DM + u.pn * 256 + 32 * wc);
        unsigned lo = 2u * (unsigned)(fr * DM + 8 * fq); asm volatile("" : "+v"(lo));
#pragma unroll
        for (int ai = 0; ai < 2; ++ai)
#pragma unroll
            for (int m = 0; m < 4; ++m)
#pragma unroll
                for (int bj = 0; bj < 2; ++bj)
                    *(v4u*)(ub + (size_t)(2 * ((128 * ai + 16 * m) * DM + 128 * bj)) + lo) = pack8(acc[ai][bj][m][0], acc[ai][bj][m][1]);
    }
};
template <int NKV, bool RMS> struct EpiQKV { static constexpr bool PERM = true, AFTER_DRAIN = false;
    bf16 *Q, *K, *V; const float* bias; const float* qn; const float* kn; const float* ropc; const float* rops;
    __device__ __forceinline__ void operator()(EPI_ARGS) const {
        const int hh = 4 * u.pn + wc; const int kind = hh < 16 ? 0 : (hh < 16 + NKV ? 1 : 2);
        const int pitch = kind == 0 ? DM : NKV * 64, hd = kind == 0 ? hh : (kind == 1 ? hh - 16 : hh - 16 - NKV);
        const bool f8 = RMS && kind < 2;
        const unsigned es = f8 ? 1u : 2u;
        const size_t doff = f8 ? (kind == 0 ? (size_t)(WS_Q8 - WS_Q) : (size_t)(WS_K8 - WS_Q)) : (kind == 0 ? (size_t)0 : (kind == 1 ? (size_t)(WS_K - WS_Q) : (size_t)(WS_V - WS_Q)));
        bf16* dst = (bf16*)((char*)Q + doff);
        const bool lat = u.pm < NLAT / 256;
        const int rowu = u.pm * 256 + 64 * wr;
        char* ub = (char*)dst + es * ((size_t)rowu * pitch + hd * 64);
        unsigned lo = es * (unsigned)(fr * pitch + 8 * fq); asm volatile("" : "+v"(lo));
        const char* rcb = (const char*)ropc + 4 * ((size_t)rowu * 32); const char* rsb = (const char*)rops + 4 * ((size_t)rowu * 32);
        unsigned rlo = 4u * (unsigned)(fr * 32 + 4 * fq); asm volatile("" : "+v"(rlo));
        f32x4 bv[2][2], gv[2][2];
#pragma unroll
        for (int bj = 0; bj < 2; ++bj)
#pragma unroll
            for (int n = 0; n < 2; ++n) { const int d = 32 * bj + 8 * fq + 4 * n; bv[bj][n] = *(const f32x4*)(bias + hh * 64 + d);
                if (RMS) { const f32x4 gq = *(const f32x4*)(qn + d), gk = *(const f32x4*)(kn + d); gv[bj][n] = kind == 0 ? gq : gk; } }
#pragma unroll
        for (int ai = 0; ai < 2; ++ai)
#pragma unroll
            for (int m = 0; m < 4; ++m) {
                f32x4 v[2][2];
#pragma unroll
                for (int bj = 0; bj < 2; ++bj)
#pragma unroll
                    for (int n = 0; n < 2; ++n) v[bj][n] = acc[ai][bj][m][n] + bv[bj][n];
                if (kind < 2) {
                    if (RMS) { float ss = 0.f;
#pragma unroll
                        for (int bj = 0; bj < 2; ++bj)
#pragma unroll
                            for (int n = 0; n < 2; ++n) ss += (v[bj][n][0] * v[bj][n][0] + v[bj][n][1] * v[bj][n][1]) + (v[bj][n][2] * v[bj][n][2] + v[bj][n][3] * v[bj][n][3]);
                        ss += __shfl_xor(ss, 16); ss += __shfl_xor(ss, 32);
                        const float rs = 1.f / sqrtf(ss * (1.f / 64.f) + RMS_EPS);
#pragma unroll
                        for (int bj = 0; bj < 2; ++bj)
#pragma unroll
                            for (int n = 0; n < 2; ++n) v[bj][n] = v[bj][n] * rs * gv[bj][n]; }
                    if (lat) {
#pragma unroll
                        for (int bj = 0; bj < 2; ++bj)
#pragma unroll
                            for (int n = 0; n < 2; ++n) {
                                const f32x2 c = *(const f32x2*)(rcb + 4 * ((128 * ai + 16 * m) * 32 + 16 * bj + 2 * n) + rlo), sn = *(const f32x2*)(rsb + 4 * ((128 * ai + 16 * m) * 32 + 16 * bj + 2 * n) + rlo);
                                const f32x4 x = v[bj][n];
                                v[bj][n] = (f32x4){x[0] * c.x - x[1] * sn.x, x[0] * sn.x + x[1] * c.x, x[2] * c.y - x[3] * sn.y, x[2] * sn.y + x[3] * c.y}; } }
                    if (kind == 0) {
#pragma unroll
                        for (int bj = 0; bj < 2; ++bj)
#pragma unroll
                            for (int n = 0; n < 2; ++n) v[bj][n] = v[bj][n] * QSCALE; }
                }
                char* p = ub + (size_t)(128 * ai + 16 * m) * (size_t)(es * pitch) + lo;
                if (f8) { *(v2u*)p = pack8f8(v[0][0], v[0][1]); *(v2u*)(p + 32) = pack8f8(v[1][0], v[1][1]); }
                else { *(v4u*)p = pack8(v[0][0], v[0][1]); *(v4u*)(p + 64) = pack8(v[1][0], v[1][1]); }
                if (m & 1) asm volatile("" ::: "memory"); }
    }
};
struct EpiGeluUV { static constexpr bool PERM = true, AFTER_DRAIN = false; bf16* U; bf16* V; const float* bias; float* pstat;
    __device__ __forceinline__ void operator()(EPI_ARGS) const {
        const bool isv = u.pn >= 8; const int colt = (u.pn & 7) * 256;
        char* ub = (char*)(isv ? V : U) + 2 * ((size_t)(u.pm * 256 + 64 * wr) * GM_HALF + colt + 32 * wc);
        unsigned lo = 2u * (unsigned)(fr * GM_HALF + 8 * fq); asm volatile("" : "+v"(lo));
        const float* bb = bias + u.pn * 256 + 32 * wc + 8 * fq;
        f32x4 bv[2][2];
#pragma unroll
        for (int bj = 0; bj < 2; ++bj)
#pragma unroll
            for (int n = 0; n < 2; ++n) bv[bj][n] = *(const f32x4*)(bb + 128 * bj + 4 * n);
#pragma unroll
        for (int ai = 0; ai < 2; ++ai)
#pragma unroll
            for (int m = 0; m < 4; ++m) { float s = 0.f, s2 = 0.f;
#pragma unroll
                for (int bj = 0; bj < 2; ++bj) { const f32x4 x0 = acc[ai][bj][m][0] + bv[bj][0], x1 = acc[ai][bj][m][1] + bv[bj][1];
                    const pg8::f32x2 a = pg8::gelu_pk((pg8::f32x2){x0[0], x0[1]}), b = pg8::gelu_pk((pg8::f32x2){x0[2], x0[3]}), c = pg8::gelu_pk((pg8::f32x2){x1[0], x1[1]}), d = pg8::gelu_pk((pg8::f32x2){x1[2], x1[3]});
                    s += ((a.x + a.y) + (b.x + b.y)) + ((c.x + c.y) + (d.x + d.y)); s2 += ((a.x * a.x + a.y * a.y) + (b.x * b.x + b.y * b.y)) + ((c.x * c.x + c.y * c.y) + (d.x * d.x + d.y * d.y));
                    v4u w; w.x = pg8::cvt_pk_bf16(a.x, a.y); w.y = pg8::cvt_pk_bf16(b.x, b.y); w.z = pg8::cvt_pk_bf16(c.x, c.y); w.w = pg8::cvt_pk_bf16(d.x, d.y);
                    *(v4u*)(ub + (size_t)(2 * ((128 * ai + 16 * m) * GM_HALF + 128 * bj)) + lo) = w; }
                if (isv) { s += __shfl_xor(s, 16); s += __shfl_xor(s, 32); s2 += __shfl_xor(s2, 16); s2 += __shfl_xor(s2, 32);
                    if (fq == 0) *(f32x2*)(pstat + ((size_t)(u.pm * 256 + 128 * ai + 64 * wr + 16 * m + fr) * 32 + (u.pn - 8) * 4 + wc) * 2) = (f32x2){s, s2}; } }
    }
};
struct EpiSwiGLU { static constexpr bool PERM = true, AFTER_DRAIN = false; unsigned char* O; const float* bias;
    __device__ __forceinline__ void operator()(EPI_ARGS) const {
        f32x4 bv[2][2];
        const float* bb = bias + (size_t)u.e * 2048 + u.pn * 256 + 32 * wc + 8 * fq;
#pragma unroll
        for (int bj = 0; bj < 2; ++bj)
#pragma unroll
            for (int n = 0; n < 2; ++n) bv[bj][n] = *(const f32x4*)(bb + 128 * bj + 4 * n);
        char* ub = (char*)O + (((size_t)u.pm * 256 + 64 * wr) * 1024 + u.pn * 128 + 16 * wc);
        unsigned lo = (unsigned)(fr * 1024 + 4 * fq); asm volatile("" : "+v"(lo));
#pragma unroll
        for (int ai = 0; ai < 2; ++ai)
#pragma unroll
            for (int m = 0; m < 4; ++m) {
#pragma unroll
                for (int bj = 0; bj < 2; ++bj) { float a[4];
#pragma unroll
                    for (int n = 0; n < 2; ++n) { const f32x4 x = acc[ai][bj][m][n] * W8_INV + bv[bj][n];
#pragma unroll
                        for (int q = 0; q < 2; ++q) { const float glu = fminf(x[2 * q], 7.0f), lin = fminf(fmaxf(x[2 * q + 1], -7.0f), 7.0f);
                            const float sg = __builtin_amdgcn_rcpf(1.0f + __builtin_amdgcn_exp2f(-1.702f * LOG2E * glu));
                            a[2 * n + q] = glu * sg * (lin + 1.0f); } }
                    int w = 0; w = __builtin_amdgcn_cvt_pk_fp8_f32(a[0], a[1], w, false); w = __builtin_amdgcn_cvt_pk_fp8_f32(a[2], a[3], w, true);
                    *(int*)(ub + (size_t)((128 * ai + 16 * m) * 1024 + 64 * bj) + lo) = w; } }
    }
};
struct EpiDown { static constexpr bool PERM = true, AFTER_DRAIN = false; bf16* O; const float* bias; const unsigned* stok;
    __device__ __forceinline__ void operator()(EPI_ARGS) const {
        f32x4 bv[2][2];
        const float* bb = bias + (size_t)u.e * 1024 + u.pn * 256 + 32 * wc + 8 * fq;
#pragma unroll
        for (int bj = 0; bj < 2; ++bj)
#pragma unroll
            for (int n = 0; n < 2; ++n) bv[bj][n] = *(const f32x4*)(bb + 128 * bj + 4 * n);
        const char* spb = (const char*)stok + 4 * (u.pm * 256 + 64 * wr); unsigned so = 4u * (unsigned)fr; asm volatile("" : "+v"(so));
        unsigned yr[2][4];
#pragma unroll
        for (int ai = 0; ai < 2; ++ai)
#pragma unroll
            for (int m = 0; m < 4; ++m) yr[ai][m] = *(const unsigned*)(spb + 4 * (128 * ai + 16 * m) + so);
        char* ub = (char*)O + 2 * (u.pn * 256 + 32 * wc);
        unsigned lo = 2u * (unsigned)(8 * fq); asm volatile("" : "+v"(lo));
#pragma unroll
        for (int ai = 0; ai < 2; ++ai)
#pragma unroll
            for (int m = 0; m < 4; ++m) { const unsigned ro = yr[ai][m] * (unsigned)(DM * 2) + lo;
                if (yr[ai][m] != (unsigned)(4 * T)) {
#pragma unroll
                    for (int bj = 0; bj < 2; ++bj)
                        *(v4u*)(ub + (size_t)(256 * bj) + ro) = pack8(acc[ai][bj][m][0] * W8_INV + bv[bj][0], acc[ai][bj][m][1] * W8_INV + bv[bj][1]); } }
    }
};
__device__ __forceinline__ int qkv_rowmap(int n) { return (n & ~255) + ((n >> 5) & 1) * 128 + ((n >> 6) & 3) * 32 + (n & 31); }
__device__ __forceinline__ void p0_transpose_item(const float* W, int K, int N, bf16* WT, int rowmode, LAS float* scr, int item, int lane) {
    const int nblk = N / 64, kb = item / nblk, nb = item - kb * nblk, k0 = 64 * kb, n0 = 64 * nb;
    const int r = lane >> 4, cq = lane & 15;
    f32x4 t[16];
#pragma unroll
    for (int i = 0; i < 16; ++i) t[i] = __builtin_nontemporal_load((const f32x4*)(W + (size_t)(k0 + 4 * i + r) * N + n0 + 4 * cq));
#pragma unroll
    for (int i = 0; i < 16; ++i) { LAS float* s = scr + (4 * i + r) * 65 + 4 * cq; s[0] = t[i].x; s[1] = t[i].y; s[2] = t[i].z; s[3] = t[i].w; }
    LDS_WAIT(); asm volatile("" ::: "memory");
    const int c = lane & 7, nn = lane >> 3;
#pragma unroll
    for (int j = 0; j < 8; ++j) { const int n = nn + 8 * j; const LAS float* s = scr + (8 * c) * 65 + n;
        v4u o; o.x = pk2(s[0 * 65], s[1 * 65]); o.y = pk2(s[2 * 65], s[3 * 65]); o.z = pk2(s[4 * 65], s[5 * 65]); o.w = pk2(s[6 * 65], s[7 * 65]);
        const int row = rowmode ? qkv_rowmap(n0 + n) : (n0 + n);
        __builtin_nontemporal_store(o, (GAS v4u*)(WT + (size_t)row * K + k0 + 8 * c)); }
    LDS_WAIT(); asm volatile("" ::: "memory");
}
__device__ __forceinline__ void p0_transpose_item_f8(const float* W, int K, int N, unsigned char* WT, LAS float* scr, int item, int lane) {
    const int nblk = N / 64, kb = item / nblk, nb = item - kb * nblk, k0 = 64 * kb, n0 = 64 * nb;
    const int r = lane >> 4, cq = lane & 15;
    f32x4 t[16];
#pragma unroll
    for (int i = 0; i < 16; ++i) t[i] = __builtin_nontemporal_load((const f32x4*)(W + (size_t)(k0 + 4 * i + r) * N + n0 + 4 * cq));
#pragma unroll
    for (int i = 0; i < 16; ++i) { LAS float* s = scr + (4 * i + r) * 65 + 4 * cq; s[0] = t[i].x; s[1] = t[i].y; s[2] = t[i].z; s[3] = t[i].w; }
    LDS_WAIT(); asm volatile("" ::: "memory");
    const int c = lane & 3, nn = lane >> 2;
#pragma unroll
    for (int j = 0; j < 4; ++j) { const int n = nn + 16 * j; const LAS float* s = scr + (16 * c) * 65 + n; v4u o;
#pragma unroll
        for (int q = 0; q < 4; ++q) { int w = 0; w = __builtin_amdgcn_cvt_pk_fp8_f32(s[(4 * q) * 65] * W8_SCALE, s[(4 * q + 1) * 65] * W8_SCALE, w, false);
            w = __builtin_amdgcn_cvt_pk_fp8_f32(s[(4 * q + 2) * 65] * W8_SCALE, s[(4 * q + 3) * 65] * W8_SCALE, w, true); o[q] = (unsigned)w; }
        __builtin_nontemporal_store(o, (GAS v4u*)(WT + (size_t)(n0 + n) * K + k0 + 16 * c)); }
    LDS_WAIT(); asm volatile("" ::: "memory");
}
struct WgItem { const float* W; unsigned char* WT; int N, kb, nb; };
__device__ __forceinline__ void p0_wg_load(const WgItem& I, f32x4 (&t)[16], int wave, int lane) {
#pragma unroll
    for (int i = 0; i < 16; ++i) t[i] = __builtin_nontemporal_load((const f32x4*)(I.W + (size_t)(128 * I.kb + 16 * wave + i) * I.N + 256 * I.nb + 4 * lane));
}
__device__ __forceinline__ void p0_wg_stage(const f32x4 (&t)[16], LAS float* tile, int wave, int lane) {
#pragma unroll
    for (int i = 0; i < 16; ++i) *(LAS f32x4*)(tile + (16 * wave + i) * 260 + 4 * (lane ^ wave)) = t[i];
}
__device__ __forceinline__ void p0_wg_store(const WgItem& I, LAS float* tile, int tid) {
    const int c = tid & 7, k0 = 128 * I.kb, n0 = 256 * I.nb;
#pragma unroll
    for (int j = 0; j < 4; ++j) { const int n = (tid >> 3) + 64 * j; const LAS float* s = tile + (16 * c) * 260 + (n ^ (4 * c)); v4u o;
#pragma unroll
        for (int q = 0; q < 4; ++q) { int w = 0; w = __builtin_amdgcn_cvt_pk_fp8_f32(s[(4 * q) * 260] * W8_SCALE, s[(4 * q + 1) * 260] * W8_SCALE, w, false);
            w = __builtin_amdgcn_cvt_pk_fp8_f32(s[(4 * q + 2) * 260] * W8_SCALE, s[(4 * q + 3) * 260] * W8_SCALE, w, true); o[q] = (unsigned)w; }
        __builtin_nontemporal_store(o, (GAS v4u*)(I.WT + (size_t)(n0 + n) * 1024 + k0 + 16 * c)); }
}
constexpr int CONV_PER_LAYER = 32 * 64 + 32 * 32, CONV_UP_PER = 5, CONV_DN_PER = 3, CONV_QKV_PER = 6;
constexpr bool CONV_DEFER = !MK_PER_PHASE;
__device__ __forceinline__ WgItem conv_item(Frame& F, int L, int j) { WgItem I;
    if (j < 2048) { const int le = L * 32 + (j >> 6), r = j & 63; I.W = argp(I_EWGU) + (size_t)le * 1024 * 2048; I.N = 2048; I.WT = (unsigned char*)(F.ws + WS_WEXP_GU) + (size_t)le * 2048 * 1024; I.kb = r >> 3; I.nb = r & 7; }
    else { const int q = j - 2048, le = L * 32 + (q >> 5), r = q & 31; I.W = argp(I_EWD) + (size_t)le * 1024 * 1024; I.N = 1024; I.WT = (unsigned char*)(F.ws + WS_WEXP_DN) + (size_t)le * 1024 * 1024; I.kb = r >> 2; I.nb = r & 3; }
    return I; }
__device__ __forceinline__ void conv_range(Frame& F, int L, int lo, int hi, int rank, int stride) { const int tid = otid(), lane = tid & 63;
    __syncthreads();
    f32x4 t[16]; int it = lo + rank;
    if (it < hi) p0_wg_load(conv_item(F, L, it), t, F.wave, lane);
    for (; it < hi; it += stride) {
        p0_wg_stage(t, (LAS float*)F.lds, F.wave, lane);
        __syncthreads();
        if (it + stride < hi) p0_wg_load(conv_item(F, L, it + stride), t, F.wave, lane);
        p0_wg_store(conv_item(F, L, it), (LAS float*)F.lds, tid);
        __syncthreads();
    }
}
__device__ __forceinline__ void conv_tail(Frame& F, int L, int rem, int per) {
    const int c0 = (int)F.MISC[MW_CONV]; const int fre = rem ? F.G - rem : 0; int n = per * fre; if (n > CONV_PER_LAYER - c0) n = CONV_PER_LAYER - c0;
    if (rem && F.bx >= rem) conv_range(F, L, c0, c0 + n, F.bx - rem, fre); else __syncthreads();
    if (otid() == 0) F.MISC[MW_CONV] = (unsigned)(c0 + n);
}
__device__ __forceinline__ float siluf(float v) { return v / (1.f + __expf(-v)); }
__device__ __forceinline__ void p0_prologue(Frame& F) { const int tid = otid(), lane = tid & 63; (void)tid; (void)lane;
    {
        LAS float* sc = (LAS float*)(F.lds);
        LAS float* red = sc + 2048;
        { const float* c0 = argp(I_C); const float* c1 = argp(I_CCTX);
          for (int i = tid; i < 2048; i += NTHR) { const int s = i >> 10, k = i & 1023; sc[i] = siluf(s == 0 ? c0[k] : c1[k]); } }
        __syncthreads();
        const float* adaw = argp(I_ADAW); const float* adab = argp(I_ADAB);
        for (int task = F.bx; task < 4 * 48; task += F.G) {
            const int L = task / 48, n0 = (task % 48) * 128;
            const float* w = adaw + (size_t)L * DM * 6144 + n0 + 2 * lane;
            float a0 = 0.f, a1 = 0.f, b0 = 0.f, b1 = 0.f;
#pragma unroll 8
            for (int kk = 0; kk < 128; ++kk) { const int k = 128 * F.wave + kk; const f32x2 x = *(const f32x2*)(w + (size_t)k * 6144); const float sl = sc[k], sx = sc[1024 + k];
                a0 += sl * x.x; a1 += sl * x.y; b0 += sx * x.x; b1 += sx * x.y; }
            red[(F.wave * 2 + 0) * 128 + 2 * lane] = a0; red[(F.wave * 2 + 0) * 128 + 2 * lane + 1] = a1;
            red[(F.wave * 2 + 1) * 128 + 2 * lane] = b0; red[(F.wave * 2 + 1) * 128 + 2 * lane + 1] = b1;
            __syncthreads();
            if (tid < 256) { const int s = tid >> 7, col = tid & 127; float v = adab[(size_t)L * 6144 + n0 + col];
#pragma unroll
                for (int wv = 0; wv < 8; ++wv) v += red[(wv * 2 + s) * 128 + col];
                ((float*)(F.ws + WS_MOD))[(size_t)(L * 2 + s) * 6144 + n0 + col] = v; }
            __syncthreads();
        }
    }
    {
        const int gt = F.bx * NTHR + tid, NGT = F.G * NTHR;
        bf16* fc = (bf16*)(F.ws + TB_FC); bf16* fa = (bf16*)(F.ws + TB_FA); bf16* fcc = (bf16*)(F.ws + TB_FCC); bf16* fx = (bf16*)(F.ws + TB_FX);
        float* twc = (float*)(F.ws + TB_TWC); float* tws = (float*)(F.ws + TB_TWS); float* ropc = (float*)(F.ws + TB_ROPC); float* rops = (float*)(F.ws + TB_ROPS);
        for (int i = gt; i < 512 * 256; i += NGT) { const int row = i >> 8, c = i & 255, part = row >> 8, l = row & 255; const int m = (c * l) & 255;
            const float ang = (float)m * (2.0f / 256.0f); const float v = part == 0 ? cospif(ang) : -sinpif(ang); fc[i] = (bf16)f2bf(v * (1.0f / 16.0f)); }
        for (int i = gt; i < 256 * 256; i += NGT) { const int row = i >> 8, col = i & 255, pr = row >> 7, k1 = row & 127, pc = col >> 7, n1 = col & 127; const int m = (n1 * k1) & 127;
            const float ang = (float)m * (2.0f / 128.0f); const float cs = cospif(ang), sn = sinpif(ang);
            const float v = (pr == pc) ? cs : (pr == 0 ? sn : -sn); fa[i] = (bf16)f2bf(v * 0.08838834764831845f); }
        for (int i = gt; i < 256 * 256; i += NGT) { const int row = i >> 8, col = i & 255, pc = col >> 7, n2 = col & 127; float v = 0.f;
            if (row < 128) { const int m = (n2 * row) & 127; const float ang = (float)m * (2.0f / 128.0f); v = (pc == 0 ? cospif(ang) : sinpif(ang)) * 0.08838834764831845f; }
            fcc[i] = (bf16)f2bf(v); }
        for (int i = gt; i < 256 * 512; i += NGT) { const int k = i >> 9, col = i & 511, pc = col >> 8, n = col & 255; const int m = (n * k) & 255;
            const float ang = (float)m * (2.0f / 256.0f); fx[i] = (bf16)f2bf((pc == 0 ? cospif(ang) : sinpif(ang)) * (1.0f / 16.0f)); }
        for (int i = gt; i < 128 * 128; i += NGT) { const int k1 = i >> 7, n2 = i & 127; const float ang = (float)(k1 * n2) * (2.0f / 16384.0f); twc[i] = cospif(ang); tws[i] = sinpif(ang); }
        for (int i = gt; i < NLAT * 32; i += NGT) { const int t = i >> 5, j = i & 31; const float pos = (float)(j < 16 ? (t >> 6) : (t & 63));
            const float inv = powf(10000.0f, -(float)(j & 15) * (1.0f / 16.0f)); const float ang = pos * inv; float sn, cs; sincosf(ang, &sn, &cs); ropc[i] = cs; rops[i] = sn; }
        bf16* rw = (bf16*)(F.ws + WS_RW); const float* rwin = argp(I_RW);
        for (int i = gt; i < 4 * 32 * 1024; i += NGT) { const int L = i >> 15, e = (i >> 10) & 31, k = i & 1023; rw[i] = (bf16)f2bf(rwin[((size_t)L * 1024 + k) * 32 + e]); }
    }
    __syncthreads();
    {
        LAS float* scr = (LAS float*)(F.lds) + F.wave * (64 * 65);
        const int gw = F.vcu * NWAVES + F.wave, NGW = F.G * NWAVES;
        constexpr int I1 = 16 * 16, I2 = 16 * 24, I3 = 16 * 16, I4 = 16 * 64, I5 = 32 * 16, I6 = 16 * 20, I7 = 16 * 16, ISM = I1 + I2 + I3 + I4 + I5 + I6 + I7;
        for (int it = gw; it < ISM; it += NGW) {
            int r = it;
            if (r < I1) { p0_transpose_item(argp(I_FNW), 1024, 1024, (bf16*)(F.ws + WS_WFN), 0, scr, r, lane); continue; } r -= I1;
            if (r < I2) { p0_transpose_item(argp(I_FAWQ), 1024, FA_NQKV, (bf16*)(F.ws + WS_WFAQ), 1, scr, r, lane); continue; } r -= I2;
            if (r < I3) { p0_transpose_item(argp(I_FAWO), 1024, 1024, (bf16*)(F.ws + WS_WFAO), 0, scr, r, lane); continue; } r -= I3;
            if (r < I4) { p0_transpose_item(argp(I_GMWI), 1024, GM_FF, (bf16*)(F.ws + WS_WGI), 0, scr, r, lane); continue; } r -= I4;
            if (r < I5) { p0_transpose_item(argp(I_GMWO), 2048, 1024, (bf16*)(F.ws + WS_WGO), 0, scr, r, lane); continue; } r -= I5;
            if (r < I6) { p0_transpose_item(argp(I_WAWQ), 1024, WA_NQKV, (bf16*)(F.ws + WS_WWQ), 1, scr, r, lane); continue; } r -= I6;
            p0_transpose_item(argp(I_WAWO), 1024, 1024, (bf16*)(F.ws + WS_WWO), 0, scr, r, lane);
        }
        __syncthreads();
        for (int L = 0; L < (CONV_DEFER ? 1 : 4); ++L) conv_range(F, L, 0, CONV_PER_LAYER, F.vcu, F.G);
    }
}

__device__ __forceinline__ void stok_fill(Frame& F) { const int tid = otid(); unsigned* STOK = (unsigned*)(F.ws + WS_STOK);
    for (int i = F.bx * NTHR + tid; i < 32 * ECAP; i += F.G * NTHR) STOK[i] = (unsigned)(4 * T);
}
__device__ __forceinline__ void init_row(Frame& F, int m, int lane, const RowV& x, const RowV& sc, const RowV& sh) { RowV h;
#pragma unroll
    for (int j = 0; j < 4; ++j) h.v[j] = x.v[j] * (1.f + sc.v[j]) + sh.v[j];
    strow_bf16((bf16*)(F.ws + WS_H) + (size_t)m * DM, lane, h); }
__device__ __forceinline__ void pass_init(Frame& F) { const int tid = otid(), lane = tid & 63; (void)tid; (void)lane;
    stok_fill(F);
    const int gw = F.vcu * NWAVES + F.wave, NGW = F.G * NWAVES;
    RowV sh = ldrow(modp(F, 0, 0, 0), lane), sc = ldrow(modp(F, 0, 0, 1), lane);
    const float* xin = argp(I_X);
    for (int m = gw; m < NLAT; m += 4 * NGW) {
        RowV x[4];
#pragma unroll
        for (int q = 0; q < 4; ++q) { const int mq = m + q * NGW; x[q] = ldrow(xin + (size_t)(mq < NLAT ? mq : m) * DM, lane); }
#pragma unroll
        for (int q = 0; q < 4; ++q) { const int mq = m + q * NGW; if (mq < NLAT) init_row(F, mq, lane, x[q], sc, sh); }
    }
    { const int c0 = F.wave * F.G + F.vcu;
      if (c0 < NCTX) { sh = ldrow(modp(F, 0, 1, 0), lane); sc = ldrow(modp(F, 0, 1, 1), lane);
          for (int c = c0; c < NCTX; c += NGW) { const RowV x = ldrow(argp(I_CTX) + (size_t)c * DM, lane); init_row(F, NLAT + c, lane, x, sc, sh); } } }
}

struct RawRow { v2u w[4]; };
__device__ __forceinline__ RawRow ldraw_bf16(const bf16* p, int lane) { RawRow r; const v2u* q = (const v2u*)p + lane;
#pragma unroll
    for (int j = 0; j < 4; ++j) r.w[j] = q[64 * j]; return r; }
__device__ __forceinline__ RowV cvrow(const RawRow& r) { RowV o;
#pragma unroll
    for (int j = 0; j < 4; ++j) o.v[j] = (f32x4){bf_lo(r.w[j].x), bf_hi(r.w[j].x), bf_lo(r.w[j].y), bf_hi(r.w[j].y)}; return o; }
template <int L> __device__ __forceinline__ void pass_mix(Frame& F) { const int tid = otid(), lane = tid & 63; (void)tid; (void)lane;
    constexpr bool HAS_CTX = L < 3, MIX_ON = (EN_MIX >> L) & 1, MOE_ON = (EN_MOE >> L) & 1;
    constexpr int HP = 1032;
    LAS bf16* HT = (LAS bf16*)(F.lds);
    LAS float* PART = (LAS float*)(F.lds + 32 * HP * 2);
    LAS float* LOGT = PART + 8 * 32 * 33;
    volatile LAS unsigned* LC = F.MISC + MW_LC;
    const bf16* X = (const bf16*)(F.ws + WS_X); bf16* X2 = (bf16*)(F.ws + WS_X2); bf16* H = (bf16*)(F.ws + WS_H); const bf16* Y = (const bf16*)(F.ws + WS_Y);
    const float* xin = argp(I_X); const float* cin = argp(I_CTX);
    float* GATE = (float*)(F.ws + WS_GATE); unsigned* STOK = (unsigned*)(F.ws + WS_STOK);
    LAS unsigned* ASL = (LAS unsigned*)(F.lds + 32 * HP * 2 + 8 * 32 * 33 * 4 + 32 * 33 * 4);
    const bf16* RW = (const bf16*)(F.ws + WS_RW) + (size_t)L * 32 * 1024;
    if (CONV_DEFER) { const int donec = (int)F.MISC[MW_CONV];
        if (L >= 1) conv_range(F, L, donec, CONV_PER_LAYER, F.vcu, F.G); else __syncthreads();
        if (tid == 0) F.MISC[MW_CONV] = 0u; }
    if (tid < 32) LC[tid] = 0u;
    ASL[tid] = 0xFFFFFFFFu;
    __syncthreads();
    int ti = 0;
    const float* rbias = argp(I_RB);
    const int nlt = NLAT / 32, nct = HAS_CTX ? NCTX : 0;
    int cur_s = -1; RowV g1, lg, lb, sc2, sh2;
    for (int it = F.bx; it < nlt + nct; it += F.G) {
        const bool isl = it < nlt; const int s = isl ? 0 : 1; const int row0 = isl ? it * 32 : NLAT + (it - nlt); const int nrows = isl ? 32 : 1;
        if (s != cur_s) { cur_s = s; g1 = ldrow(modp(F, L, s, 2), lane); sh2 = ldrow(modp(F, L, s, 3), lane); sc2 = ldrow(modp(F, L, s, 4), lane);
            lg = ldrow(argp(I_LNMG) + L * DM, lane); lb = ldrow(argp(I_LNMB) + L * DM, lane); }
        const int nr = isl ? 4 : (F.wave == 0 ? 1 : 0);
        RowV xf[4]; RawRow xr[4], yr[4];
#pragma unroll
        for (int q_ = 0; q_ < 4; ++q_) if (q_ < nr) { const int m = row0 + F.wave * 4 + q_;
            if (L == 0) xf[q_] = ldrow(m < NLAT ? xin + (size_t)m * DM : cin + (size_t)(m - NLAT) * DM, lane);
            else xr[q_] = ldraw_bf16(X + (size_t)m * DM, lane);
            if (MIX_ON) yr[q_] = ldraw_bf16(Y + (size_t)m * DM, lane); }
#pragma unroll
        for (int q_ = 0; q_ < 4; ++q_) if (q_ < nr) { const int rr = F.wave * 4 + q_; const int m = row0 + rr;
            RowV x = (L == 0) ? xf[q_] : cvrow(xr[q_]);
            if (MIX_ON) { const RowV y = cvrow(yr[q_]);
#pragma unroll
                for (int j = 0; j < 4; ++j) x.v[j] = x.v[j] * DN_ALPHA + g1.v[j] * y.v[j]; }
            else {
#pragma unroll
                for (int j = 0; j < 4; ++j) x.v[j] = x.v[j] * DN_ALPHA; }
            x = ln_row(x, lg, lb);
            strow_bf16(X2 + (size_t)m * DM, lane, x);
            RowV h;
#pragma unroll
            for (int j = 0; j < 4; ++j) h.v[j] = x.v[j] * (1.f + sc2.v[j]) + sh2.v[j];
            { unsigned* q8 = (unsigned*)((unsigned char*)(F.ws + WS_H8) + (size_t)m * DM) + lane;
#pragma unroll
              for (int j = 0; j < 4; ++j) { int w = 0; w = __builtin_amdgcn_cvt_pk_fp8_f32(h.v[j].x, h.v[j].y, w, false); w = __builtin_amdgcn_cvt_pk_fp8_f32(h.v[j].z, h.v[j].w, w, true); q8[64 * j] = (unsigned)w; } }
            if (MOE_ON) { LAS unsigned long long* q = (LAS unsigned long long*)(HT + rr * HP) + lane;
#pragma unroll
                for (int j = 0; j < 4; ++j) q[64 * j] = (unsigned long long)pk2(h.v[j].x, h.v[j].y) | ((unsigned long long)pk2(h.v[j].z, h.v[j].w) << 32); }
        }
        if (MOE_ON) {
            __syncthreads();
            { const int r32 = lane & 31, hi = lane >> 5; f32x16 acc = f32x16{};
#pragma unroll
                for (int st = 0; st < 8; ++st) { const int k = 128 * F.wave + 16 * st + 8 * hi;
                    const bf16x8 a = *(const LAS bf16x8*)(HT + r32 * HP + k); const bf16x8 b = *(const bf16x8*)(RW + (size_t)r32 * 1024 + k);
                    acc = __builtin_amdgcn_mfma_f32_32x32x16_bf16(a, b, acc, 0, 0, 0); }
#pragma unroll
                for (int r = 0; r < 16; ++r) { const int tok = (r & 3) + 8 * (r >> 2) + 4 * hi; PART[(F.wave * 32 + tok) * 33 + r32] = acc[r]; } }
            __syncthreads();
            { const int t = tid >> 4, e0 = tid & 15;
#pragma unroll
                for (int q = 0; q < 2; ++q) { const int e = e0 + 16 * q; float v = rbias[L * 32 + e];
#pragma unroll
                    for (int wv = 0; wv < 8; ++wv) v += PART[(wv * 32 + t) * 33 + e];
                    LOGT[t * 33 + e] = v; } }
            __syncthreads();
            if (tid < nrows) { const int t = tid; float lv[32];
#pragma unroll
                for (int e = 0; e < 32; ++e) lv[e] = LOGT[t * 33 + e];
                int idx[4]; float val[4]; unsigned taken = 0u;
#pragma unroll
                for (int k = 0; k < 4; ++k) { float best = -INFINITY; int bi = 0;
#pragma unroll
                    for (int e = 0; e < 32; ++e) { const bool ok = !((taken >> e) & 1u) && lv[e] > best; best = ok ? lv[e] : best; bi = ok ? e : bi; }
                    idx[k] = bi; val[k] = best; taken |= 1u << bi; }
                float ev[4], sum = 0.f;
#pragma unroll
                for (int k = 0; k < 4; ++k) { ev[k] = __expf(val[k] - val[0]); sum += ev[k]; }
                const float inv = 1.f / sum; const int m = row0 + t;
#pragma unroll
                for (int k = 0; k < 4; ++k) { const unsigned pos = atomicAdd((unsigned*)&LC[idx[k]], 1u); const int li = (ti & 3) * 128 + t * 4 + k; ASL[li] = ((unsigned)idx[k] << 16) | pos; ASL[512 + li] = (unsigned)(m * 4 + k); GATE[(size_t)m * 4 + k] = ev[k] * inv; } }
            __syncthreads();
        }
        ++ti;
    }
    if (MOE_ON) {
        __syncthreads();
        if (tid < 32) { const unsigned c = LC[tid]; unsigned st = 0u;
            if (c) st = __hip_atomic_fetch_add((unsigned*)(F.ctl + CW_GCNT + (L * 32 + tid) * 64), c, __ATOMIC_RELAXED, __HIP_MEMORY_SCOPE_AGENT);
            F.MISC[MW_TOT + tid] = st; }
        __syncthreads();
        { const unsigned ep = ASL[tid]; if (ep != 0xFFFFFFFFu) { const unsigned e = ep >> 16, pos = ep & 0xffffu; STOK[(size_t)e * ECAP + F.MISC[MW_TOT + e] + pos] = ASL[512 + tid]; } }
    }
}

template <int L> __device__ __forceinline__ void moe_tables(Frame& F) { const int tid = otid();
    if (tid < 64) {
        const int e = tid & 31;
        const unsigned cnt = tid < 32 ? __hip_atomic_load((unsigned*)(F.ctl + CW_GCNT + (L * 32 + e) * 64), RLX_AGENT) : 0u;
        const unsigned tiles = (cnt + 255u) >> 8; unsigned incl = tiles;
#pragma unroll
        for (int o = 1; o < 32; o <<= 1) { const unsigned v = (unsigned)__shfl_up((int)incl, o); if (tid >= o) incl += v; }
        const unsigned base = incl - tiles;
        if (tid < 32) for (unsigned q = 0; q < tiles; ++q) F.MISC[MW_MTE + base + q] = (unsigned)(ECAPT * e) + q;
        if (tid == 31) F.MISC[MW_NMT] = incl; }
    __syncthreads();
}
struct CombIn { RawRow x, y[4]; f32x4 gt; };
template <int L> __device__ __forceinline__ CombIn comb_load(Frame& F, int m, int lane) { CombIn I; constexpr bool MOE_ON = (EN_MOE >> L) & 1;
    const bf16* X2 = (const bf16*)(F.ws + WS_X2); const bf16* YS = (const bf16*)(F.ws + WS_YS); const float* GATE = (const float*)(F.ws + WS_GATE);
    I.x = ldraw_bf16(X2 + (size_t)m * DM, lane);
    if (MOE_ON) { I.gt = *(const f32x4*)(GATE + (size_t)m * 4);
#pragma unroll
        for (int k = 0; k < 4; ++k) I.y[k] = ldraw_bf16(YS + ((size_t)m * 4 + k) * DM, lane); }
    return I; }
template <int L> __device__ __forceinline__ void comb_row(Frame& F, int m, int lane, const CombIn& I, const RowV& g2, const RowV& lg, const RowV& lb, const RowV& sc, const RowV& sh) {
    constexpr bool MOE_ON = (EN_MOE >> L) & 1;
    bf16* X = (bf16*)(F.ws + WS_X); bf16* H = (bf16*)(F.ws + WS_H);
    RowV x = cvrow(I.x);
    if (MOE_ON) { RowV f;
#pragma unroll
        for (int j = 0; j < 4; ++j) f.v[j] = (f32x4){0.f, 0.f, 0.f, 0.f};
#pragma unroll
        for (int k = 0; k < 4; ++k) { const RowV y = cvrow(I.y[k]);
#pragma unroll
            for (int j = 0; j < 4; ++j) f.v[j] += y.v[j] * I.gt[k]; }
#pragma unroll
        for (int j = 0; j < 4; ++j) x.v[j] = x.v[j] * DN_ALPHA + g2.v[j] * f.v[j];
    } else {
#pragma unroll
        for (int j = 0; j < 4; ++j) x.v[j] = x.v[j] * DN_ALPHA; }
    x = ln_row(x, lg, lb);
    if (L < 3) { strow_bf16(X + (size_t)m * DM, lane, x); RowV h;
#pragma unroll
        for (int j = 0; j < 4; ++j) h.v[j] = x.v[j] * (1.f + sc.v[j]) + sh.v[j];
        strow_bf16(H + (size_t)m * DM, lane, h); }
    else strow(((float*)argp(N_IN)) + (size_t)m * DM, lane, x);
}
template <int L> __device__ __forceinline__ void pass_comb(Frame& F) { const int tid = otid(), lane = tid & 63; (void)tid; (void)lane;
    constexpr bool HAS_CTX = L < 3;
    if (L < 3) stok_fill(F);
    const int gw = F.vcu * NWAVES + F.wave, NGW = F.G * NWAVES;
    RowV g2, lg, lb, sc, sh;
    g2 = ldrow(modp(F, L, 0, 5), lane); lg = ldrow(argp(I_LNFG) + L * DM, lane); lb = ldrow(argp(I_LNFB) + L * DM, lane);
    if (L < 3) { sh = ldrow(modp(F, L < 3 ? L + 1 : 0, 0, 0), lane); sc = ldrow(modp(F, L < 3 ? L + 1 : 0, 0, 1), lane); }
    for (int m = gw; m < NLAT; m += 2 * NGW) {
        const int m1 = m + NGW; const bool two = m1 < NLAT;
        const CombIn A = comb_load<L>(F, m, lane); const CombIn B = comb_load<L>(F, two ? m1 : m, lane);
        comb_row<L>(F, m, lane, A, g2, lg, lb, sc, sh);
        if (two) comb_row<L>(F, m1, lane, B, g2, lg, lb, sc, sh);
    }
    if (HAS_CTX) {
        const int c0 = F.wave * F.G + F.vcu;
        if (c0 < NCTX) { g2 = ldrow(modp(F, L, 1, 5), lane); sh = ldrow(modp(F, L < 3 ? L + 1 : 0, 1, 0), lane); sc = ldrow(modp(F, L < 3 ? L + 1 : 0, 1, 1), lane);
            for (int c = c0; c < NCTX; c += NGW) { const CombIn A = comb_load<L>(F, NLAT + c, lane); comb_row<L>(F, NLAT + c, lane, A, g2, lg, lb, sc, sh); } }
    }
}
__device__ __forceinline__ void gate_unit(Frame& F, int t0, int h0, int nh, bool use_pstat) { const int tid = otid(), lane = tid & 63;
    constexpr int WP = 136, VP = 136, OP = 264;
    LAS bf16* WL = (LAS bf16*)(F.lds);
    LAS bf16* VT = (LAS bf16*)(F.lds + 128 * WP * 2);
    LAS bf16* OUT = (LAS bf16*)(F.lds);
    LAS float* STAT = (LAS float*)(F.lds + 128 * WP * 2 + 256 * VP * 2);
    static_assert(128 * OP * 2 <= 128 * WP * 2 + 256 * VP * 2, "OUT overlay");
    const bf16* GU = (const bf16*)(F.ws + WS_GU); const bf16* GV = (const bf16*)(F.ws + WS_GV); bf16* GG = (bf16*)(F.ws + WS_GG);
    const float* ws_ = argp(I_GMWS); const float* bs_ = argp(I_GMBS); const float* vg = argp(I_GMVG); const float* vb = argp(I_GMVB);
    const int r32 = lane & 31, hi = lane >> 5;
    if (use_pstat) {
        const int row = tid >> 2, part = tid & 3; const f32x2* ps = (const f32x2*)((const float*)(F.ws + WS_PSTAT) + ((size_t)(t0 + row) * 32 + 8 * part) * 2); float s = 0.f, s2 = 0.f;
#pragma unroll
        for (int i = 0; i < 8; ++i) { const f32x2 v = ps[i]; s += v.x; s2 += v.y; }
        s += __shfl_xor(s, 1); s += __shfl_xor(s, 2); s2 += __shfl_xor(s2, 1); s2 += __shfl_xor(s2, 2);
        if (part == 0) { const float mean = s * (1.f / GM_HALF); const float var = fmaxf(s2 * (1.f / GM_HALF) - mean * mean, 0.f); STAT[2 * row] = mean; STAT[2 * row + 1] = 1.f / sqrtf(var + LN_EPS); }
    } else {
#ifdef GATE_DUP_STATS
    for (int dup_ = 0; dup_ < 2; ++dup_)
#endif
    for (int bt = 0; bt < 2; ++bt) { v4u raw[8][4]; float s[8], s2[8];
#pragma unroll
        for (int i = 0; i < 8; ++i) { const int q = 16 * F.wave + 8 * bt + i; const v4u* src = (const v4u*)(GV + (size_t)(t0 + q) * GM_HALF) + lane;
#pragma unroll
            for (int j = 0; j < 4; ++j) raw[i][j] = src[64 * j]; }
#pragma unroll
        for (int i = 0; i < 8; ++i) { float a = 0.f, b = 0.f;
#pragma unroll
            for (int j = 0; j < 4; ++j)
#pragma unroll
                for (int e = 0; e < 4; ++e) { const float x0 = bf_lo(raw[i][j][e]), x1 = bf_hi(raw[i][j][e]); a += x0 + x1; b += x0 * x0 + x1 * x1; }
            s[i] = a; s2[i] = b; }
#pragma unroll
        for (int o = 1; o < 64; o <<= 1) {
#pragma unroll
            for (int i = 0; i < 8; ++i) { s[i] += __shfl_xor(s[i], o); s2[i] += __shfl_xor(s2[i], o); } }
        if (lane == 0) {
#pragma unroll
            for (int i = 0; i < 8; ++i) { const int q = 16 * F.wave + 8 * bt + i; const float mean = s[i] * (1.f / GM_HALF); const float var = fmaxf(s2[i] * (1.f / GM_HALF) - mean * mean, 0.f);
                STAT[2 * q] = mean; STAT[2 * q + 1] = 1.f / sqrtf(var + LN_EPS); } } }
    }
    __syncthreads();
    const int wp = tid >> 2, wq0 = (tid & 3) * 32;
    const int vck = tid & 31, vqb0 = tid >> 5;
    const int ck = tid & 31;
    f32x4 wr[8]; v4u wv[8];
    { const f32x4* src = (const f32x4*)(ws_ + ((size_t)h0 * 128 + wp) * 128 + wq0);
#pragma unroll
      for (int i = 0; i < 8; ++i) wr[i] = src[i];
#pragma unroll
      for (int j = 0; j < 8; ++j) wv[j] = *(const v4u*)(GV + (size_t)(t0 + 4 * (vqb0 + 16 * (j >> 2)) + (j & 3)) * GM_HALF + h0 * 256 + 8 * vck); }
    for (int hh = 0; hh < nh; ++hh) { const int h = h0 + hh;
#pragma unroll
        for (int i = 0; i < 4; ++i) { const f32x4 a = wr[2 * i], b = wr[2 * i + 1]; v4u w; w.x = pk2(a[0], a[1]); w.y = pk2(a[2], a[3]); w.z = pk2(b[0], b[1]); w.w = pk2(b[2], b[3]);
            *(LAS v4u*)(WL + wp * WP + wq0 + 8 * i) = w; }
        { const f32x4 g0 = *(const f32x4*)(vg + h * 256 + 8 * vck), g1 = *(const f32x4*)(vg + h * 256 + 8 * vck + 4), b0 = *(const f32x4*)(vb + h * 256 + 8 * vck), b1 = *(const f32x4*)(vb + h * 256 + 8 * vck + 4);
#pragma unroll
            for (int bk = 0; bk < 2; ++bk) { const int q0 = 4 * (vqb0 + 16 * bk); float x[4][8];
#pragma unroll
                for (int r = 0; r < 4; ++r) { const v4u w = wv[4 * bk + r]; const float mean = STAT[2 * (q0 + r)], rstd = STAT[2 * (q0 + r) + 1];
#pragma unroll
                    for (int i = 0; i < 4; ++i) { x[r][2 * i] = (bf_lo(w[i]) - mean) * rstd; x[r][2 * i + 1] = (bf_hi(w[i]) - mean) * rstd; } }
#pragma unroll
                for (int i = 0; i < 8; ++i) { const float gg = i < 4 ? g0[i & 3] : g1[i & 3], bb = i < 4 ? b0[i & 3] : b1[i & 3];
                    v2u w; w.x = pk2(x[0][i] * gg + bb, x[1][i] * gg + bb); w.y = pk2(x[2][i] * gg + bb, x[3][i] * gg + bb);
                    *(LAS v2u*)(VT + (8 * vck + i) * VP + q0) = w; } } }
        if (hh + 1 < nh) { const f32x4* src = (const f32x4*)(ws_ + ((size_t)(h + 1) * 128 + wp) * 128 + wq0);
#pragma unroll
            for (int i = 0; i < 8; ++i) wr[i] = src[i];
#pragma unroll
            for (int j = 0; j < 8; ++j) wv[j] = *(const v4u*)(GV + (size_t)(t0 + 4 * (vqb0 + 16 * (j >> 2)) + (j & 3)) * GM_HALF + (h + 1) * 256 + 8 * vck); }
        v4u uo[8];
#pragma unroll
        for (int j = 0; j < 8; ++j) { const int p = (tid >> 5) + 16 * j; uo[j] = *(const v4u*)(GU + (size_t)(t0 + p) * GM_HALF + h * 256 + 8 * ck); }
        __syncthreads();
        const int wm = F.wave >> 2, wn = F.wave & 3; f32x16 acc[2][2];
#pragma unroll
        for (int i = 0; i < 2; ++i)
#pragma unroll
            for (int jn = 0; jn < 2; ++jn) acc[i][jn] = f32x16{};
#pragma unroll
        for (int ks = 0; ks < 8; ++ks) { bf16x8 a[2], b[2];
#pragma unroll
            for (int i = 0; i < 2; ++i) { a[i] = *(const LAS bf16x8*)(VT + (64 * wn + 32 * i + r32) * VP + 16 * ks + 8 * hi); b[i] = *(const LAS bf16x8*)(WL + (64 * wm + 32 * i + r32) * WP + 16 * ks + 8 * hi); }
#pragma unroll
            for (int i = 0; i < 2; ++i)
#pragma unroll
                for (int jn = 0; jn < 2; ++jn) acc[i][jn] = __builtin_amdgcn_mfma_f32_32x32x16_bf16(a[i], b[jn], acc[i][jn], 0, 0, 0); }
        __syncthreads();
#pragma unroll
        for (int jn = 0; jn < 2; ++jn) { const int p = 64 * wm + 32 * jn + r32; const float bias = bs_[h * 128 + p];
#pragma unroll
            for (int i = 0; i < 2; ++i)
#pragma unroll
                for (int rg = 0; rg < 4; ++rg) { const int c = 64 * wn + 32 * i + 8 * rg + 4 * hi;
                    v2u w; w.x = pk2(acc[i][jn][4 * rg] + bias, acc[i][jn][4 * rg + 1] + bias); w.y = pk2(acc[i][jn][4 * rg + 2] + bias, acc[i][jn][4 * rg + 3] + bias);
                    *(LAS v2u*)(OUT + p * OP + c) = w; } }
        __syncthreads();
#ifdef GATE_DUP_EPI
        for (int dup_ = 0; dup_ < 2; ++dup_) {
#endif
#pragma unroll
        for (int j = 0; j < 8; ++j) { const int p = (tid >> 5) + 16 * j; const size_t off = (size_t)(t0 + p) * GM_HALF + h * 256 + 8 * ck;
            const v4u oo = *(const LAS v4u*)(OUT + p * OP + 8 * ck); v4u g;
#pragma unroll
            for (int e = 0; e < 4; ++e) g[e] = pk2(bf_lo(uo[j][e]) * bf_lo(oo[e]), bf_hi(uo[j][e]) * bf_hi(oo[e]));
            *(v4u*)(GG + off) = g; }
#ifdef GATE_DUP_EPI
        }
#endif
        __syncthreads();
    }
}
__device__ __forceinline__ void gate_phase(Frame& F) {
    for (int uid = F.bx; uid < 2 * (NLAT / 128); uid += F.G) gate_unit(F, (uid >> 1) * 128, 4 * (uid & 1), 4, true);
    if ((F.bx & 15) == 0 && (F.bx >> 4) < 16) { const int su = F.bx >> 4; gate_unit(F, NLAT + (su >> 3) * 128, su & 7, 1, true); }
}

template <int MODE> __device__ __forceinline__ void attn_phase(Frame& F, char* lds_generic) {
    using abf = attn_body::bf16;
    const abf* Q = (const abf*)(F.ws + WS_Q); const abf* K = (const abf*)(F.ws + WS_K); const abf* V = (const abf*)(F.ws + WS_V); abf* O = (abf*)(F.ws + WS_O);
    constexpr int U = 1024; const int per = (U + F.G - 1) / F.G;
    float mstat = 0.f;
    if (MODE == 0) { const float* gq = argp(I_FAQN); const float* gk = argp(I_FAKN); float mq = 0.f, mk = 0.f;
        for (int d = 0; d < 64; ++d) { mq = fmaxf(mq, fabsf(gq[d])); mk = fmaxf(mk, fabsf(gk[d])); }
        mstat = fminf(64.f * QSCALE * mq * mk, 100.f); }
    for (int i = 0; i <= per; ++i) {
        int h, kvh, q0, NT, kbase; float sink = 0.f;
        if (i < per) { const int id = F.vcu * per + i; if (id >= U) continue; const int x = id >> 7, r = id & 127; const int qb = (r >> 2) * 2 + (r & 1);
            q0 = 256 * qb;
            if (MODE == 0) { kvh = x >> 1; h = kvh * 4 + (x & 1) * 2 + ((r & 3) >> 1); NT = T / 64; kbase = 0; }
            else { h = 2 * x + ((r & 3) >> 1); kvh = h >> 3; const int ks = q0 >= 128 ? q0 - 128 : 0, ke = (q0 + 384) < NLAT ? (q0 + 384) : NLAT; kbase = ks; NT = 4 + (ke - ks) / 64; sink = argp(I_WASK)[h] * LOG2E; } }
        else { if (MODE != 0) continue; if ((F.vcu & 15) != 0 || (F.vcu >> 4) >= 16) continue; h = F.vcu >> 4; kvh = h >> 2; q0 = NLAT; NT = 4; kbase = NLAT; }
        if constexpr (MODE == 0) attn_body::attn_unit_q8<256>(h, kvh, q0, NT, kbase, mstat, (const unsigned char*)(F.ws + WS_Q8), (const unsigned char*)(F.ws + WS_K8), V, O, lds_generic);
        else attn_body::attn_unit<1, 128, 8>(h, kvh, q0, NT, kbase, sink, Q, K, V, O, lds_generic);
    }
}
struct CtxEpiY { bf16* Y; const float* bias;
    __device__ __forceinline__ void operator()(int row, int col, float (&v)[4]) const { const f32x4 b = *(const f32x4*)(bias + col);
        v2u w; w.x = pk2(v[0] + b[0], v[1] + b[1]); w.y = pk2(v[2] + b[2], v[3] + b[3]); *(v2u*)(Y + (size_t)row * DM + col) = w; } };
struct CtxEpiGelu { bf16* U; bf16* V; const float* bias; float* pstat;
    __device__ __forceinline__ void operator()(int row, int col, float (&v)[4]) const { const f32x4 b = *(const f32x4*)(bias + col);
        const pg8::f32x2 a = pg8::gelu_pk((pg8::f32x2){v[0] + b[0], v[1] + b[1]}), c = pg8::gelu_pk((pg8::f32x2){v[2] + b[2], v[3] + b[3]});
        v2u w; w.x = pk2(a.x, a.y); w.y = pk2(c.x, c.y); bf16* dst = col < GM_HALF ? U + (size_t)row * GM_HALF + col : V + (size_t)row * GM_HALF + (col - GM_HALF); *(v2u*)dst = w;
        if (col >= GM_HALF) { float s = (a.x + a.y) + (c.x + c.y), s2 = (a.x * a.x + a.y * a.y) + (c.x * c.x + c.y * c.y);
            s += __shfl_xor(s, 1); s += __shfl_xor(s, 2); s += __shfl_xor(s, 4); s += __shfl_xor(s, 8); s2 += __shfl_xor(s2, 1); s2 += __shfl_xor(s2, 2); s2 += __shfl_xor(s2, 4); s2 += __shfl_xor(s2, 8);
            if ((col & 63) == 0) *(f32x2*)(pstat + ((size_t)row * 32 + ((col - GM_HALF) >> 6)) * 2) = (f32x2){s, s2}; } } };
template <int NKV, bool RMS> struct CtxEpiQKV { bf16* Q; const float* bias; const float* qn; const float* kn;
    __device__ __forceinline__ void operator()(int row, int col, float (&v)[4]) const {
        const int hh = col >> 6, d = col & 63; const int kind = hh < 16 ? 0 : (hh < 16 + NKV ? 1 : 2);
        const f32x4 b = *(const f32x4*)(bias + col);
#pragma unroll
        for (int i = 0; i < 4; ++i) v[i] += b[i];
        if (RMS) { float ss = (v[0] * v[0] + v[1] * v[1]) + (v[2] * v[2] + v[3] * v[3]);
            ss += __shfl_xor(ss, 1); ss += __shfl_xor(ss, 2); ss += __shfl_xor(ss, 4); ss += __shfl_xor(ss, 8);
            const float rs = 1.f / sqrtf(ss * (1.f / 64.f) + RMS_EPS); const f32x4 gq = *(const f32x4*)(qn + d), gk = *(const f32x4*)(kn + d);
            if (kind < 2) {
#pragma unroll
                for (int i = 0; i < 4; ++i) v[i] = v[i] * rs * (kind == 0 ? gq[i] : gk[i]); } }
        if (kind == 0) {
#pragma unroll
            for (int i = 0; i < 4; ++i) v[i] *= QSCALE; }
        const int pitch = kind == 0 ? DM : NKV * 64, hd = kind == 0 ? hh : (kind == 1 ? hh - 16 : hh - 16 - NKV);
        const size_t doff = kind == 0 ? (size_t)0 : (kind == 1 ? (size_t)(WS_K - WS_Q) : (size_t)(WS_V - WS_Q));
        if (RMS && kind < 2) { *(unsigned*)((char*)Q + (kind == 0 ? (size_t)(WS_Q8 - WS_Q) : (size_t)(WS_K8 - WS_Q)) + (size_t)row * pitch + hd * 64 + d) = pk4f8(v[0], v[1], v[2], v[3]); return; }
        v2u w; w.x = pk2(v[0], v[1]); w.y = pk2(v[2], v[3]); *(v2u*)((bf16*)((char*)Q + doff) + (size_t)row * pitch + hd * 64 + d) = w; } };
template <class Epi> __device__ __forceinline__ void ctx_gemm(Frame& F, const bf16* A, const bf16* Bt, int N, int K, int rowmode, const Epi& E, int bfirst = -1, int bstride = 0) {
    const int tid = otid(), lane = tid & 63, r32 = lane & 31, hi = lane >> 5;
    LAS float* PART = (LAS float*)(F.lds);
    const int nblk = 8 * (N / 64), kw = K / 8;
    if (bfirst < 0) { bfirst = F.bx; bstride = F.G; }
    for (int b = bfirst; b < nblk; b += bstride) { const int rb = b & 7, cb = b >> 3;
        const bf16* ap = A + (size_t)(NLAT + rb * 32 + r32) * K + F.wave * kw + 8 * hi;
        const int n0 = cb * 64 + r32, n1 = n0 + 32;
        const bf16* bp0 = Bt + (size_t)(rowmode ? qkv_rowmap(n0) : n0) * K + F.wave * kw + 8 * hi;
        const bf16* bp1 = Bt + (size_t)(rowmode ? qkv_rowmap(n1) : n1) * K + F.wave * kw + 8 * hi;
        f32x16 acc0 = f32x16{}, acc1 = f32x16{};
        for (int k = 0; k < kw; k += 128) { bf16x8 a[8], b0[8], b1[8];
#pragma unroll
            for (int i = 0; i < 8; ++i) { a[i] = *(const bf16x8*)(ap + k + 16 * i); b0[i] = *(const bf16x8*)(bp0 + k + 16 * i); b1[i] = *(const bf16x8*)(bp1 + k + 16 * i); }
#pragma unroll
            for (int i = 0; i < 8; ++i) { acc0 = __builtin_amdgcn_mfma_f32_32x32x16_bf16(a[i], b0[i], acc0, 0, 0, 0); acc1 = __builtin_amdgcn_mfma_f32_32x32x16_bf16(a[i], b1[i], acc1, 0, 0, 0); } }
#pragma unroll
        for (int r = 0; r < 16; ++r) { const int rw = (r & 3) + 8 * (r >> 2) + 4 * hi; PART[(F.wave * 32 + rw) * 66 + r32] = acc0[r]; PART[(F.wave * 32 + rw) * 66 + 32 + r32] = acc1[r]; }
        __syncthreads();
        { const int row = tid >> 4, c4 = (tid & 15) * 4; float v[4] = {0.f, 0.f, 0.f, 0.f};
#pragma unroll
            for (int w = 0; w < 8; ++w) { const LAS float* p = PART + (w * 32 + row) * 66 + c4; v[0] += p[0]; v[1] += p[1]; v[2] += p[2]; v[3] += p[3]; }
            E(NLAT + rb * 32 + row, cb * 64 + c4, v); }
        __syncthreads();
    }
}
struct Args { const float* in[N_IN]; float* out; unsigned char* ws; int ph_lo, ph_hi; };
static_assert(sizeof(Args) == N_IN * 8 + 8 + 8 + 8, "Args has no padding");

#ifndef MOE_WGM_UP
#define MOE_WGM_UP 4
#endif
#ifndef MOE_WGM_DN
#define MOE_WGM_DN 4
#endif
template <int ACT> __device__ __forceinline__ void tok_gemm(Frame& F, const bf16* A, const bf16* Bt, int N, int K, const pg8::EpiBf16<ACT>& E) {
    pg8::Gemm g{A, Bt, K, K, K, (unsigned)(128 * K * 2), (unsigned)(128 * K * 2)};
    TokOrder S; S.init(NLAT / 256, N / 256, F.G, F.bx); S.apan = (size_t)256 * K * 2; S.bpan = (size_t)256 * K * 2;
    pg8::gemm_phase<pg8::EpiBf16<ACT>, TokOrder, true, true>(F.lds + RING_OFF, g, S, E);
}
template <int L> __device__ __forceinline__ void moe_up(Frame& F) {
    moe_tables<L>(F);
    pg8::Gemm g{(const bf16*)(F.ws + WS_H8), (const bf16*)(F.ws + WS_WEXP_GU + (size_t)L * 32 * 2048 * 1024), 512, 512, 512, 128 * 512 * 2, 128 * 512 * 2};
    MoeOrderG S; S.init((int)F.MISC[MW_NMT], 8, F.G, F.bx, MOE_WGM_UP); S.mte = F.MISC + MW_MTE; S.bexp = (size_t)2048 * 1024; S.bpan = (size_t)256 * 1024; S.stok = (const unsigned*)(F.ws + WS_STOK); S.rowbytes = 1024u;
    EpiSwiGLU E{(unsigned char*)(F.ws + WS_ACT), argp(I_EBGU) + (size_t)L * 32 * 2048};
    pg8::gemm_phase<EpiSwiGLU, MoeOrderG, true, true, true, true>(F.lds + RING_OFF, g, S, E);
    if (CONV_DEFER && L < 3) {
        conv_tail(F, L + 1, ((int)F.MISC[MW_NMT] * 8) % F.G, CONV_UP_PER); }
}
template <int L> __device__ __forceinline__ void moe_down(Frame& F) {
    if (MK_PER_PHASE) moe_tables<L>(F);
    pg8::Gemm g{(const bf16*)(F.ws + WS_ACT), (const bf16*)(F.ws + WS_WEXP_DN + (size_t)L * 32 * 1024 * 1024), 512, 512, 512, 128 * 512 * 2, 128 * 512 * 2};
    MoeOrder S; S.init((int)F.MISC[MW_NMT], 4, F.G, F.bx, MOE_WGM_DN); S.mte = F.MISC + MW_MTE; S.bexp = (size_t)1024 * 1024; S.apan = (size_t)256 * 1024; S.bpan = (size_t)256 * 1024;
    EpiDown E{(bf16*)(F.ws + WS_YS), argp(I_EBD) + (size_t)L * 32 * 1024, (const unsigned*)(F.ws + WS_STOK)};
    pg8::gemm_phase<EpiDown, MoeOrder, true, true, false, true>(F.lds + RING_OFF, g, S, E);
    if (CONV_DEFER && L < 3) {
        conv_tail(F, L + 1, ((int)F.MISC[MW_NMT] * 4) % F.G, CONV_DN_PER); }
}

__global__ void __launch_bounds__(NTHR, 2) mk_fwd(Args args) {
    extern __shared__ __attribute__((aligned(16))) unsigned char lds[];
    Frame F;
    F.lds = (LAS unsigned char*)lds;
    F.MISC = (volatile LAS unsigned*)(F.lds + MISC_OFF);
    F.wave = __builtin_amdgcn_readfirstlane((int)threadIdx.x >> 6);
    F.G = gridDim.x; F.bx = blockIdx.x; F.vcu = (F.G % 8 == 0) ? (F.bx % 8) * (F.G / 8) + F.bx / 8 : F.bx;
    F.ws = args.ws; F.ctl = (gu32*)(args.ws + WS_CTL);
    for (int u = threadIdx.x; u < (LDS_BYTES - MISC_OFF) / 4; u += NTHR) ((LAS unsigned*)(F.lds + MISC_OFF))[u] = 0u;
    __syncthreads();
    XcdBarrier bar; bar.bar = (unsigned*)(F.ctl + CW_BAR); bar.x = 0; bar.st = nullptr;
    if (!MK_PER_PHASE) bar = xcd_barrier_post((unsigned*)(F.ctl + CW_BAR), F.MISC + MW_BAR);
    const int lo = args.ph_lo, hi = args.ph_hi;
#ifdef MK_ONLY
#define IN(k) ((k) == MK_ONLY && lo <= (k))
#else
#define IN(k) (lo <= (k) && (k) < hi)
#endif
#define SEAM(k) do { if (IN(k) && IN((k) + 1)) xcd_barrier(bar); } while (0)
#ifdef MK_REP_MASK
#define REP(k) (((MK_REP_MASK >> (k)) & 1ull) ? 2 : 1)
#else
#define REP(k) 1
#endif
#ifdef MK_PROBE_MASK
#define STAMP(k) do { if (threadIdx.x == 0) { const unsigned long long t_ = __builtin_amdgcn_s_memrealtime(); F.MISC[512 + 2 * (k)] = (unsigned)t_; F.MISC[513 + 2 * (k)] = (unsigned)(t_ >> 32); } } while (0)
#else
#define STAMP(k) do {} while (0)
#endif
    const bf16* Hb = (const bf16*)(F.ws + WS_H); bf16* Yb = (bf16*)(F.ws + WS_Y);

    STAMP(0); if (IN(0)) for (int rep_ = 0; rep_ < REP(0); ++rep_) { if (rep_) xcd_barrier(bar); asm volatile("; MK_PHASE_0" ::: "memory"); p0_prologue(F); } SEAM(0);
    STAMP(1); if (IN(1)) for (int rep_ = 0; rep_ < REP(1); ++rep_) { if (rep_) xcd_barrier(bar); asm volatile("; MK_PHASE_1" ::: "memory"); pass_init(F); } SEAM(1);
    STAMP(2); if (IN(2)) for (int rep_ = 0; rep_ < REP(2); ++rep_) { if (rep_) xcd_barrier(bar); asm volatile("; MK_PHASE_2" ::: "memory"); if ((EN_MIX >> 0) & 1) {
        { pg8::Gemm g{(const bf16*)(F.ws + TB_FC), Hb, 256, 256, 128 * DM, 128 * 256 * 2, DM * 2};
          ChDftOrder S; S.init(2, 256, F.G, F.bx); EpiChDft E{(bf16*)(F.ws + WS_BTA)};
          pg8::gemm_phase<EpiChDft, ChDftOrder, true, true>(F.lds + RING_OFF, g, S, E); }
#ifndef NO_CTX_DFT
        { pg8::Gemm g{(const bf16*)(F.ws + TB_FC), Hb, 256, 256, DM, 128 * 256 * 2, 128 * DM * 2};
          ChDftCtxOrder S; S.init(2, 4, F.G, F.bx); EpiChDftCtx E{(bf16*)(F.ws + WS_BTX)};
          pg8::gemm_phase<EpiChDftCtx, ChDftCtxOrder, true, true>(F.lds + RING_OFF, g, S, E); }
#endif
        } } SEAM(2);
    STAMP(3); if (IN(3)) for (int rep_ = 0; rep_ < REP(3); ++rep_) { if (rep_) xcd_barrier(bar); asm volatile("; MK_PHASE_3" ::: "memory"); if ((EN_MIX >> 0) & 1) {
        { pg8::Gemm g{(const bf16*)(F.ws + TB_FA), (const bf16*)(F.ws + WS_BTA), 256, 256, 256, 128 * 256 * 2, 128 * 256 * 2};
          TokOrder S; S.init(1, 512, F.G, F.bx); S.apan = 0; S.bpan = (size_t)256 * 256 * 2;
          EpiStepA E{(bf16*)(F.ws + WS_BTC), (const float*)(F.ws + TB_TWC), (const float*)(F.ws + TB_TWS)};
          pg8::gemm_phase<EpiStepA, TokOrder, true, true>(F.lds + RING_OFF, g, S, E); }
        } } SEAM(3);
    STAMP(4); if (IN(4)) for (int rep_ = 0; rep_ < REP(4); ++rep_) { if (rep_) xcd_barrier(bar); asm volatile("; MK_PHASE_4" ::: "memory"); if ((EN_MIX >> 0) & 1) {
        { pg8::Gemm g{(const bf16*)(F.ws + TB_FCC), (const bf16*)(F.ws + WS_BTC), 256, 256, 256, 128 * 256 * 2, 128 * 256 * 2};
        TokOrder S; S.init(1, 512, F.G, F.bx); S.apan = 0; S.bpan = (size_t)256 * 256 * 2;
        EpiStepC E{(bf16*)(F.ws + WS_MIXB)};
        pg8::gemm_phase<EpiStepC, TokOrder, true, true>(F.lds + RING_OFF, g, S, E); }
#ifndef NO_CTX_DFT
        { pg8::Gemm g{(const bf16*)(F.ws + TB_FX), (const bf16*)(F.ws + WS_BTX), 512, 512, 512, 128 * 512 * 2, 128 * 512 * 2};
          TokOrder S; S.init(1, 4, F.G, F.bx); S.apan = 0; S.bpan = (size_t)256 * 512 * 2;
          EpiCtxPos E{(bf16*)(F.ws + WS_MIXB)};
          pg8::gemm_phase<EpiCtxPos, TokOrder, true, true>(F.lds + RING_OFF, g, S, E); }
#endif
        } } SEAM(4);
    STAMP(5); if (IN(5)) for (int rep_ = 0; rep_ < REP(5); ++rep_) { if (rep_) xcd_barrier(bar); asm volatile("; MK_PHASE_5" ::: "memory"); if ((EN_MIX >> 0) & 1) { pg8::EpiBf16<0> E{Yb, DM, argp(I_FNB), 0, 0, 1.f}; tok_gemm<0>(F, (const bf16*)(F.ws + WS_MIXB), (const bf16*)(F.ws + WS_WFN), DM, DM, E);
        ctx_gemm(F, (const bf16*)(F.ws + WS_MIXB), (const bf16*)(F.ws + WS_WFN), DM, DM, 0, CtxEpiY{Yb, argp(I_FNB)}); } } SEAM(5);
    STAMP(6); if (IN(6)) for (int rep_ = 0; rep_ < REP(6); ++rep_) { if (rep_) xcd_barrier(bar); asm volatile("; MK_PHASE_6" ::: "memory"); pass_mix<0>(F); } SEAM(6);
    STAMP(7); if (IN(7)) for (int rep_ = 0; rep_ < REP(7); ++rep_) { if (rep_) xcd_barrier(bar); asm volatile("; MK_PHASE_7" ::: "memory"); }
    STAMP(8); if (IN(8)) for (int rep_ = 0; rep_ < REP(8); ++rep_) { if (rep_) xcd_barrier(bar); asm volatile("; MK_PHASE_8" ::: "memory"); if ((EN_MOE >> 0) & 1) moe_up<0>(F); } SEAM(8);
    STAMP(9); if (IN(9)) for (int rep_ = 0; rep_ < REP(9); ++rep_) { if (rep_) xcd_barrier(bar); asm volatile("; MK_PHASE_9" ::: "memory"); if ((EN_MOE >> 0) & 1) moe_down<0>(F); } SEAM(9);
    STAMP(10); if (IN(10)) for (int rep_ = 0; rep_ < REP(10); ++rep_) { if (rep_) xcd_barrier(bar); asm volatile("; MK_PHASE_10" ::: "memory"); pass_comb<0>(F); } SEAM(10);
    STAMP(11); if (IN(11)) for (int rep_ = 0; rep_ < REP(11); ++rep_) { if (rep_) xcd_barrier(bar); asm volatile("; MK_PHASE_11" ::: "memory"); if ((EN_MIX >> 1) & 1) {
        pg8::Gemm g{Hb, (const bf16*)(F.ws + WS_WFAQ), DM, DM, DM, 128 * DM * 2, 128 * DM * 2};
        TokOrder S; S.init(NLAT / 256, FA_NQKV / 256, F.G, F.bx); S.apan = (size_t)256 * DM * 2; S.bpan = (size_t)256 * DM * 2;
        EpiQKV<4, true> E{(bf16*)(F.ws + WS_Q), (bf16*)(F.ws + WS_K), (bf16*)(F.ws + WS_V), argp(I_FABQ), argp(I_FAQN), argp(I_FAKN), (const float*)(F.ws + TB_ROPC), (const float*)(F.ws + TB_ROPS)};
        pg8::gemm_phase<EpiQKV<4, true>, TokOrder, true, true>(F.lds + RING_OFF, g, S, E);
        { const int rem = ((NLAT / 256) * (FA_NQKV / 256)) % F.G;
          if (rem == 0) ctx_gemm(F, Hb, (const bf16*)(F.ws + WS_WFAQ), FA_NQKV, DM, 1, CtxEpiQKV<4, true>{(bf16*)(F.ws + WS_Q), argp(I_FABQ), argp(I_FAQN), argp(I_FAKN)});
          else if (F.bx >= rem) ctx_gemm(F, Hb, (const bf16*)(F.ws + WS_WFAQ), FA_NQKV, DM, 1, CtxEpiQKV<4, true>{(bf16*)(F.ws + WS_Q), argp(I_FABQ), argp(I_FAQN), argp(I_FAKN)}, F.bx - rem, F.G - rem);
          if (CONV_DEFER) conv_tail(F, 1, rem, CONV_QKV_PER); } } } SEAM(11);
    STAMP(12); if (IN(12)) for (int rep_ = 0; rep_ < REP(12); ++rep_) { if (rep_) xcd_barrier(bar); asm volatile("; MK_PHASE_12" ::: "memory"); if ((EN_MIX >> 1) & 1) attn_phase<0>(F, (char*)lds + RING_OFF); } SEAM(12);
    STAMP(13); if (IN(13)) for (int rep_ = 0; rep_ < REP(13); ++rep_) { if (rep_) xcd_barrier(bar); asm volatile("; MK_PHASE_13" ::: "memory"); if ((EN_MIX >> 1) & 1) { pg8::EpiBf16<0> E{Yb, DM, argp(I_FABO), 0, 0, 1.f}; tok_gemm<0>(F, (const bf16*)(F.ws + WS_O), (const bf16*)(F.ws + WS_WFAO), DM, DM, E);
        ctx_gemm(F, (const bf16*)(F.ws + WS_O), (const bf16*)(F.ws + WS_WFAO), DM, DM, 0, CtxEpiY{Yb, argp(I_FABO)}); } } SEAM(13);
    STAMP(14); if (IN(14)) for (int rep_ = 0; rep_ < REP(14); ++rep_) { if (rep_) xcd_barrier(bar); asm volatile("; MK_PHASE_14" ::: "memory"); pass_mix<1>(F); } SEAM(14);
    STAMP(15); if (IN(15)) for (int rep_ = 0; rep_ < REP(15); ++rep_) { if (rep_) xcd_barrier(bar); asm volatile("; MK_PHASE_15" ::: "memory"); }
    STAMP(16); if (IN(16)) for (int rep_ = 0; rep_ < REP(16); ++rep_) { if (rep_) xcd_barrier(bar); asm volatile("; MK_PHASE_16" ::: "memory"); if ((EN_MOE >> 1) & 1) moe_up<1>(F); } SEAM(16);
    STAMP(17); if (IN(17)) for (int rep_ = 0; rep_ < REP(17); ++rep_) { if (rep_) xcd_barrier(bar); asm volatile("; MK_PHASE_17" ::: "memory"); if ((EN_MOE >> 1) & 1) moe_down<1>(F); } SEAM(17);
    STAMP(18); if (IN(18)) for (int rep_ = 0; rep_ < REP(18); ++rep_) { if (rep_) xcd_barrier(bar); asm volatile("; MK_PHASE_18" ::: "memory"); pass_comb<1>(F); } SEAM(18);
    STAMP(19); if (IN(19)) for (int rep_ = 0; rep_ < REP(19); ++rep_) { if (rep_) xcd_barrier(bar); asm volatile("; MK_PHASE_19" ::: "memory"); if ((EN_MIX >> 2) & 1) {
        { pg8::Gemm g{Hb, (const bf16*)(F.ws + WS_WGI), DM, DM, DM, 128 * DM * 2, 128 * DM * 2};
          TokOrder S; S.init(NLAT / 256, GM_FF / 256, F.G, F.bx); S.apan = (size_t)256 * DM * 2; S.bpan = (size_t)256 * DM * 2;
          EpiGeluUV E{(bf16*)(F.ws + WS_GU), (bf16*)(F.ws + WS_GV), argp(I_GMBI), (float*)(F.ws + WS_PSTAT)};
          pg8::gemm_phase<EpiGeluUV, TokOrder, true, true>(F.lds + RING_OFF, g, S, E); }
        ctx_gemm(F, Hb, (const bf16*)(F.ws + WS_WGI), GM_FF, DM, 0, CtxEpiGelu{(bf16*)(F.ws + WS_GU), (bf16*)(F.ws + WS_GV), argp(I_GMBI), (float*)(F.ws + WS_PSTAT)}); } } SEAM(19);
    STAMP(20); if (IN(20)) for (int rep_ = 0; rep_ < REP(20); ++rep_) { if (rep_) xcd_barrier(bar); asm volatile("; MK_PHASE_20" ::: "memory"); if ((EN_MIX >> 2) & 1) gate_phase(F); } SEAM(20);
    STAMP(21); if (IN(21)) for (int rep_ = 0; rep_ < REP(21); ++rep_) { if (rep_) xcd_barrier(bar); asm volatile("; MK_PHASE_21" ::: "memory"); if ((EN_MIX >> 2) & 1) { pg8::EpiBf16<0> E{Yb, DM, argp(I_GMBO), 0, 0, 1.f}; tok_gemm<0>(F, (const bf16*)(F.ws + WS_GG), (const bf16*)(F.ws + WS_WGO), DM, GM_HALF, E);
        ctx_gemm(F, (const bf16*)(F.ws + WS_GG), (const bf16*)(F.ws + WS_WGO), DM, GM_HALF, 0, CtxEpiY{Yb, argp(I_GMBO)}); } } SEAM(21);
    STAMP(22); if (IN(22)) for (int rep_ = 0; rep_ < REP(22); ++rep_) { if (rep_) xcd_barrier(bar); asm volatile("; MK_PHASE_22" ::: "memory"); pass_mix<2>(F); } SEAM(22);
    STAMP(23); if (IN(23)) for (int rep_ = 0; rep_ < REP(23); ++rep_) { if (rep_) xcd_barrier(bar); asm volatile("; MK_PHASE_23" ::: "memory"); }
    STAMP(24); if (IN(24)) for (int rep_ = 0; rep_ < REP(24); ++rep_) { if (rep_) xcd_barrier(bar); asm volatile("; MK_PHASE_24" ::: "memory"); if ((EN_MOE >> 2) & 1) moe_up<2>(F); } SEAM(24);
    STAMP(25); if (IN(25)) for (int rep_ = 0; rep_ < REP(25); ++rep_) { if (rep_) xcd_barrier(bar); asm volatile("; MK_PHASE_25" ::: "memory"); if ((EN_MOE >> 2) & 1) moe_down<2>(F); } SEAM(25);
    STAMP(26); if (IN(26)) for (int rep_ = 0; rep_ < REP(26); ++rep_) { if (rep_) xcd_barrier(bar); asm volatile("; MK_PHASE_26" ::: "memory"); pass_comb<2>(F); } SEAM(26);
    STAMP(27); if (IN(27)) for (int rep_ = 0; rep_ < REP(27); ++rep_) { if (rep_) xcd_barrier(bar); asm volatile("; MK_PHASE_27" ::: "memory"); if ((EN_MIX >> 3) & 1) {
        pg8::Gemm g{Hb, (const bf16*)(F.ws + WS_WWQ), DM, DM, DM, 128 * DM * 2, 128 * DM * 2};
        TokOrder S; S.init(NLAT / 256, WA_NQKV / 256, F.G, F.bx); S.apan = (size_t)256 * DM * 2; S.bpan = (size_t)256 * DM * 2;
        EpiQKV<2, false> E{(bf16*)(F.ws + WS_Q), (bf16*)(F.ws + WS_K), (bf16*)(F.ws + WS_V), argp(I_WABQ), nullptr, nullptr, (const float*)(F.ws + TB_ROPC), (const float*)(F.ws + TB_ROPS)};
        pg8::gemm_phase<EpiQKV<2, false>, TokOrder, true, true>(F.lds + RING_OFF, g, S, E);
        { const int rem = ((NLAT / 256) * (WA_NQKV / 256)) % F.G;
          if (rem == 0) ctx_gemm(F, Hb, (const bf16*)(F.ws + WS_WWQ), WA_NQKV, DM, 1, CtxEpiQKV<2, false>{(bf16*)(F.ws + WS_Q), argp(I_WABQ), argp(I_WABQ), argp(I_WABQ)});
          else if (F.bx >= rem) ctx_gemm(F, Hb, (const bf16*)(F.ws + WS_WWQ), WA_NQKV, DM, 1, CtxEpiQKV<2, false>{(bf16*)(F.ws + WS_Q), argp(I_WABQ), argp(I_WABQ), argp(I_WABQ)}, F.bx - rem, F.G - rem);
          if (CONV_DEFER) conv_tail(F, 3, rem, CONV_QKV_PER); } } } SEAM(27);
    STAMP(28); if (IN(28)) for (int rep_ = 0; rep_ < REP(28); ++rep_) { if (rep_) xcd_barrier(bar); asm volatile("; MK_PHASE_28" ::: "memory"); if ((EN_MIX >> 3) & 1) attn_phase<1>(F, (char*)lds + RING_OFF); } SEAM(28);
    STAMP(29); if (IN(29)) for (int rep_ = 0; rep_ < REP(29); ++rep_) { if (rep_) xcd_barrier(bar); asm volatile("; MK_PHASE_29" ::: "memory"); if ((EN_MIX >> 3) & 1) { pg8::EpiBf16<0> E{Yb, DM, argp(I_WABO), 0, 0, 1.f}; tok_gemm<0>(F, (const bf16*)(F.ws + WS_O), (const bf16*)(F.ws + WS_WWO), DM, DM, E); } } SEAM(29);
    STAMP(30); if (IN(30)) for (int rep_ = 0; rep_ < REP(30); ++rep_) { if (rep_) xcd_barrier(bar); asm volatile("; MK_PHASE_30" ::: "memory"); pass_mix<3>(F); } SEAM(30);
    STAMP(31); if (IN(31)) for (int rep_ = 0; rep_ < REP(31); ++rep_) { if (rep_) xcd_barrier(bar); asm volatile("; MK_PHASE_31" ::: "memory"); }
    STAMP(32); if (IN(32)) for (int rep_ = 0; rep_ < REP(32); ++rep_) { if (rep_) xcd_barrier(bar); asm volatile("; MK_PHASE_32" ::: "memory"); if ((EN_MOE >> 3) & 1) moe_up<3>(F); } SEAM(32);
    STAMP(33); if (IN(33)) for (int rep_ = 0; rep_ < REP(33); ++rep_) { if (rep_) xcd_barrier(bar); asm volatile("; MK_PHASE_33" ::: "memory"); if ((EN_MOE >> 3) & 1) moe_down<3>(F); } SEAM(33);
    STAMP(34); if (IN(34)) for (int rep_ = 0; rep_ < REP(34); ++rep_) { if (rep_) xcd_barrier(bar); asm volatile("; MK_PHASE_34" ::: "memory"); pass_comb<3>(F); }
#ifdef MK_PROBE_MASK
    STAMP(35); __syncthreads();
    { float us = 0.f;
      for (int k = 0; k < 35; ++k) if ((MK_PROBE_MASK >> k) & 1ull) { const unsigned long long a = ((unsigned long long)F.MISC[513 + 2 * k] << 32) | F.MISC[512 + 2 * k], b = ((unsigned long long)F.MISC[515 + 2 * k] << 32) | F.MISC[514 + 2 * k]; us += (float)(b - a) * 0.01f; }
      const float cval = us / (float)(MK_PROBE_DIV);
      const int lane = threadIdx.x & 63, gw = F.vcu * NWAVES + F.wave, NGW = F.G * NWAVES; RowV r;
      for (int j = 0; j < 4; ++j) r.v[j] = (f32x4){cval, cval, cval, cval};
      float* outp = (float*)argp(N_IN);
      for (int m = gw; m < NLAT; m += NGW) strow(outp + (size_t)m * DM, lane, r); }
#endif
#undef IN
#undef SEAM
}

extern "C" void kernel_launch(void* const* d_in, const int* in_sizes, int n_in, void* d_out, int out_size, void* d_ws, size_t ws_size, hipStream_t stream) {
    static int grid = 0;
    if (grid == 0) {
        if (n_in != N_IN || in_sizes[0] != NLAT * DM || out_size != NLAT * DM || ws_size < WS_END) { fprintf(stderr, "kernel_launch: unexpected shapes (n_in %d, in0 %d, out %d, ws %zu)\n", n_in, n_in > 0 ? in_sizes[0] : -1, out_size, ws_size); grid = -1; return; }
        int dev = 0, cus = 0, per_cu = 0;
        if (hipGetDevice(&dev) != hipSuccess || hipDeviceGetAttribute(&cus, hipDeviceAttributeMultiprocessorCount, dev) != hipSuccess) { grid = -1; return; }
        if (hipFuncSetAttribute((const void*)mk_fwd, hipFuncAttributeMaxDynamicSharedMemorySize, LDS_BYTES) != hipSuccess) { fprintf(stderr, "kernel_launch: hipFuncSetAttribute failed\n"); grid = -1; return; }
        if (hipOccupancyMaxActiveBlocksPerMultiprocessor(&per_cu, (const void*)mk_fwd, NTHR, LDS_BYTES) != hipSuccess || per_cu < 1) fprintf(stderr, "kernel_launch: occupancy query says %d\n", per_cu);
        (void)hipGetLastError();
        grid = cus;
    }
    if (grid < 0) return;
    if (hipMemsetAsync((char*)d_ws + WS_CTL, 0, CTL_ZERO_BYTES, stream) != hipSuccess) return;
    Args a{};
    for (int i = 0; i < N_IN; ++i) a.in[i] = (const float*)d_in[i];
    a.out = (float*)d_out; a.ws = (unsigned char*)d_ws;
#if MK_PER_PHASE
    for (int p = 0; p < NPHASE; ++p) { a.ph_lo = p; a.ph_hi = p + 1; hipLaunchKernelGGL(mk_fwd, dim3(grid), dim3(NTHR), LDS_BYTES, stream, a); }
#else
    a.ph_lo = 0; a.ph_hi = NPHASE; hipLaunchKernelGGL(mk_fwd, dim3(grid), dim3(NTHR), LDS_BYTES, stream, a);
#endif
}
```

```cpp
#define MK_PER_PHASE 0
#define EN_MIX 15
#define EN_MOE 15
#include <hip/hip_runtime.h>
#include <hip/hip_bf16.h>
#include <cstdio>
#include <cstdint>
#include <cmath>
#ifndef MK_PER_PHASE
#define MK_PER_PHASE 0
#endif
namespace pg8 {
#define PG8_LAS __attribute__((address_space(3)))
typedef unsigned short bf16_t;
typedef short bf16x8 __attribute__((ext_vector_type(8)));
typedef float f32x4 __attribute__((ext_vector_type(4)));
typedef float f32x2 __attribute__((ext_vector_type(2)));
typedef unsigned u32x4 __attribute__((ext_vector_type(4)));
typedef unsigned u32x2 __attribute__((ext_vector_type(2)));
constexpr int BM = 256, BK = 64, HALF = 128, HTB = HALF * BK * 2  , STAGE_BYTES = 8 * HTB, NXCD = 8, WGM = 2;

__host__ __device__ __forceinline__ int lds_byte(int r, int c) { const int st = (r >> 4) * 2 + (c >> 5), rr = r & 15, cc = c & 31, ob = rr * 64 + cc * 2; return st * 1024 + (ob ^ (((ob >> 9) & 1) << 5)); }
__host__ __device__ __forceinline__ void stage_rc(int b, int& R, int& C) { const int st = b / 1024, sb = b % 1024, swz = sb ^ (((sb >> 9) & 1) << 5); R = (st >> 1) * 16 + swz / 64; C = (st & 1) * 32 + (swz % 64) / 2; }
__host__ __device__ __forceinline__ int perm32(int rho) { const int n = rho >> 4, i = rho & 15; return 8 * (i >> 2) + 4 * n + (i & 3); }

struct Unit { int pm, pn, e; };
struct Gemm { const bf16_t* A; const bf16_t* Bt; int K, lda, ldb; unsigned hstepA, hstepB; };

struct GridOrder {
    int nM, nN, nwg, G, c, wgm;
    __device__ __forceinline__ void init(int nM_, int nN_, int G_, int c_, int wgm_ = WGM) { nM = nM_; nN = nN_; nwg = nM * nN; G = G_; c = c_; wgm = wgm_; }
    __device__ __forceinline__ bool next_mn(int i, int& pm, int& pn) const {
        const long L = (long)i * G + c; if (L >= nwg) return false;
        int wgid = (int)L; { const int q = nwg / NXCD, r = nwg % NXCD, xcd = wgid % NXCD, off = wgid / NXCD; wgid = (xcd < r ? xcd * (q + 1) : r * (q + 1) + (xcd - r) * q) + off; }
        const int nig = wgm * nN, gid = wgid / nig, fm = gid * wgm, gsz = (nM - fm) < wgm ? (nM - fm) : wgm;
        pm = fm + ((wgid % nig) % gsz); pn = (wgid % nig) / gsz; return true;
    }
};
__device__ __forceinline__ unsigned cvt_pk_bf16(float lo, float hi) { unsigned r; asm volatile("v_cvt_pk_bf16_f32 %0, %1, %2" : "=v"(r) : "v"(lo), "v"(hi)); return r; }
__device__ __forceinline__ f32x2 gelu_pk(f32x2 v) {
    const f32x2 av = __builtin_elementwise_abs(v), d = av * 0.2316418882f + 1.0f;
    f32x2 t; t.x = __builtin_amdgcn_rcpf(d.x); t.y = __builtin_amdgcn_rcpf(d.y);
    f32x2 q = t * 0.5307027145f + (-0.7265760135f); q = q * t + 0.7107068705f; q = q * t + (-0.142248368f); q = q * t + 0.127414796f; q = q * t;
    const f32x2 s = (v * v) * (-0.72134752044f);
    f32x2 e; e.x = __builtin_amdgcn_exp2f(s.x); e.y = __builtin_amdgcn_exp2f(s.y);
    const f32x2 m = v * (q * e), r = v - m;
    f32x2 o; o.x = v.x < 0.f ? m.x : r.x; o.y = v.y < 0.f ? m.y : r.y; return o;
}

template <int ACT  > struct EpiBf16 {
    static constexpr bool PERM = true, AFTER_DRAIN = false; static_assert(ACT == 0 || ACT == 1, "EpiBf16: ACT is 0 (none) or 1 (gelu_pk)");
    bf16_t* O; int ldc; const float* bias; int split_cols; size_t split_stride; float scale0;
    __device__ __forceinline__ void operator()(const f32x4 (&acc)[2][2][4][2], const Unit& u, int wr, int wc, int fr, int fq) const {
        const int row0 = u.pm * BM + wr * 64 + fr; int colt = u.pn * BM; bf16_t* base = O;
        float sc = 1.f; if (split_cols) { const int t = colt / split_cols; base += (size_t)t * split_stride; colt -= t * split_cols; if (t == 0) sc = scale0; }
        const int col0 = colt + wc * 32 + 8 * fq, bcol0 = u.pn * BM + wc * 32 + 8 * fq;
        f32x4 bv[2][2];
#pragma unroll
        for (int bj = 0; bj < 2; ++bj)
#pragma unroll
            for (int n = 0; n < 2; ++n) bv[bj][n] = bias ? *(const f32x4*)(bias + bcol0 + bj * HALF + 4 * n) : (f32x4){0.f, 0.f, 0.f, 0.f};
#pragma unroll
        for (int ai = 0; ai < 2; ++ai)
#pragma unroll
            for (int m = 0; m < 4; ++m) { bf16_t* rowp = base + (size_t)(row0 + ai * HALF + m * 16) * ldc + col0;
#pragma unroll
                for (int bj = 0; bj < 2; ++bj) { f32x4 v0 = acc[ai][bj][m][0] + bv[bj][0], v1 = acc[ai][bj][m][1] + bv[bj][1];
                    if (ACT == 1) { f32x2 a = gelu_pk((f32x2){v0[0], v0[1]}), b = gelu_pk((f32x2){v0[2], v0[3]}), c = gelu_pk((f32x2){v1[0], v1[1]}), d = gelu_pk((f32x2){v1[2], v1[3]});
                        v0 = (f32x4){a.x, a.y, b.x, b.y}; v1 = (f32x4){c.x, c.y, d.x, d.y}; }
                    v0 = v0 * sc; v1 = v1 * sc; u32x4 w; w.x = cvt_pk_bf16(v0[0], v0[1]); w.y = cvt_pk_bf16(v0[2], v0[3]); w.z = cvt_pk_bf16(v1[0], v1[1]); w.w = cvt_pk_bf16(v1[2], v1[3]);
                    *(u32x4*)(rowp + bj * HALF) = w; } }
    }
};
typedef int v8i_t __attribute__((ext_vector_type(8))); typedef int v4i_t __attribute__((ext_vector_type(4)));
template <class Epi, class Sched, bool ALIGN_EPI = false, bool SP2 = false, bool GATHER = false, bool F8 = false>
__device__ __forceinline__ void gemm_phase(PG8_LAS unsigned char* lds, const Gemm g, const Sched& S, const Epi& E) {
    int tid_ = threadIdx.x; asm volatile("" : "+v"(tid_));
    const int tid = tid_, wid = __builtin_amdgcn_readfirstlane(tid >> 6), lane = tid & 63, wr = wid >> 2, wc = wid & 3, fr = lane & 15, fq = lane >> 4;
    const int K = g.K; int nt = K / BK; if constexpr (F8) asm volatile("" : "+s"(nt));
    unsigned voffA[2], voffB[2];
#pragma unroll
    for (int i = 0; i < 2; ++i) { int R, C; stage_rc(tid * 16 + i * 8192, R, C); const int Rb = Epi::PERM ? ((R & ~31) + perm32(R & 31)) : R;
        voffA[i] = (unsigned)(R * g.lda + C) * 2u; voffB[i] = (unsigned)(Rb * g.ldb + C) * 2u; }
    const size_t kstep = (size_t)(BK * 2);
    const size_t hstepA = g.hstepA, hstepB = g.hstepB;
    const unsigned ldsw = (unsigned)wid * 1024u;
    const int aoff = lds_byte(wr * 64 + fr, fq * 8), boff = lds_byte(wc * 32 + fr, fq * 8);
#define PG8_SA(b, h) (((b) * 2 + (h)) * HTB)
#define PG8_SB(b, h) ((4 + (b) * 2 + (h)) * HTB)
#define PG8_STAGE(bufoff, gbase, voff) do { _Pragma("unroll") for (int _i = 0; _i < 2; ++_i) { unsigned _vo = (voff)[_i]; asm volatile("" : "+v"(_vo));     \
        __builtin_amdgcn_global_load_lds((const unsigned*)((const char*)(gbase) + _vo), (PG8_LAS unsigned*)(lds + (bufoff) + ldsw + _i * 8192), 16, 0, 0); } } while (0)
#define PG8_CAT8(x, y) __builtin_shufflevector(__builtin_bit_cast(v4i_t, x), __builtin_bit_cast(v4i_t, y), 0, 1, 2, 3, 4, 5, 6, 7)
#define PG8_LDA(dst, b, h) do { _Pragma("unroll") for (int m = 0; m < 4; ++m) { const bf16x8 f0_ = *(const PG8_LAS bf16x8*)(lds + PG8_SA(b, h) + aoff + m * 2048), f1_ = *(const PG8_LAS bf16x8*)(lds + PG8_SA(b, h) + aoff + m * 2048 + 1024); \
        if constexpr (F8) dst##8[m] = PG8_CAT8(f0_, f1_); else { dst[m][0] = f0_; dst[m][1] = f1_; } } } while (0)
#define PG8_LDB(dst, b, h) do { _Pragma("unroll") for (int n = 0; n < 2; ++n) { const bf16x8 f0_ = *(const PG8_LAS bf16x8*)(lds + PG8_SB(b, h) + boff + n * 2048), f1_ = *(const PG8_LAS bf16x8*)(lds + PG8_SB(b, h) + boff + n * 2048 + 1024); \
        if constexpr (F8) dst##8[n] = PG8_CAT8(f0_, f1_); else { dst[n][0] = f0_; dst[n][1] = f1_; } } } while (0)
#define PG8_MMA(ai, bj, At, Bt) do { __builtin_amdgcn_s_setprio(1); _Pragma("unroll") for (int m = 0; m < 4; ++m) _Pragma("unroll") for (int n = 0; n < 2; ++n) { \
        if constexpr (F8) asm volatile("v_mfma_scale_f32_16x16x128_f8f6f4 %0, %1, %2, %0, %3, %3 op_sel_hi:[0,0,0]" : "+v"(acc[ai][bj][m][n]) : "v"(Bt##8[n]), "v"(At##8[m]), "v"(f8scale));   \
        else { _Pragma("unroll") for (int k = 0; k < 2; ++k) acc[ai][bj][m][n] = __builtin_amdgcn_mfma_f32_16x16x32_bf16(Bt[n][k], At[m][k], acc[ai][bj][m][n], 0, 0, 0); } } __builtin_amdgcn_s_setprio(0); } while (0)
#define PG8_WAIT_V(n) asm volatile("s_waitcnt vmcnt(" #n ")" ::: "memory")
#define PG8_WAIT_L(n) asm volatile("s_waitcnt lgkmcnt(" #n ")" ::: "memory")
#define PG8_BAR __builtin_amdgcn_s_barrier()
#define PG8_SCHED __builtin_amdgcn_sched_barrier(0)
    Unit cur, nxt; int ui = 0;
    if (!S.next(0, cur)) return;
    f32x4 acc[2][2][4][2];
#pragma unroll
    for (int a = 0; a < 2; ++a)
#pragma unroll
        for (int b = 0; b < 2; ++b)
#pragma unroll
            for (int m = 0; m < 4; ++m)
#pragma unroll
                for (int n = 0; n < 2; ++n) acc[a][b][m][n] = (f32x4){0.f, 0.f, 0.f, 0.f};
    const int f8scale = 0x7F7F7F7F;
    bf16x8 At[4][2], B0[2][2], B1[2][2]; v8i_t At8[4], B08[2], B18[2];
    const char* cA = (const char*)g.A + S.offA(cur); const char* cB = (const char*)g.Bt + S.offB(cur);
    unsigned va0[2], va1[2], vn0[2], vn1[2];
#define PG8_AOFFS(dst0, dst1, unit) do { _Pragma("unroll") for (int i = 0; i < 2; ++i) { if constexpr (GATHER) { int R, C; stage_rc(tid * 16 + i * 8192, R, C); \
        dst0[i] = S.rowoff(unit, R) + (unsigned)C * 2u; dst1[i] = S.rowoff(unit, R + HALF) + (unsigned)C * 2u; } else { dst0[i] = voffA[i]; dst1[i] = voffA[i] + (unsigned)hstepA; } } } while (0)
    PG8_AOFFS(va0, va1, cur);
    S.a_ready(cur);
    if constexpr (SP2) {
        PG8_STAGE(PG8_SB(0, 0), cB, voffB); PG8_STAGE(PG8_SB(0, 1), cB + hstepB, voffB); PG8_STAGE(PG8_SA(0, 0), cA, va0); PG8_STAGE(PG8_SA(0, 1), cA, va1);
        if (wr == 1) PG8_BAR;
        PG8_WAIT_V(2); PG8_BAR;
        PG8_STAGE(PG8_SB(1, 0), cB + kstep, voffB); PG8_STAGE(PG8_SA(1, 0), cA + kstep, va0); PG8_STAGE(PG8_SB(1, 1), cB + hstepB + kstep, voffB);
        PG8_WAIT_V(6); PG8_BAR;
    } else {
        PG8_STAGE(PG8_SB(0, 0), cB, voffB); PG8_STAGE(PG8_SA(0, 0), cA, va0); PG8_STAGE(PG8_SB(0, 1), cB + hstepB, voffB); PG8_STAGE(PG8_SA(0, 1), cA, va1);
        if (wr == 1) PG8_BAR;
        PG8_WAIT_V(4); PG8_BAR;
        PG8_STAGE(PG8_SB(1, 0), cB + kstep, voffB); PG8_STAGE(PG8_SA(1, 0), cA + kstep, va0); PG8_STAGE(PG8_SB(1, 1), cB + hstepB + kstep, voffB);
        PG8_WAIT_V(6); PG8_BAR;
    }
    for (;;) {
        const bool has_next = S.next(ui + 1, nxt);
        if (GATHER && has_next) PG8_AOFFS(vn0, vn1, nxt); else { vn0[0] = va0[0]; vn0[1] = va0[1]; vn1[0] = va1[0]; vn1[1] = va1[1]; }
        const char* nA = has_next ? (const char*)g.A + S.offA(nxt) : cA; const char* nB = has_next ? (const char*)g.Bt + S.offB(nxt) : cB;
        for (int t = 0; t < nt; t += 2) {
            const bool last = (t == nt - 2);
            const unsigned vs0[2] = {last ? vn0[0] : va0[0], last ? vn0[1] : va0[1]}, vs1[2] = {last ? vn1[0] : va1[0], last ? vn1[1] : va1[1]};
            const char* a1 = cA + (size_t)(t + 1) * kstep;
            const char* a2 = last ? nA : cA + (size_t)(t + 2) * kstep; const char* b2 = last ? nB : cB + (size_t)(t + 2) * kstep;
            const char* a3 = a2 + kstep; const char* b3 = b2 + kstep;
            if (last && has_next) S.a_ready(nxt);
            if constexpr (SP2) {
            PG8_LDB(B0, 0, 0); PG8_LDB(B1, 0, 1); PG8_SCHED; PG8_LDA(At, 0, 0); PG8_STAGE(PG8_SA(1, 1), a1, va1);
            PG8_WAIT_V(8); PG8_WAIT_L(0); PG8_BAR; PG8_MMA(0, 0, At, B0); PG8_MMA(0, 1, At, B1); PG8_BAR; PG8_SCHED;
            PG8_LDA(At, 0, 1); PG8_STAGE(PG8_SB(0, 0), b2, voffB); PG8_STAGE(PG8_SB(0, 1), b2 + hstepB, voffB); PG8_STAGE(PG8_SA(0, 0), a2, vs0);
            PG8_WAIT_V(8); PG8_WAIT_L(0); PG8_BAR; PG8_MMA(1, 0, At, B0); PG8_MMA(1, 1, At, B1); PG8_BAR; PG8_SCHED;
            PG8_LDB(B0, 1, 0); PG8_LDB(B1, 1, 1); PG8_SCHED; PG8_LDA(At, 1, 0); PG8_STAGE(PG8_SA(0, 1), a2, vs1);
            PG8_WAIT_V(8); PG8_WAIT_L(0); PG8_BAR; PG8_MMA(0, 0, At, B0); PG8_MMA(0, 1, At, B1); PG8_BAR; PG8_SCHED;
            PG8_LDA(At, 1, 1); PG8_STAGE(PG8_SB(1, 0), b3, voffB); PG8_STAGE(PG8_SB(1, 1), b3 + hstepB, voffB); PG8_STAGE(PG8_SA(1, 0), a3, vs0);
            PG8_WAIT_V(8); PG8_WAIT_L(0); PG8_BAR; PG8_MMA(1, 0, At, B0); PG8_MMA(1, 1, At, B1); PG8_BAR; PG8_SCHED;
            } else {
            PG8_LDB(B0, 0, 0); PG8_SCHED; PG8_LDA(At, 0, 0); PG8_STAGE(PG8_SA(1, 1), a1, va1);
            PG8_WAIT_L(8); PG8_BAR; PG8_WAIT_L(0); PG8_MMA(0, 0, At, B0); PG8_BAR; PG8_SCHED;
            PG8_LDB(B1, 0, 1); PG8_STAGE(PG8_SB(0, 0), b2, voffB);
            PG8_BAR; PG8_WAIT_L(0); PG8_MMA(0, 1, At, B1); PG8_BAR;
            PG8_LDA(At, 0, 1); PG8_STAGE(PG8_SA(0, 0), a2, vs0);
            PG8_BAR; PG8_WAIT_L(0); PG8_MMA(1, 0, At, B0); PG8_BAR; PG8_SCHED;
            PG8_STAGE(PG8_SB(0, 1), b2 + hstepB, voffB);
            PG8_WAIT_V(6); PG8_BAR; PG8_MMA(1, 1, At, B1); PG8_BAR;
            PG8_LDB(B0, 1, 0); PG8_SCHED; PG8_LDA(At, 1, 0); PG8_STAGE(PG8_SA(0, 1), a2, vs1);
            PG8_WAIT_L(8); PG8_BAR; PG8_WAIT_L(0); PG8_MMA(0, 0, At, B0); PG8_BAR; PG8_SCHED;
            PG8_LDB(B1, 1, 1); PG8_STAGE(PG8_SB(1, 0), b3, voffB);
            PG8_BAR; PG8_WAIT_L(0); PG8_MMA(0, 1, At, B1); PG8_BAR;
            PG8_LDA(At, 1, 1); PG8_STAGE(PG8_SA(1, 0), a3, vs0);
            PG8_BAR; PG8_WAIT_L(0); PG8_MMA(1, 0, At, B0); PG8_BAR; PG8_SCHED;
            PG8_STAGE(PG8_SB(1, 1), b3 + hstepB, voffB);
            PG8_WAIT_V(6); PG8_BAR; PG8_MMA(1, 1, At, B1); PG8_BAR;
            }
        }
        if constexpr (ALIGN_EPI) { if (wr == 0) PG8_BAR; }
        if constexpr (F8) asm volatile("s_nop 15\n\ts_nop 7" ::: "memory");
        if constexpr (!Epi::AFTER_DRAIN) { E(acc, cur, wr, wc, fr, fq); S.done(cur); }
        if (!has_next) break;
#pragma unroll
        for (int a = 0; a < 2; ++a)
#pragma unroll
            for (int b = 0; b < 2; ++b)
#pragma unroll
                for (int m = 0; m < 4; ++m)
#pragma unroll
                    for (int n = 0; n < 2; ++n) acc[a][b][m][n] = (f32x4){0.f, 0.f, 0.f, 0.f};
        cur = nxt; cA = nA; cB = nB; ++ui; va0[0] = vn0[0]; va0[1] = vn0[1]; va1[0] = vn1[0]; va1[1] = vn1[1];
        if constexpr (ALIGN_EPI) { if (wr == 1) PG8_BAR; }
    }
    PG8_WAIT_V(0);
    if constexpr (!ALIGN_EPI) { if (wr == 0) PG8_BAR; }
    PG8_BAR;
    if constexpr (Epi::AFTER_DRAIN) { E.fused(acc, cur, wr, wc, fr, fq, lds, wid, lane); S.done(cur); }
#undef PG8_SA
#undef PG8_AOFFS
#undef PG8_SB
#undef PG8_STAGE
#undef PG8_LDA
#undef PG8_LDB
#undef PG8_MMA
#undef PG8_CAT8
#undef PG8_WAIT_V
#undef PG8_WAIT_L
#undef PG8_BAR
#undef PG8_SCHED
}
}
namespace attn_body {
using bf16=__hip_bfloat16;
using bf16x8=__attribute__((ext_vector_type(8)))short;
using s16x4=__attribute__((ext_vector_type(4)))short;
using f32x16=__attribute__((ext_vector_type(16)))float;
using u32x4=__attribute__((ext_vector_type(4)))unsigned;
constexpr int D=64,QP=1024;
constexpr int NW=8,QBLK=32,QB=QBLK*NW,KVBLK=64;
__device__ __forceinline__ void wmask(f32x16&p0,f32x16&p1,int t,int kstart,int qabs,int hi){
  if(t<4)return; const float NEG=-INFINITY; const int kb=kstart+64*(t-4)+4*hi-qabs;
  #pragma unroll
  for(int r=0;r<16;++r){const int dk=kb+(r&3)+8*(r>>2); if(dk>128||dk<-128)p0[r]=NEG; if(dk+32>128||dk+32<-128)p1[r]=NEG;}
}
__device__ __forceinline__ int crow(int r,int hi){return (r&3)+8*(r>>2)+4*hi;}
#define SBAR() __builtin_amdgcn_sched_barrier(0)
__device__ __forceinline__ void cmask(f32x16&p0,f32x16&p1,int jb,int qrel,int hi){
  const float NEG=-INFINITY; int kb=64*jb+4*hi;
  #pragma unroll
  for(int r=0;r<16;++r){int kv=kb+(r&3)+8*(r>>2); if(kv>qrel)p0[r]=NEG; if(kv+32>qrel)p1[r]=NEG;}
}

constexpr int NSLOT=3, SLOTB=8192;
constexpr int LDS_K=0, LDS_V=NSLOT*SLOTB, LDS_WS=2*NSLOT*SLOTB, LDS_OST=LDS_WS+NW*64*4, LDS_BYTES=LDS_OST+NW*4096;
constexpr float C2=0.125f*1.4426950408889634f;
__device__ __forceinline__ void glds16(const void*gsrc,unsigned lds_dst){unsigned keep;
  asm volatile("s_mov_b32 %0, m0\n\ts_mov_b32 m0, %2\n\ts_nop 0\n\tglobal_load_lds_dwordx4 %1, off\n\ts_mov_b32 m0, %0":"=&s"(keep):"v"(gsrc),"s"(lds_dst):"memory");}
__device__ __forceinline__ float max3f(float a,float b,float c){float r;asm("v_max3_f32 %0, %1, %2, %3":"=v"(r):"v"(a),"v"(b),"v"(c));return r;}
__device__ __forceinline__ float max2f(float a,float b){float r;asm("v_max_f32_e32 %0, %1, %2":"=v"(r):"v"(a),"v"(b));return r;}
__device__ __forceinline__ float fadd_s(float a,float b){float r;asm("v_add_f32_e32 %0, %1, %2":"=v"(r):"v"(a),"v"(b));return r;}
__device__ __forceinline__ float fsub_s(float a,float b){float r;asm("v_sub_f32_e32 %0, %1, %2":"=v"(r):"v"(a),"v"(b));return r;}
typedef float f32x2_t __attribute__((ext_vector_type(2))); typedef __bf16 bf16x2_t __attribute__((ext_vector_type(2)));
__device__ __forceinline__ unsigned cvtpk_s(float lo,float hi){f32x2_t v={lo,hi};bf16x2_t b=__builtin_convertvector(v,bf16x2_t);return __builtin_bit_cast(unsigned,b);}
#define WAIT_BAR(N) asm volatile("s_waitcnt vmcnt(" #N ") lgkmcnt(0)\n\ts_barrier":::"memory")

__device__ __forceinline__ void qkt(f32x16&p0,f32x16&p1,const char*Kslot,const bf16x8*qr,const f32x16&negm,int r32,int hi){
  const char*kb=Kslot+hi*1024+r32*16;
  #pragma unroll
  for(int d0=0;d0<4;++d0){
    const bf16x8 b0=*reinterpret_cast<const bf16x8*>(kb+d0*2048);
    const bf16x8 b1=*reinterpret_cast<const bf16x8*>(kb+d0*2048+512);
    if(d0==0){p0=__builtin_amdgcn_mfma_f32_32x32x16_bf16(b0,qr[0],negm,0,0,0);p1=__builtin_amdgcn_mfma_f32_32x32x16_bf16(b1,qr[0],negm,0,0,0);}
    else{p0=__builtin_amdgcn_mfma_f32_32x32x16_bf16(b0,qr[d0],p0,0,0,0);p1=__builtin_amdgcn_mfma_f32_32x32x16_bf16(b1,qr[d0],p1,0,0,0);}}
}
typedef __attribute__((address_space(3))) const char* lds_cptr;
typedef short v4i16_t __attribute__((ext_vector_type(4)));
__device__ __forceinline__ void kload8(bf16x8*kf,lds_cptr kp){
  kf[0]=*(const __attribute__((address_space(3))) bf16x8*)(kp);      kf[1]=*(const __attribute__((address_space(3))) bf16x8*)(kp+512);
  kf[2]=*(const __attribute__((address_space(3))) bf16x8*)(kp+2048); kf[3]=*(const __attribute__((address_space(3))) bf16x8*)(kp+2560);
  kf[4]=*(const __attribute__((address_space(3))) bf16x8*)(kp+4096); kf[5]=*(const __attribute__((address_space(3))) bf16x8*)(kp+4608);
  kf[6]=*(const __attribute__((address_space(3))) bf16x8*)(kp+6144); kf[7]=*(const __attribute__((address_space(3))) bf16x8*)(kp+6656);
}
__device__ __forceinline__ void kload2(bf16x8*kf,lds_cptr kp,int j){ kf[2*j]=*(const __attribute__((address_space(3))) bf16x8*)(kp+j*2048); kf[2*j+1]=*(const __attribute__((address_space(3))) bf16x8*)(kp+j*2048+512); }
__device__ __forceinline__ s16x4 vtr(lds_cptr p){ return __builtin_bit_cast(s16x4,__builtin_amdgcn_ds_read_tr16_b64_v4i16((__attribute__((address_space(3))) v4i16_t*)p)); }
__device__ __forceinline__ float rowmax(const f32x16&p0,const f32x16&p1){
  float a=max3f(p0[0],p0[1],p1[0]),b=max3f(p0[2],p0[3],p1[1]);a=max3f(a,p1[2],p1[3]);
  #pragma unroll
  for(int r=4;r<16;r+=4){a=max3f(a,p0[r],p0[r+1]);b=max3f(b,p0[r+2],p0[r+3]);a=max3f(a,p1[r],p1[r+1]);b=max3f(b,p1[r+2],p1[r+3]);}
  const float m=max2f(a,b);
  auto rr=__builtin_amdgcn_permlane32_swap(__float_as_uint(m),__float_as_uint(m),false,false);
  return max2f(__uint_as_float(rr[0]),__uint_as_float(rr[1]));
}
__device__ __forceinline__ void pv(f32x16*o,int vb,bf16x8 pa0,bf16x8 pa1,bf16x8 pa2,bf16x8 pa3){
  #pragma unroll
  for(int d0=0;d0<2;++d0){s16x4 lo[4],hi[4];
    #pragma unroll
    for(int ks=0;ks<4;++ks){
      asm volatile("ds_read_b64_tr_b16 %0,%1 offset:%c2":"=&v"(lo[ks]):"v"(vb),"i"(d0*4096+ks*1024):"memory");
      asm volatile("ds_read_b64_tr_b16 %0,%1 offset:%c2":"=&v"(hi[ks]):"v"(vb),"i"(d0*4096+ks*1024+512):"memory");}
    asm volatile("s_waitcnt lgkmcnt(0)":::"memory");SBAR();
    #define PK(k) (bf16x8){lo[k][0],lo[k][1],lo[k][2],lo[k][3],hi[k][0],hi[k][1],hi[k][2],hi[k][3]}
    o[d0]=__builtin_amdgcn_mfma_f32_32x32x16_bf16(pa0,PK(0),o[d0],0,0,0);
    o[d0]=__builtin_amdgcn_mfma_f32_32x32x16_bf16(pa1,PK(1),o[d0],0,0,0);
    o[d0]=__builtin_amdgcn_mfma_f32_32x32x16_bf16(pa2,PK(2),o[d0],0,0,0);
    o[d0]=__builtin_amdgcn_mfma_f32_32x32x16_bf16(pa3,PK(3),o[d0],0,0,0);
    #undef PK
  }
}

#ifndef ATTN_STORE16
#define ATTN_STORE16(p,v) (*(u32x4*)(p)=(v))
#endif
template<int MODE,int KP,int THRL> __device__ __forceinline__ void attn_unit(int h,int kvh,int q0,int NT,int kbase,float sink_l2,const bf16*Q,const bf16*__restrict__ K,const bf16*__restrict__ V,bf16*O,char*shm){
  int tid_=threadIdx.x; asm volatile("":"+v"(tid_)); const int tid=tid_,lane=tid&63,r32=lane&31,hi=lane>>5; const int wid=__builtin_amdgcn_readfirstlane(tid>>6);
  #define TROW(t) (MODE==0 ? (kbase+64*(t)) : ((t)<4 ? 16384+64*(t) : kbase+64*((t)-4)))
  const bf16*Qw=Q+(long)(q0+wid*QBLK)*QP+h*D;
  const bf16*Kh=K+kvh*D,*Vh=V+kvh*D;
  const unsigned lds0=(unsigned)(uintptr_t)shm;
  float*wsf=(float*)(shm+LDS_WS)+wid*64;
  const bf16*ksrc=Kh+(long)lane*KP+wid*8;
  const bf16*vsrc=Vh+(long)(16*(wid&3)+(lane>>2))*KP+(wid>>2)*32+(lane&3)*8;
  const unsigned kdst=lds0+LDS_K+wid*1024, vdst=lds0+LDS_V+wid*1024;
  #define DMA_K(t,slot) glds16(ksrc+(long)TROW(t)*KP,(unsigned)__builtin_amdgcn_readfirstlane(kdst+(slot)))
  #define DMA_V(t,slot) glds16(vsrc+(long)TROW(t)*KP,(unsigned)__builtin_amdgcn_readfirstlane(vdst+(slot)))
  const int vb0=(int)(lds0+LDS_V)+((lane>>4)&1)*32+(lane&3)*8+(4*hi+((lane&15)>>2))*64;
  const char*Kbase=shm+LDS_K; bf16x8 kf[8];
  const lds_cptr shm3=(lds_cptr)shm; const lds_cptr kp0=shm3+LDS_K+hi*1024+r32*16; const lds_cptr vp0=shm3+LDS_V+((lane>>4)&1)*32+(lane&3)*8+(4*hi+((lane&15)>>2))*64;
  DMA_K(0,0);DMA_V(0,0);DMA_K(1,SLOTB);
  bf16x8 qr[4];
  #pragma unroll
  for(int d0=0;d0<4;++d0)qr[d0]=*reinterpret_cast<const bf16x8*>(&Qw[(long)r32*QP+d0*16+hi*8]);
  float mhat=0.f,l_reg=0.f;f32x16 o[2];o[0]=f32x16{};o[1]=f32x16{};f32x16 negm=f32x16{};asm volatile("":"+v"(negm));
  const int qabs=q0+wid*QBLK+r32;
  #define CMASK(P0,P1,t) do{ if(MODE==1) wmask(P0,P1,(t),kbase,qabs,hi); }while(0)
  bool resc=false;
  #define START(P0,P1) do{ const float rm=rowmax(P0,P1); resc=false; \
    { const float dl=rm; mhat=fadd_s(mhat,dl); \
      _Pragma("unroll") for(int r=0;r<16;++r){P0[r]=fsub_s(P0[r],dl);P1[r]=fsub_s(P1[r],dl);} \
      _Pragma("unroll") for(int r=0;r<16;++r)negm[r]=-mhat; asm volatile("":"+v"(negm)); } \
    _Pragma("unroll") for(int r=0;r<16;++r)P0[r]=__builtin_amdgcn_exp2f(P0[r]); }while(0)
  #define RESC() do{ if(resc){ asm volatile("s_waitcnt lgkmcnt(0)":::"memory"); \
      _Pragma("unroll") for(int d_=0;d_<2;++d_) _Pragma("unroll") for(int r=0;r<16;++r)o[d_][r]*=wsf[crow(r,hi)]; } }while(0)
  f32x16 pA0,pA1,pB0,pB1;
  int sl_prev=0,sl_cur=0,sl_next=SLOTB;
  #define ROT() do{sl_prev=sl_cur;sl_cur=sl_next;sl_next=(sl_next==(NSLOT-1)*SLOTB)?0:sl_next+SLOTB;}while(0)
  DMA_K(2,2*SLOTB);
  WAIT_BAR(3);
  qkt(pA0,pA1,Kbase,qr,negm,r32,hi);asm volatile("s_nop 15\n\ts_nop 7":"+v"(pA0),"+v"(pA1));CMASK(pA0,pA1,0);
  START(pA0,pA1);
  _Pragma("unroll") for(int r=0;r<16;++r)pA1[r]=__builtin_amdgcn_exp2f(pA1[r]);
  WAIT_BAR(0);
  DMA_K(3,0);DMA_V(1,SLOTB);
  ROT();
  kload8(kf,kp0+sl_cur);
  WAIT_BAR(2);
  s16x4 vlo[8],vhi[8]; u32x4 pw0,pw1,pw2,pw3;
  #define PKW(P,B) cvtpk_s(P[B],P[B+1])
  #define PAF(k) __builtin_bit_cast(bf16x8,pw##k)
  #define VFR(i) (bf16x8){vlo[i][0],vlo[i][1],vlo[i][2],vlo[i][3],vhi[i][0],vhi[i][1],vhi[i][2],vhi[i][3]}
  #define PIN(x) asm volatile("":"+v"(x))
  #define MX3(a,b,c) __builtin_fmaxf(__builtin_fmaxf((a),(b)),(c))
  #define GAPA(MF,A0,A1,A2,A3,W0,W1,PW) do{ MF; sacc+=A0; sacc+=A1; sacc+=A2; sacc+=A3; PIN(sacc); W0; W1; PIN(PW); SBAR(); }while(0)
  #define EX(v) __builtin_amdgcn_exp2f(v)
  #define GAPB(MF,X,B) do{ MF; X[B]=EX(X[B]); X[B+1]=EX(X[B+1]); X[B+2]=EX(X[B+2]); X[B+3]=EX(X[B+3]); PIN(X); SBAR(); }while(0)
  #define VRD(i) do{ vlo[i]=vtr(vp_+(((i)>>2)*4096+((i)&3)*1024)); vhi[i]=vtr(vp_+(((i)>>2)*4096+((i)&3)*1024+512)); }while(0)
  #define KRD(G,j) do{ if(G){ kload2(kf,kp0+sl_next,j); SBAR(); } }while(0)
  #define STEP(C0,C1,P0,P1,t,GK,GV,GL) do{ SBAR(); \
    const lds_cptr vp_=vp0+sl_prev; \
    VRD(0); SBAR(); float sacc=(P0[0]+P0[1]); \
    GAPA(C0=__builtin_amdgcn_mfma_f32_32x32x16_bf16(kf[0],qr[0],negm,0,0,0), P0[2],P0[3],P0[4],P0[5],     pw0[0]=PKW(P0,0), pw0[1]=PKW(P0,2), pw0); \
    VRD(4); SBAR(); GAPA(C1=__builtin_amdgcn_mfma_f32_32x32x16_bf16(kf[1],qr[0],negm,0,0,0), P0[6],P0[7],P0[8],P0[9],     pw0[2]=PKW(P0,4), pw0[3]=PKW(P0,6), pw0); \
    VRD(1); SBAR(); GAPA(C0=__builtin_amdgcn_mfma_f32_32x32x16_bf16(kf[2],qr[1],C0,0,0,0),   P0[10],P0[11],P0[12],P0[13], pw1[0]=PKW(P0,8), pw1[1]=PKW(P0,10), pw1); \
    VRD(5); SBAR(); GAPA(C1=__builtin_amdgcn_mfma_f32_32x32x16_bf16(kf[3],qr[1],C1,0,0,0),   P0[14],P0[15],P1[0],P1[1],   pw1[2]=PKW(P0,12),pw1[3]=PKW(P0,14), pw1); \
    VRD(2); SBAR(); GAPA(C0=__builtin_amdgcn_mfma_f32_32x32x16_bf16(kf[4],qr[2],C0,0,0,0),   P1[2],P1[3],P1[4],P1[5],     pw2[0]=PKW(P1,0), pw2[1]=PKW(P1,2), pw2); \
    VRD(6); SBAR(); GAPA(C1=__builtin_amdgcn_mfma_f32_32x32x16_bf16(kf[5],qr[2],C1,0,0,0),   P1[6],P1[7],P1[8],P1[9],     pw2[2]=PKW(P1,4), pw2[3]=PKW(P1,6), pw2); \
    VRD(3); SBAR(); GAPA(C0=__builtin_amdgcn_mfma_f32_32x32x16_bf16(kf[6],qr[3],C0,0,0,0),   P1[10],P1[11],P1[12],P1[13], pw3[0]=PKW(P1,8), pw3[1]=PKW(P1,10), pw3); \
    VRD(7); SBAR(); GAPA(C1=__builtin_amdgcn_mfma_f32_32x32x16_bf16(kf[7],qr[3],C1,0,0,0),   P1[14],P1[15],0.f,0.f,       pw3[2]=PKW(P1,12),pw3[3]=PKW(P1,14), pw3); \
    l_reg+=sacc; \
    if(GK){DMA_K((t)+3,sl_cur);} if(GV){DMA_V((t)+1,sl_next);} \
    CMASK(C0,C1,t); \
    { float a=MX3(C0[0],C0[1],C1[0]),b=MX3(C0[2],C0[3],C1[1]); a=MX3(a,C1[2],C1[3]); \
      _Pragma("unroll") for(int r=4;r<16;r+=4){a=MX3(a,C0[r],C0[r+1]);b=MX3(b,C0[r+2],C0[r+3]);a=MX3(a,C1[r],C1[r+1]);b=MX3(b,C1[r+2],C1[r+3]);} \
      float rm=__builtin_fmaxf(a,b); { auto rr=__builtin_amdgcn_permlane32_swap(__float_as_uint(rm),__float_as_uint(rm),false,false); rm=__builtin_fmaxf(__uint_as_float(rr[0]),__uint_as_float(rr[1])); } \
      resc=false; \
      if(__builtin_expect(__any(rm>(float)THRL),0)){ const float dl=__builtin_fmaxf(rm,0.f); mhat+=dl; \
        _Pragma("unroll") for(int r=0;r<16;++r){C0[r]-=dl;C1[r]-=dl;} \
        _Pragma("unroll") for(int r=0;r<16;++r)negm[r]=-mhat; asm volatile("":"+v"(negm)); \
        const float f=__builtin_amdgcn_exp2f(-dl); l_reg*=f; if(hi==0)wsf[r32]=f; resc=true; } } \
    SBAR(); \
    GAPB(o[0]=__builtin_amdgcn_mfma_f32_32x32x16_bf16(PAF(0),VFR(0),o[0],0,0,0), C0,0); \
    GAPB(o[1]=__builtin_amdgcn_mfma_f32_32x32x16_bf16(PAF(0),VFR(4),o[1],0,0,0), C0,4); \
    KRD(GL,0); GAPB(o[0]=__builtin_amdgcn_mfma_f32_32x32x16_bf16(PAF(1),VFR(1),o[0],0,0,0), C0,8); \
    KRD(GL,1); GAPB(o[1]=__builtin_amdgcn_mfma_f32_32x32x16_bf16(PAF(1),VFR(5),o[1],0,0,0), C0,12); \
    KRD(GL,2); GAPB(o[0]=__builtin_amdgcn_mfma_f32_32x32x16_bf16(PAF(2),VFR(2),o[0],0,0,0), C1,0); \
    KRD(GL,3); GAPB(o[1]=__builtin_amdgcn_mfma_f32_32x32x16_bf16(PAF(2),VFR(6),o[1],0,0,0), C1,4); \
    GAPB(o[0]=__builtin_amdgcn_mfma_f32_32x32x16_bf16(PAF(3),VFR(3),o[0],0,0,0), C1,8); \
    GAPB(o[1]=__builtin_amdgcn_mfma_f32_32x32x16_bf16(PAF(3),VFR(7),o[1],0,0,0), C1,12); \
    }while(0)
  int t=1;
  #undef CMASK
  #define CMASK(P0,P1,t) do{}while(0)
  if constexpr(MODE==0)
  for(;t+5<NT;t+=2){
    STEP(pB0,pB1,pA0,pA1,t,true,true,true);     WAIT_BAR(2); RESC(); ROT();
    STEP(pA0,pA1,pB0,pB1,t+1,true,true,true);   WAIT_BAR(2); RESC(); ROT();
  }
  #undef CMASK
  #define CMASK(P0,P1,t) do{ if(MODE==1) wmask(P0,P1,(t),kbase,qabs,hi); }while(0)
  #define ENDW(tt) do{ if((tt)+3<NT){WAIT_BAR(2);} else if((tt)+2<NT){WAIT_BAR(1);} else {WAIT_BAR(0);} }while(0)
  for(;t+1<NT;t+=2){
    STEP(pB0,pB1,pA0,pA1,t,(t+3<NT),(t+1<NT),(t+1<NT));       ENDW(t);   RESC(); ROT();
    STEP(pA0,pA1,pB0,pB1,t+1,(t+4<NT),(t+2<NT),(t+2<NT));     ENDW(t+1); RESC(); ROT();
  }
  STEP(pB0,pB1,pA0,pA1,NT-1,false,false,false); RESC();
  { float sacc=pB0[0]+pB0[1]; _Pragma("unroll") for(int r=2;r<16;++r)sacc+=pB0[r]; _Pragma("unroll") for(int r=0;r<16;++r)sacc+=pB1[r]; l_reg+=sacc;
    pw0=(u32x4){PKW(pB0,0),PKW(pB0,2),PKW(pB0,4),PKW(pB0,6)};pw1=(u32x4){PKW(pB0,8),PKW(pB0,10),PKW(pB0,12),PKW(pB0,14)};pw2=(u32x4){PKW(pB1,0),PKW(pB1,2),PKW(pB1,4),PKW(pB1,6)};pw3=(u32x4){PKW(pB1,8),PKW(pB1,10),PKW(pB1,12),PKW(pB1,14)};
    SBAR(); pv(o,vb0+sl_cur,PAF(0),PAF(1),PAF(2),PAF(3)); }
  #undef PKW
  #undef PAF
  #undef VFR
  #undef PIN
  #undef MX3
  #undef GAPA
  #undef GAPB
  #undef EX
  #undef VRD
  #undef KRD
  #undef STEP
  #undef ENDW
  {auto rr=__builtin_amdgcn_permlane32_swap(__float_as_uint(l_reg),__float_as_uint(l_reg),false,false);l_reg=__uint_as_float(rr[0])+__uint_as_float(rr[1]);}
  if(MODE==1)l_reg+=__builtin_amdgcn_exp2f(sink_l2-mhat);
  if(hi==0)wsf[32+r32]=l_reg;asm volatile("s_waitcnt lgkmcnt(0)":::"memory");
  float rli[16];
  #pragma unroll
  for(int r=0;r<16;++r)rli[r]=__builtin_amdgcn_rcpf(wsf[32+crow(r,hi)]);
  bf16*Ow=O+(long)(q0+wid*QBLK)*QP+h*D;
  { bf16*stg=(bf16*)(shm+LDS_OST)+wid*2048;
    #pragma unroll
    for(int r=0;r<16;++r){const int orow=crow(r,hi);
      #pragma unroll
      for(int d0=0;d0<2;++d0)stg[orow*64+d0*32+r32]=__float2bfloat16(o[d0][r]*rli[r]);}
    asm volatile("s_waitcnt lgkmcnt(0)":::"memory");
    #pragma unroll
    for(int i=0;i<4;++i){const int row=i*8+(lane>>3),ch=lane&7; const u32x4 v=*(const u32x4*)(stg+row*64+ch*8); ATTN_STORE16(Ow+(long)row*QP+ch*8,v);} }
  asm volatile("s_waitcnt lgkmcnt(0)\n\ts_barrier":::"memory");
  #undef DMA_K
  #undef DMA_V
  #undef CMASK
  #undef TROW
  #undef START
  #undef RESC
  #undef ROT
}
template<int KP> __device__ __forceinline__ void attn_unit_s(int h,int kvh,int q0,int NT,int kbase,float mstat,const bf16*Q,const bf16*__restrict__ K,const bf16*__restrict__ V,bf16*O,char*shm){
  int tid_=threadIdx.x; asm volatile("":"+v"(tid_)); const int tid=tid_,lane=tid&63,r32=lane&31,hi=lane>>5; const int wid=__builtin_amdgcn_readfirstlane(tid>>6);
  #define TROW(t) (kbase+64*(t))
  const bf16*Qw=Q+(long)(q0+wid*QBLK)*QP+h*D;
  const bf16*Kh=K+kvh*D,*Vh=V+kvh*D;
  const unsigned lds0=(unsigned)(uintptr_t)shm;
  float*wsf=(float*)(shm+LDS_WS)+wid*64;
  const bf16*ksrc=Kh+(long)lane*KP+wid*8;
  const bf16*vsrc=Vh+(long)(16*(wid&3)+(lane>>2))*KP+(wid>>2)*32+(lane&3)*8;
  const unsigned kdst=lds0+LDS_K+wid*1024, vdst=lds0+LDS_V+wid*1024;
  #define DMA_K(t,slot) glds16(ksrc+(long)TROW(t)*KP,(unsigned)__builtin_amdgcn_readfirstlane(kdst+(slot)))
  #define DMA_V(t,slot) glds16(vsrc+(long)TROW(t)*KP,(unsigned)__builtin_amdgcn_readfirstlane(vdst+(slot)))
  const int vb0=(int)(lds0+LDS_V)+((lane>>4)&1)*32+(lane&3)*8+(4*hi+((lane&15)>>2))*64;
  const char*Kbase=shm+LDS_K; bf16x8 kf[8];
  const lds_cptr shm3=(lds_cptr)shm; const lds_cptr kp0=shm3+LDS_K+hi*1024+r32*16; const lds_cptr vp0=shm3+LDS_V+((lane>>4)&1)*32+(lane&3)*8+(4*hi+((lane&15)>>2))*64;
  DMA_K(0,0);DMA_V(0,0);DMA_K(1,SLOTB);
  bf16x8 qr[4];
  #pragma unroll
  for(int d0=0;d0<4;++d0)qr[d0]=*reinterpret_cast<const bf16x8*>(&Qw[(long)r32*QP+d0*16+hi*8]);
  float l_reg=0.f;f32x16 o[2];o[0]=f32x16{};o[1]=f32x16{};f32x16 negm;
  #pragma unroll
  for(int r=0;r<16;++r)negm[r]=-mstat;
  asm volatile("":"+v"(negm));
  #define CMASK(P0,P1,t) do{}while(0)
  #define START(P0,P1) do{ _Pragma("unroll") for(int r=0;r<16;++r)P0[r]=__builtin_amdgcn_exp2f(P0[r]); }while(0)
  #define RESC() do{}while(0)
  f32x16 pA0,pA1,pB0,pB1;
  int sl_prev=0,sl_cur=0,sl_next=SLOTB;
  #define ROT() do{sl_prev=sl_cur;sl_cur=sl_next;sl_next=(sl_next==(NSLOT-1)*SLOTB)?0:sl_next+SLOTB;}while(0)
  DMA_K(2,2*SLOTB);
  WAIT_BAR(3);
  qkt(pA0,pA1,Kbase,qr,negm,r32,hi);asm volatile("s_nop 15\n\ts_nop 7":"+v"(pA0),"+v"(pA1));CMASK(pA0,pA1,0);
  START(pA0,pA1);
  _Pragma("unroll") for(int r=0;r<16;++r)pA1[r]=__builtin_amdgcn_exp2f(pA1[r]);
  WAIT_BAR(0);
  DMA_K(3,0);DMA_V(1,SLOTB);
  ROT();
  kload8(kf,kp0+sl_cur);
  WAIT_BAR(2);
  s16x4 vlo[8],vhi[8]; u32x4 pw0,pw1,pw2,pw3;
  #define PKW(P,B) cvtpk_s(P[B],P[B+1])
  #define PAF(k) __builtin_bit_cast(bf16x8,pw##k)
  #define VFR(i) (bf16x8){vlo[i][0],vlo[i][1],vlo[i][2],vlo[i][3],vhi[i][0],vhi[i][1],vhi[i][2],vhi[i][3]}
  #define PIN(x) asm volatile("":"+v"(x))
  #define MX3(a,b,c) __builtin_fmaxf(__builtin_fmaxf((a),(b)),(c))
  #define GAPA(MF,A0,A1,A2,A3,W0,W1,PW) do{ MF; sacc+=A0; sacc+=A1; sacc+=A2; sacc+=A3; PIN(sacc); W0; W1; PIN(PW); SBAR(); }while(0)
  #define EX(v) __builtin_amdgcn_exp2f(v)
  #define GAPB(MF,X,B) do{ MF; X[B]=EX(X[B]); X[B+1]=EX(X[B+1]); X[B+2]=EX(X[B+2]); X[B+3]=EX(X[B+3]); PIN(X); SBAR(); }while(0)
  #define VRD(i) do{ vlo[i]=vtr(vp_+(((i)>>2)*4096+((i)&3)*1024)); vhi[i]=vtr(vp_+(((i)>>2)*4096+((i)&3)*1024+512)); }while(0)
  #define KRD(G,j) do{ if(G){ kload2(kf,kp0+sl_next,j); SBAR(); } }while(0)
  #define STEP(C0,C1,P0,P1,t,GK,GV,GL) do{ SBAR(); \
    const lds_cptr vp_=vp0+sl_prev; \
    VRD(0); SBAR(); float sacc=(P0[0]+P0[1]); \
    GAPA(C0=__builtin_amdgcn_mfma_f32_32x32x16_bf16(kf[0],qr[0],negm,0,0,0), P0[2],P0[3],P0[4],P0[5],     pw0[0]=PKW(P0,0), pw0[1]=PKW(P0,2), pw0); \
    VRD(4); SBAR(); GAPA(C1=__builtin_amdgcn_mfma_f32_32x32x16_bf16(kf[1],qr[0],negm,0,0,0), P0[6],P0[7],P0[8],P0[9],     pw0[2]=PKW(P0,4), pw0[3]=PKW(P0,6), pw0); \
    VRD(1); SBAR(); GAPA(C0=__builtin_amdgcn_mfma_f32_32x32x16_bf16(kf[2],qr[1],C0,0,0,0),   P0[10],P0[11],P0[12],P0[13], pw1[0]=PKW(P0,8), pw1[1]=PKW(P0,10), pw1); \
    VRD(5); SBAR(); GAPA(C1=__builtin_amdgcn_mfma_f32_32x32x16_bf16(kf[3],qr[1],C1,0,0,0),   P0[14],P0[15],P1[0],P1[1],   pw1[2]=PKW(P0,12),pw1[3]=PKW(P0,14), pw1); \
    VRD(2); SBAR(); GAPA(C0=__builtin_amdgcn_mfma_f32_32x32x16_bf16(kf[4],qr[2],C0,0,0,0),   P1[2],P1[3],P1[4],P1[5],     pw2[0]=PKW(P1,0), pw2[1]=PKW(P1,2), pw2); \
    VRD(6); SBAR(); GAPA(C1=__builtin_amdgcn_mfma_f32_32x32x16_bf16(kf[5],qr[2],C1,0,0,0),   P1[6],P1[7],P1[8],P1[9],     pw2[2]=PKW(P1,4), pw2[3]=PKW(P1,6), pw2); \
    VRD(3); SBAR(); GAPA(C0=__builtin_amdgcn_mfma_f32_32x32x16_bf16(kf[6],qr[3],C0,0,0,0),   P1[10],P1[11],P1[12],P1[13], pw3[0]=PKW(P1,8), pw3[1]=PKW(P1,10), pw3); \
    VRD(7); SBAR(); GAPA(C1=__builtin_amdgcn_mfma_f32_32x32x16_bf16(kf[7],qr[3],C1,0,0,0),   P1[14],P1[15],0.f,0.f,       pw3[2]=PKW(P1,12),pw3[3]=PKW(P1,14), pw3); \
    l_reg+=sacc; \
    if(GK){DMA_K((t)+3,sl_cur);} if(GV){DMA_V((t)+1,sl_next);} \
    SBAR(); \
    GAPB(o[0]=__builtin_amdgcn_mfma_f32_32x32x16_bf16(PAF(0),VFR(0),o[0],0,0,0), C0,0); \
    GAPB(o[1]=__builtin_amdgcn_mfma_f32_32x32x16_bf16(PAF(0),VFR(4),o[1],0,0,0), C0,4); \
    KRD(GL,0); GAPB(o[0]=__builtin_amdgcn_mfma_f32_32x32x16_bf16(PAF(1),VFR(1),o[0],0,0,0), C0,8); \
    KRD(GL,1); GAPB(o[1]=__builtin_amdgcn_mfma_f32_32x32x16_bf16(PAF(1),VFR(5),o[1],0,0,0), C0,12); \
    KRD(GL,2); GAPB(o[0]=__builtin_amdgcn_mfma_f32_32x32x16_bf16(PAF(2),VFR(2),o[0],0,0,0), C1,0); \
    KRD(GL,3); GAPB(o[1]=__builtin_amdgcn_mfma_f32_32x32x16_bf16(PAF(2),VFR(6),o[1],0,0,0), C1,4); \
    GAPB(o[0]=__builtin_amdgcn_mfma_f32_32x32x16_bf16(PAF(3),VFR(3),o[0],0,0,0), C1,8); \
    GAPB(o[1]=__builtin_amdgcn_mfma_f32_32x32x16_bf16(PAF(3),VFR(7),o[1],0,0,0), C1,12); \
    }while(0)
  int t=1;
  #undef CMASK
  #define CMASK(P0,P1,t) do{}while(0)
  for(;t+5<NT;t+=2){
    STEP(pB0,pB1,pA0,pA1,t,true,true,true);     WAIT_BAR(2); RESC(); ROT();
    STEP(pA0,pA1,pB0,pB1,t+1,true,true,true);   WAIT_BAR(2); RESC(); ROT();
  }
  #undef CMASK
  #define CMASK(P0,P1,t) do{}while(0)
  #define ENDW(tt) do{ if((tt)+3<NT){WAIT_BAR(2);} else if((tt)+2<NT){WAIT_BAR(1);} else {WAIT_BAR(0);} }while(0)
  for(;t+1<NT;t+=2){
    STEP(pB0,pB1,pA0,pA1,t,(t+3<NT),(t+1<NT),(t+1<NT));       ENDW(t);   RESC(); ROT();
    STEP(pA0,pA1,pB0,pB1,t+1,(t+4<NT),(t+2<NT),(t+2<NT));     ENDW(t+1); RESC(); ROT();
  }
  STEP(pB0,pB1,pA0,pA1,NT-1,false,false,false); RESC();
  { float sacc=pB0[0]+pB0[1]; _Pragma("unroll") for(int r=2;r<16;++r)sacc+=pB0[r]; _Pragma("unroll") for(int r=0;r<16;++r)sacc+=pB1[r]; l_reg+=sacc;
    pw0=(u32x4){PKW(pB0,0),PKW(pB0,2),PKW(pB0,4),PKW(pB0,6)};pw1=(u32x4){PKW(pB0,8),PKW(pB0,10),PKW(pB0,12),PKW(pB0,14)};pw2=(u32x4){PKW(pB1,0),PKW(pB1,2),PKW(pB1,4),PKW(pB1,6)};pw3=(u32x4){PKW(pB1,8),PKW(pB1,10),PKW(pB1,12),PKW(pB1,14)};
    SBAR(); pv(o,vb0+sl_cur,PAF(0),PAF(1),PAF(2),PAF(3)); }
  #undef PKW
  #undef PAF
  #undef VFR
  #undef PIN
  #undef MX3
  #undef GAPA
  #undef GAPB
  #undef EX
  #undef VRD
  #undef KRD
  #undef STEP
  #undef ENDW
  {auto rr=__builtin_amdgcn_permlane32_swap(__float_as_uint(l_reg),__float_as_uint(l_reg),false,false);l_reg=__uint_as_float(rr[0])+__uint_as_float(rr[1]);}
  if(hi==0)wsf[32+r32]=l_reg;asm volatile("s_waitcnt lgkmcnt(0)":::"memory");
  float rli[16];
  #pragma unroll
  for(int r=0;r<16;++r)rli[r]=__builtin_amdgcn_rcpf(wsf[32+crow(r,hi)]);
  bf16*Ow=O+(long)(q0+wid*QBLK)*QP+h*D;
  { bf16*stg=(bf16*)(shm+LDS_OST)+wid*2048;
    #pragma unroll
    for(int r=0;r<16;++r){const int orow=crow(r,hi);
      #pragma unroll
      for(int d0=0;d0<2;++d0)stg[orow*64+d0*32+r32]=__float2bfloat16(o[d0][r]*rli[r]);}
    asm volatile("s_waitcnt lgkmcnt(0)":::"memory");
    #pragma unroll
    for(int i=0;i<4;++i){const int row=i*8+(lane>>3),ch=lane&7; const u32x4 v=*(const u32x4*)(stg+row*64+ch*8); ATTN_STORE16(Ow+(long)row*QP+ch*8,v);} }
  asm volatile("s_waitcnt lgkmcnt(0)\n\ts_barrier":::"memory");
  #undef DMA_K
  #undef DMA_V
  #undef CMASK
  #undef TROW
  #undef START
  #undef RESC
  #undef ROT
}
template<int KP> __device__ __forceinline__ void attn_unit_q8(int h,int kvh,int q0,int NT,int kbase,float mstat,const unsigned char*Q8,const unsigned char*__restrict__ K8,const bf16*__restrict__ V,bf16*O,char*shm){
  int tid_=threadIdx.x; asm volatile("":"+v"(tid_)); const int tid=tid_,lane=tid&63,r32=lane&31,hi=lane>>5; const int wid=__builtin_amdgcn_readfirstlane(tid>>6);
  #define TROW(t) (kbase+64*(t))
  const unsigned char*Qw=Q8+(long)(q0+wid*QBLK)*QP+h*D;
  const unsigned char*Kh=K8+kvh*D; const bf16*Vh=V+kvh*D;
  const unsigned lds0=(unsigned)(uintptr_t)shm;
  float*wsf=(float*)(shm+LDS_WS)+wid*64;
  const unsigned char*ksrc=Kh+(long)lane*KP+(wid&3)*16;
  const bf16*vsrc=Vh+(long)(16*(wid&3)+(lane>>2))*KP+(wid>>2)*32+(lane&3)*8;
  const unsigned kdst=lds0+LDS_K+(wid&3)*1024, vdst=lds0+LDS_V+wid*1024;
  #define DMA_K(t,slot) glds16(ksrc+(long)TROW(t)*KP,(unsigned)__builtin_amdgcn_readfirstlane(kdst+(slot)))
  #define DMA_V(t,slot) glds16(vsrc+(long)TROW(t)*KP,(unsigned)__builtin_amdgcn_readfirstlane(vdst+(slot)))
  const int vb0=(int)(lds0+LDS_V)+((lane>>4)&1)*32+(lane&3)*8+(4*hi+((lane&15)>>2))*64;
  typedef int v8i_t __attribute__((ext_vector_type(8))); typedef int v4i_t __attribute__((ext_vector_type(4))); typedef __attribute__((address_space(3))) const v4i_t* lds_v4p;
  v8i_t kf8[2];
  const int f8sc=0x7F7F7F7F;
  const lds_cptr shm3=(lds_cptr)shm; const lds_cptr kp0=shm3+LDS_K+hi*2048+r32*16; const lds_cptr vp0=shm3+LDS_V+((lane>>4)&1)*32+(lane&3)*8+(4*hi+((lane&15)>>2))*64;
  DMA_K(0,0);DMA_V(0,0);DMA_K(1,SLOTB);
  v8i_t q8; { const v4i_t qa=*reinterpret_cast<const v4i_t*>(Qw+(long)r32*QP+32*hi), qb=*reinterpret_cast<const v4i_t*>(Qw+(long)r32*QP+32*hi+16); q8=__builtin_shufflevector(qa,qb,0,1,2,3,4,5,6,7); }
  #define KLD(j,kp) do{ const v4i_t a_=*(lds_v4p)((kp)+(j)*512), b_=*(lds_v4p)((kp)+(j)*512+1024); kf8[j]=__builtin_shufflevector(a_,b_,0,1,2,3,4,5,6,7); }while(0)
  #define QKMF(C,j) asm volatile("v_mfma_scale_f32_32x32x64_f8f6f4 %0, %1, %2, %3, %4, %4 op_sel_hi:[0,0,0]":"=&v"(C):"v"(kf8[j]),"v"(q8),"v"(negm),"v"(f8sc))
  float l_reg=0.f;f32x16 o[2];o[0]=f32x16{};o[1]=f32x16{};f32x16 negm;
  #pragma unroll
  for(int r=0;r<16;++r)negm[r]=-mstat;
  asm volatile("":"+v"(negm));
  #define CMASK(P0,P1,t) do{}while(0)
  #define START(P0,P1) do{ _Pragma("unroll") for(int r=0;r<16;++r)P0[r]=__builtin_amdgcn_exp2f(P0[r]); }while(0)
  #define RESC() do{}while(0)
  f32x16 pA0,pA1,pB0,pB1;
  int sl_prev=0,sl_cur=0,sl_next=SLOTB;
  #define ROT() do{sl_prev=sl_cur;sl_cur=sl_next;sl_next=(sl_next==(NSLOT-1)*SLOTB)?0:sl_next+SLOTB;}while(0)
  DMA_K(2,2*SLOTB);
  WAIT_BAR(3);
  KLD(0,kp0);KLD(1,kp0);QKMF(pA0,0);QKMF(pA1,1);asm volatile("s_nop 15\n\ts_nop 15\n\ts_nop 15\n\ts_nop 15\n\ts_nop 15":"+v"(pA0),"+v"(pA1));
  START(pA0,pA1);
  _Pragma("unroll") for(int r=0;r<16;++r)pA1[r]=__builtin_amdgcn_exp2f(pA1[r]);
  WAIT_BAR(0);
  DMA_K(3,0);DMA_V(1,SLOTB);
  ROT();
  KLD(0,kp0+sl_cur);KLD(1,kp0+sl_cur);
  WAIT_BAR(2);
  s16x4 vlo[8],vhi[8]; u32x4 pw0,pw1,pw2,pw3;
  #define PKW(P,B) cvtpk_s(P[B],P[B+1])
  #define PAF(k) __builtin_bit_cast(bf16x8,pw##k)
  #define VFR(i) (bf16x8){vlo[i][0],vlo[i][1],vlo[i][2],vlo[i][3],vhi[i][0],vhi[i][1],vhi[i][2],vhi[i][3]}
  #define PIN(x) asm volatile("":"+v"(x))
  #define MX3(a,b,c) __builtin_fmaxf(__builtin_fmaxf((a),(b)),(c))
  #define GAPA(MF,A0,A1,A2,A3,W0,W1,PW) do{ MF; sacc+=A0; sacc+=A1; sacc+=A2; sacc+=A3; PIN(sacc); W0; W1; PIN(PW); SBAR(); }while(0)
  #define EX(v) __builtin_amdgcn_exp2f(v)
  #define GAPB(MF,X,B) do{ MF; X[B]=EX(X[B]); X[B+1]=EX(X[B+1]); X[B+2]=EX(X[B+2]); X[B+3]=EX(X[B+3]); PIN(X); SBAR(); }while(0)
  #define VRD(i) do{ vlo[i]=vtr(vp_+(((i)>>2)*4096+((i)&3)*1024)); vhi[i]=vtr(vp_+(((i)>>2)*4096+((i)&3)*1024+512)); }while(0)
  #define KRD(G,j) do{ if((G)&&(j)<2){ KLD(j,kp0+sl_next); SBAR(); } }while(0)
  #define STEP(C0,C1,P0,P1,t,GK,GV,GL) do{ SBAR(); \
    const lds_cptr vp_=vp0+sl_prev; \
    VRD(0); SBAR(); float sacc=(P0[0]+P0[1]); \
    GAPA(QKMF(C0,0), P0[2],P0[3],P0[4],P0[5],     pw0[0]=PKW(P0,0), pw0[1]=PKW(P0,2), pw0); \
    VRD(4); SBAR(); GAPA(QKMF(C1,1), P0[6],P0[7],P0[8],P0[9],     pw0[2]=PKW(P0,4), pw0[3]=PKW(P0,6), pw0); \
    VRD(1); SBAR(); GAPA((void)0, P0[10],P0[11],P0[12],P0[13], pw1[0]=PKW(P0,8), pw1[1]=PKW(P0,10), pw1); \
    VRD(5); SBAR(); GAPA((void)0, P0[14],P0[15],P1[0],P1[1],   pw1[2]=PKW(P0,12),pw1[3]=PKW(P0,14), pw1); \
    VRD(2); SBAR(); GAPA((void)0, P1[2],P1[3],P1[4],P1[5],     pw2[0]=PKW(P1,0), pw2[1]=PKW(P1,2), pw2); \
    VRD(6); SBAR(); GAPA((void)0, P1[6],P1[7],P1[8],P1[9],     pw2[2]=PKW(P1,4), pw2[3]=PKW(P1,6), pw2); \
    VRD(3); SBAR(); GAPA((void)0, P1[10],P1[11],P1[12],P1[13], pw3[0]=PKW(P1,8), pw3[1]=PKW(P1,10), pw3); \
    VRD(7); SBAR(); GAPA((void)0, P1[14],P1[15],0.f,0.f,       pw3[2]=PKW(P1,12),pw3[3]=PKW(P1,14), pw3); \
    l_reg+=sacc; \
    if(GK){DMA_K((t)+3,sl_cur);} if(GV){DMA_V((t)+1,sl_next);} \
    SBAR(); \
    GAPB(o[0]=__builtin_amdgcn_mfma_f32_32x32x16_bf16(PAF(0),VFR(0),o[0],0,0,0), C0,0); \
    GAPB(o[1]=__builtin_amdgcn_mfma_f32_32x32x16_bf16(PAF(0),VFR(4),o[1],0,0,0), C0,4); \
    KRD(GL,0); GAPB(o[0]=__builtin_amdgcn_mfma_f32_32x32x16_bf16(PAF(1),VFR(1),o[0],0,0,0), C0,8); \
    KRD(GL,1); GAPB(o[1]=__builtin_amdgcn_mfma_f32_32x32x16_bf16(PAF(1),VFR(5),o[1],0,0,0), C0,12); \
    KRD(GL,2); GAPB(o[0]=__builtin_amdgcn_mfma_f32_32x32x16_bf16(PAF(2),VFR(2),o[0],0,0,0), C1,0); \
    KRD(GL,3); GAPB(o[1]=__builtin_amdgcn_mfma_f32_32x32x16_bf16(PAF(2),VFR(6),o[1],0,0,0), C1,4); \
    GAPB(o[0]=__builtin_amdgcn_mfma_f32_32x32x16_bf16(PAF(3),VFR(3),o[0],0,0,0), C1,8); \
    GAPB(o[1]=__builtin_amdgcn_mfma_f32_32x32x16_bf16(PAF(3),VFR(7),o[1],0,0,0), C1,12); \
    }while(0)
  int t=1;
  #undef CMASK
  #define CMASK(P0,P1,t) do{}while(0)
  for(;t+5<NT;t+=2){
    STEP(pB0,pB1,pA0,pA1,t,true,true,true);     WAIT_BAR(2); RESC(); ROT();
    STEP(pA0,pA1,pB0,pB1,t+1,true,true,true);   WAIT_BAR(2); RESC(); ROT();
  }
  #undef CMASK
  #define CMASK(P0,P1,t) do{}while(0)
  #define ENDW(tt) do{ if((tt)+3<NT){WAIT_BAR(2);} else if((tt)+2<NT){WAIT_BAR(1);} else {WAIT_BAR(0);} }while(0)
  for(;t+1<NT;t+=2){
    STEP(pB0,pB1,pA0,pA1,t,(t+3<NT),(t+1<NT),(t+1<NT));       ENDW(t);   RESC(); ROT();
    STEP(pA0,pA1,pB0,pB1,t+1,(t+4<NT),(t+2<NT),(t+2<NT));     ENDW(t+1); RESC(); ROT();
  }
  STEP(pB0,pB1,pA0,pA1,NT-1,false,false,false); RESC();
  { float sacc=pB0[0]+pB0[1]; _Pragma("unroll") for(int r=2;r<16;++r)sacc+=pB0[r]; _Pragma("unroll") for(int r=0;r<16;++r)sacc+=pB1[r]; l_reg+=sacc;
    pw0=(u32x4){PKW(pB0,0),PKW(pB0,2),PKW(pB0,4),PKW(pB0,6)};pw1=(u32x4){PKW(pB0,8),PKW(pB0,10),PKW(pB0,12),PKW(pB0,14)};pw2=(u32x4){PKW(pB1,0),PKW(pB1,2),PKW(pB1,4),PKW(pB1,6)};pw3=(u32x4){PKW(pB1,8),PKW(pB1,10),PKW(pB1,12),PKW(pB1,14)};
    SBAR(); pv(o,vb0+sl_cur,PAF(0),PAF(1),PAF(2),PAF(3)); }
  #undef PKW
  #undef PAF
  #undef VFR
  #undef PIN
  #undef MX3
  #undef GAPA
  #undef GAPB
  #undef EX
  #undef VRD
  #undef KRD
  #undef KLD
  #undef QKMF
  #undef STEP
  #undef ENDW
  {auto rr=__builtin_amdgcn_permlane32_swap(__float_as_uint(l_reg),__float_as_uint(l_reg),false,false);l_reg=__uint_as_float(rr[0])+__uint_as_float(rr[1]);}
  if(hi==0)wsf[32+r32]=l_reg;asm volatile("s_waitcnt lgkmcnt(0)":::"memory");
  float rli[16];
  #pragma unroll
  for(int r=0;r<16;++r)rli[r]=__builtin_amdgcn_rcpf(wsf[32+crow(r,hi)]);
  bf16*Ow=O+(long)(q0+wid*QBLK)*QP+h*D;
  { bf16*stg=(bf16*)(shm+LDS_OST)+wid*2048;
    #pragma unroll
    for(int r=0;r<16;++r){const int orow=crow(r,hi);
      #pragma unroll
      for(int d0=0;d0<2;++d0)stg[orow*64+d0*32+r32]=__float2bfloat16(o[d0][r]*rli[r]);}
    asm volatile("s_waitcnt lgkmcnt(0)":::"memory");
    #pragma unroll
    for(int i=0;i<4;++i){const int row=i*8+(lane>>3),ch=lane&7; const u32x4 v=*(const u32x4*)(stg+row*64+ch*8); ATTN_STORE16(Ow+(long)row*QP+ch*8,v);} }
  asm volatile("s_waitcnt lgkmcnt(0)\n\ts_barrier":::"memory");
  #undef DMA_K
  #undef DMA_V
  #undef CMASK
  #undef TROW
  #undef START
  #undef RESC
  #undef ROT
}
constexpr int ATTN_LDS_BYTES=LDS_BYTES;
#undef SBAR
#undef WAIT_BAR
}
#ifndef EN_MIX
#define EN_MIX 15
#endif
#ifndef EN_MOE
#define EN_MOE 15
#endif
constexpr int NWAVES = 8, NTHR = 512;
constexpr int DM = 1024, NLAT = 16384, NCTX = 256, T = NLAT + NCTX, NPAN = T / 256;
constexpr int NE = 32, TOPK = 4, EFF = 1024;
constexpr int FA_NQKV = 1536, WA_NQKV = 1280, GM_FF = 4096, GM_HALF = 2048;
constexpr float LN_EPS = 1e-5f, RMS_EPS = 1e-6f;
constexpr float DN_ALPHA = 1.6817928305074292f;
constexpr float LOG2E = 1.4426950408889634f, QSCALE = 0.125f * LOG2E;
constexpr int NPHASE = 35;

constexpr size_t MiB = 1u << 20;
constexpr size_t WS_CTL = 0, CTL_ZERO_BYTES = 64 * 1024;
constexpr size_t WS_MOD = 1 * MiB;
constexpr size_t WS_TAB = 2 * MiB;
constexpr size_t TB_FC = WS_TAB, TB_FA = TB_FC + 512 * 256 * 2, TB_FCC = TB_FA + 256 * 256 * 2, TB_FX = TB_FCC + 256 * 256 * 2, TB_TWC = TB_FX + 256 * 512 * 2,
                 TB_TWS = TB_TWC + 128 * 128 * 4, TB_ROPC = TB_TWS + 128 * 128 * 4, TB_ROPS = TB_ROPC + (size_t)NLAT * 32 * 4, TB_END = TB_ROPS + (size_t)NLAT * 32 * 4;
static_assert(TB_END <= 10 * MiB, "tables");
constexpr size_t WS_RW = 10 * MiB;
constexpr size_t WS_LCNT = 11 * MiB;
constexpr size_t WS_ASG = 12 * MiB, WS_GATE = WS_ASG + (size_t)T * 16, WS_SLOT = WS_GATE + (size_t)T * 16;
constexpr int ECAPT = 65, ECAP = ECAPT * 256;
constexpr size_t WS_STOK_OLD = WS_ASG + 1 * MiB;
static_assert(WS_SLOT + (size_t)T * 16 <= WS_STOK_OLD, "assign");
constexpr size_t WS_WFN = 16 * MiB, WS_WFAQ = WS_WFN + 2 * MiB, WS_WFAO = WS_WFAQ + 3 * MiB, WS_WGI = WS_WFAO + 2 * MiB, WS_WGO = WS_WGI + 8 * MiB,
                 WS_WWQ = WS_WGO + 4 * MiB, WS_WWO = WS_WWQ + 3 * MiB, WS_WSM_END = WS_WWO + 2 * MiB;
static_assert(WS_WSM_END <= 40 * MiB, "small weights");
constexpr size_t WS_X = 40 * MiB;
constexpr size_t WS_H = 106 * MiB;
constexpr size_t WS_Y = 140 * MiB;
constexpr size_t WS_BIG = 176 * MiB;
constexpr size_t WS_BTA = WS_BIG, WS_BTC = WS_BTA + 64 * MiB, WS_BTX = WS_BTC + 64 * MiB, WS_MIXB = WS_BTX + 1 * MiB;
constexpr size_t WS_Q = WS_BIG, WS_K = WS_Q + 33 * MiB, WS_V = WS_K + 9 * MiB, WS_O = WS_V + 9 * MiB;
constexpr size_t WS_Q8 = WS_Q + 86 * MiB, WS_K8 = WS_Q + 104 * MiB;
constexpr size_t WS_GU = WS_BIG, WS_GV = WS_GU + 65 * MiB, WS_GG = WS_GV + 65 * MiB, WS_PSTAT = WS_GG + 66 * MiB;
constexpr int MAXMT = 292; constexpr size_t SLOTROWS = (size_t)MAXMT * 256;
constexpr size_t WS_XS = WS_BIG, WS_YS = WS_XS + 292 * MiB;
constexpr size_t WS_H8 = WS_XS;
constexpr float W8_SCALE = 32.0f, W8_INV = 1.0f / 32.0f;
static_assert(SLOTROWS * 2048 <= 146 * MiB, "slots");
constexpr size_t WS_WEXP_GU = 640 * MiB, WS_WEXP_DN = WS_WEXP_GU + 512 * MiB, WS_X2 = WS_WEXP_DN + 256 * MiB, WS_STOK = WS_X2 + 66 * MiB  , WS_ACT = WS_STOK + 4 * MiB  , WS_END = WS_ACT + (size_t)32 * ECAP * 2048;
static_assert(WS_YS + 146 * MiB <= WS_WEXP_GU && (size_t)32 * ECAP * 4 <= 4 * MiB, "big region");
constexpr int CW_BAR = 4096;
constexpr int CW_GCNT = 8192;
constexpr int CW_TMO = 0;
constexpr int CW_MCNT = 16384, MCNT_LAYER = 320 * 64;
static_assert((CW_BAR + 3456) <= CW_GCNT && (CW_GCNT + 4 * 32 * 64) * 4 <= (int)CTL_ZERO_BYTES, "control words inside the memset region");

constexpr int RING_OFF = 0, RING_BYTES = 131072;
constexpr int PRO_SCR_BYTES = 8 * 64 * 65 * 4;
constexpr int MISC_OFF = 136 * 1024;
constexpr int LDS_BYTES = 147456;
constexpr int MW_BAR = 0, MW_LC = 8, MW_TOT = 480, MW_EBASE = 64, MW_MYBASE = 96, MW_NMT = 128, MW_CONV = 132, MW_MTE = 160;
static_assert(MISC_OFF + (MW_MTE + 304) * 4 <= LDS_BYTES && PRO_SCR_BYTES <= MISC_OFF, "LDS map");

#define GAS __attribute__((address_space(1)))
#define LAS __attribute__((address_space(3)))
typedef unsigned short bf16;
typedef unsigned v4u __attribute__((ext_vector_type(4)));
typedef unsigned v2u __attribute__((ext_vector_type(2)));
typedef float f32x4 __attribute__((ext_vector_type(4)));
typedef float f32x2 __attribute__((ext_vector_type(2)));
typedef float f32x16 __attribute__((ext_vector_type(16)));
typedef short bf16x8 __attribute__((ext_vector_type(8)));
typedef GAS unsigned gu32;
#define RLX_AGENT __ATOMIC_RELAXED, __HIP_MEMORY_SCOPE_AGENT
#define LDS_WAIT() asm volatile("s_waitcnt lgkmcnt(0)" ::: "memory")
#define VM_WAIT() asm volatile("s_waitcnt vmcnt(0)" ::: "memory")
__device__ __forceinline__ unsigned f2bf(float f) { unsigned u = __builtin_bit_cast(unsigned, f); return (u + 0x7fffu + ((u >> 16) & 1u)) >> 16; }
__device__ __forceinline__ unsigned pk2(float lo, float hi) { return f2bf(lo) | (f2bf(hi) << 16); }
__device__ __forceinline__ float bf_lo(unsigned w) { return __builtin_bit_cast(float, w << 16); }
__device__ __forceinline__ float bf_hi(unsigned w) { return __builtin_bit_cast(float, w & 0xffff0000u); }
#define XB_TMO      128
#define XB_XCNT(j)  (256  + 64 * (j))
#define XB_XSUB(j)  (1280 + 64 * (j))
#define XB_XGEN(j)  (2304 + 64 * (j))
#define XB_TOP      3328
#define XB_TOPGEN   3392
#define XCD_BAR_WORDS 3456
#define XB_SPIN_CAP (1u << 18)

__device__ __forceinline__ unsigned xb_ld(unsigned* p)              { return __hip_atomic_load(p, __ATOMIC_RELAXED, __HIP_MEMORY_SCOPE_AGENT); }
__device__ __forceinline__ unsigned xb_add(unsigned* p, unsigned v) { return __hip_atomic_fetch_add(p, v, __ATOMIC_RELAXED, __HIP_MEMORY_SCOPE_AGENT); }
__device__ __forceinline__ unsigned xb_xcc_id() { return (unsigned)__builtin_amdgcn_s_getreg((3 << 11) | 20) & 0xFu; }
#define XB_SPIN(cond, bar) do { unsigned _sp = 0; while (cond) { __builtin_amdgcn_s_sleep(1); \
    if ((++_sp & 255u) == 0u) { if (xb_ld(&(bar)[XB_TMO])) break; if (_sp > XB_SPIN_CAP) { atomicAdd(&(bar)[XB_TMO], 1u); break; } } } } while (0)

struct XcdBarrier {
    unsigned* bar; unsigned x;
    volatile LAS unsigned* st;
};

__device__ __forceinline__ XcdBarrier xcd_barrier_post(unsigned* bar, volatile LAS unsigned* st) {
    XcdBarrier b; b.bar = bar; b.x = xb_xcc_id(); b.st = st;
    if (threadIdx.x == 0) (void)xb_add(&bar[XB_XCNT(b.x)], 1u);
    return b;
}
__device__ __forceinline__ void xcd_barrier_complete(unsigned* bar, unsigned x, unsigned& nloc, unsigned& nx) {
    const unsigned G = gridDim.x * gridDim.y * gridDim.z;
    unsigned sum, cnt, mine, sp = 0u;
    for (;;) {
        sum = 0u; cnt = 0u; mine = 0u;
#pragma unroll
        for (unsigned j = 0; j < 16; ++j) { const unsigned c = xb_ld(&bar[XB_XCNT(j)]); sum += c; cnt += (c > 0u) ? 1u : 0u; mine = (j == x) ? c : mine; }
        if (sum == G) break;
        __builtin_amdgcn_s_sleep(1);
        if ((++sp & 255u) == 0u) { if (xb_ld(&bar[XB_TMO])) break; if (sp > XB_SPIN_CAP) { atomicAdd(&bar[XB_TMO], 1u); break; } }
    }
    nloc = mine > 0u ? mine : 1u; nx = cnt > 0u ? cnt : 1u;
}

__device__ __forceinline__ void xcd_barrier(const XcdBarrier& b) {
    asm volatile("s_waitcnt vmcnt(0)" ::: "memory");
    __syncthreads();
    if (threadIdx.x == 0) {
        unsigned* bar = b.bar;
        __builtin_amdgcn_s_waitcnt(0);
        unsigned nloc = b.st[0], nx = b.st[1];
        if (nloc == 0u) { xcd_barrier_complete(bar, b.x, nloc, nx); b.st[0] = nloc; b.st[1] = nx; }
        const unsigned old = xb_add(&bar[XB_XSUB(b.x)], 1u);
        const unsigned gen = old / nloc;
        if (old + 1u == (gen + 1u) * nloc) {
            __builtin_amdgcn_fence(__ATOMIC_RELEASE, "agent");
            asm volatile("s_waitcnt vmcnt(0)" ::: "memory");
            const unsigned og = xb_add(&bar[XB_TOP], 1u);
            const unsigned tg = og / nx;
            if (og + 1u == (tg + 1u) * nx) xb_add(&bar[XB_TOPGEN], 1u);
            else XB_SPIN(xb_ld(&bar[XB_TOPGEN]) == tg, bar);
            __builtin_amdgcn_fence(__ATOMIC_ACQUIRE, "agent");
            xb_add(&bar[XB_XGEN(b.x)], 1u);
            asm volatile("s_waitcnt vmcnt(0)" ::: "memory");
        } else {
            XB_SPIN(xb_ld(&bar[XB_XGEN(b.x)]) == gen, bar);
            __builtin_amdgcn_fence(__ATOMIC_ACQUIRE, "agent");
            asm volatile("s_waitcnt vmcnt(0)" ::: "memory");
        }
    }
    __syncthreads();
}
struct Frame {
    LAS unsigned char* lds;
    volatile LAS unsigned* MISC;
    gu32* ctl;
    unsigned char* ws;
    int wave, vcu, G, bx;
};
enum In { I_X = 0, I_C, I_CTX, I_CCTX, I_ADAW, I_ADAB, I_LNMG, I_LNMB, I_LNFG, I_LNFB, I_FNW, I_FNB, I_FAWQ, I_FABQ, I_FAQN, I_FAKN, I_FAWO, I_FABO,
          I_GMWI, I_GMBI, I_GMVG, I_GMVB, I_GMWS, I_GMBS, I_GMWO, I_GMBO, I_WAWQ, I_WABQ, I_WASK, I_WAWO, I_WABO, I_RW, I_RB, I_EWGU, I_EBGU, I_EWD, I_EBD, N_IN };

#define CAS __attribute__((address_space(4)))
typedef const float* cfptr_t;
__device__ __forceinline__ const float* argp(int idx) {
    unsigned long long a = (unsigned long long)__builtin_amdgcn_kernarg_segment_ptr(); asm volatile("" : "+s"(a));
    return ((const CAS cfptr_t*)a)[idx];
}
__device__ __forceinline__ int otid() { int t = threadIdx.x; asm volatile("" : "+v"(t)); return t; }
__device__ __forceinline__ float wave_sum(float v) {
#pragma unroll
    for (int o = 1; o < 64; o <<= 1) v += __shfl_xor(v, o);
    return v;
}
struct RowV { f32x4 v[4]; };
__device__ __forceinline__ RowV ldrow(const float* p, int lane) { RowV r; const f32x4* q = (const f32x4*)p + lane;
#pragma unroll
    for (int j = 0; j < 4; ++j) r.v[j] = q[64 * j]; return r; }
__device__ __forceinline__ void strow(float* p, int lane, const RowV& r) { f32x4* q = (f32x4*)p + lane;
#pragma unroll
    for (int j = 0; j < 4; ++j) q[64 * j] = r.v[j]; }
__device__ __forceinline__ void strow_bf16(bf16* p, int lane, const RowV& r) { unsigned long long* q = (unsigned long long*)p + lane;
#pragma unroll
    for (int j = 0; j < 4; ++j) q[64 * j] = (unsigned long long)pk2(r.v[j].x, r.v[j].y) | ((unsigned long long)pk2(r.v[j].z, r.v[j].w) << 32); }
__device__ __forceinline__ RowV ldrow_bf16(const bf16* p, int lane) { RowV r; const v2u* q = (const v2u*)p + lane;
#pragma unroll
    for (int j = 0; j < 4; ++j) { const v2u w = q[64 * j]; r.v[j] = (f32x4){bf_lo(w.x), bf_hi(w.x), bf_lo(w.y), bf_hi(w.y)}; } return r; }
__device__ __forceinline__ RowV ln_row(const RowV& x, const RowV& g, const RowV& b) {
    float s = 0.f;
#pragma unroll
    for (int j = 0; j < 4; ++j) s += (x.v[j].x + x.v[j].y) + (x.v[j].z + x.v[j].w);
    const float mean = wave_sum(s) * (1.f / DM); float s2 = 0.f; RowV d;
#pragma unroll
    for (int j = 0; j < 4; ++j) { d.v[j] = x.v[j] - mean; s2 += (d.v[j].x * d.v[j].x + d.v[j].y * d.v[j].y) + (d.v[j].z * d.v[j].z + d.v[j].w * d.v[j].w); }
    const float rstd = 1.f / sqrtf(wave_sum(s2) * (1.f / DM) + LN_EPS);
#pragma unroll
    for (int j = 0; j < 4; ++j) d.v[j] = d.v[j] * rstd * g.v[j] + b.v[j];
    return d;
}
__device__ __forceinline__ const float* modp(const Frame& F, int L, int s, int which) { return (const float*)(F.ws + WS_MOD) + ((size_t)(L * 2 + s) * 6 + which) * DM; }

struct TokOrder : pg8::GridOrder {
    size_t apan, bpan;
    __device__ __forceinline__ bool next(int i, pg8::Unit& u) const { u.e = 0; return next_mn(i, u.pm, u.pn); }
    __device__ __forceinline__ size_t offA(const pg8::Unit& u) const { return (size_t)u.pm * apan; }
    __device__ __forceinline__ size_t offB(const pg8::Unit& u) const { return (size_t)u.pn * bpan; }
    __device__ __forceinline__ void a_ready(const pg8::Unit&) const {}
    __device__ __forceinline__ void done(const pg8::Unit&) const {}
};
struct ChDftOrder : pg8::GridOrder {
    __device__ __forceinline__ bool next(int i, pg8::Unit& u) const { u.e = 0; return next_mn(i, u.pm, u.pn); }
    __device__ __forceinline__ size_t offA(const pg8::Unit& u) const { return (size_t)u.pm * (256 * 256 * 2); }
    __device__ __forceinline__ size_t offB(const pg8::Unit& u) const { const int g = u.pn >> 6, j = u.pn & 63; return ((size_t)(2 * j) * DM + g * 256) * 2; }
    __device__ __forceinline__ void a_ready(const pg8::Unit&) const {}
    __device__ __forceinline__ void done(const pg8::Unit&) const {}
};
struct ChDftCtxOrder : pg8::GridOrder {
    __device__ __forceinline__ bool next(int i, pg8::Unit& u) const { u.e = 0; return next_mn(i, u.pm, u.pn); }
    __device__ __forceinline__ size_t offA(const pg8::Unit& u) const { return (size_t)u.pm * (256 * 256 * 2); }
    __device__ __forceinline__ size_t offB(const pg8::Unit& u) const { return ((size_t)NLAT * DM + u.pn * 256) * 2; }
    __device__ __forceinline__ void a_ready(const pg8::Unit&) const {}
    __device__ __forceinline__ void done(const pg8::Unit&) const {}
};
struct MoeOrder : pg8::GridOrder {
    const volatile LAS unsigned* mte; size_t bexp, apan, bpan;
    __device__ __forceinline__ bool next(int i, pg8::Unit& u) const { int pl; if (!next_mn(i, pl, u.pn)) return false; u.pm = (int)mte[pl]; u.e = u.pm / ECAPT; return true; }
    __device__ __forceinline__ size_t offA(const pg8::Unit& u) const { return (size_t)u.pm * apan; }
    __device__ __forceinline__ size_t offB(const pg8::Unit& u) const { return (size_t)u.e * bexp + (size_t)u.pn * bpan; }
    __device__ __forceinline__ void a_ready(const pg8::Unit&) const {}
    __device__ __forceinline__ void done(const pg8::Unit&) const {}
};

struct MoeOrderG : pg8::GridOrder {
    const volatile LAS unsigned* mte; size_t bexp, bpan; const unsigned* stok; unsigned rowbytes;
    __device__ __forceinline__ bool next(int i, pg8::Unit& u) const { int pl; if (!next_mn(i, pl, u.pn)) return false; u.pm = (int)mte[pl]; u.e = u.pm / ECAPT; return true; }
    __device__ __forceinline__ size_t offA(const pg8::Unit&) const { return 0; }
    __device__ __forceinline__ size_t offB(const pg8::Unit& u) const { return (size_t)u.e * bexp + (size_t)u.pn * bpan; }
    __device__ __forceinline__ unsigned rowoff(const pg8::Unit& u, int row) const { return (stok[u.pm * 256 + row] >> 2) * rowbytes; }
    __device__ __forceinline__ void a_ready(const pg8::Unit&) const {}
    __device__ __forceinline__ void done(const pg8::Unit&) const {}
};

#define EPI_ARGS const pg8::f32x4 (&acc)[2][2][4][2], const pg8::Unit& u, int wr, int wc, int fr, int fq
__device__ __forceinline__ unsigned pk4f8(float a, float b, float c, float d) { int w = 0; w = __builtin_amdgcn_cvt_pk_fp8_f32(a, b, w, false); w = __builtin_amdgcn_cvt_pk_fp8_f32(c, d, w, true); return (unsigned)w; }
__device__ __forceinline__ v2u pack8f8(const f32x4& a, const f32x4& b) { v2u w; w.x = pk4f8(a[0], a[1], a[2], a[3]); w.y = pk4f8(b[0], b[1], b[2], b[3]); return w; }
__device__ __forceinline__ v4u pack8(const f32x4& a, const f32x4& b) { v4u w; w.x = pg8::cvt_pk_bf16(a[0], a[1]); w.y = pg8::cvt_pk_bf16(a[2], a[3]); w.z = pg8::cvt_pk_bf16(b[0], b[1]); w.w = pg8::cvt_pk_bf16(b[2], b[3]); return w; }

struct EpiChDft { static constexpr bool PERM = true, AFTER_DRAIN = false; bf16* O;
    __device__ __forceinline__ void operator()(EPI_ARGS) const {
        const int g = u.pn >> 6, j = u.pn & 63, part = u.pm;
        char* ub = (char*)O + 2 * ((size_t)((g * 256 + 64 * wr) * 128 + 2 * j) * 256 + part * 128 + 32 * wc);
        unsigned lo = 2u * (unsigned)(fr * 128 * 256 + 8 * fq); asm volatile("" : "+v"(lo));
#pragma unroll
        for (int ai = 0; ai < 2; ++ai)
#pragma unroll
            for (int m = 0; m < 4; ++m)
#pragma unroll
                for (int bj = 0; bj < 2; ++bj)
                    *(v4u*)(ub + (size_t)(2 * (((128 * ai + 16 * m) * 128 + bj) * 256)) + lo) = pack8(acc[ai][bj][m][0], acc[ai][bj][m][1]);
    }
};
struct EpiChDftCtx { static constexpr bool PERM = true, AFTER_DRAIN = false; bf16* O;
    __device__ __forceinline__ void operator()(EPI_ARGS) const {
        const int g = u.pn, part = u.pm;
        char* ub = (char*)O + 2 * ((size_t)(g * 256 + 64 * wr) * 512 + part * 256 + 32 * wc);
        unsigned lo = 2u * (unsigned)(fr * 512 + 8 * fq); asm volatile("" : "+v"(lo));
#pragma unroll
        for (int ai = 0; ai < 2; ++ai)
#pragma unroll
            for (int m = 0; m < 4; ++m)
#pragma unroll
                for (int bj = 0; bj < 2; ++bj)
                    *(v4u*)(ub + (size_t)(2 * ((128 * ai + 16 * m) * 512 + 128 * bj)) + lo) = pack8(acc[ai][bj][m][0], acc[ai][bj][m][1]);
    }
};
struct EpiStepA { static constexpr bool PERM = true, AFTER_DRAIN = false; bf16* O; const float* twc; const float* tws;
    __device__ __forceinline__ void operator()(EPI_ARGS) const {
        char* ub = (char*)O + 2 * ((size_t)(64 * wr * 1024 + 2 * u.pn) * 256 + 32 * wc);
        unsigned lo = 2u * (unsigned)(fr * 1024 * 256 + 8 * fq); asm volatile("" : "+v"(lo));
        const char* tcb = (const char*)twc + 4 * (64 * wr * 128 + 32 * wc); const char* tsb = (const char*)tws + 4 * (64 * wr * 128 + 32 * wc);
        unsigned tlo = 4u * (unsigned)(fr * 128 + 8 * fq); asm volatile("" : "+v"(tlo));
#pragma unroll
        for (int m = 0; m < 4; ++m) {
            const f32x4 c0 = *(const f32x4*)(tcb + 4 * (16 * m * 128) + tlo), c1 = *(const f32x4*)(tcb + 4 * (16 * m * 128 + 4) + tlo), s0 = *(const f32x4*)(tsb + 4 * (16 * m * 128) + tlo), s1 = *(const f32x4*)(tsb + 4 * (16 * m * 128 + 4) + tlo);
#pragma unroll
            for (int bj = 0; bj < 2; ++bj) {
                const f32x4 zr0 = acc[0][bj][m][0], zr1 = acc[0][bj][m][1], zi0 = acc[1][bj][m][0], zi1 = acc[1][bj][m][1];
                const f32x4 yr0 = zr0 * c0 + zi0 * s0, yr1 = zr1 * c1 + zi1 * s1, yi0 = zi0 * c0 - zr0 * s0, yi1 = zi1 * c1 - zr1 * s1;
                char* p = ub + (size_t)(2 * ((16 * m * 1024 + bj) * 256)) + lo;
                *(v4u*)p = pack8(yr0, yr1); *(v4u*)(p + 256) = pack8(yi0, yi1); }
            asm volatile("" ::: "memory"); }
    }
};
struct EpiStepC { static constexpr bool PERM = true, AFTER_DRAIN = false; bf16* O;
    __device__ __forceinline__ void operator()(EPI_ARGS) const {
        const int k1 = u.pn >> 2, chb = (u.pn & 3) * 256;
        char* ub = (char*)O + 2 * ((size_t)(k1 + 128 * 64 * wr) * DM + chb + 32 * wc);
        unsigned lo = 2u * (unsigned)(128 * fr * DM + 8 * fq); asm volatile("" : "+v"(lo));
#pragma unroll
        for (int m = 0; m < 4; ++m)
#pragma unroll
            for (int bj = 0; bj < 2; ++bj)
                *(v4u*)(ub + (size_t)(2 * (128 * 16 * m * DM + 128 * bj)) + lo) = pack8(acc[0][bj][m][0], acc[0][bj][m][1]);
    }
};
struct EpiCtxPos { static constexpr bool PERM = true, AFTER_DRAIN = false; bf16* O;
    __device__ __forceinline__ void operator()(EPI_ARGS) const {
        char* ub = (char*)O + 2 * ((size_t)(NLAT + 64 * wr) * DM + u.pn * 256 + 32 * wc);
        unsigned lo = 2u * (unsigned)(fr * DM + 8 * fq); asm volatile("" : "+v"(lo));
#pragma unroll
        for (int ai = 0; ai < 2; ++ai)
#pragma unroll
            for (int m = 0; m < 4; ++m)
#pragma unroll
                for (int bj = 0; bj < 2; ++bj)
                    *(v4u*)(ub + (size_t)(2 * ((128 * ai + 16 * m) * DM + 128 * bj)) + lo) = pack8(acc[ai][bj][m][0], acc[ai][bj][m][1]);
    }
};
template <int NKV, bool RMS> struct EpiQKV { static constexpr bool PERM = true, AFTER_DRAIN = false;
    bf16 *Q, *K, *V; const float* bias; const float* qn; const float* kn; const float* ropc; const float* rops;
    __device__ __forceinline__ void operator()(EPI_ARGS) const {
        const int hh = 4 * u.pn + wc; const int kind = hh < 16 ? 0 : (hh < 16 + NKV ? 1 : 2);
        const int pitch = kind == 0 ? DM : NKV * 64, hd = kind == 0 ? hh : (kind == 1 ? hh - 16 : hh - 16 - NKV);
        const bool f8 = RMS && kind < 2;
        const unsigned es = f8 ? 1u : 2u;
        const size_t doff = f8 ? (kind == 0 ? (size_t)(WS_Q8 - WS_Q) : (size_t)(WS_K8 - WS_Q)) : (kind == 0 ? (size_t)0 : (kind == 1 ? (size_t)(WS_K - WS_Q) : (size_t)(WS_V - WS_Q)));
        bf16* dst = (bf16*)((char*)Q + doff);
        const bool lat = u.pm < NLAT / 256;
        const int rowu = u.pm * 256 + 64 * wr;
        char* ub = (char*)dst + es * ((size_t)rowu * pitch + hd * 64);
        unsigned lo = es * (unsigned)(fr * pitch + 8 * fq); asm volatile("" : "+v"(lo));
        const char* rcb = (const char*)ropc + 4 * ((size_t)rowu * 32); const char* rsb = (const char*)rops + 4 * ((size_t)rowu * 32);
        unsigned rlo = 4u * (unsigned)(fr * 32 + 4 * fq); asm volatile("" : "+v"(rlo));
        f32x4 bv[2][2], gv[2][2];
#pragma unroll
        for (int bj = 0; bj < 2; ++bj)
#pragma unroll
            for (int n = 0; n < 2; ++n) { const int d = 32 * bj + 8 * fq + 4 * n; bv[bj][n] = *(const f32x4*)(bias + hh * 64 + d);
                if (RMS) { const f32x4 gq = *(const f32x4*)(qn + d), gk = *(const f32x4*)(kn + d); gv[bj][n] = kind == 0 ? gq : gk; } }
#pragma unroll
        for (int ai = 0; ai < 2; ++ai)
#pragma unroll
            for (int m = 0; m < 4; ++m) {
                f32x4 v[2][2];
#pragma unroll
                for (int bj = 0; bj < 2; ++bj)
#pragma unroll
                    for (int n = 0; n < 2; ++n) v[bj][n] = acc[ai][bj][m][n] + bv[bj][n];
                if (kind < 2) {
                    if (RMS) { float ss = 0.f;
#pragma unroll
                        for (int bj = 0; bj < 2; ++bj)
#pragma unroll
                            for (int n = 0; n < 2; ++n) ss += (v[bj][n][0] * v[bj][n][0] + v[bj][n][1] * v[bj][n][1]) + (v[bj][n][2] * v[bj][n][2] + v[bj][n][3] * v[bj][n][3]);
                        ss += __shfl_xor(ss, 16); ss += __shfl_xor(ss, 32);
                        const float rs = 1.f / sqrtf(ss * (1.f / 64.f) + RMS_EPS);
#pragma unroll
                        for (int bj = 0; bj < 2; ++bj)
#pragma unroll
                            for (int n = 0; n < 2; ++n) v[bj][n] = v[bj][n] * rs * gv[bj][n]; }
                    if (lat) {
#pragma unroll
                        for (int bj = 0; bj < 2; ++bj)
#pragma unroll
                            for (int n = 0; n < 2; ++n) {
                                const f32x2 c = *(const f32x2*)(rcb + 4 * ((128 * ai + 16 * m) * 32 + 16 * bj + 2 * n) + rlo), sn = *(const f32x2*)(rsb + 4 * ((128 * ai + 16 * m) * 32 + 16 * bj + 2 * n) + rlo);
                                const f32x4 x = v[bj][n];
                                v[bj][n] = (f32x4){x[0] * c.x - x[1] * sn.x, x[0] * sn.x + x[1] * c.x, x[2] * c.y - x[3] * sn.y, x[2] * sn.y + x[3] * c.y}; } }
                    if (kind == 0) {
#pragma unroll
                        for (int bj = 0; bj < 2; ++bj)
#pragma unroll
                            for (int n = 0; n < 2; ++n) v[bj][n] = v[bj][n] * QSCALE; }
                }
                char* p = ub + (size_t)(128 * ai + 16 * m) * (size_t)(es * pitch) + lo;
                if (f8) { *(v2u*)p = pack8f8(v[0][0], v[0][1]); *(v2u*)(p + 32) = pack8f8(v[1][0], v[1][1]); }
                else { *(v4u*)p = pack8(v[0][0], v[0][1]); *(v4u*)(p + 64) = pack8(v[1][0], v[1][1]); }
                if (m & 1) asm volatile("" ::: "memory"); }
    }
};
struct EpiGeluUV { static constexpr bool PERM = true, AFTER_DRAIN = false; bf16* U; bf16* V; const float* bias; float* pstat;
    __device__ __forceinline__ void operator()(EPI_ARGS) const {
        const bool isv = u.pn >= 8; const int colt = (u.pn & 7) * 256;
        char* ub = (char*)(isv ? V : U) + 2 * ((size_t)(u.pm * 256 + 64 * wr) * GM_HALF + colt + 32 * wc);
        unsigned lo = 2u * (unsigned)(fr * GM_HALF + 8 * fq); asm volatile("" : "+v"(lo));
        const float* bb = bias + u.pn * 256 + 32 * wc + 8 * fq;
        f32x4 bv[2][2];
#pragma unroll
        for (int bj = 0; bj < 2; ++bj)
#pragma unroll
            for (int n = 0; n < 2; ++n) bv[bj][n] = *(const f32x4*)(bb + 128 * bj + 4 * n);
#pragma unroll
        for (int ai = 0; ai < 2; ++ai)
#pragma unroll
            for (int m = 0; m < 4; ++m) { float s = 0.f, s2 = 0.f;
#pragma unroll
                for (int bj = 0; bj < 2; ++bj) { const f32x4 x0 = acc[ai][bj][m][0] + bv[bj][0], x1 = acc[ai][bj][m][1] + bv[bj][1];
                    const pg8::f32x2 a = pg8::gelu_pk((pg8::f32x2){x0[0], x0[1]}), b = pg8::gelu_pk((pg8::f32x2){x0[2], x0[3]}), c = pg8::gelu_pk((pg8::f32x2){x1[0], x1[1]}), d = pg8::gelu_pk((pg8::f32x2){x1[2], x1[3]});
                    s += ((a.x + a.y) + (b.x + b.y)) + ((c.x + c.y) + (d.x + d.y)); s2 += ((a.x * a.x + a.y * a.y) + (b.x * b.x + b.y * b.y)) + ((c.x * c.x + c.y * c.y) + (d.x * d.x + d.y * d.y));
                    v4u w; w.x = pg8::cvt_pk_bf16(a.x, a.y); w.y = pg8::cvt_pk_bf16(b.x, b.y); w.z = pg8::cvt_pk_bf16(c.x, c.y); w.w = pg8::cvt_pk_bf16(d.x, d.y);
                    *(v4u*)(ub + (size_t)(2 * ((128 * ai + 16 * m) * GM_HALF + 128 * bj)) + lo) = w; }
                if (isv) { s += __shfl_xor(s, 16); s += __shfl_xor(s, 32); s2 += __shfl_xor(s2, 16); s2 += __shfl_xor(s2, 32);
                    if (fq == 0) *(f32x2*)(pstat + ((size_t)(u.pm * 256 + 128 * ai + 64 * wr + 16 * m + fr) * 32 + (u.pn - 8) * 4 + wc) * 2) = (f32x2){s, s2}; } }
    }
};
struct EpiSwiGLU { static constexpr bool PERM = true, AFTER_DRAIN = false; unsigned char* O; const float* bias;
    __device__ __forceinline__ void operator()(EPI_ARGS) const {
        f32x4 bv[2][2];
        const float* bb = bias + (size_t)u.e * 2048 + u.pn * 256 + 32 * wc + 8 * fq;
#pragma unroll
        for (int bj = 0; bj < 2; ++bj)
#pragma unroll
            for (int n = 0; n < 2; ++n) bv[bj][n] = *(const f32x4*)(bb + 128 * bj + 4 * n);
        char* ub = (char*)O + (((size_t)u.pm * 256 + 64 * wr) * 1024 + u.pn * 128 + 16 * wc);
        unsigned lo = (unsigned)(fr * 1024 + 4 * fq); asm volatile("" : "+v"(lo));
#pragma unroll
        for (int ai = 0; ai < 2; ++ai)
#pragma unroll
            for (int m = 0; m < 4; ++m) {
#pragma unroll
                for (int bj = 0; bj < 2; ++bj) { float a[4];
#pragma unroll
                    for (int n = 0; n < 2; ++n) { const f32x4 x = acc[ai][bj][m][n] * W8_INV + bv[bj][n];
#pragma unroll
                        for (int q = 0; q < 2; ++q) { const float glu = fminf(x[2 * q], 7.0f), lin = fminf(fmaxf(x[2 * q + 1], -7.0f), 7.0f);
                            const float sg = __builtin_amdgcn_rcpf(1.0f + __builtin_amdgcn_exp2f(-1.702f * LOG2E * glu));
                            a[2 * n + q] = glu * sg * (lin + 1.0f); } }
                    int w = 0; w = __builtin_amdgcn_cvt_pk_fp8_f32(a[0], a[1], w, false); w = __builtin_amdgcn_cvt_pk_fp8_f32(a[2], a[3], w, true);
                    *(int*)(ub + (size_t)((128 * ai + 16 * m) * 1024 + 64 * bj) + lo) = w; } }
    }
};
struct EpiDown { static constexpr bool PERM = true, AFTER_DRAIN = false; bf16* O; const float* bias; const unsigned* stok;
    __device__ __forceinline__ void operator()(EPI_ARGS) const {
        f32x4 bv[2][2];
        const float* bb = bias + (size_t)u.e * 1024 + u.pn * 256 + 32 * wc + 8 * fq;
#pragma unroll
        for (int bj = 0; bj < 2; ++bj)
#pragma unroll
            for (int n = 0; n < 2; ++n) bv[bj][n] = *(const f32x4*)(bb + 128 * bj + 4 * n);
        const char* spb = (const char*)stok + 4 * (u.pm * 256 + 64 * wr); unsigned so = 4u * (unsigned)fr; asm volatile("" : "+v"(so));
        unsigned yr[2][4];
#pragma unroll
        for (int ai = 0; ai < 2; ++ai)
#pragma unroll
            for (int m = 0; m < 4; ++m) yr[ai][m] = *(const unsigned*)(spb + 4 * (128 * ai + 16 * m) + so);
        char* ub = (char*)O + 2 * (u.pn * 256 + 32 * wc);
        unsigned lo = 2u * (unsigned)(8 * fq); asm volatile("" : "+v"(lo));
#pragma unroll
        for (int ai = 0; ai < 2; ++ai)
#pragma unroll
            for (int m = 0; m < 4; ++m) { const unsigned ro = yr[ai][m] * (unsigned)(DM * 2) + lo;
                if (yr[ai][m] != (unsigned)(4 * T)) {
#pragma unroll
                    for (int bj = 0; bj < 2; ++bj)
                        *(v4u*)(ub + (size_t)(256 * bj) + ro) = pack8(acc[ai][bj][m][0] * W8_INV + bv[bj][0], acc[ai][bj][m][1] * W8_INV + bv[bj][1]); } }
    }
};
__device__ __forceinline__ int qkv_rowmap(int n) { return (n & ~255) + ((n >> 5) & 1) * 128 + ((n >> 6) & 3) * 32 + (n & 31); }
__device__ __forceinline__ void p0_transpose_item(const float* W, int K, int N, bf16* WT, int rowmode, LAS float* scr, int item, int lane) {
    const int nblk = N / 64, kb = item / nblk, nb = item - kb * nblk, k0 = 64 * kb, n0 = 64 * nb;
    const int r = lane >> 4, cq = lane & 15;
    f32x4 t[16];
#pragma unroll
    for (int i = 0; i < 16; ++i) t[i] = __builtin_nontemporal_load((const f32x4*)(W + (size_t)(k0 + 4 * i + r) * N + n0 + 4 * cq));
#pragma unroll
    for (int i = 0; i < 16; ++i) { LAS float* s = scr + (4 * i + r) * 65 + 4 * cq; s[0] = t[i].x; s[1] = t[i].y; s[2] = t[i].z; s[3] = t[i].w; }
    LDS_WAIT(); asm volatile("" ::: "memory");
    const int c = lane & 7, nn = lane >> 3;
#pragma unroll
    for (int j = 0; j < 8; ++j) { const int n = nn + 8 * j; const LAS float* s = scr + (8 * c) * 65 + n;
        v4u o; o.x = pk2(s[0 * 65], s[1 * 65]); o.y = pk2(s[2 * 65], s[3 * 65]); o.z = pk2(s[4 * 65], s[5 * 65]); o.w = pk2(s[6 * 65], s[7 * 65]);
        const int row = rowmode ? qkv_rowmap(n0 + n) : (n0 + n);
        __builtin_nontemporal_store(o, (GAS v4u*)(WT + (size_t)row * K + k0 + 8 * c)); }
    LDS_WAIT(); asm volatile("" ::: "memory");
}
__device__ __forceinline__ void p0_transpose_item_f8(const float* W, int K, int N, unsigned char* WT, LAS float* scr, int item, int lane) {
    const int nblk = N / 64, kb = item / nblk, nb = item - kb * nblk, k0 = 64 * kb, n0 = 64 * nb;
    const int r = lane >> 4, cq = lane & 15;
    f32x4 t[16];
#pragma unroll
    for (int i = 0; i < 16; ++i) t[i] = __builtin_nontemporal_load((const f32x4*)(W + (size_t)(k0 + 4 * i + r) * N + n0 + 4 * cq));
#pragma unroll
    for (int i = 0; i < 16; ++i) { LAS float* s = scr + (4 * i + r) * 65 + 4 * cq; s[0] = t[i].x; s[1] = t[i].y; s[2] = t[i].z; s[3] = t[i].w; }
    LDS_WAIT(); asm volatile("" ::: "memory");
    const int c = lane & 3, nn = lane >> 2;
#pragma unroll
    for (int j = 0; j < 4; ++j) { const int n = nn + 16 * j; const LAS float* s = scr + (16 * c) * 65 + n; v4u o;
#pragma unroll
        for (int q = 0; q < 4; ++q) { int w = 0; w = __builtin_amdgcn_cvt_pk_fp8_f32(s[(4 * q) * 65] * W8_SCALE, s[(4 * q + 1) * 65] * W8_SCALE, w, false);
            w = __builtin_amdgcn_cvt_pk_fp8_f32(s[(4 * q + 2) * 65] * W8_SCALE, s[(4 * q + 3) * 65] * W8_SCALE, w, true); o[q] = (unsigned)w; }
        __builtin_nontemporal_store(o, (GAS v4u*)(WT + (size_t)(n0 + n) * K + k0 + 16 * c)); }
    LDS_WAIT(); asm volatile("" ::: "memory");
}
struct WgItem { const float* W; unsigned char* WT; int N, kb, nb; };
__device__ __forceinline__ void p0_wg_load(const WgItem& I, f32x4 (&t)[16], int wave, int lane) {
#pragma unroll
    for (int i = 0; i < 16; ++i) t[i] = __builtin_nontemporal_load((const f32x4*)(I.W + (size_t)(128 * I.kb + 16 * wave + i) * I.N + 256 * I.nb + 4 * lane));
}
__device__ __forceinline__ void p0_wg_stage(const f32x4 (&t)[16], LAS float* tile, int wave, int lane) {
#pragma unroll
    for (int i = 0; i < 16; ++i) *(LAS f32x4*)(tile + (16 * wave + i) * 260 + 4 * (lane ^ wave)) = t[i];
}
__device__ __forceinline__ void p0_wg_store(const WgItem& I, LAS float* tile, int tid) {
    const int c = tid & 7, k0 = 128 * I.kb, n0 = 256 * I.nb;
#pragma unroll
    for (int j = 0; j < 4; ++j) { const int n = (tid >> 3) + 64 * j; const LAS float* s = tile + (16 * c) * 260 + (n ^ (4 * c)); v4u o;
#pragma unroll
        for (int q = 0; q < 4; ++q) { int w = 0; w = __builtin_amdgcn_cvt_pk_fp8_f32(s[(4 * q) * 260] * W8_SCALE, s[(4 * q + 1) * 260] * W8_SCALE, w, false);
            w = __builtin_amdgcn_cvt_pk_fp8_f32(s[(4 * q + 2) * 260] * W8_SCALE, s[(4 * q + 3) * 260] * W8_SCALE, w, true); o[q] = (unsigned)w; }
        __builtin_nontemporal_store(o, (GAS v4u*)(I.WT + (size_t)(n0 + n) * 1024 + k0 + 16 * c)); }
}
constexpr int CONV_PER_LAYER = 32 * 64 + 32 * 32, CONV_UP_PER = 5, CONV_DN_PER = 3, CONV_QKV_PER = 6;
constexpr bool CONV_DEFER = !MK_PER_PHASE;
__device__ __forceinline__ WgItem conv_item(Frame& F, int L, int j) { WgItem I;
    if (j < 2048) { const int le = L * 32 + (j >> 6), r = j & 63; I.W = argp(I_EWGU) + (size_t)le * 1024 * 2048; I.N = 2048; I.WT = (unsigned char*)(F.ws + WS_WEXP_GU) + (size_t)le * 2048 * 1024; I.kb = r >> 3; I.nb = r & 7; }
    else { const int q = j - 2048, le = L * 32 + (q >> 5), r = q & 31; I.W = argp(I_EWD) + (size_t)le * 1024 * 1024; I.N = 1024; I.WT = (unsigned char*)(F.ws + WS_WEXP_DN) + (size_t)le * 1024 * 1024; I.kb = r >> 2; I.nb = r & 3; }
    return I; }
__device__ __forceinline__ void conv_range(Frame& F, int L, int lo, int hi, int rank, int stride) { const int tid = otid(), lane = tid & 63;
    __syncthreads();
    f32x4 t[16]; int it = lo + rank;
    if (it < hi) p0_wg_load(conv_item(F, L, it), t, F.wave, lane);
    for (; it < hi; it += stride) {
        p0_wg_stage(t, (LAS float*)F.lds, F.wave, lane);
        __syncthreads();
        if (it + stride < hi) p0_wg_load(conv_item(F, L, it + stride), t, F.wave, lane);
        p0_wg_store(conv_item(F, L, it), (LAS float*)F.lds, tid);
        __syncthreads();
    }
}
__device__ __forceinline__ void conv_tail(Frame& F, int L, int rem, int per) {
    const int c0 = (int)F.MISC[MW_CONV]; const int fre = rem ? F.G - rem : 0; int n = per * fre; if (n > CONV_PER_LAYER - c0) n = CONV_PER_LAYER - c0;
    if (rem && F.bx >= rem) conv_range(F, L, c0, c0 + n, F.bx - rem, fre); else __syncthreads();
    if (otid() == 0) F.MISC[MW_CONV] = (unsigned)(c0 + n);
}
__device__ __forceinline__ float siluf(float v) { return v / (1.f + __expf(-v)); }
__device__ __forceinline__ void p0_prologue(Frame& F) { const int tid = otid(), lane = tid & 63; (void)tid; (void)lane;
    {
        LAS float* sc = (LAS float*)(F.lds);
        LAS float* red = sc + 2048;
        { const float* c0 = argp(I_C); const float* c1 = argp(I_CCTX);
          for (int i = tid; i < 2048; i += NTHR) { const int s = i >> 10, k = i & 1023; sc[i] = siluf(s == 0 ? c0[k] : c1[k]); } }
        __syncthreads();
        const float* adaw = argp(I_ADAW); const float* adab = argp(I_ADAB);
        for (int task = F.bx; task < 4 * 48; task += F.G) {
            const int L = task / 48, n0 = (task % 48) * 128;
            const float* w = adaw + (size_t)L * DM * 6144 + n0 + 2 * lane;
            float a0 = 0.f, a1 = 0.f, b0 = 0.f, b1 = 0.f;
#pragma unroll 8
            for (int kk = 0; kk < 128; ++kk) { const int k = 128 * F.wave + kk; const f32x2 x = *(const f32x2*)(w + (size_t)k * 6144); const float sl = sc[k], sx = sc[1024 + k];
                a0 += sl * x.x; a1 += sl * x.y; b0 += sx * x.x; b1 += sx * x.y; }
            red[(F.wave * 2 + 0) * 128 + 2 * lane] = a0; red[(F.wave * 2 + 0) * 128 + 2 * lane + 1] = a1;
            red[(F.wave * 2 + 1) * 128 + 2 * lane] = b0; red[(F.wave * 2 + 1) * 128 + 2 * lane + 1] = b1;
            __syncthreads();
            if (tid < 256) { const int s = tid >> 7, col = tid & 127; float v = adab[(size_t)L * 6144 + n0 + col];
#pragma unroll
                for (int wv = 0; wv < 8; ++wv) v += red[(wv * 2 + s) * 128 + col];
                ((float*)(F.ws + WS_MOD))[(size_t)(L * 2 + s) * 6144 + n0 + col] = v; }
            __syncthreads();
        }
    }
    {
        const int gt = F.bx * NTHR + tid, NGT = F.G * NTHR;
        bf16* fc = (bf16*)(F.ws + TB_FC); bf16* fa = (bf16*)(F.ws + TB_FA); bf16* fcc = (bf16*)(F.ws + TB_FCC); bf16* fx = (bf16*)(F.ws + TB_FX);
        float* twc = (float*)(F.ws + TB_TWC); float* tws = (float*)(F.ws + TB_TWS); float* ropc = (float*)(F.ws + TB_ROPC); float* rops = (float*)(F.ws + TB_ROPS);
        for (int i = gt; i < 512 * 256; i += NGT) { const int row = i >> 8, c = i & 255, part = row >> 8, l = row & 255; const int m = (c * l) & 255;
            const float ang = (float)m * (2.0f / 256.0f); const float v = part == 0 ? cospif(ang) : -sinpif(ang); fc[i] = (bf16)f2bf(v * (1.0f / 16.0f)); }
        for (int i = gt; i < 256 * 256; i += NGT) { const int row = i >> 8, col = i & 255, pr = row >> 7, k1 = row & 127, pc = col >> 7, n1 = col & 127; const int m = (n1 * k1) & 127;
            const float ang = (float)m * (2.0f / 128.0f); const float cs = cospif(ang), sn = sinpif(ang);
            const float v = (pr == pc) ? cs : (pr == 0 ? sn : -sn); fa[i] = (bf16)f2bf(v * 0.08838834764831845f); }
        for (int i = gt; i < 256 * 256; i += NGT) { const int row = i >> 8, col = i & 255, pc = col >> 7, n2 = col & 127; float v = 0.f;
            if (row < 128) { const int m = (n2 * row) & 127; const float ang = (float)m * (2.0f / 128.0f); v = (pc == 0 ? cospif(ang) : sinpif(ang)) * 0.08838834764831845f; }
            fcc[i] = (bf16)f2bf(v); }
        for (int i = gt; i < 256 * 512; i += NGT) { const int k = i >> 9, col = i & 511, pc = col >> 8, n = col & 255; const int m = (n * k) & 255;
            const float ang = (float)m * (2.0f / 256.0f); fx[i] = (bf16)f2bf((pc == 0 ? cospif(ang) : sinpif(ang)) * (1.0f / 16.0f)); }
        for (int i = gt; i < 128 * 128; i += NGT) { const int k1 = i >> 7, n2 = i & 127; const float ang = (float)(k1 * n2) * (2.0f / 16384.0f); twc[i] = cospif(ang); tws[i] = sinpif(ang); }
        for (int i = gt; i < NLAT * 32; i += NGT) { const int t = i >> 5, j = i & 31; const float pos = (float)(j < 16 ? (t >> 6) : (t & 63));
            const float inv = powf(10000.0f, -(float)(j & 15) * (1.0f / 16.0f)); const float ang = pos * inv; float sn, cs; sincosf(ang, &sn, &cs); ropc[i] = cs; rops[i] = sn; }
        bf16* rw = (bf16*)(F.ws + WS_RW); const float* rwin = argp(I_RW);
        for (int i = gt; i < 4 * 32 * 1024; i += NGT) { const int L = i >> 15, e = (i >> 10) & 31, k = i & 1023; rw[i] = (bf16)f2bf(rwin[((size_t)L * 1024 + k) * 32 + e]); }
    }
    __syncthreads();
    {
        LAS float* scr = (LAS float*)(F.lds) + F.wave * (64 * 65);
        const int gw = F.vcu * NWAVES + F.wave, NGW = F.G * NWAVES;
        constexpr int I1 = 16 * 16, I2 = 16 * 24, I3 = 16 * 16, I4 = 16 * 64, I5 = 32 * 16, I6 = 16 * 20, I7 = 16 * 16, ISM = I1 + I2 + I3 + I4 + I5 + I6 + I7;
        for (int it = gw; it < ISM; it += NGW) {
            int r = it;
            if (r < I1) { p0_transpose_item(argp(I_FNW), 1024, 1024, (bf16*)(F.ws + WS_WFN), 0, scr, r, lane); continue; } r -= I1;
            if (r < I2) { p0_transpose_item(argp(I_FAWQ), 1024, FA_NQKV, (bf16*)(F.ws + WS_WFAQ), 1, scr, r, lane); continue; } r -= I2;
            if (r < I3) { p0_transpose_item(argp(I_FAWO), 1024, 1024, (bf16*)(F.ws + WS_WFAO), 0, scr, r, lane); continue; } r -= I3;
            if (r < I4) { p0_transpose_item(argp(I_GMWI), 1024, GM_FF, (bf16*)(F.ws + WS_WGI), 0, scr, r, lane); continue; } r -= I4;
            if (r < I5) { p0_transpose_item(argp(I_GMWO), 2048, 1024, (bf16*)(F.ws + WS_WGO), 0, scr, r, lane); continue; } r -= I5;
            if (r < I6) { p0_transpose_item(argp(I_WAWQ), 1024, WA_NQKV, (bf16*)(F.ws + WS_WWQ), 1, scr, r, lane); continue; } r -= I6;
            p0_transpose_item(argp(I_WAWO), 1024, 1024, (bf16*)(F.ws + WS_WWO), 0, scr, r, lane);
        }
        __syncthreads();
        for (int L = 0; L < (CONV_DEFER ? 1 : 4); ++L) conv_range(F, L, 0, CONV_PER_LAYER, F.vcu, F.G);
    }
}

__device__ __forceinline__ void stok_fill(Frame& F) { const int tid = otid(); unsigned* STOK = (unsigned*)(F.ws + WS_STOK);
    for (int i = F.bx * NTHR + tid; i < 32 * ECAP; i += F.G * NTHR) STOK[i] = (unsigned)(4 * T);
}
__device__ __forceinline__ void init_row(Frame& F, int m, int lane, const RowV& x, const RowV& sc, const RowV& sh) { RowV h;
#pragma unroll
    for (int j = 0; j < 4; ++j) h.v[j] = x.v[j] * (1.f + sc.v[j]) + sh.v[j];
    strow_bf16((bf16*)(F.ws + WS_H) + (size_t)m * DM, lane, h); }
__device__ __forceinline__ void pass_init(Frame& F) { const int tid = otid(), lane = tid & 63; (void)tid; (void)lane;
    stok_fill(F);
    const int gw = F.vcu * NWAVES + F.wave, NGW = F.G * NWAVES;
    RowV sh = ldrow(modp(F, 0, 0, 0), lane), sc = ldrow(modp(F, 0, 0, 1), lane);
    const float* xin = argp(I_X);
    for (int m = gw; m < NLAT; m += 4 * NGW) {
        RowV x[4];
#pragma unroll
        for (int q = 0; q < 4; ++q) { const int mq = m + q * NGW; x[q] = ldrow(xin + (size_t)(mq < NLAT ? mq : m) * DM, lane); }
#pragma unroll
        for (int q = 0; q < 4; ++q) { const int mq = m + q * NGW; if (mq < NLAT) init_row(F, mq, lane, x[q], sc, sh); }
    }
    { const int c0 = F.wave * F.G + F.vcu;
      if (c0 < NCTX) { sh = ldrow(modp(F, 0, 1, 0), lane); sc = ldrow(modp(F, 0, 1, 1), lane);
          for (int c = c0; c < NCTX; c += NGW) { const RowV x = ldrow(argp(I_CTX) + (size_t)c * DM, lane); init_row(F, NLAT + c, lane, x, sc, sh); } } }
}

struct RawRow { v2u w[4]; };
__device__ __forceinline__ RawRow ldraw_bf16(const bf16* p, int lane) { RawRow r; const v2u* q = (const v2u*)p + lane;
#pragma unroll
    for (int j = 0; j < 4; ++j) r.w[j] = q[64 * j]; return r; }
__device__ __forceinline__ RowV cvrow(const RawRow& r) { RowV o;
#pragma unroll
    for (int j = 0; j < 4; ++j) o.v[j] = (f32x4){bf_lo(r.w[j].x), bf_hi(r.w[j].x), bf_lo(r.w[j].y), bf_hi(r.w[j].y)}; return o; }
template <int L> __device__ __forceinline__ void pass_mix(Frame& F) { const int tid = otid(), lane = tid & 63; (void)tid; (void)lane;
    constexpr bool HAS_CTX = L < 3, MIX_ON = (EN_MIX >> L) & 1, MOE_ON = (EN_MOE >> L) & 1;
    constexpr int HP = 1032;
    LAS bf16* HT = (LAS bf16*)(F.lds);
    LAS float* PART = (LAS float*)(F.lds + 32 * HP * 2);
    LAS float* LOGT = PART + 8 * 32 * 33;
    volatile LAS unsigned* LC = F.MISC + MW_LC;
    const bf16* X = (const bf16*)(F.ws + WS_X); bf16* X2 = (bf16*)(F.ws + WS_X2); bf16* H = (bf16*)(F.ws + WS_H); const bf16* Y = (const bf16*)(F.ws + WS_Y);
    const float* xin = argp(I_X); const float* cin = argp(I_CTX);
    float* GATE = (float*)(F.ws + WS_GATE); unsigned* STOK = (unsigned*)(F.ws + WS_STOK);
    LAS unsigned* ASL = (LAS unsigned*)(F.lds + 32 * HP * 2 + 8 * 32 * 33 * 4 + 32 * 33 * 4);
    const bf16* RW = (const bf16*)(F.ws + WS_RW) + (size_t)L * 32 * 1024;
    if (CONV_DEFER) { const int donec = (int)F.MISC[MW_CONV];
        if (L >= 1) conv_range(F, L, donec, CONV_PER_LAYER, F.vcu, F.G); else __syncthreads();
        if (tid == 0) F.MISC[MW_CONV] = 0u; }
    if (tid < 32) LC[tid] = 0u;
    ASL[tid] = 0xFFFFFFFFu;
    __syncthreads();
    int ti = 0;
    const float* rbias = argp(I_RB);
    const int nlt = NLAT / 32, nct = HAS_CTX ? NCTX : 0;
    int cur_s = -1; RowV g1, lg, lb, sc2, sh2;
    for (int it = F.bx; it < nlt + nct; it += F.G) {
        const bool isl = it < nlt; const int s = isl ? 0 : 1; const int row0 = isl ? it * 32 : NLAT + (it - nlt); const int nrows = isl ? 32 : 1;
        if (s != cur_s) { cur_s = s; g1 = ldrow(modp(F, L, s, 2), lane); sh2 = ldrow(modp(F, L, s, 3), lane); sc2 = ldrow(modp(F, L, s, 4), lane);
            lg = ldrow(argp(I_LNMG) + L * DM, lane); lb = ldrow(argp(I_LNMB) + L * DM, lane); }
        const int nr = isl ? 4 : (F.wave == 0 ? 1 : 0);
        RowV xf[4]; RawRow xr[4], yr[4];
#pragma unroll
        for (int q_ = 0; q_ < 4; ++q_) if (q_ < nr) { const int m = row0 + F.wave * 4 + q_;
            if (L == 0) xf[q_] = ldrow(m < NLAT ? xin + (size_t)m * DM : cin + (size_t)(m - NLAT) * DM, lane);
            else xr[q_] = ldraw_bf16(X + (size_t)m * DM, lane);
            if (MIX_ON) yr[q_] = ldraw_bf16(Y + (size_t)m * DM, lane); }
#pragma unroll
        for (int q_ = 0; q_ < 4; ++q_) if (q_ < nr) { const int rr = F.wave * 4 + q_; const int m = row0 + rr;
            RowV x = (L == 0) ? xf[q_] : cvrow(xr[q_]);
            if (MIX_ON) { const RowV y = cvrow(yr[q_]);
#pragma unroll
                for (int j = 0; j < 4; ++j) x.v[j] = x.v[j] * DN_ALPHA + g1.v[j] * y.v[j]; }
            else {
#pragma unroll
                for (int j = 0; j < 4; ++j) x.v[j] = x.v[j] * DN_ALPHA; }
            x = ln_row(x, lg, lb);
            strow_bf16(X2 + (size_t)m * DM, lane, x);
            RowV h;
#pragma unroll
            for (int j = 0; j < 4; ++j) h.v[j] = x.v[j] * (1.f + sc2.v[j]) + sh2.v[j];
            { unsigned* q8 = (unsigned*)((unsigned char*)(F.ws + WS_H8) + (size_t)m * DM) + lane;
#pragma unroll
              for (int j = 0; j < 4; ++j) { int w = 0; w = __builtin_amdgcn_cvt_pk_fp8_f32(h.v[j].x, h.v[j].y, w, false); w = __builtin_amdgcn_cvt_pk_fp8_f32(h.v[j].z, h.v[j].w, w, true); q8[64 * j] = (unsigned)w; } }
            if (MOE_ON) { LAS unsigned long long* q = (LAS unsigned long long*)(HT + rr * HP) + lane;
#pragma unroll
                for (int j = 0; j < 4; ++j) q[64 * j] = (unsigned long long)pk2(h.v[j].x, h.v[j].y) | ((unsigned long long)pk2(h.v[j].z, h.v[j].w) << 32); }
        }
        if (MOE_ON) {
            __syncthreads();
            { const int r32 = lane & 31, hi = lane >> 5; f32x16 acc = f32x16{};
#pragma unroll
                for (int st = 0; st < 8; ++st) { const int k = 128 * F.wave + 16 * st + 8 * hi;
                    const bf16x8 a = *(const LAS bf16x8*)(HT + r32 * HP + k); const bf16x8 b = *(const bf16x8*)(RW + (size_t)r32 * 1024 + k);
                    acc = __builtin_amdgcn_mfma_f32_32x32x16_bf16(a, b, acc, 0, 0, 0); }
#pragma unroll
                for (int r = 0; r < 16; ++r) { const int tok = (r & 3) + 8 * (r >> 2) + 4 * hi; PART[(F.wave * 32 + tok) * 33 + r32] = acc[r]; } }
            __syncthreads();
            { const int t = tid >> 4, e0 = tid & 15;
#pragma unroll
                for (int q = 0; q < 2; ++q) { const int e = e0 + 16 * q; float v = rbias[L * 32 + e];
#pragma unroll
                    for (int wv = 0; wv < 8; ++wv) v += PART[(wv * 32 + t) * 33 + e];
                    LOGT[t * 33 + e] = v; } }
            __syncthreads();
            if (tid < nrows) { const int t = tid; float lv[32];
#pragma unroll
                for (int e = 0; e < 32; ++e) lv[e] = LOGT[t * 33 + e];
                int idx[4]; float val[4]; unsigned taken = 0u;
#pragma unroll
                for (int k = 0; k < 4; ++k) { float best = -INFINITY; int bi = 0;
#pragma unroll
                    for (int e = 0; e < 32; ++e) { const bool ok = !((taken >> e) & 1u) && lv[e] > best; best = ok ? lv[e] : best; bi = ok ? e : bi; }
                    idx[k] = bi; val[k] = best; taken |= 1u << bi; }
                float ev[4], sum = 0.f;
#pragma unroll
                for (int k = 0; k < 4; ++k) { ev[k] = __expf(val[k] - val[0]); sum += ev[k]; }
                const float inv = 1.f / sum; const int m = row0 + t;
#pragma unroll
                for (int k = 0; k < 4; ++k) { const unsigned pos = atomicAdd((unsigned*)&LC[idx[k]], 1u); const int li = (ti & 3) * 128 + t * 4 + k; ASL[li] = ((unsigned)idx[k] << 16) | pos; ASL[512 + li] = (unsigned)(m * 4 + k); GATE[(size_t)m * 4 + k] = ev[k] * inv; } }
            __syncthreads();
        }
        ++ti;
    }
    if (MOE_ON) {
        __syncthreads();
        if (tid < 32) { const unsigned c = LC[tid]; unsigned st = 0u;
            if (c) st = __hip_atomic_fetch_add((unsigned*)(F.ctl + CW_GCNT + (L * 32 + tid) * 64), c, __ATOMIC_RELAXED, __HIP_MEMORY_SCOPE_AGENT);
            F.MISC[MW_TOT + tid] = st; }
        __syncthreads();
        { const unsigned ep = ASL[tid]; if (ep != 0xFFFFFFFFu) { const unsigned e = ep >> 16, pos = ep & 0xffffu; STOK[(size_t)e * ECAP + F.MISC[MW_TOT + e] + pos] = ASL[512 + tid]; } }
    }
}

template <int L> __device__ __forceinline__ void moe_tables(Frame& F) { const int tid = otid();
    if (tid < 64) {
        const int e = tid & 31;
        const unsigned cnt = tid < 32 ? __hip_atomic_load((unsigned*)(F.ctl + CW_GCNT + (L * 32 + e) * 64), RLX_AGENT) : 0u;
        const unsigned tiles = (cnt + 255u) >> 8; unsigned incl = tiles;
#pragma unroll
        for (int o = 1; o < 32; o <<= 1) { const unsigned v = (unsigned)__shfl_up((int)incl, o); if (tid >= o) incl += v; }
        const unsigned base = incl - tiles;
        if (tid < 32) for (unsigned q = 0; q < tiles; ++q) F.MISC[MW_MTE + base + q] = (unsigned)(ECAPT * e) + q;
        if (tid == 31) F.MISC[MW_NMT] = incl; }
    __syncthreads();
}
struct CombIn { RawRow x, y[4]; f32x4 gt; };
template <int L> __device__ __forceinline__ CombIn comb_load(Frame& F, int m, int lane) { CombIn I; constexpr bool MOE_ON = (EN_MOE >> L) & 1;
    const bf16* X2 = (const bf16*)(F.ws + WS_X2); const bf16* YS = (const bf16*)(F.ws + WS_YS); const float* GATE = (const float*)(F.ws + WS_GATE);
    I.x = ldraw_bf16(X2 + (size_t)m * DM, lane);
    if (MOE_ON) { I.gt = *(const f32x4*)(GATE + (size_t)m * 4);
#pragma unroll
        for (int k = 0; k < 4; ++k) I.y[k] = ldraw_bf16(YS + ((size_t)m * 4 + k) * DM, lane); }
    return I; }
template <int L> __device__ __forceinline__ void comb_row(Frame& F, int m, int lane, const CombIn& I, const RowV& g2, const RowV& lg, const RowV& lb, const RowV& sc, const RowV& sh) {
    constexpr bool MOE_ON = (EN_MOE >> L) & 1;
    bf16* X = (bf16*)(F.ws + WS_X); bf16* H = (bf16*)(F.ws + WS_H);
    RowV x = cvrow(I.x);
    if (MOE_ON) { RowV f;
#pragma unroll
        for (int j = 0; j < 4; ++j) f.v[j] = (f32x4){0.f, 0.f, 0.f, 0.f};
#pragma unroll
        for (int k = 0; k < 4; ++k) { const RowV y = cvrow(I.y[k]);
#pragma unroll
            for (int j = 0; j < 4; ++j) f.v[j] += y.v[j] * I.gt[k]; }
#pragma unroll
        for (int j = 0; j < 4; ++j) x.v[j] = x.v[j] * DN_ALPHA + g2.v[j] * f.v[j];
    } else {
#pragma unroll
        for (int j = 0; j < 4; ++j) x.v[j] = x.v[j] * DN_ALPHA; }
    x = ln_row(x, lg, lb);
    if (L < 3) { strow_bf16(X + (size_t)m * DM, lane, x); RowV h;
#pragma unroll
        for (int j = 0; j < 4; ++j) h.v[j] = x.v[j] * (1.f + sc.v[j]) + sh.v[j];
        strow_bf16(H + (size_t)m * DM, lane, h); }
    else strow(((float*)argp(N_IN)) + (size_t)m * DM, lane, x);
}
template <int L> __device__ __forceinline__ void pass_comb(Frame& F) { const int tid = otid(), lane = tid & 63; (void)tid; (void)lane;
    constexpr bool HAS_CTX = L < 3;
    if (L < 3) stok_fill(F);
    const int gw = F.vcu * NWAVES + F.wave, NGW = F.G * NWAVES;
    RowV g2, lg, lb, sc, sh;
    g2 = ldrow(modp(F, L, 0, 5), lane); lg = ldrow(argp(I_LNFG) + L * DM, lane); lb = ldrow(argp(I_LNFB) + L * DM, lane);
    if (L < 3) { sh = ldrow(modp(F, L < 3 ? L + 1 : 0, 0, 0), lane); sc = ldrow(modp(F, L < 3 ? L + 1 : 0, 0, 1), lane); }
    for (int m = gw; m < NLAT; m += 2 * NGW) {
        const int m1 = m + NGW; const bool two = m1 < NLAT;
        const CombIn A = comb_load<L>(F, m, lane); const CombIn B = comb_load<L>(F, two ? m1 : m, lane);
        comb_row<L>(F, m, lane, A, g2, lg, lb, sc, sh);
        if (two) comb_row<L>(F, m1, lane, B, g2, lg, lb, sc, sh);
    }
    if (HAS_CTX) {
        const int c0 = F.wave * F.G + F.vcu;
        if (c0 < NCTX) { g2 = ldrow(modp(F, L, 1, 5), lane); sh = ldrow(modp(F, L < 3 ? L + 1 : 0, 1, 0), lane); sc = ldrow(modp(F, L < 3 ? L + 1 : 0, 1, 1), lane);
            for (int c = c0; c < NCTX; c += NGW) { const CombIn A = comb_load<L>(F, NLAT + c, lane); comb_row<L>(F, NLAT + c, lane, A, g2, lg, lb, sc, sh); } }
    }
}
__device__ __forceinline__ void gate_unit(Frame& F, int t0, int h0, int nh, bool use_pstat) { const int tid = otid(), lane = tid & 63;
    constexpr int WP = 136, VP = 136, OP = 264;
    LAS bf16* WL = (LAS bf16*)(F.lds);
    LAS bf16* VT = (LAS bf16*)(F.lds + 128 * WP * 2);
    LAS bf16* OUT = (LAS bf16*)(F.lds);
    LAS float* STAT = (LAS float*)(F.lds + 128 * WP * 2 + 256 * VP * 2);
    static_assert(128 * OP * 2 <= 128 * WP * 2 + 256 * VP * 2, "OUT overlay");
    const bf16* GU = (const bf16*)(F.ws + WS_GU); const bf16* GV = (const bf16*)(F.ws + WS_GV); bf16* GG = (bf16*)(F.ws + WS_GG);
    const float* ws_ = argp(I_GMWS); const float* bs_ = argp(I_GMBS); const float* vg = argp(I_GMVG); const float* vb = argp(I_GMVB);
    const int r32 = lane & 31, hi = lane >> 5;
    if (use_pstat) {
        const int row = tid >> 2, part = tid & 3; const f32x2* ps = (const f32x2*)((const float*)(F.ws + WS_PSTAT) + ((size_t)(t0 + row) * 32 + 8 * part) * 2); float s = 0.f, s2 = 0.f;
#pragma unroll
        for (int i = 0; i < 8; ++i) { const f32x2 v = ps[i]; s += v.x; s2 += v.y; }
        s += __shfl_xor(s, 1); s += __shfl_xor(s, 2); s2 += __shfl_xor(s2, 1); s2 += __shfl_xor(s2, 2);
        if (part == 0) { const float mean = s * (1.f / GM_HALF); const float var = fmaxf(s2 * (1.f / GM_HALF) - mean * mean, 0.f); STAT[2 * row] = mean; STAT[2 * row + 1] = 1.f / sqrtf(var + LN_EPS); }
    } else {
#ifdef GATE_DUP_STATS
    for (int dup_ = 0; dup_ < 2; ++dup_)
#endif
    for (int bt = 0; bt < 2; ++bt) { v4u raw[8][4]; float s[8], s2[8];
#pragma unroll
        for (int i = 0; i < 8; ++i) { const int q = 16 * F.wave + 8 * bt + i; const v4u* src = (const v4u*)(GV + (size_t)(t0 + q) * GM_HALF) + lane;
#pragma unroll
            for (int j = 0; j < 4; ++j) raw[i][j] = src[64 * j]; }
#pragma unroll
        for (int i = 0; i < 8; ++i) { float a = 0.f, b = 0.f;
#pragma unroll
            for (int j = 0; j < 4; ++j)
#pragma unroll
                for (int e = 0; e < 4; ++e) { const float x0 = bf_lo(raw[i][j][e]), x1 = bf_hi(raw[i][j][e]); a += x0 + x1; b += x0 * x0 + x1 * x1; }
            s[i] = a; s2[i] = b; }
#pragma unroll
        for (int o = 1; o < 64; o <<= 1) {
#pragma unroll
            for (int i = 0; i < 8; ++i) { s[i] += __shfl_xor(s[i], o); s2[i] += __shfl_xor(s2[i], o); } }
        if (lane == 0) {
#pragma unroll
            for (int i = 0; i < 8; ++i) { const int q = 16 * F.wave + 8 * bt + i; const float mean = s[i] * (1.f / GM_HALF); const float var = fmaxf(s2[i] * (1.f / GM_HALF) - mean * mean, 0.f);
                STAT[2 * q] = mean; STAT[2 * q + 1] = 1.f / sqrtf(var + LN_EPS); } } }
    }
    __syncthreads();
    const int wp = tid >> 2, wq0 = (tid & 3) * 32;
    const int vck = tid & 31, vqb0 = tid >> 5;
    const int ck = tid & 31;
    f32x4 wr[8]; v4u wv[8];
    { const f32x4* src = (const f32x4*)(ws_ + ((size_t)h0 * 128 + wp) * 128 + wq0);
#pragma unroll
      for (int i = 0; i < 8; ++i) wr[i] = src[i];
#pragma unroll
      for (int j = 0; j < 8; ++j) wv[j] = *(const v4u*)(GV + (size_t)(t0 + 4 * (vqb0 + 16 * (j >> 2)) + (j & 3)) * GM_HALF + h0 * 256 + 8 * vck); }
    for (int hh = 0; hh < nh; ++hh) { const int h = h0 + hh;
#pragma unroll
        for (int i = 0; i < 4; ++i) { const f32x4 a = wr[2 * i], b = wr[2 * i + 1]; v4u w; w.x = pk2(a[0], a[1]); w.y = pk2(a[2], a[3]); w.z = pk2(b[0], b[1]); w.w = pk2(b[2], b[3]);
            *(LAS v4u*)(WL + wp * WP + wq0 + 8 * i) = w; }
        { const f32x4 g0 = *(const f32x4*)(vg + h * 256 + 8 * vck), g1 = *(const f32x4*)(vg + h * 256 + 8 * vck + 4), b0 = *(const f32x4*)(vb + h * 256 + 8 * vck), b1 = *(const f32x4*)(vb + h * 256 + 8 * vck + 4);
#pragma unroll
            for (int bk = 0; bk < 2; ++bk) { const int q0 = 4 * (vqb0 + 16 * bk); float x[4][8];
#pragma unroll
                for (int r = 0; r < 4; ++r) { const v4u w = wv[4 * bk + r]; const float mean = STAT[2 * (q0 + r)], rstd = STAT[2 * (q0 + r) + 1];
#pragma unroll
                    for (int i = 0; i < 4; ++i) { x[r][2 * i] = (bf_lo(w[i]) - mean) * rstd; x[r][2 * i + 1] = (bf_hi(w[i]) - mean) * rstd; } }
#pragma unroll
                for (int i = 0; i < 8; ++i) { const float gg = i < 4 ? g0[i & 3] : g1[i & 3], bb = i < 4 ? b0[i & 3] : b1[i & 3];
                    v2u w; w.x = pk2(x[0][i] * gg + bb, x[1][i] * gg + bb); w.y = pk2(x[2][i] * gg + bb, x[3][i] * gg + bb);
                    *(LAS v2u*)(VT + (8 * vck + i) * VP + q0) = w; } } }
        if (hh + 1 < nh) { const f32x4* src = (const f32x4*)(ws_ + ((size_t)(h + 1) * 128 + wp) * 128 + wq0);
#pragma unroll
            for (int i = 0; i < 8; ++i) wr[i] = src[i];
#pragma unroll
            for (int j = 0; j < 8; ++j) wv[j] = *(const v4u*)(GV + (size_t)(t0 + 4 * (vqb0 + 16 * (j >> 2)) + (j & 3)) * GM_HALF + (h + 1) * 256 + 8 * vck); }
        v4u uo[8];
#pragma unroll
        for (int j = 0; j < 8; ++j) { const int p = (tid >> 5) + 16 * j; uo[j] = *(const v4u*)(GU + (size_t)(t0 + p) * GM_HALF + h * 256 + 8 * ck); }
        __syncthreads();
        const int wm = F.wave >> 2, wn = F.wave & 3; f32x16 acc[2][2];
#pragma unroll
        for (int i = 0; i < 2; ++i)
#pragma unroll
            for (int jn = 0; jn < 2; ++jn) acc[i][jn] = f32x16{};
#pragma unroll
        for (int ks = 0; ks < 8; ++ks) { bf16x8 a[2], b[2];
#pragma unroll
            for (int i = 0; i < 2; ++i) { a[i] = *(const LAS bf16x8*)(VT + (64 * wn + 32 * i + r32) * VP + 16 * ks + 8 * hi); b[i] = *(const LAS bf16x8*)(WL + (64 * wm + 32 * i + r32) * WP + 16 * ks + 8 * hi); }
#pragma unroll
            for (int i = 0; i < 2; ++i)
#pragma unroll
                for (int jn = 0; jn < 2; ++jn) acc[i][jn] = __builtin_amdgcn_mfma_f32_32x32x16_bf16(a[i], b[jn], acc[i][jn], 0, 0, 0); }
        __syncthreads();
#pragma unroll
        for (int jn = 0; jn < 2; ++jn) { const int p = 64 * wm + 32 * jn + r32; const float bias = bs_[h * 128 + p];
#pragma unroll
            for (int i = 0; i < 2; ++i)
#pragma unroll
                for (int rg = 0; rg < 4; ++rg) { const int c = 64 * wn + 32 * i + 8 * rg + 4 * hi;
                    v2u w; w.x = pk2(acc[i][jn][4 * rg] + bias, acc[i][jn][4 * rg + 1] + bias); w.y = pk2(acc[i][jn][4 * rg + 2] + bias, acc[i][jn][4 * rg + 3] + bias);
                    *(LAS v2u*)(OUT + p * OP + c) = w; } }
        __syncthreads();
#ifdef GATE_DUP_EPI
        for (int dup_ = 0; dup_ < 2; ++dup_) {
#endif
#pragma unroll
        for (int j = 0; j < 8; ++j) { const int p = (tid >> 5) + 16 * j; const size_t off = (size_t)(t0 + p) * GM_HALF + h * 256 + 8 * ck;
            const v4u oo = *(const LAS v4u*)(OUT + p * OP + 8 * ck); v4u g;
#pragma unroll
            for (int e = 0; e < 4; ++e) g[e] = pk2(bf_lo(uo[j][e]) * bf_lo(oo[e]), bf_hi(uo[j][e]) * bf_hi(oo[e]));
            *(v4u*)(GG + off) = g; }
#ifdef GATE_DUP_EPI
        }
#endif
        __syncthreads();
    }
}
__device__ __forceinline__ void gate_phase(Frame& F) {
    for (int uid = F.bx; uid < 2 * (NLAT / 128); uid += F.G) gate_unit(F, (uid >> 1) * 128, 4 * (uid & 1), 4, true);
    if ((F.bx & 15) == 0 && (F.bx >> 4) < 16) { const int su = F.bx >> 4; gate_unit(F, NLAT + (su >> 3) * 128, su & 7, 1, true); }
}

template <int MODE> __device__ __forceinline__ void attn_phase(Frame& F, char* lds_generic) {
    using abf = attn_body::bf16;
    const abf* Q = (const abf*)(F.ws + WS_Q); const abf* K = (const abf*)(F.ws + WS_K); const abf* V = (const abf*)(F.ws + WS_V); abf* O = (abf*)(F.ws + WS_O);
    constexpr int U = 1024; const int per = (U + F.G - 1) / F.G;
    float mstat = 0.f;
    if (MODE == 0) { const float* gq = argp(I_FAQN); const float* gk = argp(I_FAKN); float mq = 0.f, mk = 0.f;
        for (int d = 0; d < 64; ++d) { mq = fmaxf(mq, fabsf(gq[d])); mk = fmaxf(mk, fabsf(gk[d])); }
        mstat = fminf(64.f * QSCALE * mq * mk, 100.f); }
    for (int i = 0; i <= per; ++i) {
        int h, kvh, q0, NT, kbase; float sink = 0.f;
        if (i < per) { const int id = F.vcu * per + i; if (id >= U) continue; const int x = id >> 7, r = id & 127; const int qb = (r >> 2) * 2 + (r & 1);
            q0 = 256 * qb;
            if (MODE == 0) { kvh = x >> 1; h = kvh * 4 + (x & 1) * 2 + ((r & 3) >> 1); NT = T / 64; kbase = 0; }
            else { h = 2 * x + ((r & 3) >> 1); kvh = h >> 3; const int ks = q0 >= 128 ? q0 - 128 : 0, ke = (q0 + 384) < NLAT ? (q0 + 384) : NLAT; kbase = ks; NT = 4 + (ke - ks) / 64; sink = argp(I_WASK)[h] * LOG2E; } }
        else { if (MODE != 0) continue; if ((F.vcu & 15) != 0 || (F.vcu >> 4) >= 16) continue; h = F.vcu >> 4; kvh = h >> 2; q0 = NLAT; NT = 4; kbase = NLAT; }
        if constexpr (MODE == 0) attn_body::attn_unit_q8<256>(h, kvh, q0, NT, kbase, mstat, (const unsigned char*)(F.ws + WS_Q8), (const unsigned char*)(F.ws + WS_K8), V, O, lds_generic);
        else attn_body::attn_unit<1, 128, 8>(h, kvh, q0, NT, kbase, sink, Q, K, V, O, lds_generic);
    }
}
struct CtxEpiY { bf16* Y; const float* bias;
    __device__ __forceinline__ void operator()(int row, int col, float (&v)[4]) const { const f32x4 b = *(const f32x4*)(bias + col);
        v2u w; w.x = pk2(v[0] + b[0], v[1] + b[1]); w.y = pk2(v[2] + b[2], v[3] + b[3]); *(v2u*)(Y + (size_t)row * DM + col) = w; } };
struct CtxEpiGelu { bf16* U; bf16* V; const float* bias; float* pstat;
    __device__ __forceinline__ void operator()(int row, int col, float (&v)[4]) const { const f32x4 b = *(const f32x4*)(bias + col);
        const pg8::f32x2 a = pg8::gelu_pk((pg8::f32x2){v[0] + b[0], v[1] + b[1]}), c = pg8::gelu_pk((pg8::f32x2){v[2] + b[2], v[3] + b[3]});
        v2u w; w.x = pk2(a.x, a.y); w.y = pk2(c.x, c.y); bf16* dst = col < GM_HALF ? U + (size_t)row * GM_HALF + col : V + (size_t)row * GM_HALF + (col - GM_HALF); *(v2u*)dst = w;
        if (col >= GM_HALF) { float s = (a.x + a.y) + (c.x + c.y), s2 = (a.x * a.x + a.y * a.y) + (c.x * c.x + c.y * c.y);
            s += __shfl_xor(s, 1); s += __shfl_xor(s, 2); s += __shfl_xor(s, 4); s += __shfl_xor(s, 8); s2 += __shfl_xor(s2, 1); s2 += __shfl_xor(s2, 2); s2 += __shfl_xor(s2, 4); s2 += __shfl_xor(s2, 8);
            if ((col & 63) == 0) *(f32x2*)(pstat + ((size_t)row * 32 + ((col - GM_HALF) >> 6)) * 2) = (f32x2){s, s2}; } } };
template <int NKV, bool RMS> struct CtxEpiQKV { bf16* Q; const float* bias; const float* qn; const float* kn;
    __device__ __forceinline__ void operator()(int row, int col, float (&v)[4]) const {
        const int hh = col >> 6, d = col & 63; const int kind = hh < 16 ? 0 : (hh < 16 + NKV ? 1 : 2);
        const f32x4 b = *(const f32x4*)(bias + col);
#pragma unroll
        for (int i = 0; i < 4; ++i) v[i] += b[i];
        if (RMS) { float ss = (v[0] * v[0] + v[1] * v[1]) + (v[2] * v[2] + v[3] * v[3]);
            ss += __shfl_xor(ss, 1); ss += __shfl_xor(ss, 2); ss += __shfl_xor(ss, 4); ss += __shfl_xor(ss, 8);
            const float rs = 1.f / sqrtf(ss * (1.f / 64.f) + RMS_EPS); const f32x4 gq = *(const f32x4*)(qn + d), gk = *(const f32x4*)(kn + d);
            if (kind < 2) {
#pragma unroll
                for (int i = 0; i < 4; ++i) v[i] = v[i] * rs * (kind == 0 ? gq[i] : gk[i]); } }
        if (kind == 0) {
#pragma unroll
            for (int i = 0; i < 4; ++i) v[i] *= QSCALE; }
        const int pitch = kind == 0 ? DM : NKV * 64, hd = kind == 0 ? hh : (kind == 1 ? hh - 16 : hh - 16 - NKV);
        const size_t doff = kind == 0 ? (size_t)0 : (kind == 1 ? (size_t)(WS_K - WS_Q) : (size_t)(WS_V - WS_Q));
        if (RMS && kind < 2) { *(unsigned*)((char*)Q + (kind == 0 ? (size_t)(WS_Q8 - WS_Q) : (size_t)(WS_K8 - WS_Q)) + (size_t)row * pitch + hd * 64 + d) = pk4f8(v[0], v[1], v[2], v[3]); return; }
        v2u w; w.x = pk2(v[0], v[1]); w.y = pk2(v[2], v[3]); *(v2u*)((bf16*)((char*)Q + doff) + (size_t)row * pitch + hd * 64 + d) = w; } };
template <class Epi> __device__ __forceinline__ void ctx_gemm(Frame& F, const bf16* A, const bf16* Bt, int N, int K, int rowmode, const Epi& E) {
    const int tid = otid(), lane = tid & 63, r32 = lane & 31, hi = lane >> 5;
    LAS float* PART = (LAS float*)(F.lds);
    const int nblk = 8 * (N / 64), kw = K / 8;
    for (int b = F.bx; b < nblk; b += F.G) { const int rb = b & 7, cb = b >> 3;
        const bf16* ap = A + (size_t)(NLAT + rb * 32 + r32) * K + F.wave * kw + 8 * hi;
        const int n0 = cb * 64 + r32, n1 = n0 + 32;
        const bf16* bp0 = Bt + (size_t)(rowmode ? qkv_rowmap(n0) : n0) * K + F.wave * kw + 8 * hi;
        const bf16* bp1 = Bt + (size_t)(rowmode ? qkv_rowmap(n1) : n1) * K + F.wave * kw + 8 * hi;
        f32x16 acc0 = f32x16{}, acc1 = f32x16{};
        for (int k = 0; k < kw; k += 128) { bf16x8 a[8], b0[8], b1[8];
#pragma unroll
            for (int i = 0; i < 8; ++i) { a[i] = *(const bf16x8*)(ap + k + 16 * i); b0[i] = *(const bf16x8*)(bp0 + k + 16 * i); b1[i] = *(const bf16x8*)(bp1 + k + 16 * i); }
#pragma unroll
            for (int i = 0; i < 8; ++i) { acc0 = __builtin_amdgcn_mfma_f32_32x32x16_bf16(a[i], b0[i], acc0, 0, 0, 0); acc1 = __builtin_amdgcn_mfma_f32_32x32x16_bf16(a[i], b1[i], acc1, 0, 0, 0); } }
#pragma unroll
        for (int r = 0; r < 16; ++r) { const int rw = (r & 3) + 8 * (r >> 2) + 4 * hi; PART[(F.wave * 32 + rw) * 66 + r32] = acc0[r]; PART[(F.wave * 32 + rw) * 66 + 32 + r32] = acc1[r]; }
        __syncthreads();
        { const int row = tid >> 4, c4 = (tid & 15) * 4; float v[4] = {0.f, 0.f, 0.f, 0.f};
#pragma unroll
            for (int w = 0; w < 8; ++w) { const LAS float* p = PART + (w * 32 + row) * 66 + c4; v[0] += p[0]; v[1] += p[1]; v[2] += p[2]; v[3] += p[3]; }
            E(NLAT + rb * 32 + row, cb * 64 + c4, v); }
        __syncthreads();
    }
}
struct Args { const float* in[N_IN]; float* out; unsigned char* ws; int ph_lo, ph_hi; };
static_assert(sizeof(Args) == N_IN * 8 + 8 + 8 + 8, "Args has no padding");

#ifndef MOE_WGM_UP
#define MOE_WGM_UP 4
#endif
#ifndef MOE_WGM_DN
#define MOE_WGM_DN 4
#endif
template <int ACT> __device__ __forceinline__ void tok_gemm(Frame& F, const bf16* A, const bf16* Bt, int N, int K, const pg8::EpiBf16<ACT>& E) {
    pg8::Gemm g{A, Bt, K, K, K, (unsigned)(128 * K * 2), (unsigned)(128 * K * 2)};
    TokOrder S; S.init(NLAT / 256, N / 256, F.G, F.bx); S.apan = (size_t)256 * K * 2; S.bpan = (size_t)256 * K * 2;
    pg8::gemm_phase<pg8::EpiBf16<ACT>, TokOrder, true, true>(F.lds + RING_OFF, g, S, E);
}
template <int L> __device__ __forceinline__ void moe_up(Frame& F) {
    moe_tables<L>(F);
    pg8::Gemm g{(const bf16*)(F.ws + WS_H8), (const bf16*)(F.ws + WS_WEXP_GU + (size_t)L * 32 * 2048 * 1024), 512, 512, 512, 128 * 512 * 2, 128 * 512 * 2};
    MoeOrderG S; S.init((int)F.MISC[MW_NMT], 8, F.G, F.bx, MOE_WGM_UP); S.mte = F.MISC + MW_MTE; S.bexp = (size_t)2048 * 1024; S.bpan = (size_t)256 * 1024; S.stok = (const unsigned*)(F.ws + WS_STOK); S.rowbytes = 1024u;
    EpiSwiGLU E{(unsigned char*)(F.ws + WS_ACT), argp(I_EBGU) + (size_t)L * 32 * 2048};
    pg8::gemm_phase<EpiSwiGLU, MoeOrderG, true, true, true, true>(F.lds + RING_OFF, g, S, E);
    if (CONV_DEFER && L < 3) {
        conv_tail(F, L + 1, ((int)F.MISC[MW_NMT] * 8) % F.G, CONV_UP_PER); }
}
template <int L> __device__ __forceinline__ void moe_down(Frame& F) {
    if (MK_PER_PHASE) moe_tables<L>(F);
    pg8::Gemm g{(const bf16*)(F.ws + WS_ACT), (const bf16*)(F.ws + WS_WEXP_DN + (size_t)L * 32 * 1024 * 1024), 512, 512, 512, 128 * 512 * 2, 128 * 512 * 2};
    MoeOrder S; S.init((int)F.MISC[MW_NMT], 4, F.G, F.bx, MOE_WGM_DN); S.mte = F.MISC + MW_MTE; S.bexp = (size_t)1024 * 1024; S.apan = (size_t)256 * 1024; S.bpan = (size_t)256 * 1024;
    EpiDown E{(bf16*)(F.ws + WS_YS), argp(I_EBD) + (size_t)L * 32 * 1024, (const unsigned*)(F.ws + WS_STOK)};
    pg8::gemm_phase<EpiDown, MoeOrder, true, true, false, true>(F.lds + RING_OFF, g, S, E);
    if (CONV_DEFER && L < 3) {
        conv_tail(F, L + 1, ((int)F.MISC[MW_NMT] * 4) % F.G, CONV_DN_PER); }
}

__global__ void __launch_bounds__(NTHR, 2) mk_fwd(Args args) {
    extern __shared__ __attribute__((aligned(16))) unsigned char lds[];
    Frame F;
    F.lds = (LAS unsigned char*)lds;
    F.MISC = (volatile LAS unsigned*)(F.lds + MISC_OFF);
    F.wave = __builtin_amdgcn_readfirstlane((int)threadIdx.x >> 6);
    F.G = gridDim.x; F.bx = blockIdx.x; F.vcu = (F.G % 8 == 0) ? (F.bx % 8) * (F.G / 8) + F.bx / 8 : F.bx;
    F.ws = args.ws; F.ctl = (gu32*)(args.ws + WS_CTL);
    for (int u = threadIdx.x; u < (LDS_BYTES - MISC_OFF) / 4; u += NTHR) ((LAS unsigned*)(F.lds + MISC_OFF))[u] = 0u;
    __syncthreads();
    XcdBarrier bar; bar.bar = (unsigned*)(F.ctl + CW_BAR); bar.x = 0; bar.st = nullptr;
    if (!MK_PER_PHASE) bar = xcd_barrier_post((unsigned*)(F.ctl + CW_BAR), F.MISC + MW_BAR);
    const int lo = args.ph_lo, hi = args.ph_hi;
#ifdef MK_ONLY
#define IN(k) ((k) == MK_ONLY && lo <= (k))
#else
#define IN(k) (lo <= (k) && (k) < hi)
#endif
#define SEAM(k) do { if (IN(k) && IN((k) + 1)) xcd_barrier(bar); } while (0)
#ifdef MK_REP_MASK
#define REP(k) (((MK_REP_MASK >> (k)) & 1ull) ? 2 : 1)
#else
#define REP(k) 1
#endif
#ifdef MK_PROBE_MASK
#define STAMP(k) do { if (threadIdx.x == 0) { const unsigned long long t_ = __builtin_amdgcn_s_memrealtime(); F.MISC[512 + 2 * (k)] = (unsigned)t_; F.MISC[513 + 2 * (k)] = (unsigned)(t_ >> 32); } } while (0)
#else
#define STAMP(k) do {} while (0)
#endif
    const bf16* Hb = (const bf16*)(F.ws + WS_H); bf16* Yb = (bf16*)(F.ws + WS_Y);

    STAMP(0); if (IN(0)) for (int rep_ = 0; rep_ < REP(0); ++rep_) { if (rep_) xcd_barrier(bar); asm volatile("; MK_PHASE_0" ::: "memory"); asm volatile("s_nop 13\n\t.fill 0, 4, 0xBF800000" ::: "memory"); p0_prologue(F); } SEAM(0);
    STAMP(1); if (IN(1)) for (int rep_ = 0; rep_ < REP(1); ++rep_) { if (rep_) xcd_barrier(bar); asm volatile("; MK_PHASE_1" ::: "memory"); asm volatile("s_nop 13\n\t.fill 0, 4, 0xBF800000" ::: "memory"); pass_init(F); } SEAM(1);
    STAMP(2); if (IN(2)) for (int rep_ = 0; rep_ < REP(2); ++rep_) { if (rep_) xcd_barrier(bar); asm volatile("; MK_PHASE_2" ::: "memory"); asm volatile("s_nop 13\n\t.fill 196, 4, 0xBF800000" ::: "memory"); if ((EN_MIX >> 0) & 1) {
        { pg8::Gemm g{(const bf16*)(F.ws + TB_FC), Hb, 256, 256, 128 * DM, 128 * 256 * 2, DM * 2};
          ChDftOrder S; S.init(2, 256, F.G, F.bx); EpiChDft E{(bf16*)(F.ws + WS_BTA)};
          pg8::gemm_phase<EpiChDft, ChDftOrder, true, true>(F.lds + RING_OFF, g, S, E); }
#ifndef NO_CTX_DFT
        { pg8::Gemm g{(const bf16*)(F.ws + TB_FC), Hb, 256, 256, DM, 128 * 256 * 2, 128 * DM * 2};
          ChDftCtxOrder S; S.init(2, 4, F.G, F.bx); EpiChDftCtx E{(bf16*)(F.ws + WS_BTX)};
          pg8::gemm_phase<EpiChDftCtx, ChDftCtxOrder, true, true>(F.lds + RING_OFF, g, S, E); }
#endif
        } } SEAM(2);
    STAMP(3); if (IN(3)) for (int rep_ = 0; rep_ < REP(3); ++rep_) { if (rep_) xcd_barrier(bar); asm volatile("; MK_PHASE_3" ::: "memory"); asm volatile("s_nop 13\n\t.fill 165, 4, 0xBF800000" ::: "memory"); if ((EN_MIX >> 0) & 1) {
        { pg8::Gemm g{(const bf16*)(F.ws + TB_FA), (const bf16*)(F.ws + WS_BTA), 256, 256, 256, 128 * 256 * 2, 128 * 256 * 2};
          TokOrder S; S.init(1, 512, F.G, F.bx); S.apan = 0; S.bpan = (size_t)256 * 256 * 2;
          EpiStepA E{(bf16*)(F.ws + WS_BTC), (const float*)(F.ws + TB_TWC), (const float*)(F.ws + TB_TWS)};
          pg8::gemm_phase<EpiStepA, TokOrder, true, true>(F.lds + RING_OFF, g, S, E); }
        } } SEAM(3);
    STAMP(4); if (IN(4)) for (int rep_ = 0; rep_ < REP(4); ++rep_) { if (rep_) xcd_barrier(bar); asm volatile("; MK_PHASE_4" ::: "memory"); asm volatile("s_nop 13\n\t.fill 564, 4, 0xBF800000" ::: "memory"); if ((EN_MIX >> 0) & 1) {
        { pg8::Gemm g{(const bf16*)(F.ws + TB_FCC), (const bf16*)(F.ws + WS_BTC), 256, 256, 256, 128 * 256 * 2, 128 * 256 * 2};
        TokOrder S; S.init(1, 512, F.G, F.bx); S.apan = 0; S.bpan = (size_t)256 * 256 * 2;
        EpiStepC E{(bf16*)(F.ws + WS_MIXB)};
        pg8::gemm_phase<EpiStepC, TokOrder, true, true>(F.lds + RING_OFF, g, S, E); }
#ifndef NO_CTX_DFT
        { pg8::Gemm g{(const bf16*)(F.ws + TB_FX), (const bf16*)(F.ws + WS_BTX), 512, 512, 512, 128 * 512 * 2, 128 * 512 * 2};
          TokOrder S; S.init(1, 4, F.G, F.bx); S.apan = 0; S.bpan = (size_t)256 * 512 * 2;
          EpiCtxPos E{(bf16*)(F.ws + WS_MIXB)};
          pg8::gemm_phase<EpiCtxPos, TokOrder, true, true>(F.lds + RING_OFF, g, S, E); }
#endif
        } } SEAM(4);
    STAMP(5); if (IN(5)) for (int rep_ = 0; rep_ < REP(5); ++rep_) { if (rep_) xcd_barrier(bar); asm volatile("; MK_PHASE_5" ::: "memory"); asm volatile("s_nop 13\n\t.fill 0, 4, 0xBF800000" ::: "memory"); if ((EN_MIX >> 0) & 1) { pg8::EpiBf16<0> E{Yb, DM, argp(I_FNB), 0, 0, 1.f}; tok_gemm<0>(F, (const bf16*)(F.ws + WS_MIXB), (const bf16*)(F.ws + WS_WFN), DM, DM, E);
        ctx_gemm(F, (const bf16*)(F.ws + WS_MIXB), (const bf16*)(F.ws + WS_WFN), DM, DM, 0, CtxEpiY{Yb, argp(I_FNB)}); } } SEAM(5);
    STAMP(6); if (IN(6)) for (int rep_ = 0; rep_ < REP(6); ++rep_) { if (rep_) xcd_barrier(bar); asm volatile("; MK_PHASE_6" ::: "memory"); asm volatile("s_nop 13\n\t.fill 0, 4, 0xBF800000" ::: "memory"); pass_mix<0>(F); } SEAM(6);
    STAMP(7); if (IN(7)) for (int rep_ = 0; rep_ < REP(7); ++rep_) { if (rep_) xcd_barrier(bar); asm volatile("; MK_PHASE_7" ::: "memory"); asm volatile("s_nop 13\n\t.fill 0, 4, 0xBF800000" ::: "memory"); }
    STAMP(8); if (IN(8)) for (int rep_ = 0; rep_ < REP(8); ++rep_) { if (rep_) xcd_barrier(bar); asm volatile("; MK_PHASE_8" ::: "memory"); asm volatile("s_nop 13\n\t.fill 520, 4, 0xBF800000" ::: "memory"); if ((EN_MOE >> 0) & 1) moe_up<0>(F); } SEAM(8);
    STAMP(9); if (IN(9)) for (int rep_ = 0; rep_ < REP(9); ++rep_) { if (rep_) xcd_barrier(bar); asm volatile("; MK_PHASE_9" ::: "memory"); asm volatile("s_nop 13\n\t.fill 0, 4, 0xBF800000" ::: "memory"); if ((EN_MOE >> 0) & 1) moe_down<0>(F); } SEAM(9);
    STAMP(10); if (IN(10)) for (int rep_ = 0; rep_ < REP(10); ++rep_) { if (rep_) xcd_barrier(bar); asm volatile("; MK_PHASE_10" ::: "memory"); asm volatile("s_nop 13\n\t.fill 0, 4, 0xBF800000" ::: "memory"); pass_comb<0>(F); } SEAM(10);
    STAMP(11); if (IN(11)) for (int rep_ = 0; rep_ < REP(11); ++rep_) { if (rep_) xcd_barrier(bar); asm volatile("; MK_PHASE_11" ::: "memory"); asm volatile("s_nop 13\n\t.fill 386, 4, 0xBF800000" ::: "memory"); if ((EN_MIX >> 1) & 1) {
        pg8::Gemm g{Hb, (const bf16*)(F.ws + WS_WFAQ), DM, DM, DM, 128 * DM * 2, 128 * DM * 2};
        TokOrder S; S.init(NLAT / 256, FA_NQKV / 256, F.G, F.bx); S.apan = (size_t)256 * DM * 2; S.bpan = (size_t)256 * DM * 2;
        EpiQKV<4, true> E{(bf16*)(F.ws + WS_Q), (bf16*)(F.ws + WS_K), (bf16*)(F.ws + WS_V), argp(I_FABQ), argp(I_FAQN), argp(I_FAKN), (const float*)(F.ws + TB_ROPC), (const float*)(F.ws + TB_ROPS)};
        pg8::gemm_phase<EpiQKV<4, true>, TokOrder, true, true>(F.lds + RING_OFF, g, S, E);
        if (CONV_DEFER) conv_tail(F, 1, ((NLAT / 256) * (FA_NQKV / 256)) % F.G, CONV_QKV_PER);
        ctx_gemm(F, Hb, (const bf16*)(F.ws + WS_WFAQ), FA_NQKV, DM, 1, CtxEpiQKV<4, true>{(bf16*)(F.ws + WS_Q), argp(I_FABQ), argp(I_FAQN), argp(I_FAKN)}); } } SEAM(11);
    STAMP(12); if (IN(12)) for (int rep_ = 0; rep_ < REP(12); ++rep_) { if (rep_) xcd_barrier(bar); asm volatile("; MK_PHASE_12" ::: "memory"); asm volatile("s_nop 13\n\t.fill 516, 4, 0xBF800000" ::: "memory"); if ((EN_MIX >> 1) & 1) attn_phase<0>(F, (char*)lds + RING_OFF); } SEAM(12);
    STAMP(13); if (IN(13)) for (int rep_ = 0; rep_ < REP(13); ++rep_) { if (rep_) xcd_barrier(bar); asm volatile("; MK_PHASE_13" ::: "memory"); asm volatile("s_nop 13\n\t.fill 119, 4, 0xBF800000" ::: "memory"); if ((EN_MIX >> 1) & 1) { pg8::EpiBf16<0> E{Yb, DM, argp(I_FABO), 0, 0, 1.f}; tok_gemm<0>(F, (const bf16*)(F.ws + WS_O), (const bf16*)(F.ws + WS_WFAO), DM, DM, E);
        ctx_gemm(F, (const bf16*)(F.ws + WS_O), (const bf16*)(F.ws + WS_WFAO), DM, DM, 0, CtxEpiY{Yb, argp(I_FABO)}); } } SEAM(13);
    STAMP(14); if (IN(14)) for (int rep_ = 0; rep_ < REP(14); ++rep_) { if (rep_) xcd_barrier(bar); asm volatile("; MK_PHASE_14" ::: "memory"); asm volatile("s_nop 13\n\t.fill 0, 4, 0xBF800000" ::: "memory"); pass_mix<1>(F); } SEAM(14);
    STAMP(15); if (IN(15)) for (int rep_ = 0; rep_ < REP(15); ++rep_) { if (rep_) xcd_barrier(bar); asm volatile("; MK_PHASE_15" ::: "memory"); asm volatile("s_nop 13\n\t.fill 0, 4, 0xBF800000" ::: "memory"); }
    STAMP(16); if (IN(16)) for (int rep_ = 0; rep_ < REP(16); ++rep_) { if (rep_) xcd_barrier(bar); asm volatile("; MK_PHASE_16" ::: "memory"); asm volatile("s_nop 13\n\t.fill 0, 4, 0xBF800000" ::: "memory"); if ((EN_MOE >> 1) & 1) moe_up<1>(F); } SEAM(16);
    STAMP(17); if (IN(17)) for (int rep_ = 0; rep_ < REP(17); ++rep_) { if (rep_) xcd_barrier(bar); asm volatile("; MK_PHASE_17" ::: "memory"); asm volatile("s_nop 13\n\t.fill 0, 4, 0xBF800000" ::: "memory"); if ((EN_MOE >> 1) & 1) moe_down<1>(F); } SEAM(17);
    STAMP(18); if (IN(18)) for (int rep_ = 0; rep_ < REP(18); ++rep_) { if (rep_) xcd_barrier(bar); asm volatile("; MK_PHASE_18" ::: "memory"); asm volatile("s_nop 13\n\t.fill 0, 4, 0xBF800000" ::: "memory"); pass_comb<1>(F); } SEAM(18);
    STAMP(19); if (IN(19)) for (int rep_ = 0; rep_ < REP(19); ++rep_) { if (rep_) xcd_barrier(bar); asm volatile("; MK_PHASE_19" ::: "memory"); asm volatile("s_nop 13\n\t.fill 0, 4, 0xBF800000" ::: "memory"); if ((EN_MIX >> 2) & 1) {
        { pg8::Gemm g{Hb, (const bf16*)(F.ws + WS_WGI), DM, DM, DM, 128 * DM * 2, 128 * DM * 2};
          TokOrder S; S.init(NLAT / 256, GM_FF / 256, F.G, F.bx); S.apan = (size_t)256 * DM * 2; S.bpan = (size_t)256 * DM * 2;
          EpiGeluUV E{(bf16*)(F.ws + WS_GU), (bf16*)(F.ws + WS_GV), argp(I_GMBI), (float*)(F.ws + WS_PSTAT)};
          pg8::gemm_phase<EpiGeluUV, TokOrder, true, true>(F.lds + RING_OFF, g, S, E); }
        ctx_gemm(F, Hb, (const bf16*)(F.ws + WS_WGI), GM_FF, DM, 0, CtxEpiGelu{(bf16*)(F.ws + WS_GU), (bf16*)(F.ws + WS_GV), argp(I_GMBI), (float*)(F.ws + WS_PSTAT)}); } } SEAM(19);
    STAMP(20); if (IN(20)) for (int rep_ = 0; rep_ < REP(20); ++rep_) { if (rep_) xcd_barrier(bar); asm volatile("; MK_PHASE_20" ::: "memory"); asm volatile("s_nop 13\n\t.fill 610, 4, 0xBF800000" ::: "memory"); if ((EN_MIX >> 2) & 1) gate_phase(F); } SEAM(20);
    STAMP(21); if (IN(21)) for (int rep_ = 0; rep_ < REP(21); ++rep_) { if (rep_) xcd_barrier(bar); asm volatile("; MK_PHASE_21" ::: "memory"); asm volatile("s_nop 13\n\t.fill 544, 4, 0xBF800000" ::: "memory"); if ((EN_MIX >> 2) & 1) { pg8::EpiBf16<0> E{Yb, DM, argp(I_GMBO), 0, 0, 1.f}; tok_gemm<0>(F, (const bf16*)(F.ws + WS_GG), (const bf16*)(F.ws + WS_WGO), DM, GM_HALF, E);
        ctx_gemm(F, (const bf16*)(F.ws + WS_GG), (const bf16*)(F.ws + WS_WGO), DM, GM_HALF, 0, CtxEpiY{Yb, argp(I_GMBO)}); } } SEAM(21);
    STAMP(22); if (IN(22)) for (int rep_ = 0; rep_ < REP(22); ++rep_) { if (rep_) xcd_barrier(bar); asm volatile("; MK_PHASE_22" ::: "memory"); asm volatile("s_nop 13\n\t.fill 0, 4, 0xBF800000" ::: "memory"); pass_mix<2>(F); } SEAM(22);
    STAMP(23); if (IN(23)) for (int rep_ = 0; rep_ < REP(23); ++rep_) { if (rep_) xcd_barrier(bar); asm volatile("; MK_PHASE_23" ::: "memory"); asm volatile("s_nop 13\n\t.fill 0, 4, 0xBF800000" ::: "memory"); }
    STAMP(24); if (IN(24)) for (int rep_ = 0; rep_ < REP(24); ++rep_) { if (rep_) xcd_barrier(bar); asm volatile("; MK_PHASE_24" ::: "memory"); asm volatile("s_nop 13\n\t.fill 510, 4, 0xBF800000" ::: "memory"); if ((EN_MOE >> 2) & 1) moe_up<2>(F); } SEAM(24);
    STAMP(25); if (IN(25)) for (int rep_ = 0; rep_ < REP(25); ++rep_) { if (rep_) xcd_barrier(bar); asm volatile("; MK_PHASE_25" ::: "memory"); asm volatile("s_nop 13\n\t.fill 0, 4, 0xBF800000" ::: "memory"); if ((EN_MOE >> 2) & 1) moe_down<2>(F); } SEAM(25);
    STAMP(26); if (IN(26)) for (int rep_ = 0; rep_ < REP(26); ++rep_) { if (rep_) xcd_barrier(bar); asm volatile("; MK_PHASE_26" ::: "memory"); asm volatile("s_nop 13\n\t.fill 0, 4, 0xBF800000" ::: "memory"); pass_comb<2>(F); } SEAM(26);
    STAMP(27); if (IN(27)) for (int rep_ = 0; rep_ < REP(27); ++rep_) { if (rep_) xcd_barrier(bar); asm volatile("; MK_PHASE_27" ::: "memory"); asm volatile("s_nop 13\n\t.fill 490, 4, 0xBF800000" ::: "memory"); if ((EN_MIX >> 3) & 1) {
        pg8::Gemm g{Hb, (const bf16*)(F.ws + WS_WWQ), DM, DM, DM, 128 * DM * 2, 128 * DM * 2};
        TokOrder S; S.init(NLAT / 256, WA_NQKV / 256, F.G, F.bx); S.apan = (size_t)256 * DM * 2; S.bpan = (size_t)256 * DM * 2;
        EpiQKV<2, false> E{(bf16*)(F.ws + WS_Q), (bf16*)(F.ws + WS_K), (bf16*)(F.ws + WS_V), argp(I_WABQ), nullptr, nullptr, (const float*)(F.ws + TB_ROPC), (const float*)(F.ws + TB_ROPS)};
        pg8::gemm_phase<EpiQKV<2, false>, TokOrder, true, true>(F.lds + RING_OFF, g, S, E);
        if (CONV_DEFER) conv_tail(F, 3, ((NLAT / 256) * (WA_NQKV / 256)) % F.G, CONV_QKV_PER);
        ctx_gemm(F, Hb, (const bf16*)(F.ws + WS_WWQ), WA_NQKV, DM, 1, CtxEpiQKV<2, false>{(bf16*)(F.ws + WS_Q), argp(I_WABQ), argp(I_WABQ), argp(I_WABQ)}); } } SEAM(27);
    STAMP(28); if (IN(28)) for (int rep_ = 0; rep_ < REP(28); ++rep_) { if (rep_) xcd_barrier(bar); asm volatile("; MK_PHASE_28" ::: "memory"); asm volatile("s_nop 13\n\t.fill 0, 4, 0xBF800000" ::: "memory"); if ((EN_MIX >> 3) & 1) attn_phase<1>(F, (char*)lds + RING_OFF); } SEAM(28);
    STAMP(29); if (IN(29)) for (int rep_ = 0; rep_ < REP(29); ++rep_) { if (rep_) xcd_barrier(bar); asm volatile("; MK_PHASE_29" ::: "memory"); asm volatile("s_nop 13\n\t.fill 309, 4, 0xBF800000" ::: "memory"); if ((EN_MIX >> 3) & 1) { pg8::EpiBf16<0> E{Yb, DM, argp(I_WABO), 0, 0, 1.f}; tok_gemm<0>(F, (const bf16*)(F.ws + WS_O), (const bf16*)(F.ws + WS_WWO), DM, DM, E); } } SEAM(29);
    STAMP(30); if (IN(30)) for (int rep_ = 0; rep_ < REP(30); ++rep_) { if (rep_) xcd_barrier(bar); asm volatile("; MK_PHASE_30" ::: "memory"); asm volatile("s_nop 13\n\t.fill 353, 4, 0xBF800000" ::: "memory"); pass_mix<3>(F); } SEAM(30);
    STAMP(31); if (IN(31)) for (int rep_ = 0; rep_ < REP(31); ++rep_) { if (rep_) xcd_barrier(bar); asm volatile("; MK_PHASE_31" ::: "memory"); asm volatile("s_nop 13\n\t.fill 0, 4, 0xBF800000" ::: "memory"); }
    STAMP(32); if (IN(32)) for (int rep_ = 0; rep_ < REP(32); ++rep_) { if (rep_) xcd_barrier(bar); asm volatile("; MK_PHASE_32" ::: "memory"); asm volatile("s_nop 13\n\t.fill 0, 4, 0xBF800000" ::: "memory"); if ((EN_MOE >> 3) & 1) moe_up<3>(F); } SEAM(32);
    STAMP(33); if (IN(33)) for (int rep_ = 0; rep_ < REP(33); ++rep_) { if (rep_) xcd_barrier(bar); asm volatile("; MK_PHASE_33" ::: "memory"); asm volatile("s_nop 13\n\t.fill 0, 4, 0xBF800000" ::: "memory"); if ((EN_MOE >> 3) & 1) moe_down<3>(F); } SEAM(33);
    STAMP(34); if (IN(34)) for (int rep_ = 0; rep_ < REP(34); ++rep_) { if (rep_) xcd_barrier(bar); asm volatile("; MK_PHASE_34" ::: "memory"); asm volatile("s_nop 13\n\t.fill 0, 4, 0xBF800000" ::: "memory"); pass_comb<3>(F); }
#ifdef MK_PROBE_MASK
    STAMP(35); __syncthreads();
    { float us = 0.f;
      for (int k = 0; k < 35; ++k) if ((MK_PROBE_MASK >> k) & 1ull) { const unsigned long long a = ((unsigned long long)F.MISC[513 + 2 * k] << 32) | F.MISC[512 + 2 * k], b = ((unsigned long long)F.MISC[515 + 2 * k] << 32) | F.MISC[514 + 2 * k]; us += (float)(b - a) * 0.01f; }
      const float cval = us / (float)(MK_PROBE_DIV);
      const int lane = threadIdx.x & 63, gw = F.vcu * NWAVES + F.wave, NGW = F.G * NWAVES; RowV r;
      for (int j = 0; j < 4; ++j) r.v[j] = (f32x4){cval, cval, cval, cval};
      float* outp = (float*)argp(N_IN);
      for (int m = gw; m < NLAT; m += NGW) strow(outp + (size_t)m * DM, lane, r); }
#endif
#undef IN
#undef SEAM
}

extern "C" void kernel_launch(void* const* d_in, const int* in_sizes, int n_in, void* d_out, int out_size, void* d_ws, size_t ws_size, hipStream_t stream) {
    static int grid = 0;
    if (grid == 0) {
        if (n_in != N_IN || in_sizes[0] != NLAT * DM || out_size != NLAT * DM || ws_size < WS_END) { fprintf(stderr, "kernel_launch: unexpected shapes (n_in %d, in0 %d, out %d, ws %zu)\n", n_in, n_in > 0 ? in_sizes[0] : -1, out_size, ws_size); grid = -1; return; }
        int dev = 0, cus = 0, per_cu = 0;
        if (hipGetDevice(&dev) != hipSuccess || hipDeviceGetAttribute(&cus, hipDeviceAttributeMultiprocessorCount, dev) != hipSuccess) { grid = -1; return; }
        if (hipFuncSetAttribute((const void*)mk_fwd, hipFuncAttributeMaxDynamicSharedMemorySize, LDS_BYTES) != hipSuccess) { fprintf(stderr, "kernel_launch: hipFuncSetAttribute failed\n"); grid = -1; return; }
        if (hipOccupancyMaxActiveBlocksPerMultiprocessor(&per_cu, (const void*)mk_fwd, NTHR, LDS_BYTES) != hipSuccess || per_cu < 1) fprintf(stderr, "kernel_launch: occupancy query says %d\n", per_cu);
        (void)hipGetLastError();
        grid = cus;
    }
    if (grid < 0) return;
    if (hipMemsetAsync((char*)d_ws + WS_CTL, 0, CTL_ZERO_BYTES, stream) != hipSuccess) return;
    Args a{};
    for (int i = 0; i < N_IN; ++i) a.in[i] = (const float*)d_in[i];
    a.out = (float*)d_out; a.ws = (unsigned char*)d_ws;
#if MK_PER_PHASE
    for (int p = 0; p < NPHASE; ++p) { a.ph_lo = p; a.ph_hi = p + 1; hipLaunchKernelGGL(mk_fwd, dim3(grid), dim3(NTHR), LDS_BYTES, stream, a); }
#else
    a.ph_lo = 0; a.ph_hi = NPHASE; hipLaunchKernelGGL(mk_fwd, dim3(grid), dim3(NTHR), LDS_BYTES, stream, a);
#endif
}
```

```cpp
#define MK_PER_PHASE 0
#define EN_MIX 15
#define EN_MOE 15
#include <hip/hip_runtime.h>
#include <hip/hip_bf16.h>
#include <cstdio>
#include <cstdint>
#include <cmath>
#ifndef MK_PER_PHASE
#define MK_PER_PHASE 0
#endif
namespace pg8 {
#define PG8_LAS __attribute__((address_space(3)))
typedef unsigned short bf16_t;
typedef short bf16x8 __attribute__((ext_vector_type(8)));
typedef float f32x4 __attribute__((ext_vector_type(4)));
typedef float f32x2 __attribute__((ext_vector_type(2)));
typedef unsigned u32x4 __attribute__((ext_vector_type(4)));
typedef unsigned u32x2 __attribute__((ext_vector_type(2)));
constexpr int BM = 256, BK = 64, HALF = 128, HTB = HALF * BK * 2  , STAGE_BYTES = 8 * HTB, NXCD = 8, WGM = 2;

__host__ __device__ __forceinline__ int lds_byte(int r, int c) { const int st = (r >> 4) * 2 + (c >> 5), rr = r & 15, cc = c & 31, ob = rr * 64 + cc * 2; return st * 1024 + (ob ^ (((ob >> 9) & 1) << 5)); }
__host__ __device__ __forceinline__ void stage_rc(int b, int& R, int& C) { const int st = b / 1024, sb = b % 1024, swz = sb ^ (((sb >> 9) & 1) << 5); R = (st >> 1) * 16 + swz / 64; C = (st & 1) * 32 + (swz % 64) / 2; }
__host__ __device__ __forceinline__ int perm32(int rho) { const int n = rho >> 4, i = rho & 15; return 8 * (i >> 2) + 4 * n + (i & 3); }

struct Unit { int pm, pn, e; };
struct Gemm { const bf16_t* A; const bf16_t* Bt; int K, lda, ldb; unsigned hstepA, hstepB; };

struct GridOrder {
    int nM, nN, nwg, G, c, wgm;
    __device__ __forceinline__ void init(int nM_, int nN_, int G_, int c_, int wgm_ = WGM) { nM = nM_; nN = nN_; nwg = nM * nN; G = G_; c = c_; wgm = wgm_; }
    __device__ __forceinline__ bool next_mn(int i, int& pm, int& pn) const {
        const long L = (long)i * G + c; if (L >= nwg) return false;
        int wgid = (int)L; { const int q = nwg / NXCD, r = nwg % NXCD, xcd = wgid % NXCD, off = wgid / NXCD; wgid = (xcd < r ? xcd * (q + 1) : r * (q + 1) + (xcd - r) * q) + off; }
        const int nig = wgm * nN, gid = wgid / nig, fm = gid * wgm, gsz = (nM - fm) < wgm ? (nM - fm) : wgm;
        pm = fm + ((wgid % nig) % gsz); pn = (wgid % nig) / gsz; return true;
    }
};
__device__ __forceinline__ unsigned cvt_pk_bf16(float lo, float hi) { unsigned r; asm volatile("v_cvt_pk_bf16_f32 %0, %1, %2" : "=v"(r) : "v"(lo), "v"(hi)); return r; }
__device__ __forceinline__ f32x2 gelu_pk(f32x2 v) {
    const f32x2 av = __builtin_elementwise_abs(v), d = av * 0.2316418882f + 1.0f;
    f32x2 t; t.x = __builtin_amdgcn_rcpf(d.x); t.y = __builtin_amdgcn_rcpf(d.y);
    f32x2 q = t * 0.5307027145f + (-0.7265760135f); q = q * t + 0.7107068705f; q = q * t + (-0.142248368f); q = q * t + 0.127414796f; q = q * t;
    const f32x2 s = (v * v) * (-0.72134752044f);
    f32x2 e; e.x = __builtin_amdgcn_exp2f(s.x); e.y = __builtin_amdgcn_exp2f(s.y);
    const f32x2 m = v * (q * e), r = v - m;
    f32x2 o; o.x = v.x < 0.f ? m.x : r.x; o.y = v.y < 0.f ? m.y : r.y; return o;
}

template <int ACT  > struct EpiBf16 {
    static constexpr bool PERM = true, AFTER_DRAIN = false; static_assert(ACT == 0 || ACT == 1, "EpiBf16: ACT is 0 (none) or 1 (gelu_pk)");
    bf16_t* O; int ldc; const float* bias; int split_cols; size_t split_stride; float scale0;
    __device__ __forceinline__ void operator()(const f32x4 (&acc)[2][2][4][2], const Unit& u, int wr, int wc, int fr, int fq) const {
        const int row0 = u.pm * BM + wr * 64 + fr; int colt = u.pn * BM; bf16_t* base = O;
        float sc = 1.f; if (split_cols) { const int t = colt / split_cols; base += (size_t)t * split_stride; colt -= t * split_cols; if (t == 0) sc = scale0; }
        const int col0 = colt + wc * 32 + 8 * fq, bcol0 = u.pn * BM + wc * 32 + 8 * fq;
        f32x4 bv[2][2];
#pragma unroll
        for (int bj = 0; bj < 2; ++bj)
#pragma unroll
            for (int n = 0; n < 2; ++n) bv[bj][n] = bias ? *(const f32x4*)(bias + bcol0 + bj * HALF + 4 * n) : (f32x4){0.f, 0.f, 0.f, 0.f};
#pragma unroll
        for (int ai = 0; ai < 2; ++ai)
#pragma unroll
            for (int m = 0; m < 4; ++m) { bf16_t* rowp = base + (size_t)(row0 + ai * HALF + m * 16) * ldc + col0;
#pragma unroll
                for (int bj = 0; bj < 2; ++bj) { f32x4 v0 = acc[ai][bj][m][0] + bv[bj][0], v1 = acc[ai][bj][m][1] + bv[bj][1];
                    if (ACT == 1) { f32x2 a = gelu_pk((f32x2){v0[0], v0[1]}), b = gelu_pk((f32x2){v0[2], v0[3]}), c = gelu_pk((f32x2){v1[0], v1[1]}), d = gelu_pk((f32x2){v1[2], v1[3]});
                        v0 = (f32x4){a.x, a.y, b.x, b.y}; v1 = (f32x4){c.x, c.y, d.x, d.y}; }
                    v0 = v0 * sc; v1 = v1 * sc; u32x4 w; w.x = cvt_pk_bf16(v0[0], v0[1]); w.y = cvt_pk_bf16(v0[2], v0[3]); w.z = cvt_pk_bf16(v1[0], v1[1]); w.w = cvt_pk_bf16(v1[2], v1[3]);
                    *(u32x4*)(rowp + bj * HALF) = w; } }
    }
};
typedef int v8i_t __attribute__((ext_vector_type(8))); typedef int v4i_t __attribute__((ext_vector_type(4)));
template <class Epi, class Sched, bool ALIGN_EPI = false, bool SP2 = false, bool GATHER = false, bool F8 = false>
__device__ __forceinline__ void gemm_phase(PG8_LAS unsigned char* lds, const Gemm g, const Sched& S, const Epi& E) {
    int tid_ = threadIdx.x; asm volatile("" : "+v"(tid_));
    const int tid = tid_, wid = __builtin_amdgcn_readfirstlane(tid >> 6), lane = tid & 63, wr = wid >> 2, wc = wid & 3, fr = lane & 15, fq = lane >> 4;
    const int K = g.K; int nt = K / BK; if constexpr (F8) asm volatile("" : "+s"(nt));
    unsigned voffA[2], voffB[2];
#pragma unroll
    for (int i = 0; i < 2; ++i) { int R, C; stage_rc(tid * 16 + i * 8192, R, C); const int Rb = Epi::PERM ? ((R & ~31) + perm32(R & 31)) : R;
        voffA[i] = (unsigned)(R * g.lda + C) * 2u; voffB[i] = (unsigned)(Rb * g.ldb + C) * 2u; }
    const size_t kstep = (size_t)(BK * 2);
    const size_t hstepA = g.hstepA, hstepB = g.hstepB;
    const unsigned ldsw = (unsigned)wid * 1024u;
    const int aoff = lds_byte(wr * 64 + fr, fq * 8), boff = lds_byte(wc * 32 + fr, fq * 8);
#define PG8_SA(b, h) (((b) * 2 + (h)) * HTB)
#define PG8_SB(b, h) ((4 + (b) * 2 + (h)) * HTB)
#define PG8_STAGE(bufoff, gbase, voff) do { _Pragma("unroll") for (int _i = 0; _i < 2; ++_i) { unsigned _vo = (voff)[_i]; asm volatile("" : "+v"(_vo));     \
        __builtin_amdgcn_global_load_lds((const unsigned*)((const char*)(gbase) + _vo), (PG8_LAS unsigned*)(lds + (bufoff) + ldsw + _i * 8192), 16, 0, 0); } } while (0)
#define PG8_CAT8(x, y) __builtin_shufflevector(__builtin_bit_cast(v4i_t, x), __builtin_bit_cast(v4i_t, y), 0, 1, 2, 3, 4, 5, 6, 7)
#define PG8_LDA(dst, b, h) do { _Pragma("unroll") for (int m = 0; m < 4; ++m) { const bf16x8 f0_ = *(const PG8_LAS bf16x8*)(lds + PG8_SA(b, h) + aoff + m * 2048), f1_ = *(const PG8_LAS bf16x8*)(lds + PG8_SA(b, h) + aoff + m * 2048 + 1024); \
        if constexpr (F8) dst##8[m] = PG8_CAT8(f0_, f1_); else { dst[m][0] = f0_; dst[m][1] = f1_; } } } while (0)
#define PG8_LDB(dst, b, h) do { _Pragma("unroll") for (int n = 0; n < 2; ++n) { const bf16x8 f0_ = *(const PG8_LAS bf16x8*)(lds + PG8_SB(b, h) + boff + n * 2048), f1_ = *(const PG8_LAS bf16x8*)(lds + PG8_SB(b, h) + boff + n * 2048 + 1024); \
        if constexpr (F8) dst##8[n] = PG8_CAT8(f0_, f1_); else { dst[n][0] = f0_; dst[n][1] = f1_; } } } while (0)
#define PG8_MMA(ai, bj, At, Bt) do { __builtin_amdgcn_s_setprio(1); _Pragma("unroll") for (int m = 0; m < 4; ++m) _Pragma("unroll") for (int n = 0; n < 2; ++n) { \
        if constexpr (F8) asm volatile("v_mfma_scale_f32_16x16x128_f8f6f4 %0, %1, %2, %0, %3, %3 op_sel_hi:[0,0,0]" : "+v"(acc[ai][bj][m][n]) : "v"(Bt##8[n]), "v"(At##8[m]), "v"(f8scale));   \
        else { _Pragma("unroll") for (int k = 0; k < 2; ++k) acc[ai][bj][m][n] = __builtin_amdgcn_mfma_f32_16x16x32_bf16(Bt[n][k], At[m][k], acc[ai][bj][m][n], 0, 0, 0); } } __builtin_amdgcn_s_setprio(0); } while (0)
#define PG8_WAIT_V(n) asm volatile("s_waitcnt vmcnt(" #n ")" ::: "memory")
#define PG8_WAIT_L(n) asm volatile("s_waitcnt lgkmcnt(" #n ")" ::: "memory")
#define PG8_BAR __builtin_amdgcn_s_barrier()
#define PG8_SCHED __builtin_amdgcn_sched_barrier(0)
    Unit cur, nxt; int ui = 0;
    if (!S.next(0, cur)) return;
    f32x4 acc[2][2][4][2];
#pragma unroll
    for (int a = 0; a < 2; ++a)
#pragma unroll
        for (int b = 0; b < 2; ++b)
#pragma unroll
            for (int m = 0; m < 4; ++m)
#pragma unroll
                for (int n = 0; n < 2; ++n) acc[a][b][m][n] = (f32x4){0.f, 0.f, 0.f, 0.f};
    const int f8scale = 0x7C7C7C7C;
    bf16x8 At[4][2], B0[2][2], B1[2][2]; v8i_t At8[4], B08[2], B18[2];
    const char* cA = (const char*)g.A + S.offA(cur); const char* cB = (const char*)g.Bt + S.offB(cur);
    unsigned va0[2], va1[2], vn0[2], vn1[2];
#define PG8_AOFFS(dst0, dst1, unit) do { _Pragma("unroll") for (int i = 0; i < 2; ++i) { if constexpr (GATHER) { int R, C; stage_rc(tid * 16 + i * 8192, R, C); \
        dst0[i] = S.rowoff(unit, R) + (unsigned)C * 2u; dst1[i] = S.rowoff(unit, R + HALF) + (unsigned)C * 2u; } else { dst0[i] = voffA[i]; dst1[i] = voffA[i] + (unsigned)hstepA; } } } while (0)
    PG8_AOFFS(va0, va1, cur);
    S.a_ready(cur);
    if constexpr (SP2) {
        PG8_STAGE(PG8_SB(0, 0), cB, voffB); PG8_STAGE(PG8_SB(0, 1), cB + hstepB, voffB); PG8_STAGE(PG8_SA(0, 0), cA, va0); PG8_STAGE(PG8_SA(0, 1), cA, va1);
        if (wr == 1) PG8_BAR;
        PG8_WAIT_V(2); PG8_BAR;
        PG8_STAGE(PG8_SB(1, 0), cB + kstep, voffB); PG8_STAGE(PG8_SA(1, 0), cA + kstep, va0); PG8_STAGE(PG8_SB(1, 1), cB + hstepB + kstep, voffB);
        PG8_WAIT_V(6); PG8_BAR;
    } else {
        PG8_STAGE(PG8_SB(0, 0), cB, voffB); PG8_STAGE(PG8_SA(0, 0), cA, va0); PG8_STAGE(PG8_SB(0, 1), cB + hstepB, voffB); PG8_STAGE(PG8_SA(0, 1), cA, va1);
        if (wr == 1) PG8_BAR;
        PG8_WAIT_V(4); PG8_BAR;
        PG8_STAGE(PG8_SB(1, 0), cB + kstep, voffB); PG8_STAGE(PG8_SA(1, 0), cA + kstep, va0); PG8_STAGE(PG8_SB(1, 1), cB + hstepB + kstep, voffB);
        PG8_WAIT_V(6); PG8_BAR;
    }
    for (;;) {
        const bool has_next = S.next(ui + 1, nxt);
        if (GATHER && has_next) PG8_AOFFS(vn0, vn1, nxt); else { vn0[0] = va0[0]; vn0[1] = va0[1]; vn1[0] = va1[0]; vn1[1] = va1[1]; }
        const char* nA = has_next ? (const char*)g.A + S.offA(nxt) : cA; const char* nB = has_next ? (const char*)g.Bt + S.offB(nxt) : cB;
        for (int t = 0; t < nt; t += 2) {
            const bool last = (t == nt - 2);
            const unsigned vs0[2] = {last ? vn0[0] : va0[0], last ? vn0[1] : va0[1]}, vs1[2] = {last ? vn1[0] : va1[0], last ? vn1[1] : va1[1]};
            const char* a1 = cA + (size_t)(t + 1) * kstep;
            const char* a2 = last ? nA : cA + (size_t)(t + 2) * kstep; const char* b2 = last ? nB : cB + (size_t)(t + 2) * kstep;
            const char* a3 = a2 + kstep; const char* b3 = b2 + kstep;
            if (last && has_next) S.a_ready(nxt);
            if constexpr (SP2) {
            PG8_LDB(B0, 0, 0); PG8_LDB(B1, 0, 1); PG8_SCHED; PG8_LDA(At, 0, 0); PG8_STAGE(PG8_SA(1, 1), a1, va1);
            PG8_WAIT_V(8); PG8_WAIT_L(0); PG8_BAR; PG8_MMA(0, 0, At, B0); PG8_MMA(0, 1, At, B1); PG8_BAR; PG8_SCHED;
            PG8_LDA(At, 0, 1); PG8_STAGE(PG8_SB(0, 0), b2, voffB); PG8_STAGE(PG8_SB(0, 1), b2 + hstepB, voffB); PG8_STAGE(PG8_SA(0, 0), a2, vs0);
            PG8_WAIT_V(8); PG8_WAIT_L(0); PG8_BAR; PG8_MMA(1, 0, At, B0); PG8_MMA(1, 1, At, B1); PG8_BAR; PG8_SCHED;
            PG8_LDB(B0, 1, 0); PG8_LDB(B1, 1, 1); PG8_SCHED; PG8_LDA(At, 1, 0); PG8_STAGE(PG8_SA(0, 1), a2, vs1);
            PG8_WAIT_V(8); PG8_WAIT_L(0); PG8_BAR; PG8_MMA(0, 0, At, B0); PG8_MMA(0, 1, At, B1); PG8_BAR; PG8_SCHED;
            PG8_LDA(At, 1, 1); PG8_STAGE(PG8_SB(1, 0), b3, voffB); PG8_STAGE(PG8_SB(1, 1), b3 + hstepB, voffB); PG8_STAGE(PG8_SA(1, 0), a3, vs0);
            PG8_WAIT_V(8); PG8_WAIT_L(0); PG8_BAR; PG8_MMA(1, 0, At, B0); PG8_MMA(1, 1, At, B1); PG8_BAR; PG8_SCHED;
            } else {
            PG8_LDB(B0, 0, 0); PG8_SCHED; PG8_LDA(At, 0, 0); PG8_STAGE(PG8_SA(1, 1), a1, va1);
            PG8_WAIT_L(8); PG8_BAR; PG8_WAIT_L(0); PG8_MMA(0, 0, At, B0); PG8_BAR; PG8_SCHED;
            PG8_LDB(B1, 0, 1); PG8_STAGE(PG8_SB(0, 0), b2, voffB);
            PG8_BAR; PG8_WAIT_L(0); PG8_MMA(0, 1, At, B1); PG8_BAR;
            PG8_LDA(At, 0, 1); PG8_STAGE(PG8_SA(0, 0), a2, vs0);
            PG8_BAR; PG8_WAIT_L(0); PG8_MMA(1, 0, At, B0); PG8_BAR; PG8_SCHED;
            PG8_STAGE(PG8_SB(0, 1), b2 + hstepB, voffB);
            PG8_WAIT_V(6); PG8_BAR; PG8_MMA(1, 1, At, B1); PG8_BAR;
            PG8_LDB(B0, 1, 0); PG8_SCHED; PG8_LDA(At, 1, 0); PG8_STAGE(PG8_SA(0, 1), a2, vs1);
            PG8_WAIT_L(8); PG8_BAR; PG8_WAIT_L(0); PG8_MMA(0, 0, At, B0); PG8_BAR; PG8_SCHED;
            PG8_LDB(B1, 1, 1); PG8_STAGE(PG8_SB(1, 0), b3, voffB);
            PG8_BAR; PG8_WAIT_L(0); PG8_MMA(0, 1, At, B1); PG8_BAR;
            PG8_LDA(At, 1, 1); PG8_STAGE(PG8_SA(1, 0), a3, vs0);
            PG8_BAR; PG8_WAIT_L(0); PG8_MMA(1, 0, At, B0); PG8_BAR; PG8_SCHED;
            PG8_STAGE(PG8_SB(1, 1), b3 + hstepB, voffB);
            PG8_WAIT_V(6); PG8_BAR; PG8_MMA(1, 1, At, B1); PG8_BAR;
            }
        }
        if constexpr (ALIGN_EPI) { if (wr == 0) PG8_BAR; }
        if constexpr (F8) asm volatile("s_nop 15\n\ts_nop 7" ::: "memory");
        if constexpr (!Epi::AFTER_DRAIN) { E(acc, cur, wr, wc, fr, fq); S.done(cur); }
        if (!has_next) break;
#pragma unroll
        for (int a = 0; a < 2; ++a)
#pragma unroll
            for (int b = 0; b < 2; ++b)
#pragma unroll
                for (int m = 0; m < 4; ++m)
#pragma unroll
                    for (int n = 0; n < 2; ++n) acc[a][b][m][n] = (f32x4){0.f, 0.f, 0.f, 0.f};
        cur = nxt; cA = nA; cB = nB; ++ui; va0[0] = vn0[0]; va0[1] = vn0[1]; va1[0] = vn1[0]; va1[1] = vn1[1];
        if constexpr (ALIGN_EPI) { if (wr == 1) PG8_BAR; }
    }
    PG8_WAIT_V(0);
    if constexpr (!ALIGN_EPI) { if (wr == 0) PG8_BAR; }
    PG8_BAR;
    if constexpr (Epi::AFTER_DRAIN) { E.fused(acc, cur, wr, wc, fr, fq, lds, wid, lane); S.done(cur); }
#undef PG8_SA
#undef PG8_AOFFS
#undef PG8_SB
#undef PG8_STAGE
#undef PG8_LDA
#undef PG8_LDB
#undef PG8_MMA
#undef PG8_CAT8
#undef PG8_WAIT_V
#undef PG8_WAIT_L
#undef PG8_BAR
#undef PG8_SCHED
}
}
namespace attn_body {
using bf16=__hip_bfloat16;
using bf16x8=__attribute__((ext_vector_type(8)))short;
using s16x4=__attribute__((ext_vector_type(4)))short;
using f32x16=__attribute__((ext_vector_type(16)))float;
using u32x4=__attribute__((ext_vector_type(4)))unsigned;
constexpr int D=64,QP=1024;
constexpr int NW=8,QBLK=32,QB=QBLK*NW,KVBLK=64;
__device__ __forceinline__ void wmask(f32x16&p0,f32x16&p1,int t,int kstart,int qabs,int hi){
  if(t<4)return; const float NEG=-INFINITY; const int kb=kstart+64*(t-4)+4*hi-qabs;
  #pragma unroll
  for(int r=0;r<16;++r){const int dk=kb+(r&3)+8*(r>>2); if(dk>128||dk<-128)p0[r]=NEG; if(dk+32>128||dk+32<-128)p1[r]=NEG;}
}
__device__ __forceinline__ int crow(int r,int hi){return (r&3)+8*(r>>2)+4*hi;}
#define SBAR() __builtin_amdgcn_sched_barrier(0)
__device__ __forceinline__ void cmask(f32x16&p0,f32x16&p1,int jb,int qrel,int hi){
  const float NEG=-INFINITY; int kb=64*jb+4*hi;
  #pragma unroll
  for(int r=0;r<16;++r){int kv=kb+(r&3)+8*(r>>2); if(kv>qrel)p0[r]=NEG; if(kv+32>qrel)p1[r]=NEG;}
}

constexpr int NSLOT=3, SLOTB=8192;
constexpr int LDS_K=0, LDS_V=NSLOT*SLOTB, LDS_WS=2*NSLOT*SLOTB, LDS_OST=LDS_WS+NW*64*4, LDS_BYTES=LDS_OST+NW*4096;
constexpr float C2=0.125f*1.4426950408889634f;
__device__ __forceinline__ void glds16(const void*gsrc,unsigned lds_dst){unsigned keep;
  asm volatile("s_mov_b32 %0, m0\n\ts_mov_b32 m0, %2\n\ts_nop 0\n\tglobal_load_lds_dwordx4 %1, off\n\ts_mov_b32 m0, %0":"=&s"(keep):"v"(gsrc),"s"(lds_dst):"memory");}
__device__ __forceinline__ float max3f(float a,float b,float c){float r;asm("v_max3_f32 %0, %1, %2, %3":"=v"(r):"v"(a),"v"(b),"v"(c));return r;}
__device__ __forceinline__ float max2f(float a,float b){float r;asm("v_max_f32_e32 %0, %1, %2":"=v"(r):"v"(a),"v"(b));return r;}
__device__ __forceinline__ float fadd_s(float a,float b){float r;asm("v_add_f32_e32 %0, %1, %2":"=v"(r):"v"(a),"v"(b));return r;}
__device__ __forceinline__ float fsub_s(float a,float b){float r;asm("v_sub_f32_e32 %0, %1, %2":"=v"(r):"v"(a),"v"(b));return r;}
typedef float f32x2_t __attribute__((ext_vector_type(2))); typedef __bf16 bf16x2_t __attribute__((ext_vector_type(2)));
__device__ __forceinline__ unsigned cvtpk_s(float lo,float hi){f32x2_t v={lo,hi};bf16x2_t b=__builtin_convertvector(v,bf16x2_t);return __builtin_bit_cast(unsigned,b);}
#define WAIT_BAR(N) asm volatile("s_waitcnt vmcnt(" #N ") lgkmcnt(0)\n\ts_barrier":::"memory")

__device__ __forceinline__ void qkt(f32x16&p0,f32x16&p1,const char*Kslot,const bf16x8*qr,const f32x16&negm,int r32,int hi){
  const char*kb=Kslot+hi*1024+r32*16;
  #pragma unroll
  for(int d0=0;d0<4;++d0){
    const bf16x8 b0=*reinterpret_cast<const bf16x8*>(kb+d0*2048);
    const bf16x8 b1=*reinterpret_cast<const bf16x8*>(kb+d0*2048+512);
    if(d0==0){p0=__builtin_amdgcn_mfma_f32_32x32x16_bf16(b0,qr[0],negm,0,0,0);p1=__builtin_amdgcn_mfma_f32_32x32x16_bf16(b1,qr[0],negm,0,0,0);}
    else{p0=__builtin_amdgcn_mfma_f32_32x32x16_bf16(b0,qr[d0],p0,0,0,0);p1=__builtin_amdgcn_mfma_f32_32x32x16_bf16(b1,qr[d0],p1,0,0,0);}}
}
typedef __attribute__((address_space(3))) const char* lds_cptr;
typedef short v4i16_t __attribute__((ext_vector_type(4)));
__device__ __forceinline__ void kload8(bf16x8*kf,lds_cptr kp){
  kf[0]=*(const __attribute__((address_space(3))) bf16x8*)(kp);      kf[1]=*(const __attribute__((address_space(3))) bf16x8*)(kp+512);
  kf[2]=*(const __attribute__((address_space(3))) bf16x8*)(kp+2048); kf[3]=*(const __attribute__((address_space(3))) bf16x8*)(kp+2560);
  kf[4]=*(const __attribute__((address_space(3))) bf16x8*)(kp+4096); kf[5]=*(const __attribute__((address_space(3))) bf16x8*)(kp+4608);
  kf[6]=*(const __attribute__((address_space(3))) bf16x8*)(kp+6144); kf[7]=*(const __attribute__((address_space(3))) bf16x8*)(kp+6656);
}
__device__ __forceinline__ void kload2(bf16x8*kf,lds_cptr kp,int j){ kf[2*j]=*(const __attribute__((address_space(3))) bf16x8*)(kp+j*2048); kf[2*j+1]=*(const __attribute__((address_space(3))) bf16x8*)(kp+j*2048+512); }
__device__ __forceinline__ s16x4 vtr(lds_cptr p){ return __builtin_bit_cast(s16x4,__builtin_amdgcn_ds_read_tr16_b64_v4i16((__attribute__((address_space(3))) v4i16_t*)p)); }
__device__ __forceinline__ float rowmax(const f32x16&p0,const f32x16&p1){
  float a=max3f(p0[0],p0[1],p1[0]),b=max3f(p0[2],p0[3],p1[1]);a=max3f(a,p1[2],p1[3]);
  #pragma unroll
  for(int r=4;r<16;r+=4){a=max3f(a,p0[r],p0[r+1]);b=max3f(b,p0[r+2],p0[r+3]);a=max3f(a,p1[r],p1[r+1]);b=max3f(b,p1[r+2],p1[r+3]);}
  const float m=max2f(a,b);
  auto rr=__builtin_amdgcn_permlane32_swap(__float_as_uint(m),__float_as_uint(m),false,false);
  return max2f(__uint_as_float(rr[0]),__uint_as_float(rr[1]));
}
__device__ __forceinline__ void pv(f32x16*o,int vb,bf16x8 pa0,bf16x8 pa1,bf16x8 pa2,bf16x8 pa3){
  #pragma unroll
  for(int d0=0;d0<2;++d0){s16x4 lo[4],hi[4];
    #pragma unroll
    for(int ks=0;ks<4;++ks){
      asm volatile("ds_read_b64_tr_b16 %0,%1 offset:%c2":"=&v"(lo[ks]):"v"(vb),"i"(d0*4096+ks*1024):"memory");
      asm volatile("ds_read_b64_tr_b16 %0,%1 offset:%c2":"=&v"(hi[ks]):"v"(vb),"i"(d0*4096+ks*1024+512):"memory");}
    asm volatile("s_waitcnt lgkmcnt(0)":::"memory");SBAR();
    #define PK(k) (bf16x8){lo[k][0],lo[k][1],lo[k][2],lo[k][3],hi[k][0],hi[k][1],hi[k][2],hi[k][3]}
    o[d0]=__builtin_amdgcn_mfma_f32_32x32x16_bf16(pa0,PK(0),o[d0],0,0,0);
    o[d0]=__builtin_amdgcn_mfma_f32_32x32x16_bf16(pa1,PK(1),o[d0],0,0,0);
    o[d0]=__builtin_amdgcn_mfma_f32_32x32x16_bf16(pa2,PK(2),o[d0],0,0,0);
    o[d0]=__builtin_amdgcn_mfma_f32_32x32x16_bf16(pa3,PK(3),o[d0],0,0,0);
    #undef PK
  }
}

#ifndef ATTN_STORE16
#define ATTN_STORE16(p,v) (*(u32x4*)(p)=(v))
#endif
template<int MODE,int KP,int THRL> __device__ __forceinline__ void attn_unit(int h,int kvh,int q0,int NT,int kbase,float sink_l2,const bf16*Q,const bf16*__restrict__ K,const bf16*__restrict__ V,bf16*O,char*shm){
  int tid_=threadIdx.x; asm volatile("":"+v"(tid_)); const int tid=tid_,lane=tid&63,r32=lane&31,hi=lane>>5; const int wid=__builtin_amdgcn_readfirstlane(tid>>6);
  #define TROW(t) (MODE==0 ? (kbase+64*(t)) : ((t)<4 ? 16384+64*(t) : kbase+64*((t)-4)))
  const bf16*Qw=Q+(long)(q0+wid*QBLK)*QP+h*D;
  const bf16*Kh=K+kvh*D,*Vh=V+kvh*D;
  const unsigned lds0=(unsigned)(uintptr_t)shm;
  float*wsf=(float*)(shm+LDS_WS)+wid*64;
  const bf16*ksrc=Kh+(long)lane*KP+wid*8;
  const bf16*vsrc=Vh+(long)(16*(wid&3)+(lane>>2))*KP+(wid>>2)*32+(lane&3)*8;
  const unsigned kdst=lds0+LDS_K+wid*1024, vdst=lds0+LDS_V+wid*1024;
  #define DMA_K(t,slot) glds16(ksrc+(long)TROW(t)*KP,(unsigned)__builtin_amdgcn_readfirstlane(kdst+(slot)))
  #define DMA_V(t,slot) glds16(vsrc+(long)TROW(t)*KP,(unsigned)__builtin_amdgcn_readfirstlane(vdst+(slot)))
  const int vb0=(int)(lds0+LDS_V)+((lane>>4)&1)*32+(lane&3)*8+(4*hi+((lane&15)>>2))*64;
  const char*Kbase=shm+LDS_K; bf16x8 kf[8];
  const lds_cptr shm3=(lds_cptr)shm; const lds_cptr kp0=shm3+LDS_K+hi*1024+r32*16; const lds_cptr vp0=shm3+LDS_V+((lane>>4)&1)*32+(lane&3)*8+(4*hi+((lane&15)>>2))*64;
  DMA_K(0,0);DMA_V(0,0);DMA_K(1,SLOTB);
  bf16x8 qr[4];
  #pragma unroll
  for(int d0=0;d0<4;++d0)qr[d0]=*reinterpret_cast<const bf16x8*>(&Qw[(long)r32*QP+d0*16+hi*8]);
  float mhat=0.f,l_reg=0.f;f32x16 o[2];o[0]=f32x16{};o[1]=f32x16{};f32x16 negm=f32x16{};asm volatile("":"+v"(negm));
  const int qabs=q0+wid*QBLK+r32;
  #define CMASK(P0,P1,t) do{ if(MODE==1) wmask(P0,P1,(t),kbase,qabs,hi); }while(0)
  bool resc=false;
  #define START(P0,P1) do{ const float rm=rowmax(P0,P1); resc=false; \
    { const float dl=rm; mhat=fadd_s(mhat,dl); \
      _Pragma("unroll") for(int r=0;r<16;++r){P0[r]=fsub_s(P0[r],dl);P1[r]=fsub_s(P1[r],dl);} \
      _Pragma("unroll") for(int r=0;r<16;++r)negm[r]=-mhat; asm volatile("":"+v"(negm)); } \
    _Pragma("unroll") for(int r=0;r<16;++r)P0[r]=__builtin_amdgcn_exp2f(P0[r]); }while(0)
  #define RESC() do{ if(resc){ asm volatile("s_waitcnt lgkmcnt(0)":::"memory"); \
      _Pragma("unroll") for(int d_=0;d_<2;++d_) _Pragma("unroll") for(int r=0;r<16;++r)o[d_][r]*=wsf[crow(r,hi)]; } }while(0)
  f32x16 pA0,pA1,pB0,pB1;
  int sl_prev=0,sl_cur=0,sl_next=SLOTB;
  #define ROT() do{sl_prev=sl_cur;sl_cur=sl_next;sl_next=(sl_next==(NSLOT-1)*SLOTB)?0:sl_next+SLOTB;}while(0)
  DMA_K(2,2*SLOTB);
  WAIT_BAR(3);
  qkt(pA0,pA1,Kbase,qr,negm,r32,hi);asm volatile("s_nop 15\n\ts_nop 7":"+v"(pA0),"+v"(pA1));CMASK(pA0,pA1,0);
  START(pA0,pA1);
  _Pragma("unroll") for(int r=0;r<16;++r)pA1[r]=__builtin_amdgcn_exp2f(pA1[r]);
  WAIT_BAR(0);
  DMA_K(3,0);DMA_V(1,SLOTB);
  ROT();
  kload8(kf,kp0+sl_cur);
  WAIT_BAR(2);
  s16x4 vlo[8],vhi[8]; u32x4 pw0,pw1,pw2,pw3;
  #define PKW(P,B) cvtpk_s(P[B],P[B+1])
  #define PAF(k) __builtin_bit_cast(bf16x8,pw##k)
  #define VFR(i) (bf16x8){vlo[i][0],vlo[i][1],vlo[i][2],vlo[i][3],vhi[i][0],vhi[i][1],vhi[i][2],vhi[i][3]}
  #define PIN(x) asm volatile("":"+v"(x))
  #define MX3(a,b,c) __builtin_fmaxf(__builtin_fmaxf((a),(b)),(c))
  #define GAPA(MF,A0,A1,A2,A3,W0,W1,PW) do{ MF; sacc+=A0; sacc+=A1; sacc+=A2; sacc+=A3; PIN(sacc); W0; W1; PIN(PW); SBAR(); }while(0)
  #define EX(v) __builtin_amdgcn_exp2f(v)
  #define GAPB(MF,X,B) do{ MF; X[B]=EX(X[B]); X[B+1]=EX(X[B+1]); X[B+2]=EX(X[B+2]); X[B+3]=EX(X[B+3]); PIN(X); SBAR(); }while(0)
  #define VRD(i) do{ vlo[i]=vtr(vp_+(((i)>>2)*4096+((i)&3)*1024)); vhi[i]=vtr(vp_+(((i)>>2)*4096+((i)&3)*1024+512)); }while(0)
  #define KRD(G,j) do{ if(G){ kload2(kf,kp0+sl_next,j); SBAR(); } }while(0)
  #define STEP(C0,C1,P0,P1,t,GK,GV,GL) do{ SBAR(); \
    const lds_cptr vp_=vp0+sl_prev; \
    VRD(0); SBAR(); float sacc=(P0[0]+P0[1]); \
    GAPA(C0=__builtin_amdgcn_mfma_f32_32x32x16_bf16(kf[0],qr[0],negm,0,0,0), P0[2],P0[3],P0[4],P0[5],     pw0[0]=PKW(P0,0), pw0[1]=PKW(P0,2), pw0); \
    VRD(4); SBAR(); GAPA(C1=__builtin_amdgcn_mfma_f32_32x32x16_bf16(kf[1],qr[0],negm,0,0,0), P0[6],P0[7],P0[8],P0[9],     pw0[2]=PKW(P0,4), pw0[3]=PKW(P0,6), pw0); \
    VRD(1); SBAR(); GAPA(C0=__builtin_amdgcn_mfma_f32_32x32x16_bf16(kf[2],qr[1],C0,0,0,0),   P0[10],P0[11],P0[12],P0[13], pw1[0]=PKW(P0,8), pw1[1]=PKW(P0,10), pw1); \
    VRD(5); SBAR(); GAPA(C1=__builtin_amdgcn_mfma_f32_32x32x16_bf16(kf[3],qr[1],C1,0,0,0),   P0[14],P0[15],P1[0],P1[1],   pw1[2]=PKW(P0,12),pw1[3]=PKW(P0,14), pw1); \
    VRD(2); SBAR(); GAPA(C0=__builtin_amdgcn_mfma_f32_32x32x16_bf16(kf[4],qr[2],C0,0,0,0),   P1[2],P1[3],P1[4],P1[5],     pw2[0]=PKW(P1,0), pw2[1]=PKW(P1,2), pw2); \
    VRD(6); SBAR(); GAPA(C1=__builtin_amdgcn_mfma_f32_32x32x16_bf16(kf[5],qr[2],C1,0,0,0),   P1[6],P1[7],P1[8],P1[9],     pw2[2]=PKW(P1,4), pw2[3]=PKW(P1,6), pw2); \
    VRD(3); SBAR(); GAPA(C0=__builtin_amdgcn_mfma_f32_32x32x16_bf16(kf[6],qr[3],C0,0,0,0),   P1[10],P1[11],P1[12],P1[13], pw3[0]=PKW(P1,8), pw3[1]=PKW(P1,10), pw3); \
    VRD(7); SBAR(); GAPA(C1=__builtin_amdgcn_mfma_f32_32x32x16_bf16(kf[7],qr[3],C1,0,0,0),   P1[14],P1[15],0.f,0.f,       pw3[2]=PKW(P1,12),pw3[3]=PKW(P1,14), pw3); \
    l_reg+=sacc; \
    if(GK){DMA_K((t)+3,sl_cur);} if(GV){DMA_V((t)+1,sl_next);} \
    CMASK(C0,C1,t); \
    { float a=MX3(C0[0],C0[1],C1[0]),b=MX3(C0[2],C0[3],C1[1]); a=MX3(a,C1[2],C1[3]); \
      _Pragma("unroll") for(int r=4;r<16;r+=4){a=MX3(a,C0[r],C0[r+1]);b=MX3(b,C0[r+2],C0[r+3]);a=MX3(a,C1[r],C1[r+1]);b=MX3(b,C1[r+2],C1[r+3]);} \
      float rm=__builtin_fmaxf(a,b); { auto rr=__builtin_amdgcn_permlane32_swap(__float_as_uint(rm),__float_as_uint(rm),false,false); rm=__builtin_fmaxf(__uint_as_float(rr[0]),__uint_as_float(rr[1])); } \
      resc=false; \
      if(__builtin_expect(__any(rm>(float)THRL),0)){ const float dl=__builtin_fmaxf(rm,0.f); mhat+=dl; \
        _Pragma("unroll") for(int r=0;r<16;++r){C0[r]-=dl;C1[r]-=dl;} \
        _Pragma("unroll") for(int r=0;r<16;++r)negm[r]=-mhat; asm volatile("":"+v"(negm)); \
        const float f=__builtin_amdgcn_exp2f(-dl); l_reg*=f; if(hi==0)wsf[r32]=f; resc=true; } } \
    SBAR(); \
    GAPB(o[0]=__builtin_amdgcn_mfma_f32_32x32x16_bf16(PAF(0),VFR(0),o[0],0,0,0), C0,0); \
    GAPB(o[1]=__builtin_amdgcn_mfma_f32_32x32x16_bf16(PAF(0),VFR(4),o[1],0,0,0), C0,4); \
    KRD(GL,0); GAPB(o[0]=__builtin_amdgcn_mfma_f32_32x32x16_bf16(PAF(1),VFR(1),o[0],0,0,0), C0,8); \
    KRD(GL,1); GAPB(o[1]=__builtin_amdgcn_mfma_f32_32x32x16_bf16(PAF(1),VFR(5),o[1],0,0,0), C0,12); \
    KRD(GL,2); GAPB(o[0]=__builtin_amdgcn_mfma_f32_32x32x16_bf16(PAF(2),VFR(2),o[0],0,0,0), C1,0); \
    KRD(GL,3); GAPB(o[1]=__builtin_amdgcn_mfma_f32_32x32x16_bf16(PAF(2),VFR(6),o[1],0,0,0), C1,4); \
    GAPB(o[0]=__builtin_amdgcn_mfma_f32_32x32x16_bf16(PAF(3),VFR(3),o[0],0,0,0), C1,8); \
    GAPB(o[1]=__builtin_amdgcn_mfma_f32_32x32x16_bf16(PAF(3),VFR(7),o[1],0,0,0), C1,12); \
    }while(0)
  int t=1;
  #undef CMASK
  #define CMASK(P0,P1,t) do{}while(0)
  if constexpr(MODE==0)
  for(;t+5<NT;t+=2){
    STEP(pB0,pB1,pA0,pA1,t,true,true,true);     WAIT_BAR(2); RESC(); ROT();
    STEP(pA0,pA1,pB0,pB1,t+1,true,true,true);   WAIT_BAR(2); RESC(); ROT();
  }
  #undef CMASK
  #define CMASK(P0,P1,t) do{ if(MODE==1) wmask(P0,P1,(t),kbase,qabs,hi); }while(0)
  #define ENDW(tt) do{ if((tt)+3<NT){WAIT_BAR(2);} else if((tt)+2<NT){WAIT_BAR(1);} else {WAIT_BAR(0);} }while(0)
  for(;t+1<NT;t+=2){
    STEP(pB0,pB1,pA0,pA1,t,(t+3<NT),(t+1<NT),(t+1<NT));       ENDW(t);   RESC(); ROT();
    STEP(pA0,pA1,pB0,pB1,t+1,(t+4<NT),(t+2<NT),(t+2<NT));     ENDW(t+1); RESC(); ROT();
  }
  STEP(pB0,pB1,pA0,pA1,NT-1,false,false,false); RESC();
  { float sacc=pB0[0]+pB0[1]; _Pragma("unroll") for(int r=2;r<16;++r)sacc+=pB0[r]; _Pragma("unroll") for(int r=0;r<16;++r)sacc+=pB1[r]; l_reg+=sacc;
    pw0=(u32x4){PKW(pB0,0),PKW(pB0,2),PKW(pB0,4),PKW(pB0,6)};pw1=(u32x4){PKW(pB0,8),PKW(pB0,10),PKW(pB0,12),PKW(pB0,14)};pw2=(u32x4){PKW(pB1,0),PKW(pB1,2),PKW(pB1,4),PKW(pB1,6)};pw3=(u32x4){PKW(pB1,8),PKW(pB1,10),PKW(pB1,12),PKW(pB1,14)};
    SBAR(); pv(o,vb0+sl_cur,PAF(0),PAF(1),PAF(2),PAF(3)); }
  #undef PKW
  #undef PAF
  #undef VFR
  #undef PIN
  #undef MX3
  #undef GAPA
  #undef GAPB
  #undef EX
  #undef VRD
  #undef KRD
  #undef STEP
  #undef ENDW
  {auto rr=__builtin_amdgcn_permlane32_swap(__float_as_uint(l_reg),__float_as_uint(l_reg),false,false);l_reg=__uint_as_float(rr[0])+__uint_as_float(rr[1]);}
  if(MODE==1)l_reg+=__builtin_amdgcn_exp2f(sink_l2-mhat);
  if(hi==0)wsf[32+r32]=l_reg;asm volatile("s_waitcnt lgkmcnt(0)":::"memory");
  float rli[16];
  #pragma unroll
  for(int r=0;r<16;++r)rli[r]=__builtin_amdgcn_rcpf(wsf[32+crow(r,hi)]);
  bf16*Ow=O+(long)(q0+wid*QBLK)*QP+h*D;
  { bf16*stg=(bf16*)(shm+LDS_OST)+wid*2048;
    #pragma unroll
    for(int r=0;r<16;++r){const int orow=crow(r,hi);
      #pragma unroll
      for(int d0=0;d0<2;++d0)stg[orow*64+d0*32+r32]=__float2bfloat16(o[d0][r]*rli[r]);}
    asm volatile("s_waitcnt lgkmcnt(0)":::"memory");
    #pragma unroll
    for(int i=0;i<4;++i){const int row=i*8+(lane>>3),ch=lane&7; const u32x4 v=*(const u32x4*)(stg+row*64+ch*8); ATTN_STORE16(Ow+(long)row*QP+ch*8,v);} }
  asm volatile("s_waitcnt lgkmcnt(0)\n\ts_barrier":::"memory");
  #undef DMA_K
  #undef DMA_V
  #undef CMASK
  #undef TROW
  #undef START
  #undef RESC
  #undef ROT
}
template<int KP> __device__ __forceinline__ void attn_unit_s(int h,int kvh,int q0,int NT,int kbase,float mstat,const bf16*Q,const bf16*__restrict__ K,const bf16*__restrict__ V,bf16*O,char*shm){
  int tid_=threadIdx.x; asm volatile("":"+v"(tid_)); const int tid=tid_,lane=tid&63,r32=lane&31,hi=lane>>5; const int wid=__builtin_amdgcn_readfirstlane(tid>>6);
  #define TROW(t) (kbase+64*(t))
  const bf16*Qw=Q+(long)(q0+wid*QBLK)*QP+h*D;
  const bf16*Kh=K+kvh*D,*Vh=V+kvh*D;
  const unsigned lds0=(unsigned)(uintptr_t)shm;
  float*wsf=(float*)(shm+LDS_WS)+wid*64;
  const bf16*ksrc=Kh+(long)lane*KP+wid*8;
  const bf16*vsrc=Vh+(long)(16*(wid&3)+(lane>>2))*KP+(wid>>2)*32+(lane&3)*8;
  const unsigned kdst=lds0+LDS_K+wid*1024, vdst=lds0+LDS_V+wid*1024;
  #define DMA_K(t,slot) glds16(ksrc+(long)TROW(t)*KP,(unsigned)__builtin_amdgcn_readfirstlane(kdst+(slot)))
  #define DMA_V(t,slot) glds16(vsrc+(long)TROW(t)*KP,(unsigned)__builtin_amdgcn_readfirstlane(vdst+(slot)))
  const int vb0=(int)(lds0+LDS_V)+((lane>>4)&1)*32+(lane&3)*8+(4*hi+((lane&15)>>2))*64;
  const char*Kbase=shm+LDS_K; bf16x8 kf[8];
  const lds_cptr shm3=(lds_cptr)shm; const lds_cptr kp0=shm3+LDS_K+hi*1024+r32*16; const lds_cptr vp0=shm3+LDS_V+((lane>>4)&1)*32+(lane&3)*8+(4*hi+((lane&15)>>2))*64;
  DMA_K(0,0);DMA_V(0,0);DMA_K(1,SLOTB);
  bf16x8 qr[4];
  #pragma unroll
  for(int d0=0;d0<4;++d0)qr[d0]=*reinterpret_cast<const bf16x8*>(&Qw[(long)r32*QP+d0*16+hi*8]);
  float l_reg=0.f;f32x16 o[2];o[0]=f32x16{};o[1]=f32x16{};f32x16 negm;
  #pragma unroll
  for(int r=0;r<16;++r)negm[r]=-mstat;
  asm volatile("":"+v"(negm));
  #define CMASK(P0,P1,t) do{}while(0)
  #define START(P0,P1) do{ _Pragma("unroll") for(int r=0;r<16;++r)P0[r]=__builtin_amdgcn_exp2f(P0[r]); }while(0)
  #define RESC() do{}while(0)
  f32x16 pA0,pA1,pB0,pB1;
  int sl_prev=0,sl_cur=0,sl_next=SLOTB;
  #define ROT() do{sl_prev=sl_cur;sl_cur=sl_next;sl_next=(sl_next==(NSLOT-1)*SLOTB)?0:sl_next+SLOTB;}while(0)
  DMA_K(2,2*SLOTB);
  WAIT_BAR(3);
  qkt(pA0,pA1,Kbase,qr,negm,r32,hi);asm volatile("s_nop 15\n\ts_nop 7":"+v"(pA0),"+v"(pA1));CMASK(pA0,pA1,0);
  START(pA0,pA1);
  _Pragma("unroll") for(int r=0;r<16;++r)pA1[r]=__builtin_amdgcn_exp2f(pA1[r]);
  WAIT_BAR(0);
  DMA_K(3,0);DMA_V(1,SLOTB);
  ROT();
  kload8(kf,kp0+sl_cur);
  WAIT_BAR(2);
  s16x4 vlo[8],vhi[8]; u32x4 pw0,pw1,pw2,pw3;
  #define PKW(P,B) cvtpk_s(P[B],P[B+1])
  #define PAF(k) __builtin_bit_cast(bf16x8,pw##k)
  #define VFR(i) (bf16x8){vlo[i][0],vlo[i][1],vlo[i][2],vlo[i][3],vhi[i][0],vhi[i][1],vhi[i][2],vhi[i][3]}
  #define PIN(x) asm volatile("":"+v"(x))
  #define MX3(a,b,c) __builtin_fmaxf(__builtin_fmaxf((a),(b)),(c))
  #define GAPA(MF,A0,A1,A2,A3,W0,W1,PW) do{ MF; sacc+=A0; sacc+=A1; sacc+=A2; sacc+=A3; PIN(sacc); W0; W1; PIN(PW); SBAR(); }while(0)
  #define EX(v) __builtin_amdgcn_exp2f(v)
  #define GAPB(MF,X,B) do{ MF; X[B]=EX(X[B]); X[B+1]=EX(X[B+1]); X[B+2]=EX(X[B+2]); X[B+3]=EX(X[B+3]); PIN(X); SBAR(); }while(0)
  #define VRD(i) do{ vlo[i]=vtr(vp_+(((i)>>2)*4096+((i)&3)*1024)); vhi[i]=vtr(vp_+(((i)>>2)*4096+((i)&3)*1024+512)); }while(0)
  #define KRD(G,j) do{ if(G){ kload2(kf,kp0+sl_next,j); SBAR(); } }while(0)
  #define STEP(C0,C1,P0,P1,t,GK,GV,GL) do{ SBAR(); \
    const lds_cptr vp_=vp0+sl_prev; \
    VRD(0); SBAR(); float sacc=(P0[0]+P0[1]); \
    GAPA(C0=__builtin_amdgcn_mfma_f32_32x32x16_bf16(kf[0],qr[0],negm,0,0,0), P0[2],P0[3],P0[4],P0[5],     pw0[0]=PKW(P0,0), pw0[1]=PKW(P0,2), pw0); \
    VRD(4); SBAR(); GAPA(C1=__builtin_amdgcn_mfma_f32_32x32x16_bf16(kf[1],qr[0],negm,0,0,0), P0[6],P0[7],P0[8],P0[9],     pw0[2]=PKW(P0,4), pw0[3]=PKW(P0,6), pw0); \
    VRD(1); SBAR(); GAPA(C0=__builtin_amdgcn_mfma_f32_32x32x16_bf16(kf[2],qr[1],C0,0,0,0),   P0[10],P0[11],P0[12],P0[13], pw1[0]=PKW(P0,8), pw1[1]=PKW(P0,10), pw1); \
    VRD(5); SBAR(); GAPA(C1=__builtin_amdgcn_mfma_f32_32x32x16_bf16(kf[3],qr[1],C1,0,0,0),   P0[14],P0[15],P1[0],P1[1],   pw1[2]=PKW(P0,12),pw1[3]=PKW(P0,14), pw1); \
    VRD(2); SBAR(); GAPA(C0=__builtin_amdgcn_mfma_f32_32x32x16_bf16(kf[4],qr[2],C0,0,0,0),   P1[2],P1[3],P1[4],P1[5],     pw2[0]=PKW(P1,0), pw2[1]=PKW(P1,2), pw2); \
    VRD(6); SBAR(); GAPA(C1=__builtin_amdgcn_mfma_f32_32x32x16_bf16(kf[5],qr[2],C1,0,0,0),   P1[6],P1[7],P1[8],P1[9],     pw2[2]=PKW(P1,4), pw2[3]=PKW(P1,6), pw2); \
    VRD(3); SBAR(); GAPA(C0=__builtin_amdgcn_mfma_f32_32x32x16_bf16(kf[6],qr[3],C0,0,0,0),   P1[10],P1[11],P1[12],P1[13], pw3[0]=PKW(P1,8), pw3[1]=PKW(P1,10), pw3); \
    VRD(7); SBAR(); GAPA(C1=__builtin_amdgcn_mfma_f32_32x32x16_bf16(kf[7],qr[3],C1,0,0,0),   P1[14],P1[15],0.f,0.f,       pw3[2]=PKW(P1,12),pw3[3]=PKW(P1,14), pw3); \
    l_reg+=sacc; \
    if(GK){DMA_K((t)+3,sl_cur);} if(GV){DMA_V((t)+1,sl_next);} \
    SBAR(); \
    GAPB(o[0]=__builtin_amdgcn_mfma_f32_32x32x16_bf16(PAF(0),VFR(0),o[0],0,0,0), C0,0); \
    GAPB(o[1]=__builtin_amdgcn_mfma_f32_32x32x16_bf16(PAF(0),VFR(4),o[1],0,0,0), C0,4); \
    KRD(GL,0); GAPB(o[0]=__builtin_amdgcn_mfma_f32_32x32x16_bf16(PAF(1),VFR(1),o[0],0,0,0), C0,8); \
    KRD(GL,1); GAPB(o[1]=__builtin_amdgcn_mfma_f32_32x32x16_bf16(PAF(1),VFR(5),o[1],0,0,0), C0,12); \
    KRD(GL,2); GAPB(o[0]=__builtin_amdgcn_mfma_f32_32x32x16_bf16(PAF(2),VFR(2),o[0],0,0,0), C1,0); \
    KRD(GL,3); GAPB(o[1]=__builtin_amdgcn_mfma_f32_32x32x16_bf16(PAF(2),VFR(6),o[1],0,0,0), C1,4); \
    GAPB(o[0]=__builtin_amdgcn_mfma_f32_32x32x16_bf16(PAF(3),VFR(3),o[0],0,0,0), C1,8); \
    GAPB(o[1]=__builtin_amdgcn_mfma_f32_32x32x16_bf16(PAF(3),VFR(7),o[1],0,0,0), C1,12); \
    }while(0)
  int t=1;
  #undef CMASK
  #define CMASK(P0,P1,t) do{}while(0)
  for(;t+5<NT;t+=2){
    STEP(pB0,pB1,pA0,pA1,t,true,true,true);     WAIT_BAR(2); RESC(); ROT();
    STEP(pA0,pA1,pB0,pB1,t+1,true,true,true);   WAIT_BAR(2); RESC(); ROT();
  }
  #undef CMASK
  #define CMASK(P0,P1,t) do{}while(0)
  #define ENDW(tt) do{ if((tt)+3<NT){WAIT_BAR(2);} else if((tt)+2<NT){WAIT_BAR(1);} else {WAIT_BAR(0);} }while(0)
  for(;t+1<NT;t+=2){
    STEP(pB0,pB1,pA0,pA1,t,(t+3<NT),(t+1<NT),(t+1<NT));       ENDW(t);   RESC(); ROT();
    STEP(pA0,pA1,pB0,pB1,t+1,(t+4<NT),(t+2<NT),(t+2<NT));     ENDW(t+1); RESC(); ROT();
  }
  STEP(pB0,pB1,pA0,pA1,NT-1,false,false,false); RESC();
  { float sacc=pB0[0]+pB0[1]; _Pragma("unroll") for(int r=2;r<16;++r)sacc+=pB0[r]; _Pragma("unroll") for(int r=0;r<16;++r)sacc+=pB1[r]; l_reg+=sacc;
    pw0=(u32x4){PKW(pB0,0),PKW(pB0,2),PKW(pB0,4),PKW(pB0,6)};pw1=(u32x4){PKW(pB0,8),PKW(pB0,10),PKW(pB0,12),PKW(pB0,14)};pw2=(u32x4){PKW(pB1,0),PKW(pB1,2),PKW(pB1,4),PKW(pB1,6)};pw3=(u32x4){PKW(pB1,8),PKW(pB1,10),PKW(pB1,12),PKW(pB1,14)};
    SBAR(); pv(o,vb0+sl_cur,PAF(0),PAF(1),PAF(2),PAF(3)); }
  #undef PKW
  #undef PAF
  #undef VFR
  #undef PIN
  #undef MX3
  #undef GAPA
  #undef GAPB
  #undef EX
  #undef VRD
  #undef KRD
  #undef STEP
  #undef ENDW
  {auto rr=__builtin_amdgcn_permlane32_swap(__float_as_uint(l_reg),__float_as_uint(l_reg),false,false);l_reg=__uint_as_float(rr[0])+__uint_as_float(rr[1]);}
  if(hi==0)wsf[32+r32]=l_reg;asm volatile("s_waitcnt lgkmcnt(0)":::"memory");
  float rli[16];
  #pragma unroll
  for(int r=0;r<16;++r)rli[r]=__builtin_amdgcn_rcpf(wsf[32+crow(r,hi)]);
  bf16*Ow=O+(long)(q0+wid*QBLK)*QP+h*D;
  { bf16*stg=(bf16*)(shm+LDS_OST)+wid*2048;
    #pragma unroll
    for(int r=0;r<16;++r){const int orow=crow(r,hi);
      #pragma unroll
      for(int d0=0;d0<2;++d0)stg[orow*64+d0*32+r32]=__float2bfloat16(o[d0][r]*rli[r]);}
    asm volatile("s_waitcnt lgkmcnt(0)":::"memory");
    #pragma unroll
    for(int i=0;i<4;++i){const int row=i*8+(lane>>3),ch=lane&7; const u32x4 v=*(const u32x4*)(stg+row*64+ch*8); ATTN_STORE16(Ow+(long)row*QP+ch*8,v);} }
  asm volatile("s_waitcnt lgkmcnt(0)\n\ts_barrier":::"memory");
  #undef DMA_K
  #undef DMA_V
  #undef CMASK
  #undef TROW
  #undef START
  #undef RESC
  #undef ROT
}
template<int KP> __device__ __forceinline__ void attn_unit_q8(int h,int kvh,int q0,int NT,int kbase,float mstat,const unsigned char*Q8,const unsigned char*__restrict__ K8,const bf16*__restrict__ V,bf16*O,char*shm){
  int tid_=threadIdx.x; asm volatile("":"+v"(tid_)); const int tid=tid_,lane=tid&63,r32=lane&31,hi=lane>>5; const int wid=__builtin_amdgcn_readfirstlane(tid>>6);
  #define TROW(t) (kbase+64*(t))
  const unsigned char*Qw=Q8+(long)(q0+wid*QBLK)*QP+h*D;
  const unsigned char*Kh=K8+kvh*D; const bf16*Vh=V+kvh*D;
  const unsigned lds0=(unsigned)(uintptr_t)shm;
  float*wsf=(float*)(shm+LDS_WS)+wid*64;
  const unsigned char*ksrc=Kh+(long)lane*KP+(wid&3)*16;
  const bf16*vsrc=Vh+(long)(16*(wid&3)+(lane>>2))*KP+(wid>>2)*32+(lane&3)*8;
  const unsigned kdst=lds0+LDS_K+(wid&3)*1024, vdst=lds0+LDS_V+wid*1024;
  #define DMA_K(t,slot) glds16(ksrc+(long)TROW(t)*KP,(unsigned)__builtin_amdgcn_readfirstlane(kdst+(slot)))
  #define DMA_V(t,slot) glds16(vsrc+(long)TROW(t)*KP,(unsigned)__builtin_amdgcn_readfirstlane(vdst+(slot)))
  const int vb0=(int)(lds0+LDS_V)+((lane>>4)&1)*32+(lane&3)*8+(4*hi+((lane&15)>>2))*64;
  typedef int v8i_t __attribute__((ext_vector_type(8))); typedef int v4i_t __attribute__((ext_vector_type(4))); typedef __attribute__((address_space(3))) const v4i_t* lds_v4p;
  v8i_t kf8[2];
  const int f8sc=0x7F7F7F7F;
  const lds_cptr shm3=(lds_cptr)shm; const lds_cptr kp0=shm3+LDS_K+hi*2048+r32*16; const lds_cptr vp0=shm3+LDS_V+((lane>>4)&1)*32+(lane&3)*8+(4*hi+((lane&15)>>2))*64;
  DMA_K(0,0);DMA_V(0,0);DMA_K(1,SLOTB);
  v8i_t q8; { const v4i_t qa=*reinterpret_cast<const v4i_t*>(Qw+(long)r32*QP+32*hi), qb=*reinterpret_cast<const v4i_t*>(Qw+(long)r32*QP+32*hi+16); q8=__builtin_shufflevector(qa,qb,0,1,2,3,4,5,6,7); }
  #define KLD(j,kp) do{ const v4i_t a_=*(lds_v4p)((kp)+(j)*512), b_=*(lds_v4p)((kp)+(j)*512+1024); kf8[j]=__builtin_shufflevector(a_,b_,0,1,2,3,4,5,6,7); }while(0)
  #define QKMF(C,j) asm volatile("v_mfma_scale_f32_32x32x64_f8f6f4 %0, %1, %2, %3, %4, %4 op_sel_hi:[0,0,0]":"=&v"(C):"v"(kf8[j]),"v"(q8),"v"(negm),"v"(f8sc))
  float l_reg=0.f;f32x16 o[2];o[0]=f32x16{};o[1]=f32x16{};f32x16 negm;
  #pragma unroll
  for(int r=0;r<16;++r)negm[r]=-mstat;
  asm volatile("":"+v"(negm));
  #define CMASK(P0,P1,t) do{}while(0)
  #define START(P0,P1) do{ _Pragma("unroll") for(int r=0;r<16;++r)P0[r]=__builtin_amdgcn_exp2f(P0[r]); }while(0)
  #define RESC() do{}while(0)
  f32x16 pA0,pA1,pB0,pB1;
  int sl_prev=0,sl_cur=0,sl_next=SLOTB;
  #define ROT() do{sl_prev=sl_cur;sl_cur=sl_next;sl_next=(sl_next==(NSLOT-1)*SLOTB)?0:sl_next+SLOTB;}while(0)
  DMA_K(2,2*SLOTB);
  WAIT_BAR(3);
  KLD(0,kp0);KLD(1,kp0);QKMF(pA0,0);QKMF(pA1,1);asm volatile("s_nop 15\n\ts_nop 15\n\ts_nop 15\n\ts_nop 15\n\ts_nop 15":"+v"(pA0),"+v"(pA1));
  START(pA0,pA1);
  _Pragma("unroll") for(int r=0;r<16;++r)pA1[r]=__builtin_amdgcn_exp2f(pA1[r]);
  WAIT_BAR(0);
  DMA_K(3,0);DMA_V(1,SLOTB);
  ROT();
  KLD(0,kp0+sl_cur);KLD(1,kp0+sl_cur);
  WAIT_BAR(2);
  s16x4 vlo[8],vhi[8]; u32x4 pw0,pw1,pw2,pw3;
  #define PKW(P,B) cvtpk_s(P[B],P[B+1])
  #define PAF(k) __builtin_bit_cast(bf16x8,pw##k)
  #define VFR(i) (bf16x8){vlo[i][0],vlo[i][1],vlo[i][2],vlo[i][3],vhi[i][0],vhi[i][1],vhi[i][2],vhi[i][3]}
  #define PIN(x) asm volatile("":"+v"(x))
  #define MX3(a,b,c) __builtin_fmaxf(__builtin_fmaxf((a),(b)),(c))
  #define GAPA(MF,A0,A1,A2,A3,W0,W1,PW) do{ MF; sacc+=A0; sacc+=A1; sacc+=A2; sacc+=A3; PIN(sacc); W0; W1; PIN(PW); SBAR(); }while(0)
  #define EX(v) __builtin_amdgcn_exp2f(v)
  #define GAPB(MF,X,B) do{ MF; X[B]=EX(X[B]); X[B+1]=EX(X[B+1]); X[B+2]=EX(X[B+2]); X[B+3]=EX(X[B+3]); PIN(X); SBAR(); }while(0)
  #define VRD(i) do{ vlo[i]=vtr(vp_+(((i)>>2)*4096+((i)&3)*1024)); vhi[i]=vtr(vp_+(((i)>>2)*4096+((i)&3)*1024+512)); }while(0)
  #define KRD(G,j) do{ if((G)&&(j)<2){ KLD(j,kp0+sl_next); SBAR(); } }while(0)
  #define STEP(C0,C1,P0,P1,t,GK,GV,GL) do{ SBAR(); \
    const lds_cptr vp_=vp0+sl_prev; \
    VRD(0); SBAR(); float sacc=(P0[0]+P0[1]); \
    GAPA(QKMF(C0,0), P0[2],P0[3],P0[4],P0[5],     pw0[0]=PKW(P0,0), pw0[1]=PKW(P0,2), pw0); \
    VRD(4); SBAR(); GAPA(QKMF(C1,1), P0[6],P0[7],P0[8],P0[9],     pw0[2]=PKW(P0,4), pw0[3]=PKW(P0,6), pw0); \
    VRD(1); SBAR(); GAPA((void)0, P0[10],P0[11],P0[12],P0[13], pw1[0]=PKW(P0,8), pw1[1]=PKW(P0,10), pw1); \
    VRD(5); SBAR(); GAPA((void)0, P0[14],P0[15],P1[0],P1[1],   pw1[2]=PKW(P0,12),pw1[3]=PKW(P0,14), pw1); \
    VRD(2); SBAR(); GAPA((void)0, P1[2],P1[3],P1[4],P1[5],     pw2[0]=PKW(P1,0), pw2[1]=PKW(P1,2), pw2); \
    VRD(6); SBAR(); GAPA((void)0, P1[6],P1[7],P1[8],P1[9],     pw2[2]=PKW(P1,4), pw2[3]=PKW(P1,6), pw2); \
    VRD(3); SBAR(); GAPA((void)0, P1[10],P1[11],P1[12],P1[13], pw3[0]=PKW(P1,8), pw3[1]=PKW(P1,10), pw3); \
    VRD(7); SBAR(); GAPA((void)0, P1[14],P1[15],0.f,0.f,       pw3[2]=PKW(P1,12),pw3[3]=PKW(P1,14), pw3); \
    l_reg+=sacc; \
    if(GK){DMA_K((t)+3,sl_cur);} if(GV){DMA_V((t)+1,sl_next);} \
    SBAR(); \
    GAPB(o[0]=__builtin_amdgcn_mfma_f32_32x32x16_bf16(PAF(0),VFR(0),o[0],0,0,0), C0,0); \
    GAPB(o[1]=__builtin_amdgcn_mfma_f32_32x32x16_bf16(PAF(0),VFR(4),o[1],0,0,0), C0,4); \
    KRD(GL,0); GAPB(o[0]=__builtin_amdgcn_mfma_f32_32x32x16_bf16(PAF(1),VFR(1),o[0],0,0,0), C0,8); \
    KRD(GL,1); GAPB(o[1]=__builtin_amdgcn_mfma_f32_32x32x16_bf16(PAF(1),VFR(5),o[1],0,0,0), C0,12); \
    KRD(GL,2); GAPB(o[0]=__builtin_amdgcn_mfma_f32_32x32x16_bf16(PAF(2),VFR(2),o[0],0,0,0), C1,0); \
    KRD(GL,3); GAPB(o[1]=__builtin_amdgcn_mfma_f32_32x32x16_bf16(PAF(2),VFR(6),o[1],0,0,0), C1,4); \
    GAPB(o[0]=__builtin_amdgcn_mfma_f32_32x32x16_bf16(PAF(3),VFR(3),o[0],0,0,0), C1,8); \
    GAPB(o[1]=__builtin_amdgcn_mfma_f32_32x32x16_bf16(PAF(3),VFR(7),o[1],0,0,0), C1,12); \
    }while(0)
  int t=1;
  #undef CMASK
  #define CMASK(P0,P1,t) do{}while(0)
  for(;t+5<NT;t+=2){
    STEP(pB0,pB1,pA0,pA1,t,true,true,true);     WAIT_BAR(2); RESC(); ROT();
    STEP(pA0,pA1,pB0,pB1,t+1,true,true,true);   WAIT_BAR(2); RESC(); ROT();
  }
  #undef CMASK
  #define CMASK(P0,P1,t) do{}while(0)
  #define ENDW(tt) do{ if((tt)+3<NT){WAIT_BAR(2);} else if((tt)+2<NT){WAIT_BAR(1);} else {WAIT_BAR(0);} }while(0)
  for(;t+1<NT;t+=2){
    STEP(pB0,pB1,pA0,pA1,t,(t+3<NT),(t+1<NT),(t+1<NT));       ENDW(t);   RESC(); ROT();
    STEP(pA0,pA1,pB0,pB1,t+1,(t+4<NT),(t+2<NT),(t+2<NT));     ENDW(t+1); RESC(); ROT();
  }
  STEP(pB0,pB1,pA0,pA1,NT-1,false,false,false); RESC();
  { float sacc=pB0[0]+pB0[1]; _Pragma("unroll") for(int r=2;r<16;++r)sacc+=pB0[r]; _Pragma("unroll") for(int r=0;r<16;++r)sacc+=pB1[r]; l_reg+=sacc;
    pw0=(u32x4){PKW(pB0,0),PKW(pB0,2),PKW(pB0,4),PKW(pB0,6)};pw1=(u32x4){PKW(pB0,8),PKW(pB0,10),PKW(pB0,12),PKW(pB0,14)};pw2=(u32x4){PKW(pB1,0),PKW(pB1,2),PKW(pB1,4),PKW(pB1,6)};pw3=(u32x4){PKW(pB1,8),PKW(pB1,10),PKW(pB1,12),PKW(pB1,14)};
    SBAR(); pv(o,vb0+sl_cur,PAF(0),PAF(1),PAF(2),PAF(3)); }
  #undef PKW
  #undef PAF
  #undef VFR
  #undef PIN
  #undef MX3
  #undef GAPA
  #undef GAPB
  #undef EX
  #undef VRD
  #undef KRD
  #undef KLD
  #undef QKMF
  #undef STEP
  #undef ENDW
  {auto rr=__builtin_amdgcn_permlane32_swap(__float_as_uint(l_reg),__float_as_uint(l_reg),false,false);l_reg=__uint_as_float(rr[0])+__uint_as_float(rr[1]);}
  if(hi==0)wsf[32+r32]=l_reg;asm volatile("s_waitcnt lgkmcnt(0)":::"memory");
  float rli[16];
  #pragma unroll
  for(int r=0;r<16;++r)rli[r]=__builtin_amdgcn_rcpf(wsf[32+crow(r,hi)]);
  bf16*Ow=O+(long)(q0+wid*QBLK)*QP+h*D;
  { bf16*stg=(bf16*)(shm+LDS_OST)+wid*2048;
    #pragma unroll
    for(int r=0;r<16;++r){const int orow=crow(r,hi);
      #pragma unroll
      for(int d0=0;d0<2;++d0)stg[orow*64+d0*32+r32]=__float2bfloat16(o[d0][r]*rli[r]);}
    asm volatile("s_waitcnt lgkmcnt(0)":::"memory");
    #pragma unroll
    for(int i=0;i<4;++i){const int row=i*8+(lane>>3),ch=lane&7; const u32x4 v=*(const u32x4*)(stg+row*64+ch*8); ATTN_STORE16(Ow+(long)row*QP+ch*8,v);} }
  asm volatile("s_waitcnt lgkmcnt(0)\n\ts_barrier":::"memory");
  #undef DMA_K
  #undef DMA_V
  #undef CMASK
  #undef TROW
  #undef START
  #undef RESC
  #undef ROT
}
constexpr int ATTN_LDS_BYTES=LDS_BYTES;
#undef SBAR
#undef WAIT_BAR
}
#ifndef EN_MIX
#define EN_MIX 15
#endif
#ifndef EN_MOE
#define EN_MOE 15
#endif
constexpr int NWAVES = 8, NTHR = 512;
constexpr int DM = 1024, NLAT = 16384, NCTX = 256, T = NLAT + NCTX, NPAN = T / 256;
constexpr int NE = 32, TOPK = 4, EFF = 1024;
constexpr int FA_NQKV = 1536, WA_NQKV = 1280, GM_FF = 4096, GM_HALF = 2048;
constexpr float LN_EPS = 1e-5f, RMS_EPS = 1e-6f;
constexpr float DN_ALPHA = 1.6817928305074292f;
constexpr float LOG2E = 1.4426950408889634f, QSCALE = 0.125f * LOG2E;
constexpr int NPHASE = 35;

constexpr size_t MiB = 1u << 20;
constexpr size_t WS_CTL = 0, CTL_ZERO_BYTES = 64 * 1024;
constexpr size_t WS_MOD = 1 * MiB;
constexpr size_t WS_TAB = 2 * MiB;
constexpr size_t TB_FC = WS_TAB, TB_FA = TB_FC + 512 * 256 * 2, TB_FCC = TB_FA + 256 * 256 * 2, TB_FX = TB_FCC + 256 * 256 * 2, TB_TWC = TB_FX + 256 * 512 * 2,
                 TB_TWS = TB_TWC + 128 * 128 * 4, TB_ROPC = TB_TWS + 128 * 128 * 4, TB_ROPS = TB_ROPC + (size_t)NLAT * 32 * 4, TB_END = TB_ROPS + (size_t)NLAT * 32 * 4;
static_assert(TB_END <= 10 * MiB, "tables");
constexpr size_t WS_RW = 10 * MiB;
constexpr size_t WS_LCNT = 11 * MiB;
constexpr size_t WS_ASG = 12 * MiB, WS_GATE = WS_ASG + (size_t)T * 16, WS_SLOT = WS_GATE + (size_t)T * 16;
constexpr int ECAPT = 65, ECAP = ECAPT * 256;
constexpr size_t WS_STOK_OLD = WS_ASG + 1 * MiB;
static_assert(WS_SLOT + (size_t)T * 16 <= WS_STOK_OLD, "assign");
constexpr size_t WS_WFN = 16 * MiB, WS_WFAQ = WS_WFN + 2 * MiB, WS_WFAO = WS_WFAQ + 3 * MiB, WS_WGI = WS_WFAO + 2 * MiB, WS_WGO = WS_WGI + 8 * MiB,
                 WS_WWQ = WS_WGO + 4 * MiB, WS_WWO = WS_WWQ + 3 * MiB, WS_WSM_END = WS_WWO + 2 * MiB;
static_assert(WS_WSM_END <= 40 * MiB, "small weights");
constexpr size_t WS_X = 40 * MiB;
constexpr size_t WS_H = 106 * MiB;
constexpr size_t WS_Y = 140 * MiB;
constexpr size_t WS_BIG = 176 * MiB;
constexpr size_t WS_BTA = WS_BIG, WS_BTC = WS_BTA + 64 * MiB, WS_BTX = WS_BTC + 64 * MiB, WS_MIXB = WS_BTX + 1 * MiB;
constexpr size_t WS_Q = WS_BIG, WS_K = WS_Q + 33 * MiB, WS_V = WS_K + 9 * MiB, WS_O = WS_V + 9 * MiB;
constexpr size_t WS_Q8 = WS_Q + 86 * MiB, WS_K8 = WS_Q + 104 * MiB;
constexpr size_t WS_GU = WS_BIG, WS_GV = WS_GU + 65 * MiB, WS_GG = WS_GV + 65 * MiB, WS_PSTAT = WS_GG + 66 * MiB;
constexpr int MAXMT = 292; constexpr size_t SLOTROWS = (size_t)MAXMT * 256;
constexpr size_t WS_XS = WS_BIG, WS_YS = WS_XS + 292 * MiB;
constexpr size_t WS_H8 = WS_XS;
constexpr float W8_SCALE = 64.0f;
static_assert(SLOTROWS * 2048 <= 146 * MiB, "slots");
constexpr size_t WS_WEXP_GU = 640 * MiB, WS_WEXP_DN = WS_WEXP_GU + 512 * MiB, WS_X2 = WS_WEXP_DN + 256 * MiB, WS_STOK = WS_X2 + 66 * MiB  , WS_ACT = WS_STOK + 4 * MiB  , WS_END = WS_ACT + (size_t)32 * ECAP * 2048;
static_assert(WS_YS + 146 * MiB <= WS_WEXP_GU && (size_t)32 * ECAP * 4 <= 4 * MiB, "big region");
constexpr int CW_BAR = 4096;
constexpr int CW_GCNT = 8192;
constexpr int CW_TMO = 0;
constexpr int CW_MCNT = 16384, MCNT_LAYER = 320 * 64;
static_assert((CW_BAR + 3456) <= CW_GCNT && (CW_GCNT + 4 * 32 * 64) * 4 <= (int)CTL_ZERO_BYTES, "control words inside the memset region");

constexpr int RING_OFF = 0, RING_BYTES = 131072;
constexpr int PRO_SCR_BYTES = 8 * 64 * 65 * 4;
constexpr int MISC_OFF = 136 * 1024;
constexpr int LDS_BYTES = 147456;
constexpr int MW_BAR = 0, MW_LC = 8, MW_TOT = 480, MW_EBASE = 64, MW_MYBASE = 96, MW_NMT = 128, MW_CONV = 132, MW_MTE = 160;
static_assert(MISC_OFF + (MW_MTE + 304) * 4 <= LDS_BYTES && PRO_SCR_BYTES <= MISC_OFF, "LDS map");

#define GAS __attribute__((address_space(1)))
#define LAS __attribute__((address_space(3)))
typedef unsigned short bf16;
typedef unsigned v4u __attribute__((ext_vector_type(4)));
typedef unsigned v2u __attribute__((ext_vector_type(2)));
typedef float f32x4 __attribute__((ext_vector_type(4)));
typedef float f32x2 __attribute__((ext_vector_type(2)));
typedef float f32x16 __attribute__((ext_vector_type(16)));
typedef short bf16x8 __attribute__((ext_vector_type(8)));
typedef GAS unsigned gu32;
#define RLX_AGENT __ATOMIC_RELAXED, __HIP_MEMORY_SCOPE_AGENT
#define LDS_WAIT() asm volatile("s_waitcnt lgkmcnt(0)" ::: "memory")
#define VM_WAIT() asm volatile("s_waitcnt vmcnt(0)" ::: "memory")
__device__ __forceinline__ unsigned f2bf(float f) { unsigned u = __builtin_bit_cast(unsigned, f); return (u + 0x7fffu + ((u >> 16) & 1u)) >> 16; }
__device__ __forceinline__ unsigned pk2(float lo, float hi) { return f2bf(lo) | (f2bf(hi) << 16); }
__device__ __forceinline__ float bf_lo(unsigned w) { return __builtin_bit_cast(float, w << 16); }
__device__ __forceinline__ float bf_hi(unsigned w) { return __builtin_bit_cast(float, w & 0xffff0000u); }
#define XB_TMO      128
#define XB_XCNT(j)  (256  + 64 * (j))
#define XB_XSUB(j)  (1280 + 64 * (j))
#define XB_XGEN(j)  (2304 + 64 * (j))
#define XB_TOP      3328
#define XB_TOPGEN   3392
#define XCD_BAR_WORDS 3456
#define XB_SPIN_CAP (1u << 18)

__device__ __forceinline__ unsigned xb_ld(unsigned* p)              { return __hip_atomic_load(p, __ATOMIC_RELAXED, __HIP_MEMORY_SCOPE_AGENT); }
__device__ __forceinline__ unsigned xb_add(unsigned* p, unsigned v) { return __hip_atomic_fetch_add(p, v, __ATOMIC_RELAXED, __HIP_MEMORY_SCOPE_AGENT); }
__device__ __forceinline__ unsigned xb_xcc_id() { return (unsigned)__builtin_amdgcn_s_getreg((3 << 11) | 20) & 0xFu; }
#define XB_SPIN(cond, bar) do { unsigned _sp = 0; while (cond) { __builtin_amdgcn_s_sleep(1); \
    if ((++_sp & 255u) == 0u) { if (xb_ld(&(bar)[XB_TMO])) break; if (_sp > XB_SPIN_CAP) { atomicAdd(&(bar)[XB_TMO], 1u); break; } } } } while (0)

struct XcdBarrier {
    unsigned* bar; unsigned x;
    volatile LAS unsigned* st;
};

__device__ __forceinline__ XcdBarrier xcd_barrier_post(unsigned* bar, volatile LAS unsigned* st) {
    XcdBarrier b; b.bar = bar; b.x = xb_xcc_id(); b.st = st;
    if (threadIdx.x == 0) (void)xb_add(&bar[XB_XCNT(b.x)], 1u);
    return b;
}
__device__ __forceinline__ void xcd_barrier_complete(unsigned* bar, unsigned x, unsigned& nloc, unsigned& nx) {
    const unsigned G = gridDim.x * gridDim.y * gridDim.z;
    unsigned sum, cnt, mine, sp = 0u;
    for (;;) {
        sum = 0u; cnt = 0u; mine = 0u;
#pragma unroll
        for (unsigned j = 0; j < 16; ++j) { const unsigned c = xb_ld(&bar[XB_XCNT(j)]); sum += c; cnt += (c > 0u) ? 1u : 0u; mine = (j == x) ? c : mine; }
        if (sum == G) break;
        __builtin_amdgcn_s_sleep(1);
        if ((++sp & 255u) == 0u) { if (xb_ld(&bar[XB_TMO])) break; if (sp > XB_SPIN_CAP) { atomicAdd(&bar[XB_TMO], 1u); break; } }
    }
    nloc = mine > 0u ? mine : 1u; nx = cnt > 0u ? cnt : 1u;
}

__device__ __forceinline__ void xcd_barrier(const XcdBarrier& b) {
    asm volatile("s_waitcnt vmcnt(0)" ::: "memory");
    __syncthreads();
    if (threadIdx.x == 0) {
        unsigned* bar = b.bar;
        __builtin_amdgcn_s_waitcnt(0);
        unsigned nloc = b.st[0], nx = b.st[1];
        if (nloc == 0u) { xcd_barrier_complete(bar, b.x, nloc, nx); b.st[0] = nloc; b.st[1] = nx; }
        const unsigned old = xb_add(&bar[XB_XSUB(b.x)], 1u);
        const unsigned gen = old / nloc;
        if (old + 1u == (gen + 1u) * nloc) {
            __builtin_amdgcn_fence(__ATOMIC_RELEASE, "agent");
            asm volatile("s_waitcnt vmcnt(0)" ::: "memory");
            const unsigned og = xb_add(&bar[XB_TOP], 1u);
            const unsigned tg = og / nx;
            if (og + 1u == (tg + 1u) * nx) xb_add(&bar[XB_TOPGEN], 1u);
            else XB_SPIN(xb_ld(&bar[XB_TOPGEN]) == tg, bar);
            __builtin_amdgcn_fence(__ATOMIC_ACQUIRE, "agent");
            xb_add(&bar[XB_XGEN(b.x)], 1u);
            asm volatile("s_waitcnt vmcnt(0)" ::: "memory");
        } else {
            XB_SPIN(xb_ld(&bar[XB_XGEN(b.x)]) == gen, bar);
            __builtin_amdgcn_fence(__ATOMIC_ACQUIRE, "agent");
            asm volatile("s_waitcnt vmcnt(0)" ::: "memory");
        }
    }
    __syncthreads();
}
struct Frame {
    LAS unsigned char* lds;
    volatile LAS unsigned* MISC;
    gu32* ctl;
    unsigned char* ws;
    int wave, vcu, G, bx;
};
enum In { I_X = 0, I_C, I_CTX, I_CCTX, I_ADAW, I_ADAB, I_LNMG, I_LNMB, I_LNFG, I_LNFB, I_FNW, I_FNB, I_FAWQ, I_FABQ, I_FAQN, I_FAKN, I_FAWO, I_FABO,
          I_GMWI, I_GMBI, I_GMVG, I_GMVB, I_GMWS, I_GMBS, I_GMWO, I_GMBO, I_WAWQ, I_WABQ, I_WASK, I_WAWO, I_WABO, I_RW, I_RB, I_EWGU, I_EBGU, I_EWD, I_EBD, N_IN };

#define CAS __attribute__((address_space(4)))
typedef const float* cfptr_t;
__device__ __forceinline__ const float* argp(int idx) {
    unsigned long long a = (unsigned long long)__builtin_amdgcn_kernarg_segment_ptr(); asm volatile("" : "+s"(a));
    return ((const CAS cfptr_t*)a)[idx];
}
__device__ __forceinline__ int otid() { int t = threadIdx.x; asm volatile("" : "+v"(t)); return t; }
__device__ __forceinline__ float wave_sum(float v) {
#pragma unroll
    for (int o = 1; o < 64; o <<= 1) v += __shfl_xor(v, o);
    return v;
}
struct RowV { f32x4 v[4]; };
__device__ __forceinline__ RowV ldrow(const float* p, int lane) { RowV r; const f32x4* q = (const f32x4*)p + lane;
#pragma unroll
    for (int j = 0; j < 4; ++j) r.v[j] = q[64 * j]; return r; }
__device__ __forceinline__ void strow(float* p, int lane, const RowV& r) { f32x4* q = (f32x4*)p + lane;
#pragma unroll
    for (int j = 0; j < 4; ++j) q[64 * j] = r.v[j]; }
__device__ __forceinline__ void strow_bf16(bf16* p, int lane, const RowV& r) { unsigned long long* q = (unsigned long long*)p + lane;
#pragma unroll
    for (int j = 0; j < 4; ++j) q[64 * j] = (unsigned long long)pk2(r.v[j].x, r.v[j].y) | ((unsigned long long)pk2(r.v[j].z, r.v[j].w) << 32); }
__device__ __forceinline__ RowV ldrow_bf16(const bf16* p, int lane) { RowV r; const v2u* q = (const v2u*)p + lane;
#pragma unroll
    for (int j = 0; j < 4; ++j) { const v2u w = q[64 * j]; r.v[j] = (f32x4){bf_lo(w.x), bf_hi(w.x), bf_lo(w.y), bf_hi(w.y)}; } return r; }
__device__ __forceinline__ RowV ln_row(const RowV& x, const RowV& g, const RowV& b) {
    float s = 0.f;
#pragma unroll
    for (int j = 0; j < 4; ++j) s += (x.v[j].x + x.v[j].y) + (x.v[j].z + x.v[j].w);
    const float mean = wave_sum(s) * (1.f / DM); float s2 = 0.f; RowV d;
#pragma unroll
    for (int j = 0; j < 4; ++j) { d.v[j] = x.v[j] - mean; s2 += (d.v[j].x * d.v[j].x + d.v[j].y * d.v[j].y) + (d.v[j].z * d.v[j].z + d.v[j].w * d.v[j].w); }
    const float rstd = 1.f / sqrtf(wave_sum(s2) * (1.f / DM) + LN_EPS);
#pragma unroll
    for (int j = 0; j < 4; ++j) d.v[j] = d.v[j] * rstd * g.v[j] + b.v[j];
    return d;
}
__device__ __forceinline__ const float* modp(const Frame& F, int L, int s, int which) { return (const float*)(F.ws + WS_MOD) + ((size_t)(L * 2 + s) * 6 + which) * DM; }

struct TokOrder : pg8::GridOrder {
    size_t apan, bpan;
    __device__ __forceinline__ bool next(int i, pg8::Unit& u) const { u.e = 0; return next_mn(i, u.pm, u.pn); }
    __device__ __forceinline__ size_t offA(const pg8::Unit& u) const { return (size_t)u.pm * apan; }
    __device__ __forceinline__ size_t offB(const pg8::Unit& u) const { return (size_t)u.pn * bpan; }
    __device__ __forceinline__ void a_ready(const pg8::Unit&) const {}
    __device__ __forceinline__ void done(const pg8::Unit&) const {}
};
struct ChDftOrder : pg8::GridOrder {
    __device__ __forceinline__ bool next(int i, pg8::Unit& u) const { u.e = 0; return next_mn(i, u.pm, u.pn); }
    __device__ __forceinline__ size_t offA(const pg8::Unit& u) const { return (size_t)u.pm * (256 * 256 * 2); }
    __device__ __forceinline__ size_t offB(const pg8::Unit& u) const { const int g = u.pn >> 6, j = u.pn & 63; return ((size_t)(2 * j) * DM + g * 256) * 2; }
    __device__ __forceinline__ void a_ready(const pg8::Unit&) const {}
    __device__ __forceinline__ void done(const pg8::Unit&) const {}
};
struct ChDftCtxOrder : pg8::GridOrder {
    __device__ __forceinline__ bool next(int i, pg8::Unit& u) const { u.e = 0; return next_mn(i, u.pm, u.pn); }
    __device__ __forceinline__ size_t offA(const pg8::Unit& u) const { return (size_t)u.pm * (256 * 256 * 2); }
    __device__ __forceinline__ size_t offB(const pg8::Unit& u) const { return ((size_t)NLAT * DM + u.pn * 256) * 2; }
    __device__ __forceinline__ void a_ready(const pg8::Unit&) const {}
    __device__ __forceinline__ void done(const pg8::Unit&) const {}
};
struct MoeOrder : pg8::GridOrder {
    const volatile LAS unsigned* mte; size_t bexp, apan, bpan;
    __device__ __forceinline__ bool next(int i, pg8::Unit& u) const { int pl; if (!next_mn(i, pl, u.pn)) return false; u.pm = (int)mte[pl]; u.e = u.pm / ECAPT; return true; }
    __device__ __forceinline__ size_t offA(const pg8::Unit& u) const { return (size_t)u.pm * apan; }
    __device__ __forceinline__ size_t offB(const pg8::Unit& u) const { return (size_t)u.e * bexp + (size_t)u.pn * bpan; }
    __device__ __forceinline__ void a_ready(const pg8::Unit&) const {}
    __device__ __forceinline__ void done(const pg8::Unit&) const {}
};

struct MoeOrderG : pg8::GridOrder {
    const volatile LAS unsigned* mte; size_t bexp, bpan; const unsigned* stok; unsigned rowbytes;
    __device__ __forceinline__ bool next(int i, pg8::Unit& u) const { int pl; if (!next_mn(i, pl, u.pn)) return false; u.pm = (int)mte[pl]; u.e = u.pm / ECAPT; return true; }
    __device__ __forceinline__ size_t offA(const pg8::Unit&) const { return 0; }
    __device__ __forceinline__ size_t offB(const pg8::Unit& u) const { return (size_t)u.e * bexp + (size_t)u.pn * bpan; }
    __device__ __forceinline__ unsigned rowoff(const pg8::Unit& u, int row) const { return (stok[u.pm * 256 + row] >> 2) * rowbytes; }
    __device__ __forceinline__ void a_ready(const pg8::Unit&) const {}
    __device__ __forceinline__ void done(const pg8::Unit&) const {}
};

#define EPI_ARGS const pg8::f32x4 (&acc)[2][2][4][2], const pg8::Unit& u, int wr, int wc, int fr, int fq
__device__ __forceinline__ unsigned pk4f8(float a, float b, float c, float d) { int w = 0; w = __builtin_amdgcn_cvt_pk_fp8_f32(a, b, w, false); w = __builtin_amdgcn_cvt_pk_fp8_f32(c, d, w, true); return (unsigned)w; }
__device__ __forceinline__ v2u pack8f8(const f32x4& a, const f32x4& b) { v2u w; w.x = pk4f8(a[0], a[1], a[2], a[3]); w.y = pk4f8(b[0], b[1], b[2], b[3]); return w; }
__device__ __forceinline__ v4u pack8(const f32x4& a, const f32x4& b) { v4u w; w.x = pg8::cvt_pk_bf16(a[0], a[1]); w.y = pg8::cvt_pk_bf16(a[2], a[3]); w.z = pg8::cvt_pk_bf16(b[0], b[1]); w.w = pg8::cvt_pk_bf16(b[2], b[3]); return w; }

struct EpiChDft { static constexpr bool PERM = true, AFTER_DRAIN = false; bf16* O;
    __device__ __forceinline__ void operator()(EPI_ARGS) const {
        const int g = u.pn >> 6, j = u.pn & 63, part = u.pm;
        char* ub = (char*)O + 2 * ((size_t)((g * 256 + 64 * wr) * 128 + 2 * j) * 256 + part * 128 + 32 * wc);
        unsigned lo = 2u * (unsigned)(fr * 128 * 256 + 8 * fq); asm volatile("" : "+v"(lo));
#pragma unroll
        for (int ai = 0; ai < 2; ++ai)
#pragma unroll
            for (int m = 0; m < 4; ++m)
#pragma unroll
                for (int bj = 0; bj < 2; ++bj)
                    *(v4u*)(ub + (size_t)(2 * (((128 * ai + 16 * m) * 128 + bj) * 256)) + lo) = pack8(acc[ai][bj][m][0], acc[ai][bj][m][1]);
    }
};
struct EpiChDftCtx { static constexpr bool PERM = true, AFTER_DRAIN = false; bf16* O;
    __device__ __forceinline__ void operator()(EPI_ARGS) const {
        const int g = u.pn, part = u.pm;
        char* ub = (char*)O + 2 * ((size_t)(g * 256 + 64 * wr) * 512 + part * 256 + 32 * wc);
        unsigned lo = 2u * (unsigned)(fr * 512 + 8 * fq); asm volatile("" : "+v"(lo));
#pragma unroll
        for (int ai = 0; ai < 2; ++ai)
#pragma unroll
            for (int m = 0; m < 4; ++m)
#pragma unroll
                for (int bj = 0; bj < 2; ++bj)
                    *(v4u*)(ub + (size_t)(2 * ((128 * ai + 16 * m) * 512 + 128 * bj)) + lo) = pack8(acc[ai][bj][m][0], acc[ai][bj][m][1]);
    }
};
struct EpiStepA { static constexpr bool PERM = true, AFTER_DRAIN = false; bf16* O; const float* twc; const float* tws;
    __device__ __forceinline__ void operator()(EPI_ARGS) const {
        char* ub = (char*)O + 2 * ((size_t)(64 * wr * 1024 + 2 * u.pn) * 256 + 32 * wc);
        unsigned lo = 2u * (unsigned)(fr * 1024 * 256 + 8 * fq); asm volatile("" : "+v"(lo));
        const char* tcb = (const char*)twc + 4 * (64 * wr * 128 + 32 * wc); const char* tsb = (const char*)tws + 4 * (64 * wr * 128 + 32 * wc);
        unsigned tlo = 4u * (unsigned)(fr * 128 + 8 * fq); asm volatile("" : "+v"(tlo));
#pragma unroll
        for (int m = 0; m < 4; ++m) {
            const f32x4 c0 = *(const f32x4*)(tcb + 4 * (16 * m * 128) + tlo), c1 = *(const f32x4*)(tcb + 4 * (16 * m * 128 + 4) + tlo), s0 = *(const f32x4*)(tsb + 4 * (16 * m * 128) + tlo), s1 = *(const f32x4*)(tsb + 4 * (16 * m * 128 + 4) + tlo);
#pragma unroll
            for (int bj = 0; bj < 2; ++bj) {
                const f32x4 zr0 = acc[0][bj][m][0], zr1 = acc[0][bj][m][1], zi0 = acc[1][bj][m][0], zi1 = acc[1][bj][m][1];
                const f32x4 yr0 = zr0 * c0 + zi0 * s0, yr1 = zr1 * c1 + zi1 * s1, yi0 = zi0 * c0 - zr0 * s0, yi1 = zi1 * c1 - zr1 * s1;
                char* p = ub + (size_t)(2 * ((16 * m * 1024 + bj) * 256)) + lo;
                *(v4u*)p = pack8(yr0, yr1); *(v4u*)(p + 256) = pack8(yi0, yi1); }
            asm volatile("" ::: "memory"); }
    }
};
struct EpiStepC { static constexpr bool PERM = true, AFTER_DRAIN = false; bf16* O;
    __device__ __forceinline__ void operator()(EPI_ARGS) const {
        const int k1 = u.pn >> 2, chb = (u.pn & 3) * 256;
        char* ub = (char*)O + 2 * ((size_t)(k1 + 128 * 64 * wr) * DM + chb + 32 * wc);
        unsigned lo = 2u * (unsigned)(128 * fr * DM + 8 * fq); asm volatile("" : "+v"(lo));
#pragma unroll
        for (int m = 0; m < 4; ++m)
#pragma unroll
            for (int bj = 0; bj < 2; ++bj)
                *(v4u*)(ub + (size_t)(2 * (128 * 16 * m * DM + 128 * bj)) + lo) = pack8(acc[0][bj][m][0], acc[0][bj][m][1]);
    }
};
struct EpiCtxPos { static constexpr bool PERM = true, AFTER_DRAIN = false; bf16* O;
    __device__ __forceinline__ void operator()(EPI_ARGS) const {
        char* ub = (char*)O + 2 * ((size_t)(NLAT + 64 * wr) * DM + u.pn * 256 + 32 * wc);
        unsigned lo = 2u * (unsigned)(fr * DM + 8 * fq); asm volatile("" : "+v"(lo));
#pragma unroll
        for (int ai = 0; ai < 2; ++ai)
#pragma unroll
            for (int m = 0; m < 4; ++m)
#pragma unroll
                for (int bj = 0; bj < 2; ++bj)
                    *(v4u*)(ub + (size_t)(2 * ((128 * ai + 16 * m) * DM + 128 * bj)) + lo) = pack8(acc[ai][bj][m][0], acc[ai][bj][m][1]);
    }
};
template <int NKV, bool RMS> struct EpiQKV { static constexpr bool PERM = true, AFTER_DRAIN = false;
    bf16 *Q, *K, *V; const float* bias; const float* qn; const float* kn; const float* ropc; const float* rops;
    __device__ __forceinline__ void operator()(EPI_ARGS) const {
        const int hh = 4 * u.pn + wc; const int kind = hh < 16 ? 0 : (hh < 16 + NKV ? 1 : 2);
        const int pitch = kind == 0 ? DM : NKV * 64, hd = kind == 0 ? hh : (kind == 1 ? hh - 16 : hh - 16 - NKV);
        const bool f8 = RMS && kind < 2;
        const unsigned es = f8 ? 1u : 2u;
        const size_t doff = f8 ? (kind == 0 ? (size_t)(WS_Q8 - WS_Q) : (size_t)(WS_K8 - WS_Q)) : (kind == 0 ? (size_t)0 : (kind == 1 ? (size_t)(WS_K - WS_Q) : (size_t)(WS_V - WS_Q)));
        bf16* dst = (bf16*)((char*)Q + doff);
        const bool lat = u.pm < NLAT / 256;
        const int rowu = u.pm * 256 + 64 * wr;
        char* ub = (char*)dst + es * ((size_t)rowu * pitch + hd * 64);
        unsigned lo = es * (unsigned)(fr * pitch + 8 * fq); asm volatile("" : "+v"(lo));
        const char* rcb = (const char*)ropc + 4 * ((size_t)rowu * 32); const char* rsb = (const char*)rops + 4 * ((size_t)rowu * 32);
        unsigned rlo = 4u * (unsigned)(fr * 32 + 4 * fq); asm volatile("" : "+v"(rlo));
        f32x4 bv[2][2], gv[2][2];
#pragma unroll
        for (int bj = 0; bj < 2; ++bj)
#pragma unroll
            for (int n = 0; n < 2; ++n) { const int d = 32 * bj + 8 * fq + 4 * n; bv[bj][n] = *(const f32x4*)(bias + hh * 64 + d);
                if (RMS) { const f32x4 gq = *(const f32x4*)(qn + d), gk = *(const f32x4*)(kn + d); gv[bj][n] = kind == 0 ? gq : gk; } }
#pragma unroll
        for (int ai = 0; ai < 2; ++ai)
#pragma unroll
            for (int m = 0; m < 4; ++m) {
                f32x4 v[2][2];
#pragma unroll
                for (int bj = 0; bj < 2; ++bj)
#pragma unroll
                    for (int n = 0; n < 2; ++n) v[bj][n] = acc[ai][bj][m][n] + bv[bj][n];
                if (kind < 2) {
                    if (RMS) { float ss = 0.f;
#pragma unroll
                        for (int bj = 0; bj < 2; ++bj)
#pragma unroll
                            for (int n = 0; n < 2; ++n) ss += (v[bj][n][0] * v[bj][n][0] + v[bj][n][1] * v[bj][n][1]) + (v[bj][n][2] * v[bj][n][2] + v[bj][n][3] * v[bj][n][3]);
                        ss += __shfl_xor(ss, 16); ss += __shfl_xor(ss, 32);
                        const float rs = 1.f / sqrtf(ss * (1.f / 64.f) + RMS_EPS);
#pragma unroll
                        for (int bj = 0; bj < 2; ++bj)
#pragma unroll
                            for (int n = 0; n < 2; ++n) v[bj][n] = v[bj][n] * rs * gv[bj][n]; }
                    if (lat) {
#pragma unroll
                        for (int bj = 0; bj < 2; ++bj)
#pragma unroll
                            for (int n = 0; n < 2; ++n) {
                                const f32x2 c = *(const f32x2*)(rcb + 4 * ((128 * ai + 16 * m) * 32 + 16 * bj + 2 * n) + rlo), sn = *(const f32x2*)(rsb + 4 * ((128 * ai + 16 * m) * 32 + 16 * bj + 2 * n) + rlo);
                                const f32x4 x = v[bj][n];
                                v[bj][n] = (f32x4){x[0] * c.x - x[1] * sn.x, x[0] * sn.x + x[1] * c.x, x[2] * c.y - x[3] * sn.y, x[2] * sn.y + x[3] * c.y}; } }
                    if (kind == 0) {
#pragma unroll
                        for (int bj = 0; bj < 2; ++bj)
#pragma unroll
                            for (int n = 0; n < 2; ++n) v[bj][n] = v[bj][n] * QSCALE; }
                }
                char* p = ub + (size_t)(128 * ai + 16 * m) * (size_t)(es * pitch) + lo;
                if (f8) { *(v2u*)p = pack8f8(v[0][0], v[0][1]); *(v2u*)(p + 32) = pack8f8(v[1][0], v[1][1]); }
                else { *(v4u*)p = pack8(v[0][0], v[0][1]); *(v4u*)(p + 64) = pack8(v[1][0], v[1][1]); }
                if (m & 1) asm volatile("" ::: "memory"); }
    }
};
struct EpiGeluUV { static constexpr bool PERM = true, AFTER_DRAIN = false; bf16* U; bf16* V; const float* bias; float* pstat;
    __device__ __forceinline__ void operator()(EPI_ARGS) const {
        const bool isv = u.pn >= 8; const int colt = (u.pn & 7) * 256;
        char* ub = (char*)(isv ? V : U) + 2 * ((size_t)(u.pm * 256 + 64 * wr) * GM_HALF + colt + 32 * wc);
        unsigned lo = 2u * (unsigned)(fr * GM_HALF + 8 * fq); asm volatile("" : "+v"(lo));
        const float* bb = bias + u.pn * 256 + 32 * wc + 8 * fq;
        f32x4 bv[2][2];
#pragma unroll
        for (int bj = 0; bj < 2; ++bj)
#pragma unroll
            for (int n = 0; n < 2; ++n) bv[bj][n] = *(const f32x4*)(bb + 128 * bj + 4 * n);
#pragma unroll
        for (int ai = 0; ai < 2; ++ai)
#pragma unroll
            for (int m = 0; m < 4; ++m) { float s = 0.f, s2 = 0.f;
#pragma unroll
                for (int bj = 0; bj < 2; ++bj) { const f32x4 x0 = acc[ai][bj][m][0] + bv[bj][0], x1 = acc[ai][bj][m][1] + bv[bj][1];
                    const pg8::f32x2 a = pg8::gelu_pk((pg8::f32x2){x0[0], x0[1]}), b = pg8::gelu_pk((pg8::f32x2){x0[2], x0[3]}), c = pg8::gelu_pk((pg8::f32x2){x1[0], x1[1]}), d = pg8::gelu_pk((pg8::f32x2){x1[2], x1[3]});
                    s += ((a.x + a.y) + (b.x + b.y)) + ((c.x + c.y) + (d.x + d.y)); s2 += ((a.x * a.x + a.y * a.y) + (b.x * b.x + b.y * b.y)) + ((c.x * c.x + c.y * c.y) + (d.x * d.x + d.y * d.y));
                    v4u w; w.x = pg8::cvt_pk_bf16(a.x, a.y); w.y = pg8::cvt_pk_bf16(b.x, b.y); w.z = pg8::cvt_pk_bf16(c.x, c.y); w.w = pg8::cvt_pk_bf16(d.x, d.y);
                    *(v4u*)(ub + (size_t)(2 * ((128 * ai + 16 * m) * GM_HALF + 128 * bj)) + lo) = w; }
                if (isv) { s += __shfl_xor(s, 16); s += __shfl_xor(s, 32); s2 += __shfl_xor(s2, 16); s2 += __shfl_xor(s2, 32);
                    if (fq == 0) *(f32x2*)(pstat + ((size_t)(u.pm * 256 + 128 * ai + 64 * wr + 16 * m + fr) * 32 + (u.pn - 8) * 4 + wc) * 2) = (f32x2){s, s2}; } }
    }
};
struct EpiSwiGLU { static constexpr bool PERM = true, AFTER_DRAIN = false; unsigned char* O; const float* bias;
    __device__ __forceinline__ void operator()(EPI_ARGS) const {
        f32x4 bv[2][2];
        const float* bb = bias + (size_t)u.e * 2048 + u.pn * 256 + 32 * wc + 8 * fq;
#pragma unroll
        for (int bj = 0; bj < 2; ++bj)
#pragma unroll
            for (int n = 0; n < 2; ++n) bv[bj][n] = *(const f32x4*)(bb + 128 * bj + 4 * n);
        char* ub = (char*)O + (((size_t)u.pm * 256 + 64 * wr) * 1024 + u.pn * 128 + 16 * wc);
        unsigned lo = (unsigned)(fr * 1024 + 4 * fq); asm volatile("" : "+v"(lo));
#pragma unroll
        for (int ai = 0; ai < 2; ++ai)
#pragma unroll
            for (int m = 0; m < 4; ++m) {
#pragma unroll
                for (int bj = 0; bj < 2; ++bj) { float a[4];
#pragma unroll
                    for (int n = 0; n < 2; ++n) { const f32x4 x = acc[ai][bj][m][n] + bv[bj][n];
#pragma unroll
                        for (int q = 0; q < 2; ++q) { const float glu = fminf(x[2 * q], 7.0f), lin = fminf(fmaxf(x[2 * q + 1], -7.0f), 7.0f);
                            const float sg = __builtin_amdgcn_rcpf(1.0f + __builtin_amdgcn_exp2f(-1.702f * LOG2E * glu));
                            a[2 * n + q] = glu * sg * (lin + 1.0f); } }
                    int w = 0; w = __builtin_amdgcn_cvt_pk_fp8_f32(a[0], a[1], w, false); w = __builtin_amdgcn_cvt_pk_fp8_f32(a[2], a[3], w, true);
                    *(int*)(ub + (size_t)((128 * ai + 16 * m) * 1024 + 64 * bj) + lo) = w; } }
    }
};
struct EpiDown { static constexpr bool PERM = true, AFTER_DRAIN = false; bf16* O; const float* bias; const unsigned* stok;
    __device__ __forceinline__ void operator()(EPI_ARGS) const {
        f32x4 bv[2][2];
        const float* bb = bias + (size_t)u.e * 1024 + u.pn * 256 + 32 * wc + 8 * fq;
#pragma unroll
        for (int bj = 0; bj < 2; ++bj)
#pragma unroll
            for (int n = 0; n < 2; ++n) bv[bj][n] = *(const f32x4*)(bb + 128 * bj + 4 * n);
        const char* spb = (const char*)stok + 4 * (u.pm * 256 + 64 * wr); unsigned so = 4u * (unsigned)fr; asm volatile("" : "+v"(so));
        unsigned yr[2][4];
#pragma unroll
        for (int ai = 0; ai < 2; ++ai)
#pragma unroll
            for (int m = 0; m < 4; ++m) yr[ai][m] = *(const unsigned*)(spb + 4 * (128 * ai + 16 * m) + so);
        char* ub = (char*)O + 2 * (u.pn * 256 + 32 * wc);
        unsigned lo = 2u * (unsigned)(8 * fq); asm volatile("" : "+v"(lo));
#pragma unroll
        for (int ai = 0; ai < 2; ++ai)
#pragma unroll
            for (int m = 0; m < 4; ++m) { const unsigned ro = yr[ai][m] * (unsigned)(DM * 2) + lo;
                if (yr[ai][m] != (unsigned)(4 * T)) {
#pragma unroll
                    for (int bj = 0; bj < 2; ++bj)
                        *(v4u*)(ub + (size_t)(256 * bj) + ro) = pack8(acc[ai][bj][m][0] + bv[bj][0], acc[ai][bj][m][1] + bv[bj][1]); } }
    }
};
__device__ __forceinline__ int qkv_rowmap(int n) { return (n & ~255) + ((n >> 5) & 1) * 128 + ((n >> 6) & 3) * 32 + (n & 31); }
__device__ __forceinline__ void p0_transpose_item(const float* W, int K, int N, bf16* WT, int rowmode, LAS float* scr, int item, int lane) {
    const int nblk = N / 64, kb = item / nblk, nb = item - kb * nblk, k0 = 64 * kb, n0 = 64 * nb;
    const int r = lane >> 4, cq = lane & 15;
    f32x4 t[16];
#pragma unroll
    for (int i = 0; i < 16; ++i) t[i] = __builtin_nontemporal_load((const f32x4*)(W + (size_t)(k0 + 4 * i + r) * N + n0 + 4 * cq));
#pragma unroll
    for (int i = 0; i < 16; ++i) { LAS float* s = scr + (4 * i + r) * 65 + 4 * cq; s[0] = t[i].x; s[1] = t[i].y; s[2] = t[i].z; s[3] = t[i].w; }
    LDS_WAIT(); asm volatile("" ::: "memory");
    const int c = lane & 7, nn = lane >> 3;
#pragma unroll
    for (int j = 0; j < 8; ++j) { const int n = nn + 8 * j; const LAS float* s = scr + (8 * c) * 65 + n;
        v4u o; o.x = pk2(s[0 * 65], s[1 * 65]); o.y = pk2(s[2 * 65], s[3 * 65]); o.z = pk2(s[4 * 65], s[5 * 65]); o.w = pk2(s[6 * 65], s[7 * 65]);
        const int row = rowmode ? qkv_rowmap(n0 + n) : (n0 + n);
        __builtin_nontemporal_store(o, (GAS v4u*)(WT + (size_t)row * K + k0 + 8 * c)); }
    LDS_WAIT(); asm volatile("" ::: "memory");
}
__device__ __forceinline__ void p0_transpose_item_f8(const float* W, int K, int N, unsigned char* WT, LAS float* scr, int item, int lane) {
    const int nblk = N / 64, kb = item / nblk, nb = item - kb * nblk, k0 = 64 * kb, n0 = 64 * nb;
    const int r = lane >> 4, cq = lane & 15;
    f32x4 t[16];
#pragma unroll
    for (int i = 0; i < 16; ++i) t[i] = __builtin_nontemporal_load((const f32x4*)(W + (size_t)(k0 + 4 * i + r) * N + n0 + 4 * cq));
#pragma unroll
    for (int i = 0; i < 16; ++i) { LAS float* s = scr + (4 * i + r) * 65 + 4 * cq; s[0] = t[i].x; s[1] = t[i].y; s[2] = t[i].z; s[3] = t[i].w; }
    LDS_WAIT(); asm volatile("" ::: "memory");
    const int c = lane & 3, nn = lane >> 2;
#pragma unroll
    for (int j = 0; j < 4; ++j) { const int n = nn + 16 * j; const LAS float* s = scr + (16 * c) * 65 + n; v4u o;
#pragma unroll
        for (int q = 0; q < 4; ++q) { int w = 0; w = __builtin_amdgcn_cvt_pk_fp8_f32(s[(4 * q) * 65] * W8_SCALE, s[(4 * q + 1) * 65] * W8_SCALE, w, false);
            w = __builtin_amdgcn_cvt_pk_fp8_f32(s[(4 * q + 2) * 65] * W8_SCALE, s[(4 * q + 3) * 65] * W8_SCALE, w, true); o[q] = (unsigned)w; }
        __builtin_nontemporal_store(o, (GAS v4u*)(WT + (size_t)(n0 + n) * K + k0 + 16 * c)); }
    LDS_WAIT(); asm volatile("" ::: "memory");
}
struct WgItem { const float* W; unsigned char* WT; int N, kb, nb; };
__device__ __forceinline__ void p0_wg_load(const WgItem& I, f32x4 (&t)[16], int wave, int lane) {
#pragma unroll
    for (int i = 0; i < 16; ++i) t[i] = __builtin_nontemporal_load((const f32x4*)(I.W + (size_t)(128 * I.kb + 16 * wave + i) * I.N + 256 * I.nb + 4 * lane));
}
__device__ __forceinline__ void p0_wg_stage(const f32x4 (&t)[16], LAS float* tile, int wave, int lane) {
#pragma unroll
    for (int i = 0; i < 16; ++i) *(LAS f32x4*)(tile + (16 * wave + i) * 260 + 4 * (lane ^ wave)) = t[i];
}
__device__ __forceinline__ void p0_wg_store(const WgItem& I, LAS float* tile, int tid) {
    const int c = tid & 7, k0 = 128 * I.kb, n0 = 256 * I.nb;
#pragma unroll
    for (int j = 0; j < 4; ++j) { const int n = (tid >> 3) + 64 * j; const LAS float* s = tile + (16 * c) * 260 + (n ^ (4 * c)); v4u o;
#pragma unroll
        for (int q = 0; q < 4; ++q) { int w = 0; w = __builtin_amdgcn_cvt_pk_fp8_f32(s[(4 * q) * 260] * W8_SCALE, s[(4 * q + 1) * 260] * W8_SCALE, w, false);
            w = __builtin_amdgcn_cvt_pk_fp8_f32(s[(4 * q + 2) * 260] * W8_SCALE, s[(4 * q + 3) * 260] * W8_SCALE, w, true); o[q] = (unsigned)w; }
        __builtin_nontemporal_store(o, (GAS v4u*)(I.WT + (size_t)(n0 + n) * 1024 + k0 + 16 * c)); }
}
constexpr int CONV_PER_LAYER = 32 * 64 + 32 * 32, CONV_UP_PER = 5, CONV_DN_PER = 3, CONV_QKV_PER = 6;
constexpr bool CONV_DEFER = !MK_PER_PHASE;
__device__ __forceinline__ WgItem conv_item(Frame& F, int L, int j) { WgItem I;
    if (j < 2048) { const int le = L * 32 + (j >> 6), r = j & 63; I.W = argp(I_EWGU) + (size_t)le * 1024 * 2048; I.N = 2048; I.WT = (unsigned char*)(F.ws + WS_WEXP_GU) + (size_t)le * 2048 * 1024; I.kb = r >> 3; I.nb = r & 7; }
    else { const int q = j - 2048, le = L * 32 + (q >> 5), r = q & 31; I.W = argp(I_EWD) + (size_t)le * 1024 * 1024; I.N = 1024; I.WT = (unsigned char*)(F.ws + WS_WEXP_DN) + (size_t)le * 1024 * 1024; I.kb = r >> 2; I.nb = r & 3; }
    return I; }
__device__ __forceinline__ void conv_range(Frame& F, int L, int lo, int hi, int rank, int stride) { const int tid = otid(), lane = tid & 63;
    __syncthreads();
    f32x4 t[16]; int it = lo + rank;
    if (it < hi) p0_wg_load(conv_item(F, L, it), t, F.wave, lane);
    for (; it < hi; it += stride) {
        p0_wg_stage(t, (LAS float*)F.lds, F.wave, lane);
        __syncthreads();
        if (it + stride < hi) p0_wg_load(conv_item(F, L, it + stride), t, F.wave, lane);
        p0_wg_store(conv_item(F, L, it), (LAS float*)F.lds, tid);
        __syncthreads();
    }
}
__device__ __forceinline__ void conv_tail(Frame& F, int L, int rem, int per) {
    const int c0 = (int)F.MISC[MW_CONV]; const int fre = rem ? F.G - rem : 0; int n = per * fre; if (n > CONV_PER_LAYER - c0) n = CONV_PER_LAYER - c0;
    if (rem && F.bx >= rem) conv_range(F, L, c0, c0 + n, F.bx - rem, fre); else __syncthreads();
    if (otid() == 0) F.MISC[MW_CONV] = (unsigned)(c0 + n);
}
__device__ __forceinline__ float siluf(float v) { return v / (1.f + __expf(-v)); }
__device__ __forceinline__ void p0_prologue(Frame& F) { const int tid = otid(), lane = tid & 63; (void)tid; (void)lane;
    {
        LAS float* sc = (LAS float*)(F.lds);
        LAS float* red = sc + 2048;
        { const float* c0 = argp(I_C); const float* c1 = argp(I_CCTX);
          for (int i = tid; i < 2048; i += NTHR) { const int s = i >> 10, k = i & 1023; sc[i] = siluf(s == 0 ? c0[k] : c1[k]); } }
        __syncthreads();
        const float* adaw = argp(I_ADAW); const float* adab = argp(I_ADAB);
        for (int task = F.bx; task < 4 * 48; task += F.G) {
            const int L = task / 48, n0 = (task % 48) * 128;
            const float* w = adaw + (size_t)L * DM * 6144 + n0 + 2 * lane;
            float a0 = 0.f, a1 = 0.f, b0 = 0.f, b1 = 0.f;
#pragma unroll 8
            for (int kk = 0; kk < 128; ++kk) { const int k = 128 * F.wave + kk; const f32x2 x = *(const f32x2*)(w + (size_t)k * 6144); const float sl = sc[k], sx = sc[1024 + k];
                a0 += sl * x.x; a1 += sl * x.y; b0 += sx * x.x; b1 += sx * x.y; }
            red[(F.wave * 2 + 0) * 128 + 2 * lane] = a0; red[(F.wave * 2 + 0) * 128 + 2 * lane + 1] = a1;
            red[(F.wave * 2 + 1) * 128 + 2 * lane] = b0; red[(F.wave * 2 + 1) * 128 + 2 * lane + 1] = b1;
            __syncthreads();
            if (tid < 256) { const int s = tid >> 7, col = tid & 127; float v = adab[(size_t)L * 6144 + n0 + col];
#pragma unroll
                for (int wv = 0; wv < 8; ++wv) v += red[(wv * 2 + s) * 128 + col];
                ((float*)(F.ws + WS_MOD))[(size_t)(L * 2 + s) * 6144 + n0 + col] = v; }
            __syncthreads();
        }
    }
    {
        const int gt = F.bx * NTHR + tid, NGT = F.G * NTHR;
        bf16* fc = (bf16*)(F.ws + TB_FC); bf16* fa = (bf16*)(F.ws + TB_FA); bf16* fcc = (bf16*)(F.ws + TB_FCC); bf16* fx = (bf16*)(F.ws + TB_FX);
        float* twc = (float*)(F.ws + TB_TWC); float* tws = (float*)(F.ws + TB_TWS); float* ropc = (float*)(F.ws + TB_ROPC); float* rops = (float*)(F.ws + TB_ROPS);
        for (int i = gt; i < 512 * 256; i += NGT) { const int row = i >> 8, c = i & 255, part = row >> 8, l = row & 255; const int m = (c * l) & 255;
            const float ang = (float)m * (2.0f / 256.0f); const float v = part == 0 ? cospif(ang) : -sinpif(ang); fc[i] = (bf16)f2bf(v * (1.0f / 16.0f)); }
        for (int i = gt; i < 256 * 256; i += NGT) { const int row = i >> 8, col = i & 255, pr = row >> 7, k1 = row & 127, pc = col >> 7, n1 = col & 127; const int m = (n1 * k1) & 127;
            const float ang = (float)m * (2.0f / 128.0f); const float cs = cospif(ang), sn = sinpif(ang);
            const float v = (pr == pc) ? cs : (pr == 0 ? sn : -sn); fa[i] = (bf16)f2bf(v * 0.08838834764831845f); }
        for (int i = gt; i < 256 * 256; i += NGT) { const int row = i >> 8, col = i & 255, pc = col >> 7, n2 = col & 127; float v = 0.f;
            if (row < 128) { const int m = (n2 * row) & 127; const float ang = (float)m * (2.0f / 128.0f); v = (pc == 0 ? cospif(ang) : sinpif(ang)) * 0.08838834764831845f; }
            fcc[i] = (bf16)f2bf(v); }
        for (int i = gt; i < 256 * 512; i += NGT) { const int k = i >> 9, col = i & 511, pc = col >> 8, n = col & 255; const int m = (n * k) & 255;
            const float ang = (float)m * (2.0f / 256.0f); fx[i] = (bf16)f2bf((pc == 0 ? cospif(ang) : sinpif(ang)) * (1.0f / 16.0f)); }
        for (int i = gt; i < 128 * 128; i += NGT) { const int k1 = i >> 7, n2 = i & 127; const float ang = (float)(k1 * n2) * (2.0f / 16384.0f); twc[i] = cospif(ang); tws[i] = sinpif(ang); }
        for (int i = gt; i < NLAT * 32; i += NGT) { const int t = i >> 5, j = i & 31; const float pos = (float)(j < 16 ? (t >> 6) : (t & 63));
            const float inv = powf(10000.0f, -(float)(j & 15) * (1.0f / 16.0f)); const float ang = pos * inv; float sn, cs; sincosf(ang, &sn, &cs); ropc[i] = cs; rops[i] = sn; }
        bf16* rw = (bf16*)(F.ws + WS_RW); const float* rwin = argp(I_RW);
        for (int i = gt; i < 4 * 32 * 1024; i += NGT) { const int L = i >> 15, e = (i >> 10) & 31, k = i & 1023; rw[i] = (bf16)f2bf(rwin[((size_t)L * 1024 + k) * 32 + e]); }
    }
    __syncthreads();
    {
        LAS float* scr = (LAS float*)(F.lds) + F.wave * (64 * 65);
        const int gw = F.vcu * NWAVES + F.wave, NGW = F.G * NWAVES;
        constexpr int I1 = 16 * 16, I2 = 16 * 24, I3 = 16 * 16, I4 = 16 * 64, I5 = 32 * 16, I6 = 16 * 20, I7 = 16 * 16, ISM = I1 + I2 + I3 + I4 + I5 + I6 + I7;
        for (int it = gw; it < ISM; it += NGW) {
            int r = it;
            if (r < I1) { p0_transpose_item(argp(I_FNW), 1024, 1024, (bf16*)(F.ws + WS_WFN), 0, scr, r, lane); continue; } r -= I1;
            if (r < I2) { p0_transpose_item(argp(I_FAWQ), 1024, FA_NQKV, (bf16*)(F.ws + WS_WFAQ), 1, scr, r, lane); continue; } r -= I2;
            if (r < I3) { p0_transpose_item(argp(I_FAWO), 1024, 1024, (bf16*)(F.ws + WS_WFAO), 0, scr, r, lane); continue; } r -= I3;
            if (r < I4) { p0_transpose_item(argp(I_GMWI), 1024, GM_FF, (bf16*)(F.ws + WS_WGI), 0, scr, r, lane); continue; } r -= I4;
            if (r < I5) { p0_transpose_item(argp(I_GMWO), 2048, 1024, (bf16*)(F.ws + WS_WGO), 0, scr, r, lane); continue; } r -= I5;
            if (r < I6) { p0_transpose_item(argp(I_WAWQ), 1024, WA_NQKV, (bf16*)(F.ws + WS_WWQ), 1, scr, r, lane); continue; } r -= I6;
            p0_transpose_item(argp(I_WAWO), 1024, 1024, (bf16*)(F.ws + WS_WWO), 0, scr, r, lane);
        }
        __syncthreads();
        for (int L = 0; L < (CONV_DEFER ? 1 : 4); ++L) conv_range(F, L, 0, CONV_PER_LAYER, F.vcu, F.G);
    }
}

__device__ __forceinline__ void stok_fill(Frame& F) { const int tid = otid(); unsigned* STOK = (unsigned*)(F.ws + WS_STOK);
    for (int i = F.bx * NTHR + tid; i < 32 * ECAP; i += F.G * NTHR) STOK[i] = (unsigned)(4 * T);
}
__device__ __forceinline__ void init_row(Frame& F, int m, int lane, const RowV& x, const RowV& sc, const RowV& sh) { RowV h;
#pragma unroll
    for (int j = 0; j < 4; ++j) h.v[j] = x.v[j] * (1.f + sc.v[j]) + sh.v[j];
    strow_bf16((bf16*)(F.ws + WS_H) + (size_t)m * DM, lane, h); }
__device__ __forceinline__ void pass_init(Frame& F) { const int tid = otid(), lane = tid & 63; (void)tid; (void)lane;
    stok_fill(F);
    const int gw = F.vcu * NWAVES + F.wave, NGW = F.G * NWAVES;
    RowV sh = ldrow(modp(F, 0, 0, 0), lane), sc = ldrow(modp(F, 0, 0, 1), lane);
    const float* xin = argp(I_X);
    for (int m = gw; m < NLAT; m += 4 * NGW) {
        RowV x[4];
#pragma unroll
        for (int q = 0; q < 4; ++q) { const int mq = m + q * NGW; x[q] = ldrow(xin + (size_t)(mq < NLAT ? mq : m) * DM, lane); }
#pragma unroll
        for (int q = 0; q < 4; ++q) { const int mq = m + q * NGW; if (mq < NLAT) init_row(F, mq, lane, x[q], sc, sh); }
    }
    { const int c0 = F.wave * F.G + F.vcu;
      if (c0 < NCTX) { sh = ldrow(modp(F, 0, 1, 0), lane); sc = ldrow(modp(F, 0, 1, 1), lane);
          for (int c = c0; c < NCTX; c += NGW) { const RowV x = ldrow(argp(I_CTX) + (size_t)c * DM, lane); init_row(F, NLAT + c, lane, x, sc, sh); } } }
}

struct RawRow { v2u w[4]; };
__device__ __forceinline__ RawRow ldraw_bf16(const bf16* p, int lane) { RawRow r; const v2u* q = (const v2u*)p + lane;
#pragma unroll
    for (int j = 0; j < 4; ++j) r.w[j] = q[64 * j]; return r; }
__device__ __forceinline__ RowV cvrow(const RawRow& r) { RowV o;
#pragma unroll
    for (int j = 0; j < 4; ++j) o.v[j] = (f32x4){bf_lo(r.w[j].x), bf_hi(r.w[j].x), bf_lo(r.w[j].y), bf_hi(r.w[j].y)}; return o; }
template <int L> __device__ __forceinline__ void pass_mix(Frame& F) { const int tid = otid(), lane = tid & 63; (void)tid; (void)lane;
    constexpr bool HAS_CTX = L < 3, MIX_ON = (EN_MIX >> L) & 1, MOE_ON = (EN_MOE >> L) & 1;
    constexpr int HP = 1032;
    LAS bf16* HT = (LAS bf16*)(F.lds);
    LAS float* PART = (LAS float*)(F.lds + 32 * HP * 2);
    LAS float* LOGT = PART + 8 * 32 * 33;
    volatile LAS unsigned* LC = F.MISC + MW_LC;
    const bf16* X = (const bf16*)(F.ws + WS_X); bf16* X2 = (bf16*)(F.ws + WS_X2); bf16* H = (bf16*)(F.ws + WS_H); const bf16* Y = (const bf16*)(F.ws + WS_Y);
    const float* xin = argp(I_X); const float* cin = argp(I_CTX);
    float* GATE = (float*)(F.ws + WS_GATE); unsigned* STOK = (unsigned*)(F.ws + WS_STOK);
    LAS unsigned* ASL = (LAS unsigned*)(F.lds + 32 * HP * 2 + 8 * 32 * 33 * 4 + 32 * 33 * 4);
    const bf16* RW = (const bf16*)(F.ws + WS_RW) + (size_t)L * 32 * 1024;
    if (CONV_DEFER) { const int donec = (int)F.MISC[MW_CONV];
        if (L >= 1) conv_range(F, L, donec, CONV_PER_LAYER, F.vcu, F.G); else __syncthreads();
        if (tid == 0) F.MISC[MW_CONV] = 0u; }
    if (tid < 32) LC[tid] = 0u;
    ASL[tid] = 0xFFFFFFFFu;
    __syncthreads();
    int ti = 0;
    const float* rbias = argp(I_RB);
    const int nlt = NLAT / 32, nct = HAS_CTX ? NCTX : 0;
    int cur_s = -1; RowV g1, lg, lb, sc2, sh2;
    for (int it = F.bx; it < nlt + nct; it += F.G) {
        const bool isl = it < nlt; const int s = isl ? 0 : 1; const int row0 = isl ? it * 32 : NLAT + (it - nlt); const int nrows = isl ? 32 : 1;
        if (s != cur_s) { cur_s = s; g1 = ldrow(modp(F, L, s, 2), lane); sh2 = ldrow(modp(F, L, s, 3), lane); sc2 = ldrow(modp(F, L, s, 4), lane);
            lg = ldrow(argp(I_LNMG) + L * DM, lane); lb = ldrow(argp(I_LNMB) + L * DM, lane); }
        const int nr = isl ? 4 : (F.wave == 0 ? 1 : 0);
        RowV xf[4]; RawRow xr[4], yr[4];
#pragma unroll
        for (int q_ = 0; q_ < 4; ++q_) if (q_ < nr) { const int m = row0 + F.wave * 4 + q_;
            if (L == 0) xf[q_] = ldrow(m < NLAT ? xin + (size_t)m * DM : cin + (size_t)(m - NLAT) * DM, lane);
            else xr[q_] = ldraw_bf16(X + (size_t)m * DM, lane);
            if (MIX_ON) yr[q_] = ldraw_bf16(Y + (size_t)m * DM, lane); }
#pragma unroll
        for (int q_ = 0; q_ < 4; ++q_) if (q_ < nr) { const int rr = F.wave * 4 + q_; const int m = row0 + rr;
            RowV x = (L == 0) ? xf[q_] : cvrow(xr[q_]);
            if (MIX_ON) { const RowV y = cvrow(yr[q_]);
#pragma unroll
                for (int j = 0; j < 4; ++j) x.v[j] = x.v[j] * DN_ALPHA + g1.v[j] * y.v[j]; }
            else {
#pragma unroll
                for (int j = 0; j < 4; ++j) x.v[j] = x.v[j] * DN_ALPHA; }
            x = ln_row(x, lg, lb);
            strow_bf16(X2 + (size_t)m * DM, lane, x);
            RowV h;
#pragma unroll
            for (int j = 0; j < 4; ++j) h.v[j] = x.v[j] * (1.f + sc2.v[j]) + sh2.v[j];
            { unsigned* q8 = (unsigned*)((unsigned char*)(F.ws + WS_H8) + (size_t)m * DM) + lane;
#pragma unroll
              for (int j = 0; j < 4; ++j) { int w = 0; w = __builtin_amdgcn_cvt_pk_fp8_f32(h.v[j].x, h.v[j].y, w, false); w = __builtin_amdgcn_cvt_pk_fp8_f32(h.v[j].z, h.v[j].w, w, true); q8[64 * j] = (unsigned)w; } }
            if (MOE_ON) { LAS unsigned long long* q = (LAS unsigned long long*)(HT + rr * HP) + lane;
#pragma unroll
                for (int j = 0; j < 4; ++j) q[64 * j] = (unsigned long long)pk2(h.v[j].x, h.v[j].y) | ((unsigned long long)pk2(h.v[j].z, h.v[j].w) << 32); }
        }
        if (MOE_ON) {
            __syncthreads();
            { const int r32 = lane & 31, hi = lane >> 5; f32x16 acc = f32x16{};
#pragma unroll
                for (int st = 0; st < 8; ++st) { const int k = 128 * F.wave + 16 * st + 8 * hi;
                    const bf16x8 a = *(const LAS bf16x8*)(HT + r32 * HP + k); const bf16x8 b = *(const bf16x8*)(RW + (size_t)r32 * 1024 + k);
                    acc = __builtin_amdgcn_mfma_f32_32x32x16_bf16(a, b, acc, 0, 0, 0); }
#pragma unroll
                for (int r = 0; r < 16; ++r) { const int tok = (r & 3) + 8 * (r >> 2) + 4 * hi; PART[(F.wave * 32 + tok) * 33 + r32] = acc[r]; } }
            __syncthreads();
            { const int t = tid >> 4, e0 = tid & 15;
#pragma unroll
                for (int q = 0; q < 2; ++q) { const int e = e0 + 16 * q; float v = rbias[L * 32 + e];
#pragma unroll
                    for (int wv = 0; wv < 8; ++wv) v += PART[(wv * 32 + t) * 33 + e];
                    LOGT[t * 33 + e] = v; } }
            __syncthreads();
            if (tid < nrows) { const int t = tid; float lv[32];
#pragma unroll
                for (int e = 0; e < 32; ++e) lv[e] = LOGT[t * 33 + e];
                int idx[4]; float val[4]; unsigned taken = 0u;
#pragma unroll
                for (int k = 0; k < 4; ++k) { float best = -INFINITY; int bi = 0;
#pragma unroll
                    for (int e = 0; e < 32; ++e) { const bool ok = !((taken >> e) & 1u) && lv[e] > best; best = ok ? lv[e] : best; bi = ok ? e : bi; }
                    idx[k] = bi; val[k] = best; taken |= 1u << bi; }
                float ev[4], sum = 0.f;
#pragma unroll
                for (int k = 0; k < 4; ++k) { ev[k] = __expf(val[k] - val[0]); sum += ev[k]; }
                const float inv = 1.f / sum; const int m = row0 + t;
#pragma unroll
                for (int k = 0; k < 4; ++k) { const unsigned pos = atomicAdd((unsigned*)&LC[idx[k]], 1u); const int li = (ti & 3) * 128 + t * 4 + k; ASL[li] = ((unsigned)idx[k] << 16) | pos; ASL[512 + li] = (unsigned)(m * 4 + k); GATE[(size_t)m * 4 + k] = ev[k] * inv; } }
            __syncthreads();
        }
        ++ti;
    }
    if (MOE_ON) {
        __syncthreads();
        if (tid < 32) { const unsigned c = LC[tid]; unsigned st = 0u;
            if (c) st = __hip_atomic_fetch_add((unsigned*)(F.ctl + CW_GCNT + (L * 32 + tid) * 64), c, __ATOMIC_RELAXED, __HIP_MEMORY_SCOPE_AGENT);
            F.MISC[MW_TOT + tid] = st; }
        __syncthreads();
        { const unsigned ep = ASL[tid]; if (ep != 0xFFFFFFFFu) { const unsigned e = ep >> 16, pos = ep & 0xffffu; STOK[(size_t)e * ECAP + F.MISC[MW_TOT + e] + pos] = ASL[512 + tid]; } }
    }
}

template <int L> __device__ __forceinline__ void moe_tables(Frame& F) { const int tid = otid();
    if (tid < 64) {
        const int e = tid & 31;
        const unsigned cnt = tid < 32 ? __hip_atomic_load((unsigned*)(F.ctl + CW_GCNT + (L * 32 + e) * 64), RLX_AGENT) : 0u;
        const unsigned tiles = (cnt + 255u) >> 8; unsigned incl = tiles;
#pragma unroll
        for (int o = 1; o < 32; o <<= 1) { const unsigned v = (unsigned)__shfl_up((int)incl, o); if (tid >= o) incl += v; }
        const unsigned base = incl - tiles;
        if (tid < 32) for (unsigned q = 0; q < tiles; ++q) F.MISC[MW_MTE + base + q] = (unsigned)(ECAPT * e) + q;
        if (tid == 31) F.MISC[MW_NMT] = incl; }
    __syncthreads();
}
struct CombIn { RawRow x, y[4]; f32x4 gt; };
template <int L> __device__ __forceinline__ CombIn comb_load(Frame& F, int m, int lane) { CombIn I; constexpr bool MOE_ON = (EN_MOE >> L) & 1;
    const bf16* X2 = (const bf16*)(F.ws + WS_X2); const bf16* YS = (const bf16*)(F.ws + WS_YS); const float* GATE = (const float*)(F.ws + WS_GATE);
    I.x = ldraw_bf16(X2 + (size_t)m * DM, lane);
    if (MOE_ON) { I.gt = *(const f32x4*)(GATE + (size_t)m * 4);
#pragma unroll
        for (int k = 0; k < 4; ++k) I.y[k] = ldraw_bf16(YS + ((size_t)m * 4 + k) * DM, lane); }
    return I; }
template <int L> __device__ __forceinline__ void comb_row(Frame& F, int m, int lane, const CombIn& I, const RowV& g2, const RowV& lg, const RowV& lb, const RowV& sc, const RowV& sh) {
    constexpr bool MOE_ON = (EN_MOE >> L) & 1;
    bf16* X = (bf16*)(F.ws + WS_X); bf16* H = (bf16*)(F.ws + WS_H);
    RowV x = cvrow(I.x);
    if (MOE_ON) { RowV f;
#pragma unroll
        for (int j = 0; j < 4; ++j) f.v[j] = (f32x4){0.f, 0.f, 0.f, 0.f};
#pragma unroll
        for (int k = 0; k < 4; ++k) { const RowV y = cvrow(I.y[k]);
#pragma unroll
            for (int j = 0; j < 4; ++j) f.v[j] += y.v[j] * I.gt[k]; }
#pragma unroll
        for (int j = 0; j < 4; ++j) x.v[j] = x.v[j] * DN_ALPHA + g2.v[j] * f.v[j];
    } else {
#pragma unroll
        for (int j = 0; j < 4; ++j) x.v[j] = x.v[j] * DN_ALPHA; }
    x = ln_row(x, lg, lb);
    if (L < 3) { strow_bf16(X + (size_t)m * DM, lane, x); RowV h;
#pragma unroll
        for (int j = 0; j < 4; ++j) h.v[j] = x.v[j] * (1.f + sc.v[j]) + sh.v[j];
        strow_bf16(H + (size_t)m * DM, lane, h); }
    else strow(((float*)argp(N_IN)) + (size_t)m * DM, lane, x);
}
template <int L> __device__ __forceinline__ void pass_comb(Frame& F) { const int tid = otid(), lane = tid & 63; (void)tid; (void)lane;
    constexpr bool HAS_CTX = L < 3;
    if (L < 3) stok_fill(F);
    const int gw = F.vcu * NWAVES + F.wave, NGW = F.G * NWAVES;
    RowV g2, lg, lb, sc, sh;
    g2 = ldrow(modp(F, L, 0, 5), lane); lg = ldrow(argp(I_LNFG) + L * DM, lane); lb = ldrow(argp(I_LNFB) + L * DM, lane);
    if (L < 3) { sh = ldrow(modp(F, L < 3 ? L + 1 : 0, 0, 0), lane); sc = ldrow(modp(F, L < 3 ? L + 1 : 0, 0, 1), lane); }
    for (int m = gw; m < NLAT; m += 2 * NGW) {
        const int m1 = m + NGW; const bool two = m1 < NLAT;
        const CombIn A = comb_load<L>(F, m, lane); const CombIn B = comb_load<L>(F, two ? m1 : m, lane);
        comb_row<L>(F, m, lane, A, g2, lg, lb, sc, sh);
        if (two) comb_row<L>(F, m1, lane, B, g2, lg, lb, sc, sh);
    }
    if (HAS_CTX) {
        const int c0 = F.wave * F.G + F.vcu;
        if (c0 < NCTX) { g2 = ldrow(modp(F, L, 1, 5), lane); sh = ldrow(modp(F, L < 3 ? L + 1 : 0, 1, 0), lane); sc = ldrow(modp(F, L < 3 ? L + 1 : 0, 1, 1), lane);
            for (int c = c0; c < NCTX; c += NGW) { const CombIn A = comb_load<L>(F, NLAT + c, lane); comb_row<L>(F, NLAT + c, lane, A, g2, lg, lb, sc, sh); } }
    }
}
__device__ __forceinline__ void gate_unit(Frame& F, int t0, int h0, int nh, bool use_pstat) { const int tid = otid(), lane = tid & 63;
    constexpr int WP = 136, VP = 136, OP = 264;
    LAS bf16* WL = (LAS bf16*)(F.lds);
    LAS bf16* VT = (LAS bf16*)(F.lds + 128 * WP * 2);
    LAS bf16* OUT = (LAS bf16*)(F.lds);
    LAS float* STAT = (LAS float*)(F.lds + 128 * WP * 2 + 256 * VP * 2);
    static_assert(128 * OP * 2 <= 128 * WP * 2 + 256 * VP * 2, "OUT overlay");
    const bf16* GU = (const bf16*)(F.ws + WS_GU); const bf16* GV = (const bf16*)(F.ws + WS_GV); bf16* GG = (bf16*)(F.ws + WS_GG);
    const float* ws_ = argp(I_GMWS); const float* bs_ = argp(I_GMBS); const float* vg = argp(I_GMVG); const float* vb = argp(I_GMVB);
    const int r32 = lane & 31, hi = lane >> 5;
    if (use_pstat) {
        const int row = tid >> 2, part = tid & 3; const f32x2* ps = (const f32x2*)((const float*)(F.ws + WS_PSTAT) + ((size_t)(t0 + row) * 32 + 8 * part) * 2); float s = 0.f, s2 = 0.f;
#pragma unroll
        for (int i = 0; i < 8; ++i) { const f32x2 v = ps[i]; s += v.x; s2 += v.y; }
        s += __shfl_xor(s, 1); s += __shfl_xor(s, 2); s2 += __shfl_xor(s2, 1); s2 += __shfl_xor(s2, 2);
        if (part == 0) { const float mean = s * (1.f / GM_HALF); const float var = fmaxf(s2 * (1.f / GM_HALF) - mean * mean, 0.f); STAT[2 * row] = mean; STAT[2 * row + 1] = 1.f / sqrtf(var + LN_EPS); }
    } else {
#ifdef GATE_DUP_STATS
    for (int dup_ = 0; dup_ < 2; ++dup_)
#endif
    for (int bt = 0; bt < 2; ++bt) { v4u raw[8][4]; float s[8], s2[8];
#pragma unroll
        for (int i = 0; i < 8; ++i) { const int q = 16 * F.wave + 8 * bt + i; const v4u* src = (const v4u*)(GV + (size_t)(t0 + q) * GM_HALF) + lane;
#pragma unroll
            for (int j = 0; j < 4; ++j) raw[i][j] = src[64 * j]; }
#pragma unroll
        for (int i = 0; i < 8; ++i) { float a = 0.f, b = 0.f;
#pragma unroll
            for (int j = 0; j < 4; ++j)
#pragma unroll
                for (int e = 0; e < 4; ++e) { const float x0 = bf_lo(raw[i][j][e]), x1 = bf_hi(raw[i][j][e]); a += x0 + x1; b += x0 * x0 + x1 * x1; }
            s[i] = a; s2[i] = b; }
#pragma unroll
        for (int o = 1; o < 64; o <<= 1) {
#pragma unroll
            for (int i = 0; i < 8; ++i) { s[i] += __shfl_xor(s[i], o); s2[i] += __shfl_xor(s2[i], o); } }
        if (lane == 0) {
#pragma unroll
            for (int i = 0; i < 8; ++i) { const int q = 16 * F.wave + 8 * bt + i; const float mean = s[i] * (1.f / GM_HALF); const float var = fmaxf(s2[i] * (1.f / GM_HALF) - mean * mean, 0.f);
                STAT[2 * q] = mean; STAT[2 * q + 1] = 1.f / sqrtf(var + LN_EPS); } } }
    }
    __syncthreads();
    const int wp = tid >> 2, wq0 = (tid & 3) * 32;
    const int vck = tid & 31, vqb0 = tid >> 5;
    const int ck = tid & 31;
    f32x4 wr[8]; v4u wv[8];
    { const f32x4* src = (const f32x4*)(ws_ + ((size_t)h0 * 128 + wp) * 128 + wq0);
#pragma unroll
      for (int i = 0; i < 8; ++i) wr[i] = src[i];
#pragma unroll
      for (int j = 0; j < 8; ++j) wv[j] = *(const v4u*)(GV + (size_t)(t0 + 4 * (vqb0 + 16 * (j >> 2)) + (j & 3)) * GM_HALF + h0 * 256 + 8 * vck); }
    for (int hh = 0; hh < nh; ++hh) { const int h = h0 + hh;
#pragma unroll
        for (int i = 0; i < 4; ++i) { const f32x4 a = wr[2 * i], b = wr[2 * i + 1]; v4u w; w.x = pk2(a[0], a[1]); w.y = pk2(a[2], a[3]); w.z = pk2(b[0], b[1]); w.w = pk2(b[2], b[3]);
            *(LAS v4u*)(WL + wp * WP + wq0 + 8 * i) = w; }
        { const f32x4 g0 = *(const f32x4*)(vg + h * 256 + 8 * vck), g1 = *(const f32x4*)(vg + h * 256 + 8 * vck + 4), b0 = *(const f32x4*)(vb + h * 256 + 8 * vck), b1 = *(const f32x4*)(vb + h * 256 + 8 * vck + 4);
#pragma unroll
            for (int bk = 0; bk < 2; ++bk) { const int q0 = 4 * (vqb0 + 16 * bk); float x[4][8];
#pragma unroll
                for (int r = 0; r < 4; ++r) { const v4u w = wv[4 * bk + r]; const float mean = STAT[2 * (q0 + r)], rstd = STAT[2 * (q0 + r) + 1];
#pragma unroll
                    for (int i = 0; i < 4; ++i) { x[r][2 * i] = (bf_lo(w[i]) - mean) * rstd; x[r][2 * i + 1] = (bf_hi(w[i]) - mean) * rstd; } }
#pragma unroll
                for (int i = 0; i < 8; ++i) { const float gg = i < 4 ? g0[i & 3] : g1[i & 3], bb = i < 4 ? b0[i & 3] : b1[i & 3];
                    v2u w; w.x = pk2(x[0][i] * gg + bb, x[1][i] * gg + bb); w.y = pk2(x[2][i] * gg + bb, x[3][i] * gg + bb);
                    *(LAS v2u*)(VT + (8 * vck + i) * VP + q0) = w; } } }
        if (hh + 1 < nh) { const f32x4* src = (const f32x4*)(ws_ + ((size_t)(h + 1) * 128 + wp) * 128 + wq0);
#pragma unroll
            for (int i = 0; i < 8; ++i) wr[i] = src[i];
#pragma unroll
            for (int j = 0; j < 8; ++j) wv[j] = *(const v4u*)(GV + (size_t)(t0 + 4 * (vqb0 + 16 * (j >> 2)) + (j & 3)) * GM_HALF + (h + 1) * 256 + 8 * vck); }
        v4u uo[8];
#pragma unroll
        for (int j = 0; j < 8; ++j) { const int p = (tid >> 5) + 16 * j; uo[j] = *(const v4u*)(GU + (size_t)(t0 + p) * GM_HALF + h * 256 + 8 * ck); }
        __syncthreads();
        const int wm = F.wave >> 2, wn = F.wave & 3; f32x16 acc[2][2];
#pragma unroll
        for (int i = 0; i < 2; ++i)
#pragma unroll
            for (int jn = 0; jn < 2; ++jn) acc[i][jn] = f32x16{};
#pragma unroll
        for (int ks = 0; ks < 8; ++ks) { bf16x8 a[2], b[2];
#pragma unroll
            for (int i = 0; i < 2; ++i) { a[i] = *(const LAS bf16x8*)(VT + (64 * wn + 32 * i + r32) * VP + 16 * ks + 8 * hi); b[i] = *(const LAS bf16x8*)(WL + (64 * wm + 32 * i + r32) * WP + 16 * ks + 8 * hi); }
#pragma unroll
            for (int i = 0; i < 2; ++i)
#pragma unroll
                for (int jn = 0; jn < 2; ++jn) acc[i][jn] = __builtin_amdgcn_mfma_f32_32x32x16_bf16(a[i], b[jn], acc[i][jn], 0, 0, 0); }
        __syncthreads();
#pragma unroll
        for (int jn = 0; jn < 2; ++jn) { const int p = 64 * wm + 32 * jn + r32; const float bias = bs_[h * 128 + p];
#pragma unroll
            for (int i = 0; i < 2; ++i)
#pragma unroll
                for (int rg = 0; rg < 4; ++rg) { const int c = 64 * wn + 32 * i + 8 * rg + 4 * hi;
                    v2u w; w.x = pk2(acc[i][jn][4 * rg] + bias, acc[i][jn][4 * rg + 1] + bias); w.y = pk2(acc[i][jn][4 * rg + 2] + bias, acc[i][jn][4 * rg + 3] + bias);
                    *(LAS v2u*)(OUT + p * OP + c) = w; } }
        __syncthreads();
#ifdef GATE_DUP_EPI
        for (int dup_ = 0; dup_ < 2; ++dup_) {
#endif
#pragma unroll
        for (int j = 0; j < 8; ++j) { const int p = (tid >> 5) + 16 * j; const size_t off = (size_t)(t0 + p) * GM_HALF + h * 256 + 8 * ck;
            const v4u oo = *(const LAS v4u*)(OUT + p * OP + 8 * ck); v4u g;
#pragma unroll
            for (int e = 0; e < 4; ++e) g[e] = pk2(bf_lo(uo[j][e]) * bf_lo(oo[e]), bf_hi(uo[j][e]) * bf_hi(oo[e]));
            *(v4u*)(GG + off) = g; }
#ifdef GATE_DUP_EPI
        }
#endif
        __syncthreads();
    }
}
__device__ __forceinline__ void gate_phase(Frame& F) {
    for (int uid = F.bx; uid < 2 * (NLAT / 128); uid += F.G) gate_unit(F, (uid >> 1) * 128, 4 * (uid & 1), 4, true);
    if ((F.bx & 15) == 0 && (F.bx >> 4) < 16) { const int su = F.bx >> 4; gate_unit(F, NLAT + (su >> 3) * 128, su & 7, 1, true); }
}

template <int MODE> __device__ __forceinline__ void attn_phase(Frame& F, char* lds_generic) {
    using abf = attn_body::bf16;
    const abf* Q = (const abf*)(F.ws + WS_Q); const abf* K = (const abf*)(F.ws + WS_K); const abf* V = (const abf*)(F.ws + WS_V); abf* O = (abf*)(F.ws + WS_O);
    constexpr int U = 1024; const int per = (U + F.G - 1) / F.G;
    float mstat = 0.f;
    if (MODE == 0) { const float* gq = argp(I_FAQN); const float* gk = argp(I_FAKN); float mq = 0.f, mk = 0.f;
        for (int d = 0; d < 64; ++d) { mq = fmaxf(mq, fabsf(gq[d])); mk = fmaxf(mk, fabsf(gk[d])); }
        mstat = fminf(64.f * QSCALE * mq * mk, 100.f); }
    for (int i = 0; i <= per; ++i) {
        int h, kvh, q0, NT, kbase; float sink = 0.f;
        if (i < per) { const int id = F.vcu * per + i; if (id >= U) continue; const int x = id >> 7, r = id & 127; const int qb = (r >> 2) * 2 + (r & 1);
            q0 = 256 * qb;
            if (MODE == 0) { kvh = x >> 1; h = kvh * 4 + (x & 1) * 2 + ((r & 3) >> 1); NT = T / 64; kbase = 0; }
            else { h = 2 * x + ((r & 3) >> 1); kvh = h >> 3; const int ks = q0 >= 128 ? q0 - 128 : 0, ke = (q0 + 384) < NLAT ? (q0 + 384) : NLAT; kbase = ks; NT = 4 + (ke - ks) / 64; sink = argp(I_WASK)[h] * LOG2E; } }
        else { if (MODE != 0) continue; if ((F.vcu & 15) != 0 || (F.vcu >> 4) >= 16) continue; h = F.vcu >> 4; kvh = h >> 2; q0 = NLAT; NT = 4; kbase = NLAT; }
        if constexpr (MODE == 0) attn_body::attn_unit_q8<256>(h, kvh, q0, NT, kbase, mstat, (const unsigned char*)(F.ws + WS_Q8), (const unsigned char*)(F.ws + WS_K8), V, O, lds_generic);
        else attn_body::attn_unit<1, 128, 8>(h, kvh, q0, NT, kbase, sink, Q, K, V, O, lds_generic);
    }
}
struct CtxEpiY { bf16* Y; const float* bias;
    __device__ __forceinline__ void operator()(int row, int col, float (&v)[4]) const { const f32x4 b = *(const f32x4*)(bias + col);
        v2u w; w.x = pk2(v[0] + b[0], v[1] + b[1]); w.y = pk2(v[2] + b[2], v[3] + b[3]); *(v2u*)(Y + (size_t)row * DM + col) = w; } };
struct CtxEpiGelu { bf16* U; bf16* V; const float* bias; float* pstat;
    __device__ __forceinline__ void operator()(int row, int col, float (&v)[4]) const { const f32x4 b = *(const f32x4*)(bias + col);
        const pg8::f32x2 a = pg8::gelu_pk((pg8::f32x2){v[0] + b[0], v[1] + b[1]}), c = pg8::gelu_pk((pg8::f32x2){v[2] + b[2], v[3] + b[3]});
        v2u w; w.x = pk2(a.x, a.y); w.y = pk2(c.x, c.y); bf16* dst = col < GM_HALF ? U + (size_t)row * GM_HALF + col : V + (size_t)row * GM_HALF + (col - GM_HALF); *(v2u*)dst = w;
        if (col >= GM_HALF) { float s = (a.x + a.y) + (c.x + c.y), s2 = (a.x * a.x + a.y * a.y) + (c.x * c.x + c.y * c.y);
            s += __shfl_xor(s, 1); s += __shfl_xor(s, 2); s += __shfl_xor(s, 4); s += __shfl_xor(s, 8); s2 += __shfl_xor(s2, 1); s2 += __shfl_xor(s2, 2); s2 += __shfl_xor(s2, 4); s2 += __shfl_xor(s2, 8);
            if ((col & 63) == 0) *(f32x2*)(pstat + ((size_t)row * 32 + ((col - GM_HALF) >> 6)) * 2) = (f32x2){s, s2}; } } };
template <int NKV, bool RMS> struct CtxEpiQKV { bf16* Q; const float* bias; const float* qn; const float* kn;
    __device__ __forceinline__ void operator()(int row, int col, float (&v)[4]) const {
        const int hh = col >> 6, d = col & 63; const int kind = hh < 16 ? 0 : (hh < 16 + NKV ? 1 : 2);
        const f32x4 b = *(const f32x4*)(bias + col);
#pragma unroll
        for (int i = 0; i < 4; ++i) v[i] += b[i];
        if (RMS) { float ss = (v[0] * v[0] + v[1] * v[1]) + (v[2] * v[2] + v[3] * v[3]);
            ss += __shfl_xor(ss, 1); ss += __shfl_xor(ss, 2); ss += __shfl_xor(ss, 4); ss += __shfl_xor(ss, 8);
            const float rs = 1.f / sqrtf(ss * (1.f / 64.f) + RMS_EPS); const f32x4 gq = *(const f32x4*)(qn + d), gk = *(const f32x4*)(kn + d);
            if (kind < 2) {
#pragma unroll
                for (int i = 0; i < 4; ++i) v[i] = v[i] * rs * (kind == 0 ? gq[i] : gk[i]); } }
        if (kind == 0) {
#pragma unroll
            for (int i = 0; i < 4; ++i) v[i] *= QSCALE; }
        const int pitch = kind == 0 ? DM : NKV * 64, hd = kind == 0 ? hh : (kind == 1 ? hh - 16 : hh - 16 - NKV);
        const size_t doff = kind == 0 ? (size_t)0 : (kind == 1 ? (size_t)(WS_K - WS_Q) : (size_t)(WS_V - WS_Q));
        if (RMS && kind < 2) { *(unsigned*)((char*)Q + (kind == 0 ? (size_t)(WS_Q8 - WS_Q) : (size_t)(WS_K8 - WS_Q)) + (size_t)row * pitch + hd * 64 + d) = pk4f8(v[0], v[1], v[2], v[3]); return; }
        v2u w; w.x = pk2(v[0], v[1]); w.y = pk2(v[2], v[3]); *(v2u*)((bf16*)((char*)Q + doff) + (size_t)row * pitch + hd * 64 + d) = w; } };
template <class Epi> __device__ __forceinline__ void ctx_gemm(Frame& F, const bf16* A, const bf16* Bt, int N, int K, int rowmode, const Epi& E) {
    const int tid = otid(), lane = tid & 63, r32 = lane & 31, hi = lane >> 5;
    LAS float* PART = (LAS float*)(F.lds);
    const int nblk = 8 * (N / 64), kw = K / 8;
    for (int b = F.bx; b < nblk; b += F.G) { const int rb = b & 7, cb = b >> 3;
        const bf16* ap = A + (size_t)(NLAT + rb * 32 + r32) * K + F.wave * kw + 8 * hi;
        const int n0 = cb * 64 + r32, n1 = n0 + 32;
        const bf16* bp0 = Bt + (size_t)(rowmode ? qkv_rowmap(n0) : n0) * K + F.wave * kw + 8 * hi;
        const bf16* bp1 = Bt + (size_t)(rowmode ? qkv_rowmap(n1) : n1) * K + F.wave * kw + 8 * hi;
        f32x16 acc0 = f32x16{}, acc1 = f32x16{};
        for (int k = 0; k < kw; k += 128) { bf16x8 a[8], b0[8], b1[8];
#pragma unroll
            for (int i = 0; i < 8; ++i) { a[i] = *(const bf16x8*)(ap + k + 16 * i); b0[i] = *(const bf16x8*)(bp0 + k + 16 * i); b1[i] = *(const bf16x8*)(bp1 + k + 16 * i); }
#pragma unroll
            for (int i = 0; i < 8; ++i) { acc0 = __builtin_amdgcn_mfma_f32_32x32x16_bf16(a[i], b0[i], acc0, 0, 0, 0); acc1 = __builtin_amdgcn_mfma_f32_32x32x16_bf16(a[i], b1[i], acc1, 0, 0, 0); } }
#pragma unroll
        for (int r = 0; r < 16; ++r) { const int rw = (r & 3) + 8 * (r >> 2) + 4 * hi; PART[(F.wave * 32 + rw) * 66 + r32] = acc0[r]; PART[(F.wave * 32 + rw) * 66 + 32 + r32] = acc1[r]; }
        __syncthreads();
        { const int row = tid >> 4, c4 = (tid & 15) * 4; float v[4] = {0.f, 0.f, 0.f, 0.f};
#pragma unroll
            for (int w = 0; w < 8; ++w) { const LAS float* p = PART + (w * 32 + row) * 66 + c4; v[0] += p[0]; v[1] += p[1]; v[2] += p[2]; v[3] += p[3]; }
            E(NLAT + rb * 32 + row, cb * 64 + c4, v); }
        __syncthreads();
    }
}
struct Args { const float* in[N_IN]; float* out; unsigned char* ws; int ph_lo, ph_hi; };
static_assert(sizeof(Args) == N_IN * 8 + 8 + 8 + 8, "Args has no padding");

#ifndef MOE_WGM_UP
#define MOE_WGM_UP 4
#endif
#ifndef MOE_WGM_DN
#define MOE_WGM_DN 4
#endif
template <int ACT> __device__ __forceinline__ void tok_gemm(Frame& F, const bf16* A, const bf16* Bt, int N, int K, const pg8::EpiBf16<ACT>& E) {
    pg8::Gemm g{A, Bt, K, K, K, (unsigned)(128 * K * 2), (unsigned)(128 * K * 2)};
    TokOrder S; S.init(NLAT / 256, N / 256, F.G, F.bx); S.apan = (size_t)256 * K * 2; S.bpan = (size_t)256 * K * 2;
    pg8::gemm_phase<pg8::EpiBf16<ACT>, TokOrder, true, true>(F.lds + RING_OFF, g, S, E);
}
template <int L> __device__ __forceinline__ void moe_up(Frame& F) {
    moe_tables<L>(F);
    pg8::Gemm g{(const bf16*)(F.ws + WS_H8), (const bf16*)(F.ws + WS_WEXP_GU + (size_t)L * 32 * 2048 * 1024), 512, 512, 512, 128 * 512 * 2, 128 * 512 * 2};
    MoeOrderG S; S.init((int)F.MISC[MW_NMT], 8, F.G, F.bx, MOE_WGM_UP); S.mte = F.MISC + MW_MTE; S.bexp = (size_t)2048 * 1024; S.bpan = (size_t)256 * 1024; S.stok = (const unsigned*)(F.ws + WS_STOK); S.rowbytes = 1024u;
    EpiSwiGLU E{(unsigned char*)(F.ws + WS_ACT), argp(I_EBGU) + (size_t)L * 32 * 2048};
    pg8::gemm_phase<EpiSwiGLU, MoeOrderG, true, true, true, true>(F.lds + RING_OFF, g, S, E);
    if (CONV_DEFER && L < 3) {
        conv_tail(F, L + 1, ((int)F.MISC[MW_NMT] * 8) % F.G, CONV_UP_PER); }
}
template <int L> __device__ __forceinline__ void moe_down(Frame& F) {
    if (MK_PER_PHASE) moe_tables<L>(F);
    pg8::Gemm g{(const bf16*)(F.ws + WS_ACT), (const bf16*)(F.ws + WS_WEXP_DN + (size_t)L * 32 * 1024 * 1024), 512, 512, 512, 128 * 512 * 2, 128 * 512 * 2};
    MoeOrder S; S.init((int)F.MISC[MW_NMT], 4, F.G, F.bx, MOE_WGM_DN); S.mte = F.MISC + MW_MTE; S.bexp = (size_t)1024 * 1024; S.apan = (size_t)256 * 1024; S.bpan = (size_t)256 * 1024;
    EpiDown E{(bf16*)(F.ws + WS_YS), argp(I_EBD) + (size_t)L * 32 * 1024, (const unsigned*)(F.ws + WS_STOK)};
    pg8::gemm_phase<EpiDown, MoeOrder, true, true, false, true>(F.lds + RING_OFF, g, S, E);
    if (CONV_DEFER && L < 3) {
        conv_tail(F, L + 1, ((int)F.MISC[MW_NMT] * 4) % F.G, CONV_DN_PER); }
}

__global__ void __launch_bounds__(NTHR, 2) mk_fwd(Args args) {
    extern __shared__ __attribute__((aligned(16))) unsigned char lds[];
    Frame F;
    F.lds = (LAS unsigned char*)lds;
    F.MISC = (volatile LAS unsigned*)(F.lds + MISC_OFF);
    F.wave = __builtin_amdgcn_readfirstlane((int)threadIdx.x >> 6);
    F.G = gridDim.x; F.bx = blockIdx.x; F.vcu = (F.G % 8 == 0) ? (F.bx % 8) * (F.G / 8) + F.bx / 8 : F.bx;
    F.ws = args.ws; F.ctl = (gu32*)(args.ws + WS_CTL);
    for (int u = threadIdx.x; u < (LDS_BYTES - MISC_OFF) / 4; u += NTHR) ((LAS unsigned*)(F.lds + MISC_OFF))[u] = 0u;
    __syncthreads();
    XcdBarrier bar; bar.bar = (unsigned*)(F.ctl + CW_BAR); bar.x = 0; bar.st = nullptr;
    if (!MK_PER_PHASE) bar = xcd_barrier_post((unsigned*)(F.ctl + CW_BAR), F.MISC + MW_BAR);
    const int lo = args.ph_lo, hi = args.ph_hi;
#ifdef MK_ONLY
#define IN(k) ((k) == MK_ONLY && lo <= (k))
#else
#define IN(k) (lo <= (k) && (k) < hi)
#endif
#define SEAM(k) do { if (IN(k) && IN((k) + 1)) xcd_barrier(bar); } while (0)
#ifdef MK_REP_MASK
#define REP(k) (((MK_REP_MASK >> (k)) & 1ull) ? 2 : 1)
#else
#define REP(k) 1
#endif
#ifdef MK_PROBE_MASK
#define STAMP(k) do { if (threadIdx.x == 0) { const unsigned long long t_ = __builtin_amdgcn_s_memrealtime(); F.MISC[512 + 2 * (k)] = (unsigned)t_; F.MISC[513 + 2 * (k)] = (unsigned)(t_ >> 32); } } while (0)
#else
#define STAMP(k) do {} while (0)
#endif
    const bf16* Hb = (const bf16*)(F.ws + WS_H); bf16* Yb = (bf16*)(F.ws + WS_Y);

    STAMP(0); if (IN(0)) for (int rep_ = 0; rep_ < REP(0); ++rep_) { if (rep_) xcd_barrier(bar); asm volatile("; MK_PHASE_0" ::: "memory"); p0_prologue(F); } SEAM(0);
    STAMP(1); if (IN(1)) for (int rep_ = 0; rep_ < REP(1); ++rep_) { if (rep_) xcd_barrier(bar); asm volatile("; MK_PHASE_1" ::: "memory"); pass_init(F); } SEAM(1);
    STAMP(2); if (IN(2)) for (int rep_ = 0; rep_ < REP(2); ++rep_) { if (rep_) xcd_barrier(bar); asm volatile("; MK_PHASE_2" ::: "memory"); if ((EN_MIX >> 0) & 1) {
        { pg8::Gemm g{(const bf16*)(F.ws + TB_FC), Hb, 256, 256, 128 * DM, 128 * 256 * 2, DM * 2};
          ChDftOrder S; S.init(2, 256, F.G, F.bx); EpiChDft E{(bf16*)(F.ws + WS_BTA)};
          pg8::gemm_phase<EpiChDft, ChDftOrder, true, true>(F.lds + RING_OFF, g, S, E); }
#ifndef NO_CTX_DFT
        { pg8::Gemm g{(const bf16*)(F.ws + TB_FC), Hb, 256, 256, DM, 128 * 256 * 2, 128 * DM * 2};
          ChDftCtxOrder S; S.init(2, 4, F.G, F.bx); EpiChDftCtx E{(bf16*)(F.ws + WS_BTX)};
          pg8::gemm_phase<EpiChDftCtx, ChDftCtxOrder, true, true>(F.lds + RING_OFF, g, S, E); }
#endif
        } } SEAM(2);
    STAMP(3); if (IN(3)) for (int rep_ = 0; rep_ < REP(3); ++rep_) { if (rep_) xcd_barrier(bar); asm volatile("; MK_PHASE_3" ::: "memory"); if ((EN_MIX >> 0) & 1) {
        { pg8::Gemm g{(const bf16*)(F.ws + TB_FA), (const bf16*)(F.ws + WS_BTA), 256, 256, 256, 128 * 256 * 2, 128 * 256 * 2};
          TokOrder S; S.init(1, 512, F.G, F.bx); S.apan = 0; S.bpan = (size_t)256 * 256 * 2;
          EpiStepA E{(bf16*)(F.ws + WS_BTC), (const float*)(F.ws + TB_TWC), (const float*)(F.ws + TB_TWS)};
          pg8::gemm_phase<EpiStepA, TokOrder, true, true>(F.lds + RING_OFF, g, S, E); }
        } } SEAM(3);
    STAMP(4); if (IN(4)) for (int rep_ = 0; rep_ < REP(4); ++rep_) { if (rep_) xcd_barrier(bar); asm volatile("; MK_PHASE_4" ::: "memory"); if ((EN_MIX >> 0) & 1) {
        { pg8::Gemm g{(const bf16*)(F.ws + TB_FCC), (const bf16*)(F.ws + WS_BTC), 256, 256, 256, 128 * 256 * 2, 128 * 256 * 2};
        TokOrder S; S.init(1, 512, F.G, F.bx); S.apan = 0; S.bpan = (size_t)256 * 256 * 2;
        EpiStepC E{(bf16*)(F.ws + WS_MIXB)};
        pg8::gemm_phase<EpiStepC, TokOrder, true, true>(F.lds + RING_OFF, g, S, E); }
#ifndef NO_CTX_DFT
        { pg8::Gemm g{(const bf16*)(F.ws + TB_FX), (const bf16*)(F.ws + WS_BTX), 512, 512, 512, 128 * 512 * 2, 128 * 512 * 2};
          TokOrder S; S.init(1, 4, F.G, F.bx); S.apan = 0; S.bpan = (size_t)256 * 512 * 2;
          EpiCtxPos E{(bf16*)(F.ws + WS_MIXB)};
          pg8::gemm_phase<EpiCtxPos, TokOrder, true, true>(F.lds + RING_OFF, g, S, E); }
#endif
        } } SEAM(4);
    STAMP(5); if (IN(5)) for (int rep_ = 0; rep_ < REP(5); ++rep_) { if (rep_) xcd_barrier(bar); asm volatile("; MK_PHASE_5" ::: "memory"); if ((EN_MIX >> 0) & 1) { pg8::EpiBf16<0> E{Yb, DM, argp(I_FNB), 0, 0, 1.f}; tok_gemm<0>(F, (const bf16*)(F.ws + WS_MIXB), (const bf16*)(F.ws + WS_WFN), DM, DM, E);
        ctx_gemm(F, (const bf16*)(F.ws + WS_MIXB), (const bf16*)(F.ws + WS_WFN), DM, DM, 0, CtxEpiY{Yb, argp(I_FNB)}); } } SEAM(5);
    STAMP(6); if (IN(6)) for (int rep_ = 0; rep_ < REP(6); ++rep_) { if (rep_) xcd_barrier(bar); asm volatile("; MK_PHASE_6" ::: "memory"); pass_mix<0>(F); } SEAM(6);
    STAMP(7); if (IN(7)) for (int rep_ = 0; rep_ < REP(7); ++rep_) { if (rep_) xcd_barrier(bar); asm volatile("; MK_PHASE_7" ::: "memory"); }
    STAMP(8); if (IN(8)) for (int rep_ = 0; rep_ < REP(8); ++rep_) { if (rep_) xcd_barrier(bar); asm volatile("; MK_PHASE_8" ::: "memory"); if ((EN_MOE >> 0) & 1) moe_up<0>(F); } SEAM(8);
    STAMP(9); if (IN(9)) for (int rep_ = 0; rep_ < REP(9); ++rep_) { if (rep_) xcd_barrier(bar); asm volatile("; MK_PHASE_9" ::: "memory"); if ((EN_MOE >> 0) & 1) moe_down<0>(F); } SEAM(9);
    STAMP(10); if (IN(10)) for (int rep_ = 0; rep_ < REP(10); ++rep_) { if (rep_) xcd_barrier(bar); asm volatile("; MK_PHASE_10" ::: "memory"); pass_comb<0>(F); } SEAM(10);
    STAMP(11); if (IN(11)) for (int rep_ = 0; rep_ < REP(11); ++rep_) { if (rep_) xcd_barrier(bar); asm volatile("; MK_PHASE_11" ::: "memory"); if ((EN_MIX >> 1) & 1) {
        pg8::Gemm g{Hb, (const bf16*)(F.ws + WS_WFAQ), DM, DM, DM, 128 * DM * 2, 128 * DM * 2};
        TokOrder S; S.init(NLAT / 256, FA_NQKV / 256, F.G, F.bx); S.apan = (size_t)256 * DM * 2; S.bpan = (size_t)256 * DM * 2;
        EpiQKV<4, true> E{(bf16*)(F.ws + WS_Q), (bf16*)(F.ws + WS_K), (bf16*)(F.ws + WS_V), argp(I_FABQ), argp(I_FAQN), argp(I_FAKN), (const float*)(F.ws + TB_ROPC), (const float*)(F.ws + TB_ROPS)};
        pg8::gemm_phase<EpiQKV<4, true>, TokOrder, true, true>(F.lds + RING_OFF, g, S, E);
        if (CONV_DEFER) conv_tail(F, 1, ((NLAT / 256) * (FA_NQKV / 256)) % F.G, CONV_QKV_PER);
        ctx_gemm(F, Hb, (const bf16*)(F.ws + WS_WFAQ), FA_NQKV, DM, 1, CtxEpiQKV<4, true>{(bf16*)(F.ws + WS_Q), argp(I_FABQ), argp(I_FAQN), argp(I_FAKN)}); } } SEAM(11);
    STAMP(12); if (IN(12)) for (int rep_ = 0; rep_ < REP(12); ++rep_) { if (rep_) xcd_barrier(bar); asm volatile("; MK_PHASE_12" ::: "memory"); if ((EN_MIX >> 1) & 1) attn_phase<0>(F, (char*)lds + RING_OFF); } SEAM(12);
    STAMP(13); if (IN(13)) for (int rep_ = 0; rep_ < REP(13); ++rep_) { if (rep_) xcd_barrier(bar); asm volatile("; MK_PHASE_13" ::: "memory"); if ((EN_MIX >> 1) & 1) { pg8::EpiBf16<0> E{Yb, DM, argp(I_FABO), 0, 0, 1.f}; tok_gemm<0>(F, (const bf16*)(F.ws + WS_O), (const bf16*)(F.ws + WS_WFAO), DM, DM, E);
        ctx_gemm(F, (const bf16*)(F.ws + WS_O), (const bf16*)(F.ws + WS_WFAO), DM, DM, 0, CtxEpiY{Yb, argp(I_FABO)}); } } SEAM(13);
    STAMP(14); if (IN(14)) for (int rep_ = 0; rep_ < REP(14); ++rep_) { if (rep_) xcd_barrier(bar); asm volatile("; MK_PHASE_14" ::: "memory"); pass_mix<1>(F); } SEAM(14);
    STAMP(15); if (IN(15)) for (int rep_ = 0; rep_ < REP(15); ++rep_) { if (rep_) xcd_barrier(bar); asm volatile("; MK_PHASE_15" ::: "memory"); }
    STAMP(16); if (IN(16)) for (int rep_ = 0; rep_ < REP(16); ++rep_) { if (rep_) xcd_barrier(bar); asm volatile("; MK_PHASE_16" ::: "memory"); if ((EN_MOE >> 1) & 1) moe_up<1>(F); } SEAM(16);
    STAMP(17); if (IN(17)) for (int rep_ = 0; rep_ < REP(17); ++rep_) { if (rep_) xcd_barrier(bar); asm volatile("; MK_PHASE_17" ::: "memory"); if ((EN_MOE >> 1) & 1) moe_down<1>(F); } SEAM(17);
    STAMP(18); if (IN(18)) for (int rep_ = 0; rep_ < REP(18); ++rep_) { if (rep_) xcd_barrier(bar); asm volatile("; MK_PHASE_18" ::: "memory"); pass_comb<1>(F); } SEAM(18);
    STAMP(19); if (IN(19)) for (int rep_ = 0; rep_ < REP(19); ++rep_) { if (rep_) xcd_barrier(bar); asm volatile("; MK_PHASE_19" ::: "memory"); if ((EN_MIX >> 2) & 1) {
        { pg8::Gemm g{Hb, (const bf16*)(F.ws + WS_WGI), DM, DM, DM, 128 * DM * 2, 128 * DM * 2};
          TokOrder S; S.init(NLAT / 256, GM_FF / 256, F.G, F.bx); S.apan = (size_t)256 * DM * 2; S.bpan = (size_t)256 * DM * 2;
          EpiGeluUV E{(bf16*)(F.ws + WS_GU), (bf16*)(F.ws + WS_GV), argp(I_GMBI), (float*)(F.ws + WS_PSTAT)};
          pg8::gemm_phase<EpiGeluUV, TokOrder, true, true>(F.lds + RING_OFF, g, S, E); }
        ctx_gemm(F, Hb, (const bf16*)(F.ws + WS_WGI), GM_FF, DM, 0, CtxEpiGelu{(bf16*)(F.ws + WS_GU), (bf16*)(F.ws + WS_GV), argp(I_GMBI), (float*)(F.ws + WS_PSTAT)}); } } SEAM(19);
    STAMP(20); if (IN(20)) for (int rep_ = 0; rep_ < REP(20); ++rep_) { if (rep_) xcd_barrier(bar); asm volatile("; MK_PHASE_20" ::: "memory"); if ((EN_MIX >> 2) & 1) gate_phase(F); } SEAM(20);
    STAMP(21); if (IN(21)) for (int rep_ = 0; rep_ < REP(21); ++rep_) { if (rep_) xcd_barrier(bar); asm volatile("; MK_PHASE_21" ::: "memory"); if ((EN_MIX >> 2) & 1) { pg8::EpiBf16<0> E{Yb, DM, argp(I_GMBO), 0, 0, 1.f}; tok_gemm<0>(F, (const bf16*)(F.ws + WS_GG), (const bf16*)(F.ws + WS_WGO), DM, GM_HALF, E);
        ctx_gemm(F, (const bf16*)(F.ws + WS_GG), (const bf16*)(F.ws + WS_WGO), DM, GM_HALF, 0, CtxEpiY{Yb, argp(I_GMBO)}); } } SEAM(21);
    STAMP(22); if (IN(22)) for (int rep_ = 0; rep_ < REP(22); ++rep_) { if (rep_) xcd_barrier(bar); asm volatile("; MK_PHASE_22" ::: "memory"); pass_mix<2>(F); } SEAM(22);
    STAMP(23); if (IN(23)) for (int rep_ = 0; rep_ < REP(23); ++rep_) { if (rep_) xcd_barrier(bar); asm volatile("; MK_PHASE_23" ::: "memory"); }
    STAMP(24); if (IN(24)) for (int rep_ = 0; rep_ < REP(24); ++rep_) { if (rep_) xcd_barrier(bar); asm volatile("; MK_PHASE_24" ::: "memory"); if ((EN_MOE >> 2) & 1) moe_up<2>(F); } SEAM(24);
    STAMP(25); if (IN(25)) for (int rep_ = 0; rep_ < REP(25); ++rep_) { if (rep_) xcd_barrier(bar); asm volatile("; MK_PHASE_25" ::: "memory"); if ((EN_MOE >> 2) & 1) moe_down<2>(F); } SEAM(25);
    STAMP(26); if (IN(26)) for (int rep_ = 0; rep_ < REP(26); ++rep_) { if (rep_) xcd_barrier(bar); asm volatile("; MK_PHASE_26" ::: "memory"); pass_comb<2>(F); } SEAM(26);
    STAMP(27); if (IN(27)) for (int rep_ = 0; rep_ < REP(27); ++rep_) { if (rep_) xcd_barrier(bar); asm volatile("; MK_PHASE_27" ::: "memory"); if ((EN_MIX >> 3) & 1) {
        pg8::Gemm g{Hb, (const bf16*)(F.ws + WS_WWQ), DM, DM, DM, 128 * DM * 2, 128 * DM * 2};
        TokOrder S; S.init(NLAT / 256, WA_NQKV / 256, F.G, F.bx); S.apan = (size_t)256 * DM * 2; S.bpan = (size_t)256 * DM * 2;
        EpiQKV<2, false> E{(bf16*)(F.ws + WS_Q), (bf16*)(F.ws + WS_K), (bf16*)(F.ws + WS_V), argp(I_WABQ), nullptr, nullptr, (const float*)(F.ws + TB_ROPC), (const float*)(F.ws + TB_ROPS)};
        pg8::gemm_phase<EpiQKV<2, false>, TokOrder, true, true>(F.lds + RING_OFF, g, S, E);
        if (CONV_DEFER) conv_tail(F, 3, ((NLAT / 256) * (WA_NQKV / 256)) % F.G, CONV_QKV_PER);
        ctx_gemm(F, Hb, (const bf16*)(F.ws + WS_WWQ), WA_NQKV, DM, 1, CtxEpiQKV<2, false>{(bf16*)(F.ws + WS_Q), argp(I_WABQ), argp(I_WABQ), argp(I_WABQ)}); } } SEAM(27);
    STAMP(28); if (IN(28)) for (int rep_ = 0; rep_ < REP(28); ++rep_) { if (rep_) xcd_barrier(bar); asm volatile("; MK_PHASE_28" ::: "memory"); if ((EN_MIX >> 3) & 1) attn_phase<1>(F, (char*)lds + RING_OFF); } SEAM(28);
    STAMP(29); if (IN(29)) for (int rep_ = 0; rep_ < REP(29); ++rep_) { if (rep_) xcd_barrier(bar); asm volatile("; MK_PHASE_29" ::: "memory"); if ((EN_MIX >> 3) & 1) { pg8::EpiBf16<0> E{Yb, DM, argp(I_WABO), 0, 0, 1.f}; tok_gemm<0>(F, (const bf16*)(F.ws + WS_O), (const bf16*)(F.ws + WS_WWO), DM, DM, E); } } SEAM(29);
    STAMP(30); if (IN(30)) for (int rep_ = 0; rep_ < REP(30); ++rep_) { if (rep_) xcd_barrier(bar); asm volatile("; MK_PHASE_30" ::: "memory"); pass_mix<3>(F); } SEAM(30);
    STAMP(31); if (IN(31)) for (int rep_ = 0; rep_ < REP(31); ++rep_) { if (rep_) xcd_barrier(bar); asm volatile("; MK_PHASE_31" ::: "memory"); }
    STAMP(32); if (IN(32)) for (int rep_ = 0; rep_ < REP(32); ++rep_) { if (rep_) xcd_barrier(bar); asm volatile("; MK_PHASE_32" ::: "memory"); if ((EN_MOE >> 3) & 1) moe_up<3>(F); } SEAM(32);
    STAMP(33); if (IN(33)) for (int rep_ = 0; rep_ < REP(33); ++rep_) { if (rep_) xcd_barrier(bar); asm volatile("; MK_PHASE_33" ::: "memory"); if ((EN_MOE >> 3) & 1) moe_down<3>(F); } SEAM(33);
    STAMP(34); if (IN(34)) for (int rep_ = 0; rep_ < REP(34); ++rep_) { if (rep_) xcd_barrier(bar); asm volatile("; MK_PHASE_34" ::: "memory"); pass_comb<3>(F); }
#ifdef MK_PROBE_MASK
    STAMP(35); __syncthreads();
    { float us = 0.f;
      for (int k = 0; k < 35; ++k) if ((MK_PROBE_MASK >> k) & 1ull) { const unsigned long long a = ((unsigned long long)F.MISC[513 + 2 * k] << 32) | F.MISC[512 + 2 * k], b = ((unsigned long long)F.MISC[515 + 2 * k] << 32) | F.MISC[514 + 2 * k]; us += (float)(b - a) * 0.01f; }
      const float cval = us / (float)(MK_PROBE_DIV);
      const int lane = threadIdx.x & 63, gw = F.vcu * NWAVES + F.wave, NGW = F.G * NWAVES; RowV r;
      for (int j = 0; j < 4; ++j) r.v[j] = (f32x4){cval, cval, cval, cval};
      float* outp = (float*)argp(N_IN);
      for (int m = gw; m < NLAT; m += NGW) strow(outp + (size_t)m * DM, lane, r); }
#endif
#undef IN
#undef SEAM
}

extern "C" void kernel_launch(void* const* d_in, const int* in_sizes, int n_in, void* d_out, int out_size, void* d_ws, size_t ws_size, hipStream_t stream) {
    static int grid = 0;
    if (grid == 0) {
        if (n_in != N_IN || in_sizes[0] != NLAT * DM || out_size != NLAT * DM || ws_size < WS_END) { fprintf(stderr, "kernel_launch: unexpected shapes (n_in %d, in0 %d, out %d, ws %zu)\n", n_in, n_in > 0 ? in_sizes[0] : -1, out_size, ws_size); grid = -1; return; }
        int dev = 0, cus = 0, per_cu = 0;
        if (hipGetDevice(&dev) != hipSuccess || hipDeviceGetAttribute(&cus, hipDeviceAttributeMultiprocessorCount, dev) != hipSuccess) { grid = -1; return; }
        if (hipFuncSetAttribute((const void*)mk_fwd, hipFuncAttributeMaxDynamicSharedMemorySize, LDS_BYTES) != hipSuccess) { fprintf(stderr, "kernel_launch: hipFuncSetAttribute failed\n"); grid = -1; return; }
        if (hipOccupancyMaxActiveBlocksPerMultiprocessor(&per_cu, (const void*)mk_fwd, NTHR, LDS_BYTES) != hipSuccess || per_cu < 1) fprintf(stderr, "kernel_launch: occupancy query says %d\n", per_cu);
        (void)hipGetLastError();
        grid = cus;
    }
    if (grid < 0) return;
    if (hipMemsetAsync((char*)d_ws + WS_CTL, 0, CTL_ZERO_BYTES, stream) != hipSuccess) return;
    Args a{};
    for (int i = 0; i < N_IN; ++i) a.in[i] = (const float*)d_in[i];
    a.out = (float*)d_out; a.ws = (unsigned char*)d_ws;
#if MK_PER_PHASE
    for (int p = 0; p < NPHASE; ++p) { a.ph_lo = p; a.ph_hi = p + 1; hipLaunchKernelGGL(mk_fwd, dim3(grid), dim3(NTHR), LDS_BYTES, stream, a); }
#else
    a.ph_lo = 0; a.ph_hi = NPHASE; hipLaunchKernelGGL(mk_fwd, dim3(grid), dim3(NTHR), LDS_BYTES, stream, a);
#endif
}
```

```cpp
#define MK_PER_PHASE 0
#define EN_MIX 15
#define EN_MOE 15
#include <hip/hip_runtime.h>
#include <hip/hip_bf16.h>
#include <cstdio>
#include <cstdint>
#include <cmath>
#ifndef MK_PER_PHASE
#define MK_PER_PHASE 0
#endif
namespace pg8 {
#define PG8_LAS __attribute__((address_space(3)))
typedef unsigned short bf16_t;
typedef short bf16x8 __attribute__((ext_vector_type(8)));
typedef float f32x4 __attribute__((ext_vector_type(4)));
typedef float f32x2 __attribute__((ext_vector_type(2)));
typedef unsigned u32x4 __attribute__((ext_vector_type(4)));
typedef unsigned u32x2 __attribute__((ext_vector_type(2)));
constexpr int BM = 256, BK = 64, HALF = 128, HTB = HALF * BK * 2  , STAGE_BYTES = 8 * HTB, NXCD = 8, WGM = 2;

__host__ __device__ __forceinline__ int lds_byte(int r, int c) { const int st = (r >> 4) * 2 + (c >> 5), rr = r & 15, cc = c & 31, ob = rr * 64 + cc * 2; return st * 1024 + (ob ^ (((ob >> 9) & 1) << 5)); }
__host__ __device__ __forceinline__ void stage_rc(int b, int& R, int& C) { const int st = b / 1024, sb = b % 1024, swz = sb ^ (((sb >> 9) & 1) << 5); R = (st >> 1) * 16 + swz / 64; C = (st & 1) * 32 + (swz % 64) / 2; }
__host__ __device__ __forceinline__ int perm32(int rho) { const int n = rho >> 4, i = rho & 15; return 8 * (i >> 2) + 4 * n + (i & 3); }

struct Unit { int pm, pn, e; };
struct Gemm { const bf16_t* A; const bf16_t* Bt; int K, lda, ldb; unsigned hstepA, hstepB; };

struct GridOrder {
    int nM, nN, nwg, G, c, wgm;
    __device__ __forceinline__ void init(int nM_, int nN_, int G_, int c_, int wgm_ = WGM) { nM = nM_; nN = nN_; nwg = nM * nN; G = G_; c = c_; wgm = wgm_; }
    __device__ __forceinline__ bool next_mn(int i, int& pm, int& pn) const {
        const long L = (long)i * G + c; if (L >= nwg) return false;
        int wgid = (int)L; { const int q = nwg / NXCD, r = nwg % NXCD, xcd = wgid % NXCD, off = wgid / NXCD; wgid = (xcd < r ? xcd * (q + 1) : r * (q + 1) + (xcd - r) * q) + off; }
        const int nig = wgm * nN, gid = wgid / nig, fm = gid * wgm, gsz = (nM - fm) < wgm ? (nM - fm) : wgm;
        pm = fm + ((wgid % nig) % gsz); pn = (wgid % nig) / gsz; return true;
    }
};
__device__ __forceinline__ unsigned cvt_pk_bf16(float lo, float hi) { unsigned r; asm volatile("v_cvt_pk_bf16_f32 %0, %1, %2" : "=v"(r) : "v"(lo), "v"(hi)); return r; }
__device__ __forceinline__ f32x2 gelu_pk(f32x2 v) {
    const f32x2 av = __builtin_elementwise_abs(v), d = av * 0.2316418882f + 1.0f;
    f32x2 t; t.x = __builtin_amdgcn_rcpf(d.x); t.y = __builtin_amdgcn_rcpf(d.y);
    f32x2 q = t * 0.5307027145f + (-0.7265760135f); q = q * t + 0.7107068705f; q = q * t + (-0.142248368f); q = q * t + 0.127414796f; q = q * t;
    const f32x2 s = (v * v) * (-0.72134752044f);
    f32x2 e; e.x = __builtin_amdgcn_exp2f(s.x); e.y = __builtin_amdgcn_exp2f(s.y);
    const f32x2 m = v * (q * e), r = v - m;
    f32x2 o; o.x = v.x < 0.f ? m.x : r.x; o.y = v.y < 0.f ? m.y : r.y; return o;
}

template <int ACT  > struct EpiBf16 {
    static constexpr bool PERM = true, AFTER_DRAIN = false; static_assert(ACT == 0 || ACT == 1, "EpiBf16: ACT is 0 (none) or 1 (gelu_pk)");
    bf16_t* O; int ldc; const float* bias; int split_cols; size_t split_stride; float scale0;
    __device__ __forceinline__ void operator()(const f32x4 (&acc)[2][2][4][2], const Unit& u, int wr, int wc, int fr, int fq) const {
        const int row0 = u.pm * BM + wr * 64 + fr; int colt = u.pn * BM; bf16_t* base = O;
        float sc = 1.f; if (split_cols) { const int t = colt / split_cols; base += (size_t)t * split_stride; colt -= t * split_cols; if (t == 0) sc = scale0; }
        const int col0 = colt + wc * 32 + 8 * fq, bcol0 = u.pn * BM + wc * 32 + 8 * fq;
        f32x4 bv[2][2];
#pragma unroll
        for (int bj = 0; bj < 2; ++bj)
#pragma unroll
            for (int n = 0; n < 2; ++n) bv[bj][n] = bias ? *(const f32x4*)(bias + bcol0 + bj * HALF + 4 * n) : (f32x4){0.f, 0.f, 0.f, 0.f};
#pragma unroll
        for (int ai = 0; ai < 2; ++ai)
#pragma unroll
            for (int m = 0; m < 4; ++m) { bf16_t* rowp = base + (size_t)(row0 + ai * HALF + m * 16) * ldc + col0;
#pragma unroll
                for (int bj = 0; bj < 2; ++bj) { f32x4 v0 = acc[ai][bj][m][0] + bv[bj][0], v1 = acc[ai][bj][m][1] + bv[bj][1];
                    if (ACT == 1) { f32x2 a = gelu_pk((f32x2){v0[0], v0[1]}), b = gelu_pk((f32x2){v0[2], v0[3]}), c = gelu_pk((f32x2){v1[0], v1[1]}), d = gelu_pk((f32x2){v1[2], v1[3]});
                        v0 = (f32x4){a.x, a.y, b.x, b.y}; v1 = (f32x4){c.x, c.y, d.x, d.y}; }
                    v0 = v0 * sc; v1 = v1 * sc; u32x4 w; w.x = cvt_pk_bf16(v0[0], v0[1]); w.y = cvt_pk_bf16(v0[2], v0[3]); w.z = cvt_pk_bf16(v1[0], v1[1]); w.w = cvt_pk_bf16(v1[2], v1[3]);
                    *(u32x4*)(rowp + bj * HALF) = w; } }
    }
};
typedef int v8i_t __attribute__((ext_vector_type(8))); typedef int v4i_t __attribute__((ext_vector_type(4)));
template <class Epi, class Sched, bool ALIGN_EPI = false, bool SP2 = false, bool GATHER = false, bool F8 = false>
__device__ __forceinline__ void gemm_phase(PG8_LAS unsigned char* lds, const Gemm g, const Sched& S, const Epi& E) {
    int tid_ = threadIdx.x; asm volatile("" : "+v"(tid_));
    const int tid = tid_, wid = __builtin_amdgcn_readfirstlane(tid >> 6), lane = tid & 63, wr = wid >> 2, wc = wid & 3, fr = lane & 15, fq = lane >> 4;
    const int K = g.K; int nt = K / BK; if constexpr (F8) asm volatile("" : "+s"(nt));
    unsigned voffA[2], voffB[2];
#pragma unroll
    for (int i = 0; i < 2; ++i) { int R, C; stage_rc(tid * 16 + i * 8192, R, C); const int Rb = Epi::PERM ? ((R & ~31) + perm32(R & 31)) : R;
        voffA[i] = (unsigned)(R * g.lda + C) * 2u; voffB[i] = (unsigned)(Rb * g.ldb + C) * 2u; }
    const size_t kstep = (size_t)(BK * 2);
    const size_t hstepA = g.hstepA, hstepB = g.hstepB;
    const unsigned ldsw = (unsigned)wid * 1024u;
    const int aoff = lds_byte(wr * 64 + fr, fq * 8), boff = lds_byte(wc * 32 + fr, fq * 8);
#define PG8_SA(b, h) (((b) * 2 + (h)) * HTB)
#define PG8_SB(b, h) ((4 + (b) * 2 + (h)) * HTB)
#define PG8_STAGE(bufoff, gbase, voff) do { _Pragma("unroll") for (int _i = 0; _i < 2; ++_i) { unsigned _vo = (voff)[_i]; asm volatile("" : "+v"(_vo));     \
        __builtin_amdgcn_global_load_lds((const unsigned*)((const char*)(gbase) + _vo), (PG8_LAS unsigned*)(lds + (bufoff) + ldsw + _i * 8192), 16, 0, 0); } } while (0)
#define PG8_CAT8(x, y) __builtin_shufflevector(__builtin_bit_cast(v4i_t, x), __builtin_bit_cast(v4i_t, y), 0, 1, 2, 3, 4, 5, 6, 7)
#define PG8_LDA(dst, b, h) do { _Pragma("unroll") for (int m = 0; m < 4; ++m) { const bf16x8 f0_ = *(const PG8_LAS bf16x8*)(lds + PG8_SA(b, h) + aoff + m * 2048), f1_ = *(const PG8_LAS bf16x8*)(lds + PG8_SA(b, h) + aoff + m * 2048 + 1024); \
        if constexpr (F8) dst##8[m] = PG8_CAT8(f0_, f1_); else { dst[m][0] = f0_; dst[m][1] = f1_; } } } while (0)
#define PG8_LDB(dst, b, h) do { _Pragma("unroll") for (int n = 0; n < 2; ++n) { const bf16x8 f0_ = *(const PG8_LAS bf16x8*)(lds + PG8_SB(b, h) + boff + n * 2048), f1_ = *(const PG8_LAS bf16x8*)(lds + PG8_SB(b, h) + boff + n * 2048 + 1024); \
        if constexpr (F8) dst##8[n] = PG8_CAT8(f0_, f1_); else { dst[n][0] = f0_; dst[n][1] = f1_; } } } while (0)
#define PG8_MMA(ai, bj, At, Bt) do { __builtin_amdgcn_s_setprio(1); _Pragma("unroll") for (int m = 0; m < 4; ++m) _Pragma("unroll") for (int n = 0; n < 2; ++n) { \
        if constexpr (F8) asm volatile("v_mfma_scale_f32_16x16x128_f8f6f4 %0, %1, %2, %0, %3, %3 op_sel_hi:[0,0,0]" : "+v"(acc[ai][bj][m][n]) : "v"(Bt##8[n]), "v"(At##8[m]), "v"(f8scale));   \
        else { _Pragma("unroll") for (int k = 0; k < 2; ++k) acc[ai][bj][m][n] = __builtin_amdgcn_mfma_f32_16x16x32_bf16(Bt[n][k], At[m][k], acc[ai][bj][m][n], 0, 0, 0); } } __builtin_amdgcn_s_setprio(0); } while (0)
#define PG8_WAIT_V(n) asm volatile("s_waitcnt vmcnt(" #n ")" ::: "memory")
#define PG8_WAIT_L(n) asm volatile("s_waitcnt lgkmcnt(" #n ")" ::: "memory")
#define PG8_BAR __builtin_amdgcn_s_barrier()
#define PG8_SCHED __builtin_amdgcn_sched_barrier(0)
    Unit cur, nxt; int ui = 0;
    if (!S.next(0, cur)) return;
    f32x4 acc[2][2][4][2];
#pragma unroll
    for (int a = 0; a < 2; ++a)
#pragma unroll
        for (int b = 0; b < 2; ++b)
#pragma unroll
            for (int m = 0; m < 4; ++m)
#pragma unroll
                for (int n = 0; n < 2; ++n) acc[a][b][m][n] = (f32x4){0.f, 0.f, 0.f, 0.f};
    const int f8scale = 0x7F7F7F7F;
    bf16x8 At[4][2], B0[2][2], B1[2][2]; v8i_t At8[4], B08[2], B18[2];
    const char* cA = (const char*)g.A + S.offA(cur); const char* cB = (const char*)g.Bt + S.offB(cur);
    unsigned va0[2], va1[2], vn0[2], vn1[2];
#define PG8_AOFFS(dst0, dst1, unit) do { _Pragma("unroll") for (int i = 0; i < 2; ++i) { if constexpr (GATHER) { int R, C; stage_rc(tid * 16 + i * 8192, R, C); \
        dst0[i] = S.rowoff(unit, R) + (unsigned)C * 2u; dst1[i] = S.rowoff(unit, R + HALF) + (unsigned)C * 2u; } else { dst0[i] = voffA[i]; dst1[i] = voffA[i] + (unsigned)hstepA; } } } while (0)
    PG8_AOFFS(va0, va1, cur);
    S.a_ready(cur);
    if constexpr (SP2) {
        PG8_STAGE(PG8_SB(0, 0), cB, voffB); PG8_STAGE(PG8_SB(0, 1), cB + hstepB, voffB); PG8_STAGE(PG8_SA(0, 0), cA, va0); PG8_STAGE(PG8_SA(0, 1), cA, va1);
        if (wr == 1) PG8_BAR;
        PG8_WAIT_V(2); PG8_BAR;
        PG8_STAGE(PG8_SB(1, 0), cB + kstep, voffB); PG8_STAGE(PG8_SA(1, 0), cA + kstep, va0); PG8_STAGE(PG8_SB(1, 1), cB + hstepB + kstep, voffB);
        PG8_WAIT_V(6); PG8_BAR;
    } else {
        PG8_STAGE(PG8_SB(0, 0), cB, voffB); PG8_STAGE(PG8_SA(0, 0), cA, va0); PG8_STAGE(PG8_SB(0, 1), cB + hstepB, voffB); PG8_STAGE(PG8_SA(0, 1), cA, va1);
        if (wr == 1) PG8_BAR;
        PG8_WAIT_V(4); PG8_BAR;
        PG8_STAGE(PG8_SB(1, 0), cB + kstep, voffB); PG8_STAGE(PG8_SA(1, 0), cA + kstep, va0); PG8_STAGE(PG8_SB(1, 1), cB + hstepB + kstep, voffB);
        PG8_WAIT_V(6); PG8_BAR;
    }
    for (;;) {
        const bool has_next = S.next(ui + 1, nxt);
        if (GATHER && has_next) PG8_AOFFS(vn0, vn1, nxt); else { vn0[0] = va0[0]; vn0[1] = va0[1]; vn1[0] = va1[0]; vn1[1] = va1[1]; }
        const char* nA = has_next ? (const char*)g.A + S.offA(nxt) : cA; const char* nB = has_next ? (const char*)g.Bt + S.offB(nxt) : cB;
        for (int t = 0; t < nt; t += 2) {
            const bool last = (t == nt - 2);
            const unsigned vs0[2] = {last ? vn0[0] : va0[0], last ? vn0[1] : va0[1]}, vs1[2] = {last ? vn1[0] : va1[0], last ? vn1[1] : va1[1]};
            const char* a1 = cA + (size_t)(t + 1) * kstep;
            const char* a2 = last ? nA : cA + (size_t)(t + 2) * kstep; const char* b2 = last ? nB : cB + (size_t)(t + 2) * kstep;
            const char* a3 = a2 + kstep; const char* b3 = b2 + kstep;
            if (last && has_next) S.a_ready(nxt);
            if constexpr (SP2) {
            PG8_LDB(B0, 0, 0); PG8_LDB(B1, 0, 1); PG8_SCHED; PG8_LDA(At, 0, 0); PG8_STAGE(PG8_SA(1, 1), a1, va1);
            PG8_WAIT_V(8); PG8_WAIT_L(0); PG8_BAR; PG8_MMA(0, 0, At, B0); PG8_MMA(0, 1, At, B1); PG8_BAR; PG8_SCHED;
            PG8_LDA(At, 0, 1); PG8_STAGE(PG8_SB(0, 0), b2, voffB); PG8_STAGE(PG8_SB(0, 1), b2 + hstepB, voffB); PG8_STAGE(PG8_SA(0, 0), a2, vs0);
            PG8_WAIT_V(8); PG8_WAIT_L(0); PG8_BAR; PG8_MMA(1, 0, At, B0); PG8_MMA(1, 1, At, B1); PG8_BAR; PG8_SCHED;
            PG8_LDB(B0, 1, 0); PG8_LDB(B1, 1, 1); PG8_SCHED; PG8_LDA(At, 1, 0); PG8_STAGE(PG8_SA(0, 1), a2, vs1);
            PG8_WAIT_V(8); PG8_WAIT_L(0); PG8_BAR; PG8_MMA(0, 0, At, B0); PG8_MMA(0, 1, At, B1); PG8_BAR; PG8_SCHED;
            PG8_LDA(At, 1, 1); PG8_STAGE(PG8_SB(1, 0), b3, voffB); PG8_STAGE(PG8_SB(1, 1), b3 + hstepB, voffB); PG8_STAGE(PG8_SA(1, 0), a3, vs0);
            PG8_WAIT_V(8); PG8_WAIT_L(0); PG8_BAR; PG8_MMA(1, 0, At, B0); PG8_MMA(1, 1, At, B1); PG8_BAR; PG8_SCHED;
            } else {
            PG8_LDB(B0, 0, 0); PG8_SCHED; PG8_LDA(At, 0, 0); PG8_STAGE(PG8_SA(1, 1), a1, va1);
            PG8_WAIT_L(8); PG8_BAR; PG8_WAIT_L(0); PG8_MMA(0, 0, At, B0); PG8_BAR; PG8_SCHED;
            PG8_LDB(B1, 0, 1); PG8_STAGE(PG8_SB(0, 0), b2, voffB);
            PG8_BAR; PG8_WAIT_L(0); PG8_MMA(0, 1, At, B1); PG8_BAR;
            PG8_LDA(At, 0, 1); PG8_STAGE(PG8_SA(0, 0), a2, vs0);
            PG8_BAR; PG8_WAIT_L(0); PG8_MMA(1, 0, At, B0); PG8_BAR; PG8_SCHED;
            PG8_STAGE(PG8_SB(0, 1), b2 + hstepB, voffB);
            PG8_WAIT_V(6); PG8_BAR; PG8_MMA(1, 1, At, B1); PG8_BAR;
            PG8_LDB(B0, 1, 0); PG8_SCHED; PG8_LDA(At, 1, 0); PG8_STAGE(PG8_SA(0, 1), a2, vs1);
            PG8_WAIT_L(8); PG8_BAR; PG8_WAIT_L(0); PG8_MMA(0, 0, At, B0); PG8_BAR; PG8_SCHED;
            PG8_LDB(B1, 1, 1); PG8_STAGE(PG8_SB(1, 0), b3, voffB);
            PG8_BAR; PG8_WAIT_L(0); PG8_MMA(0, 1, At, B1); PG8_BAR;
            PG8_LDA(At, 1, 1); PG8_STAGE(PG8_SA(1, 0), a3, vs0);
            PG8_BAR; PG8_WAIT_L(0); PG8_MMA(1, 0, At, B0); PG8_BAR; PG8_SCHED;
            PG8_STAGE(PG8_SB(1, 1), b3 + hstepB, voffB);
            PG8_WAIT_V(6); PG8_BAR; PG8_MMA(1, 1, At, B1); PG8_BAR;
            }
        }
        if constexpr (ALIGN_EPI) { if (wr == 0) PG8_BAR; }
        if constexpr (F8) asm volatile("s_nop 15\n\ts_nop 7" ::: "memory");
        if constexpr (!Epi::AFTER_DRAIN) { E(acc, cur, wr, wc, fr, fq); S.done(cur); }
        if (!has_next) break;
#pragma unroll
        for (int a = 0; a < 2; ++a)
#pragma unroll
            for (int b = 0; b < 2; ++b)
#pragma unroll
                for (int m = 0; m < 4; ++m)
#pragma unroll
                    for (int n = 0; n < 2; ++n) acc[a][b][m][n] = (f32x4){0.f, 0.f, 0.f, 0.f};
        cur = nxt; cA = nA; cB = nB; ++ui; va0[0] = vn0[0]; va0[1] = vn0[1]; va1[0] = vn1[0]; va1[1] = vn1[1];
        if constexpr (ALIGN_EPI) { if (wr == 1) PG8_BAR; }
    }
    PG8_WAIT_V(0);
    if constexpr (!ALIGN_EPI) { if (wr == 0) PG8_BAR; }
    PG8_BAR;
    if constexpr (Epi::AFTER_DRAIN) { E.fused(acc, cur, wr, wc, fr, fq, lds, wid, lane); S.done(cur); }
#undef PG8_SA
#undef PG8_AOFFS
#undef PG8_SB
#undef PG8_STAGE
#undef PG8_LDA
#undef PG8_LDB
#undef PG8_MMA
#undef PG8_CAT8
#undef PG8_WAIT_V
#undef PG8_WAIT_L
#undef PG8_BAR
#undef PG8_SCHED
}
}
namespace attn_body {
using bf16=__hip_bfloat16;
using bf16x8=__attribute__((ext_vector_type(8)))short;
using s16x4=__attribute__((ext_vector_type(4)))short;
using f32x16=__attribute__((ext_vector_type(16)))float;
using u32x4=__attribute__((ext_vector_type(4)))unsigned;
constexpr int D=64,QP=1024;
constexpr int NW=8,QBLK=32,QB=QBLK*NW,KVBLK=64;
__device__ __forceinline__ void wmask(f32x16&p0,f32x16&p1,int t,int kstart,int qabs,int hi){
  if(t<4)return; const float NEG=-INFINITY; const int kb=kstart+64*(t-4)+4*hi-qabs;
  #pragma unroll
  for(int r=0;r<16;++r){const int dk=kb+(r&3)+8*(r>>2); if(dk>128||dk<-128)p0[r]=NEG; if(dk+32>128||dk+32<-128)p1[r]=NEG;}
}
__device__ __forceinline__ int crow(int r,int hi){return (r&3)+8*(r>>2)+4*hi;}
#define SBAR() __builtin_amdgcn_sched_barrier(0)
__device__ __forceinline__ void cmask(f32x16&p0,f32x16&p1,int jb,int qrel,int hi){
  const float NEG=-INFINITY; int kb=64*jb+4*hi;
  #pragma unroll
  for(int r=0;r<16;++r){int kv=kb+(r&3)+8*(r>>2); if(kv>qrel)p0[r]=NEG; if(kv+32>qrel)p1[r]=NEG;}
}

constexpr int NSLOT=3, SLOTB=8192;
constexpr int LDS_K=0, LDS_V=NSLOT*SLOTB, LDS_WS=2*NSLOT*SLOTB, LDS_OST=LDS_WS+NW*64*4, LDS_BYTES=LDS_OST+NW*4096;
constexpr float C2=0.125f*1.4426950408889634f;
__device__ __forceinline__ void glds16(const void*gsrc,unsigned lds_dst){unsigned keep;
  asm volatile("s_mov_b32 %0, m0\n\ts_mov_b32 m0, %2\n\ts_nop 0\n\tglobal_load_lds_dwordx4 %1, off\n\ts_mov_b32 m0, %0":"=&s"(keep):"v"(gsrc),"s"(lds_dst):"memory");}
__device__ __forceinline__ float max3f(float a,float b,float c){float r;asm("v_max3_f32 %0, %1, %2, %3":"=v"(r):"v"(a),"v"(b),"v"(c));return r;}
__device__ __forceinline__ float max2f(float a,float b){float r;asm("v_max_f32_e32 %0, %1, %2":"=v"(r):"v"(a),"v"(b));return r;}
__device__ __forceinline__ float fadd_s(float a,float b){float r;asm("v_add_f32_e32 %0, %1, %2":"=v"(r):"v"(a),"v"(b));return r;}
__device__ __forceinline__ float fsub_s(float a,float b){float r;asm("v_sub_f32_e32 %0, %1, %2":"=v"(r):"v"(a),"v"(b));return r;}
typedef float f32x2_t __attribute__((ext_vector_type(2))); typedef __bf16 bf16x2_t __attribute__((ext_vector_type(2)));
__device__ __forceinline__ unsigned cvtpk_s(float lo,float hi){f32x2_t v={lo,hi};bf16x2_t b=__builtin_convertvector(v,bf16x2_t);return __builtin_bit_cast(unsigned,b);}
#define WAIT_BAR(N) asm volatile("s_waitcnt vmcnt(" #N ") lgkmcnt(0)\n\ts_barrier":::"memory")

__device__ __forceinline__ void qkt(f32x16&p0,f32x16&p1,const char*Kslot,const bf16x8*qr,const f32x16&negm,int r32,int hi){
  const char*kb=Kslot+hi*1024+r32*16;
  #pragma unroll
  for(int d0=0;d0<4;++d0){
    const bf16x8 b0=*reinterpret_cast<const bf16x8*>(kb+d0*2048);
    const bf16x8 b1=*reinterpret_cast<const bf16x8*>(kb+d0*2048+512);
    if(d0==0){p0=__builtin_amdgcn_mfma_f32_32x32x16_bf16(b0,qr[0],negm,0,0,0);p1=__builtin_amdgcn_mfma_f32_32x32x16_bf16(b1,qr[0],negm,0,0,0);}
    else{p0=__builtin_amdgcn_mfma_f32_32x32x16_bf16(b0,qr[d0],p0,0,0,0);p1=__builtin_amdgcn_mfma_f32_32x32x16_bf16(b1,qr[d0],p1,0,0,0);}}
}
typedef __attribute__((address_space(3))) const char* lds_cptr;
typedef short v4i16_t __attribute__((ext_vector_type(4)));
__device__ __forceinline__ void kload8(bf16x8*kf,lds_cptr kp){
  kf[0]=*(const __attribute__((address_space(3))) bf16x8*)(kp);      kf[1]=*(const __attribute__((address_space(3))) bf16x8*)(kp+512);
  kf[2]=*(const __attribute__((address_space(3))) bf16x8*)(kp+2048); kf[3]=*(const __attribute__((address_space(3))) bf16x8*)(kp+2560);
  kf[4]=*(const __attribute__((address_space(3))) bf16x8*)(kp+4096); kf[5]=*(const __attribute__((address_space(3))) bf16x8*)(kp+4608);
  kf[6]=*(const __attribute__((address_space(3))) bf16x8*)(kp+6144); kf[7]=*(const __attribute__((address_space(3))) bf16x8*)(kp+6656);
}
__device__ __forceinline__ void kload2(bf16x8*kf,lds_cptr kp,int j){ kf[2*j]=*(const __attribute__((address_space(3))) bf16x8*)(kp+j*2048); kf[2*j+1]=*(const __attribute__((address_space(3))) bf16x8*)(kp+j*2048+512); }
__device__ __forceinline__ s16x4 vtr(lds_cptr p){ return __builtin_bit_cast(s16x4,__builtin_amdgcn_ds_read_tr16_b64_v4i16((__attribute__((address_space(3))) v4i16_t*)p)); }
__device__ __forceinline__ float rowmax(const f32x16&p0,const f32x16&p1){
  float a=max3f(p0[0],p0[1],p1[0]),b=max3f(p0[2],p0[3],p1[1]);a=max3f(a,p1[2],p1[3]);
  #pragma unroll
  for(int r=4;r<16;r+=4){a=max3f(a,p0[r],p0[r+1]);b=max3f(b,p0[r+2],p0[r+3]);a=max3f(a,p1[r],p1[r+1]);b=max3f(b,p1[r+2],p1[r+3]);}
  const float m=max2f(a,b);
  auto rr=__builtin_amdgcn_permlane32_swap(__float_as_uint(m),__float_as_uint(m),false,false);
  return max2f(__uint_as_float(rr[0]),__uint_as_float(rr[1]));
}
__device__ __forceinline__ void pv(f32x16*o,int vb,bf16x8 pa0,bf16x8 pa1,bf16x8 pa2,bf16x8 pa3){
  #pragma unroll
  for(int d0=0;d0<2;++d0){s16x4 lo[4],hi[4];
    #pragma unroll
    for(int ks=0;ks<4;++ks){
      asm volatile("ds_read_b64_tr_b16 %0,%1 offset:%c2":"=&v"(lo[ks]):"v"(vb),"i"(d0*4096+ks*1024):"memory");
      asm volatile("ds_read_b64_tr_b16 %0,%1 offset:%c2":"=&v"(hi[ks]):"v"(vb),"i"(d0*4096+ks*1024+512):"memory");}
    asm volatile("s_waitcnt lgkmcnt(0)":::"memory");SBAR();
    #define PK(k) (bf16x8){lo[k][0],lo[k][1],lo[k][2],lo[k][3],hi[k][0],hi[k][1],hi[k][2],hi[k][3]}
    o[d0]=__builtin_amdgcn_mfma_f32_32x32x16_bf16(pa0,PK(0),o[d0],0,0,0);
    o[d0]=__builtin_amdgcn_mfma_f32_32x32x16_bf16(pa1,PK(1),o[d0],0,0,0);
    o[d0]=__builtin_amdgcn_mfma_f32_32x32x16_bf16(pa2,PK(2),o[d0],0,0,0);
    o[d0]=__builtin_amdgcn_mfma_f32_32x32x16_bf16(pa3,PK(3),o[d0],0,0,0);
    #undef PK
  }
}

#ifndef ATTN_STORE16
#define ATTN_STORE16(p,v) (*(u32x4*)(p)=(v))
#endif
template<int MODE,int KP,int THRL> __device__ __forceinline__ void attn_unit(int h,int kvh,int q0,int NT,int kbase,float sink_l2,const bf16*Q,const bf16*__restrict__ K,const bf16*__restrict__ V,bf16*O,char*shm){
  int tid_=threadIdx.x; asm volatile("":"+v"(tid_)); const int tid=tid_,lane=tid&63,r32=lane&31,hi=lane>>5; const int wid=__builtin_amdgcn_readfirstlane(tid>>6);
  #define TROW(t) (MODE==0 ? (kbase+64*(t)) : ((t)<4 ? 16384+64*(t) : kbase+64*((t)-4)))
  const bf16*Qw=Q+(long)(q0+wid*QBLK)*QP+h*D;
  const bf16*Kh=K+kvh*D,*Vh=V+kvh*D;
  const unsigned lds0=(unsigned)(uintptr_t)shm;
  float*wsf=(float*)(shm+LDS_WS)+wid*64;
  const bf16*ksrc=Kh+(long)lane*KP+wid*8;
  const bf16*vsrc=Vh+(long)(16*(wid&3)+(lane>>2))*KP+(wid>>2)*32+(lane&3)*8;
  const unsigned kdst=lds0+LDS_K+wid*1024, vdst=lds0+LDS_V+wid*1024;
  #define DMA_K(t,slot) glds16(ksrc+(long)TROW(t)*KP,(unsigned)__builtin_amdgcn_readfirstlane(kdst+(slot)))
  #define DMA_V(t,slot) glds16(vsrc+(long)TROW(t)*KP,(unsigned)__builtin_amdgcn_readfirstlane(vdst+(slot)))
  const int vb0=(int)(lds0+LDS_V)+((lane>>4)&1)*32+(lane&3)*8+(4*hi+((lane&15)>>2))*64;
  const char*Kbase=shm+LDS_K; bf16x8 kf[8];
  const lds_cptr shm3=(lds_cptr)shm; const lds_cptr kp0=shm3+LDS_K+hi*1024+r32*16; const lds_cptr vp0=shm3+LDS_V+((lane>>4)&1)*32+(lane&3)*8+(4*hi+((lane&15)>>2))*64;
  DMA_K(0,0);DMA_V(0,0);DMA_K(1,SLOTB);
  bf16x8 qr[4];
  #pragma unroll
  for(int d0=0;d0<4;++d0)qr[d0]=*reinterpret_cast<const bf16x8*>(&Qw[(long)r32*QP+d0*16+hi*8]);
  float mhat=0.f,l_reg=0.f;f32x16 o[2];o[0]=f32x16{};o[1]=f32x16{};f32x16 negm=f32x16{};asm volatile("":"+v"(negm));
  const int qabs=q0+wid*QBLK+r32;
  #define CMASK(P0,P1,t) do{ if(MODE==1) wmask(P0,P1,(t),kbase,qabs,hi); }while(0)
  bool resc=false;
  #define START(P0,P1) do{ const float rm=rowmax(P0,P1); resc=false; \
    { const float dl=rm; mhat=fadd_s(mhat,dl); \
      _Pragma("unroll") for(int r=0;r<16;++r){P0[r]=fsub_s(P0[r],dl);P1[r]=fsub_s(P1[r],dl);} \
      _Pragma("unroll") for(int r=0;r<16;++r)negm[r]=-mhat; asm volatile("":"+v"(negm)); } \
    _Pragma("unroll") for(int r=0;r<16;++r)P0[r]=__builtin_amdgcn_exp2f(P0[r]); }while(0)
  #define RESC() do{ if(resc){ asm volatile("s_waitcnt lgkmcnt(0)":::"memory"); \
      _Pragma("unroll") for(int d_=0;d_<2;++d_) _Pragma("unroll") for(int r=0;r<16;++r)o[d_][r]*=wsf[crow(r,hi)]; } }while(0)
  f32x16 pA0,pA1,pB0,pB1;
  int sl_prev=0,sl_cur=0,sl_next=SLOTB;
  #define ROT() do{sl_prev=sl_cur;sl_cur=sl_next;sl_next=(sl_next==(NSLOT-1)*SLOTB)?0:sl_next+SLOTB;}while(0)
  DMA_K(2,2*SLOTB);
  WAIT_BAR(3);
  qkt(pA0,pA1,Kbase,qr,negm,r32,hi);asm volatile("s_nop 15\n\ts_nop 7":"+v"(pA0),"+v"(pA1));CMASK(pA0,pA1,0);
  START(pA0,pA1);
  _Pragma("unroll") for(int r=0;r<16;++r)pA1[r]=__builtin_amdgcn_exp2f(pA1[r]);
  WAIT_BAR(0);
  DMA_K(3,0);DMA_V(1,SLOTB);
  ROT();
  kload8(kf,kp0+sl_cur);
  WAIT_BAR(2);
  s16x4 vlo[8],vhi[8]; u32x4 pw0,pw1,pw2,pw3;
  #define PKW(P,B) cvtpk_s(P[B],P[B+1])
  #define PAF(k) __builtin_bit_cast(bf16x8,pw##k)
  #define VFR(i) (bf16x8){vlo[i][0],vlo[i][1],vlo[i][2],vlo[i][3],vhi[i][0],vhi[i][1],vhi[i][2],vhi[i][3]}
  #define PIN(x) asm volatile("":"+v"(x))
  #define MX3(a,b,c) __builtin_fmaxf(__builtin_fmaxf((a),(b)),(c))
  #define GAPA(MF,A0,A1,A2,A3,W0,W1,PW) do{ MF; sacc+=A0; sacc+=A1; sacc+=A2; sacc+=A3; PIN(sacc); W0; W1; PIN(PW); SBAR(); }while(0)
  #define EX(v) __builtin_amdgcn_exp2f(v)
  #define GAPB(MF,X,B) do{ MF; X[B]=EX(X[B]); X[B+1]=EX(X[B+1]); X[B+2]=EX(X[B+2]); X[B+3]=EX(X[B+3]); PIN(X); SBAR(); }while(0)
  #define VRD(i) do{ vlo[i]=vtr(vp_+(((i)>>2)*4096+((i)&3)*1024)); vhi[i]=vtr(vp_+(((i)>>2)*4096+((i)&3)*1024+512)); }while(0)
  #define KRD(G,j) do{ if(G){ kload2(kf,kp0+sl_next,j); SBAR(); } }while(0)
  #define STEP(C0,C1,P0,P1,t,GK,GV,GL) do{ SBAR(); \
    const lds_cptr vp_=vp0+sl_prev; \
    VRD(0); SBAR(); float sacc=(P0[0]+P0[1]); \
    GAPA(C0=__builtin_amdgcn_mfma_f32_32x32x16_bf16(kf[0],qr[0],negm,0,0,0), P0[2],P0[3],P0[4],P0[5],     pw0[0]=PKW(P0,0), pw0[1]=PKW(P0,2), pw0); \
    VRD(4); SBAR(); GAPA(C1=__builtin_amdgcn_mfma_f32_32x32x16_bf16(kf[1],qr[0],negm,0,0,0), P0[6],P0[7],P0[8],P0[9],     pw0[2]=PKW(P0,4), pw0[3]=PKW(P0,6), pw0); \
    VRD(1); SBAR(); GAPA(C0=__builtin_amdgcn_mfma_f32_32x32x16_bf16(kf[2],qr[1],C0,0,0,0),   P0[10],P0[11],P0[12],P0[13], pw1[0]=PKW(P0,8), pw1[1]=PKW(P0,10), pw1); \
    VRD(5); SBAR(); GAPA(C1=__builtin_amdgcn_mfma_f32_32x32x16_bf16(kf[3],qr[1],C1,0,0,0),   P0[14],P0[15],P1[0],P1[1],   pw1[2]=PKW(P0,12),pw1[3]=PKW(P0,14), pw1); \
    VRD(2); SBAR(); GAPA(C0=__builtin_amdgcn_mfma_f32_32x32x16_bf16(kf[4],qr[2],C0,0,0,0),   P1[2],P1[3],P1[4],P1[5],     pw2[0]=PKW(P1,0), pw2[1]=PKW(P1,2), pw2); \
    VRD(6); SBAR(); GAPA(C1=__builtin_amdgcn_mfma_f32_32x32x16_bf16(kf[5],qr[2],C1,0,0,0),   P1[6],P1[7],P1[8],P1[9],     pw2[2]=PKW(P1,4), pw2[3]=PKW(P1,6), pw2); \
    VRD(3); SBAR(); GAPA(C0=__builtin_amdgcn_mfma_f32_32x32x16_bf16(kf[6],qr[3],C0,0,0,0),   P1[10],P1[11],P1[12],P1[13], pw3[0]=PKW(P1,8), pw3[1]=PKW(P1,10), pw3); \
    VRD(7); SBAR(); GAPA(C1=__builtin_amdgcn_mfma_f32_32x32x16_bf16(kf[7],qr[3],C1,0,0,0),   P1[14],P1[15],0.f,0.f,       pw3[2]=PKW(P1,12),pw3[3]=PKW(P1,14), pw3); \
    l_reg+=sacc; \
    if(GK){DMA_K((t)+3,sl_cur);} if(GV){DMA_V((t)+1,sl_next);} \
    CMASK(C0,C1,t); \
    { float a=MX3(C0[0],C0[1],C1[0]),b=MX3(C0[2],C0[3],C1[1]); a=MX3(a,C1[2],C1[3]); \
      _Pragma("unroll") for(int r=4;r<16;r+=4){a=MX3(a,C0[r],C0[r+1]);b=MX3(b,C0[r+2],C0[r+3]);a=MX3(a,C1[r],C1[r+1]);b=MX3(b,C1[r+2],C1[r+3]);} \
      float rm=__builtin_fmaxf(a,b); { auto rr=__builtin_amdgcn_permlane32_swap(__float_as_uint(rm),__float_as_uint(rm),false,false); rm=__builtin_fmaxf(__uint_as_float(rr[0]),__uint_as_float(rr[1])); } \
      resc=false; \
      if(__builtin_expect(__any(rm>(float)THRL),0)){ const float dl=__builtin_fmaxf(rm,0.f); mhat+=dl; \
        _Pragma("unroll") for(int r=0;r<16;++r){C0[r]-=dl;C1[r]-=dl;} \
        _Pragma("unroll") for(int r=0;r<16;++r)negm[r]=-mhat; asm volatile("":"+v"(negm)); \
        const float f=__builtin_amdgcn_exp2f(-dl); l_reg*=f; if(hi==0)wsf[r32]=f; resc=true; } } \
    SBAR(); \
    GAPB(o[0]=__builtin_amdgcn_mfma_f32_32x32x16_bf16(PAF(0),VFR(0),o[0],0,0,0), C0,0); \
    GAPB(o[1]=__builtin_amdgcn_mfma_f32_32x32x16_bf16(PAF(0),VFR(4),o[1],0,0,0), C0,4); \
    KRD(GL,0); GAPB(o[0]=__builtin_amdgcn_mfma_f32_32x32x16_bf16(PAF(1),VFR(1),o[0],0,0,0), C0,8); \
    KRD(GL,1); GAPB(o[1]=__builtin_amdgcn_mfma_f32_32x32x16_bf16(PAF(1),VFR(5),o[1],0,0,0), C0,12); \
    KRD(GL,2); GAPB(o[0]=__builtin_amdgcn_mfma_f32_32x32x16_bf16(PAF(2),VFR(2),o[0],0,0,0), C1,0); \
    KRD(GL,3); GAPB(o[1]=__builtin_amdgcn_mfma_f32_32x32x16_bf16(PAF(2),VFR(6),o[1],0,0,0), C1,4); \
    GAPB(o[0]=__builtin_amdgcn_mfma_f32_32x32x16_bf16(PAF(3),VFR(3),o[0],0,0,0), C1,8); \
    GAPB(o[1]=__builtin_amdgcn_mfma_f32_32x32x16_bf16(PAF(3),VFR(7),o[1],0,0,0), C1,12); \
    }while(0)
  int t=1;
  #undef CMASK
  #define CMASK(P0,P1,t) do{}while(0)
  if constexpr(MODE==0)
  for(;t+5<NT;t+=2){
    STEP(pB0,pB1,pA0,pA1,t,true,true,true);     WAIT_BAR(2); RESC(); ROT();
    STEP(pA0,pA1,pB0,pB1,t+1,true,true,true);   WAIT_BAR(2); RESC(); ROT();
  }
  #undef CMASK
  #define CMASK(P0,P1,t) do{ if(MODE==1) wmask(P0,P1,(t),kbase,qabs,hi); }while(0)
  #define ENDW(tt) do{ if((tt)+3<NT){WAIT_BAR(2);} else if((tt)+2<NT){WAIT_BAR(1);} else {WAIT_BAR(0);} }while(0)
  for(;t+1<NT;t+=2){
    STEP(pB0,pB1,pA0,pA1,t,(t+3<NT),(t+1<NT),(t+1<NT));       ENDW(t);   RESC(); ROT();
    STEP(pA0,pA1,pB0,pB1,t+1,(t+4<NT),(t+2<NT),(t+2<NT));     ENDW(t+1); RESC(); ROT();
  }
  STEP(pB0,pB1,pA0,pA1,NT-1,false,false,false); RESC();
  { float sacc=pB0[0]+pB0[1]; _Pragma("unroll") for(int r=2;r<16;++r)sacc+=pB0[r]; _Pragma("unroll") for(int r=0;r<16;++r)sacc+=pB1[r]; l_reg+=sacc;
    pw0=(u32x4){PKW(pB0,0),PKW(pB0,2),PKW(pB0,4),PKW(pB0,6)};pw1=(u32x4){PKW(pB0,8),PKW(pB0,10),PKW(pB0,12),PKW(pB0,14)};pw2=(u32x4){PKW(pB1,0),PKW(pB1,2),PKW(pB1,4),PKW(pB1,6)};pw3=(u32x4){PKW(pB1,8),PKW(pB1,10),PKW(pB1,12),PKW(pB1,14)};
    SBAR(); pv(o,vb0+sl_cur,PAF(0),PAF(1),PAF(2),PAF(3)); }
  #undef PKW
  #undef PAF
  #undef VFR
  #undef PIN
  #undef MX3
  #undef GAPA
  #undef GAPB
  #undef EX
  #undef VRD
  #undef KRD
  #undef STEP
  #undef ENDW
  {auto rr=__builtin_amdgcn_permlane32_swap(__float_as_uint(l_reg),__float_as_uint(l_reg),false,false);l_reg=__uint_as_float(rr[0])+__uint_as_float(rr[1]);}
  if(MODE==1)l_reg+=__builtin_amdgcn_exp2f(sink_l2-mhat);
  if(hi==0)wsf[32+r32]=l_reg;asm volatile("s_waitcnt lgkmcnt(0)":::"memory");
  float rli[16];
  #pragma unroll
  for(int r=0;r<16;++r)rli[r]=__builtin_amdgcn_rcpf(wsf[32+crow(r,hi)]);
  bf16*Ow=O+(long)(q0+wid*QBLK)*QP+h*D;
  { bf16*stg=(bf16*)(shm+LDS_OST)+wid*2048;
    #pragma unroll
    for(int r=0;r<16;++r){const int orow=crow(r,hi);
      #pragma unroll
      for(int d0=0;d0<2;++d0)stg[orow*64+d0*32+r32]=__float2bfloat16(o[d0][r]*rli[r]);}
    asm volatile("s_waitcnt lgkmcnt(0)":::"memory");
    #pragma unroll
    for(int i=0;i<4;++i){const int row=i*8+(lane>>3),ch=lane&7; const u32x4 v=*(const u32x4*)(stg+row*64+ch*8); ATTN_STORE16(Ow+(long)row*QP+ch*8,v);} }
  asm volatile("s_waitcnt lgkmcnt(0)\n\ts_barrier":::"memory");
  #undef DMA_K
  #undef DMA_V
  #undef CMASK
  #undef TROW
  #undef START
  #undef RESC
  #undef ROT
}
template<int KP> __device__ __forceinline__ void attn_unit_s(int h,int kvh,int q0,int NT,int kbase,float mstat,const bf16*Q,const bf16*__restrict__ K,const bf16*__restrict__ V,bf16*O,char*shm){
  int tid_=threadIdx.x; asm volatile("":"+v"(tid_)); const int tid=tid_,lane=tid&63,r32=lane&31,hi=lane>>5; const int wid=__builtin_amdgcn_readfirstlane(tid>>6);
  #define TROW(t) (kbase+64*(t))
  const bf16*Qw=Q+(long)(q0+wid*QBLK)*QP+h*D;
  const bf16*Kh=K+kvh*D,*Vh=V+kvh*D;
  const unsigned lds0=(unsigned)(uintptr_t)shm;
  float*wsf=(float*)(shm+LDS_WS)+wid*64;
  const bf16*ksrc=Kh+(long)lane*KP+wid*8;
  const bf16*vsrc=Vh+(long)(16*(wid&3)+(lane>>2))*KP+(wid>>2)*32+(lane&3)*8;
  const unsigned kdst=lds0+LDS_K+wid*1024, vdst=lds0+LDS_V+wid*1024;
  #define DMA_K(t,slot) glds16(ksrc+(long)TROW(t)*KP,(unsigned)__builtin_amdgcn_readfirstlane(kdst+(slot)))
  #define DMA_V(t,slot) glds16(vsrc+(long)TROW(t)*KP,(unsigned)__builtin_amdgcn_readfirstlane(vdst+(slot)))
  const int vb0=(int)(lds0+LDS_V)+((lane>>4)&1)*32+(lane&3)*8+(4*hi+((lane&15)>>2))*64;
  const char*Kbase=shm+LDS_K; bf16x8 kf[8];
  const lds_cptr shm3=(lds_cptr)shm; const lds_cptr kp0=shm3+LDS_K+hi*1024+r32*16; const lds_cptr vp0=shm3+LDS_V+((lane>>4)&1)*32+(lane&3)*8+(4*hi+((lane&15)>>2))*64;
  DMA_K(0,0);DMA_V(0,0);DMA_K(1,SLOTB);
  bf16x8 qr[4];
  #pragma unroll
  for(int d0=0;d0<4;++d0)qr[d0]=*reinterpret_cast<const bf16x8*>(&Qw[(long)r32*QP+d0*16+hi*8]);
  float l_reg=0.f;f32x16 o[2];o[0]=f32x16{};o[1]=f32x16{};f32x16 negm;
  #pragma unroll
  for(int r=0;r<16;++r)negm[r]=-mstat;
  asm volatile("":"+v"(negm));
  #define CMASK(P0,P1,t) do{}while(0)
  #define START(P0,P1) do{ _Pragma("unroll") for(int r=0;r<16;++r)P0[r]=__builtin_amdgcn_exp2f(P0[r]); }while(0)
  #define RESC() do{}while(0)
  f32x16 pA0,pA1,pB0,pB1;
  int sl_prev=0,sl_cur=0,sl_next=SLOTB;
  #define ROT() do{sl_prev=sl_cur;sl_cur=sl_next;sl_next=(sl_next==(NSLOT-1)*SLOTB)?0:sl_next+SLOTB;}while(0)
  DMA_K(2,2*SLOTB);
  WAIT_BAR(3);
  qkt(pA0,pA1,Kbase,qr,negm,r32,hi);asm volatile("s_nop 15\n\ts_nop 7":"+v"(pA0),"+v"(pA1));CMASK(pA0,pA1,0);
  START(pA0,pA1);
  _Pragma("unroll") for(int r=0;r<16;++r)pA1[r]=__builtin_amdgcn_exp2f(pA1[r]);
  WAIT_BAR(0);
  DMA_K(3,0);DMA_V(1,SLOTB);
  ROT();
  kload8(kf,kp0+sl_cur);
  WAIT_BAR(2);
  s16x4 vlo[8],vhi[8]; u32x4 pw0,pw1,pw2,pw3;
  #define PKW(P,B) cvtpk_s(P[B],P[B+1])
  #define PAF(k) __builtin_bit_cast(bf16x8,pw##k)
  #define VFR(i) (bf16x8){vlo[i][0],vlo[i][1],vlo[i][2],vlo[i][3],vhi[i][0],vhi[i][1],vhi[i][2],vhi[i][3]}
  #define PIN(x) asm volatile("":"+v"(x))
  #define MX3(a,b,c) __builtin_fmaxf(__builtin_fmaxf((a),(b)),(c))
  #define GAPA(MF,A0,A1,A2,A3,W0,W1,PW) do{ MF; sacc+=A0; sacc+=A1; sacc+=A2; sacc+=A3; PIN(sacc); W0; W1; PIN(PW); SBAR(); }while(0)
  #define EX(v) __builtin_amdgcn_exp2f(v)
  #define GAPB(MF,X,B) do{ MF; X[B]=EX(X[B]); X[B+1]=EX(X[B+1]); X[B+2]=EX(X[B+2]); X[B+3]=EX(X[B+3]); PIN(X); SBAR(); }while(0)
  #define VRD(i) do{ vlo[i]=vtr(vp_+(((i)>>2)*4096+((i)&3)*1024)); vhi[i]=vtr(vp_+(((i)>>2)*4096+((i)&3)*1024+512)); }while(0)
  #define KRD(G,j) do{ if(G){ kload2(kf,kp0+sl_next,j); SBAR(); } }while(0)
  #define STEP(C0,C1,P0,P1,t,GK,GV,GL) do{ SBAR(); \
    const lds_cptr vp_=vp0+sl_prev; \
    VRD(0); SBAR(); float sacc=(P0[0]+P0[1]); \
    GAPA(C0=__builtin_amdgcn_mfma_f32_32x32x16_bf16(kf[0],qr[0],negm,0,0,0), P0[2],P0[3],P0[4],P0[5],     pw0[0]=PKW(P0,0), pw0[1]=PKW(P0,2), pw0); \
    VRD(4); SBAR(); GAPA(C1=__builtin_amdgcn_mfma_f32_32x32x16_bf16(kf[1],qr[0],negm,0,0,0), P0[6],P0[7],P0[8],P0[9],     pw0[2]=PKW(P0,4), pw0[3]=PKW(P0,6), pw0); \
    VRD(1); SBAR(); GAPA(C0=__builtin_amdgcn_mfma_f32_32x32x16_bf16(kf[2],qr[1],C0,0,0,0),   P0[10],P0[11],P0[12],P0[13], pw1[0]=PKW(P0,8), pw1[1]=PKW(P0,10), pw1); \
    VRD(5); SBAR(); GAPA(C1=__builtin_amdgcn_mfma_f32_32x32x16_bf16(kf[3],qr[1],C1,0,0,0),   P0[14],P0[15],P1[0],P1[1],   pw1[2]=PKW(P0,12),pw1[3]=PKW(P0,14), pw1); \
    VRD(2); SBAR(); GAPA(C0=__builtin_amdgcn_mfma_f32_32x32x16_bf16(kf[4],qr[2],C0,0,0,0),   P1[2],P1[3],P1[4],P1[5],     pw2[0]=PKW(P1,0), pw2[1]=PKW(P1,2), pw2); \
    VRD(6); SBAR(); GAPA(C1=__builtin_amdgcn_mfma_f32_32x32x16_bf16(kf[5],qr[2],C1,0,0,0),   P1[6],P1[7],P1[8],P1[9],     pw2[2]=PKW(P1,4), pw2[3]=PKW(P1,6), pw2); \
    VRD(3); SBAR(); GAPA(C0=__builtin_amdgcn_mfma_f32_32x32x16_bf16(kf[6],qr[3],C0,0,0,0),   P1[10],P1[11],P1[12],P1[13], pw3[0]=PKW(P1,8), pw3[1]=PKW(P1,10), pw3); \
    VRD(7); SBAR(); GAPA(C1=__builtin_amdgcn_mfma_f32_32x32x16_bf16(kf[7],qr[3],C1,0,0,0),   P1[14],P1[15],0.f,0.f,       pw3[2]=PKW(P1,12),pw3[3]=PKW(P1,14), pw3); \
    l_reg+=sacc; \
    if(GK){DMA_K((t)+3,sl_cur);} if(GV){DMA_V((t)+1,sl_next);} \
    SBAR(); \
    GAPB(o[0]=__builtin_amdgcn_mfma_f32_32x32x16_bf16(PAF(0),VFR(0),o[0],0,0,0), C0,0); \
    GAPB(o[1]=__builtin_amdgcn_mfma_f32_32x32x16_bf16(PAF(0),VFR(4),o[1],0,0,0), C0,4); \
    KRD(GL,0); GAPB(o[0]=__builtin_amdgcn_mfma_f32_32x32x16_bf16(PAF(1),VFR(1),o[0],0,0,0), C0,8); \
    KRD(GL,1); GAPB(o[1]=__builtin_amdgcn_mfma_f32_32x32x16_bf16(PAF(1),VFR(5),o[1],0,0,0), C0,12); \
    KRD(GL,2); GAPB(o[0]=__builtin_amdgcn_mfma_f32_32x32x16_bf16(PAF(2),VFR(2),o[0],0,0,0), C1,0); \
    KRD(GL,3); GAPB(o[1]=__builtin_amdgcn_mfma_f32_32x32x16_bf16(PAF(2),VFR(6),o[1],0,0,0), C1,4); \
    GAPB(o[0]=__builtin_amdgcn_mfma_f32_32x32x16_bf16(PAF(3),VFR(3),o[0],0,0,0), C1,8); \
    GAPB(o[1]=__builtin_amdgcn_mfma_f32_32x32x16_bf16(PAF(3),VFR(7),o[1],0,0,0), C1,12); \
    }while(0)
  int t=1;
  #undef CMASK
  #define CMASK(P0,P1,t) do{}while(0)
  for(;t+5<NT;t+=2){
    STEP(pB0,pB1,pA0,pA1,t,true,true,true);     WAIT_BAR(2); RESC(); ROT();
    STEP(pA0,pA1,pB0,pB1,t+1,true,true,true);   WAIT_BAR(2); RESC(); ROT();
  }
  #undef CMASK
  #define CMASK(P0,P1,t) do{}while(0)
  #define ENDW(tt) do{ if((tt)+3<NT){WAIT_BAR(2);} else if((tt)+2<NT){WAIT_BAR(1);} else {WAIT_BAR(0);} }while(0)
  for(;t+1<NT;t+=2){
    STEP(pB0,pB1,pA0,pA1,t,(t+3<NT),(t+1<NT),(t+1<NT));       ENDW(t);   RESC(); ROT();
    STEP(pA0,pA1,pB0,pB1,t+1,(t+4<NT),(t+2<NT),(t+2<NT));     ENDW(t+1); RESC(); ROT();
  }
  STEP(pB0,pB1,pA0,pA1,NT-1,false,false,false); RESC();
  { float sacc=pB0[0]+pB0[1]; _Pragma("unroll") for(int r=2;r<16;++r)sacc+=pB0[r]; _Pragma("unroll") for(int r=0;r<16;++r)sacc+=pB1[r]; l_reg+=sacc;
    pw0=(u32x4){PKW(pB0,0),PKW(pB0,2),PKW(pB0,4),PKW(pB0,6)};pw1=(u32x4){PKW(pB0,8),PKW(pB0,10),PKW(pB0,12),PKW(pB0,14)};pw2=(u32x4){PKW(pB1,0),PKW(pB1,2),PKW(pB1,4),PKW(pB1,6)};pw3=(u32x4){PKW(pB1,8),PKW(pB1,10),PKW(pB1,12),PKW(pB1,14)};
    SBAR(); pv(o,vb0+sl_cur,PAF(0),PAF(1),PAF(2),PAF(3)); }
  #undef PKW
  #undef PAF
  #undef VFR
  #undef PIN
  #undef MX3
  #undef GAPA
  #undef GAPB
  #undef EX
  #undef VRD
  #undef KRD
  #undef STEP
  #undef ENDW
  {auto rr=__builtin_amdgcn_permlane32_swap(__float_as_uint(l_reg),__float_as_uint(l_reg),false,false);l_reg=__uint_as_float(rr[0])+__uint_as_float(rr[1]);}
  if(hi==0)wsf[32+r32]=l_reg;asm volatile("s_waitcnt lgkmcnt(0)":::"memory");
  float rli[16];
  #pragma unroll
  for(int r=0;r<16;++r)rli[r]=__builtin_amdgcn_rcpf(wsf[32+crow(r,hi)]);
  bf16*Ow=O+(long)(q0+wid*QBLK)*QP+h*D;
  { bf16*stg=(bf16*)(shm+LDS_OST)+wid*2048;
    #pragma unroll
    for(int r=0;r<16;++r){const int orow=crow(r,hi);
      #pragma unroll
      for(int d0=0;d0<2;++d0)stg[orow*64+d0*32+r32]=__float2bfloat16(o[d0][r]*rli[r]);}
    asm volatile("s_waitcnt lgkmcnt(0)":::"memory");
    #pragma unroll
    for(int i=0;i<4;++i){const int row=i*8+(lane>>3),ch=lane&7; const u32x4 v=*(const u32x4*)(stg+row*64+ch*8); ATTN_STORE16(Ow+(long)row*QP+ch*8,v);} }
  asm volatile("s_waitcnt lgkmcnt(0)\n\ts_barrier":::"memory");
  #undef DMA_K
  #undef DMA_V
  #undef CMASK
  #undef TROW
  #undef START
  #undef RESC
  #undef ROT
}
template<int KP> __device__ __forceinline__ void attn_unit_q8(int h,int kvh,int q0,int NT,int kbase,float mstat,const unsigned char*Q8,const unsigned char*__restrict__ K8,const bf16*__restrict__ V,bf16*O,char*shm){
  int tid_=threadIdx.x; asm volatile("":"+v"(tid_)); const int tid=tid_,lane=tid&63,r32=lane&31,hi=lane>>5; const int wid=__builtin_amdgcn_readfirstlane(tid>>6);
  #define TROW(t) (kbase+64*(t))
  const unsigned char*Qw=Q8+(long)(q0+wid*QBLK)*QP+h*D;
  const unsigned char*Kh=K8+kvh*D; const bf16*Vh=V+kvh*D;
  const unsigned lds0=(unsigned)(uintptr_t)shm;
  float*wsf=(float*)(shm+LDS_WS)+wid*64;
  const unsigned char*ksrc=Kh+(long)lane*KP+(wid&3)*16;
  const bf16*vsrc=Vh+(long)(16*(wid&3)+(lane>>2))*KP+(wid>>2)*32+(lane&3)*8;
  const unsigned kdst=lds0+LDS_K+(wid&3)*1024, vdst=lds0+LDS_V+wid*1024;
  #define DMA_K(t,slot) glds16(ksrc+(long)TROW(t)*KP,(unsigned)__builtin_amdgcn_readfirstlane(kdst+(slot)))
  #define DMA_V(t,slot) glds16(vsrc+(long)TROW(t)*KP,(unsigned)__builtin_amdgcn_readfirstlane(vdst+(slot)))
  const int vb0=(int)(lds0+LDS_V)+((lane>>4)&1)*32+(lane&3)*8+(4*hi+((lane&15)>>2))*64;
  typedef int v8i_t __attribute__((ext_vector_type(8))); typedef int v4i_t __attribute__((ext_vector_type(4))); typedef __attribute__((address_space(3))) const v4i_t* lds_v4p;
  v8i_t kf8[2];
  const int f8sc=0x7F7F7F7F;
  const lds_cptr shm3=(lds_cptr)shm; const lds_cptr kp0=shm3+LDS_K+hi*2048+r32*16; const lds_cptr vp0=shm3+LDS_V+((lane>>4)&1)*32+(lane&3)*8+(4*hi+((lane&15)>>2))*64;
  DMA_K(0,0);DMA_V(0,0);DMA_K(1,SLOTB);
  v8i_t q8; { const v4i_t qa=*reinterpret_cast<const v4i_t*>(Qw+(long)r32*QP+32*hi), qb=*reinterpret_cast<const v4i_t*>(Qw+(long)r32*QP+32*hi+16); q8=__builtin_shufflevector(qa,qb,0,1,2,3,4,5,6,7); }
  #define KLD(j,kp) do{ const v4i_t a_=*(lds_v4p)((kp)+(j)*512), b_=*(lds_v4p)((kp)+(j)*512+1024); kf8[j]=__builtin_shufflevector(a_,b_,0,1,2,3,4,5,6,7); }while(0)
  #define QKMF(C,j) asm volatile("v_mfma_scale_f32_32x32x64_f8f6f4 %0, %1, %2, %3, %4, %4 op_sel_hi:[0,0,0]":"=&v"(C):"v"(kf8[j]),"v"(q8),"v"(negm),"v"(f8sc))
  float l_reg=0.f;f32x16 o[2];o[0]=f32x16{};o[1]=f32x16{};f32x16 negm;
  #pragma unroll
  for(int r=0;r<16;++r)negm[r]=-mstat;
  asm volatile("":"+v"(negm));
  #define CMASK(P0,P1,t) do{}while(0)
  #define START(P0,P1) do{ _Pragma("unroll") for(int r=0;r<16;++r)P0[r]=__builtin_amdgcn_exp2f(P0[r]); }while(0)
  #define RESC() do{}while(0)
  f32x16 pA0,pA1,pB0,pB1;
  int sl_prev=0,sl_cur=0,sl_next=SLOTB;
  #define ROT() do{sl_prev=sl_cur;sl_cur=sl_next;sl_next=(sl_next==(NSLOT-1)*SLOTB)?0:sl_next+SLOTB;}while(0)
  DMA_K(2,2*SLOTB);
  WAIT_BAR(3);
  KLD(0,kp0);KLD(1,kp0);QKMF(pA0,0);QKMF(pA1,1);asm volatile("s_nop 15\n\ts_nop 15\n\ts_nop 15\n\ts_nop 15\n\ts_nop 15":"+v"(pA0),"+v"(pA1));
  START(pA0,pA1);
  _Pragma("unroll") for(int r=0;r<16;++r)pA1[r]=__builtin_amdgcn_exp2f(pA1[r]);
  WAIT_BAR(0);
  DMA_K(3,0);DMA_V(1,SLOTB);
  ROT();
  KLD(0,kp0+sl_cur);KLD(1,kp0+sl_cur);
  WAIT_BAR(2);
  s16x4 vlo[8],vhi[8]; u32x4 pw0,pw1,pw2,pw3;
  #define PKW(P,B) cvtpk_s(P[B],P[B+1])
  #define PAF(k) __builtin_bit_cast(bf16x8,pw##k)
  #define VFR(i) (bf16x8){vlo[i][0],vlo[i][1],vlo[i][2],vlo[i][3],vhi[i][0],vhi[i][1],vhi[i][2],vhi[i][3]}
  #define PIN(x) asm volatile("":"+v"(x))
  #define MX3(a,b,c) __builtin_fmaxf(__builtin_fmaxf((a),(b)),(c))
  #define GAPA(MF,A0,A1,A2,A3,W0,W1,PW) do{ MF; sacc+=A0; sacc+=A1; sacc+=A2; sacc+=A3; PIN(sacc); W0; W1; PIN(PW); SBAR(); }while(0)
  #define EX(v) __builtin_amdgcn_exp2f(v)
  #define GAPB(MF,X,B) do{ MF; X[B]=EX(X[B]); X[B+1]=EX(X[B+1]); X[B+2]=EX(X[B+2]); X[B+3]=EX(X[B+3]); PIN(X); SBAR(); }while(0)
  #define VRD(i) do{ vlo[i]=vtr(vp_+(((i)>>2)*4096+((i)&3)*1024)); vhi[i]=vtr(vp_+(((i)>>2)*4096+((i)&3)*1024+512)); }while(0)
  #define KRD(G,j) do{ if((G)&&(j)<2){ KLD(j,kp0+sl_next); SBAR(); } }while(0)
  #define STEP(C0,C1,P0,P1,t,GK,GV,GL) do{ SBAR(); \
    const lds_cptr vp_=vp0+sl_prev; \
    VRD(0); SBAR(); float sacc=(P0[0]+P0[1]); \
    GAPA(QKMF(C0,0), P0[2],P0[3],P0[4],P0[5],     pw0[0]=PKW(P0,0), pw0[1]=PKW(P0,2), pw0); \
    VRD(4); SBAR(); GAPA(QKMF(C1,1), P0[6],P0[7],P0[8],P0[9],     pw0[2]=PKW(P0,4), pw0[3]=PKW(P0,6), pw0); \
    VRD(1); SBAR(); GAPA((void)0, P0[10],P0[11],P0[12],P0[13], pw1[0]=PKW(P0,8), pw1[1]=PKW(P0,10), pw1); \
    VRD(5); SBAR(); GAPA((void)0, P0[14],P0[15],P1[0],P1[1],   pw1[2]=PKW(P0,12),pw1[3]=PKW(P0,14), pw1); \
    VRD(2); SBAR(); GAPA((void)0, P1[2],P1[3],P1[4],P1[5],     pw2[0]=PKW(P1,0), pw2[1]=PKW(P1,2), pw2); \
    VRD(6); SBAR(); GAPA((void)0, P1[6],P1[7],P1[8],P1[9],     pw2[2]=PKW(P1,4), pw2[3]=PKW(P1,6), pw2); \
    VRD(3); SBAR(); GAPA((void)0, P1[10],P1[11],P1[12],P1[13], pw3[0]=PKW(P1,8), pw3[1]=PKW(P1,10), pw3); \
    VRD(7); SBAR(); GAPA((void)0, P1[14],P1[15],0.f,0.f,       pw3[2]=PKW(P1,12),pw3[3]=PKW(P1,14), pw3); \
    l_reg+=sacc; \
    if(GK){DMA_K((t)+3,sl_cur);} if(GV){DMA_V((t)+1,sl_next);} \
    SBAR(); \
    GAPB(o[0]=__builtin_amdgcn_mfma_f32_32x32x16_bf16(PAF(0),VFR(0),o[0],0,0,0), C0,0); \
    GAPB(o[1]=__builtin_amdgcn_mfma_f32_32x32x16_bf16(PAF(0),VFR(4),o[1],0,0,0), C0,4); \
    KRD(GL,0); GAPB(o[0]=__builtin_amdgcn_mfma_f32_32x32x16_bf16(PAF(1),VFR(1),o[0],0,0,0), C0,8); \
    KRD(GL,1); GAPB(o[1]=__builtin_amdgcn_mfma_f32_32x32x16_bf16(PAF(1),VFR(5),o[1],0,0,0), C0,12); \
    KRD(GL,2); GAPB(o[0]=__builtin_amdgcn_mfma_f32_32x32x16_bf16(PAF(2),VFR(2),o[0],0,0,0), C1,0); \
    KRD(GL,3); GAPB(o[1]=__builtin_amdgcn_mfma_f32_32x32x16_bf16(PAF(2),VFR(6),o[1],0,0,0), C1,4); \
    GAPB(o[0]=__builtin_amdgcn_mfma_f32_32x32x16_bf16(PAF(3),VFR(3),o[0],0,0,0), C1,8); \
    GAPB(o[1]=__builtin_amdgcn_mfma_f32_32x32x16_bf16(PAF(3),VFR(7),o[1],0,0,0), C1,12); \
    }while(0)
  int t=1;
  #undef CMASK
  #define CMASK(P0,P1,t) do{}while(0)
  for(;t+5<NT;t+=2){
    STEP(pB0,pB1,pA0,pA1,t,true,true,true);     WAIT_BAR(2); RESC(); ROT();
    STEP(pA0,pA1,pB0,pB1,t+1,true,true,true);   WAIT_BAR(2); RESC(); ROT();
  }
  #undef CMASK
  #define CMASK(P0,P1,t) do{}while(0)
  #define ENDW(tt) do{ if((tt)+3<NT){WAIT_BAR(2);} else if((tt)+2<NT){WAIT_BAR(1);} else {WAIT_BAR(0);} }while(0)
  for(;t+1<NT;t+=2){
    STEP(pB0,pB1,pA0,pA1,t,(t+3<NT),(t+1<NT),(t+1<NT));       ENDW(t);   RESC(); ROT();
    STEP(pA0,pA1,pB0,pB1,t+1,(t+4<NT),(t+2<NT),(t+2<NT));     ENDW(t+1); RESC(); ROT();
  }
  STEP(pB0,pB1,pA0,pA1,NT-1,false,false,false); RESC();
  { float sacc=pB0[0]+pB0[1]; _Pragma("unroll") for(int r=2;r<16;++r)sacc+=pB0[r]; _Pragma("unroll") for(int r=0;r<16;++r)sacc+=pB1[r]; l_reg+=sacc;
    pw0=(u32x4){PKW(pB0,0),PKW(pB0,2),PKW(pB0,4),PKW(pB0,6)};pw1=(u32x4){PKW(pB0,8),PKW(pB0,10),PKW(pB0,12),PKW(pB0,14)};pw2=(u32x4){PKW(pB1,0),PKW(pB1,2),PKW(pB1,4),PKW(pB1,6)};pw3=(u32x4){PKW(pB1,8),PKW(pB1,10),PKW(pB1,12),PKW(pB1,14)};
    SBAR(); pv(o,vb0+sl_cur,PAF(0),PAF(1),PAF(2),PAF(3)); }
  #undef PKW
  #undef PAF
  #undef VFR
  #undef PIN
  #undef MX3
  #undef GAPA
  #undef GAPB
  #undef EX
  #undef VRD
  #undef KRD
  #undef KLD
  #undef QKMF
  #undef STEP
  #undef ENDW
  {auto rr=__builtin_amdgcn_permlane32_swap(__float_as_uint(l_reg),__float_as_uint(l_reg),false,false);l_reg=__uint_as_float(rr[0])+__uint_as_float(rr[1]);}
  if(hi==0)wsf[32+r32]=l_reg;asm volatile("s_waitcnt lgkmcnt(0)":::"memory");
  float rli[16];
  #pragma unroll
  for(int r=0;r<16;++r)rli[r]=__builtin_amdgcn_rcpf(wsf[32+crow(r,hi)]);
  bf16*Ow=O+(long)(q0+wid*QBLK)*QP+h*D;
  { bf16*stg=(bf16*)(shm+LDS_OST)+wid*2048;
    #pragma unroll
    for(int r=0;r<16;++r){const int orow=crow(r,hi);
      #pragma unroll
      for(int d0=0;d0<2;++d0)stg[orow*64+d0*32+r32]=__float2bfloat16(o[d0][r]*rli[r]);}
    asm volatile("s_waitcnt lgkmcnt(0)":::"memory");
    #pragma unroll
    for(int i=0;i<4;++i){const int row=i*8+(lane>>3),ch=lane&7; const u32x4 v=*(const u32x4*)(stg+row*64+ch*8); ATTN_STORE16(Ow+(long)row*QP+ch*8,v);} }
  asm volatile("s_waitcnt lgkmcnt(0)\n\ts_barrier":::"memory");
  #undef DMA_K
  #undef DMA_V
  #undef CMASK
  #undef TROW
  #undef START
  #undef RESC
  #undef ROT
}
constexpr int ATTN_LDS_BYTES=LDS_BYTES;
#undef SBAR
#undef WAIT_BAR
}
#ifndef EN_MIX
#define EN_MIX 15
#endif
#ifndef EN_MOE
#define EN_MOE 15
#endif
constexpr int NWAVES = 8, NTHR = 512;
constexpr int DM = 1024, NLAT = 16384, NCTX = 256, T = NLAT + NCTX, NPAN = T / 256;
constexpr int NE = 32, TOPK = 4, EFF = 1024;
constexpr int FA_NQKV = 1536, WA_NQKV = 1280, GM_FF = 4096, GM_HALF = 2048;
constexpr float LN_EPS = 1e-5f, RMS_EPS = 1e-6f;
constexpr float DN_ALPHA = 1.6817928305074292f;
constexpr float LOG2E = 1.4426950408889634f, QSCALE = 0.125f * LOG2E;
constexpr int NPHASE = 35;

constexpr size_t MiB = 1u << 20;
constexpr size_t WS_CTL = 0, CTL_ZERO_BYTES = 64 * 1024;
constexpr size_t WS_MOD = 1 * MiB;
constexpr size_t WS_TAB = 2 * MiB;
constexpr size_t TB_FC = WS_TAB, TB_FA = TB_FC + 512 * 256 * 2, TB_FCC = TB_FA + 256 * 256 * 2, TB_FX = TB_FCC + 256 * 256 * 2, TB_TWC = TB_FX + 256 * 512 * 2,
                 TB_TWS = TB_TWC + 128 * 128 * 4, TB_ROPC = TB_TWS + 128 * 128 * 4, TB_ROPS = TB_ROPC + (size_t)NLAT * 32 * 4, TB_END = TB_ROPS + (size_t)NLAT * 32 * 4;
static_assert(TB_END <= 10 * MiB, "tables");
constexpr size_t WS_RW = 10 * MiB;
constexpr size_t WS_LCNT = 11 * MiB;
constexpr size_t WS_ASG = 12 * MiB, WS_GATE = WS_ASG + (size_t)T * 16, WS_SLOT = WS_GATE + (size_t)T * 16;
constexpr int ECAPT = 65, ECAP = ECAPT * 256;
constexpr size_t WS_STOK_OLD = WS_ASG + 1 * MiB;
static_assert(WS_SLOT + (size_t)T * 16 <= WS_STOK_OLD, "assign");
constexpr size_t WS_WFN = 16 * MiB, WS_WFAQ = WS_WFN + 2 * MiB, WS_WFAO = WS_WFAQ + 3 * MiB, WS_WGI = WS_WFAO + 2 * MiB, WS_WGO = WS_WGI + 8 * MiB,
                 WS_WWQ = WS_WGO + 4 * MiB, WS_WWO = WS_WWQ + 3 * MiB, WS_WSM_END = WS_WWO + 2 * MiB;
static_assert(WS_WSM_END <= 40 * MiB, "small weights");
constexpr size_t WS_X = 40 * MiB;
constexpr size_t WS_H = 106 * MiB;
constexpr size_t WS_Y = 140 * MiB;
constexpr size_t WS_BIG = 176 * MiB;
constexpr size_t WS_BTA = WS_BIG, WS_BTC = WS_BTA + 64 * MiB, WS_BTX = WS_BTC + 64 * MiB, WS_MIXB = WS_BTX + 1 * MiB;
constexpr size_t WS_Q = WS_BIG, WS_K = WS_Q + 33 * MiB, WS_V = WS_K + 9 * MiB, WS_O = WS_V + 9 * MiB;
constexpr size_t WS_Q8 = WS_Q + 86 * MiB, WS_K8 = WS_Q + 104 * MiB;
constexpr size_t WS_GU = WS_BIG, WS_GV = WS_GU + 65 * MiB, WS_GG = WS_GV + 65 * MiB, WS_PSTAT = WS_GG + 66 * MiB;
constexpr int MAXMT = 292; constexpr size_t SLOTROWS = (size_t)MAXMT * 256;
constexpr size_t WS_XS = WS_BIG, WS_YS = WS_XS + 292 * MiB;
constexpr size_t WS_H8 = WS_XS;
constexpr float W8_SCALE = 32.0f, W8_INV = 1.0f / 32.0f;
static_assert(SLOTROWS * 2048 <= 146 * MiB, "slots");
constexpr size_t WS_WEXP_GU = 640 * MiB, WS_WEXP_DN = WS_WEXP_GU + 512 * MiB, WS_X2 = WS_WEXP_DN + 256 * MiB, WS_STOK = WS_X2 + 66 * MiB  , WS_ACT = WS_STOK + 4 * MiB  , WS_END = WS_ACT + (size_t)32 * ECAP * 2048;
static_assert(WS_YS + 146 * MiB <= WS_WEXP_GU && (size_t)32 * ECAP * 4 <= 4 * MiB, "big region");
constexpr int CW_BAR = 4096;
constexpr int CW_GCNT = 8192;
constexpr int CW_TMO = 0;
constexpr int CW_MCNT = 16384, MCNT_LAYER = 320 * 64;
static_assert((CW_BAR + 3456) <= CW_GCNT && (CW_GCNT + 4 * 32 * 64) * 4 <= (int)CTL_ZERO_BYTES, "control words inside the memset region");

constexpr int RING_OFF = 0, RING_BYTES = 131072;
constexpr int PRO_SCR_BYTES = 8 * 64 * 65 * 4;
constexpr int MISC_OFF = 136 * 1024;
constexpr int LDS_BYTES = 147456;
constexpr int MW_BAR = 0, MW_LC = 8, MW_TOT = 480, MW_EBASE = 64, MW_MYBASE = 96, MW_NMT = 128, MW_CONV = 132, MW_MTE = 160;
static_assert(MISC_OFF + (MW_MTE + 304) * 4 <= LDS_BYTES && PRO_SCR_BYTES <= MISC_OFF, "LDS map");

#define GAS __attribute__((address_space(1)))
#define LAS __attribute__((address_space(3)))
typedef unsigned short bf16;
typedef unsigned v4u __attribute__((ext_vector_type(4)));
typedef unsigned v2u __attribute__((ext_vector_type(2)));
typedef float f32x4 __attribute__((ext_vector_type(4)));
typedef float f32x2 __attribute__((ext_vector_type(2)));
typedef float f32x16 __attribute__((ext_vector_type(16)));
typedef short bf16x8 __attribute__((ext_vector_type(8)));
typedef GAS unsigned gu32;
#define RLX_AGENT __ATOMIC_RELAXED, __HIP_MEMORY_SCOPE_AGENT
#define LDS_WAIT() asm volatile("s_waitcnt lgkmcnt(0)" ::: "memory")
#define VM_WAIT() asm volatile("s_waitcnt vmcnt(0)" ::: "memory")
__device__ __forceinline__ unsigned f2bf(float f) { unsigned u = __builtin_bit_cast(unsigned, f); return (u + 0x7fffu + ((u >> 16) & 1u)) >> 16; }
__device__ __forceinline__ unsigned pk2(float lo, float hi) { return f2bf(lo) | (f2bf(hi) << 16); }
__device__ __forceinline__ float bf_lo(unsigned w) { return __builtin_bit_cast(float, w << 16); }
__device__ __forceinline__ float bf_hi(unsigned w) { return __builtin_bit_cast(float, w & 0xffff0000u); }
#define XB_TMO      128
#define XB_XCNT(j)  (256  + 64 * (j))
#define XB_XSUB(j)  (1280 + 64 * (j))
#define XB_XGEN(j)  (2304 + 64 * (j))
#define XB_TOP      3328
#define XB_TOPGEN   3392
#define XCD_BAR_WORDS 3456
#define XB_SPIN_CAP (1u << 18)

__device__ __forceinline__ unsigned xb_ld(unsigned* p)              { return __hip_atomic_load(p, __ATOMIC_RELAXED, __HIP_MEMORY_SCOPE_AGENT); }
__device__ __forceinline__ unsigned xb_add(unsigned* p, unsigned v) { return __hip_atomic_fetch_add(p, v, __ATOMIC_RELAXED, __HIP_MEMORY_SCOPE_AGENT); }
__device__ __forceinline__ unsigned xb_xcc_id() { return (unsigned)__builtin_amdgcn_s_getreg((3 << 11) | 20) & 0xFu; }
#define XB_SPIN(cond, bar) do { unsigned _sp = 0; while (cond) { __builtin_amdgcn_s_sleep(1); \
    if ((++_sp & 255u) == 0u) { if (xb_ld(&(bar)[XB_TMO])) break; if (_sp > XB_SPIN_CAP) { atomicAdd(&(bar)[XB_TMO], 1u); break; } } } } while (0)

struct XcdBarrier {
    unsigned* bar; unsigned x;
    volatile LAS unsigned* st;
};

__device__ __forceinline__ XcdBarrier xcd_barrier_post(unsigned* bar, volatile LAS unsigned* st) {
    XcdBarrier b; b.bar = bar; b.x = xb_xcc_id(); b.st = st;
    if (threadIdx.x == 0) (void)xb_add(&bar[XB_XCNT(b.x)], 1u);
    return b;
}
__device__ __forceinline__ void xcd_barrier_complete(unsigned* bar, unsigned x, unsigned& nloc, unsigned& nx) {
    const unsigned G = gridDim.x * gridDim.y * gridDim.z;
    unsigned sum, cnt, mine, sp = 0u;
    for (;;) {
        sum = 0u; cnt = 0u; mine = 0u;
#pragma unroll
        for (unsigned j = 0; j < 16; ++j) { const unsigned c = xb_ld(&bar[XB_XCNT(j)]); sum += c; cnt += (c > 0u) ? 1u : 0u; mine = (j == x) ? c : mine; }
        if (sum == G) break;
        __builtin_amdgcn_s_sleep(1);
        if ((++sp & 255u) == 0u) { if (xb_ld(&bar[XB_TMO])) break; if (sp > XB_SPIN_CAP) { atomicAdd(&bar[XB_TMO], 1u); break; } }
    }
    nloc = mine > 0u ? mine : 1u; nx = cnt > 0u ? cnt : 1u;
}

__device__ __forceinline__ void xcd_barrier(const XcdBarrier& b) {
    asm volatile("s_waitcnt vmcnt(0)" ::: "memory");
    __syncthreads();
    if (threadIdx.x == 0) {
        unsigned* bar = b.bar;
        __builtin_amdgcn_s_waitcnt(0);
        unsigned nloc = b.st[0], nx = b.st[1];
        if (nloc == 0u) { xcd_barrier_complete(bar, b.x, nloc, nx); b.st[0] = nloc; b.st[1] = nx; }
        const unsigned old = xb_add(&bar[XB_XSUB(b.x)], 1u);
        const unsigned gen = old / nloc;
        if (old + 1u == (gen + 1u) * nloc) {
            __builtin_amdgcn_fence(__ATOMIC_RELEASE, "agent");
            asm volatile("s_waitcnt vmcnt(0)" ::: "memory");
            const unsigned og = xb_add(&bar[XB_TOP], 1u);
            const unsigned tg = og / nx;
            if (og + 1u == (tg + 1u) * nx) xb_add(&bar[XB_TOPGEN], 1u);
            else XB_SPIN(xb_ld(&bar[XB_TOPGEN]) == tg, bar);
            __builtin_amdgcn_fence(__ATOMIC_ACQUIRE, "agent");
            xb_add(&bar[XB_XGEN(b.x)], 1u);
            asm volatile("s_waitcnt vmcnt(0)" ::: "memory");
        } else {
            XB_SPIN(xb_ld(&bar[XB_XGEN(b.x)]) == gen, bar);
            __builtin_amdgcn_fence(__ATOMIC_ACQUIRE, "agent");
            asm volatile("s_waitcnt vmcnt(0)" ::: "memory");
        }
    }
    __syncthreads();
}
struct Frame {
    LAS unsigned char* lds;
    volatile LAS unsigned* MISC;
    gu32* ctl;
    unsigned char* ws;
    int wave, vcu, G, bx;
};
enum In { I_X = 0, I_C, I_CTX, I_CCTX, I_ADAW, I_ADAB, I_LNMG, I_LNMB, I_LNFG, I_LNFB, I_FNW, I_FNB, I_FAWQ, I_FABQ, I_FAQN, I_FAKN, I_FAWO, I_FABO,
          I_GMWI, I_GMBI, I_GMVG, I_GMVB, I_GMWS, I_GMBS, I_GMWO, I_GMBO, I_WAWQ, I_WABQ, I_WASK, I_WAWO, I_WABO, I_RW, I_RB, I_EWGU, I_EBGU, I_EWD, I_EBD, N_IN };

#define CAS __attribute__((address_space(4)))
typedef const float* cfptr_t;
__device__ __forceinline__ const float* argp(int idx) {
    unsigned long long a = (unsigned long long)__builtin_amdgcn_kernarg_segment_ptr(); asm volatile("" : "+s"(a));
    return ((const CAS cfptr_t*)a)[idx];
}
__device__ __forceinline__ int otid() { int t = threadIdx.x; asm volatile("" : "+v"(t)); return t; }
__device__ __forceinline__ float wave_sum(float v) {
#pragma unroll
    for (int o = 1; o < 64; o <<= 1) v += __shfl_xor(v, o);
    return v;
}
struct RowV { f32x4 v[4]; };
__device__ __forceinline__ RowV ldrow(const float* p, int lane) { RowV r; const f32x4* q = (const f32x4*)p + lane;
#pragma unroll
    for (int j = 0; j < 4; ++j) r.v[j] = q[64 * j]; return r; }
__device__ __forceinline__ void strow(float* p, int lane, const RowV& r) { f32x4* q = (f32x4*)p + lane;
#pragma unroll
    for (int j = 0; j < 4; ++j) q[64 * j] = r.v[j]; }
__device__ __forceinline__ void strow_bf16(bf16* p, int lane, const RowV& r) { unsigned long long* q = (unsigned long long*)p + lane;
#pragma unroll
    for (int j = 0; j < 4; ++j) q[64 * j] = (unsigned long long)pk2(r.v[j].x, r.v[j].y) | ((unsigned long long)pk2(r.v[j].z, r.v[j].w) << 32); }
__device__ __forceinline__ RowV ldrow_bf16(const bf16* p, int lane) { RowV r; const v2u* q = (const v2u*)p + lane;
#pragma unroll
    for (int j = 0; j < 4; ++j) { const v2u w = q[64 * j]; r.v[j] = (f32x4){bf_lo(w.x), bf_hi(w.x), bf_lo(w.y), bf_hi(w.y)}; } return r; }
__device__ __forceinline__ RowV ln_row(const RowV& x, const RowV& g, const RowV& b) {
    float s = 0.f;
#pragma unroll
    for (int j = 0; j < 4; ++j) s += (x.v[j].x + x.v[j].y) + (x.v[j].z + x.v[j].w);
    const float mean = wave_sum(s) * (1.f / DM); float s2 = 0.f; RowV d;
#pragma unroll
    for (int j = 0; j < 4; ++j) { d.v[j] = x.v[j] - mean; s2 += (d.v[j].x * d.v[j].x + d.v[j].y * d.v[j].y) + (d.v[j].z * d.v[j].z + d.v[j].w * d.v[j].w); }
    const float rstd = 1.f / sqrtf(wave_sum(s2) * (1.f / DM) + LN_EPS);
#pragma unroll
    for (int j = 0; j < 4; ++j) d.v[j] = d.v[j] * rstd * g.v[j] + b.v[j];
    return d;
}
__device__ __forceinline__ const float* modp(const Frame& F, int L, int s, int which) { return (const float*)(F.ws + WS_MOD) + ((size_t)(L * 2 + s) * 6 + which) * DM; }

struct TokOrder : pg8::GridOrder {
    size_t apan, bpan;
    __device__ __forceinline__ bool next(int i, pg8::Unit& u) const { u.e = 0; return next_mn(i, u.pm, u.pn); }
    __device__ __forceinline__ size_t offA(const pg8::Unit& u) const { return (size_t)u.pm * apan; }
    __device__ __forceinline__ size_t offB(const pg8::Unit& u) const { return (size_t)u.pn * bpan; }
    __device__ __forceinline__ void a_ready(const pg8::Unit&) const {}
    __device__ __forceinline__ void done(const pg8::Unit&) const {}
};
struct ChDftOrder : pg8::GridOrder {
    __device__ __forceinline__ bool next(int i, pg8::Unit& u) const { u.e = 0; return next_mn(i, u.pm, u.pn); }
    __device__ __forceinline__ size_t offA(const pg8::Unit& u) const { return (size_t)u.pm * (256 * 256 * 2); }
    __device__ __forceinline__ size_t offB(const pg8::Unit& u) const { const int g = u.pn >> 6, j = u.pn & 63; return ((size_t)(2 * j) * DM + g * 256) * 2; }
    __device__ __forceinline__ void a_ready(const pg8::Unit&) const {}
    __device__ __forceinline__ void done(const pg8::Unit&) const {}
};
struct ChDftCtxOrder : pg8::GridOrder {
    __device__ __forceinline__ bool next(int i, pg8::Unit& u) const { u.e = 0; return next_mn(i, u.pm, u.pn); }
    __device__ __forceinline__ size_t offA(const pg8::Unit& u) const { return (size_t)u.pm * (256 * 256 * 2); }
    __device__ __forceinline__ size_t offB(const pg8::Unit& u) const { return ((size_t)NLAT * DM + u.pn * 256) * 2; }
    __device__ __forceinline__ void a_ready(const pg8::Unit&) const {}
    __device__ __forceinline__ void done(const pg8::Unit&) const {}
};
struct MoeOrder : pg8::GridOrder {
    const volatile LAS unsigned* mte; size_t bexp, apan, bpan;
    __device__ __forceinline__ bool next(int i, pg8::Unit& u) const { int pl; if (!next_mn(i, pl, u.pn)) return false; u.pm = (int)mte[pl]; u.e = u.pm / ECAPT; return true; }
    __device__ __forceinline__ size_t offA(const pg8::Unit& u) const { return (size_t)u.pm * apan; }
    __device__ __forceinline__ size_t offB(const pg8::Unit& u) const { return (size_t)u.e * bexp + (size_t)u.pn * bpan; }
    __device__ __forceinline__ void a_ready(const pg8::Unit&) const {}
    __device__ __forceinline__ void done(const pg8::Unit&) const {}
};

struct MoeOrderG : pg8::GridOrder {
    const volatile LAS unsigned* mte; size_t bexp, bpan; const unsigned* stok; unsigned rowbytes;
    __device__ __forceinline__ bool next(int i, pg8::Unit& u) const { int pl; if (!next_mn(i, pl, u.pn)) return false; u.pm = (int)mte[pl]; u.e = u.pm / ECAPT; return true; }
    __device__ __forceinline__ size_t offA(const pg8::Unit&) const { return 0; }
    __device__ __forceinline__ size_t offB(const pg8::Unit& u) const { return (size_t)u.e * bexp + (size_t)u.pn * bpan; }
    __device__ __forceinline__ unsigned rowoff(const pg8::Unit& u, int row) const { return (stok[u.pm * 256 + row] >> 2) * rowbytes; }
    __device__ __forceinline__ void a_ready(const pg8::Unit&) const {}
    __device__ __forceinline__ void done(const pg8::Unit&) const {}
};

#define EPI_ARGS const pg8::f32x4 (&acc)[2][2][4][2], const pg8::Unit& u, int wr, int wc, int fr, int fq
__device__ __forceinline__ unsigned pk4f8(float a, float b, float c, float d) { int w = 0; w = __builtin_amdgcn_cvt_pk_fp8_f32(a, b, w, false); w = __builtin_amdgcn_cvt_pk_fp8_f32(c, d, w, true); return (unsigned)w; }
__device__ __forceinline__ v2u pack8f8(const f32x4& a, const f32x4& b) { v2u w; w.x = pk4f8(a[0], a[1], a[2], a[3]); w.y = pk4f8(b[0], b[1], b[2], b[3]); return w; }
__device__ __forceinline__ v4u pack8(const f32x4& a, const f32x4& b) { v4u w; w.x = pg8::cvt_pk_bf16(a[0], a[1]); w.y = pg8::cvt_pk_bf16(a[2], a[3]); w.z = pg8::cvt_pk_bf16(b[0], b[1]); w.w = pg8::cvt_pk_bf16(b[2], b[3]); return w; }

struct EpiChDft { static constexpr bool PERM = true, AFTER_DRAIN = false; bf16* O;
    __device__ __forceinline__ void operator()(EPI_ARGS) const {
        const int g = u.pn >> 6, j = u.pn & 63, part = u.pm;
        char* ub = (char*)O + 2 * ((size_t)((g * 256 + 64 * wr) * 128 + 2 * j) * 256 + part * 128 + 32 * wc);
        unsigned lo = 2u * (unsigned)(fr * 128 * 256 + 8 * fq); asm volatile("" : "+v"(lo));
#pragma unroll
        for (int ai = 0; ai < 2; ++ai)
#pragma unroll
            for (int m = 0; m < 4; ++m)
#pragma unroll
                for (int bj = 0; bj < 2; ++bj)
                    *(v4u*)(ub + (size_t)(2 * (((128 * ai + 16 * m) * 128 + bj) * 256)) + lo) = pack8(acc[ai][bj][m][0], acc[ai][bj][m][1]);
    }
};
struct EpiChDftCtx { static constexpr bool PERM = true, AFTER_DRAIN = false; bf16* O;
    __device__ __forceinline__ void operator()(EPI_ARGS) const {
        const int g = u.pn, part = u.pm;
        char* ub = (char*)O + 2 * ((size_t)(g * 256 + 64 * wr) * 512 + part * 256 + 32 * wc);
        unsigned lo = 2u * (unsigned)(fr * 512 + 8 * fq); asm volatile("" : "+v"(lo));
#pragma unroll
        for (int ai = 0; ai < 2; ++ai)
#pragma unroll
            for (int m = 0; m < 4; ++m)
#pragma unroll
                for (int bj = 0; bj < 2; ++bj)
                    *(v4u*)(ub + (size_t)(2 * ((128 * ai + 16 * m) * 512 + 128 * bj)) + lo) = pack8(acc[ai][bj][m][0], acc[ai][bj][m][1]);
    }
};
struct EpiStepA { static constexpr bool PERM = true, AFTER_DRAIN = false; bf16* O; const float* twc; const float* tws;
    __device__ __forceinline__ void operator()(EPI_ARGS) const {
        char* ub = (char*)O + 2 * ((size_t)(64 * wr * 1024 + 2 * u.pn) * 256 + 32 * wc);
        unsigned lo = 2u * (unsigned)(fr * 1024 * 256 + 8 * fq); asm volatile("" : "+v"(lo));
        const char* tcb = (const char*)twc + 4 * (64 * wr * 128 + 32 * wc); const char* tsb = (const char*)tws + 4 * (64 * wr * 128 + 32 * wc);
        unsigned tlo = 4u * (unsigned)(fr * 128 + 8 * fq); asm volatile("" : "+v"(tlo));
#pragma unroll
        for (int m = 0; m < 4; ++m) {
            const f32x4 c0 = *(const f32x4*)(tcb + 4 * (16 * m * 128) + tlo), c1 = *(const f32x4*)(tcb + 4 * (16 * m * 128 + 4) + tlo), s0 = *(const f32x4*)(tsb + 4 * (16 * m * 128) + tlo), s1 = *(const f32x4*)(tsb + 4 * (16 * m * 128 + 4) + tlo);
#pragma unroll
            for (int bj = 0; bj < 2; ++bj) {
                const f32x4 zr0 = acc[0][bj][m][0], zr1 = acc[0][bj][m][1], zi0 = acc[1][bj][m][0], zi1 = acc[1][bj][m][1];
                const f32x4 yr0 = zr0 * c0 + zi0 * s0, yr1 = zr1 * c1 + zi1 * s1, yi0 = zi0 * c0 - zr0 * s0, yi1 = zi1 * c1 - zr1 * s1;
                char* p = ub + (size_t)(2 * ((16 * m * 1024 + bj) * 256)) + lo;
                *(v4u*)p = pack8(yr0, yr1); *(v4u*)(p + 256) = pack8(yi0, yi1); }
            asm volatile("" ::: "memory"); }
    }
};
struct EpiStepC { static constexpr bool PERM = true, AFTER_DRAIN = false; bf16* O;
    __device__ __forceinline__ void operator()(EPI_ARGS) const {
        const int k1 = u.pn >> 2, chb = (u.pn & 3) * 256;
        char* ub = (char*)O + 2 * ((size_t)(k1 + 128 * 64 * wr) * DM + chb + 32 * wc);
        unsigned lo = 2u * (unsigned)(128 * fr * DM + 8 * fq); asm volatile("" : "+v"(lo));
#pragma unroll
        for (int m = 0; m < 4; ++m)
#pragma unroll
            for (int bj = 0; bj < 2; ++bj)
                *(v4u*)(ub + (size_t)(2 * (128 * 16 * m * DM + 128 * bj)) + lo) = pack8(acc[0][bj][m][0], acc[0][bj][m][1]);
    }
};
struct EpiCtxPos { static constexpr bool PERM = true, AFTER_DRAIN = false; bf16* O;
    __device__ __forceinline__ void operator()(EPI_ARGS) const {
        char* ub = (char*)O + 2 * ((size_t)(NLAT + 64 * wr) * DM + u.pn * 256 + 32 * wc);
        unsigned lo = 2u * (unsigned)(fr * DM + 8 * fq); asm volatile("" : "+v"(lo));
#pragma unroll
        for (int ai = 0; ai < 2; ++ai)
#pragma unroll
            for (int m = 0; m < 4; ++m)
#pragma unroll
                for (int bj = 0; bj < 2; ++bj)
                    *(v4u*)(ub + (size_t)(2 * ((128 * ai + 16 * m) * DM + 128 * bj)) + lo) = pack8(acc[ai][bj][m][0], acc[ai][bj][m][1]);
    }
};
template <int NKV, bool RMS> struct EpiQKV { static constexpr bool PERM = true, AFTER_DRAIN = false;
    bf16 *Q, *K, *V; const float* bias; const float* qn; const float* kn; const float* ropc; const float* rops;
    __device__ __forceinline__ void operator()(EPI_ARGS) const {
        const int hh = 4 * u.pn + wc; const int kind = hh < 16 ? 0 : (hh < 16 + NKV ? 1 : 2);
        const int pitch = kind == 0 ? DM : NKV * 64, hd = kind == 0 ? hh : (kind == 1 ? hh - 16 : hh - 16 - NKV);
        const bool f8 = RMS && kind < 2;
        const unsigned es = f8 ? 1u : 2u;
        const size_t doff = f8 ? (kind == 0 ? (size_t)(WS_Q8 - WS_Q) : (size_t)(WS_K8 - WS_Q)) : (kind == 0 ? (size_t)0 : (kind == 1 ? (size_t)(WS_K - WS_Q) : (size_t)(WS_V - WS_Q)));
        bf16* dst = (bf16*)((char*)Q + doff);
        const bool lat = u.pm < NLAT / 256;
        const int rowu = u.pm * 256 + 64 * wr;
        char* ub = (char*)dst + es * ((size_t)rowu * pitch + hd * 64);
        unsigned lo = es * (unsigned)(fr * pitch + 8 * fq); asm volatile("" : "+v"(lo));
        const char* rcb = (const char*)ropc + 4 * ((size_t)rowu * 32); const char* rsb = (const char*)rops + 4 * ((size_t)rowu * 32);
        unsigned rlo = 4u * (unsigned)(fr * 32 + 4 * fq); asm volatile("" : "+v"(rlo));
        f32x4 bv[2][2], gv[2][2];
#pragma unroll
        for (int bj = 0; bj < 2; ++bj)
#pragma unroll
            for (int n = 0; n < 2; ++n) { const int d = 32 * bj + 8 * fq + 4 * n; bv[bj][n] = *(const f32x4*)(bias + hh * 64 + d);
                if (RMS) { const f32x4 gq = *(const f32x4*)(qn + d), gk = *(const f32x4*)(kn + d); gv[bj][n] = kind == 0 ? gq : gk; } }
#pragma unroll
        for (int ai = 0; ai < 2; ++ai)
#pragma unroll
            for (int m = 0; m < 4; ++m) {
                f32x4 v[2][2];
#pragma unroll
                for (int bj = 0; bj < 2; ++bj)
#pragma unroll
                    for (int n = 0; n < 2; ++n) v[bj][n] = acc[ai][bj][m][n] + bv[bj][n];
                if (kind < 2) {
                    if (RMS) { float ss = 0.f;
#pragma unroll
                        for (int bj = 0; bj < 2; ++bj)
#pragma unroll
                            for (int n = 0; n < 2; ++n) ss += (v[bj][n][0] * v[bj][n][0] + v[bj][n][1] * v[bj][n][1]) + (v[bj][n][2] * v[bj][n][2] + v[bj][n][3] * v[bj][n][3]);
                        ss += __shfl_xor(ss, 16); ss += __shfl_xor(ss, 32);
                        const float rs = 1.f / sqrtf(ss * (1.f / 64.f) + RMS_EPS);
#pragma unroll
                        for (int bj = 0; bj < 2; ++bj)
#pragma unroll
                            for (int n = 0; n < 2; ++n) v[bj][n] = v[bj][n] * rs * gv[bj][n]; }
                    if (lat) {
#pragma unroll
                        for (int bj = 0; bj < 2; ++bj)
#pragma unroll
                            for (int n = 0; n < 2; ++n) {
                                const f32x2 c = *(const f32x2*)(rcb + 4 * ((128 * ai + 16 * m) * 32 + 16 * bj + 2 * n) + rlo), sn = *(const f32x2*)(rsb + 4 * ((128 * ai + 16 * m) * 32 + 16 * bj + 2 * n) + rlo);
                                const f32x4 x = v[bj][n];
                                v[bj][n] = (f32x4){x[0] * c.x - x[1] * sn.x, x[0] * sn.x + x[1] * c.x, x[2] * c.y - x[3] * sn.y, x[2] * sn.y + x[3] * c.y}; } }
                    if (kind == 0) {
#pragma unroll
                        for (int bj = 0; bj < 2; ++bj)
#pragma unroll
                            for (int n = 0; n < 2; ++n) v[bj][n] = v[bj][n] * QSCALE; }
                }
                char* p = ub + (size_t)(128 * ai + 16 * m) * (size_t)(es * pitch) + lo;
                if (f8) { *(v2u*)p = pack8f8(v[0][0], v[0][1]); *(v2u*)(p + 32) = pack8f8(v[1][0], v[1][1]); }
                else { *(v4u*)p = pack8(v[0][0], v[0][1]); *(v4u*)(p + 64) = pack8(v[1][0], v[1][1]); }
                if (m & 1) asm volatile("" ::: "memory"); }
    }
};
struct EpiGeluUV { static constexpr bool PERM = true, AFTER_DRAIN = false; bf16* U; bf16* V; const float* bias; float* pstat;
    __device__ __forceinline__ void operator()(EPI_ARGS) const {
        const bool isv = u.pn >= 8; const int colt = (u.pn & 7) * 256;
        char* ub = (char*)(isv ? V : U) + 2 * ((size_t)(u.pm * 256 + 64 * wr) * GM_HALF + colt + 32 * wc);
        unsigned lo = 2u * (unsigned)(fr * GM_HALF + 8 * fq); asm volatile("" : "+v"(lo));
        const float* bb = bias + u.pn * 256 + 32 * wc + 8 * fq;
        f32x4 bv[2][2];
#pragma unroll
        for (int bj = 0; bj < 2; ++bj)
#pragma unroll
            for (int n = 0; n < 2; ++n) bv[bj][n] = *(const f32x4*)(bb + 128 * bj + 4 * n);
#pragma unroll
        for (int ai = 0; ai < 2; ++ai)
#pragma unroll
            for (int m = 0; m < 4; ++m) { float s = 0.f, s2 = 0.f;
#pragma unroll
                for (int bj = 0; bj < 2; ++bj) { const f32x4 x0 = acc[ai][bj][m][0] + bv[bj][0], x1 = acc[ai][bj][m][1] + bv[bj][1];
                    const pg8::f32x2 a = pg8::gelu_pk((pg8::f32x2){x0[0], x0[1]}), b = pg8::gelu_pk((pg8::f32x2){x0[2], x0[3]}), c = pg8::gelu_pk((pg8::f32x2){x1[0], x1[1]}), d = pg8::gelu_pk((pg8::f32x2){x1[2], x1[3]});
                    s += ((a.x + a.y) + (b.x + b.y)) + ((c.x + c.y) + (d.x + d.y)); s2 += ((a.x * a.x + a.y * a.y) + (b.x * b.x + b.y * b.y)) + ((c.x * c.x + c.y * c.y) + (d.x * d.x + d.y * d.y));
                    v4u w; w.x = pg8::cvt_pk_bf16(a.x, a.y); w.y = pg8::cvt_pk_bf16(b.x, b.y); w.z = pg8::cvt_pk_bf16(c.x, c.y); w.w = pg8::cvt_pk_bf16(d.x, d.y);
                    *(v4u*)(ub + (size_t)(2 * ((128 * ai + 16 * m) * GM_HALF + 128 * bj)) + lo) = w; }
                if (isv) { s += __shfl_xor(s, 16); s += __shfl_xor(s, 32); s2 += __shfl_xor(s2, 16); s2 += __shfl_xor(s2, 32);
                    if (fq == 0) *(f32x2*)(pstat + ((size_t)(u.pm * 256 + 128 * ai + 64 * wr + 16 * m + fr) * 32 + (u.pn - 8) * 4 + wc) * 2) = (f32x2){s, s2}; } }
    }
};
struct EpiSwiGLU { static constexpr bool PERM = true, AFTER_DRAIN = false; unsigned char* O; const float* bias;
    __device__ __forceinline__ void operator()(EPI_ARGS) const {
        f32x4 bv[2][2];
        const float* bb = bias + (size_t)u.e * 2048 + u.pn * 256 + 32 * wc + 8 * fq;
#pragma unroll
        for (int bj = 0; bj < 2; ++bj)
#pragma unroll
            for (int n = 0; n < 2; ++n) bv[bj][n] = *(const f32x4*)(bb + 128 * bj + 4 * n);
        char* ub = (char*)O + (((size_t)u.pm * 256 + 64 * wr) * 1024 + u.pn * 128 + 16 * wc);
        unsigned lo = (unsigned)(fr * 1024 + 4 * fq); asm volatile("" : "+v"(lo));
#pragma unroll
        for (int ai = 0; ai < 2; ++ai)
#pragma unroll
            for (int m = 0; m < 4; ++m) {
#pragma unroll
                for (int bj = 0; bj < 2; ++bj) { float a[4];
#pragma unroll
                    for (int n = 0; n < 2; ++n) { const f32x4 x = acc[ai][bj][m][n] * W8_INV + bv[bj][n];
#pragma unroll
                        for (int q = 0; q < 2; ++q) { const float glu = fminf(x[2 * q], 7.0f), lin = fminf(fmaxf(x[2 * q + 1], -7.0f), 7.0f);
                            const float sg = __builtin_amdgcn_rcpf(1.0f + __builtin_amdgcn_exp2f(-1.702f * LOG2E * glu));
                            a[2 * n + q] = glu * sg * (lin + 1.0f); } }
                    int w = 0; w = __builtin_amdgcn_cvt_pk_fp8_f32(a[0], a[1], w, false); w = __builtin_amdgcn_cvt_pk_fp8_f32(a[2], a[3], w, true);
                    *(int*)(ub + (size_t)((128 * ai + 16 * m) * 1024 + 64 * bj) + lo) = w; } }
    }
};
struct EpiDown { static constexpr bool PERM = true, AFTER_DRAIN = false; bf16* O; const float* bias; const unsigned* stok;
    __device__ __forceinline__ void operator()(EPI_ARGS) const {
        f32x4 bv[2][2];
        const float* bb = bias + (size_t)u.e * 1024 + u.pn * 256 + 32 * wc + 8 * fq;
#pragma unroll
        for (int bj = 0; bj < 2; ++bj)
#pragma unroll
            for (int n = 0; n < 2; ++n) bv[bj][n] = *(const f32x4*)(bb + 128 * bj + 4 * n);
        const char* spb = (const char*)stok + 4 * (u.pm * 256 + 64 * wr); unsigned so = 4u * (unsigned)fr; asm volatile("" : "+v"(so));
        unsigned yr[2][4];
#pragma unroll
        for (int ai = 0; ai < 2; ++ai)
#pragma unroll
            for (int m = 0; m < 4; ++m) yr[ai][m] = *(const unsigned*)(spb + 4 * (128 * ai + 16 * m) + so);
        char* ub = (char*)O + 2 * (u.pn * 256 + 32 * wc);
        unsigned lo = 2u * (unsigned)(8 * fq); asm volatile("" : "+v"(lo));
#pragma unroll
        for (int ai = 0; ai < 2; ++ai)
#pragma unroll
            for (int m = 0; m < 4; ++m) { const unsigned ro = yr[ai][m] * (unsigned)(DM * 2) + lo;
                if (yr[ai][m] != (unsigned)(4 * T)) {
#pragma unroll
                    for (int bj = 0; bj < 2; ++bj)
                        *(v4u*)(ub + (size_t)(256 * bj) + ro) = pack8(acc[ai][bj][m][0] * W8_INV + bv[bj][0], acc[ai][bj][m][1] * W8_INV + bv[bj][1]); } }
    }
};
__device__ __forceinline__ int qkv_rowmap(int n) { return (n & ~255) + ((n >> 5) & 1) * 128 + ((n >> 6) & 3) * 32 + (n & 31); }
__device__ __forceinline__ void p0_transpose_item(const float* W, int K, int N, bf16* WT, int rowmode, LAS float* scr, int item, int lane) {
    const int nblk = N / 64, kb = item / nblk, nb = item - kb * nblk, k0 = 64 * kb, n0 = 64 * nb;
    const int r = lane >> 4, cq = lane & 15;
    f32x4 t[16];
#pragma unroll
    for (int i = 0; i < 16; ++i) t[i] = __builtin_nontemporal_load((const f32x4*)(W + (size_t)(k0 + 4 * i + r) * N + n0 + 4 * cq));
#pragma unroll
    for (int i = 0; i < 16; ++i) { LAS float* s = scr + (4 * i + r) * 65 + 4 * cq; s[0] = t[i].x; s[1] = t[i].y; s[2] = t[i].z; s[3] = t[i].w; }
    LDS_WAIT(); asm volatile("" ::: "memory");
    const int c = lane & 7, nn = lane >> 3;
#pragma unroll
    for (int j = 0; j < 8; ++j) { const int n = nn + 8 * j; const LAS float* s = scr + (8 * c) * 65 + n;
        v4u o; o.x = pk2(s[0 * 65], s[1 * 65]); o.y = pk2(s[2 * 65], s[3 * 65]); o.z = pk2(s[4 * 65], s[5 * 65]); o.w = pk2(s[6 * 65], s[7 * 65]);
        const int row = rowmode ? qkv_rowmap(n0 + n) : (n0 + n);
        __builtin_nontemporal_store(o, (GAS v4u*)(WT + (size_t)row * K + k0 + 8 * c)); }
    LDS_WAIT(); asm volatile("" ::: "memory");
}
__device__ __forceinline__ void p0_transpose_item_f8(const float* W, int K, int N, unsigned char* WT, LAS float* scr, int item, int lane) {
    const int nblk = N / 64, kb = item / nblk, nb = item - kb * nblk, k0 = 64 * kb, n0 = 64 * nb;
    const int r = lane >> 4, cq = lane & 15;
    f32x4 t[16];
#pragma unroll
    for (int i = 0; i < 16; ++i) t[i] = __builtin_nontemporal_load((const f32x4*)(W + (size_t)(k0 + 4 * i + r) * N + n0 + 4 * cq));
#pragma unroll
    for (int i = 0; i < 16; ++i) { LAS float* s = scr + (4 * i + r) * 65 + 4 * cq; s[0] = t[i].x; s[1] = t[i].y; s[2] = t[i].z; s[3] = t[i].w; }
    LDS_WAIT(); asm volatile("" ::: "memory");
    const int c = lane & 3, nn = lane >> 2;
#pragma unroll
    for (int j = 0; j < 4; ++j) { const int n = nn + 16 * j; const LAS float* s = scr + (16 * c) * 65 + n; v4u o;
#pragma unroll
        for (int q = 0; q < 4; ++q) { int w = 0; w = __builtin_amdgcn_cvt_pk_fp8_f32(s[(4 * q) * 65] * W8_SCALE, s[(4 * q + 1) * 65] * W8_SCALE, w, false);
            w = __builtin_amdgcn_cvt_pk_fp8_f32(s[(4 * q + 2) * 65] * W8_SCALE, s[(4 * q + 3) * 65] * W8_SCALE, w, true); o[q] = (unsigned)w; }
        __builtin_nontemporal_store(o, (GAS v4u*)(WT + (size_t)(n0 + n) * K + k0 + 16 * c)); }
    LDS_WAIT(); asm volatile("" ::: "memory");
}
struct WgItem { const float* W; unsigned char* WT; int N, kb, nb; };
__device__ __forceinline__ void p0_wg_load(const WgItem& I, f32x4 (&t)[16], int wave, int lane) {
#pragma unroll
    for (int i = 0; i < 16; ++i) t[i] = __builtin_nontemporal_load((const f32x4*)(I.W + (size_t)(128 * I.kb + 16 * wave + i) * I.N + 256 * I.nb + 4 * lane));
}
__device__ __forceinline__ void p0_wg_stage(const f32x4 (&t)[16], LAS float* tile, int wave, int lane) {
#pragma unroll
    for (int i = 0; i < 16; ++i) *(LAS f32x4*)(tile + (16 * wave + i) * 260 + 4 * (lane ^ wave)) = t[i];
}
__device__ __forceinline__ void p0_wg_store(const WgItem& I, LAS float* tile, int tid) {
    const int c = tid & 7, k0 = 128 * I.kb, n0 = 256 * I.nb;
#pragma unroll
    for (int j = 0; j < 4; ++j) { const int n = (tid >> 3) + 64 * j; const LAS float* s = tile + (16 * c) * 260 + (n ^ (4 * c)); v4u o;
#pragma unroll
        for (int q = 0; q < 4; ++q) { int w = 0; w = __builtin_amdgcn_cvt_pk_fp8_f32(s[(4 * q) * 260] * W8_SCALE, s[(4 * q + 1) * 260] * W8_SCALE, w, false);
            w = __builtin_amdgcn_cvt_pk_fp8_f32(s[(4 * q + 2) * 260] * W8_SCALE, s[(4 * q + 3) * 260] * W8_SCALE, w, true); o[q] = (unsigned)w; }
        __builtin_nontemporal_store(o, (GAS v4u*)(I.WT + (size_t)(n0 + n) * 1024 + k0 + 16 * c)); }
}
constexpr int CONV_PER_LAYER = 32 * 64 + 32 * 32, CONV_UP_PER = 5, CONV_DN_PER = 3, CONV_QKV_PER = 6, CONV_ATTN_L2 = 2048;
constexpr bool CONV_DEFER = !MK_PER_PHASE;
__device__ __forceinline__ WgItem conv_item(Frame& F, int L, int j) { WgItem I;
    if (j < 2048) { const int le = L * 32 + (j >> 6), r = j & 63; I.W = argp(I_EWGU) + (size_t)le * 1024 * 2048; I.N = 2048; I.WT = (unsigned char*)(F.ws + WS_WEXP_GU) + (size_t)le * 2048 * 1024; I.kb = r >> 3; I.nb = r & 7; }
    else { const int q = j - 2048, le = L * 32 + (q >> 5), r = q & 31; I.W = argp(I_EWD) + (size_t)le * 1024 * 1024; I.N = 1024; I.WT = (unsigned char*)(F.ws + WS_WEXP_DN) + (size_t)le * 1024 * 1024; I.kb = r >> 2; I.nb = r & 3; }
    return I; }
__device__ __forceinline__ void conv_range(Frame& F, int L, int lo, int hi, int rank, int stride) { const int tid = otid(), lane = tid & 63;
    __syncthreads();
    f32x4 t[16]; int it = lo + rank;
    if (it < hi) p0_wg_load(conv_item(F, L, it), t, F.wave, lane);
    for (; it < hi; it += stride) {
        p0_wg_stage(t, (LAS float*)F.lds, F.wave, lane);
        __syncthreads();
        if (it + stride < hi) p0_wg_load(conv_item(F, L, it + stride), t, F.wave, lane);
        p0_wg_store(conv_item(F, L, it), (LAS float*)F.lds, tid);
        __syncthreads();
    }
}
__device__ __forceinline__ void conv_tail(Frame& F, int L, int rem, int per) {
    const int c0 = (int)F.MISC[MW_CONV]; const int fre = rem ? F.G - rem : 0; int n = per * fre; if (n > CONV_PER_LAYER - c0) n = CONV_PER_LAYER - c0;
    if (rem && F.bx >= rem) conv_range(F, L, c0, c0 + n, F.bx - rem, fre); else __syncthreads();
    if (otid() == 0) F.MISC[MW_CONV] = (unsigned)(c0 + n);
}
__device__ __forceinline__ float siluf(float v) { return v / (1.f + __expf(-v)); }
__device__ __forceinline__ void p0_prologue(Frame& F) { const int tid = otid(), lane = tid & 63; (void)tid; (void)lane;
    {
        LAS float* sc = (LAS float*)(F.lds);
        LAS float* red = sc + 2048;
        { const float* c0 = argp(I_C); const float* c1 = argp(I_CCTX);
          for (int i = tid; i < 2048; i += NTHR) { const int s = i >> 10, k = i & 1023; sc[i] = siluf(s == 0 ? c0[k] : c1[k]); } }
        __syncthreads();
        const float* adaw = argp(I_ADAW); const float* adab = argp(I_ADAB);
        for (int task = F.bx; task < 4 * 48; task += F.G) {
            const int L = task / 48, n0 = (task % 48) * 128;
            const float* w = adaw + (size_t)L * DM * 6144 + n0 + 2 * lane;
            float a0 = 0.f, a1 = 0.f, b0 = 0.f, b1 = 0.f;
#pragma unroll 8
            for (int kk = 0; kk < 128; ++kk) { const int k = 128 * F.wave + kk; const f32x2 x = *(const f32x2*)(w + (size_t)k * 6144); const float sl = sc[k], sx = sc[1024 + k];
                a0 += sl * x.x; a1 += sl * x.y; b0 += sx * x.x; b1 += sx * x.y; }
            red[(F.wave * 2 + 0) * 128 + 2 * lane] = a0; red[(F.wave * 2 + 0) * 128 + 2 * lane + 1] = a1;
            red[(F.wave * 2 + 1) * 128 + 2 * lane] = b0; red[(F.wave * 2 + 1) * 128 + 2 * lane + 1] = b1;
            __syncthreads();
            if (tid < 256) { const int s = tid >> 7, col = tid & 127; float v = adab[(size_t)L * 6144 + n0 + col];
#pragma unroll
                for (int wv = 0; wv < 8; ++wv) v += red[(wv * 2 + s) * 128 + col];
                ((float*)(F.ws + WS_MOD))[(size_t)(L * 2 + s) * 6144 + n0 + col] = v; }
            __syncthreads();
        }
    }
    {
        const int gt = F.bx * NTHR + tid, NGT = F.G * NTHR;
        bf16* fc = (bf16*)(F.ws + TB_FC); bf16* fa = (bf16*)(F.ws + TB_FA); bf16* fcc = (bf16*)(F.ws + TB_FCC); bf16* fx = (bf16*)(F.ws + TB_FX);
        float* twc = (float*)(F.ws + TB_TWC); float* tws = (float*)(F.ws + TB_TWS); float* ropc = (float*)(F.ws + TB_ROPC); float* rops = (float*)(F.ws + TB_ROPS);
        for (int i = gt; i < 512 * 256; i += NGT) { const int row = i >> 8, c = i & 255, part = row >> 8, l = row & 255; const int m = (c * l) & 255;
            const float ang = (float)m * (2.0f / 256.0f); const float v = part == 0 ? cospif(ang) : -sinpif(ang); fc[i] = (bf16)f2bf(v * (1.0f / 16.0f)); }
        for (int i = gt; i < 256 * 256; i += NGT) { const int row = i >> 8, col = i & 255, pr = row >> 7, k1 = row & 127, pc = col >> 7, n1 = col & 127; const int m = (n1 * k1) & 127;
            const float ang = (float)m * (2.0f / 128.0f); const float cs = cospif(ang), sn = sinpif(ang);
            const float v = (pr == pc) ? cs : (pr == 0 ? sn : -sn); fa[i] = (bf16)f2bf(v * 0.08838834764831845f); }
        for (int i = gt; i < 256 * 256; i += NGT) { const int row = i >> 8, col = i & 255, pc = col >> 7, n2 = col & 127; float v = 0.f;
            if (row < 128) { const int m = (n2 * row) & 127; const float ang = (float)m * (2.0f / 128.0f); v = (pc == 0 ? cospif(ang) : sinpif(ang)) * 0.08838834764831845f; }
            fcc[i] = (bf16)f2bf(v); }
        for (int i = gt; i < 256 * 512; i += NGT) { const int k = i >> 9, col = i & 511, pc = col >> 8, n = col & 255; const int m = (n * k) & 255;
            const float ang = (float)m * (2.0f / 256.0f); fx[i] = (bf16)f2bf((pc == 0 ? cospif(ang) : sinpif(ang)) * (1.0f / 16.0f)); }
        for (int i = gt; i < 128 * 128; i += NGT) { const int k1 = i >> 7, n2 = i & 127; const float ang = (float)(k1 * n2) * (2.0f / 16384.0f); twc[i] = cospif(ang); tws[i] = sinpif(ang); }
        for (int i = gt; i < NLAT * 32; i += NGT) { const int t = i >> 5, j = i & 31; const float pos = (float)(j < 16 ? (t >> 6) : (t & 63));
            const float inv = powf(10000.0f, -(float)(j & 15) * (1.0f / 16.0f)); const float ang = pos * inv; float sn, cs; sincosf(ang, &sn, &cs); ropc[i] = cs; rops[i] = sn; }
        bf16* rw = (bf16*)(F.ws + WS_RW); const float* rwin = argp(I_RW);
        for (int i = gt; i < 4 * 32 * 1024; i += NGT) { const int L = i >> 15, e = (i >> 10) & 31, k = i & 1023; rw[i] = (bf16)f2bf(rwin[((size_t)L * 1024 + k) * 32 + e]); }
    }
    __syncthreads();
    {
        LAS float* scr = (LAS float*)(F.lds) + F.wave * (64 * 65);
        const int gw = F.vcu * NWAVES + F.wave, NGW = F.G * NWAVES;
        constexpr int I1 = 16 * 16, I2 = 16 * 24, I3 = 16 * 16, I4 = 16 * 64, I5 = 32 * 16, I6 = 16 * 20, I7 = 16 * 16, ISM = I1 + I2 + I3 + I4 + I5 + I6 + I7;
        for (int it = gw; it < ISM; it += NGW) {
            int r = it;
            if (r < I1) { p0_transpose_item(argp(I_FNW), 1024, 1024, (bf16*)(F.ws + WS_WFN), 0, scr, r, lane); continue; } r -= I1;
            if (r < I2) { p0_transpose_item(argp(I_FAWQ), 1024, FA_NQKV, (bf16*)(F.ws + WS_WFAQ), 1, scr, r, lane); continue; } r -= I2;
            if (r < I3) { p0_transpose_item(argp(I_FAWO), 1024, 1024, (bf16*)(F.ws + WS_WFAO), 0, scr, r, lane); continue; } r -= I3;
            if (r < I4) { p0_transpose_item(argp(I_GMWI), 1024, GM_FF, (bf16*)(F.ws + WS_WGI), 0, scr, r, lane); continue; } r -= I4;
            if (r < I5) { p0_transpose_item(argp(I_GMWO), 2048, 1024, (bf16*)(F.ws + WS_WGO), 0, scr, r, lane); continue; } r -= I5;
            if (r < I6) { p0_transpose_item(argp(I_WAWQ), 1024, WA_NQKV, (bf16*)(F.ws + WS_WWQ), 1, scr, r, lane); continue; } r -= I6;
            p0_transpose_item(argp(I_WAWO), 1024, 1024, (bf16*)(F.ws + WS_WWO), 0, scr, r, lane);
        }
        __syncthreads();
        for (int L = 0; L < (CONV_DEFER ? 1 : 4); ++L) conv_range(F, L, 0, CONV_PER_LAYER, F.vcu, F.G);
    }
}

__device__ __forceinline__ void stok_fill(Frame& F) { const int tid = otid(); unsigned* STOK = (unsigned*)(F.ws + WS_STOK);
    for (int i = F.bx * NTHR + tid; i < 32 * ECAP; i += F.G * NTHR) STOK[i] = (unsigned)(4 * T);
}
__device__ __forceinline__ void init_row(Frame& F, int m, int lane, const RowV& x, const RowV& sc, const RowV& sh) { RowV h;
#pragma unroll
    for (int j = 0; j < 4; ++j) h.v[j] = x.v[j] * (1.f + sc.v[j]) + sh.v[j];
    strow_bf16((bf16*)(F.ws + WS_H) + (size_t)m * DM, lane, h); }
__device__ __forceinline__ void pass_init(Frame& F) { const int tid = otid(), lane = tid & 63; (void)tid; (void)lane;
    stok_fill(F);
    const int gw = F.vcu * NWAVES + F.wave, NGW = F.G * NWAVES;
    RowV sh = ldrow(modp(F, 0, 0, 0), lane), sc = ldrow(modp(F, 0, 0, 1), lane);
    const float* xin = argp(I_X);
    for (int m = gw; m < NLAT; m += 4 * NGW) {
        RowV x[4];
#pragma unroll
        for (int q = 0; q < 4; ++q) { const int mq = m + q * NGW; x[q] = ldrow(xin + (size_t)(mq < NLAT ? mq : m) * DM, lane); }
#pragma unroll
        for (int q = 0; q < 4; ++q) { const int mq = m + q * NGW; if (mq < NLAT) init_row(F, mq, lane, x[q], sc, sh); }
    }
    { const int c0 = F.wave * F.G + F.vcu;
      if (c0 < NCTX) { sh = ldrow(modp(F, 0, 1, 0), lane); sc = ldrow(modp(F, 0, 1, 1), lane);
          for (int c = c0; c < NCTX; c += NGW) { const RowV x = ldrow(argp(I_CTX) + (size_t)c * DM, lane); init_row(F, NLAT + c, lane, x, sc, sh); } } }
}

struct RawRow { v2u w[4]; };
__device__ __forceinline__ RawRow ldraw_bf16(const bf16* p, int lane) { RawRow r; const v2u* q = (const v2u*)p + lane;
#pragma unroll
    for (int j = 0; j < 4; ++j) r.w[j] = q[64 * j]; return r; }
__device__ __forceinline__ RowV cvrow(const RawRow& r) { RowV o;
#pragma unroll
    for (int j = 0; j < 4; ++j) o.v[j] = (f32x4){bf_lo(r.w[j].x), bf_hi(r.w[j].x), bf_lo(r.w[j].y), bf_hi(r.w[j].y)}; return o; }
template <int L> __device__ __forceinline__ void pass_mix(Frame& F) { const int tid = otid(), lane = tid & 63; (void)tid; (void)lane;
    constexpr bool HAS_CTX = L < 3, MIX_ON = (EN_MIX >> L) & 1, MOE_ON = (EN_MOE >> L) & 1;
    constexpr int HP = 1032;
    LAS bf16* HT = (LAS bf16*)(F.lds);
    LAS float* PART = (LAS float*)(F.lds + 32 * HP * 2);
    LAS float* LOGT = PART + 8 * 32 * 33;
    volatile LAS unsigned* LC = F.MISC + MW_LC;
    const bf16* X = (const bf16*)(F.ws + WS_X); bf16* X2 = (bf16*)(F.ws + WS_X2); bf16* H = (bf16*)(F.ws + WS_H); const bf16* Y = (const bf16*)(F.ws + WS_Y);
    const float* xin = argp(I_X); const float* cin = argp(I_CTX);
    float* GATE = (float*)(F.ws + WS_GATE); unsigned* STOK = (unsigned*)(F.ws + WS_STOK);
    LAS unsigned* ASL = (LAS unsigned*)(F.lds + 32 * HP * 2 + 8 * 32 * 33 * 4 + 32 * 33 * 4);
    const bf16* RW = (const bf16*)(F.ws + WS_RW) + (size_t)L * 32 * 1024;
    if (CONV_DEFER) { const int donec = (int)F.MISC[MW_CONV];
        if (L >= 1) conv_range(F, L, donec, CONV_PER_LAYER, F.vcu, F.G); else __syncthreads();
        if (tid == 0) F.MISC[MW_CONV] = (L == 1) ? (unsigned)CONV_ATTN_L2 : 0u; }
    if (tid < 32) LC[tid] = 0u;
    ASL[tid] = 0xFFFFFFFFu;
    __syncthreads();
    int ti = 0;
    const float* rbias = argp(I_RB);
    const int nlt = NLAT / 32, nct = HAS_CTX ? NCTX : 0;
    int cur_s = -1; RowV g1, lg, lb, sc2, sh2;
    for (int it = F.bx; it < nlt + nct; it += F.G) {
        const bool isl = it < nlt; const int s = isl ? 0 : 1; const int row0 = isl ? it * 32 : NLAT + (it - nlt); const int nrows = isl ? 32 : 1;
        if (s != cur_s) { cur_s = s; g1 = ldrow(modp(F, L, s, 2), lane); sh2 = ldrow(modp(F, L, s, 3), lane); sc2 = ldrow(modp(F, L, s, 4), lane);
            lg = ldrow(argp(I_LNMG) + L * DM, lane); lb = ldrow(argp(I_LNMB) + L * DM, lane); }
        const int nr = isl ? 4 : (F.wave == 0 ? 1 : 0);
        RowV xf[4]; RawRow xr[4], yr[4];
#pragma unroll
        for (int q_ = 0; q_ < 4; ++q_) if (q_ < nr) { const int m = row0 + F.wave * 4 + q_;
            if (L == 0) xf[q_] = ldrow(m < NLAT ? xin + (size_t)m * DM : cin + (size_t)(m - NLAT) * DM, lane);
            else xr[q_] = ldraw_bf16(X + (size_t)m * DM, lane);
            if (MIX_ON) yr[q_] = ldraw_bf16(Y + (size_t)m * DM, lane); }
#pragma unroll
        for (int q_ = 0; q_ < 4; ++q_) if (q_ < nr) { const int rr = F.wave * 4 + q_; const int m = row0 + rr;
            RowV x = (L == 0) ? xf[q_] : cvrow(xr[q_]);
            if (MIX_ON) { const RowV y = cvrow(yr[q_]);
#pragma unroll
                for (int j = 0; j < 4; ++j) x.v[j] = x.v[j] * DN_ALPHA + g1.v[j] * y.v[j]; }
            else {
#pragma unroll
                for (int j = 0; j < 4; ++j) x.v[j] = x.v[j] * DN_ALPHA; }
            x = ln_row(x, lg, lb);
            strow_bf16(X2 + (size_t)m * DM, lane, x);
            RowV h;
#pragma unroll
            for (int j = 0; j < 4; ++j) h.v[j] = x.v[j] * (1.f + sc2.v[j]) + sh2.v[j];
            { unsigned* q8 = (unsigned*)((unsigned char*)(F.ws + WS_H8) + (size_t)m * DM) + lane;
#pragma unroll
              for (int j = 0; j < 4; ++j) { int w = 0; w = __builtin_amdgcn_cvt_pk_fp8_f32(h.v[j].x, h.v[j].y, w, false); w = __builtin_amdgcn_cvt_pk_fp8_f32(h.v[j].z, h.v[j].w, w, true); q8[64 * j] = (unsigned)w; } }
            if (MOE_ON) { LAS unsigned long long* q = (LAS unsigned long long*)(HT + rr * HP) + lane;
#pragma unroll
                for (int j = 0; j < 4; ++j) q[64 * j] = (unsigned long long)pk2(h.v[j].x, h.v[j].y) | ((unsigned long long)pk2(h.v[j].z, h.v[j].w) << 32); }
        }
        if (MOE_ON) {
            __syncthreads();
            { const int r32 = lane & 31, hi = lane >> 5; f32x16 acc = f32x16{};
#pragma unroll
                for (int st = 0; st < 8; ++st) { const int k = 128 * F.wave + 16 * st + 8 * hi;
                    const bf16x8 a = *(const LAS bf16x8*)(HT + r32 * HP + k); const bf16x8 b = *(const bf16x8*)(RW + (size_t)r32 * 1024 + k);
                    acc = __builtin_amdgcn_mfma_f32_32x32x16_bf16(a, b, acc, 0, 0, 0); }
#pragma unroll
                for (int r = 0; r < 16; ++r) { const int tok = (r & 3) + 8 * (r >> 2) + 4 * hi; PART[(F.wave * 32 + tok) * 33 + r32] = acc[r]; } }
            __syncthreads();
            { const int t = tid >> 4, e0 = tid & 15;
#pragma unroll
                for (int q = 0; q < 2; ++q) { const int e = e0 + 16 * q; float v = rbias[L * 32 + e];
#pragma unroll
                    for (int wv = 0; wv < 8; ++wv) v += PART[(wv * 32 + t) * 33 + e];
                    LOGT[t * 33 + e] = v; } }
            __syncthreads();
            if (tid < nrows) { const int t = tid; float lv[32];
#pragma unroll
                for (int e = 0; e < 32; ++e) lv[e] = LOGT[t * 33 + e];
                int idx[4]; float val[4]; unsigned taken = 0u;
#pragma unroll
                for (int k = 0; k < 4; ++k) { float best = -INFINITY; int bi = 0;
#pragma unroll
                    for (int e = 0; e < 32; ++e) { const bool ok = !((taken >> e) & 1u) && lv[e] > best; best = ok ? lv[e] : best; bi = ok ? e : bi; }
                    idx[k] = bi; val[k] = best; taken |= 1u << bi; }
                float ev[4], sum = 0.f;
#pragma unroll
                for (int k = 0; k < 4; ++k) { ev[k] = __expf(val[k] - val[0]); sum += ev[k]; }
                const float inv = 1.f / sum; const int m = row0 + t;
#pragma unroll
                for (int k = 0; k < 4; ++k) { const unsigned pos = atomicAdd((unsigned*)&LC[idx[k]], 1u); const int li = (ti & 3) * 128 + t * 4 + k; ASL[li] = ((unsigned)idx[k] << 16) | pos; ASL[512 + li] = (unsigned)(m * 4 + k); GATE[(size_t)m * 4 + k] = ev[k] * inv; } }
            __syncthreads();
        }
        ++ti;
    }
    if (MOE_ON) {
        __syncthreads();
        if (tid < 32) { const unsigned c = LC[tid]; unsigned st = 0u;
            if (c) st = __hip_atomic_fetch_add((unsigned*)(F.ctl + CW_GCNT + (L * 32 + tid) * 64), c, __ATOMIC_RELAXED, __HIP_MEMORY_SCOPE_AGENT);
            F.MISC[MW_TOT + tid] = st; }
        __syncthreads();
        { const unsigned ep = ASL[tid]; if (ep != 0xFFFFFFFFu) { const unsigned e = ep >> 16, pos = ep & 0xffffu; STOK[(size_t)e * ECAP + F.MISC[MW_TOT + e] + pos] = ASL[512 + tid]; } }
    }
}

template <int L> __device__ __forceinline__ void moe_tables(Frame& F) { const int tid = otid();
    if (tid < 64) {
        const int e = tid & 31;
        const unsigned cnt = tid < 32 ? __hip_atomic_load((unsigned*)(F.ctl + CW_GCNT + (L * 32 + e) * 64), RLX_AGENT) : 0u;
        const unsigned tiles = (cnt + 255u) >> 8; unsigned incl = tiles;
#pragma unroll
        for (int o = 1; o < 32; o <<= 1) { const unsigned v = (unsigned)__shfl_up((int)incl, o); if (tid >= o) incl += v; }
        const unsigned base = incl - tiles;
        if (tid < 32) for (unsigned q = 0; q < tiles; ++q) F.MISC[MW_MTE + base + q] = (unsigned)(ECAPT * e) + q;
        if (tid == 31) F.MISC[MW_NMT] = incl; }
    __syncthreads();
}
struct CombIn { RawRow x, y[4]; f32x4 gt; };
template <int L> __device__ __forceinline__ CombIn comb_load(Frame& F, int m, int lane) { CombIn I; constexpr bool MOE_ON = (EN_MOE >> L) & 1;
    const bf16* X2 = (const bf16*)(F.ws + WS_X2); const bf16* YS = (const bf16*)(F.ws + WS_YS); const float* GATE = (const float*)(F.ws + WS_GATE);
    I.x = ldraw_bf16(X2 + (size_t)m * DM, lane);
    if (MOE_ON) { I.gt = *(const f32x4*)(GATE + (size_t)m * 4);
#pragma unroll
        for (int k = 0; k < 4; ++k) I.y[k] = ldraw_bf16(YS + ((size_t)m * 4 + k) * DM, lane); }
    return I; }
template <int L> __device__ __forceinline__ void comb_row(Frame& F, int m, int lane, const CombIn& I, const RowV& g2, const RowV& lg, const RowV& lb, const RowV& sc, const RowV& sh) {
    constexpr bool MOE_ON = (EN_MOE >> L) & 1;
    bf16* X = (bf16*)(F.ws + WS_X); bf16* H = (bf16*)(F.ws + WS_H);
    RowV x = cvrow(I.x);
    if (MOE_ON) { RowV f;
#pragma unroll
        for (int j = 0; j < 4; ++j) f.v[j] = (f32x4){0.f, 0.f, 0.f, 0.f};
#pragma unroll
        for (int k = 0; k < 4; ++k) { const RowV y = cvrow(I.y[k]);
#pragma unroll
            for (int j = 0; j < 4; ++j) f.v[j] += y.v[j] * I.gt[k]; }
#pragma unroll
        for (int j = 0; j < 4; ++j) x.v[j] = x.v[j] * DN_ALPHA + g2.v[j] * f.v[j];
    } else {
#pragma unroll
        for (int j = 0; j < 4; ++j) x.v[j] = x.v[j] * DN_ALPHA; }
    x = ln_row(x, lg, lb);
    if (L < 3) { strow_bf16(X + (size_t)m * DM, lane, x); RowV h;
#pragma unroll
        for (int j = 0; j < 4; ++j) h.v[j] = x.v[j] * (1.f + sc.v[j]) + sh.v[j];
        strow_bf16(H + (size_t)m * DM, lane, h); }
    else strow(((float*)argp(N_IN)) + (size_t)m * DM, lane, x);
}
template <int L> __device__ __forceinline__ void pass_comb(Frame& F) { const int tid = otid(), lane = tid & 63; (void)tid; (void)lane;
    constexpr bool HAS_CTX = L < 3;
    if (L < 3) stok_fill(F);
    const int gw = F.vcu * NWAVES + F.wave, NGW = F.G * NWAVES;
    RowV g2, lg, lb, sc, sh;
    g2 = ldrow(modp(F, L, 0, 5), lane); lg = ldrow(argp(I_LNFG) + L * DM, lane); lb = ldrow(argp(I_LNFB) + L * DM, lane);
    if (L < 3) { sh = ldrow(modp(F, L < 3 ? L + 1 : 0, 0, 0), lane); sc = ldrow(modp(F, L < 3 ? L + 1 : 0, 0, 1), lane); }
    for (int m = gw; m < NLAT; m += 2 * NGW) {
        const int m1 = m + NGW; const bool two = m1 < NLAT;
        const CombIn A = comb_load<L>(F, m, lane); const CombIn B = comb_load<L>(F, two ? m1 : m, lane);
        comb_row<L>(F, m, lane, A, g2, lg, lb, sc, sh);
        if (two) comb_row<L>(F, m1, lane, B, g2, lg, lb, sc, sh);
    }
    if (HAS_CTX) {
        const int c0 = F.wave * F.G + F.vcu;
        if (c0 < NCTX) { g2 = ldrow(modp(F, L, 1, 5), lane); sh = ldrow(modp(F, L < 3 ? L + 1 : 0, 1, 0), lane); sc = ldrow(modp(F, L < 3 ? L + 1 : 0, 1, 1), lane);
            for (int c = c0; c < NCTX; c += NGW) { const CombIn A = comb_load<L>(F, NLAT + c, lane); comb_row<L>(F, NLAT + c, lane, A, g2, lg, lb, sc, sh); } }
    }
}
__device__ __forceinline__ void gate_unit(Frame& F, int t0, int h0, int nh, bool use_pstat) { const int tid = otid(), lane = tid & 63;
    constexpr int WP = 136, VP = 136, OP = 264;
    LAS bf16* WL = (LAS bf16*)(F.lds);
    LAS bf16* VT = (LAS bf16*)(F.lds + 128 * WP * 2);
    LAS bf16* OUT = (LAS bf16*)(F.lds);
    LAS float* STAT = (LAS float*)(F.lds + 128 * WP * 2 + 256 * VP * 2);
    static_assert(128 * OP * 2 <= 128 * WP * 2 + 256 * VP * 2, "OUT overlay");
    const bf16* GU = (const bf16*)(F.ws + WS_GU); const bf16* GV = (const bf16*)(F.ws + WS_GV); bf16* GG = (bf16*)(F.ws + WS_GG);
    const float* ws_ = argp(I_GMWS); const float* bs_ = argp(I_GMBS); const float* vg = argp(I_GMVG); const float* vb = argp(I_GMVB);
    const int r32 = lane & 31, hi = lane >> 5;
    if (use_pstat) {
        const int row = tid >> 2, part = tid & 3; const f32x2* ps = (const f32x2*)((const float*)(F.ws + WS_PSTAT) + ((size_t)(t0 + row) * 32 + 8 * part) * 2); float s = 0.f, s2 = 0.f;
#pragma unroll
        for (int i = 0; i < 8; ++i) { const f32x2 v = ps[i]; s += v.x; s2 += v.y; }
        s += __shfl_xor(s, 1); s += __shfl_xor(s, 2); s2 += __shfl_xor(s2, 1); s2 += __shfl_xor(s2, 2);
        if (part == 0) { const float mean = s * (1.f / GM_HALF); const float var = fmaxf(s2 * (1.f / GM_HALF) - mean * mean, 0.f); STAT[2 * row] = mean; STAT[2 * row + 1] = 1.f / sqrtf(var + LN_EPS); }
    } else {
#ifdef GATE_DUP_STATS
    for (int dup_ = 0; dup_ < 2; ++dup_)
#endif
    for (int bt = 0; bt < 2; ++bt) { v4u raw[8][4]; float s[8], s2[8];
#pragma unroll
        for (int i = 0; i < 8; ++i) { const int q = 16 * F.wave + 8 * bt + i; const v4u* src = (const v4u*)(GV + (size_t)(t0 + q) * GM_HALF) + lane;
#pragma unroll
            for (int j = 0; j < 4; ++j) raw[i][j] = src[64 * j]; }
#pragma unroll
        for (int i = 0; i < 8; ++i) { float a = 0.f, b = 0.f;
#pragma unroll
            for (int j = 0; j < 4; ++j)
#pragma unroll
                for (int e = 0; e < 4; ++e) { const float x0 = bf_lo(raw[i][j][e]), x1 = bf_hi(raw[i][j][e]); a += x0 + x1; b += x0 * x0 + x1 * x1; }
            s[i] = a; s2[i] = b; }
#pragma unroll
        for (int o = 1; o < 64; o <<= 1) {
#pragma unroll
            for (int i = 0; i < 8; ++i) { s[i] += __shfl_xor(s[i], o); s2[i] += __shfl_xor(s2[i], o); } }
        if (lane == 0) {
#pragma unroll
            for (int i = 0; i < 8; ++i) { const int q = 16 * F.wave + 8 * bt + i; const float mean = s[i] * (1.f / GM_HALF); const float var = fmaxf(s2[i] * (1.f / GM_HALF) - mean * mean, 0.f);
                STAT[2 * q] = mean; STAT[2 * q + 1] = 1.f / sqrtf(var + LN_EPS); } } }
    }
    __syncthreads();
    const int wp = tid >> 2, wq0 = (tid & 3) * 32;
    const int vck = tid & 31, vqb0 = tid >> 5;
    const int ck = tid & 31;
    f32x4 wr[8]; v4u wv[8];
    { const f32x4* src = (const f32x4*)(ws_ + ((size_t)h0 * 128 + wp) * 128 + wq0);
#pragma unroll
      for (int i = 0; i < 8; ++i) wr[i] = src[i];
#pragma unroll
      for (int j = 0; j < 8; ++j) wv[j] = *(const v4u*)(GV + (size_t)(t0 + 4 * (vqb0 + 16 * (j >> 2)) + (j & 3)) * GM_HALF + h0 * 256 + 8 * vck); }
    for (int hh = 0; hh < nh; ++hh) { const int h = h0 + hh;
#pragma unroll
        for (int i = 0; i < 4; ++i) { const f32x4 a = wr[2 * i], b = wr[2 * i + 1]; v4u w; w.x = pk2(a[0], a[1]); w.y = pk2(a[2], a[3]); w.z = pk2(b[0], b[1]); w.w = pk2(b[2], b[3]);
            *(LAS v4u*)(WL + wp * WP + wq0 + 8 * i) = w; }
        { const f32x4 g0 = *(const f32x4*)(vg + h * 256 + 8 * vck), g1 = *(const f32x4*)(vg + h * 256 + 8 * vck + 4), b0 = *(const f32x4*)(vb + h * 256 + 8 * vck), b1 = *(const f32x4*)(vb + h * 256 + 8 * vck + 4);
#pragma unroll
            for (int bk = 0; bk < 2; ++bk) { const int q0 = 4 * (vqb0 + 16 * bk); float x[4][8];
#pragma unroll
                for (int r = 0; r < 4; ++r) { const v4u w = wv[4 * bk + r]; const float mean = STAT[2 * (q0 + r)], rstd = STAT[2 * (q0 + r) + 1];
#pragma unroll
                    for (int i = 0; i < 4; ++i) { x[r][2 * i] = (bf_lo(w[i]) - mean) * rstd; x[r][2 * i + 1] = (bf_hi(w[i]) - mean) * rstd; } }
#pragma unroll
                for (int i = 0; i < 8; ++i) { const float gg = i < 4 ? g0[i & 3] : g1[i & 3], bb = i < 4 ? b0[i & 3] : b1[i & 3];
                    v2u w; w.x = pk2(x[0][i] * gg + bb, x[1][i] * gg + bb); w.y = pk2(x[2][i] * gg + bb, x[3][i] * gg + bb);
                    *(LAS v2u*)(VT + (8 * vck + i) * VP + q0) = w; } } }
        if (hh + 1 < nh) { const f32x4* src = (const f32x4*)(ws_ + ((size_t)(h + 1) * 128 + wp) * 128 + wq0);
#pragma unroll
            for (int i = 0; i < 8; ++i) wr[i] = src[i];
#pragma unroll
            for (int j = 0; j < 8; ++j) wv[j] = *(const v4u*)(GV + (size_t)(t0 + 4 * (vqb0 + 16 * (j >> 2)) + (j & 3)) * GM_HALF + (h + 1) * 256 + 8 * vck); }
        v4u uo[8];
#pragma unroll
        for (int j = 0; j < 8; ++j) { const int p = (tid >> 5) + 16 * j; uo[j] = *(const v4u*)(GU + (size_t)(t0 + p) * GM_HALF + h * 256 + 8 * ck); }
        __syncthreads();
        const int wm = F.wave >> 2, wn = F.wave & 3; f32x16 acc[2][2];
#pragma unroll
        for (int i = 0; i < 2; ++i)
#pragma unroll
            for (int jn = 0; jn < 2; ++jn) acc[i][jn] = f32x16{};
#pragma unroll
        for (int ks = 0; ks < 8; ++ks) { bf16x8 a[2], b[2];
#pragma unroll
            for (int i = 0; i < 2; ++i) { a[i] = *(const LAS bf16x8*)(VT + (64 * wn + 32 * i + r32) * VP + 16 * ks + 8 * hi); b[i] = *(const LAS bf16x8*)(WL + (64 * wm + 32 * i + r32) * WP + 16 * ks + 8 * hi); }
#pragma unroll
            for (int i = 0; i < 2; ++i)
#pragma unroll
                for (int jn = 0; jn < 2; ++jn) acc[i][jn] = __builtin_amdgcn_mfma_f32_32x32x16_bf16(a[i], b[jn], acc[i][jn], 0, 0, 0); }
        __syncthreads();
#pragma unroll
        for (int jn = 0; jn < 2; ++jn) { const int p = 64 * wm + 32 * jn + r32; const float bias = bs_[h * 128 + p];
#pragma unroll
            for (int i = 0; i < 2; ++i)
#pragma unroll
                for (int rg = 0; rg < 4; ++rg) { const int c = 64 * wn + 32 * i + 8 * rg + 4 * hi;
                    v2u w; w.x = pk2(acc[i][jn][4 * rg] + bias, acc[i][jn][4 * rg + 1] + bias); w.y = pk2(acc[i][jn][4 * rg + 2] + bias, acc[i][jn][4 * rg + 3] + bias);
                    *(LAS v2u*)(OUT + p * OP + c) = w; } }
        __syncthreads();
#ifdef GATE_DUP_EPI
        for (int dup_ = 0; dup_ < 2; ++dup_) {
#endif
#pragma unroll
        for (int j = 0; j < 8; ++j) { const int p = (tid >> 5) + 16 * j; const size_t off = (size_t)(t0 + p) * GM_HALF + h * 256 + 8 * ck;
            const v4u oo = *(const LAS v4u*)(OUT + p * OP + 8 * ck); v4u g;
#pragma unroll
            for (int e = 0; e < 4; ++e) g[e] = pk2(bf_lo(uo[j][e]) * bf_lo(oo[e]), bf_hi(uo[j][e]) * bf_hi(oo[e]));
            *(v4u*)(GG + off) = g; }
#ifdef GATE_DUP_EPI
        }
#endif
        __syncthreads();
    }
}
__device__ __forceinline__ void gate_phase(Frame& F) {
    for (int uid = F.bx; uid < 2 * (NLAT / 128); uid += F.G) gate_unit(F, (uid >> 1) * 128, 4 * (uid & 1), 4, true);
    if ((F.bx & 15) == 0 && (F.bx >> 4) < 16) { const int su = F.bx >> 4; gate_unit(F, NLAT + (su >> 3) * 128, su & 7, 1, true); }
}

template <int MODE> __device__ __forceinline__ void attn_phase(Frame& F, char* lds_generic) {
    using abf = attn_body::bf16;
    const abf* Q = (const abf*)(F.ws + WS_Q); const abf* K = (const abf*)(F.ws + WS_K); const abf* V = (const abf*)(F.ws + WS_V); abf* O = (abf*)(F.ws + WS_O);
    constexpr int U = 1024; const int per = (U + F.G - 1) / F.G;
    float mstat = 0.f;
    if (MODE == 0) { const float* gq = argp(I_FAQN); const float* gk = argp(I_FAKN); float mq = 0.f, mk = 0.f;
        for (int d = 0; d < 64; ++d) { mq = fmaxf(mq, fabsf(gq[d])); mk = fmaxf(mk, fabsf(gk[d])); }
        mstat = fminf(64.f * QSCALE * mq * mk, 100.f); }
    for (int i = 0; i <= per; ++i) {
        int h, kvh, q0, NT, kbase; float sink = 0.f;
        if (i < per) { const int id = F.vcu * per + i; if (id >= U) continue; const int x = id >> 7, r = id & 127; const int qb = (r >> 2) * 2 + (r & 1);
            q0 = 256 * qb;
            if (MODE == 0) { kvh = x >> 1; h = kvh * 4 + (x & 1) * 2 + ((r & 3) >> 1); NT = T / 64; kbase = 0; }
            else { h = 2 * x + ((r & 3) >> 1); kvh = h >> 3; const int ks = q0 >= 128 ? q0 - 128 : 0, ke = (q0 + 384) < NLAT ? (q0 + 384) : NLAT; kbase = ks; NT = 4 + (ke - ks) / 64; sink = argp(I_WASK)[h] * LOG2E; } }
        else { if (MODE != 0) continue; if ((F.vcu & 15) != 0 || (F.vcu >> 4) >= 16) continue; h = F.vcu >> 4; kvh = h >> 2; q0 = NLAT; NT = 4; kbase = NLAT; }
        if constexpr (MODE == 0) { attn_body::attn_unit_q8<256>(h, kvh, q0, NT, kbase, mstat, (const unsigned char*)(F.ws + WS_Q8), (const unsigned char*)(F.ws + WS_K8), V, O, lds_generic);
        if (CONV_DEFER && i < per && i == (F.vcu & 3)) {
            const int c1 = (int)F.MISC[MW_CONV];
            conv_range(F, 1, c1, CONV_PER_LAYER, F.vcu, F.G);
            conv_range(F, 2, 0, CONV_ATTN_L2, F.vcu, F.G); } }
        else attn_body::attn_unit<1, 128, 8>(h, kvh, q0, NT, kbase, sink, Q, K, V, O, lds_generic);
    }
    if (CONV_DEFER && MODE == 0) { __syncthreads(); if (otid() == 0) F.MISC[MW_CONV] = (unsigned)CONV_PER_LAYER; }
}
struct CtxEpiY { bf16* Y; const float* bias;
    __device__ __forceinline__ void operator()(int row, int col, float (&v)[4]) const { const f32x4 b = *(const f32x4*)(bias + col);
        v2u w; w.x = pk2(v[0] + b[0], v[1] + b[1]); w.y = pk2(v[2] + b[2], v[3] + b[3]); *(v2u*)(Y + (size_t)row * DM + col) = w; } };
struct CtxEpiGelu { bf16* U; bf16* V; const float* bias; float* pstat;
    __device__ __forceinline__ void operator()(int row, int col, float (&v)[4]) const { const f32x4 b = *(const f32x4*)(bias + col);
        const pg8::f32x2 a = pg8::gelu_pk((pg8::f32x2){v[0] + b[0], v[1] + b[1]}), c = pg8::gelu_pk((pg8::f32x2){v[2] + b[2], v[3] + b[3]});
        v2u w; w.x = pk2(a.x, a.y); w.y = pk2(c.x, c.y); bf16* dst = col < GM_HALF ? U + (size_t)row * GM_HALF + col : V + (size_t)row * GM_HALF + (col - GM_HALF); *(v2u*)dst = w;
        if (col >= GM_HALF) { float s = (a.x + a.y) + (c.x + c.y), s2 = (a.x * a.x + a.y * a.y) + (c.x * c.x + c.y * c.y);
            s += __shfl_xor(s, 1); s += __shfl_xor(s, 2); s += __shfl_xor(s, 4); s += __shfl_xor(s, 8); s2 += __shfl_xor(s2, 1); s2 += __shfl_xor(s2, 2); s2 += __shfl_xor(s2, 4); s2 += __shfl_xor(s2, 8);
            if ((col & 63) == 0) *(f32x2*)(pstat + ((size_t)row * 32 + ((col - GM_HALF) >> 6)) * 2) = (f32x2){s, s2}; } } };
template <int NKV, bool RMS> struct CtxEpiQKV { bf16* Q; const float* bias; const float* qn; const float* kn;
    __device__ __forceinline__ void operator()(int row, int col, float (&v)[4]) const {
        const int hh = col >> 6, d = col & 63; const int kind = hh < 16 ? 0 : (hh < 16 + NKV ? 1 : 2);
        const f32x4 b = *(const f32x4*)(bias + col);
#pragma unroll
        for (int i = 0; i < 4; ++i) v[i] += b[i];
        if (RMS) { float ss = (v[0] * v[0] + v[1] * v[1]) + (v[2] * v[2] + v[3] * v[3]);
            ss += __shfl_xor(ss, 1); ss += __shfl_xor(ss, 2); ss += __shfl_xor(ss, 4); ss += __shfl_xor(ss, 8);
            const float rs = 1.f / sqrtf(ss * (1.f / 64.f) + RMS_EPS); const f32x4 gq = *(const f32x4*)(qn + d), gk = *(const f32x4*)(kn + d);
            if (kind < 2) {
#pragma unroll
                for (int i = 0; i < 4; ++i) v[i] = v[i] * rs * (kind == 0 ? gq[i] : gk[i]); } }
        if (kind == 0) {
#pragma unroll
            for (int i = 0; i < 4; ++i) v[i] *= QSCALE; }
        const int pitch = kind == 0 ? DM : NKV * 64, hd = kind == 0 ? hh : (kind == 1 ? hh - 16 : hh - 16 - NKV);
        const size_t doff = kind == 0 ? (size_t)0 : (kind == 1 ? (size_t)(WS_K - WS_Q) : (size_t)(WS_V - WS_Q));
        if (RMS && kind < 2) { *(unsigned*)((char*)Q + (kind == 0 ? (size_t)(WS_Q8 - WS_Q) : (size_t)(WS_K8 - WS_Q)) + (size_t)row * pitch + hd * 64 + d) = pk4f8(v[0], v[1], v[2], v[3]); return; }
        v2u w; w.x = pk2(v[0], v[1]); w.y = pk2(v[2], v[3]); *(v2u*)((bf16*)((char*)Q + doff) + (size_t)row * pitch + hd * 64 + d) = w; } };
template <class Epi> __device__ __forceinline__ void ctx_gemm(Frame& F, const bf16* A, const bf16* Bt, int N, int K, int rowmode, const Epi& E) {
    const int tid = otid(), lane = tid & 63, r32 = lane & 31, hi = lane >> 5;
    LAS float* PART = (LAS float*)(F.lds);
    const int nblk = 8 * (N / 64), kw = K / 8;
    for (int b = F.bx; b < nblk; b += F.G) { const int rb = b & 7, cb = b >> 3;
        const bf16* ap = A + (size_t)(NLAT + rb * 32 + r32) * K + F.wave * kw + 8 * hi;
        const int n0 = cb * 64 + r32, n1 = n0 + 32;
        const bf16* bp0 = Bt + (size_t)(rowmode ? qkv_rowmap(n0) : n0) * K + F.wave * kw + 8 * hi;
        const bf16* bp1 = Bt + (size_t)(rowmode ? qkv_rowmap(n1) : n1) * K + F.wave * kw + 8 * hi;
        f32x16 acc0 = f32x16{}, acc1 = f32x16{};
        for (int k = 0; k < kw; k += 128) { bf16x8 a[8], b0[8], b1[8];
#pragma unroll
            for (int i = 0; i < 8; ++i) { a[i] = *(const bf16x8*)(ap + k + 16 * i); b0[i] = *(const bf16x8*)(bp0 + k + 16 * i); b1[i] = *(const bf16x8*)(bp1 + k + 16 * i); }
#pragma unroll
            for (int i = 0; i < 8; ++i) { acc0 = __builtin_amdgcn_mfma_f32_32x32x16_bf16(a[i], b0[i], acc0, 0, 0, 0); acc1 = __builtin_amdgcn_mfma_f32_32x32x16_bf16(a[i], b1[i], acc1, 0, 0, 0); } }
#pragma unroll
        for (int r = 0; r < 16; ++r) { const int rw = (r & 3) + 8 * (r >> 2) + 4 * hi; PART[(F.wave * 32 + rw) * 66 + r32] = acc0[r]; PART[(F.wave * 32 + rw) * 66 + 32 + r32] = acc1[r]; }
        __syncthreads();
        { const int row = tid >> 4, c4 = (tid & 15) * 4; float v[4] = {0.f, 0.f, 0.f, 0.f};
#pragma unroll
            for (int w = 0; w < 8; ++w) { const LAS float* p = PART + (w * 32 + row) * 66 + c4; v[0] += p[0]; v[1] += p[1]; v[2] += p[2]; v[3] += p[3]; }
            E(NLAT + rb * 32 + row, cb * 64 + c4, v); }
        __syncthreads();
    }
}
struct Args { const float* in[N_IN]; float* out; unsigned char* ws; int ph_lo, ph_hi; };
static_assert(sizeof(Args) == N_IN * 8 + 8 + 8 + 8, "Args has no padding");

#ifndef MOE_WGM_UP
#define MOE_WGM_UP 4
#endif
#ifndef MOE_WGM_DN
#define MOE_WGM_DN 4
#endif
template <int ACT> __device__ __forceinline__ void tok_gemm(Frame& F, const bf16* A, const bf16* Bt, int N, int K, const pg8::EpiBf16<ACT>& E) {
    pg8::Gemm g{A, Bt, K, K, K, (unsigned)(128 * K * 2), (unsigned)(128 * K * 2)};
    TokOrder S; S.init(NLAT / 256, N / 256, F.G, F.bx); S.apan = (size_t)256 * K * 2; S.bpan = (size_t)256 * K * 2;
    pg8::gemm_phase<pg8::EpiBf16<ACT>, TokOrder, true, true>(F.lds + RING_OFF, g, S, E);
}
template <int L> __device__ __forceinline__ void moe_up(Frame& F) {
    moe_tables<L>(F);
    pg8::Gemm g{(const bf16*)(F.ws + WS_H8), (const bf16*)(F.ws + WS_WEXP_GU + (size_t)L * 32 * 2048 * 1024), 512, 512, 512, 128 * 512 * 2, 128 * 512 * 2};
    MoeOrderG S; S.init((int)F.MISC[MW_NMT], 8, F.G, F.bx, MOE_WGM_UP); S.mte = F.MISC + MW_MTE; S.bexp = (size_t)2048 * 1024; S.bpan = (size_t)256 * 1024; S.stok = (const unsigned*)(F.ws + WS_STOK); S.rowbytes = 1024u;
    EpiSwiGLU E{(unsigned char*)(F.ws + WS_ACT), argp(I_EBGU) + (size_t)L * 32 * 2048};
    pg8::gemm_phase<EpiSwiGLU, MoeOrderG, true, true, true, true>(F.lds + RING_OFF, g, S, E);
    if (CONV_DEFER && L < 3) {
        conv_tail(F, L + 1, ((int)F.MISC[MW_NMT] * 8) % F.G, CONV_UP_PER); }
}
template <int L> __device__ __forceinline__ void moe_down(Frame& F) {
    if (MK_PER_PHASE) moe_tables<L>(F);
    pg8::Gemm g{(const bf16*)(F.ws + WS_ACT), (const bf16*)(F.ws + WS_WEXP_DN + (size_t)L * 32 * 1024 * 1024), 512, 512, 512, 128 * 512 * 2, 128 * 512 * 2};
    MoeOrder S; S.init((int)F.MISC[MW_NMT], 4, F.G, F.bx, MOE_WGM_DN); S.mte = F.MISC + MW_MTE; S.bexp = (size_t)1024 * 1024; S.apan = (size_t)256 * 1024; S.bpan = (size_t)256 * 1024;
    EpiDown E{(bf16*)(F.ws + WS_YS), argp(I_EBD) + (size_t)L * 32 * 1024, (const unsigned*)(F.ws + WS_STOK)};
    pg8::gemm_phase<EpiDown, MoeOrder, true, true, false, true>(F.lds + RING_OFF, g, S, E);
    if (CONV_DEFER && L < 3) {
        conv_tail(F, L + 1, ((int)F.MISC[MW_NMT] * 4) % F.G, CONV_DN_PER); }
}

__global__ void __launch_bounds__(NTHR, 2) mk_fwd(Args args) {
    extern __shared__ __attribute__((aligned(16))) unsigned char lds[];
    Frame F;
    F.lds = (LAS unsigned char*)lds;
    F.MISC = (volatile LAS unsigned*)(F.lds + MISC_OFF);
    F.wave = __builtin_amdgcn_readfirstlane((int)threadIdx.x >> 6);
    F.G = gridDim.x; F.bx = blockIdx.x; F.vcu = (F.G % 8 == 0) ? (F.bx % 8) * (F.G / 8) + F.bx / 8 : F.bx;
    F.ws = args.ws; F.ctl = (gu32*)(args.ws + WS_CTL);
    for (int u = threadIdx.x; u < (LDS_BYTES - MISC_OFF) / 4; u += NTHR) ((LAS unsigned*)(F.lds + MISC_OFF))[u] = 0u;
    __syncthreads();
    XcdBarrier bar; bar.bar = (unsigned*)(F.ctl + CW_BAR); bar.x = 0; bar.st = nullptr;
    if (!MK_PER_PHASE) bar = xcd_barrier_post((unsigned*)(F.ctl + CW_BAR), F.MISC + MW_BAR);
    const int lo = args.ph_lo, hi = args.ph_hi;
#ifdef MK_ONLY
#define IN(k) ((k) == MK_ONLY && lo <= (k))
#else
#define IN(k) (lo <= (k) && (k) < hi)
#endif
#define SEAM(k) do { if (IN(k) && IN((k) + 1)) xcd_barrier(bar); } while (0)
#ifdef MK_REP_MASK
#define REP(k) (((MK_REP_MASK >> (k)) & 1ull) ? 2 : 1)
#else
#define REP(k) 1
#endif
#ifdef MK_PROBE_MASK
#define STAMP(k) do { if (threadIdx.x == 0) { const unsigned long long t_ = __builtin_amdgcn_s_memrealtime(); F.MISC[512 + 2 * (k)] = (unsigned)t_; F.MISC[513 + 2 * (k)] = (unsigned)(t_ >> 32); } } while (0)
#else
#define STAMP(k) do {} while (0)
#endif
    const bf16* Hb = (const bf16*)(F.ws + WS_H); bf16* Yb = (bf16*)(F.ws + WS_Y);

    STAMP(0); if (IN(0)) for (int rep_ = 0; rep_ < REP(0); ++rep_) { if (rep_) xcd_barrier(bar); asm volatile("; MK_PHASE_0" ::: "memory"); p0_prologue(F); } SEAM(0);
    STAMP(1); if (IN(1)) for (int rep_ = 0; rep_ < REP(1); ++rep_) { if (rep_) xcd_barrier(bar); asm volatile("; MK_PHASE_1" ::: "memory"); pass_init(F); } SEAM(1);
    STAMP(2); if (IN(2)) for (int rep_ = 0; rep_ < REP(2); ++rep_) { if (rep_) xcd_barrier(bar); asm volatile("; MK_PHASE_2" ::: "memory"); if ((EN_MIX >> 0) & 1) {
        { pg8::Gemm g{(const bf16*)(F.ws + TB_FC), Hb, 256, 256, 128 * DM, 128 * 256 * 2, DM * 2};
          ChDftOrder S; S.init(2, 256, F.G, F.bx); EpiChDft E{(bf16*)(F.ws + WS_BTA)};
          pg8::gemm_phase<EpiChDft, ChDftOrder, true, true>(F.lds + RING_OFF, g, S, E); }
#ifndef NO_CTX_DFT
        { pg8::Gemm g{(const bf16*)(F.ws + TB_FC), Hb, 256, 256, DM, 128 * 256 * 2, 128 * DM * 2};
          ChDftCtxOrder S; S.init(2, 4, F.G, F.bx); EpiChDftCtx E{(bf16*)(F.ws + WS_BTX)};
          pg8::gemm_phase<EpiChDftCtx, ChDftCtxOrder, true, true>(F.lds + RING_OFF, g, S, E); }
#endif
        } } SEAM(2);
    STAMP(3); if (IN(3)) for (int rep_ = 0; rep_ < REP(3); ++rep_) { if (rep_) xcd_barrier(bar); asm volatile("; MK_PHASE_3" ::: "memory"); if ((EN_MIX >> 0) & 1) {
        { pg8::Gemm g{(const bf16*)(F.ws + TB_FA), (const bf16*)(F.ws + WS_BTA), 256, 256, 256, 128 * 256 * 2, 128 * 256 * 2};
          TokOrder S; S.init(1, 512, F.G, F.bx); S.apan = 0; S.bpan = (size_t)256 * 256 * 2;
          EpiStepA E{(bf16*)(F.ws + WS_BTC), (const float*)(F.ws + TB_TWC), (const float*)(F.ws + TB_TWS)};
          pg8::gemm_phase<EpiStepA, TokOrder, true, true>(F.lds + RING_OFF, g, S, E); }
        } } SEAM(3);
    STAMP(4); if (IN(4)) for (int rep_ = 0; rep_ < REP(4); ++rep_) { if (rep_) xcd_barrier(bar); asm volatile("; MK_PHASE_4" ::: "memory"); if ((EN_MIX >> 0) & 1) {
        { pg8::Gemm g{(const bf16*)(F.ws + TB_FCC), (const bf16*)(F.ws + WS_BTC), 256, 256, 256, 128 * 256 * 2, 128 * 256 * 2};
        TokOrder S; S.init(1, 512, F.G, F.bx); S.apan = 0; S.bpan = (size_t)256 * 256 * 2;
        EpiStepC E{(bf16*)(F.ws + WS_MIXB)};
        pg8::gemm_phase<EpiStepC, TokOrder, true, true>(F.lds + RING_OFF, g, S, E); }
#ifndef NO_CTX_DFT
        { pg8::Gemm g{(const bf16*)(F.ws + TB_FX), (const bf16*)(F.ws + WS_BTX), 512, 512, 512, 128 * 512 * 2, 128 * 512 * 2};
          TokOrder S; S.init(1, 4, F.G, F.bx); S.apan = 0; S.bpan = (size_t)256 * 512 * 2;
          EpiCtxPos E{(bf16*)(F.ws + WS_MIXB)};
          pg8::gemm_phase<EpiCtxPos, TokOrder, true, true>(F.lds + RING_OFF, g, S, E); }
#endif
        } } SEAM(4);
    STAMP(5); if (IN(5)) for (int rep_ = 0; rep_ < REP(5); ++rep_) { if (rep_) xcd_barrier(bar); asm volatile("; MK_PHASE_5" ::: "memory"); if ((EN_MIX >> 0) & 1) { pg8::EpiBf16<0> E{Yb, DM, argp(I_FNB), 0, 0, 1.f}; tok_gemm<0>(F, (const bf16*)(F.ws + WS_MIXB), (const bf16*)(F.ws + WS_WFN), DM, DM, E);
        ctx_gemm(F, (const bf16*)(F.ws + WS_MIXB), (const bf16*)(F.ws + WS_WFN), DM, DM, 0, CtxEpiY{Yb, argp(I_FNB)}); } } SEAM(5);
    STAMP(6); if (IN(6)) for (int rep_ = 0; rep_ < REP(6); ++rep_) { if (rep_) xcd_barrier(bar); asm volatile("; MK_PHASE_6" ::: "memory"); pass_mix<0>(F); } SEAM(6);
    STAMP(7); if (IN(7)) for (int rep_ = 0; rep_ < REP(7); ++rep_) { if (rep_) xcd_barrier(bar); asm volatile("; MK_PHASE_7" ::: "memory"); }
    STAMP(8); if (IN(8)) for (int rep_ = 0; rep_ < REP(8); ++rep_) { if (rep_) xcd_barrier(bar); asm volatile("; MK_PHASE_8" ::: "memory"); if ((EN_MOE >> 0) & 1) moe_up<0>(F); } SEAM(8);
    STAMP(9); if (IN(9)) for (int rep_ = 0; rep_ < REP(9); ++rep_) { if (rep_) xcd_barrier(bar); asm volatile("; MK_PHASE_9" ::: "memory"); if ((EN_MOE >> 0) & 1) moe_down<0>(F); } SEAM(9);
    STAMP(10); if (IN(10)) for (int rep_ = 0; rep_ < REP(10); ++rep_) { if (rep_) xcd_barrier(bar); asm volatile("; MK_PHASE_10" ::: "memory"); pass_comb<0>(F); } SEAM(10);
    STAMP(11); if (IN(11)) for (int rep_ = 0; rep_ < REP(11); ++rep_) { if (rep_) xcd_barrier(bar); asm volatile("; MK_PHASE_11" ::: "memory"); if ((EN_MIX >> 1) & 1) {
        pg8::Gemm g{Hb, (const bf16*)(F.ws + WS_WFAQ), DM, DM, DM, 128 * DM * 2, 128 * DM * 2};
        TokOrder S; S.init(NLAT / 256, FA_NQKV / 256, F.G, F.bx); S.apan = (size_t)256 * DM * 2; S.bpan = (size_t)256 * DM * 2;
        EpiQKV<4, true> E{(bf16*)(F.ws + WS_Q), (bf16*)(F.ws + WS_K), (bf16*)(F.ws + WS_V), argp(I_FABQ), argp(I_FAQN), argp(I_FAKN), (const float*)(F.ws + TB_ROPC), (const float*)(F.ws + TB_ROPS)};
        pg8::gemm_phase<EpiQKV<4, true>, TokOrder, true, true>(F.lds + RING_OFF, g, S, E);
        if (CONV_DEFER) conv_tail(F, 1, ((NLAT / 256) * (FA_NQKV / 256)) % F.G, CONV_QKV_PER);
        ctx_gemm(F, Hb, (const bf16*)(F.ws + WS_WFAQ), FA_NQKV, DM, 1, CtxEpiQKV<4, true>{(bf16*)(F.ws + WS_Q), argp(I_FABQ), argp(I_FAQN), argp(I_FAKN)}); } } SEAM(11);
    STAMP(12); if (IN(12)) for (int rep_ = 0; rep_ < REP(12); ++rep_) { if (rep_) xcd_barrier(bar); asm volatile("; MK_PHASE_12" ::: "memory"); if ((EN_MIX >> 1) & 1) attn_phase<0>(F, (char*)lds + RING_OFF); } SEAM(12);
    STAMP(13); if (IN(13)) for (int rep_ = 0; rep_ < REP(13); ++rep_) { if (rep_) xcd_barrier(bar); asm volatile("; MK_PHASE_13" ::: "memory"); if ((EN_MIX >> 1) & 1) { pg8::EpiBf16<0> E{Yb, DM, argp(I_FABO), 0, 0, 1.f}; tok_gemm<0>(F, (const bf16*)(F.ws + WS_O), (const bf16*)(F.ws + WS_WFAO), DM, DM, E);
        ctx_gemm(F, (const bf16*)(F.ws + WS_O), (const bf16*)(F.ws + WS_WFAO), DM, DM, 0, CtxEpiY{Yb, argp(I_FABO)}); } } SEAM(13);
    STAMP(14); if (IN(14)) for (int rep_ = 0; rep_ < REP(14); ++rep_) { if (rep_) xcd_barrier(bar); asm volatile("; MK_PHASE_14" ::: "memory"); pass_mix<1>(F); } SEAM(14);
    STAMP(15); if (IN(15)) for (int rep_ = 0; rep_ < REP(15); ++rep_) { if (rep_) xcd_barrier(bar); asm volatile("; MK_PHASE_15" ::: "memory"); }
    STAMP(16); if (IN(16)) for (int rep_ = 0; rep_ < REP(16); ++rep_) { if (rep_) xcd_barrier(bar); asm volatile("; MK_PHASE_16" ::: "memory"); if ((EN_MOE >> 1) & 1) moe_up<1>(F); } SEAM(16);
    STAMP(17); if (IN(17)) for (int rep_ = 0; rep_ < REP(17); ++rep_) { if (rep_) xcd_barrier(bar); asm volatile("; MK_PHASE_17" ::: "memory"); if ((EN_MOE >> 1) & 1) moe_down<1>(F); } SEAM(17);
    STAMP(18); if (IN(18)) for (int rep_ = 0; rep_ < REP(18); ++rep_) { if (rep_) xcd_barrier(bar); asm volatile("; MK_PHASE_18" ::: "memory"); pass_comb<1>(F); } SEAM(18);
    STAMP(19); if (IN(19)) for (int rep_ = 0; rep_ < REP(19); ++rep_) { if (rep_) xcd_barrier(bar); asm volatile("; MK_PHASE_19" ::: "memory"); if ((EN_MIX >> 2) & 1) {
        { pg8::Gemm g{Hb, (const bf16*)(F.ws + WS_WGI), DM, DM, DM, 128 * DM * 2, 128 * DM * 2};
          TokOrder S; S.init(NLAT / 256, GM_FF / 256, F.G, F.bx); S.apan = (size_t)256 * DM * 2; S.bpan = (size_t)256 * DM * 2;
          EpiGeluUV E{(bf16*)(F.ws + WS_GU), (bf16*)(F.ws + WS_GV), argp(I_GMBI), (float*)(F.ws + WS_PSTAT)};
          pg8::gemm_phase<EpiGeluUV, TokOrder, true, true>(F.lds + RING_OFF, g, S, E); }
        ctx_gemm(F, Hb, (const bf16*)(F.ws + WS_WGI), GM_FF, DM, 0, CtxEpiGelu{(bf16*)(F.ws + WS_GU), (bf16*)(F.ws + WS_GV), argp(I_GMBI), (float*)(F.ws + WS_PSTAT)}); } } SEAM(19);
    STAMP(20); if (IN(20)) for (int rep_ = 0; rep_ < REP(20); ++rep_) { if (rep_) xcd_barrier(bar); asm volatile("; MK_PHASE_20" ::: "memory"); if ((EN_MIX >> 2) & 1) gate_phase(F); } SEAM(20);
    STAMP(21); if (IN(21)) for (int rep_ = 0; rep_ < REP(21); ++rep_) { if (rep_) xcd_barrier(bar); asm volatile("; MK_PHASE_21" ::: "memory"); if ((EN_MIX >> 2) & 1) { pg8::EpiBf16<0> E{Yb, DM, argp(I_GMBO), 0, 0, 1.f}; tok_gemm<0>(F, (const bf16*)(F.ws + WS_GG), (const bf16*)(F.ws + WS_WGO), DM, GM_HALF, E);
        ctx_gemm(F, (const bf16*)(F.ws + WS_GG), (const bf16*)(F.ws + WS_WGO), DM, GM_HALF, 0, CtxEpiY{Yb, argp(I_GMBO)}); } } SEAM(21);
    STAMP(22); if (IN(22)) for (int rep_ = 0; rep_ < REP(22); ++rep_) { if (rep_) xcd_barrier(bar); asm volatile("; MK_PHASE_22" ::: "memory"); pass_mix<2>(F); } SEAM(22);
    STAMP(23); if (IN(23)) for (int rep_ = 0; rep_ < REP(23); ++rep_) { if (rep_) xcd_barrier(bar); asm volatile("; MK_PHASE_23" ::: "memory"); }
    STAMP(24); if (IN(24)) for (int rep_ = 0; rep_ < REP(24); ++rep_) { if (rep_) xcd_barrier(bar); asm volatile("; MK_PHASE_24" ::: "memory"); if ((EN_MOE >> 2) & 1) moe_up<2>(F); } SEAM(24);
    STAMP(25); if (IN(25)) for (int rep_ = 0; rep_ < REP(25); ++rep_) { if (rep_) xcd_barrier(bar); asm volatile("; MK_PHASE_25" ::: "memory"); if ((EN_MOE >> 2) & 1) moe_down<2>(F); } SEAM(25);
    STAMP(26); if (IN(26)) for (int rep_ = 0; rep_ < REP(26); ++rep_) { if (rep_) xcd_barrier(bar); asm volatile("; MK_PHASE_26" ::: "memory"); pass_comb<2>(F); } SEAM(26);
    STAMP(27); if (IN(27)) for (int rep_ = 0; rep_ < REP(27); ++rep_) { if (rep_) xcd_barrier(bar); asm volatile("; MK_PHASE_27" ::: "memory"); if ((EN_MIX >> 3) & 1) {
        pg8::Gemm g{Hb, (const bf16*)(F.ws + WS_WWQ), DM, DM, DM, 128 * DM * 2, 128 * DM * 2};
        TokOrder S; S.init(NLAT / 256, WA_NQKV / 256, F.G, F.bx); S.apan = (size_t)256 * DM * 2; S.bpan = (size_t)256 * DM * 2;
        EpiQKV<2, false> E{(bf16*)(F.ws + WS_Q), (bf16*)(F.ws + WS_K), (bf16*)(F.ws + WS_V), argp(I_WABQ), nullptr, nullptr, (const float*)(F.ws + TB_ROPC), (const float*)(F.ws + TB_ROPS)};
        pg8::gemm_phase<EpiQKV<2, false>, TokOrder, true, true>(F.lds + RING_OFF, g, S, E);
        if (CONV_DEFER) conv_tail(F, 3, ((NLAT / 256) * (WA_NQKV / 256)) % F.G, CONV_QKV_PER);
        ctx_gemm(F, Hb, (const bf16*)(F.ws + WS_WWQ), WA_NQKV, DM, 1, CtxEpiQKV<2, false>{(bf16*)(F.ws + WS_Q), argp(I_WABQ), argp(I_WABQ), argp(I_WABQ)}); } } SEAM(27);
    STAMP(28); if (IN(28)) for (int rep_ = 0; rep_ < REP(28); ++rep_) { if (rep_) xcd_barrier(bar); asm volatile("; MK_PHASE_28" ::: "memory"); if ((EN_MIX >> 3) & 1) attn_phase<1>(F, (char*)lds + RING_OFF); } SEAM(28);
    STAMP(29); if (IN(29)) for (int rep_ = 0; rep_ < REP(29); ++rep_) { if (rep_) xcd_barrier(bar); asm volatile("; MK_PHASE_29" ::: "memory"); if ((EN_MIX >> 3) & 1) { pg8::EpiBf16<0> E{Yb, DM, argp(I_WABO), 0, 0, 1.f}; tok_gemm<0>(F, (const bf16*)(F.ws + WS_O), (const bf16*)(F.ws + WS_WWO), DM, DM, E); } } SEAM(29);
    STAMP(30); if (IN(30)) for (int rep_ = 0; rep_ < REP(30); ++rep_) { if (rep_) xcd_barrier(bar); asm volatile("; MK_PHASE_30" ::: "memory"); pass_mix<3>(F); } SEAM(30);
    STAMP(31); if (IN(31)) for (int rep_ = 0; rep_ < REP(31); ++rep_) { if (rep_) xcd_barrier(bar); asm volatile("; MK_PHASE_31" ::: "memory"); }
    STAMP(32); if (IN(32)) for (int rep_ = 0; rep_ < REP(32); ++rep_) { if (rep_) xcd_barrier(bar); asm volatile("; MK_PHASE_32" ::: "memory"); if ((EN_MOE >> 3) & 1) moe_up<3>(F); } SEAM(32);
    STAMP(33); if (IN(33)) for (int rep_ = 0; rep_ < REP(33); ++rep_) { if (rep_) xcd_barrier(bar); asm volatile("; MK_PHASE_33" ::: "memory"); if ((EN_MOE >> 3) & 1) moe_down<3>(F); } SEAM(33);
    STAMP(34); if (IN(34)) for (int rep_ = 0; rep_ < REP(34); ++rep_) { if (rep_) xcd_barrier(bar); asm volatile("; MK_PHASE_34" ::: "memory"); pass_comb<3>(F); }
#ifdef MK_PROBE_MASK
    STAMP(35); __syncthreads();
    { float us = 0.f;
      for (int k = 0; k < 35; ++k) if ((MK_PROBE_MASK >> k) & 1ull) { const unsigned long long a = ((unsigned long long)F.MISC[513 + 2 * k] << 32) | F.MISC[512 + 2 * k], b = ((unsigned long long)F.MISC[515 + 2 * k] << 32) | F.MISC[514 + 2 * k]; us += (float)(b - a) * 0.01f; }
      const float cval = us / (float)(MK_PROBE_DIV);
      const int lane = threadIdx.x & 63, gw = F.vcu * NWAVES + F.wave, NGW = F.G * NWAVES; RowV r;
      for (int j = 0; j < 4; ++j) r.v[j] = (f32x4){cval, cval, cval, cval};
      float* outp = (float*)argp(N_IN);
      for (int m = gw; m < NLAT; m += NGW) strow(outp + (size_t)m * DM, lane, r); }
#endif
#undef IN
#undef SEAM
}

extern "C" void kernel_launch(void* const* d_in, const int* in_sizes, int n_in, void* d_out, int out_size, void* d_ws, size_t ws_size, hipStream_t stream) {
    static int grid = 0;
    if (grid == 0) {
        if (n_in != N_IN || in_sizes[0] != NLAT * DM || out_size != NLAT * DM || ws_size < WS_END) { fprintf(stderr, "kernel_launch: unexpected shapes (n_in %d, in0 %d, out %d, ws %zu)\n", n_in, n_in > 0 ? in_sizes[0] : -1, out_size, ws_size); grid = -1; return; }
        int dev = 0, cus = 0, per_cu = 0;
        if (hipGetDevice(&dev) != hipSuccess || hipDeviceGetAttribute(&cus, hipDeviceAttributeMultiprocessorCount, dev) != hipSuccess) { grid = -1; return; }
        if (hipFuncSetAttribute((const void*)mk_fwd, hipFuncAttributeMaxDynamicSharedMemorySize, LDS_BYTES) != hipSuccess) { fprintf(stderr, "kernel_launch: hipFuncSetAttribute failed\n"); grid = -1; return; }
        if (hipOccupancyMaxActiveBlocksPerMultiprocessor(&per_cu, (const void*)mk_fwd, NTHR, LDS_BYTES) != hipSuccess || per_cu < 1) fprintf(stderr, "kernel_launch: occupancy query says %d\n", per_cu);
        (void)hipGetLastError();
        grid = cus;
    }
    if (grid < 0) return;
    if (hipMemsetAsync((char*)d_ws + WS_CTL, 0, CTL_ZERO_BYTES, stream) != hipSuccess) return;
    Args a{};
    for (int i = 0; i < N_IN; ++i) a.in[i] = (const float*)d_in[i];
    a.out = (float*)d_out; a.ws = (unsigned char*)d_ws;
#if MK_PER_PHASE
    for (int p = 0; p < NPHASE; ++p) { a.ph_lo = p; a.ph_hi = p + 1; hipLaunchKernelGGL(mk_fwd, dim3(grid), dim3(NTHR), LDS_BYTES, stream, a); }
#else
    a.ph_lo = 0; a.ph_hi = NPHASE; hipLaunchKernelGGL(mk_fwd, dim3(grid), dim3(NTHR), LDS_BYTES, stream, a);
#endif
}
```

```cpp
#define MK_PER_PHASE 0
#define EN_MIX 15
#define EN_MOE 15
#include <hip/hip_runtime.h>
#include <hip/hip_bf16.h>
#include <cstdio>
#include <cstdint>
#include <cmath>
#ifndef MK_PER_PHASE
#define MK_PER_PHASE 0
#endif
namespace pg8 {
#define PG8_LAS __attribute__((address_space(3)))
typedef unsigned short bf16_t;
typedef short bf16x8 __attribute__((ext_vector_type(8)));
typedef float f32x4 __attribute__((ext_vector_type(4)));
typedef float f32x2 __attribute__((ext_vector_type(2)));
typedef unsigned u32x4 __attribute__((ext_vector_type(4)));
typedef unsigned u32x2 __attribute__((ext_vector_type(2)));
constexpr int BM = 256, BK = 64, HALF = 128, HTB = HALF * BK * 2  , STAGE_BYTES = 8 * HTB, NXCD = 8, WGM = 2;

__host__ __device__ __forceinline__ int lds_byte(int r, int c) { const int st = (r >> 4) * 2 + (c >> 5), rr = r & 15, cc = c & 31, ob = rr * 64 + cc * 2; return st * 1024 + (ob ^ (((ob >> 9) & 1) << 5)); }
__host__ __device__ __forceinline__ void stage_rc(int b, int& R, int& C) { const int st = b / 1024, sb = b % 1024, swz = sb ^ (((sb >> 9) & 1) << 5); R = (st >> 1) * 16 + swz / 64; C = (st & 1) * 32 + (swz % 64) / 2; }
__host__ __device__ __forceinline__ int perm32(int rho) { const int n = rho >> 4, i = rho & 15; return 8 * (i >> 2) + 4 * n + (i & 3); }

struct Unit { int pm, pn, e; };
struct Gemm { const bf16_t* A; const bf16_t* Bt; int K, lda, ldb; unsigned hstepA, hstepB; };

struct GridOrder {
    int nM, nN, nwg, G, c, wgm;
    __device__ __forceinline__ void init(int nM_, int nN_, int G_, int c_, int wgm_ = WGM) { nM = nM_; nN = nN_; nwg = nM * nN; G = G_; c = c_; wgm = wgm_; }
    __device__ __forceinline__ bool next_mn(int i, int& pm, int& pn) const {
        const long L = (long)i * G + c; if (L >= nwg) return false;
        int wgid = (int)L; { const int q = nwg / NXCD, r = nwg % NXCD, xcd = wgid % NXCD, off = wgid / NXCD; wgid = (xcd < r ? xcd * (q + 1) : r * (q + 1) + (xcd - r) * q) + off; }
        const int nig = wgm * nN, gid = wgid / nig, fm = gid * wgm, gsz = (nM - fm) < wgm ? (nM - fm) : wgm;
        pm = fm + ((wgid % nig) % gsz); pn = (wgid % nig) / gsz; return true;
    }
};
__device__ __forceinline__ unsigned cvt_pk_bf16(float lo, float hi) { unsigned r; asm volatile("v_cvt_pk_bf16_f32 %0, %1, %2" : "=v"(r) : "v"(lo), "v"(hi)); return r; }
__device__ __forceinline__ f32x2 gelu_pk(f32x2 v) {
    const f32x2 av = __builtin_elementwise_abs(v), d = av * 0.2316418882f + 1.0f;
    f32x2 t; t.x = __builtin_amdgcn_rcpf(d.x); t.y = __builtin_amdgcn_rcpf(d.y);
    f32x2 q = t * 0.5307027145f + (-0.7265760135f); q = q * t + 0.7107068705f; q = q * t + (-0.142248368f); q = q * t + 0.127414796f; q = q * t;
    const f32x2 s = (v * v) * (-0.72134752044f);
    f32x2 e; e.x = __builtin_amdgcn_exp2f(s.x); e.y = __builtin_amdgcn_exp2f(s.y);
    const f32x2 m = v * (q * e), r = v - m;
    f32x2 o; o.x = v.x < 0.f ? m.x : r.x; o.y = v.y < 0.f ? m.y : r.y; return o;
}

template <int ACT  > struct EpiBf16 {
    static constexpr bool PERM = true, AFTER_DRAIN = false; static_assert(ACT == 0 || ACT == 1, "EpiBf16: ACT is 0 (none) or 1 (gelu_pk)");
    bf16_t* O; int ldc; const float* bias; int split_cols; size_t split_stride; float scale0;
    __device__ __forceinline__ void operator()(const f32x4 (&acc)[2][2][4][2], const Unit& u, int wr, int wc, int fr, int fq) const {
        const int row0 = u.pm * BM + wr * 64 + fr; int colt = u.pn * BM; bf16_t* base = O;
        float sc = 1.f; if (split_cols) { const int t = colt / split_cols; base += (size_t)t * split_stride; colt -= t * split_cols; if (t == 0) sc = scale0; }
        const int col0 = colt + wc * 32 + 8 * fq, bcol0 = u.pn * BM + wc * 32 + 8 * fq;
        f32x4 bv[2][2];
#pragma unroll
        for (int bj = 0; bj < 2; ++bj)
#pragma unroll
            for (int n = 0; n < 2; ++n) bv[bj][n] = bias ? *(const f32x4*)(bias + bcol0 + bj * HALF + 4 * n) : (f32x4){0.f, 0.f, 0.f, 0.f};
#pragma unroll
        for (int ai = 0; ai < 2; ++ai)
#pragma unroll
            for (int m = 0; m < 4; ++m) { bf16_t* rowp = base + (size_t)(row0 + ai * HALF + m * 16) * ldc + col0;
#pragma unroll
                for (int bj = 0; bj < 2; ++bj) { f32x4 v0 = acc[ai][bj][m][0] + bv[bj][0], v1 = acc[ai][bj][m][1] + bv[bj][1];
                    if (ACT == 1) { f32x2 a = gelu_pk((f32x2){v0[0], v0[1]}), b = gelu_pk((f32x2){v0[2], v0[3]}), c = gelu_pk((f32x2){v1[0], v1[1]}), d = gelu_pk((f32x2){v1[2], v1[3]});
                        v0 = (f32x4){a.x, a.y, b.x, b.y}; v1 = (f32x4){c.x, c.y, d.x, d.y}; }
                    v0 = v0 * sc; v1 = v1 * sc; u32x4 w; w.x = cvt_pk_bf16(v0[0], v0[1]); w.y = cvt_pk_bf16(v0[2], v0[3]); w.z = cvt_pk_bf16(v1[0], v1[1]); w.w = cvt_pk_bf16(v1[2], v1[3]);
                    *(u32x4*)(rowp + bj * HALF) = w; } }
    }
};
typedef int v8i_t __attribute__((ext_vector_type(8))); typedef int v4i_t __attribute__((ext_vector_type(4)));
template <class Epi, class Sched, bool ALIGN_EPI = false, bool SP2 = false, bool GATHER = false, bool F8 = false>
__device__ __forceinline__ void gemm_phase(PG8_LAS unsigned char* lds, const Gemm g, const Sched& S, const Epi& E) {
    int tid_ = threadIdx.x; asm volatile("" : "+v"(tid_));
    const int tid = tid_, wid = __builtin_amdgcn_readfirstlane(tid >> 6), lane = tid & 63, wr = wid >> 2, wc = wid & 3, fr = lane & 15, fq = lane >> 4;
    const int K = g.K; int nt = K / BK; if constexpr (F8) asm volatile("" : "+s"(nt));
    unsigned voffA[2], voffB[2];
#pragma unroll
    for (int i = 0; i < 2; ++i) { int R, C; stage_rc(tid * 16 + i * 8192, R, C); const int Rb = Epi::PERM ? ((R & ~31) + perm32(R & 31)) : R;
        voffA[i] = (unsigned)(R * g.lda + C) * 2u; voffB[i] = (unsigned)(Rb * g.ldb + C) * 2u; }
    const size_t kstep = (size_t)(BK * 2);
    const size_t hstepA = g.hstepA, hstepB = g.hstepB;
    const unsigned ldsw = (unsigned)wid * 1024u;
    const int aoff = lds_byte(wr * 64 + fr, fq * 8), boff = lds_byte(wc * 32 + fr, fq * 8);
#define PG8_SA(b, h) (((b) * 2 + (h)) * HTB)
#define PG8_SB(b, h) ((4 + (b) * 2 + (h)) * HTB)
#define PG8_STAGE(bufoff, gbase, voff) do { _Pragma("unroll") for (int _i = 0; _i < 2; ++_i) { unsigned _vo = (voff)[_i]; asm volatile("" : "+v"(_vo));     \
        __builtin_amdgcn_global_load_lds((const unsigned*)((const char*)(gbase) + _vo), (PG8_LAS unsigned*)(lds + (bufoff) + ldsw + _i * 8192), 16, 0, 0); } } while (0)
#define PG8_CAT8(x, y) __builtin_shufflevector(__builtin_bit_cast(v4i_t, x), __builtin_bit_cast(v4i_t, y), 0, 1, 2, 3, 4, 5, 6, 7)
#define PG8_LDA(dst, b, h) do { _Pragma("unroll") for (int m = 0; m < 4; ++m) { const bf16x8 f0_ = *(const PG8_LAS bf16x8*)(lds + PG8_SA(b, h) + aoff + m * 2048), f1_ = *(const PG8_LAS bf16x8*)(lds + PG8_SA(b, h) + aoff + m * 2048 + 1024); \
        if constexpr (F8) dst##8[m] = PG8_CAT8(f0_, f1_); else { dst[m][0] = f0_; dst[m][1] = f1_; } } } while (0)
#define PG8_LDB(dst, b, h) do { _Pragma("unroll") for (int n = 0; n < 2; ++n) { const bf16x8 f0_ = *(const PG8_LAS bf16x8*)(lds + PG8_SB(b, h) + boff + n * 2048), f1_ = *(const PG8_LAS bf16x8*)(lds + PG8_SB(b, h) + boff + n * 2048 + 1024); \
        if constexpr (F8) dst##8[n] = PG8_CAT8(f0_, f1_); else { dst[n][0] = f0_; dst[n][1] = f1_; } } } while (0)
#define PG8_MMA(ai, bj, At, Bt) do { __builtin_amdgcn_s_setprio(1); _Pragma("unroll") for (int m = 0; m < 4; ++m) _Pragma("unroll") for (int n = 0; n < 2; ++n) { \
        if constexpr (F8) asm volatile("v_mfma_scale_f32_16x16x128_f8f6f4 %0, %1, %2, %0, %3, %3 op_sel_hi:[0,0,0]" : "+v"(acc[ai][bj][m][n]) : "v"(Bt##8[n]), "v"(At##8[m]), "v"(f8scale));   \
        else { _Pragma("unroll") for (int k = 0; k < 2; ++k) acc[ai][bj][m][n] = __builtin_amdgcn_mfma_f32_16x16x32_bf16(Bt[n][k], At[m][k], acc[ai][bj][m][n], 0, 0, 0); } } __builtin_amdgcn_s_setprio(0); } while (0)
#define PG8_WAIT_V(n) asm volatile("s_waitcnt vmcnt(" #n ")" ::: "memory")
#define PG8_WAIT_L(n) asm volatile("s_waitcnt lgkmcnt(" #n ")" ::: "memory")
#define PG8_BAR __builtin_amdgcn_s_barrier()
#define PG8_SCHED __builtin_amdgcn_sched_barrier(0)
    Unit cur, nxt; int ui = 0;
    if (!S.next(0, cur)) return;
    f32x4 acc[2][2][4][2];
#pragma unroll
    for (int a = 0; a < 2; ++a)
#pragma unroll
        for (int b = 0; b < 2; ++b)
#pragma unroll
            for (int m = 0; m < 4; ++m)
#pragma unroll
                for (int n = 0; n < 2; ++n) acc[a][b][m][n] = (f32x4){0.f, 0.f, 0.f, 0.f};
    const int f8scale = 0x7F7F7F7F;
    bf16x8 At[4][2], B0[2][2], B1[2][2]; v8i_t At8[4], B08[2], B18[2];
    const char* cA = (const char*)g.A + S.offA(cur); const char* cB = (const char*)g.Bt + S.offB(cur);
    unsigned va0[2], va1[2], vn0[2], vn1[2];
#define PG8_AOFFS(dst0, dst1, unit) do { _Pragma("unroll") for (int i = 0; i < 2; ++i) { if constexpr (GATHER) { int R, C; stage_rc(tid * 16 + i * 8192, R, C); \
        dst0[i] = S.rowoff(unit, R) + (unsigned)C * 2u; dst1[i] = S.rowoff(unit, R + HALF) + (unsigned)C * 2u; } else { dst0[i] = voffA[i]; dst1[i] = voffA[i] + (unsigned)hstepA; } } } while (0)
    PG8_AOFFS(va0, va1, cur);
    S.a_ready(cur);
    if constexpr (SP2) {
        PG8_STAGE(PG8_SB(0, 0), cB, voffB); PG8_STAGE(PG8_SB(0, 1), cB + hstepB, voffB); PG8_STAGE(PG8_SA(0, 0), cA, va0); PG8_STAGE(PG8_SA(0, 1), cA, va1);
        if (wr == 1) PG8_BAR;
        PG8_WAIT_V(2); PG8_BAR;
        PG8_STAGE(PG8_SB(1, 0), cB + kstep, voffB); PG8_STAGE(PG8_SA(1, 0), cA + kstep, va0); PG8_STAGE(PG8_SB(1, 1), cB + hstepB + kstep, voffB);
        PG8_WAIT_V(6); PG8_BAR;
    } else {
        PG8_STAGE(PG8_SB(0, 0), cB, voffB); PG8_STAGE(PG8_SA(0, 0), cA, va0); PG8_STAGE(PG8_SB(0, 1), cB + hstepB, voffB); PG8_STAGE(PG8_SA(0, 1), cA, va1);
        if (wr == 1) PG8_BAR;
        PG8_WAIT_V(4); PG8_BAR;
        PG8_STAGE(PG8_SB(1, 0), cB + kstep, voffB); PG8_STAGE(PG8_SA(1, 0), cA + kstep, va0); PG8_STAGE(PG8_SB(1, 1), cB + hstepB + kstep, voffB);
        PG8_WAIT_V(6); PG8_BAR;
    }
    for (;;) {
        const bool has_next = S.next(ui + 1, nxt);
        if (GATHER && has_next) PG8_AOFFS(vn0, vn1, nxt); else { vn0[0] = va0[0]; vn0[1] = va0[1]; vn1[0] = va1[0]; vn1[1] = va1[1]; }
        const char* nA = has_next ? (const char*)g.A + S.offA(nxt) : cA; const char* nB = has_next ? (const char*)g.Bt + S.offB(nxt) : cB;
        for (int t = 0; t < nt; t += 2) {
            const bool last = (t == nt - 2);
            const unsigned vs0[2] = {last ? vn0[0] : va0[0], last ? vn0[1] : va0[1]}, vs1[2] = {last ? vn1[0] : va1[0], last ? vn1[1] : va1[1]};
            const char* a1 = cA + (size_t)(t + 1) * kstep;
            const char* a2 = last ? nA : cA + (size_t)(t + 2) * kstep; const char* b2 = last ? nB : cB + (size_t)(t + 2) * kstep;
            const char* a3 = a2 + kstep; const char* b3 = b2 + kstep;
            if (last && has_next) S.a_ready(nxt);
            if constexpr (SP2) {
            PG8_LDB(B0, 0, 0); PG8_LDB(B1, 0, 1); PG8_SCHED; PG8_LDA(At, 0, 0); PG8_STAGE(PG8_SA(1, 1), a1, va1);
            PG8_WAIT_V(8); PG8_WAIT_L(0); PG8_BAR; PG8_MMA(0, 0, At, B0); PG8_MMA(0, 1, At, B1); PG8_BAR; PG8_SCHED;
            PG8_LDA(At, 0, 1); PG8_STAGE(PG8_SB(0, 0), b2, voffB); PG8_STAGE(PG8_SB(0, 1), b2 + hstepB, voffB); PG8_STAGE(PG8_SA(0, 0), a2, vs0);
            PG8_WAIT_V(8); PG8_WAIT_L(0); PG8_BAR; PG8_MMA(1, 0, At, B0); PG8_MMA(1, 1, At, B1); PG8_BAR; PG8_SCHED;
            PG8_LDB(B0, 1, 0); PG8_LDB(B1, 1, 1); PG8_SCHED; PG8_LDA(At, 1, 0); PG8_STAGE(PG8_SA(0, 1), a2, vs1);
            PG8_WAIT_V(8); PG8_WAIT_L(0); PG8_BAR; PG8_MMA(0, 0, At, B0); PG8_MMA(0, 1, At, B1); PG8_BAR; PG8_SCHED;
            PG8_LDA(At, 1, 1); PG8_STAGE(PG8_SB(1, 0), b3, voffB); PG8_STAGE(PG8_SB(1, 1), b3 + hstepB, voffB); PG8_STAGE(PG8_SA(1, 0), a3, vs0);
            PG8_WAIT_V(8); PG8_WAIT_L(0); PG8_BAR; PG8_MMA(1, 0, At, B0); PG8_MMA(1, 1, At, B1); PG8_BAR; PG8_SCHED;
            } else {
            PG8_LDB(B0, 0, 0); PG8_SCHED; PG8_LDA(At, 0, 0); PG8_STAGE(PG8_SA(1, 1), a1, va1);
            PG8_WAIT_L(8); PG8_BAR; PG8_WAIT_L(0); PG8_MMA(0, 0, At, B0); PG8_BAR; PG8_SCHED;
            PG8_LDB(B1, 0, 1); PG8_STAGE(PG8_SB(0, 0), b2, voffB);
            PG8_BAR; PG8_WAIT_L(0); PG8_MMA(0, 1, At, B1); PG8_BAR;
            PG8_LDA(At, 0, 1); PG8_STAGE(PG8_SA(0, 0), a2, vs0);
            PG8_BAR; PG8_WAIT_L(0); PG8_MMA(1, 0, At, B0); PG8_BAR; PG8_SCHED;
            PG8_STAGE(PG8_SB(0, 1), b2 + hstepB, voffB);
            PG8_WAIT_V(6); PG8_BAR; PG8_MMA(1, 1, At, B1); PG8_BAR;
            PG8_LDB(B0, 1, 0); PG8_SCHED; PG8_LDA(At, 1, 0); PG8_STAGE(PG8_SA(0, 1), a2, vs1);
            PG8_WAIT_L(8); PG8_BAR; PG8_WAIT_L(0); PG8_MMA(0, 0, At, B0); PG8_BAR; PG8_SCHED;
            PG8_LDB(B1, 1, 1); PG8_STAGE(PG8_SB(1, 0), b3, voffB);
            PG8_BAR; PG8_WAIT_L(0); PG8_MMA(0, 1, At, B1); PG8_BAR;
            PG8_LDA(At, 1, 1); PG8_STAGE(PG8_SA(1, 0), a3, vs0);
            PG8_BAR; PG8_WAIT_L(0); PG8_MMA(1, 0, At, B0); PG8_BAR; PG8_SCHED;
            PG8_STAGE(PG8_SB(1, 1), b3 + hstepB, voffB);
            PG8_WAIT_V(6); PG8_BAR; PG8_MMA(1, 1, At, B1); PG8_BAR;
            }
        }
        if constexpr (ALIGN_EPI) { if (wr == 0) PG8_BAR; }
        if constexpr (F8) asm volatile("s_nop 15\n\ts_nop 7" ::: "memory");
        if constexpr (!Epi::AFTER_DRAIN) { E(acc, cur, wr, wc, fr, fq); S.done(cur); }
        if (!has_next) break;
#pragma unroll
        for (int a = 0; a < 2; ++a)
#pragma unroll
            for (int b = 0; b < 2; ++b)
#pragma unroll
                for (int m = 0; m < 4; ++m)
#pragma unroll
                    for (int n = 0; n < 2; ++n) acc[a][b][m][n] = (f32x4){0.f, 0.f, 0.f, 0.f};
        cur = nxt; cA = nA; cB = nB; ++ui; va0[0] = vn0[0]; va0[1] = vn0[1]; va1[0] = vn1[0]; va1[1] = vn1[1];
        if constexpr (ALIGN_EPI) { if (wr == 1) PG8_BAR; }
    }
    PG8_WAIT_V(0);
    if constexpr (!ALIGN_EPI) { if (wr == 0) PG8_BAR; }
    PG8_BAR;
    if constexpr (Epi::AFTER_DRAIN) { E.fused(acc, cur, wr, wc, fr, fq, lds, wid, lane); S.done(cur); }
#undef PG8_SA
#undef PG8_AOFFS
#undef PG8_SB
#undef PG8_STAGE
#undef PG8_LDA
#undef PG8_LDB
#undef PG8_MMA
#undef PG8_CAT8
#undef PG8_WAIT_V
#undef PG8_WAIT_L
#undef PG8_BAR
#undef PG8_SCHED
}
}
namespace attn_body {
using bf16=__hip_bfloat16;
using bf16x8=__attribute__((ext_vector_type(8)))short;
using s16x4=__attribute__((ext_vector_type(4)))short;
using f32x16=__attribute__((ext_vector_type(16)))float;
using u32x4=__attribute__((ext_vector_type(4)))unsigned;
constexpr int D=64,QP=1024;
constexpr int NW=8,QBLK=32,QB=QBLK*NW,KVBLK=64;
__device__ __forceinline__ void wmask(f32x16&p0,f32x16&p1,int t,int kstart,int qabs,int hi){
  if(t<4)return; const float NEG=-INFINITY; const int kb=kstart+64*(t-4)+4*hi-qabs;
  #pragma unroll
  for(int r=0;r<16;++r){const int dk=kb+(r&3)+8*(r>>2); if(dk>128||dk<-128)p0[r]=NEG; if(dk+32>128||dk+32<-128)p1[r]=NEG;}
}
__device__ __forceinline__ int crow(int r,int hi){return (r&3)+8*(r>>2)+4*hi;}
#define SBAR() __builtin_amdgcn_sched_barrier(0)
__device__ __forceinline__ void cmask(f32x16&p0,f32x16&p1,int jb,int qrel,int hi){
  const float NEG=-INFINITY; int kb=64*jb+4*hi;
  #pragma unroll
  for(int r=0;r<16;++r){int kv=kb+(r&3)+8*(r>>2); if(kv>qrel)p0[r]=NEG; if(kv+32>qrel)p1[r]=NEG;}
}

constexpr int NSLOT=3, SLOTB=8192;
constexpr int LDS_K=0, LDS_V=NSLOT*SLOTB, LDS_WS=2*NSLOT*SLOTB, LDS_OST=LDS_WS+NW*64*4, LDS_BYTES=LDS_OST+NW*4096;
constexpr float C2=0.125f*1.4426950408889634f;
__device__ __forceinline__ void glds16(const void*gsrc,unsigned lds_dst){unsigned keep;
  asm volatile("s_mov_b32 %0, m0\n\ts_mov_b32 m0, %2\n\ts_nop 0\n\tglobal_load_lds_dwordx4 %1, off\n\ts_mov_b32 m0, %0":"=&s"(keep):"v"(gsrc),"s"(lds_dst):"memory");}
__device__ __forceinline__ float max3f(float a,float b,float c){float r;asm("v_max3_f32 %0, %1, %2, %3":"=v"(r):"v"(a),"v"(b),"v"(c));return r;}
__device__ __forceinline__ float max2f(float a,float b){float r;asm("v_max_f32_e32 %0, %1, %2":"=v"(r):"v"(a),"v"(b));return r;}
__device__ __forceinline__ float fadd_s(float a,float b){float r;asm("v_add_f32_e32 %0, %1, %2":"=v"(r):"v"(a),"v"(b));return r;}
__device__ __forceinline__ float fsub_s(float a,float b){float r;asm("v_sub_f32_e32 %0, %1, %2":"=v"(r):"v"(a),"v"(b));return r;}
typedef float f32x2_t __attribute__((ext_vector_type(2))); typedef __bf16 bf16x2_t __attribute__((ext_vector_type(2)));
__device__ __forceinline__ unsigned cvtpk_s(float lo,float hi){f32x2_t v={lo,hi};bf16x2_t b=__builtin_convertvector(v,bf16x2_t);return __builtin_bit_cast(unsigned,b);}
#define WAIT_BAR(N) asm volatile("s_waitcnt vmcnt(" #N ") lgkmcnt(0)\n\ts_barrier":::"memory")

__device__ __forceinline__ void qkt(f32x16&p0,f32x16&p1,const char*Kslot,const bf16x8*qr,const f32x16&negm,int r32,int hi){
  const char*kb=Kslot+hi*1024+r32*16;
  #pragma unroll
  for(int d0=0;d0<4;++d0){
    const bf16x8 b0=*reinterpret_cast<const bf16x8*>(kb+d0*2048);
    const bf16x8 b1=*reinterpret_cast<const bf16x8*>(kb+d0*2048+512);
    if(d0==0){p0=__builtin_amdgcn_mfma_f32_32x32x16_bf16(b0,qr[0],negm,0,0,0);p1=__builtin_amdgcn_mfma_f32_32x32x16_bf16(b1,qr[0],negm,0,0,0);}
    else{p0=__builtin_amdgcn_mfma_f32_32x32x16_bf16(b0,qr[d0],p0,0,0,0);p1=__builtin_amdgcn_mfma_f32_32x32x16_bf16(b1,qr[d0],p1,0,0,0);}}
}
typedef __attribute__((address_space(3))) const char* lds_cptr;
typedef short v4i16_t __attribute__((ext_vector_type(4)));
__device__ __forceinline__ void kload8(bf16x8*kf,lds_cptr kp){
  kf[0]=*(const __attribute__((address_space(3))) bf16x8*)(kp);      kf[1]=*(const __attribute__((address_space(3))) bf16x8*)(kp+512);
  kf[2]=*(const __attribute__((address_space(3))) bf16x8*)(kp+2048); kf[3]=*(const __attribute__((address_space(3))) bf16x8*)(kp+2560);
  kf[4]=*(const __attribute__((address_space(3))) bf16x8*)(kp+4096); kf[5]=*(const __attribute__((address_space(3))) bf16x8*)(kp+4608);
  kf[6]=*(const __attribute__((address_space(3))) bf16x8*)(kp+6144); kf[7]=*(const __attribute__((address_space(3))) bf16x8*)(kp+6656);
}
__device__ __forceinline__ void kload2(bf16x8*kf,lds_cptr kp,int j){ kf[2*j]=*(const __attribute__((address_space(3))) bf16x8*)(kp+j*2048); kf[2*j+1]=*(const __attribute__((address_space(3))) bf16x8*)(kp+j*2048+512); }
__device__ __forceinline__ s16x4 vtr(lds_cptr p){ return __builtin_bit_cast(s16x4,__builtin_amdgcn_ds_read_tr16_b64_v4i16((__attribute__((address_space(3))) v4i16_t*)p)); }
__device__ __forceinline__ float rowmax(const f32x16&p0,const f32x16&p1){
  float a=max3f(p0[0],p0[1],p1[0]),b=max3f(p0[2],p0[3],p1[1]);a=max3f(a,p1[2],p1[3]);
  #pragma unroll
  for(int r=4;r<16;r+=4){a=max3f(a,p0[r],p0[r+1]);b=max3f(b,p0[r+2],p0[r+3]);a=max3f(a,p1[r],p1[r+1]);b=max3f(b,p1[r+2],p1[r+3]);}
  const float m=max2f(a,b);
  auto rr=__builtin_amdgcn_permlane32_swap(__float_as_uint(m),__float_as_uint(m),false,false);
  return max2f(__uint_as_float(rr[0]),__uint_as_float(rr[1]));
}
__device__ __forceinline__ void pv(f32x16*o,int vb,bf16x8 pa0,bf16x8 pa1,bf16x8 pa2,bf16x8 pa3){
  #pragma unroll
  for(int d0=0;d0<2;++d0){s16x4 lo[4],hi[4];
    #pragma unroll
    for(int ks=0;ks<4;++ks){
      asm volatile("ds_read_b64_tr_b16 %0,%1 offset:%c2":"=&v"(lo[ks]):"v"(vb),"i"(d0*4096+ks*1024):"memory");
      asm volatile("ds_read_b64_tr_b16 %0,%1 offset:%c2":"=&v"(hi[ks]):"v"(vb),"i"(d0*4096+ks*1024+512):"memory");}
    asm volatile("s_waitcnt lgkmcnt(0)":::"memory");SBAR();
    #define PK(k) (bf16x8){lo[k][0],lo[k][1],lo[k][2],lo[k][3],hi[k][0],hi[k][1],hi[k][2],hi[k][3]}
    o[d0]=__builtin_amdgcn_mfma_f32_32x32x16_bf16(pa0,PK(0),o[d0],0,0,0);
    o[d0]=__builtin_amdgcn_mfma_f32_32x32x16_bf16(pa1,PK(1),o[d0],0,0,0);
    o[d0]=__builtin_amdgcn_mfma_f32_32x32x16_bf16(pa2,PK(2),o[d0],0,0,0);
    o[d0]=__builtin_amdgcn_mfma_f32_32x32x16_bf16(pa3,PK(3),o[d0],0,0,0);
    #undef PK
  }
}

#ifndef ATTN_STORE16
#define ATTN_STORE16(p,v) (*(u32x4*)(p)=(v))
#endif
template<int MODE,int KP,int THRL> __device__ __forceinline__ void attn_unit(int h,int kvh,int q0,int NT,int kbase,float sink_l2,const bf16*Q,const bf16*__restrict__ K,const bf16*__restrict__ V,bf16*O,char*shm){
  int tid_=threadIdx.x; asm volatile("":"+v"(tid_)); const int tid=tid_,lane=tid&63,r32=lane&31,hi=lane>>5; const int wid=__builtin_amdgcn_readfirstlane(tid>>6);
  #define TROW(t) (MODE==0 ? (kbase+64*(t)) : ((t)<4 ? 16384+64*(t) : kbase+64*((t)-4)))
  const bf16*Qw=Q+(long)(q0+wid*QBLK)*QP+h*D;
  const bf16*Kh=K+kvh*D,*Vh=V+kvh*D;
  const unsigned lds0=(unsigned)(uintptr_t)shm;
  float*wsf=(float*)(shm+LDS_WS)+wid*64;
  const bf16*ksrc=Kh+(long)lane*KP+wid*8;
  const bf16*vsrc=Vh+(long)(16*(wid&3)+(lane>>2))*KP+(wid>>2)*32+(lane&3)*8;
  const unsigned kdst=lds0+LDS_K+wid*1024, vdst=lds0+LDS_V+wid*1024;
  #define DMA_K(t,slot) glds16(ksrc+(long)TROW(t)*KP,(unsigned)__builtin_amdgcn_readfirstlane(kdst+(slot)))
  #define DMA_V(t,slot) glds16(vsrc+(long)TROW(t)*KP,(unsigned)__builtin_amdgcn_readfirstlane(vdst+(slot)))
  const int vb0=(int)(lds0+LDS_V)+((lane>>4)&1)*32+(lane&3)*8+(4*hi+((lane&15)>>2))*64;
  const char*Kbase=shm+LDS_K; bf16x8 kf[8];
  const lds_cptr shm3=(lds_cptr)shm; const lds_cptr kp0=shm3+LDS_K+hi*1024+r32*16; const lds_cptr vp0=shm3+LDS_V+((lane>>4)&1)*32+(lane&3)*8+(4*hi+((lane&15)>>2))*64;
  DMA_K(0,0);DMA_V(0,0);DMA_K(1,SLOTB);
  bf16x8 qr[4];
  #pragma unroll
  for(int d0=0;d0<4;++d0)qr[d0]=*reinterpret_cast<const bf16x8*>(&Qw[(long)r32*QP+d0*16+hi*8]);
  float mhat=0.f,l_reg=0.f;f32x16 o[2];o[0]=f32x16{};o[1]=f32x16{};f32x16 negm=f32x16{};asm volatile("":"+v"(negm));
  const int qabs=q0+wid*QBLK+r32;
  #define CMASK(P0,P1,t) do{ if(MODE==1) wmask(P0,P1,(t),kbase,qabs,hi); }while(0)
  bool resc=false;
  #define START(P0,P1) do{ const float rm=rowmax(P0,P1); resc=false; \
    { const float dl=rm; mhat=fadd_s(mhat,dl); \
      _Pragma("unroll") for(int r=0;r<16;++r){P0[r]=fsub_s(P0[r],dl);P1[r]=fsub_s(P1[r],dl);} \
      _Pragma("unroll") for(int r=0;r<16;++r)negm[r]=-mhat; asm volatile("":"+v"(negm)); } \
    _Pragma("unroll") for(int r=0;r<16;++r)P0[r]=__builtin_amdgcn_exp2f(P0[r]); }while(0)
  #define RESC() do{ if(resc){ asm volatile("s_waitcnt lgkmcnt(0)":::"memory"); \
      _Pragma("unroll") for(int d_=0;d_<2;++d_) _Pragma("unroll") for(int r=0;r<16;++r)o[d_][r]*=wsf[crow(r,hi)]; } }while(0)
  f32x16 pA0,pA1,pB0,pB1;
  int sl_prev=0,sl_cur=0,sl_next=SLOTB;
  #define ROT() do{sl_prev=sl_cur;sl_cur=sl_next;sl_next=(sl_next==(NSLOT-1)*SLOTB)?0:sl_next+SLOTB;}while(0)
  DMA_K(2,2*SLOTB);
  WAIT_BAR(3);
  qkt(pA0,pA1,Kbase,qr,negm,r32,hi);asm volatile("s_nop 15\n\ts_nop 7":"+v"(pA0),"+v"(pA1));CMASK(pA0,pA1,0);
  START(pA0,pA1);
  _Pragma("unroll") for(int r=0;r<16;++r)pA1[r]=__builtin_amdgcn_exp2f(pA1[r]);
  WAIT_BAR(0);
  DMA_K(3,0);DMA_V(1,SLOTB);
  ROT();
  kload8(kf,kp0+sl_cur);
  WAIT_BAR(2);
  s16x4 vlo[8],vhi[8]; u32x4 pw0,pw1,pw2,pw3;
  #define PKW(P,B) cvtpk_s(P[B],P[B+1])
  #define PAF(k) __builtin_bit_cast(bf16x8,pw##k)
  #define VFR(i) (bf16x8){vlo[i][0],vlo[i][1],vlo[i][2],vlo[i][3],vhi[i][0],vhi[i][1],vhi[i][2],vhi[i][3]}
  #define PIN(x) asm volatile("":"+v"(x))
  #define MX3(a,b,c) __builtin_fmaxf(__builtin_fmaxf((a),(b)),(c))
  #define GAPA(MF,A0,A1,A2,A3,W0,W1,PW) do{ MF; sacc+=A0; sacc+=A1; sacc+=A2; sacc+=A3; PIN(sacc); W0; W1; PIN(PW); SBAR(); }while(0)
  #define EX(v) __builtin_amdgcn_exp2f(v)
  #define GAPB(MF,X,B) do{ MF; X[B]=EX(X[B]); X[B+1]=EX(X[B+1]); X[B+2]=EX(X[B+2]); X[B+3]=EX(X[B+3]); PIN(X); SBAR(); }while(0)
  #define VRD(i) do{ vlo[i]=vtr(vp_+(((i)>>2)*4096+((i)&3)*1024)); vhi[i]=vtr(vp_+(((i)>>2)*4096+((i)&3)*1024+512)); }while(0)
  #define KRD(G,j) do{ if(G){ kload2(kf,kp0+sl_next,j); SBAR(); } }while(0)
  #define STEP(C0,C1,P0,P1,t,GK,GV,GL) do{ SBAR(); \
    const lds_cptr vp_=vp0+sl_prev; \
    VRD(0); SBAR(); float sacc=(P0[0]+P0[1]); \
    GAPA(C0=__builtin_amdgcn_mfma_f32_32x32x16_bf16(kf[0],qr[0],negm,0,0,0), P0[2],P0[3],P0[4],P0[5],     pw0[0]=PKW(P0,0), pw0[1]=PKW(P0,2), pw0); \
    VRD(4); SBAR(); GAPA(C1=__builtin_amdgcn_mfma_f32_32x32x16_bf16(kf[1],qr[0],negm,0,0,0), P0[6],P0[7],P0[8],P0[9],     pw0[2]=PKW(P0,4), pw0[3]=PKW(P0,6), pw0); \
    VRD(1); SBAR(); GAPA(C0=__builtin_amdgcn_mfma_f32_32x32x16_bf16(kf[2],qr[1],C0,0,0,0),   P0[10],P0[11],P0[12],P0[13], pw1[0]=PKW(P0,8), pw1[1]=PKW(P0,10), pw1); \
    VRD(5); SBAR(); GAPA(C1=__builtin_amdgcn_mfma_f32_32x32x16_bf16(kf[3],qr[1],C1,0,0,0),   P0[14],P0[15],P1[0],P1[1],   pw1[2]=PKW(P0,12),pw1[3]=PKW(P0,14), pw1); \
    VRD(2); SBAR(); GAPA(C0=__builtin_amdgcn_mfma_f32_32x32x16_bf16(kf[4],qr[2],C0,0,0,0),   P1[2],P1[3],P1[4],P1[5],     pw2[0]=PKW(P1,0), pw2[1]=PKW(P1,2), pw2); \
    VRD(6); SBAR(); GAPA(C1=__builtin_amdgcn_mfma_f32_32x32x16_bf16(kf[5],qr[2],C1,0,0,0),   P1[6],P1[7],P1[8],P1[9],     pw2[2]=PKW(P1,4), pw2[3]=PKW(P1,6), pw2); \
    VRD(3); SBAR(); GAPA(C0=__builtin_amdgcn_mfma_f32_32x32x16_bf16(kf[6],qr[3],C0,0,0,0),   P1[10],P1[11],P1[12],P1[13], pw3[0]=PKW(P1,8), pw3[1]=PKW(P1,10), pw3); \
    VRD(7); SBAR(); GAPA(C1=__builtin_amdgcn_mfma_f32_32x32x16_bf16(kf[7],qr[3],C1,0,0,0),   P1[14],P1[15],0.f,0.f,       pw3[2]=PKW(P1,12),pw3[3]=PKW(P1,14), pw3); \
    l_reg+=sacc; \
    if(GK){DMA_K((t)+3,sl_cur);} if(GV){DMA_V((t)+1,sl_next);} \
    CMASK(C0,C1,t); \
    { float a=MX3(C0[0],C0[1],C1[0]),b=MX3(C0[2],C0[3],C1[1]); a=MX3(a,C1[2],C1[3]); \
      _Pragma("unroll") for(int r=4;r<16;r+=4){a=MX3(a,C0[r],C0[r+1]);b=MX3(b,C0[r+2],C0[r+3]);a=MX3(a,C1[r],C1[r+1]);b=MX3(b,C1[r+2],C1[r+3]);} \
      float rm=__builtin_fmaxf(a,b); { auto rr=__builtin_amdgcn_permlane32_swap(__float_as_uint(rm),__float_as_uint(rm),false,false); rm=__builtin_fmaxf(__uint_as_float(rr[0]),__uint_as_float(rr[1])); } \
      resc=false; \
      if(__builtin_expect(__any(rm>(float)THRL),0)){ const float dl=__builtin_fmaxf(rm,0.f); mhat+=dl; \
        _Pragma("unroll") for(int r=0;r<16;++r){C0[r]-=dl;C1[r]-=dl;} \
        _Pragma("unroll") for(int r=0;r<16;++r)negm[r]=-mhat; asm volatile("":"+v"(negm)); \
        const float f=__builtin_amdgcn_exp2f(-dl); l_reg*=f; if(hi==0)wsf[r32]=f; resc=true; } } \
    SBAR(); \
    GAPB(o[0]=__builtin_amdgcn_mfma_f32_32x32x16_bf16(PAF(0),VFR(0),o[0],0,0,0), C0,0); \
    GAPB(o[1]=__builtin_amdgcn_mfma_f32_32x32x16_bf16(PAF(0),VFR(4),o[1],0,0,0), C0,4); \
    KRD(GL,0); GAPB(o[0]=__builtin_amdgcn_mfma_f32_32x32x16_bf16(PAF(1),VFR(1),o[0],0,0,0), C0,8); \
    KRD(GL,1); GAPB(o[1]=__builtin_amdgcn_mfma_f32_32x32x16_bf16(PAF(1),VFR(5),o[1],0,0,0), C0,12); \
    KRD(GL,2); GAPB(o[0]=__builtin_amdgcn_mfma_f32_32x32x16_bf16(PAF(2),VFR(2),o[0],0,0,0), C1,0); \
    KRD(GL,3); GAPB(o[1]=__builtin_amdgcn_mfma_f32_32x32x16_bf16(PAF(2),VFR(6),o[1],0,0,0), C1,4); \
    GAPB(o[0]=__builtin_amdgcn_mfma_f32_32x32x16_bf16(PAF(3),VFR(3),o[0],0,0,0), C1,8); \
    GAPB(o[1]=__builtin_amdgcn_mfma_f32_32x32x16_bf16(PAF(3),VFR(7),o[1],0,0,0), C1,12); \
    }while(0)
  int t=1;
  #undef CMASK
  #define CMASK(P0,P1,t) do{}while(0)
  if constexpr(MODE==0)
  for(;t+5<NT;t+=2){
    STEP(pB0,pB1,pA0,pA1,t,true,true,true);     WAIT_BAR(2); RESC(); ROT();
    STEP(pA0,pA1,pB0,pB1,t+1,true,true,true);   WAIT_BAR(2); RESC(); ROT();
  }
  #undef CMASK
  #define CMASK(P0,P1,t) do{ if(MODE==1) wmask(P0,P1,(t),kbase,qabs,hi); }while(0)
  #define ENDW(tt) do{ if((tt)+3<NT){WAIT_BAR(2);} else if((tt)+2<NT){WAIT_BAR(1);} else {WAIT_BAR(0);} }while(0)
  for(;t+1<NT;t+=2){
    STEP(pB0,pB1,pA0,pA1,t,(t+3<NT),(t+1<NT),(t+1<NT));       ENDW(t);   RESC(); ROT();
    STEP(pA0,pA1,pB0,pB1,t+1,(t+4<NT),(t+2<NT),(t+2<NT));     ENDW(t+1); RESC(); ROT();
  }
  STEP(pB0,pB1,pA0,pA1,NT-1,false,false,false); RESC();
  { float sacc=pB0[0]+pB0[1]; _Pragma("unroll") for(int r=2;r<16;++r)sacc+=pB0[r]; _Pragma("unroll") for(int r=0;r<16;++r)sacc+=pB1[r]; l_reg+=sacc;
    pw0=(u32x4){PKW(pB0,0),PKW(pB0,2),PKW(pB0,4),PKW(pB0,6)};pw1=(u32x4){PKW(pB0,8),PKW(pB0,10),PKW(pB0,12),PKW(pB0,14)};pw2=(u32x4){PKW(pB1,0),PKW(pB1,2),PKW(pB1,4),PKW(pB1,6)};pw3=(u32x4){PKW(pB1,8),PKW(pB1,10),PKW(pB1,12),PKW(pB1,14)};
    SBAR(); pv(o,vb0+sl_cur,PAF(0),PAF(1),PAF(2),PAF(3)); }
  #undef PKW
  #undef PAF
  #undef VFR
  #undef PIN
  #undef MX3
  #undef GAPA
  #undef GAPB
  #undef EX
  #undef VRD
  #undef KRD
  #undef STEP
  #undef ENDW
  {auto rr=__builtin_amdgcn_permlane32_swap(__float_as_uint(l_reg),__float_as_uint(l_reg),false,false);l_reg=__uint_as_float(rr[0])+__uint_as_float(rr[1]);}
  if(MODE==1)l_reg+=__builtin_amdgcn_exp2f(sink_l2-mhat);
  if(hi==0)wsf[32+r32]=l_reg;asm volatile("s_waitcnt lgkmcnt(0)":::"memory");
  float rli[16];
  #pragma unroll
  for(int r=0;r<16;++r)rli[r]=__builtin_amdgcn_rcpf(wsf[32+crow(r,hi)]);
  bf16*Ow=O+(long)(q0+wid*QBLK)*QP+h*D;
  { bf16*stg=(bf16*)(shm+LDS_OST)+wid*2048;
    #pragma unroll
    for(int r=0;r<16;++r){const int orow=crow(r,hi);
      #pragma unroll
      for(int d0=0;d0<2;++d0)stg[orow*64+d0*32+r32]=__float2bfloat16(o[d0][r]*rli[r]);}
    asm volatile("s_waitcnt lgkmcnt(0)":::"memory");
    #pragma unroll
    for(int i=0;i<4;++i){const int row=i*8+(lane>>3),ch=lane&7; const u32x4 v=*(const u32x4*)(stg+row*64+ch*8); ATTN_STORE16(Ow+(long)row*QP+ch*8,v);} }
  asm volatile("s_waitcnt lgkmcnt(0)\n\ts_barrier":::"memory");
  #undef DMA_K
  #undef DMA_V
  #undef CMASK
  #undef TROW
  #undef START
  #undef RESC
  #undef ROT
}
template<int KP> __device__ __forceinline__ void attn_unit_s(int h,int kvh,int q0,int NT,int kbase,float mstat,const bf16*Q,const bf16*__restrict__ K,const bf16*__restrict__ V,bf16*O,char*shm){
  int tid_=threadIdx.x; asm volatile("":"+v"(tid_)); const int tid=tid_,lane=tid&63,r32=lane&31,hi=lane>>5; const int wid=__builtin_amdgcn_readfirstlane(tid>>6);
  #define TROW(t) (kbase+64*(t))
  const bf16*Qw=Q+(long)(q0+wid*QBLK)*QP+h*D;
  const bf16*Kh=K+kvh*D,*Vh=V+kvh*D;
  const unsigned lds0=(unsigned)(uintptr_t)shm;
  float*wsf=(float*)(shm+LDS_WS)+wid*64;
  const bf16*ksrc=Kh+(long)lane*KP+wid*8;
  const bf16*vsrc=Vh+(long)(16*(wid&3)+(lane>>2))*KP+(wid>>2)*32+(lane&3)*8;
  const unsigned kdst=lds0+LDS_K+wid*1024, vdst=lds0+LDS_V+wid*1024;
  #define DMA_K(t,slot) glds16(ksrc+(long)TROW(t)*KP,(unsigned)__builtin_amdgcn_readfirstlane(kdst+(slot)))
  #define DMA_V(t,slot) glds16(vsrc+(long)TROW(t)*KP,(unsigned)__builtin_amdgcn_readfirstlane(vdst+(slot)))
  const int vb0=(int)(lds0+LDS_V)+((lane>>4)&1)*32+(lane&3)*8+(4*hi+((lane&15)>>2))*64;
  const char*Kbase=shm+LDS_K; bf16x8 kf[8];
  const lds_cptr shm3=(lds_cptr)shm; const lds_cptr kp0=shm3+LDS_K+hi*1024+r32*16; const lds_cptr vp0=shm3+LDS_V+((lane>>4)&1)*32+(lane&3)*8+(4*hi+((lane&15)>>2))*64;
  DMA_K(0,0);DMA_V(0,0);DMA_K(1,SLOTB);
  bf16x8 qr[4];
  #pragma unroll
  for(int d0=0;d0<4;++d0)qr[d0]=*reinterpret_cast<const bf16x8*>(&Qw[(long)r32*QP+d0*16+hi*8]);
  float l_reg=0.f;f32x16 o[2];o[0]=f32x16{};o[1]=f32x16{};f32x16 negm;
  #pragma unroll
  for(int r=0;r<16;++r)negm[r]=-mstat;
  asm volatile("":"+v"(negm));
  #define CMASK(P0,P1,t) do{}while(0)
  #define START(P0,P1) do{ _Pragma("unroll") for(int r=0;r<16;++r)P0[r]=__builtin_amdgcn_exp2f(P0[r]); }while(0)
  #define RESC() do{}while(0)
  f32x16 pA0,pA1,pB0,pB1;
  int sl_prev=0,sl_cur=0,sl_next=SLOTB;
  #define ROT() do{sl_prev=sl_cur;sl_cur=sl_next;sl_next=(sl_next==(NSLOT-1)*SLOTB)?0:sl_next+SLOTB;}while(0)
  DMA_K(2,2*SLOTB);
  WAIT_BAR(3);
  qkt(pA0,pA1,Kbase,qr,negm,r32,hi);asm volatile("s_nop 15\n\ts_nop 7":"+v"(pA0),"+v"(pA1));CMASK(pA0,pA1,0);
  START(pA0,pA1);
  _Pragma("unroll") for(int r=0;r<16;++r)pA1[r]=__builtin_amdgcn_exp2f(pA1[r]);
  WAIT_BAR(0);
  DMA_K(3,0);DMA_V(1,SLOTB);
  ROT();
  kload8(kf,kp0+sl_cur);
  WAIT_BAR(2);
  s16x4 vlo[8],vhi[8]; u32x4 pw0,pw1,pw2,pw3;
  #define PKW(P,B) cvtpk_s(P[B],P[B+1])
  #define PAF(k) __builtin_bit_cast(bf16x8,pw##k)
  #define VFR(i) (bf16x8){vlo[i][0],vlo[i][1],vlo[i][2],vlo[i][3],vhi[i][0],vhi[i][1],vhi[i][2],vhi[i][3]}
  #define PIN(x) asm volatile("":"+v"(x))
  #define MX3(a,b,c) __builtin_fmaxf(__builtin_fmaxf((a),(b)),(c))
  #define GAPA(MF,A0,A1,A2,A3,W0,W1,PW) do{ MF; sacc+=A0; sacc+=A1; sacc+=A2; sacc+=A3; PIN(sacc); W0; W1; PIN(PW); SBAR(); }while(0)
  #define EX(v) __builtin_amdgcn_exp2f(v)
  #define GAPB(MF,X,B) do{ MF; X[B]=EX(X[B]); X[B+1]=EX(X[B+1]); X[B+2]=EX(X[B+2]); X[B+3]=EX(X[B+3]); PIN(X); SBAR(); }while(0)
  #define VRD(i) do{ vlo[i]=vtr(vp_+(((i)>>2)*4096+((i)&3)*1024)); vhi[i]=vtr(vp_+(((i)>>2)*4096+((i)&3)*1024+512)); }while(0)
  #define KRD(G,j) do{ if(G){ kload2(kf,kp0+sl_next,j); SBAR(); } }while(0)
  #define STEP(C0,C1,P0,P1,t,GK,GV,GL) do{ SBAR(); \
    const lds_cptr vp_=vp0+sl_prev; \
    VRD(0); SBAR(); float sacc=(P0[0]+P0[1]); \
    GAPA(C0=__builtin_amdgcn_mfma_f32_32x32x16_bf16(kf[0],qr[0],negm,0,0,0), P0[2],P0[3],P0[4],P0[5],     pw0[0]=PKW(P0,0), pw0[1]=PKW(P0,2), pw0); \
    VRD(4); SBAR(); GAPA(C1=__builtin_amdgcn_mfma_f32_32x32x16_bf16(kf[1],qr[0],negm,0,0,0), P0[6],P0[7],P0[8],P0[9],     pw0[2]=PKW(P0,4), pw0[3]=PKW(P0,6), pw0); \
    VRD(1); SBAR(); GAPA(C0=__builtin_amdgcn_mfma_f32_32x32x16_bf16(kf[2],qr[1],C0,0,0,0),   P0[10],P0[11],P0[12],P0[13], pw1[0]=PKW(P0,8), pw1[1]=PKW(P0,10), pw1); \
    VRD(5); SBAR(); GAPA(C1=__builtin_amdgcn_mfma_f32_32x32x16_bf16(kf[3],qr[1],C1,0,0,0),   P0[14],P0[15],P1[0],P1[1],   pw1[2]=PKW(P0,12),pw1[3]=PKW(P0,14), pw1); \
    VRD(2); SBAR(); GAPA(C0=__builtin_amdgcn_mfma_f32_32x32x16_bf16(kf[4],qr[2],C0,0,0,0),   P1[2],P1[3],P1[4],P1[5],     pw2[0]=PKW(P1,0), pw2[1]=PKW(P1,2), pw2); \
    VRD(6); SBAR(); GAPA(C1=__builtin_amdgcn_mfma_f32_32x32x16_bf16(kf[5],qr[2],C1,0,0,0),   P1[6],P1[7],P1[8],P1[9],     pw2[2]=PKW(P1,4), pw2[3]=PKW(P1,6), pw2); \
    VRD(3); SBAR(); GAPA(C0=__builtin_amdgcn_mfma_f32_32x32x16_bf16(kf[6],qr[3],C0,0,0,0),   P1[10],P1[11],P1[12],P1[13], pw3[0]=PKW(P1,8), pw3[1]=PKW(P1,10), pw3); \
    VRD(7); SBAR(); GAPA(C1=__builtin_amdgcn_mfma_f32_32x32x16_bf16(kf[7],qr[3],C1,0,0,0),   P1[14],P1[15],0.f,0.f,       pw3[2]=PKW(P1,12),pw3[3]=PKW(P1,14), pw3); \
    l_reg+=sacc; \
    if(GK){DMA_K((t)+3,sl_cur);} if(GV){DMA_V((t)+1,sl_next);} \
    SBAR(); \
    GAPB(o[0]=__builtin_amdgcn_mfma_f32_32x32x16_bf16(PAF(0),VFR(0),o[0],0,0,0), C0,0); \
    GAPB(o[1]=__builtin_amdgcn_mfma_f32_32x32x16_bf16(PAF(0),VFR(4),o[1],0,0,0), C0,4); \
    KRD(GL,0); GAPB(o[0]=__builtin_amdgcn_mfma_f32_32x32x16_bf16(PAF(1),VFR(1),o[0],0,0,0), C0,8); \
    KRD(GL,1); GAPB(o[1]=__builtin_amdgcn_mfma_f32_32x32x16_bf16(PAF(1),VFR(5),o[1],0,0,0), C0,12); \
    KRD(GL,2); GAPB(o[0]=__builtin_amdgcn_mfma_f32_32x32x16_bf16(PAF(2),VFR(2),o[0],0,0,0), C1,0); \
    KRD(GL,3); GAPB(o[1]=__builtin_amdgcn_mfma_f32_32x32x16_bf16(PAF(2),VFR(6),o[1],0,0,0), C1,4); \
    GAPB(o[0]=__builtin_amdgcn_mfma_f32_32x32x16_bf16(PAF(3),VFR(3),o[0],0,0,0), C1,8); \
    GAPB(o[1]=__builtin_amdgcn_mfma_f32_32x32x16_bf16(PAF(3),VFR(7),o[1],0,0,0), C1,12); \
    }while(0)
  int t=1;
  #undef CMASK
  #define CMASK(P0,P1,t) do{}while(0)
  for(;t+5<NT;t+=2){
    STEP(pB0,pB1,pA0,pA1,t,true,true,true);     WAIT_BAR(2); RESC(); ROT();
    STEP(pA0,pA1,pB0,pB1,t+1,true,true,true);   WAIT_BAR(2); RESC(); ROT();
  }
  #undef CMASK
  #define CMASK(P0,P1,t) do{}while(0)
  #define ENDW(tt) do{ if((tt)+3<NT){WAIT_BAR(2);} else if((tt)+2<NT){WAIT_BAR(1);} else {WAIT_BAR(0);} }while(0)
  for(;t+1<NT;t+=2){
    STEP(pB0,pB1,pA0,pA1,t,(t+3<NT),(t+1<NT),(t+1<NT));       ENDW(t);   RESC(); ROT();
    STEP(pA0,pA1,pB0,pB1,t+1,(t+4<NT),(t+2<NT),(t+2<NT));     ENDW(t+1); RESC(); ROT();
  }
  STEP(pB0,pB1,pA0,pA1,NT-1,false,false,false); RESC();
  { float sacc=pB0[0]+pB0[1]; _Pragma("unroll") for(int r=2;r<16;++r)sacc+=pB0[r]; _Pragma("unroll") for(int r=0;r<16;++r)sacc+=pB1[r]; l_reg+=sacc;
    pw0=(u32x4){PKW(pB0,0),PKW(pB0,2),PKW(pB0,4),PKW(pB0,6)};pw1=(u32x4){PKW(pB0,8),PKW(pB0,10),PKW(pB0,12),PKW(pB0,14)};pw2=(u32x4){PKW(pB1,0),PKW(pB1,2),PKW(pB1,4),PKW(pB1,6)};pw3=(u32x4){PKW(pB1,8),PKW(pB1,10),PKW(pB1,12),PKW(pB1,14)};
    SBAR(); pv(o,vb0+sl_cur,PAF(0),PAF(1),PAF(2),PAF(3)); }
  #undef PKW
  #undef PAF
  #undef VFR
  #undef PIN
  #undef MX3
  #undef GAPA
  #undef GAPB
  #undef EX
  #undef VRD
  #undef KRD
  #undef STEP
  #undef ENDW
  {auto rr=__builtin_amdgcn_permlane32_swap(__float_as_uint(l_reg),__float_as_uint(l_reg),false,false);l_reg=__uint_as_float(rr[0])+__uint_as_float(rr[1]);}
  if(hi==0)wsf[32+r32]=l_reg;asm volatile("s_waitcnt lgkmcnt(0)":::"memory");
  float rli[16];
  #pragma unroll
  for(int r=0;r<16;++r)rli[r]=__builtin_amdgcn_rcpf(wsf[32+crow(r,hi)]);
  bf16*Ow=O+(long)(q0+wid*QBLK)*QP+h*D;
  { bf16*stg=(bf16*)(shm+LDS_OST)+wid*2048;
    #pragma unroll
    for(int r=0;r<16;++r){const int orow=crow(r,hi);
      #pragma unroll
      for(int d0=0;d0<2;++d0)stg[orow*64+d0*32+r32]=__float2bfloat16(o[d0][r]*rli[r]);}
    asm volatile("s_waitcnt lgkmcnt(0)":::"memory");
    #pragma unroll
    for(int i=0;i<4;++i){const int row=i*8+(lane>>3),ch=lane&7; const u32x4 v=*(const u32x4*)(stg+row*64+ch*8); ATTN_STORE16(Ow+(long)row*QP+ch*8,v);} }
  asm volatile("s_waitcnt lgkmcnt(0)\n\ts_barrier":::"memory");
  #undef DMA_K
  #undef DMA_V
  #undef CMASK
  #undef TROW
  #undef START
  #undef RESC
  #undef ROT
}
template<int KP> __device__ __forceinline__ void attn_unit_q8(int h,int kvh,int q0,int NT,int kbase,float mstat,const unsigned char*Q8,const unsigned char*__restrict__ K8,const bf16*__restrict__ V,bf16*O,char*shm){
  int tid_=threadIdx.x; asm volatile("":"+v"(tid_)); const int tid=tid_,lane=tid&63,r32=lane&31,hi=lane>>5; const int wid=__builtin_amdgcn_readfirstlane(tid>>6);
  #define TROW(t) (kbase+64*(t))
  const unsigned char*Qw=Q8+(long)(q0+wid*QBLK)*QP+h*D;
  const unsigned char*Kh=K8+kvh*D; const bf16*Vh=V+kvh*D;
  const unsigned lds0=(unsigned)(uintptr_t)shm;
  float*wsf=(float*)(shm+LDS_WS)+wid*64;
  const unsigned char*ksrc=Kh+(long)lane*KP+(wid&3)*16;
  const bf16*vsrc=Vh+(long)(16*(wid&3)+(lane>>2))*KP+(wid>>2)*32+(lane&3)*8;
  const unsigned kdst=lds0+LDS_K+(wid&3)*1024, vdst=lds0+LDS_V+wid*1024;
  #define DMA_K(t,slot) glds16(ksrc+(long)TROW(t)*KP,(unsigned)__builtin_amdgcn_readfirstlane(kdst+(slot)))
  #define DMA_V(t,slot) glds16(vsrc+(long)TROW(t)*KP,(unsigned)__builtin_amdgcn_readfirstlane(vdst+(slot)))
  const int vb0=(int)(lds0+LDS_V)+((lane>>4)&1)*32+(lane&3)*8+(4*hi+((lane&15)>>2))*64;
  typedef int v8i_t __attribute__((ext_vector_type(8))); typedef int v4i_t __attribute__((ext_vector_type(4))); typedef __attribute__((address_space(3))) const v4i_t* lds_v4p;
  v8i_t kf8[2];
  const int f8sc=0x7F7F7F7F;
  const lds_cptr shm3=(lds_cptr)shm; const lds_cptr kp0=shm3+LDS_K+hi*2048+r32*16; const lds_cptr vp0=shm3+LDS_V+((lane>>4)&1)*32+(lane&3)*8+(4*hi+((lane&15)>>2))*64;
  DMA_K(0,0);DMA_V(0,0);DMA_K(1,SLOTB);
  v8i_t q8; { const v4i_t qa=*reinterpret_cast<const v4i_t*>(Qw+(long)r32*QP+32*hi), qb=*reinterpret_cast<const v4i_t*>(Qw+(long)r32*QP+32*hi+16); q8=__builtin_shufflevector(qa,qb,0,1,2,3,4,5,6,7); }
  #define KLD(j,kp) do{ const v4i_t a_=*(lds_v4p)((kp)+(j)*512), b_=*(lds_v4p)((kp)+(j)*512+1024); kf8[j]=__builtin_shufflevector(a_,b_,0,1,2,3,4,5,6,7); }while(0)
  #define QKMF(C,j) asm volatile("v_mfma_scale_f32_32x32x64_f8f6f4 %0, %1, %2, %3, %4, %4 op_sel_hi:[0,0,0]":"=&v"(C):"v"(kf8[j]),"v"(q8),"v"(negm),"v"(f8sc))
  float l_reg=0.f;f32x16 o[2];o[0]=f32x16{};o[1]=f32x16{};f32x16 negm;
  #pragma unroll
  for(int r=0;r<16;++r)negm[r]=-mstat;
  asm volatile("":"+v"(negm));
  #define CMASK(P0,P1,t) do{}while(0)
  #define START(P0,P1) do{ _Pragma("unroll") for(int r=0;r<16;++r)P0[r]=__builtin_amdgcn_exp2f(P0[r]); }while(0)
  #define RESC() do{}while(0)
  f32x16 pA0,pA1,pB0,pB1;
  int sl_prev=0,sl_cur=0,sl_next=SLOTB;
  #define ROT() do{sl_prev=sl_cur;sl_cur=sl_next;sl_next=(sl_next==(NSLOT-1)*SLOTB)?0:sl_next+SLOTB;}while(0)
  DMA_K(2,2*SLOTB);
  WAIT_BAR(3);
  KLD(0,kp0);KLD(1,kp0);QKMF(pA0,0);QKMF(pA1,1);asm volatile("s_nop 15\n\ts_nop 15\n\ts_nop 15\n\ts_nop 15\n\ts_nop 15":"+v"(pA0),"+v"(pA1));
  START(pA0,pA1);
  _Pragma("unroll") for(int r=0;r<16;++r)pA1[r]=__builtin_amdgcn_exp2f(pA1[r]);
  WAIT_BAR(0);
  DMA_K(3,0);DMA_V(1,SLOTB);
  ROT();
  KLD(0,kp0+sl_cur);KLD(1,kp0+sl_cur);
  WAIT_BAR(2);
  s16x4 vlo[8],vhi[8]; u32x4 pw0,pw1,pw2,pw3;
  #define PKW(P,B) cvtpk_s(P[B],P[B+1])
  #define PAF(k) __builtin_bit_cast(bf16x8,pw##k)
  #define VFR(i) (bf16x8){vlo[i][0],vlo[i][1],vlo[i][2],vlo[i][3],vhi[i][0],vhi[i][1],vhi[i][2],vhi[i][3]}
  #define PIN(x) asm volatile("":"+v"(x))
  #define MX3(a,b,c) __builtin_fmaxf(__builtin_fmaxf((a),(b)),(c))
  #define GAPA(MF,A0,A1,A2,A3,W0,W1,PW) do{ MF; sacc+=A0; sacc+=A1; sacc+=A2; sacc+=A3; PIN(sacc); W0; W1; PIN(PW); SBAR(); }while(0)
  #define EX(v) __builtin_amdgcn_exp2f(v)
  #define GAPB(MF,X,B) do{ MF; X[B]=EX(X[B]); X[B+1]=EX(X[B+1]); X[B+2]=EX(X[B+2]); X[B+3]=EX(X[B+3]); PIN(X); SBAR(); }while(0)
  #define VRD(i) do{ vlo[i]=vtr(vp_+(((i)>>2)*4096+((i)&3)*1024)); vhi[i]=vtr(vp_+(((i)>>2)*4096+((i)&3)*1024+512)); }while(0)
  #define KRD(G,j) do{ if((G)&&(j)<2){ KLD(j,kp0+sl_next); SBAR(); } }while(0)
  #define STEP(C0,C1,P0,P1,t,GK,GV,GL) do{ SBAR(); \
    const lds_cptr vp_=vp0+sl_prev; \
    VRD(0); SBAR(); float sacc=(P0[0]+P0[1]); \
    GAPA(QKMF(C0,0), P0[2],P0[3],P0[4],P0[5],     pw0[0]=PKW(P0,0), pw0[1]=PKW(P0,2), pw0); \
    VRD(4); SBAR(); GAPA(QKMF(C1,1), P0[6],P0[7],P0[8],P0[9],     pw0[2]=PKW(P0,4), pw0[3]=PKW(P0,6), pw0); \
    VRD(1); SBAR(); GAPA((void)0, P0[10],P0[11],P0[12],P0[13], pw1[0]=PKW(P0,8), pw1[1]=PKW(P0,10), pw1); \
    VRD(5); SBAR(); GAPA((void)0, P0[14],P0[15],P1[0],P1[1],   pw1[2]=PKW(P0,12),pw1[3]=PKW(P0,14), pw1); \
    VRD(2); SBAR(); GAPA((void)0, P1[2],P1[3],P1[4],P1[5],     pw2[0]=PKW(P1,0), pw2[1]=PKW(P1,2), pw2); \
    VRD(6); SBAR(); GAPA((void)0, P1[6],P1[7],P1[8],P1[9],     pw2[2]=PKW(P1,4), pw2[3]=PKW(P1,6), pw2); \
    VRD(3); SBAR(); GAPA((void)0, P1[10],P1[11],P1[12],P1[13], pw3[0]=PKW(P1,8), pw3[1]=PKW(P1,10), pw3); \
    VRD(7); SBAR(); GAPA((void)0, P1[14],P1[15],0.f,0.f,       pw3[2]=PKW(P1,12),pw3[3]=PKW(P1,14), pw3); \
    l_reg+=sacc; \
    if(GK){DMA_K((t)+3,sl_cur);} if(GV){DMA_V((t)+1,sl_next);} \
    SBAR(); \
    GAPB(o[0]=__builtin_amdgcn_mfma_f32_32x32x16_bf16(PAF(0),VFR(0),o[0],0,0,0), C0,0); \
    GAPB(o[1]=__builtin_amdgcn_mfma_f32_32x32x16_bf16(PAF(0),VFR(4),o[1],0,0,0), C0,4); \
    KRD(GL,0); GAPB(o[0]=__builtin_amdgcn_mfma_f32_32x32x16_bf16(PAF(1),VFR(1),o[0],0,0,0), C0,8); \
    KRD(GL,1); GAPB(o[1]=__builtin_amdgcn_mfma_f32_32x32x16_bf16(PAF(1),VFR(5),o[1],0,0,0), C0,12); \
    KRD(GL,2); GAPB(o[0]=__builtin_amdgcn_mfma_f32_32x32x16_bf16(PAF(2),VFR(2),o[0],0,0,0), C1,0); \
    KRD(GL,3); GAPB(o[1]=__builtin_amdgcn_mfma_f32_32x32x16_bf16(PAF(2),VFR(6),o[1],0,0,0), C1,4); \
    GAPB(o[0]=__builtin_amdgcn_mfma_f32_32x32x16_bf16(PAF(3),VFR(3),o[0],0,0,0), C1,8); \
    GAPB(o[1]=__builtin_amdgcn_mfma_f32_32x32x16_bf16(PAF(3),VFR(7),o[1],0,0,0), C1,12); \
    }while(0)
  int t=1;
  #undef CMASK
  #define CMASK(P0,P1,t) do{}while(0)
  for(;t+5<NT;t+=2){
    STEP(pB0,pB1,pA0,pA1,t,true,true,true);     WAIT_BAR(2); RESC(); ROT();
    STEP(pA0,pA1,pB0,pB1,t+1,true,true,true);   WAIT_BAR(2); RESC(); ROT();
  }
  #undef CMASK
  #define CMASK(P0,P1,t) do{}while(0)
  #define ENDW(tt) do{ if((tt)+3<NT){WAIT_BAR(2);} else if((tt)+2<NT){WAIT_BAR(1);} else {WAIT_BAR(0);} }while(0)
  for(;t+1<NT;t+=2){
    STEP(pB0,pB1,pA0,pA1,t,(t+3<NT),(t+1<NT),(t+1<NT));       ENDW(t);   RESC(); ROT();
    STEP(pA0,pA1,pB0,pB1,t+1,(t+4<NT),(t+2<NT),(t+2<NT));     ENDW(t+1); RESC(); ROT();
  }
  STEP(pB0,pB1,pA0,pA1,NT-1,false,false,false); RESC();
  { float sacc=pB0[0]+pB0[1]; _Pragma("unroll") for(int r=2;r<16;++r)sacc+=pB0[r]; _Pragma("unroll") for(int r=0;r<16;++r)sacc+=pB1[r]; l_reg+=sacc;
    pw0=(u32x4){PKW(pB0,0),PKW(pB0,2),PKW(pB0,4),PKW(pB0,6)};pw1=(u32x4){PKW(pB0,8),PKW(pB0,10),PKW(pB0,12),PKW(pB0,14)};pw2=(u32x4){PKW(pB1,0),PKW(pB1,2),PKW(pB1,4),PKW(pB1,6)};pw3=(u32x4){PKW(pB1,8),PKW(pB1,10),PKW(pB1,12),PKW(pB1,14)};
    SBAR(); pv(o,vb0+sl_cur,PAF(0),PAF(1),PAF(2),PAF(3)); }
  #undef PKW
  #undef PAF
  #undef VFR
  #undef PIN
  #undef MX3
  #undef GAPA
  #undef GAPB
  #undef EX
  #undef VRD
  #undef KRD
  #undef KLD
  #undef QKMF
  #undef STEP
  #undef ENDW
  {auto rr=__builtin_amdgcn_permlane32_swap(__float_as_uint(l_reg),__float_as_uint(l_reg),false,false);l_reg=__uint_as_float(rr[0])+__uint_as_float(rr[1]);}
  if(hi==0)wsf[32+r32]=l_reg;asm volatile("s_waitcnt lgkmcnt(0)":::"memory");
  float rli[16];
  #pragma unroll
  for(int r=0;r<16;++r)rli[r]=__builtin_amdgcn_rcpf(wsf[32+crow(r,hi)]);
  bf16*Ow=O+(long)(q0+wid*QBLK)*QP+h*D;
  { bf16*stg=(bf16*)(shm+LDS_OST)+wid*2048;
    #pragma unroll
    for(int r=0;r<16;++r){const int orow=crow(r,hi);
      #pragma unroll
      for(int d0=0;d0<2;++d0)stg[orow*64+d0*32+r32]=__float2bfloat16(o[d0][r]*rli[r]);}
    asm volatile("s_waitcnt lgkmcnt(0)":::"memory");
    #pragma unroll
    for(int i=0;i<4;++i){const int row=i*8+(lane>>3),ch=lane&7; const u32x4 v=*(const u32x4*)(stg+row*64+ch*8); ATTN_STORE16(Ow+(long)row*QP+ch*8,v);} }
  asm volatile("s_waitcnt lgkmcnt(0)\n\ts_barrier":::"memory");
  #undef DMA_K
  #undef DMA_V
  #undef CMASK
  #undef TROW
  #undef START
  #undef RESC
  #undef ROT
}
constexpr int ATTN_LDS_BYTES=LDS_BYTES;
#undef SBAR
#undef WAIT_BAR
}
#ifndef EN_MIX
#define EN_MIX 15
#endif
#ifndef EN_MOE
#define EN_MOE 15
#endif
constexpr int NWAVES = 8, NTHR = 512;
constexpr int DM = 1024, NLAT = 16384, NCTX = 256, T = NLAT + NCTX, NPAN = T / 256;
constexpr int NE = 32, TOPK = 4, EFF = 1024;
constexpr int FA_NQKV = 1536, WA_NQKV = 1280, GM_FF = 4096, GM_HALF = 2048;
constexpr float LN_EPS = 1e-5f, RMS_EPS = 1e-6f;
constexpr float DN_ALPHA = 1.6817928305074292f;
constexpr float LOG2E = 1.4426950408889634f, QSCALE = 0.125f * LOG2E;
constexpr int NPHASE = 35;

constexpr size_t MiB = 1u << 20;
constexpr size_t WS_CTL = 0, CTL_ZERO_BYTES = 64 * 1024;
constexpr size_t WS_MOD = 1 * MiB;
constexpr size_t WS_TAB = 2 * MiB;
constexpr size_t TB_FC = WS_TAB, TB_FA = TB_FC + 512 * 256 * 2, TB_FCC = TB_FA + 256 * 256 * 2, TB_FX = TB_FCC + 256 * 256 * 2, TB_TWC = TB_FX + 256 * 512 * 2,
                 TB_TWS = TB_TWC + 128 * 128 * 4, TB_ROPC = TB_TWS + 128 * 128 * 4, TB_ROPS = TB_ROPC + (size_t)NLAT * 32 * 4, TB_END = TB_ROPS + (size_t)NLAT * 32 * 4;
static_assert(TB_END <= 10 * MiB, "tables");
constexpr size_t WS_RW = 10 * MiB;
constexpr size_t WS_LCNT = 11 * MiB;
constexpr size_t WS_ASG = 12 * MiB, WS_GATE = WS_ASG + (size_t)T * 16, WS_SLOT = WS_GATE + (size_t)T * 16;
constexpr int ECAPT = 65, ECAP = ECAPT * 256;
constexpr size_t WS_STOK_OLD = WS_ASG + 1 * MiB;
static_assert(WS_SLOT + (size_t)T * 16 <= WS_STOK_OLD, "assign");
constexpr size_t WS_WFN = 16 * MiB, WS_WFAQ = WS_WFN + 2 * MiB, WS_WFAO = WS_WFAQ + 3 * MiB, WS_WGI = WS_WFAO + 2 * MiB, WS_WGO = WS_WGI + 8 * MiB,
                 WS_WWQ = WS_WGO + 4 * MiB, WS_WWO = WS_WWQ + 3 * MiB, WS_WSM_END = WS_WWO + 2 * MiB;
static_assert(WS_WSM_END <= 40 * MiB, "small weights");
constexpr size_t WS_X = 40 * MiB;
constexpr size_t WS_H = 106 * MiB;
constexpr size_t WS_Y = 140 * MiB;
constexpr size_t WS_BIG = 176 * MiB;
constexpr size_t WS_BTA = WS_BIG, WS_BTC = WS_BTA + 64 * MiB, WS_BTX = WS_BTC + 64 * MiB, WS_MIXB = WS_BTX + 1 * MiB;
constexpr size_t WS_Q = WS_BIG, WS_K = WS_Q + 33 * MiB, WS_V = WS_K + 9 * MiB, WS_O = WS_V + 9 * MiB;
constexpr size_t WS_Q8 = WS_Q + 86 * MiB, WS_K8 = WS_Q + 104 * MiB;
constexpr size_t WS_GU = WS_BIG, WS_GV = WS_GU + 65 * MiB, WS_GG = WS_GV + 65 * MiB, WS_PSTAT = WS_GG + 66 * MiB;
constexpr int MAXMT = 292; constexpr size_t SLOTROWS = (size_t)MAXMT * 256;
constexpr size_t WS_XS = WS_BIG, WS_YS = WS_XS + 292 * MiB;
constexpr size_t WS_H8 = WS_XS;
constexpr float W8_SCALE = 32.0f, W8_INV = 1.0f / 32.0f;
static_assert(SLOTROWS * 2048 <= 146 * MiB, "slots");
constexpr size_t WS_WEXP_GU = 640 * MiB, WS_WEXP_DN = WS_WEXP_GU + 512 * MiB, WS_X2 = WS_WEXP_DN + 256 * MiB, WS_STOK = WS_X2 + 66 * MiB  , WS_ACT = WS_STOK + 4 * MiB  , WS_END = WS_ACT + (size_t)32 * ECAP * 2048;
static_assert(WS_YS + 146 * MiB <= WS_WEXP_GU && (size_t)32 * ECAP * 4 <= 4 * MiB, "big region");
constexpr int CW_BAR = 4096;
constexpr int CW_GCNT = 8192;
constexpr int CW_TMO = 0;
constexpr int CW_MCNT = 16384, MCNT_LAYER = 320 * 64;
static_assert((CW_BAR + 3456) <= CW_GCNT && (CW_GCNT + 4 * 32 * 64) * 4 <= (int)CTL_ZERO_BYTES, "control words inside the memset region");

constexpr int RING_OFF = 0, RING_BYTES = 131072;
constexpr int PRO_SCR_BYTES = 8 * 64 * 65 * 4;
constexpr int MISC_OFF = 136 * 1024;
constexpr int LDS_BYTES = 147456;
constexpr int MW_BAR = 0, MW_LC = 8, MW_TOT = 480, MW_EBASE = 64, MW_MYBASE = 96, MW_NMT = 128, MW_CONV = 132, MW_MTE = 160;
static_assert(MISC_OFF + (MW_MTE + 304) * 4 <= LDS_BYTES && PRO_SCR_BYTES <= MISC_OFF, "LDS map");

#define GAS __attribute__((address_space(1)))
#define LAS __attribute__((address_space(3)))
typedef unsigned short bf16;
typedef unsigned v4u __attribute__((ext_vector_type(4)));
typedef unsigned v2u __attribute__((ext_vector_type(2)));
typedef float f32x4 __attribute__((ext_vector_type(4)));
typedef float f32x2 __attribute__((ext_vector_type(2)));
typedef float f32x16 __attribute__((ext_vector_type(16)));
typedef short bf16x8 __attribute__((ext_vector_type(8)));
typedef GAS unsigned gu32;
#define RLX_AGENT __ATOMIC_RELAXED, __HIP_MEMORY_SCOPE_AGENT
#define LDS_WAIT() asm volatile("s_waitcnt lgkmcnt(0)" ::: "memory")
#define VM_WAIT() asm volatile("s_waitcnt vmcnt(0)" ::: "memory")
__device__ __forceinline__ unsigned f2bf(float f) { unsigned u = __builtin_bit_cast(unsigned, f); return (u + 0x7fffu + ((u >> 16) & 1u)) >> 16; }
__device__ __forceinline__ unsigned pk2(float lo, float hi) { return f2bf(lo) | (f2bf(hi) << 16); }
__device__ __forceinline__ float bf_lo(unsigned w) { return __builtin_bit_cast(float, w << 16); }
__device__ __forceinline__ float bf_hi(unsigned w) { return __builtin_bit_cast(float, w & 0xffff0000u); }
#define XB_TMO      128
#define XB_XCNT(j)  (256  + 64 * (j))
#define XB_XSUB(j)  (1280 + 64 * (j))
#define XB_XGEN(j)  (2304 + 64 * (j))
#define XB_TOP      3328
#define XB_TOPGEN   3392
#define XCD_BAR_WORDS 3456
#define XB_SPIN_CAP (1u << 18)

__device__ __forceinline__ unsigned xb_ld(unsigned* p)              { return __hip_atomic_load(p, __ATOMIC_RELAXED, __HIP_MEMORY_SCOPE_AGENT); }
__device__ __forceinline__ unsigned xb_add(unsigned* p, unsigned v) { return __hip_atomic_fetch_add(p, v, __ATOMIC_RELAXED, __HIP_MEMORY_SCOPE_AGENT); }
__device__ __forceinline__ unsigned xb_xcc_id() { return (unsigned)__builtin_amdgcn_s_getreg((3 << 11) | 20) & 0xFu; }
#define XB_SPIN(cond, bar) do { unsigned _sp = 0; while (cond) { __builtin_amdgcn_s_sleep(1); \
    if ((++_sp & 255u) == 0u) { if (xb_ld(&(bar)[XB_TMO])) break; if (_sp > XB_SPIN_CAP) { atomicAdd(&(bar)[XB_TMO], 1u); break; } } } } while (0)

struct XcdBarrier {
    unsigned* bar; unsigned x;
    volatile LAS unsigned* st;
};

__device__ __forceinline__ XcdBarrier xcd_barrier_post(unsigned* bar, volatile LAS unsigned* st) {
    XcdBarrier b; b.bar = bar; b.x = xb_xcc_id(); b.st = st;
    if (threadIdx.x == 0) (void)xb_add(&bar[XB_XCNT(b.x)], 1u);
    return b;
}
__device__ __forceinline__ void xcd_barrier_complete(unsigned* bar, unsigned x, unsigned& nloc, unsigned& nx) {
    const unsigned G = gridDim.x * gridDim.y * gridDim.z;
    unsigned sum, cnt, mine, sp = 0u;
    for (;;) {
        sum = 0u; cnt = 0u; mine = 0u;
#pragma unroll
        for (unsigned j = 0; j < 16; ++j) { const unsigned c = xb_ld(&bar[XB_XCNT(j)]); sum += c; cnt += (c > 0u) ? 1u : 0u; mine = (j == x) ? c : mine; }
        if (sum == G) break;
        __builtin_amdgcn_s_sleep(1);
        if ((++sp & 255u) == 0u) { if (xb_ld(&bar[XB_TMO])) break; if (sp > XB_SPIN_CAP) { atomicAdd(&bar[XB_TMO], 1u); break; } }
    }
    nloc = mine > 0u ? mine : 1u; nx = cnt > 0u ? cnt : 1u;
}

__device__ __forceinline__ void xcd_barrier(const XcdBarrier& b) {
    asm volatile("s_waitcnt vmcnt(0)" ::: "memory");
    __syncthreads();
    if (threadIdx.x == 0) {
        unsigned* bar = b.bar;
        __builtin_amdgcn_s_waitcnt(0);
        unsigned nloc = b.st[0], nx = b.st[1];
        if (nloc == 0u) { xcd_barrier_complete(bar, b.x, nloc, nx); b.st[0] = nloc; b.st[1] = nx; }
        const unsigned old = xb_add(&bar[XB_XSUB(b.x)], 1u);
        const unsigned gen = old / nloc;
        if (old + 1u == (gen + 1u) * nloc) {
            __builtin_amdgcn_fence(__ATOMIC_RELEASE, "agent");
            asm volatile("s_waitcnt vmcnt(0)" ::: "memory");
            const unsigned og = xb_add(&bar[XB_TOP], 1u);
            const unsigned tg = og / nx;
            if (og + 1u == (tg + 1u) * nx) xb_add(&bar[XB_TOPGEN], 1u);
            else XB_SPIN(xb_ld(&bar[XB_TOPGEN]) == tg, bar);
            __builtin_amdgcn_fence(__ATOMIC_ACQUIRE, "agent");
            xb_add(&bar[XB_XGEN(b.x)], 1u);
            asm volatile("s_waitcnt vmcnt(0)" ::: "memory");
        } else {
            XB_SPIN(xb_ld(&bar[XB_XGEN(b.x)]) == gen, bar);
            __builtin_amdgcn_fence(__ATOMIC_ACQUIRE, "agent");
            asm volatile("s_waitcnt vmcnt(0)" ::: "memory");
        }
    }
    __syncthreads();
}
struct Frame {
    LAS unsigned char* lds;
    volatile LAS unsigned* MISC;
    gu32* ctl;
    unsigned char* ws;
    int wave, vcu, G, bx;
};
enum In { I_X = 0, I_C, I_CTX, I_CCTX, I_ADAW, I_ADAB, I_LNMG, I_LNMB, I_LNFG, I_LNFB, I_FNW, I_FNB, I_FAWQ, I_FABQ, I_FAQN, I_FAKN, I_FAWO, I_FABO,
          I_GMWI, I_GMBI, I_GMVG, I_GMVB, I_GMWS, I_GMBS, I_GMWO, I_GMBO, I_WAWQ, I_WABQ, I_WASK, I_WAWO, I_WABO, I_RW, I_RB, I_EWGU, I_EBGU, I_EWD, I_EBD, N_IN };

#define CAS __attribute__((address_space(4)))
typedef const float* cfptr_t;
__device__ __forceinline__ const float* argp(int idx) {
    unsigned long long a = (unsigned long long)__builtin_amdgcn_kernarg_segment_ptr(); asm volatile("" : "+s"(a));
    return ((const CAS cfptr_t*)a)[idx];
}
__device__ __forceinline__ int otid() { int t = threadIdx.x; asm volatile("" : "+v"(t)); return t; }
__device__ __forceinline__ float wave_sum(float v) {
#pragma unroll
    for (int o = 1; o < 64; o <<= 1) v += __shfl_xor(v, o);
    return v;
}
struct RowV { f32x4 v[4]; };
__device__ __forceinline__ RowV ldrow(const float* p, int lane) { RowV r; const f32x4* q = (const f32x4*)p + lane;
#pragma unroll
    for (int j = 0; j < 4; ++j) r.v[j] = q[64 * j]; return r; }
__device__ __forceinline__ void strow(float* p, int lane, const RowV& r) { f32x4* q = (f32x4*)p + lane;
#pragma unroll
    for (int j = 0; j < 4; ++j) q[64 * j] = r.v[j]; }
__device__ __forceinline__ void strow_bf16(bf16* p, int lane, const RowV& r) { unsigned long long* q = (unsigned long long*)p + lane;
#pragma unroll
    for (int j = 0; j < 4; ++j) q[64 * j] = (unsigned long long)pk2(r.v[j].x, r.v[j].y) | ((unsigned long long)pk2(r.v[j].z, r.v[j].w) << 32); }
__device__ __forceinline__ RowV ldrow_bf16(const bf16* p, int lane) { RowV r; const v2u* q = (const v2u*)p + lane;
#pragma unroll
    for (int j = 0; j < 4; ++j) { const v2u w = q[64 * j]; r.v[j] = (f32x4){bf_lo(w.x), bf_hi(w.x), bf_lo(w.y), bf_hi(w.y)}; } return r; }
__device__ __forceinline__ RowV ln_row(const RowV& x, const RowV& g, const RowV& b) {
    float s = 0.f;
#pragma unroll
    for (int j = 0; j < 4; ++j) s += (x.v[j].x + x.v[j].y) + (x.v[j].z + x.v[j].w);
    const float mean = wave_sum(s) * (1.f / DM); float s2 = 0.f; RowV d;
#pragma unroll
    for (int j = 0; j < 4; ++j) { d.v[j] = x.v[j] - mean; s2 += (d.v[j].x * d.v[j].x + d.v[j].y * d.v[j].y) + (d.v[j].z * d.v[j].z + d.v[j].w * d.v[j].w); }
    const float rstd = 1.f / sqrtf(wave_sum(s2) * (1.f / DM) + LN_EPS);
#pragma unroll
    for (int j = 0; j < 4; ++j) d.v[j] = d.v[j] * rstd * g.v[j] + b.v[j];
    return d;
}
__device__ __forceinline__ const float* modp(const Frame& F, int L, int s, int which) { return (const float*)(F.ws + WS_MOD) + ((size_t)(L * 2 + s) * 6 + which) * DM; }

struct TokOrder : pg8::GridOrder {
    size_t apan, bpan;
    __device__ __forceinline__ bool next(int i, pg8::Unit& u) const { u.e = 0; return next_mn(i, u.pm, u.pn); }
    __device__ __forceinline__ size_t offA(const pg8::Unit& u) const { return (size_t)u.pm * apan; }
    __device__ __forceinline__ size_t offB(const pg8::Unit& u) const { return (size_t)u.pn * bpan; }
    __device__ __forceinline__ void a_ready(const pg8::Unit&) const {}
    __device__ __forceinline__ void done(const pg8::Unit&) const {}
};
struct ChDftOrder : pg8::GridOrder {
    __device__ __forceinline__ bool next(int i, pg8::Unit& u) const { u.e = 0; return next_mn(i, u.pm, u.pn); }
    __device__ __forceinline__ size_t offA(const pg8::Unit& u) const { return (size_t)u.pm * (256 * 256 * 2); }
    __device__ __forceinline__ size_t offB(const pg8::Unit& u) const { const int g = u.pn >> 6, j = u.pn & 63; return ((size_t)(2 * j) * DM + g * 256) * 2; }
    __device__ __forceinline__ void a_ready(const pg8::Unit&) const {}
    __device__ __forceinline__ void done(const pg8::Unit&) const {}
};
struct ChDftCtxOrder : pg8::GridOrder {
    __device__ __forceinline__ bool next(int i, pg8::Unit& u) const { u.e = 0; return next_mn(i, u.pm, u.pn); }
    __device__ __forceinline__ size_t offA(const pg8::Unit& u) const { return (size_t)u.pm * (256 * 256 * 2); }
    __device__ __forceinline__ size_t offB(const pg8::Unit& u) const { return ((size_t)NLAT * DM + u.pn * 256) * 2; }
    __device__ __forceinline__ void a_ready(const pg8::Unit&) const {}
    __device__ __forceinline__ void done(const pg8::Unit&) const {}
};
struct MoeOrder : pg8::GridOrder {
    const volatile LAS unsigned* mte; size_t bexp, apan, bpan;
    __device__ __forceinline__ bool next(int i, pg8::Unit& u) const { int pl; if (!next_mn(i, pl, u.pn)) return false; u.pm = (int)mte[pl]; u.e = u.pm / ECAPT; return true; }
    __device__ __forceinline__ size_t offA(const pg8::Unit& u) const { return (size_t)u.pm * apan; }
    __device__ __forceinline__ size_t offB(const pg8::Unit& u) const { return (size_t)u.e * bexp + (size_t)u.pn * bpan; }
    __device__ __forceinline__ void a_ready(const pg8::Unit&) const {}
    __device__ __forceinline__ void done(const pg8::Unit&) const {}
};

struct MoeOrderG : pg8::GridOrder {
    const volatile LAS unsigned* mte; size_t bexp, bpan; const unsigned* stok; unsigned rowbytes;
    __device__ __forceinline__ bool next(int i, pg8::Unit& u) const { int pl; if (!next_mn(i, pl, u.pn)) return false; u.pm = (int)mte[pl]; u.e = u.pm / ECAPT; return true; }
    __device__ __forceinline__ size_t offA(const pg8::Unit&) const { return 0; }
    __device__ __forceinline__ size_t offB(const pg8::Unit& u) const { return (size_t)u.e * bexp + (size_t)u.pn * bpan; }
    __device__ __forceinline__ unsigned rowoff(const pg8::Unit& u, int row) const { return (stok[u.pm * 256 + row] >> 2) * rowbytes; }
    __device__ __forceinline__ void a_ready(const pg8::Unit&) const {}
    __device__ __forceinline__ void done(const pg8::Unit&) const {}
};

#define EPI_ARGS const pg8::f32x4 (&acc)[2][2][4][2], const pg8::Unit& u, int wr, int wc, int fr, int fq
__device__ __forceinline__ unsigned pk4f8(float a, float b, float c, float d) { int w = 0; w = __builtin_amdgcn_cvt_pk_fp8_f32(a, b, w, false); w = __builtin_amdgcn_cvt_pk_fp8_f32(c, d, w, true); return (unsigned)w; }
__device__ __forceinline__ v2u pack8f8(const f32x4& a, const f32x4& b) { v2u w; w.x = pk4f8(a[0], a[1], a[2], a[3]); w.y = pk4f8(b[0], b[1], b[2], b[3]); return w; }
__device__ __forceinline__ v4u pack8(const f32x4& a, const f32x4& b) { v4u w; w.x = pg8::cvt_pk_bf16(a[0], a[1]); w.y = pg8::cvt_pk_bf16(a[2], a[3]); w.z = pg8::cvt_pk_bf16(b[0], b[1]); w.w = pg8::cvt_pk_bf16(b[2], b[3]); return w; }

struct EpiChDft { static constexpr bool PERM = true, AFTER_DRAIN = false; bf16* O;
    __device__ __forceinline__ void operator()(EPI_ARGS) const {
        const int g = u.pn >> 6, j = u.pn & 63, part = u.pm;
        char* ub = (char*)O + 2 * ((size_t)((g * 256 + 64 * wr) * 128 + 2 * j) * 256 + part * 128 + 32 * wc);
        unsigned lo = 2u * (unsigned)(fr * 128 * 256 + 8 * fq); asm volatile("" : "+v"(lo));
#pragma unroll
        for (int ai = 0; ai < 2; ++ai)
#pragma unroll
            for (int m = 0; m < 4; ++m)
#pragma unroll
                for (int bj = 0; bj < 2; ++bj)
                    *(v4u*)(ub + (size_t)(2 * (((128 * ai + 16 * m) * 128 + bj) * 256)) + lo) = pack8(acc[ai][bj][m][0], acc[ai][bj][m][1]);
    }
};
struct EpiChDftCtx { static constexpr bool PERM = true, AFTER_DRAIN = false; bf16* O;
    __device__ __forceinline__ void operator()(EPI_ARGS) const {
        const int g = u.pn, part = u.pm;
        char* ub = (char*)O + 2 * ((size_t)(g * 256 + 64 * wr) * 512 + part * 256 + 32 * wc);
        unsigned lo = 2u * (unsigned)(fr * 512 + 8 * fq); asm volatile("" : "+v"(lo));
#pragma unroll
        for (int ai = 0; ai < 2; ++ai)
#pragma unroll
            for (int m = 0; m < 4; ++m)
#pragma unroll
                for (int bj = 0; bj < 2; ++bj)
                    *(v4u*)(ub + (size_t)(2 * ((128 * ai + 16 * m) * 512 + 128 * bj)) + lo) = pack8(acc[ai][bj][m][0], acc[ai][bj][m][1]);
    }
};
struct EpiStepA { static constexpr bool PERM = true, AFTER_DRAIN = false; bf16* O; const float* twc; const float* tws;
    __device__ __forceinline__ void operator()(EPI_ARGS) const {
        char* ub = (char*)O + 2 * ((size_t)(64 * wr * 1024 + 2 * u.pn) * 256 + 32 * wc);
        unsigned lo = 2u * (unsigned)(fr * 1024 * 256 + 8 * fq); asm volatile("" : "+v"(lo));
        const char* tcb = (const char*)twc + 4 * (64 * wr * 128 + 32 * wc); const char* tsb = (const char*)tws + 4 * (64 * wr * 128 + 32 * wc);
        unsigned tlo = 4u * (unsigned)(fr * 128 + 8 * fq); asm volatile("" : "+v"(tlo));
#pragma unroll
        for (int m = 0; m < 4; ++m) {
            const f32x4 c0 = *(const f32x4*)(tcb + 4 * (16 * m * 128) + tlo), c1 = *(const f32x4*)(tcb + 4 * (16 * m * 128 + 4) + tlo), s0 = *(const f32x4*)(tsb + 4 * (16 * m * 128) + tlo), s1 = *(const f32x4*)(tsb + 4 * (16 * m * 128 + 4) + tlo);
#pragma unroll
            for (int bj = 0; bj < 2; ++bj) {
                const f32x4 zr0 = acc[0][bj][m][0], zr1 = acc[0][bj][m][1], zi0 = acc[1][bj][m][0], zi1 = acc[1][bj][m][1];
                const f32x4 yr0 = zr0 * c0 + zi0 * s0, yr1 = zr1 * c1 + zi1 * s1, yi0 = zi0 * c0 - zr0 * s0, yi1 = zi1 * c1 - zr1 * s1;
                char* p = ub + (size_t)(2 * ((16 * m * 1024 + bj) * 256)) + lo;
                *(v4u*)p = pack8(yr0, yr1); *(v4u*)(p + 256) = pack8(yi0, yi1); }
            asm volatile("" ::: "memory"); }
    }
};
struct EpiStepC { static constexpr bool PERM = true, AFTER_DRAIN = false; bf16* O;
    __device__ __forceinline__ void operator()(EPI_ARGS) const {
        const int k1 = u.pn >> 2, chb = (u.pn & 3) * 256;
        char* ub = (char*)O + 2 * ((size_t)(k1 + 128 * 64 * wr) * DM + chb + 32 * wc);
        unsigned lo = 2u * (unsigned)(128 * fr * DM + 8 * fq); asm volatile("" : "+v"(lo));
#pragma unroll
        for (int m = 0; m < 4; ++m)
#pragma unroll
            for (int bj = 0; bj < 2; ++bj)
                *(v4u*)(ub + (size_t)(2 * (128 * 16 * m * DM + 128 * bj)) + lo) = pack8(acc[0][bj][m][0], acc[0][bj][m][1]);
    }
};
struct EpiCtxPos { static constexpr bool PERM = true, AFTER_DRAIN = false; bf16* O;
    __device__ __forceinline__ void operator()(EPI_ARGS) const {
        char* ub = (char*)O + 2 * ((size_t)(NLAT + 64 * wr) * DM + u.pn * 256 + 32 * wc);
        unsigned lo = 2u * (unsigned)(fr * DM + 8 * fq); asm volatile("" : "+v"(lo));
#pragma unroll
        for (int ai = 0; ai < 2; ++ai)
#pragma unroll
            for (int m = 0; m < 4; ++m)
#pragma unroll
                for (int bj = 0; bj < 2; ++bj)
                    *(v4u*)(ub + (size_t)(2 * ((128 * ai + 16 * m) * DM + 128 * bj)) + lo) = pack8(acc[ai][bj][m][0], acc[ai][bj][m][1]);
    }
};
template <int NKV, bool RMS> struct EpiQKV { static constexpr bool PERM = true, AFTER_DRAIN = false;
    bf16 *Q, *K, *V; const float* bias; const float* qn; const float* kn; const float* ropc; const float* rops;
    __device__ __forceinline__ void operator()(EPI_ARGS) const {
        const int hh = 4 * u.pn + wc; const int kind = hh < 16 ? 0 : (hh < 16 + NKV ? 1 : 2);
        const int pitch = kind == 0 ? DM : NKV * 64, hd = kind == 0 ? hh : (kind == 1 ? hh - 16 : hh - 16 - NKV);
        const bool f8 = RMS && kind < 2;
        const unsigned es = f8 ? 1u : 2u;
        const size_t doff = f8 ? (kind == 0 ? (size_t)(WS_Q8 - WS_Q) : (size_t)(WS_K8 - WS_Q)) : (kind == 0 ? (size_t)0 : (kind == 1 ? (size_t)(WS_K - WS_Q) : (size_t)(WS_V - WS_Q)));
        bf16* dst = (bf16*)((char*)Q + doff);
        const bool lat = u.pm < NLAT / 256;
        const int rowu = u.pm * 256 + 64 * wr;
        char* ub = (char*)dst + es * ((size_t)rowu * pitch + hd * 64);
        unsigned lo = es * (unsigned)(fr * pitch + 8 * fq); asm volatile("" : "+v"(lo));
        const char* rcb = (const char*)ropc + 4 * ((size_t)rowu * 32); const char* rsb = (const char*)rops + 4 * ((size_t)rowu * 32);
        unsigned rlo = 4u * (unsigned)(fr * 32 + 4 * fq); asm volatile("" : "+v"(rlo));
        f32x4 bv[2][2], gv[2][2];
#pragma unroll
        for (int bj = 0; bj < 2; ++bj)
#pragma unroll
            for (int n = 0; n < 2; ++n) { const int d = 32 * bj + 8 * fq + 4 * n; bv[bj][n] = *(const f32x4*)(bias + hh * 64 + d);
                if (RMS) { const f32x4 gq = *(const f32x4*)(qn + d), gk = *(const f32x4*)(kn + d); gv[bj][n] = kind == 0 ? gq : gk; } }
#pragma unroll
        for (int ai = 0; ai < 2; ++ai)
#pragma unroll
            for (int m = 0; m < 4; ++m) {
                f32x4 v[2][2];
#pragma unroll
                for (int bj = 0; bj < 2; ++bj)
#pragma unroll
                    for (int n = 0; n < 2; ++n) v[bj][n] = acc[ai][bj][m][n] + bv[bj][n];
                if (kind < 2) {
                    if (RMS) { float ss = 0.f;
#pragma unroll
                        for (int bj = 0; bj < 2; ++bj)
#pragma unroll
                            for (int n = 0; n < 2; ++n) ss += (v[bj][n][0] * v[bj][n][0] + v[bj][n][1] * v[bj][n][1]) + (v[bj][n][2] * v[bj][n][2] + v[bj][n][3] * v[bj][n][3]);
                        ss += __shfl_xor(ss, 16); ss += __shfl_xor(ss, 32);
                        const float rs = 1.f / sqrtf(ss * (1.f / 64.f) + RMS_EPS);
#pragma unroll
                        for (int bj = 0; bj < 2; ++bj)
#pragma unroll
                            for (int n = 0; n < 2; ++n) v[bj][n] = v[bj][n] * rs * gv[bj][n]; }
                    if (lat) {
#pragma unroll
                        for (int bj = 0; bj < 2; ++bj)
#pragma unroll
                            for (int n = 0; n < 2; ++n) {
                                const f32x2 c = *(const f32x2*)(rcb + 4 * ((128 * ai + 16 * m) * 32 + 16 * bj + 2 * n) + rlo), sn = *(const f32x2*)(rsb + 4 * ((128 * ai + 16 * m) * 32 + 16 * bj + 2 * n) + rlo);
                                const f32x4 x = v[bj][n];
                                v[bj][n] = (f32x4){x[0] * c.x - x[1] * sn.x, x[0] * sn.x + x[1] * c.x, x[2] * c.y - x[3] * sn.y, x[2] * sn.y + x[3] * c.y}; } }
                    if (kind == 0) {
#pragma unroll
                        for (int bj = 0; bj < 2; ++bj)
#pragma unroll
                            for (int n = 0; n < 2; ++n) v[bj][n] = v[bj][n] * QSCALE; }
                }
                char* p = ub + (size_t)(128 * ai + 16 * m) * (size_t)(es * pitch) + lo;
                if (f8) { *(v2u*)p = pack8f8(v[0][0], v[0][1]); *(v2u*)(p + 32) = pack8f8(v[1][0], v[1][1]); }
                else { *(v4u*)p = pack8(v[0][0], v[0][1]); *(v4u*)(p + 64) = pack8(v[1][0], v[1][1]); }
                if (m & 1) asm volatile("" ::: "memory"); }
    }
};
struct EpiGeluUV { static constexpr bool PERM = true, AFTER_DRAIN = false; bf16* U; bf16* V; const float* bias; float* pstat;
    __device__ __forceinline__ void operator()(EPI_ARGS) const {
        const bool isv = u.pn >= 8; const int colt = (u.pn & 7) * 256;
        char* ub = (char*)(isv ? V : U) + 2 * ((size_t)(u.pm * 256 + 64 * wr) * GM_HALF + colt + 32 * wc);
        unsigned lo = 2u * (unsigned)(fr * GM_HALF + 8 * fq); asm volatile("" : "+v"(lo));
        const float* bb = bias + u.pn * 256 + 32 * wc + 8 * fq;
        f32x4 bv[2][2];
#pragma unroll
        for (int bj = 0; bj < 2; ++bj)
#pragma unroll
            for (int n = 0; n < 2; ++n) bv[bj][n] = *(const f32x4*)(bb + 128 * bj + 4 * n);
#pragma unroll
        for (int ai = 0; ai < 2; ++ai)
#pragma unroll
            for (int m = 0; m < 4; ++m) { float s = 0.f, s2 = 0.f;
#pragma unroll
                for (int bj = 0; bj < 2; ++bj) { const f32x4 x0 = acc[ai][bj][m][0] + bv[bj][0], x1 = acc[ai][bj][m][1] + bv[bj][1];
                    const pg8::f32x2 a = pg8::gelu_pk((pg8::f32x2){x0[0], x0[1]}), b = pg8::gelu_pk((pg8::f32x2){x0[2], x0[3]}), c = pg8::gelu_pk((pg8::f32x2){x1[0], x1[1]}), d = pg8::gelu_pk((pg8::f32x2){x1[2], x1[3]});
                    s += ((a.x + a.y) + (b.x + b.y)) + ((c.x + c.y) + (d.x + d.y)); s2 += ((a.x * a.x + a.y * a.y) + (b.x * b.x + b.y * b.y)) + ((c.x * c.x + c.y * c.y) + (d.x * d.x + d.y * d.y));
                    v4u w; w.x = pg8::cvt_pk_bf16(a.x, a.y); w.y = pg8::cvt_pk_bf16(b.x, b.y); w.z = pg8::cvt_pk_bf16(c.x, c.y); w.w = pg8::cvt_pk_bf16(d.x, d.y);
                    *(v4u*)(ub + (size_t)(2 * ((128 * ai + 16 * m) * GM_HALF + 128 * bj)) + lo) = w; }
                if (isv) { s += __shfl_xor(s, 16); s += __shfl_xor(s, 32); s2 += __shfl_xor(s2, 16); s2 += __shfl_xor(s2, 32);
                    if (fq == 0) *(f32x2*)(pstat + ((size_t)(u.pm * 256 + 128 * ai + 64 * wr + 16 * m + fr) * 32 + (u.pn - 8) * 4 + wc) * 2) = (f32x2){s, s2}; } }
    }
};
struct EpiSwiGLU { static constexpr bool PERM = true, AFTER_DRAIN = false; unsigned char* O; const float* bias;
    __device__ __forceinline__ void operator()(EPI_ARGS) const {
        f32x4 bv[2][2];
        const float* bb = bias + (size_t)u.e * 2048 + u.pn * 256 + 32 * wc + 8 * fq;
#pragma unroll
        for (int bj = 0; bj < 2; ++bj)
#pragma unroll
            for (int n = 0; n < 2; ++n) bv[bj][n] = *(const f32x4*)(bb + 128 * bj + 4 * n);
        char* ub = (char*)O + (((size_t)u.pm * 256 + 64 * wr) * 1024 + u.pn * 128 + 16 * wc);
        unsigned lo = (unsigned)(fr * 1024 + 4 * fq); asm volatile("" : "+v"(lo));
#pragma unroll
        for (int ai = 0; ai < 2; ++ai)
#pragma unroll
            for (int m = 0; m < 4; ++m) {
#pragma unroll
                for (int bj = 0; bj < 2; ++bj) { float a[4];
#pragma unroll
                    for (int n = 0; n < 2; ++n) { const f32x4 x = acc[ai][bj][m][n] * W8_INV + bv[bj][n];
#pragma unroll
                        for (int q = 0; q < 2; ++q) { const float glu = fminf(x[2 * q], 7.0f), lin = fminf(fmaxf(x[2 * q + 1], -7.0f), 7.0f);
                            const float sg = __builtin_amdgcn_rcpf(1.0f + __builtin_amdgcn_exp2f(-1.702f * LOG2E * glu));
                            a[2 * n + q] = glu * sg * (lin + 1.0f); } }
                    int w = 0; w = __builtin_amdgcn_cvt_pk_fp8_f32(a[0], a[1], w, false); w = __builtin_amdgcn_cvt_pk_fp8_f32(a[2], a[3], w, true);
                    *(int*)(ub + (size_t)((128 * ai + 16 * m) * 1024 + 64 * bj) + lo) = w; } }
    }
};
struct EpiDown { static constexpr bool PERM = true, AFTER_DRAIN = false; bf16* O; const float* bias; const unsigned* stok;
    __device__ __forceinline__ void operator()(EPI_ARGS) const {
        f32x4 bv[2][2];
        const float* bb = bias + (size_t)u.e * 1024 + u.pn * 256 + 32 * wc + 8 * fq;
#pragma unroll
        for (int bj = 0; bj < 2; ++bj)
#pragma unroll
            for (int n = 0; n < 2; ++n) bv[bj][n] = *(const f32x4*)(bb + 128 * bj + 4 * n);
        const char* spb = (const char*)stok + 4 * (u.pm * 256 + 64 * wr); unsigned so = 4u * (unsigned)fr; asm volatile("" : "+v"(so));
        unsigned yr[2][4];
#pragma unroll
        for (int ai = 0; ai < 2; ++ai)
#pragma unroll
            for (int m = 0; m < 4; ++m) yr[ai][m] = *(const unsigned*)(spb + 4 * (128 * ai + 16 * m) + so);
        char* ub = (char*)O + 2 * (u.pn * 256 + 32 * wc);
        unsigned lo = 2u * (unsigned)(8 * fq); asm volatile("" : "+v"(lo));
#pragma unroll
        for (int ai = 0; ai < 2; ++ai)
#pragma unroll
            for (int m = 0; m < 4; ++m) { const unsigned ro = yr[ai][m] * (unsigned)(DM * 2) + lo;
                if (yr[ai][m] != (unsigned)(4 * T)) {
#pragma unroll
                    for (int bj = 0; bj < 2; ++bj)
                        *(v4u*)(ub + (size_t)(256 * bj) + ro) = pack8(acc[ai][bj][m][0] * W8_INV + bv[bj][0], acc[ai][bj][m][1] * W8_INV + bv[bj][1]); } }
    }
};
__device__ __forceinline__ int qkv_rowmap(int n) { return (n & ~255) + ((n >> 5) & 1) * 128 + ((n >> 6) & 3) * 32 + (n & 31); }
__device__ __forceinline__ void p0_transpose_item(const float* W, int K, int N, bf16* WT, int rowmode, LAS float* scr, int item, int lane) {
    const int nblk = N / 64, kb = item / nblk, nb = item - kb * nblk, k0 = 64 * kb, n0 = 64 * nb;
    const int r = lane >> 4, cq = lane & 15;
    f32x4 t[16];
#pragma unroll
    for (int i = 0; i < 16; ++i) t[i] = __builtin_nontemporal_load((const f32x4*)(W + (size_t)(k0 + 4 * i + r) * N + n0 + 4 * cq));
#pragma unroll
    for (int i = 0; i < 16; ++i) { LAS float* s = scr + (4 * i + r) * 65 + 4 * cq; s[0] = t[i].x; s[1] = t[i].y; s[2] = t[i].z; s[3] = t[i].w; }
    LDS_WAIT(); asm volatile("" ::: "memory");
    const int c = lane & 7, nn = lane >> 3;
#pragma unroll
    for (int j = 0; j < 8; ++j) { const int n = nn + 8 * j; const LAS float* s = scr + (8 * c) * 65 + n;
        v4u o; o.x = pk2(s[0 * 65], s[1 * 65]); o.y = pk2(s[2 * 65], s[3 * 65]); o.z = pk2(s[4 * 65], s[5 * 65]); o.w = pk2(s[6 * 65], s[7 * 65]);
        const int row = rowmode ? qkv_rowmap(n0 + n) : (n0 + n);
        __builtin_nontemporal_store(o, (GAS v4u*)(WT + (size_t)row * K + k0 + 8 * c)); }
    LDS_WAIT(); asm volatile("" ::: "memory");
}
__device__ __forceinline__ void p0_transpose_item_f8(const float* W, int K, int N, unsigned char* WT, LAS float* scr, int item, int lane) {
    const int nblk = N / 64, kb = item / nblk, nb = item - kb * nblk, k0 = 64 * kb, n0 = 64 * nb;
    const int r = lane >> 4, cq = lane & 15;
    f32x4 t[16];
#pragma unroll
    for (int i = 0; i < 16; ++i) t[i] = __builtin_nontemporal_load((const f32x4*)(W + (size_t)(k0 + 4 * i + r) * N + n0 + 4 * cq));
#pragma unroll
    for (int i = 0; i < 16; ++i) { LAS float* s = scr + (4 * i + r) * 65 + 4 * cq; s[0] = t[i].x; s[1] = t[i].y; s[2] = t[i].z; s[3] = t[i].w; }
    LDS_WAIT(); asm volatile("" ::: "memory");
    const int c = lane & 3, nn = lane >> 2;
#pragma unroll
    for (int j = 0; j < 4; ++j) { const int n = nn + 16 * j; const LAS float* s = scr + (16 * c) * 65 + n; v4u o;
#pragma unroll
        for (int q = 0; q < 4; ++q) { int w = 0; w = __builtin_amdgcn_cvt_pk_fp8_f32(s[(4 * q) * 65] * W8_SCALE, s[(4 * q + 1) * 65] * W8_SCALE, w, false);
            w = __builtin_amdgcn_cvt_pk_fp8_f32(s[(4 * q + 2) * 65] * W8_SCALE, s[(4 * q + 3) * 65] * W8_SCALE, w, true); o[q] = (unsigned)w; }
        __builtin_nontemporal_store(o, (GAS v4u*)(WT + (size_t)(n0 + n) * K + k0 + 16 * c)); }
    LDS_WAIT(); asm volatile("" ::: "memory");
}
struct WgItem { const float* W; unsigned char* WT; int N, kb, nb; };
__device__ __forceinline__ void p0_wg_load(const WgItem& I, f32x4 (&t)[16], int wave, int lane) {
#pragma unroll
    for (int i = 0; i < 16; ++i) t[i] = __builtin_nontemporal_load((const f32x4*)(I.W + (size_t)(128 * I.kb + 16 * wave + i) * I.N + 256 * I.nb + 4 * lane));
}
__device__ __forceinline__ void p0_wg_stage(const f32x4 (&t)[16], LAS float* tile, int wave, int lane) {
#pragma unroll
    for (int i = 0; i < 16; ++i) *(LAS f32x4*)(tile + (16 * wave + i) * 260 + 4 * (lane ^ wave)) = t[i];
}
__device__ __forceinline__ void p0_wg_store(const WgItem& I, LAS float* tile, int tid) {
    const int c = tid & 7, k0 = 128 * I.kb, n0 = 256 * I.nb;
#pragma unroll
    for (int j = 0; j < 4; ++j) { const int n = (tid >> 3) + 64 * j; const LAS float* s = tile + (16 * c) * 260 + (n ^ (4 * c)); v4u o;
#pragma unroll
        for (int q = 0; q < 4; ++q) { int w = 0; w = __builtin_amdgcn_cvt_pk_fp8_f32(s[(4 * q) * 260] * W8_SCALE, s[(4 * q + 1) * 260] * W8_SCALE, w, false);
            w = __builtin_amdgcn_cvt_pk_fp8_f32(s[(4 * q + 2) * 260] * W8_SCALE, s[(4 * q + 3) * 260] * W8_SCALE, w, true); o[q] = (unsigned)w; }
        __builtin_nontemporal_store(o, (GAS v4u*)(I.WT + (size_t)(n0 + n) * 1024 + k0 + 16 * c)); }
}
constexpr int CONV_PER_LAYER = 32 * 64 + 32 * 32, CONV_UP_PER = 5, CONV_DN_PER = 3, CONV_QKV_PER = 6, CONV_ATTN_L2 = 2048;
constexpr bool CONV_DEFER = !MK_PER_PHASE;
__device__ __forceinline__ WgItem conv_item(Frame& F, int L, int j) { WgItem I;
    if (j < 2048) { const int le = L * 32 + (j >> 6), r = j & 63; I.W = argp(I_EWGU) + (size_t)le * 1024 * 2048; I.N = 2048; I.WT = (unsigned char*)(F.ws + WS_WEXP_GU) + (size_t)le * 2048 * 1024; I.kb = r >> 3; I.nb = r & 7; }
    else { const int q = j - 2048, le = L * 32 + (q >> 5), r = q & 31; I.W = argp(I_EWD) + (size_t)le * 1024 * 1024; I.N = 1024; I.WT = (unsigned char*)(F.ws + WS_WEXP_DN) + (size_t)le * 1024 * 1024; I.kb = r >> 2; I.nb = r & 3; }
    return I; }
__device__ __forceinline__ void conv_range(Frame& F, int L, int lo, int hi, int rank, int stride) { const int tid = otid(), lane = tid & 63;
    __syncthreads();
    f32x4 t[16]; int it = lo + rank;
    if (it < hi) p0_wg_load(conv_item(F, L, it), t, F.wave, lane);
    for (; it < hi; it += stride) {
        p0_wg_stage(t, (LAS float*)F.lds, F.wave, lane);
        __syncthreads();
        if (it + stride < hi) p0_wg_load(conv_item(F, L, it + stride), t, F.wave, lane);
        p0_wg_store(conv_item(F, L, it), (LAS float*)F.lds, tid);
        __syncthreads();
    }
}
__device__ __forceinline__ void conv_range2(Frame& F, int L, int lo, int hi, int rank, int stride) { const int tid = otid(), lane = tid & 63;
    __syncthreads();
    f32x4 ta[16], tb[16]; int it = lo + rank;
    if (it < hi) p0_wg_load(conv_item(F, L, it), ta, F.wave, lane);
    if (it + stride < hi) p0_wg_load(conv_item(F, L, it + stride), tb, F.wave, lane);
    for (; it < hi; it += 2 * stride) {
        p0_wg_stage(ta, (LAS float*)F.lds, F.wave, lane);
        __syncthreads();
        if (it + 2 * stride < hi) p0_wg_load(conv_item(F, L, it + 2 * stride), ta, F.wave, lane);
        p0_wg_store(conv_item(F, L, it), (LAS float*)F.lds, tid);
        __syncthreads();
        if (it + stride < hi) {
            p0_wg_stage(tb, (LAS float*)F.lds, F.wave, lane);
            __syncthreads();
            if (it + 3 * stride < hi) p0_wg_load(conv_item(F, L, it + 3 * stride), tb, F.wave, lane);
            p0_wg_store(conv_item(F, L, it + stride), (LAS float*)F.lds, tid);
            __syncthreads(); }
    }
}
__device__ __forceinline__ void conv_tail(Frame& F, int L, int rem, int per) {
    const int c0 = (int)F.MISC[MW_CONV]; const int fre = rem ? F.G - rem : 0; int n = per * fre; if (n > CONV_PER_LAYER - c0) n = CONV_PER_LAYER - c0;
    if (rem && F.bx >= rem) conv_range(F, L, c0, c0 + n, F.bx - rem, fre); else __syncthreads();
    if (otid() == 0) F.MISC[MW_CONV] = (unsigned)(c0 + n);
}
__device__ __forceinline__ float siluf(float v) { return v / (1.f + __expf(-v)); }
__device__ __forceinline__ void p0_prologue(Frame& F) { const int tid = otid(), lane = tid & 63; (void)tid; (void)lane;
    {
        LAS float* sc = (LAS float*)(F.lds);
        LAS float* red = sc + 2048;
        { const float* c0 = argp(I_C); const float* c1 = argp(I_CCTX);
          for (int i = tid; i < 2048; i += NTHR) { const int s = i >> 10, k = i & 1023; sc[i] = siluf(s == 0 ? c0[k] : c1[k]); } }
        __syncthreads();
        const float* adaw = argp(I_ADAW); const float* adab = argp(I_ADAB);
        for (int task = F.bx; task < 4 * 48; task += F.G) {
            const int L = task / 48, n0 = (task % 48) * 128;
            const float* w = adaw + (size_t)L * DM * 6144 + n0 + 2 * lane;
            float a0 = 0.f, a1 = 0.f, b0 = 0.f, b1 = 0.f;
#pragma unroll 8
            for (int kk = 0; kk < 128; ++kk) { const int k = 128 * F.wave + kk; const f32x2 x = *(const f32x2*)(w + (size_t)k * 6144); const float sl = sc[k], sx = sc[1024 + k];
                a0 += sl * x.x; a1 += sl * x.y; b0 += sx * x.x; b1 += sx * x.y; }
            red[(F.wave * 2 + 0) * 128 + 2 * lane] = a0; red[(F.wave * 2 + 0) * 128 + 2 * lane + 1] = a1;
            red[(F.wave * 2 + 1) * 128 + 2 * lane] = b0; red[(F.wave * 2 + 1) * 128 + 2 * lane + 1] = b1;
            __syncthreads();
            if (tid < 256) { const int s = tid >> 7, col = tid & 127; float v = adab[(size_t)L * 6144 + n0 + col];
#pragma unroll
                for (int wv = 0; wv < 8; ++wv) v += red[(wv * 2 + s) * 128 + col];
                ((float*)(F.ws + WS_MOD))[(size_t)(L * 2 + s) * 6144 + n0 + col] = v; }
            __syncthreads();
        }
    }
    {
        const int gt = F.bx * NTHR + tid, NGT = F.G * NTHR;
        bf16* fc = (bf16*)(F.ws + TB_FC); bf16* fa = (bf16*)(F.ws + TB_FA); bf16* fcc = (bf16*)(F.ws + TB_FCC); bf16* fx = (bf16*)(F.ws + TB_FX);
        float* twc = (float*)(F.ws + TB_TWC); float* tws = (float*)(F.ws + TB_TWS); float* ropc = (float*)(F.ws + TB_ROPC); float* rops = (float*)(F.ws + TB_ROPS);
        for (int i = gt; i < 512 * 256; i += NGT) { const int row = i >> 8, c = i & 255, part = row >> 8, l = row & 255; const int m = (c * l) & 255;
            const float ang = (float)m * (2.0f / 256.0f); const float v = part == 0 ? cospif(ang) : -sinpif(ang); fc[i] = (bf16)f2bf(v * (1.0f / 16.0f)); }
        for (int i = gt; i < 256 * 256; i += NGT) { const int row = i >> 8, col = i & 255, pr = row >> 7, k1 = row & 127, pc = col >> 7, n1 = col & 127; const int m = (n1 * k1) & 127;
            const float ang = (float)m * (2.0f / 128.0f); const float cs = cospif(ang), sn = sinpif(ang);
            const float v = (pr == pc) ? cs : (pr == 0 ? sn : -sn); fa[i] = (bf16)f2bf(v * 0.08838834764831845f); }
        for (int i = gt; i < 256 * 256; i += NGT) { const int row = i >> 8, col = i & 255, pc = col >> 7, n2 = col & 127; float v = 0.f;
            if (row < 128) { const int m = (n2 * row) & 127; const float ang = (float)m * (2.0f / 128.0f); v = (pc == 0 ? cospif(ang) : sinpif(ang)) * 0.08838834764831845f; }
            fcc[i] = (bf16)f2bf(v); }
        for (int i = gt; i < 256 * 512; i += NGT) { const int k = i >> 9, col = i & 511, pc = col >> 8, n = col & 255; const int m = (n * k) & 255;
            const float ang = (float)m * (2.0f / 256.0f); fx[i] = (bf16)f2bf((pc == 0 ? cospif(ang) : sinpif(ang)) * (1.0f / 16.0f)); }
        for (int i = gt; i < 128 * 128; i += NGT) { const int k1 = i >> 7, n2 = i & 127; const float ang = (float)(k1 * n2) * (2.0f / 16384.0f); twc[i] = cospif(ang); tws[i] = sinpif(ang); }
        for (int i = gt; i < NLAT * 32; i += NGT) { const int t = i >> 5, j = i & 31; const float pos = (float)(j < 16 ? (t >> 6) : (t & 63));
            const float inv = powf(10000.0f, -(float)(j & 15) * (1.0f / 16.0f)); const float ang = pos * inv; float sn, cs; sincosf(ang, &sn, &cs); ropc[i] = cs; rops[i] = sn; }
        bf16* rw = (bf16*)(F.ws + WS_RW); const float* rwin = argp(I_RW);
        for (int i = gt; i < 4 * 32 * 1024; i += NGT) { const int L = i >> 15, e = (i >> 10) & 31, k = i & 1023; rw[i] = (bf16)f2bf(rwin[((size_t)L * 1024 + k) * 32 + e]); }
    }
    __syncthreads();
    {
        LAS float* scr = (LAS float*)(F.lds) + F.wave * (64 * 65);
        const int gw = F.vcu * NWAVES + F.wave, NGW = F.G * NWAVES;
        constexpr int I1 = 16 * 16, I2 = 16 * 24, I3 = 16 * 16, I4 = 16 * 64, I5 = 32 * 16, I6 = 16 * 20, I7 = 16 * 16, ISM = I1 + I2 + I3 + I4 + I5 + I6 + I7;
        for (int it = gw; it < ISM; it += NGW) {
            int r = it;
            if (r < I1) { p0_transpose_item(argp(I_FNW), 1024, 1024, (bf16*)(F.ws + WS_WFN), 0, scr, r, lane); continue; } r -= I1;
            if (r < I2) { p0_transpose_item(argp(I_FAWQ), 1024, FA_NQKV, (bf16*)(F.ws + WS_WFAQ), 1, scr, r, lane); continue; } r -= I2;
            if (r < I3) { p0_transpose_item(argp(I_FAWO), 1024, 1024, (bf16*)(F.ws + WS_WFAO), 0, scr, r, lane); continue; } r -= I3;
            if (r < I4) { p0_transpose_item(argp(I_GMWI), 1024, GM_FF, (bf16*)(F.ws + WS_WGI), 0, scr, r, lane); continue; } r -= I4;
            if (r < I5) { p0_transpose_item(argp(I_GMWO), 2048, 1024, (bf16*)(F.ws + WS_WGO), 0, scr, r, lane); continue; } r -= I5;
            if (r < I6) { p0_transpose_item(argp(I_WAWQ), 1024, WA_NQKV, (bf16*)(F.ws + WS_WWQ), 1, scr, r, lane); continue; } r -= I6;
            p0_transpose_item(argp(I_WAWO), 1024, 1024, (bf16*)(F.ws + WS_WWO), 0, scr, r, lane);
        }
        __syncthreads();
        for (int L = 0; L < (CONV_DEFER ? 1 : 4); ++L) conv_range(F, L, 0, CONV_PER_LAYER, F.vcu, F.G);
    }
}

__device__ __forceinline__ void stok_fill(Frame& F) { const int tid = otid(); unsigned* STOK = (unsigned*)(F.ws + WS_STOK);
    for (int i = F.bx * NTHR + tid; i < 32 * ECAP; i += F.G * NTHR) STOK[i] = (unsigned)(4 * T);
}
__device__ __forceinline__ void init_row(Frame& F, int m, int lane, const RowV& x, const RowV& sc, const RowV& sh) { RowV h;
#pragma unroll
    for (int j = 0; j < 4; ++j) h.v[j] = x.v[j] * (1.f + sc.v[j]) + sh.v[j];
    strow_bf16((bf16*)(F.ws + WS_H) + (size_t)m * DM, lane, h); }
__device__ __forceinline__ void pass_init(Frame& F) { const int tid = otid(), lane = tid & 63; (void)tid; (void)lane;
    stok_fill(F);
    const int gw = F.vcu * NWAVES + F.wave, NGW = F.G * NWAVES;
    RowV sh = ldrow(modp(F, 0, 0, 0), lane), sc = ldrow(modp(F, 0, 0, 1), lane);
    const float* xin = argp(I_X);
    for (int m = gw; m < NLAT; m += 4 * NGW) {
        RowV x[4];
#pragma unroll
        for (int q = 0; q < 4; ++q) { const int mq = m + q * NGW; x[q] = ldrow(xin + (size_t)(mq < NLAT ? mq : m) * DM, lane); }
#pragma unroll
        for (int q = 0; q < 4; ++q) { const int mq = m + q * NGW; if (mq < NLAT) init_row(F, mq, lane, x[q], sc, sh); }
    }
    { const int c0 = F.wave * F.G + F.vcu;
      if (c0 < NCTX) { sh = ldrow(modp(F, 0, 1, 0), lane); sc = ldrow(modp(F, 0, 1, 1), lane);
          for (int c = c0; c < NCTX; c += NGW) { const RowV x = ldrow(argp(I_CTX) + (size_t)c * DM, lane); init_row(F, NLAT + c, lane, x, sc, sh); } } }
}

struct RawRow { v2u w[4]; };
__device__ __forceinline__ RawRow ldraw_bf16(const bf16* p, int lane) { RawRow r; const v2u* q = (const v2u*)p + lane;
#pragma unroll
    for (int j = 0; j < 4; ++j) r.w[j] = q[64 * j]; return r; }
__device__ __forceinline__ RowV cvrow(const RawRow& r) { RowV o;
#pragma unroll
    for (int j = 0; j < 4; ++j) o.v[j] = (f32x4){bf_lo(r.w[j].x), bf_hi(r.w[j].x), bf_lo(r.w[j].y), bf_hi(r.w[j].y)}; return o; }
template <int L> __device__ __forceinline__ void pass_mix(Frame& F) { const int tid = otid(), lane = tid & 63; (void)tid; (void)lane;
    constexpr bool HAS_CTX = L < 3, MIX_ON = (EN_MIX >> L) & 1, MOE_ON = (EN_MOE >> L) & 1;
    constexpr int HP = 1032;
    LAS bf16* HT = (LAS bf16*)(F.lds);
    LAS float* PART = (LAS float*)(F.lds + 32 * HP * 2);
    LAS float* LOGT = PART + 8 * 32 * 33;
    volatile LAS unsigned* LC = F.MISC + MW_LC;
    const bf16* X = (const bf16*)(F.ws + WS_X); bf16* X2 = (bf16*)(F.ws + WS_X2); bf16* H = (bf16*)(F.ws + WS_H); const bf16* Y = (const bf16*)(F.ws + WS_Y);
    const float* xin = argp(I_X); const float* cin = argp(I_CTX);
    float* GATE = (float*)(F.ws + WS_GATE); unsigned* STOK = (unsigned*)(F.ws + WS_STOK);
    LAS unsigned* ASL = (LAS unsigned*)(F.lds + 32 * HP * 2 + 8 * 32 * 33 * 4 + 32 * 33 * 4);
    const bf16* RW = (const bf16*)(F.ws + WS_RW) + (size_t)L * 32 * 1024;
    if (CONV_DEFER) { const int donec = (int)F.MISC[MW_CONV];
        if (L >= 1) conv_range(F, L, donec, CONV_PER_LAYER, F.vcu, F.G); else __syncthreads();
        if (tid == 0) F.MISC[MW_CONV] = (L == 1) ? (unsigned)CONV_ATTN_L2 : 0u; }
    if (tid < 32) LC[tid] = 0u;
    ASL[tid] = 0xFFFFFFFFu;
    __syncthreads();
    int ti = 0;
    const float* rbias = argp(I_RB);
    const int nlt = NLAT / 32, nct = HAS_CTX ? NCTX : 0;
    int cur_s = -1; RowV g1, lg, lb, sc2, sh2;
    for (int it = F.bx; it < nlt + nct; it += F.G) {
        const bool isl = it < nlt; const int s = isl ? 0 : 1; const int row0 = isl ? it * 32 : NLAT + (it - nlt); const int nrows = isl ? 32 : 1;
        if (s != cur_s) { cur_s = s; g1 = ldrow(modp(F, L, s, 2), lane); sh2 = ldrow(modp(F, L, s, 3), lane); sc2 = ldrow(modp(F, L, s, 4), lane);
            lg = ldrow(argp(I_LNMG) + L * DM, lane); lb = ldrow(argp(I_LNMB) + L * DM, lane); }
        const int nr = isl ? 4 : (F.wave == 0 ? 1 : 0);
        RowV xf[4]; RawRow xr[4], yr[4];
#pragma unroll
        for (int q_ = 0; q_ < 4; ++q_) if (q_ < nr) { const int m = row0 + F.wave * 4 + q_;
            if (L == 0) xf[q_] = ldrow(m < NLAT ? xin + (size_t)m * DM : cin + (size_t)(m - NLAT) * DM, lane);
            else xr[q_] = ldraw_bf16(X + (size_t)m * DM, lane);
            if (MIX_ON) yr[q_] = ldraw_bf16(Y + (size_t)m * DM, lane); }
#pragma unroll
        for (int q_ = 0; q_ < 4; ++q_) if (q_ < nr) { const int rr = F.wave * 4 + q_; const int m = row0 + rr;
            RowV x = (L == 0) ? xf[q_] : cvrow(xr[q_]);
            if (MIX_ON) { const RowV y = cvrow(yr[q_]);
#pragma unroll
                for (int j = 0; j < 4; ++j) x.v[j] = x.v[j] * DN_ALPHA + g1.v[j] * y.v[j]; }
            else {
#pragma unroll
                for (int j = 0; j < 4; ++j) x.v[j] = x.v[j] * DN_ALPHA; }
            x = ln_row(x, lg, lb);
            strow_bf16(X2 + (size_t)m * DM, lane, x);
            RowV h;
#pragma unroll
            for (int j = 0; j < 4; ++j) h.v[j] = x.v[j] * (1.f + sc2.v[j]) + sh2.v[j];
            { unsigned* q8 = (unsigned*)((unsigned char*)(F.ws + WS_H8) + (size_t)m * DM) + lane;
#pragma unroll
              for (int j = 0; j < 4; ++j) { int w = 0; w = __builtin_amdgcn_cvt_pk_fp8_f32(h.v[j].x, h.v[j].y, w, false); w = __builtin_amdgcn_cvt_pk_fp8_f32(h.v[j].z, h.v[j].w, w, true); q8[64 * j] = (unsigned)w; } }
            if (MOE_ON) { LAS unsigned long long* q = (LAS unsigned long long*)(HT + rr * HP) + lane;
#pragma unroll
                for (int j = 0; j < 4; ++j) q[64 * j] = (unsigned long long)pk2(h.v[j].x, h.v[j].y) | ((unsigned long long)pk2(h.v[j].z, h.v[j].w) << 32); }
        }
        if (MOE_ON) {
            __syncthreads();
            { const int r32 = lane & 31, hi = lane >> 5; f32x16 acc = f32x16{};
#pragma unroll
                for (int st = 0; st < 8; ++st) { const int k = 128 * F.wave + 16 * st + 8 * hi;
                    const bf16x8 a = *(const LAS bf16x8*)(HT + r32 * HP + k); const bf16x8 b = *(const bf16x8*)(RW + (size_t)r32 * 1024 + k);
                    acc = __builtin_amdgcn_mfma_f32_32x32x16_bf16(a, b, acc, 0, 0, 0); }
#pragma unroll
                for (int r = 0; r < 16; ++r) { const int tok = (r & 3) + 8 * (r >> 2) + 4 * hi; PART[(F.wave * 32 + tok) * 33 + r32] = acc[r]; } }
            __syncthreads();
            { const int t = tid >> 4, e0 = tid & 15;
#pragma unroll
                for (int q = 0; q < 2; ++q) { const int e = e0 + 16 * q; float v = rbias[L * 32 + e];
#pragma unroll
                    for (int wv = 0; wv < 8; ++wv) v += PART[(wv * 32 + t) * 33 + e];
                    LOGT[t * 33 + e] = v; } }
            __syncthreads();
            if (tid < nrows) { const int t = tid; float lv[32];
#pragma unroll
                for (int e = 0; e < 32; ++e) lv[e] = LOGT[t * 33 + e];
                int idx[4]; float val[4]; unsigned taken = 0u;
#pragma unroll
                for (int k = 0; k < 4; ++k) { float best = -INFINITY; int bi = 0;
#pragma unroll
                    for (int e = 0; e < 32; ++e) { const bool ok = !((taken >> e) & 1u) && lv[e] > best; best = ok ? lv[e] : best; bi = ok ? e : bi; }
                    idx[k] = bi; val[k] = best; taken |= 1u << bi; }
                float ev[4], sum = 0.f;
#pragma unroll
                for (int k = 0; k < 4; ++k) { ev[k] = __expf(val[k] - val[0]); sum += ev[k]; }
                const float inv = 1.f / sum; const int m = row0 + t;
#pragma unroll
                for (int k = 0; k < 4; ++k) { const unsigned pos = atomicAdd((unsigned*)&LC[idx[k]], 1u); const int li = (ti & 3) * 128 + t * 4 + k; ASL[li] = ((unsigned)idx[k] << 16) | pos; ASL[512 + li] = (unsigned)(m * 4 + k); GATE[(size_t)m * 4 + k] = ev[k] * inv; } }
            __syncthreads();
        }
        ++ti;
    }
    if (MOE_ON) {
        __syncthreads();
        if (tid < 32) { const unsigned c = LC[tid]; unsigned st = 0u;
            if (c) st = __hip_atomic_fetch_add((unsigned*)(F.ctl + CW_GCNT + (L * 32 + tid) * 64), c, __ATOMIC_RELAXED, __HIP_MEMORY_SCOPE_AGENT);
            F.MISC[MW_TOT + tid] = st; }
        __syncthreads();
        { const unsigned ep = ASL[tid]; if (ep != 0xFFFFFFFFu) { const unsigned e = ep >> 16, pos = ep & 0xffffu; STOK[(size_t)e * ECAP + F.MISC[MW_TOT + e] + pos] = ASL[512 + tid]; } }
    }
}

template <int L> __device__ __forceinline__ void moe_tables(Frame& F) { const int tid = otid();
    if (tid < 64) {
        const int e = tid & 31;
        const unsigned cnt = tid < 32 ? __hip_atomic_load((unsigned*)(F.ctl + CW_GCNT + (L * 32 + e) * 64), RLX_AGENT) : 0u;
        const unsigned tiles = (cnt + 255u) >> 8; unsigned incl = tiles;
#pragma unroll
        for (int o = 1; o < 32; o <<= 1) { const unsigned v = (unsigned)__shfl_up((int)incl, o); if (tid >= o) incl += v; }
        const unsigned base = incl - tiles;
        if (tid < 32) for (unsigned q = 0; q < tiles; ++q) F.MISC[MW_MTE + base + q] = (unsigned)(ECAPT * e) + q;
        if (tid == 31) F.MISC[MW_NMT] = incl; }
    __syncthreads();
}
struct CombIn { RawRow x, y[4]; f32x4 gt; };
template <int L> __device__ __forceinline__ CombIn comb_load(Frame& F, int m, int lane) { CombIn I; constexpr bool MOE_ON = (EN_MOE >> L) & 1;
    const bf16* X2 = (const bf16*)(F.ws + WS_X2); const bf16* YS = (const bf16*)(F.ws + WS_YS); const float* GATE = (const float*)(F.ws + WS_GATE);
    I.x = ldraw_bf16(X2 + (size_t)m * DM, lane);
    if (MOE_ON) { I.gt = *(const f32x4*)(GATE + (size_t)m * 4);
#pragma unroll
        for (int k = 0; k < 4; ++k) I.y[k] = ldraw_bf16(YS + ((size_t)m * 4 + k) * DM, lane); }
    return I; }
template <int L> __device__ __forceinline__ void comb_row(Frame& F, int m, int lane, const CombIn& I, const RowV& g2, const RowV& lg, const RowV& lb, const RowV& sc, const RowV& sh) {
    constexpr bool MOE_ON = (EN_MOE >> L) & 1;
    bf16* X = (bf16*)(F.ws + WS_X); bf16* H = (bf16*)(F.ws + WS_H);
    RowV x = cvrow(I.x);
    if (MOE_ON) { RowV f;
#pragma unroll
        for (int j = 0; j < 4; ++j) f.v[j] = (f32x4){0.f, 0.f, 0.f, 0.f};
#pragma unroll
        for (int k = 0; k < 4; ++k) { const RowV y = cvrow(I.y[k]);
#pragma unroll
            for (int j = 0; j < 4; ++j) f.v[j] += y.v[j] * I.gt[k]; }
#pragma unroll
        for (int j = 0; j < 4; ++j) x.v[j] = x.v[j] * DN_ALPHA + g2.v[j] * f.v[j];
    } else {
#pragma unroll
        for (int j = 0; j < 4; ++j) x.v[j] = x.v[j] * DN_ALPHA; }
    x = ln_row(x, lg, lb);
    if (L < 3) { strow_bf16(X + (size_t)m * DM, lane, x); RowV h;
#pragma unroll
        for (int j = 0; j < 4; ++j) h.v[j] = x.v[j] * (1.f + sc.v[j]) + sh.v[j];
        strow_bf16(H + (size_t)m * DM, lane, h); }
    else strow(((float*)argp(N_IN)) + (size_t)m * DM, lane, x);
}
template <int L> __device__ __forceinline__ void pass_comb(Frame& F) { const int tid = otid(), lane = tid & 63; (void)tid; (void)lane;
    constexpr bool HAS_CTX = L < 3;
    if (L < 3) stok_fill(F);
    const int gw = F.vcu * NWAVES + F.wave, NGW = F.G * NWAVES;
    RowV g2, lg, lb, sc, sh;
    g2 = ldrow(modp(F, L, 0, 5), lane); lg = ldrow(argp(I_LNFG) + L * DM, lane); lb = ldrow(argp(I_LNFB) + L * DM, lane);
    if (L < 3) { sh = ldrow(modp(F, L < 3 ? L + 1 : 0, 0, 0), lane); sc = ldrow(modp(F, L < 3 ? L + 1 : 0, 0, 1), lane); }
    for (int m = gw; m < NLAT; m += 2 * NGW) {
        const int m1 = m + NGW; const bool two = m1 < NLAT;
        const CombIn A = comb_load<L>(F, m, lane); const CombIn B = comb_load<L>(F, two ? m1 : m, lane);
        comb_row<L>(F, m, lane, A, g2, lg, lb, sc, sh);
        if (two) comb_row<L>(F, m1, lane, B, g2, lg, lb, sc, sh);
    }
    if (HAS_CTX) {
        const int c0 = F.wave * F.G + F.vcu;
        if (c0 < NCTX) { g2 = ldrow(modp(F, L, 1, 5), lane); sh = ldrow(modp(F, L < 3 ? L + 1 : 0, 1, 0), lane); sc = ldrow(modp(F, L < 3 ? L + 1 : 0, 1, 1), lane);
            for (int c = c0; c < NCTX; c += NGW) { const CombIn A = comb_load<L>(F, NLAT + c, lane); comb_row<L>(F, NLAT + c, lane, A, g2, lg, lb, sc, sh); } }
    }
}
__device__ __forceinline__ void gate_unit(Frame& F, int t0, int h0, int nh, bool use_pstat) { const int tid = otid(), lane = tid & 63;
    constexpr int WP = 136, VP = 136, OP = 264;
    LAS bf16* WL = (LAS bf16*)(F.lds);
    LAS bf16* VT = (LAS bf16*)(F.lds + 128 * WP * 2);
    LAS bf16* OUT = (LAS bf16*)(F.lds);
    LAS float* STAT = (LAS float*)(F.lds + 128 * WP * 2 + 256 * VP * 2);
    static_assert(128 * OP * 2 <= 128 * WP * 2 + 256 * VP * 2, "OUT overlay");
    const bf16* GU = (const bf16*)(F.ws + WS_GU); const bf16* GV = (const bf16*)(F.ws + WS_GV); bf16* GG = (bf16*)(F.ws + WS_GG);
    const float* ws_ = argp(I_GMWS); const float* bs_ = argp(I_GMBS); const float* vg = argp(I_GMVG); const float* vb = argp(I_GMVB);
    const int r32 = lane & 31, hi = lane >> 5;
    if (use_pstat) {
        const int row = tid >> 2, part = tid & 3; const f32x2* ps = (const f32x2*)((const float*)(F.ws + WS_PSTAT) + ((size_t)(t0 + row) * 32 + 8 * part) * 2); float s = 0.f, s2 = 0.f;
#pragma unroll
        for (int i = 0; i < 8; ++i) { const f32x2 v = ps[i]; s += v.x; s2 += v.y; }
        s += __shfl_xor(s, 1); s += __shfl_xor(s, 2); s2 += __shfl_xor(s2, 1); s2 += __shfl_xor(s2, 2);
        if (part == 0) { const float mean = s * (1.f / GM_HALF); const float var = fmaxf(s2 * (1.f / GM_HALF) - mean * mean, 0.f); STAT[2 * row] = mean; STAT[2 * row + 1] = 1.f / sqrtf(var + LN_EPS); }
    } else {
#ifdef GATE_DUP_STATS
    for (int dup_ = 0; dup_ < 2; ++dup_)
#endif
    for (int bt = 0; bt < 2; ++bt) { v4u raw[8][4]; float s[8], s2[8];
#pragma unroll
        for (int i = 0; i < 8; ++i) { const int q = 16 * F.wave + 8 * bt + i; const v4u* src = (const v4u*)(GV + (size_t)(t0 + q) * GM_HALF) + lane;
#pragma unroll
            for (int j = 0; j < 4; ++j) raw[i][j] = src[64 * j]; }
#pragma unroll
        for (int i = 0; i < 8; ++i) { float a = 0.f, b = 0.f;
#pragma unroll
            for (int j = 0; j < 4; ++j)
#pragma unroll
                for (int e = 0; e < 4; ++e) { const float x0 = bf_lo(raw[i][j][e]), x1 = bf_hi(raw[i][j][e]); a += x0 + x1; b += x0 * x0 + x1 * x1; }
            s[i] = a; s2[i] = b; }
#pragma unroll
        for (int o = 1; o < 64; o <<= 1) {
#pragma unroll
            for (int i = 0; i < 8; ++i) { s[i] += __shfl_xor(s[i], o); s2[i] += __shfl_xor(s2[i], o); } }
        if (lane == 0) {
#pragma unroll
            for (int i = 0; i < 8; ++i) { const int q = 16 * F.wave + 8 * bt + i; const float mean = s[i] * (1.f / GM_HALF); const float var = fmaxf(s2[i] * (1.f / GM_HALF) - mean * mean, 0.f);
                STAT[2 * q] = mean; STAT[2 * q + 1] = 1.f / sqrtf(var + LN_EPS); } } }
    }
    __syncthreads();
    const int wp = tid >> 2, wq0 = (tid & 3) * 32;
    const int vck = tid & 31, vqb0 = tid >> 5;
    const int ck = tid & 31;
    f32x4 wr[8]; v4u wv[8];
    { const f32x4* src = (const f32x4*)(ws_ + ((size_t)h0 * 128 + wp) * 128 + wq0);
#pragma unroll
      for (int i = 0; i < 8; ++i) wr[i] = src[i];
#pragma unroll
      for (int j = 0; j < 8; ++j) wv[j] = *(const v4u*)(GV + (size_t)(t0 + 4 * (vqb0 + 16 * (j >> 2)) + (j & 3)) * GM_HALF + h0 * 256 + 8 * vck); }
    for (int hh = 0; hh < nh; ++hh) { const int h = h0 + hh;
#pragma unroll
        for (int i = 0; i < 4; ++i) { const f32x4 a = wr[2 * i], b = wr[2 * i + 1]; v4u w; w.x = pk2(a[0], a[1]); w.y = pk2(a[2], a[3]); w.z = pk2(b[0], b[1]); w.w = pk2(b[2], b[3]);
            *(LAS v4u*)(WL + wp * WP + wq0 + 8 * i) = w; }
        { const f32x4 g0 = *(const f32x4*)(vg + h * 256 + 8 * vck), g1 = *(const f32x4*)(vg + h * 256 + 8 * vck + 4), b0 = *(const f32x4*)(vb + h * 256 + 8 * vck), b1 = *(const f32x4*)(vb + h * 256 + 8 * vck + 4);
#pragma unroll
            for (int bk = 0; bk < 2; ++bk) { const int q0 = 4 * (vqb0 + 16 * bk); float x[4][8];
#pragma unroll
                for (int r = 0; r < 4; ++r) { const v4u w = wv[4 * bk + r]; const float mean = STAT[2 * (q0 + r)], rstd = STAT[2 * (q0 + r) + 1];
#pragma unroll
                    for (int i = 0; i < 4; ++i) { x[r][2 * i] = (bf_lo(w[i]) - mean) * rstd; x[r][2 * i + 1] = (bf_hi(w[i]) - mean) * rstd; } }
#pragma unroll
                for (int i = 0; i < 8; ++i) { const float gg = i < 4 ? g0[i & 3] : g1[i & 3], bb = i < 4 ? b0[i & 3] : b1[i & 3];
                    v2u w; w.x = pk2(x[0][i] * gg + bb, x[1][i] * gg + bb); w.y = pk2(x[2][i] * gg + bb, x[3][i] * gg + bb);
                    *(LAS v2u*)(VT + (8 * vck + i) * VP + q0) = w; } } }
        if (hh + 1 < nh) { const f32x4* src = (const f32x4*)(ws_ + ((size_t)(h + 1) * 128 + wp) * 128 + wq0);
#pragma unroll
            for (int i = 0; i < 8; ++i) wr[i] = src[i];
#pragma unroll
            for (int j = 0; j < 8; ++j) wv[j] = *(const v4u*)(GV + (size_t)(t0 + 4 * (vqb0 + 16 * (j >> 2)) + (j & 3)) * GM_HALF + (h + 1) * 256 + 8 * vck); }
        v4u uo[8];
#pragma unroll
        for (int j = 0; j < 8; ++j) { const int p = (tid >> 5) + 16 * j; uo[j] = *(const v4u*)(GU + (size_t)(t0 + p) * GM_HALF + h * 256 + 8 * ck); }
        __syncthreads();
        const int wm = F.wave >> 2, wn = F.wave & 3; f32x16 acc[2][2];
#pragma unroll
        for (int i = 0; i < 2; ++i)
#pragma unroll
            for (int jn = 0; jn < 2; ++jn) acc[i][jn] = f32x16{};
#pragma unroll
        for (int ks = 0; ks < 8; ++ks) { bf16x8 a[2], b[2];
#pragma unroll
            for (int i = 0; i < 2; ++i) { a[i] = *(const LAS bf16x8*)(VT + (64 * wn + 32 * i + r32) * VP + 16 * ks + 8 * hi); b[i] = *(const LAS bf16x8*)(WL + (64 * wm + 32 * i + r32) * WP + 16 * ks + 8 * hi); }
#pragma unroll
            for (int i = 0; i < 2; ++i)
#pragma unroll
                for (int jn = 0; jn < 2; ++jn) acc[i][jn] = __builtin_amdgcn_mfma_f32_32x32x16_bf16(a[i], b[jn], acc[i][jn], 0, 0, 0); }
        __syncthreads();
#pragma unroll
        for (int jn = 0; jn < 2; ++jn) { const int p = 64 * wm + 32 * jn + r32; const float bias = bs_[h * 128 + p];
#pragma unroll
            for (int i = 0; i < 2; ++i)
#pragma unroll
                for (int rg = 0; rg < 4; ++rg) { const int c = 64 * wn + 32 * i + 8 * rg + 4 * hi;
                    v2u w; w.x = pk2(acc[i][jn][4 * rg] + bias, acc[i][jn][4 * rg + 1] + bias); w.y = pk2(acc[i][jn][4 * rg + 2] + bias, acc[i][jn][4 * rg + 3] + bias);
                    *(LAS v2u*)(OUT + p * OP + c) = w; } }
        __syncthreads();
#ifdef GATE_DUP_EPI
        for (int dup_ = 0; dup_ < 2; ++dup_) {
#endif
#pragma unroll
        for (int j = 0; j < 8; ++j) { const int p = (tid >> 5) + 16 * j; const size_t off = (size_t)(t0 + p) * GM_HALF + h * 256 + 8 * ck;
            const v4u oo = *(const LAS v4u*)(OUT + p * OP + 8 * ck); v4u g;
#pragma unroll
            for (int e = 0; e < 4; ++e) g[e] = pk2(bf_lo(uo[j][e]) * bf_lo(oo[e]), bf_hi(uo[j][e]) * bf_hi(oo[e]));
            *(v4u*)(GG + off) = g; }
#ifdef GATE_DUP_EPI
        }
#endif
        __syncthreads();
    }
}
__device__ __forceinline__ void gate_phase(Frame& F) {
    for (int uid = F.bx; uid < 2 * (NLAT / 128); uid += F.G) gate_unit(F, (uid >> 1) * 128, 4 * (uid & 1), 4, true);
    if ((F.bx & 15) == 0 && (F.bx >> 4) < 16) { const int su = F.bx >> 4; gate_unit(F, NLAT + (su >> 3) * 128, su & 7, 1, true); }
}

template <int MODE> __device__ __forceinline__ void attn_phase(Frame& F, char* lds_generic) {
    using abf = attn_body::bf16;
    const abf* Q = (const abf*)(F.ws + WS_Q); const abf* K = (const abf*)(F.ws + WS_K); const abf* V = (const abf*)(F.ws + WS_V); abf* O = (abf*)(F.ws + WS_O);
    constexpr int U = 1024; const int per = (U + F.G - 1) / F.G;
    float mstat = 0.f;
    if (MODE == 0) { const float* gq = argp(I_FAQN); const float* gk = argp(I_FAKN); float mq = 0.f, mk = 0.f;
        for (int d = 0; d < 64; ++d) { mq = fmaxf(mq, fabsf(gq[d])); mk = fmaxf(mk, fabsf(gk[d])); }
        mstat = fminf(64.f * QSCALE * mq * mk, 100.f); }
    for (int i = 0; i <= per; ++i) {
        int h, kvh, q0, NT, kbase; float sink = 0.f;
        if (i < per) { const int id = F.vcu * per + i; if (id >= U) continue; const int x = id >> 7, r = id & 127; const int qb = (r >> 2) * 2 + (r & 1);
            q0 = 256 * qb;
            if (MODE == 0) { kvh = x >> 1; h = kvh * 4 + (x & 1) * 2 + ((r & 3) >> 1); NT = T / 64; kbase = 0; }
            else { h = 2 * x + ((r & 3) >> 1); kvh = h >> 3; const int ks = q0 >= 128 ? q0 - 128 : 0, ke = (q0 + 384) < NLAT ? (q0 + 384) : NLAT; kbase = ks; NT = 4 + (ke - ks) / 64; sink = argp(I_WASK)[h] * LOG2E; } }
        else { if (MODE != 0) continue; if ((F.vcu & 15) != 0 || (F.vcu >> 4) >= 16) continue; h = F.vcu >> 4; kvh = h >> 2; q0 = NLAT; NT = 4; kbase = NLAT; }
        if constexpr (MODE == 0) { attn_body::attn_unit_q8<256>(h, kvh, q0, NT, kbase, mstat, (const unsigned char*)(F.ws + WS_Q8), (const unsigned char*)(F.ws + WS_K8), V, O, lds_generic);
        if (CONV_DEFER && i < per && i == (F.vcu & 3)) {
            const int c1 = (int)F.MISC[MW_CONV];
            conv_range2(F, 1, c1, CONV_PER_LAYER, F.vcu, F.G);
            conv_range2(F, 2, 0, CONV_ATTN_L2, F.vcu, F.G); } }
        else attn_body::attn_unit<1, 128, 8>(h, kvh, q0, NT, kbase, sink, Q, K, V, O, lds_generic);
    }
    if (CONV_DEFER && MODE == 0) { __syncthreads(); if (otid() == 0) F.MISC[MW_CONV] = (unsigned)CONV_PER_LAYER; }
}
struct CtxEpiY { bf16* Y; const float* bias;
    __device__ __forceinline__ void operator()(int row, int col, float (&v)[4]) const { const f32x4 b = *(const f32x4*)(bias + col);
        v2u w; w.x = pk2(v[0] + b[0], v[1] + b[1]); w.y = pk2(v[2] + b[2], v[3] + b[3]); *(v2u*)(Y + (size_t)row * DM + col) = w; } };
struct CtxEpiGelu { bf16* U; bf16* V; const float* bias; float* pstat;
    __device__ __forceinline__ void operator()(int row, int col, float (&v)[4]) const { const f32x4 b = *(const f32x4*)(bias + col);
        const pg8::f32x2 a = pg8::gelu_pk((pg8::f32x2){v[0] + b[0], v[1] + b[1]}), c = pg8::gelu_pk((pg8::f32x2){v[2] + b[2], v[3] + b[3]});
        v2u w; w.x = pk2(a.x, a.y); w.y = pk2(c.x, c.y); bf16* dst = col < GM_HALF ? U + (size_t)row * GM_HALF + col : V + (size_t)row * GM_HALF + (col - GM_HALF); *(v2u*)dst = w;
        if (col >= GM_HALF) { float s = (a.x + a.y) + (c.x + c.y), s2 = (a.x * a.x + a.y * a.y) + (c.x * c.x + c.y * c.y);
            s += __shfl_xor(s, 1); s += __shfl_xor(s, 2); s += __shfl_xor(s, 4); s += __shfl_xor(s, 8); s2 += __shfl_xor(s2, 1); s2 += __shfl_xor(s2, 2); s2 += __shfl_xor(s2, 4); s2 += __shfl_xor(s2, 8);
            if ((col & 63) == 0) *(f32x2*)(pstat + ((size_t)row * 32 + ((col - GM_HALF) >> 6)) * 2) = (f32x2){s, s2}; } } };
template <int NKV, bool RMS> struct CtxEpiQKV { bf16* Q; const float* bias; const float* qn; const float* kn;
    __device__ __forceinline__ void operator()(int row, int col, float (&v)[4]) const {
        const int hh = col >> 6, d = col & 63; const int kind = hh < 16 ? 0 : (hh < 16 + NKV ? 1 : 2);
        const f32x4 b = *(const f32x4*)(bias + col);
#pragma unroll
        for (int i = 0; i < 4; ++i) v[i] += b[i];
        if (RMS) { float ss = (v[0] * v[0] + v[1] * v[1]) + (v[2] * v[2] + v[3] * v[3]);
            ss += __shfl_xor(ss, 1); ss += __shfl_xor(ss, 2); ss += __shfl_xor(ss, 4); ss += __shfl_xor(ss, 8);
            const float rs = 1.f / sqrtf(ss * (1.f / 64.f) + RMS_EPS); const f32x4 gq = *(const f32x4*)(qn + d), gk = *(const f32x4*)(kn + d);
            if (kind < 2) {
#pragma unroll
                for (int i = 0; i < 4; ++i) v[i] = v[i] * rs * (kind == 0 ? gq[i] : gk[i]); } }
        if (kind == 0) {
#pragma unroll
            for (int i = 0; i < 4; ++i) v[i] *= QSCALE; }
        const int pitch = kind == 0 ? DM : NKV * 64, hd = kind == 0 ? hh : (kind == 1 ? hh - 16 : hh - 16 - NKV);
        const size_t doff = kind == 0 ? (size_t)0 : (kind == 1 ? (size_t)(WS_K - WS_Q) : (size_t)(WS_V - WS_Q));
        if (RMS && kind < 2) { *(unsigned*)((char*)Q + (kind == 0 ? (size_t)(WS_Q8 - WS_Q) : (size_t)(WS_K8 - WS_Q)) + (size_t)row * pitch + hd * 64 + d) = pk4f8(v[0], v[1], v[2], v[3]); return; }
        v2u w; w.x = pk2(v[0], v[1]); w.y = pk2(v[2], v[3]); *(v2u*)((bf16*)((char*)Q + doff) + (size_t)row * pitch + hd * 64 + d) = w; } };
template <class Epi> __device__ __forceinline__ void ctx_gemm(Frame& F, const bf16* A, const bf16* Bt, int N, int K, int rowmode, const Epi& E) {
    const int tid = otid(), lane = tid & 63, r32 = lane & 31, hi = lane >> 5;
    LAS float* PART = (LAS float*)(F.lds);
    const int nblk = 8 * (N / 64), kw = K / 8;
    for (int b = F.bx; b < nblk; b += F.G) { const int rb = b & 7, cb = b >> 3;
        const bf16* ap = A + (size_t)(NLAT + rb * 32 + r32) * K + F.wave * kw + 8 * hi;
        const int n0 = cb * 64 + r32, n1 = n0 + 32;
        const bf16* bp0 = Bt + (size_t)(rowmode ? qkv_rowmap(n0) : n0) * K + F.wave * kw + 8 * hi;
        const bf16* bp1 = Bt + (size_t)(rowmode ? qkv_rowmap(n1) : n1) * K + F.wave * kw + 8 * hi;
        f32x16 acc0 = f32x16{}, acc1 = f32x16{};
        for (int k = 0; k < kw; k += 128) { bf16x8 a[8], b0[8], b1[8];
#pragma unroll
            for (int i = 0; i < 8; ++i) { a[i] = *(const bf16x8*)(ap + k + 16 * i); b0[i] = *(const bf16x8*)(bp0 + k + 16 * i); b1[i] = *(const bf16x8*)(bp1 + k + 16 * i); }
#pragma unroll
            for (int i = 0; i < 8; ++i) { acc0 = __builtin_amdgcn_mfma_f32_32x32x16_bf16(a[i], b0[i], acc0, 0, 0, 0); acc1 = __builtin_amdgcn_mfma_f32_32x32x16_bf16(a[i], b1[i], acc1, 0, 0, 0); } }
#pragma unroll
        for (int r = 0; r < 16; ++r) { const int rw = (r & 3) + 8 * (r >> 2) + 4 * hi; PART[(F.wave * 32 + rw) * 66 + r32] = acc0[r]; PART[(F.wave * 32 + rw) * 66 + 32 + r32] = acc1[r]; }
        __syncthreads();
        { const int row = tid >> 4, c4 = (tid & 15) * 4; float v[4] = {0.f, 0.f, 0.f, 0.f};
#pragma unroll
            for (int w = 0; w < 8; ++w) { const LAS float* p = PART + (w * 32 + row) * 66 + c4; v[0] += p[0]; v[1] += p[1]; v[2] += p[2]; v[3] += p[3]; }
            E(NLAT + rb * 32 + row, cb * 64 + c4, v); }
        __syncthreads();
    }
}
struct Args { const float* in[N_IN]; float* out; unsigned char* ws; int ph_lo, ph_hi; };
static_assert(sizeof(Args) == N_IN * 8 + 8 + 8 + 8, "Args has no padding");

#ifndef MOE_WGM_UP
#define MOE_WGM_UP 4
#endif
#ifndef MOE_WGM_DN
#define MOE_WGM_DN 4
#endif
template <int ACT> __device__ __forceinline__ void tok_gemm(Frame& F, const bf16* A, const bf16* Bt, int N, int K, const pg8::EpiBf16<ACT>& E) {
    pg8::Gemm g{A, Bt, K, K, K, (unsigned)(128 * K * 2), (unsigned)(128 * K * 2)};
    TokOrder S; S.init(NLAT / 256, N / 256, F.G, F.bx); S.apan = (size_t)256 * K * 2; S.bpan = (size_t)256 * K * 2;
    pg8::gemm_phase<pg8::EpiBf16<ACT>, TokOrder, true, true>(F.lds + RING_OFF, g, S, E);
}
template <int L> __device__ __forceinline__ void moe_up(Frame& F) {
    moe_tables<L>(F);
    pg8::Gemm g{(const bf16*)(F.ws + WS_H8), (const bf16*)(F.ws + WS_WEXP_GU + (size_t)L * 32 * 2048 * 1024), 512, 512, 512, 128 * 512 * 2, 128 * 512 * 2};
    MoeOrderG S; S.init((int)F.MISC[MW_NMT], 8, F.G, F.bx, MOE_WGM_UP); S.mte = F.MISC + MW_MTE; S.bexp = (size_t)2048 * 1024; S.bpan = (size_t)256 * 1024; S.stok = (const unsigned*)(F.ws + WS_STOK); S.rowbytes = 1024u;
    EpiSwiGLU E{(unsigned char*)(F.ws + WS_ACT), argp(I_EBGU) + (size_t)L * 32 * 2048};
    pg8::gemm_phase<EpiSwiGLU, MoeOrderG, true, true, true, true>(F.lds + RING_OFF, g, S, E);
    if (CONV_DEFER && L < 3) {
        conv_tail(F, L + 1, ((int)F.MISC[MW_NMT] * 8) % F.G, CONV_UP_PER); }
}
template <int L> __device__ __forceinline__ void moe_down(Frame& F) {
    if (MK_PER_PHASE) moe_tables<L>(F);
    pg8::Gemm g{(const bf16*)(F.ws + WS_ACT), (const bf16*)(F.ws + WS_WEXP_DN + (size_t)L * 32 * 1024 * 1024), 512, 512, 512, 128 * 512 * 2, 128 * 512 * 2};
    MoeOrder S; S.init((int)F.MISC[MW_NMT], 4, F.G, F.bx, MOE_WGM_DN); S.mte = F.MISC + MW_MTE; S.bexp = (size_t)1024 * 1024; S.apan = (size_t)256 * 1024; S.bpan = (size_t)256 * 1024;
    EpiDown E{(bf16*)(F.ws + WS_YS), argp(I_EBD) + (size_t)L * 32 * 1024, (const unsigned*)(F.ws + WS_STOK)};
    pg8::gemm_phase<EpiDown, MoeOrder, true, true, false, true>(F.lds + RING_OFF, g, S, E);
    if (CONV_DEFER && L < 3) {
        conv_tail(F, L + 1, ((int)F.MISC[MW_NMT] * 4) % F.G, CONV_DN_PER); }
}

__global__ void __launch_bounds__(NTHR, 2) mk_fwd(Args args) {
    extern __shared__ __attribute__((aligned(16))) unsigned char lds[];
    Frame F;
    F.lds = (LAS unsigned char*)lds;
    F.MISC = (volatile LAS unsigned*)(F.lds + MISC_OFF);
    F.wave = __builtin_amdgcn_readfirstlane((int)threadIdx.x >> 6);
    F.G = gridDim.x; F.bx = blockIdx.x; F.vcu = (F.G % 8 == 0) ? (F.bx % 8) * (F.G / 8) + F.bx / 8 : F.bx;
    F.ws = args.ws; F.ctl = (gu32*)(args.ws + WS_CTL);
    for (int u = threadIdx.x; u < (LDS_BYTES - MISC_OFF) / 4; u += NTHR) ((LAS unsigned*)(F.lds + MISC_OFF))[u] = 0u;
    __syncthreads();
    XcdBarrier bar; bar.bar = (unsigned*)(F.ctl + CW_BAR); bar.x = 0; bar.st = nullptr;
    if (!MK_PER_PHASE) bar = xcd_barrier_post((unsigned*)(F.ctl + CW_BAR), F.MISC + MW_BAR);
    const int lo = args.ph_lo, hi = args.ph_hi;
#ifdef MK_ONLY
#define IN(k) ((k) == MK_ONLY && lo <= (k))
#else
#define IN(k) (lo <= (k) && (k) < hi)
#endif
#define SEAM(k) do { if (IN(k) && IN((k) + 1)) xcd_barrier(bar); } while (0)
#ifdef MK_REP_MASK
#define REP(k) (((MK_REP_MASK >> (k)) & 1ull) ? 2 : 1)
#else
#define REP(k) 1
#endif
#ifdef MK_PROBE_MASK
#define STAMP(k) do { if (threadIdx.x == 0) { const unsigned long long t_ = __builtin_amdgcn_s_memrealtime(); F.MISC[512 + 2 * (k)] = (unsigned)t_; F.MISC[513 + 2 * (k)] = (unsigned)(t_ >> 32); } } while (0)
#else
#define STAMP(k) do {} while (0)
#endif
    const bf16* Hb = (const bf16*)(F.ws + WS_H); bf16* Yb = (bf16*)(F.ws + WS_Y);

    STAMP(0); if (IN(0)) for (int rep_ = 0; rep_ < REP(0); ++rep_) { if (rep_) xcd_barrier(bar); asm volatile("; MK_PHASE_0" ::: "memory"); p0_prologue(F); } SEAM(0);
    STAMP(1); if (IN(1)) for (int rep_ = 0; rep_ < REP(1); ++rep_) { if (rep_) xcd_barrier(bar); asm volatile("; MK_PHASE_1" ::: "memory"); pass_init(F); } SEAM(1);
    STAMP(2); if (IN(2)) for (int rep_ = 0; rep_ < REP(2); ++rep_) { if (rep_) xcd_barrier(bar); asm volatile("; MK_PHASE_2" ::: "memory"); if ((EN_MIX >> 0) & 1) {
        { pg8::Gemm g{(const bf16*)(F.ws + TB_FC), Hb, 256, 256, 128 * DM, 128 * 256 * 2, DM * 2};
          ChDftOrder S; S.init(2, 256, F.G, F.bx); EpiChDft E{(bf16*)(F.ws + WS_BTA)};
          pg8::gemm_phase<EpiChDft, ChDftOrder, true, true>(F.lds + RING_OFF, g, S, E); }
#ifndef NO_CTX_DFT
        { pg8::Gemm g{(const bf16*)(F.ws + TB_FC), Hb, 256, 256, DM, 128 * 256 * 2, 128 * DM * 2};
          ChDftCtxOrder S; S.init(2, 4, F.G, F.bx); EpiChDftCtx E{(bf16*)(F.ws + WS_BTX)};
          pg8::gemm_phase<EpiChDftCtx, ChDftCtxOrder, true, true>(F.lds + RING_OFF, g, S, E); }
#endif
        } } SEAM(2);
    STAMP(3); if (IN(3)) for (int rep_ = 0; rep_ < REP(3); ++rep_) { if (rep_) xcd_barrier(bar); asm volatile("; MK_PHASE_3" ::: "memory"); if ((EN_MIX >> 0) & 1) {
        { pg8::Gemm g{(const bf16*)(F.ws + TB_FA), (const bf16*)(F.ws + WS_BTA), 256, 256, 256, 128 * 256 * 2, 128 * 256 * 2};
          TokOrder S; S.init(1, 512, F.G, F.bx); S.apan = 0; S.bpan = (size_t)256 * 256 * 2;
          EpiStepA E{(bf16*)(F.ws + WS_BTC), (const float*)(F.ws + TB_TWC), (const float*)(F.ws + TB_TWS)};
          pg8::gemm_phase<EpiStepA, TokOrder, true, true>(F.lds + RING_OFF, g, S, E); }
        } } SEAM(3);
    STAMP(4); if (IN(4)) for (int rep_ = 0; rep_ < REP(4); ++rep_) { if (rep_) xcd_barrier(bar); asm volatile("; MK_PHASE_4" ::: "memory"); if ((EN_MIX >> 0) & 1) {
        { pg8::Gemm g{(const bf16*)(F.ws + TB_FCC), (const bf16*)(F.ws + WS_BTC), 256, 256, 256, 128 * 256 * 2, 128 * 256 * 2};
        TokOrder S; S.init(1, 512, F.G, F.bx); S.apan = 0; S.bpan = (size_t)256 * 256 * 2;
        EpiStepC E{(bf16*)(F.ws + WS_MIXB)};
        pg8::gemm_phase<EpiStepC, TokOrder, true, true>(F.lds + RING_OFF, g, S, E); }
#ifndef NO_CTX_DFT
        { pg8::Gemm g{(const bf16*)(F.ws + TB_FX), (const bf16*)(F.ws + WS_BTX), 512, 512, 512, 128 * 512 * 2, 128 * 512 * 2};
          TokOrder S; S.init(1, 4, F.G, F.bx); S.apan = 0; S.bpan = (size_t)256 * 512 * 2;
          EpiCtxPos E{(bf16*)(F.ws + WS_MIXB)};
          pg8::gemm_phase<EpiCtxPos, TokOrder, true, true>(F.lds + RING_OFF, g, S, E); }
#endif
        } } SEAM(4);
    STAMP(5); if (IN(5)) for (int rep_ = 0; rep_ < REP(5); ++rep_) { if (rep_) xcd_barrier(bar); asm volatile("; MK_PHASE_5" ::: "memory"); if ((EN_MIX >> 0) & 1) { pg8::EpiBf16<0> E{Yb, DM, argp(I_FNB), 0, 0, 1.f}; tok_gemm<0>(F, (const bf16*)(F.ws + WS_MIXB), (const bf16*)(F.ws + WS_WFN), DM, DM, E);
        ctx_gemm(F, (const bf16*)(F.ws + WS_MIXB), (const bf16*)(F.ws + WS_WFN), DM, DM, 0, CtxEpiY{Yb, argp(I_FNB)}); } } SEAM(5);
    STAMP(6); if (IN(6)) for (int rep_ = 0; rep_ < REP(6); ++rep_) { if (rep_) xcd_barrier(bar); asm volatile("; MK_PHASE_6" ::: "memory"); pass_mix<0>(F); } SEAM(6);
    STAMP(7); if (IN(7)) for (int rep_ = 0; rep_ < REP(7); ++rep_) { if (rep_) xcd_barrier(bar); asm volatile("; MK_PHASE_7" ::: "memory"); }
    STAMP(8); if (IN(8)) for (int rep_ = 0; rep_ < REP(8); ++rep_) { if (rep_) xcd_barrier(bar); asm volatile("; MK_PHASE_8" ::: "memory"); if ((EN_MOE >> 0) & 1) moe_up<0>(F); } SEAM(8);
    STAMP(9); if (IN(9)) for (int rep_ = 0; rep_ < REP(9); ++rep_) { if (rep_) xcd_barrier(bar); asm volatile("; MK_PHASE_9" ::: "memory"); if ((EN_MOE >> 0) & 1) moe_down<0>(F); } SEAM(9);
    STAMP(10); if (IN(10)) for (int rep_ = 0; rep_ < REP(10); ++rep_) { if (rep_) xcd_barrier(bar); asm volatile("; MK_PHASE_10" ::: "memory"); pass_comb<0>(F); } SEAM(10);
    STAMP(11); if (IN(11)) for (int rep_ = 0; rep_ < REP(11); ++rep_) { if (rep_) xcd_barrier(bar); asm volatile("; MK_PHASE_11" ::: "memory"); if ((EN_MIX >> 1) & 1) {
        pg8::Gemm g{Hb, (const bf16*)(F.ws + WS_WFAQ), DM, DM, DM, 128 * DM * 2, 128 * DM * 2};
        TokOrder S; S.init(NLAT / 256, FA_NQKV / 256, F.G, F.bx); S.apan = (size_t)256 * DM * 2; S.bpan = (size_t)256 * DM * 2;
        EpiQKV<4, true> E{(bf16*)(F.ws + WS_Q), (bf16*)(F.ws + WS_K), (bf16*)(F.ws + WS_V), argp(I_FABQ), argp(I_FAQN), argp(I_FAKN), (const float*)(F.ws + TB_ROPC), (const float*)(F.ws + TB_ROPS)};
        pg8::gemm_phase<EpiQKV<4, true>, TokOrder, true, true>(F.lds + RING_OFF, g, S, E);
        if (CONV_DEFER) conv_tail(F, 1, ((NLAT / 256) * (FA_NQKV / 256)) % F.G, CONV_QKV_PER);
        ctx_gemm(F, Hb, (const bf16*)(F.ws + WS_WFAQ), FA_NQKV, DM, 1, CtxEpiQKV<4, true>{(bf16*)(F.ws + WS_Q), argp(I_FABQ), argp(I_FAQN), argp(I_FAKN)}); } } SEAM(11);
    STAMP(12); if (IN(12)) for (int rep_ = 0; rep_ < REP(12); ++rep_) { if (rep_) xcd_barrier(bar); asm volatile("; MK_PHASE_12" ::: "memory"); if ((EN_MIX >> 1) & 1) attn_phase<0>(F, (char*)lds + RING_OFF); } SEAM(12);
    STAMP(13); if (IN(13)) for (int rep_ = 0; rep_ < REP(13); ++rep_) { if (rep_) xcd_barrier(bar); asm volatile("; MK_PHASE_13" ::: "memory"); if ((EN_MIX >> 1) & 1) { pg8::EpiBf16<0> E{Yb, DM, argp(I_FABO), 0, 0, 1.f}; tok_gemm<0>(F, (const bf16*)(F.ws + WS_O), (const bf16*)(F.ws + WS_WFAO), DM, DM, E);
        ctx_gemm(F, (const bf16*)(F.ws + WS_O), (const bf16*)(F.ws + WS_WFAO), DM, DM, 0, CtxEpiY{Yb, argp(I_FABO)}); } } SEAM(13);
    STAMP(14); if (IN(14)) for (int rep_ = 0; rep_ < REP(14); ++rep_) { if (rep_) xcd_barrier(bar); asm volatile("; MK_PHASE_14" ::: "memory"); pass_mix<1>(F); } SEAM(14);
    STAMP(15); if (IN(15)) for (int rep_ = 0; rep_ < REP(15); ++rep_) { if (rep_) xcd_barrier(bar); asm volatile("; MK_PHASE_15" ::: "memory"); }
    STAMP(16); if (IN(16)) for (int rep_ = 0; rep_ < REP(16); ++rep_) { if (rep_) xcd_barrier(bar); asm volatile("; MK_PHASE_16" ::: "memory"); if ((EN_MOE >> 1) & 1) moe_up<1>(F); } SEAM(16);
    STAMP(17); if (IN(17)) for (int rep_ = 0; rep_ < REP(17); ++rep_) { if (rep_) xcd_barrier(bar); asm volatile("; MK_PHASE_17" ::: "memory"); if ((EN_MOE >> 1) & 1) moe_down<1>(F); } SEAM(17);
    STAMP(18); if (IN(18)) for (int rep_ = 0; rep_ < REP(18); ++rep_) { if (rep_) xcd_barrier(bar); asm volatile("; MK_PHASE_18" ::: "memory"); pass_comb<1>(F); } SEAM(18);
    STAMP(19); if (IN(19)) for (int rep_ = 0; rep_ < REP(19); ++rep_) { if (rep_) xcd_barrier(bar); asm volatile("; MK_PHASE_19" ::: "memory"); if ((EN_MIX >> 2) & 1) {
        { pg8::Gemm g{Hb, (const bf16*)(F.ws + WS_WGI), DM, DM, DM, 128 * DM * 2, 128 * DM * 2};
          TokOrder S; S.init(NLAT / 256, GM_FF / 256, F.G, F.bx); S.apan = (size_t)256 * DM * 2; S.bpan = (size_t)256 * DM * 2;
          EpiGeluUV E{(bf16*)(F.ws + WS_GU), (bf16*)(F.ws + WS_GV), argp(I_GMBI), (float*)(F.ws + WS_PSTAT)};
          pg8::gemm_phase<EpiGeluUV, TokOrder, true, true>(F.lds + RING_OFF, g, S, E); }
        ctx_gemm(F, Hb, (const bf16*)(F.ws + WS_WGI), GM_FF, DM, 0, CtxEpiGelu{(bf16*)(F.ws + WS_GU), (bf16*)(F.ws + WS_GV), argp(I_GMBI), (float*)(F.ws + WS_PSTAT)}); } } SEAM(19);
    STAMP(20); if (IN(20)) for (int rep_ = 0; rep_ < REP(20); ++rep_) { if (rep_) xcd_barrier(bar); asm volatile("; MK_PHASE_20" ::: "memory"); if ((EN_MIX >> 2) & 1) gate_phase(F); } SEAM(20);
    STAMP(21); if (IN(21)) for (int rep_ = 0; rep_ < REP(21); ++rep_) { if (rep_) xcd_barrier(bar); asm volatile("; MK_PHASE_21" ::: "memory"); if ((EN_MIX >> 2) & 1) { pg8::EpiBf16<0> E{Yb, DM, argp(I_GMBO), 0, 0, 1.f}; tok_gemm<0>(F, (const bf16*)(F.ws + WS_GG), (const bf16*)(F.ws + WS_WGO), DM, GM_HALF, E);
        ctx_gemm(F, (const bf16*)(F.ws + WS_GG), (const bf16*)(F.ws + WS_WGO), DM, GM_HALF, 0, CtxEpiY{Yb, argp(I_GMBO)}); } } SEAM(21);
    STAMP(22); if (IN(22)) for (int rep_ = 0; rep_ < REP(22); ++rep_) { if (rep_) xcd_barrier(bar); asm volatile("; MK_PHASE_22" ::: "memory"); pass_mix<2>(F); } SEAM(22);
    STAMP(23); if (IN(23)) for (int rep_ = 0; rep_ < REP(23); ++rep_) { if (rep_) xcd_barrier(bar); asm volatile("; MK_PHASE_23" ::: "memory"); }
    STAMP(24); if (IN(24)) for (int rep_ = 0; rep_ < REP(24); ++rep_) { if (rep_) xcd_barrier(bar); asm volatile("; MK_PHASE_24" ::: "memory"); if ((EN_MOE >> 2) & 1) moe_up<2>(F); } SEAM(24);
    STAMP(25); if (IN(25)) for (int rep_ = 0; rep_ < REP(25); ++rep_) { if (rep_) xcd_barrier(bar); asm volatile("; MK_PHASE_25" ::: "memory"); if ((EN_MOE >> 2) & 1) moe_down<2>(F); } SEAM(25);
    STAMP(26); if (IN(26)) for (int rep_ = 0; rep_ < REP(26); ++rep_) { if (rep_) xcd_barrier(bar); asm volatile("; MK_PHASE_26" ::: "memory"); pass_comb<2>(F); } SEAM(26);
    STAMP(27); if (IN(27)) for (int rep_ = 0; rep_ < REP(27); ++rep_) { if (rep_) xcd_barrier(bar); asm volatile("; MK_PHASE_27" ::: "memory"); if ((EN_MIX >> 3) & 1) {
        pg8::Gemm g{Hb, (const bf16*)(F.ws + WS_WWQ), DM, DM, DM, 128 * DM * 2, 128 * DM * 2};
        TokOrder S; S.init(NLAT / 256, WA_NQKV / 256, F.G, F.bx); S.apan = (size_t)256 * DM * 2; S.bpan = (size_t)256 * DM * 2;
        EpiQKV<2, false> E{(bf16*)(F.ws + WS_Q), (bf16*)(F.ws + WS_K), (bf16*)(F.ws + WS_V), argp(I_WABQ), nullptr, nullptr, (const float*)(F.ws + TB_ROPC), (const float*)(F.ws + TB_ROPS)};
        pg8::gemm_phase<EpiQKV<2, false>, TokOrder, true, true>(F.lds + RING_OFF, g, S, E);
        if (CONV_DEFER) conv_tail(F, 3, ((NLAT / 256) * (WA_NQKV / 256)) % F.G, CONV_QKV_PER);
        ctx_gemm(F, Hb, (const bf16*)(F.ws + WS_WWQ), WA_NQKV, DM, 1, CtxEpiQKV<2, false>{(bf16*)(F.ws + WS_Q), argp(I_WABQ), argp(I_WABQ), argp(I_WABQ)}); } } SEAM(27);
    STAMP(28); if (IN(28)) for (int rep_ = 0; rep_ < REP(28); ++rep_) { if (rep_) xcd_barrier(bar); asm volatile("; MK_PHASE_28" ::: "memory"); if ((EN_MIX >> 3) & 1) attn_phase<1>(F, (char*)lds + RING_OFF); } SEAM(28);
    STAMP(29); if (IN(29)) for (int rep_ = 0; rep_ < REP(29); ++rep_) { if (rep_) xcd_barrier(bar); asm volatile("; MK_PHASE_29" ::: "memory"); if ((EN_MIX >> 3) & 1) { pg8::EpiBf16<0> E{Yb, DM, argp(I_WABO), 0, 0, 1.f}; tok_gemm<0>(F, (const bf16*)(F.ws + WS_O), (const bf16*)(F.ws + WS_WWO), DM, DM, E); } } SEAM(29);
    STAMP(30); if (IN(30)) for (int rep_ = 0; rep_ < REP(30); ++rep_) { if (rep_) xcd_barrier(bar); asm volatile("; MK_PHASE_30" ::: "memory"); pass_mix<3>(F); } SEAM(30);
    STAMP(31); if (IN(31)) for (int rep_ = 0; rep_ < REP(31); ++rep_) { if (rep_) xcd_barrier(bar); asm volatile("; MK_PHASE_31" ::: "memory"); }
    STAMP(32); if (IN(32)) for (int rep_ = 0; rep_ < REP(32); ++rep_) { if (rep_) xcd_barrier(bar); asm volatile("; MK_PHASE_32" ::: "memory"); if ((EN_MOE >> 3) & 1) moe_up<3>(F); } SEAM(32);
    STAMP(33); if (IN(33)) for (int rep_ = 0; rep_ < REP(33); ++rep_) { if (rep_) xcd_barrier(bar); asm volatile("; MK_PHASE_33" ::: "memory"); if ((EN_MOE >> 3) & 1) moe_down<3>(F); } SEAM(33);
    STAMP(34); if (IN(34)) for (int rep_ = 0; rep_ < REP(34); ++rep_) { if (rep_) xcd_barrier(bar); asm volatile("; MK_PHASE_34" ::: "memory"); pass_comb<3>(F); }
#ifdef MK_PROBE_MASK
    STAMP(35); __syncthreads();
    { float us = 0.f;
      for (int k = 0; k < 35; ++k) if ((MK_PROBE_MASK >> k) & 1ull) { const unsigned long long a = ((unsigned long long)F.MISC[513 + 2 * k] << 32) | F.MISC[512 + 2 * k], b = ((unsigned long long)F.MISC[515 + 2 * k] << 32) | F.MISC[514 + 2 * k]; us += (float)(b - a) * 0.01f; }
      const float cval = us / (float)(MK_PROBE_DIV);
      const int lane = threadIdx.x & 63, gw = F.vcu * NWAVES + F.wave, NGW = F.G * NWAVES; RowV r;
      for (int j = 0; j < 4; ++j) r.v[j] = (f32x4){cval, cval, cval, cval};
      float* outp = (float*)argp(N_IN);
      for (int m = gw; m < NLAT; m += NGW) strow(outp + (size_t)m * DM, lane, r); }
#endif
#undef IN
#undef SEAM
}

extern "C" void kernel_launch(void* const* d_in, const int* in_sizes, int n_in, void* d_out, int out_size, void* d_ws, size_t ws_size, hipStream_t stream) {
    static int grid = 0;
    if (grid == 0) {
        if (n_in != N_IN || in_sizes[0] != NLAT * DM || out_size != NLAT * DM || ws_size < WS_END) { fprintf(stderr, "kernel_launch: unexpected shapes (n_in %d, in0 %d, out %d, ws %zu)\n", n_in, n_in > 0 ? in_sizes[0] : -1, out_size, ws_size); grid = -1; return; }
        int dev = 0, cus = 0, per_cu = 0;
        if (hipGetDevice(&dev) != hipSuccess || hipDeviceGetAttribute(&cus, hipDeviceAttributeMultiprocessorCount, dev) != hipSuccess) { grid = -1; return; }
        if (hipFuncSetAttribute((const void*)mk_fwd, hipFuncAttributeMaxDynamicSharedMemorySize, LDS_BYTES) != hipSuccess) { fprintf(stderr, "kernel_launch: hipFuncSetAttribute failed\n"); grid = -1; return; }
        if (hipOccupancyMaxActiveBlocksPerMultiprocessor(&per_cu, (const void*)mk_fwd, NTHR, LDS_BYTES) != hipSuccess || per_cu < 1) fprintf(stderr, "kernel_launch: occupancy query says %d\n", per_cu);
        (void)hipGetLastError();
        grid = cus;
    }
    if (grid < 0) return;
    if (hipMemsetAsync((char*)d_ws + WS_CTL, 0, CTL_ZERO_BYTES, stream) != hipSuccess) return;
    Args a{};
    for (int i = 0; i < N_IN; ++i) a.in[i] = (const float*)d_in[i];
    a.out = (float*)d_out; a.ws = (unsigned char*)d_ws;
#if MK_PER_PHASE
    for (int p = 0; p < NPHASE; ++p) { a.ph_lo = p; a.ph_hi = p + 1; hipLaunchKernelGGL(mk_fwd, dim3(grid), dim3(NTHR), LDS_BYTES, stream, a); }
#else
    a.ph_lo = 0; a.ph_hi = NPHASE; hipLaunchKernelGGL(mk_fwd, dim3(grid), dim3(NTHR), LDS_BYTES, stream, a);
#endif
}
```
